# Optimizing an MI355X kernel written in HIP

```python
import math
import jax, jax.numpy as jnp
from jax import lax
import numpy as np

D_MODEL = 1024
BATCH = 4
SEQ = 4096
DEPTH = 2

CHUNK = 64
RMS_EPS = 1e-6

SSM_GROUP = 16
SSM_WIDTH = D_MODEL // 4
SSM_GROUPS = SSM_WIDTH // SSM_GROUP
SSM_STATE = 64
GMLP_HEADS = 4
GMLP_HEAD_DIM = 64
GMLP_WIDTH = GMLP_HEADS * GMLP_HEAD_DIM
GMLP_BLOCK = 128
ATT_HEADS = 8
ATT_HEAD_DIM = 64
ATT_WIDTH = ATT_HEADS * ATT_HEAD_DIM
KV_RANK = 128
IDX_HEADS = 4
IDX_DIM = 64
TOPK_MAX = 256
Q_BLOCK = 128

MIX_WIDTH = SSM_WIDTH + GMLP_WIDTH + ATT_WIDTH

IN_SIZES = (SSM_WIDTH, GMLP_WIDTH, GMLP_WIDTH, ATT_WIDTH, KV_RANK, IDX_HEADS * IDX_DIM, IDX_DIM, IDX_HEADS)
IN_WIDTH = sum(IN_SIZES)
IN_SPLITS = [sum(IN_SIZES[:i + 1]) for i in range(len(IN_SIZES) - 1)]

PEER_HEADS = 8
PEER_KEY_DIM = 128
PEER_N_KEYS = 128
PEER_N_EXPERTS = PEER_N_KEYS * PEER_N_KEYS
PEER_TOPK = 16
PEER_TOKEN_BLOCK = 128

kernel_name = "hybrid_s5_gmlp_dsa_peer_adaln"


def rms_norm(x, g):
    xf = x.astype(jnp.float32)
    y = xf * lax.rsqrt(jnp.mean(xf * xf, axis=-1, keepdims=True) + RMS_EPS)
    return (y * g.astype(jnp.float32)).astype(x.dtype)


def ssm_mixer(u, a_re_log, a_im, b_re, b_im, c_re, c_im, d_skip, log_dt, w_glu, b_glu):
    f32 = jnp.float32
    Bsz, L, _ = u.shape
    uf = u.astype(f32)
    ug = uf.reshape(Bsz, L, SSM_GROUPS, SSM_GROUP)
    lam_re = -jnp.exp(a_re_log.astype(f32))
    lam_im = a_im.astype(f32)
    dt = jnp.exp(log_dt.astype(f32))[:, None]
    mag = jnp.exp(lam_re * dt)
    abar_re = mag * jnp.cos(lam_im * dt)
    abar_im = mag * jnp.sin(lam_im * dt)
    den = lam_re * lam_re + lam_im * lam_im
    p = abar_re - 1.0
    q = abar_im
    f_re = (p * lam_re + q * lam_im) / den
    f_im = (q * lam_re - p * lam_im) / den
    br = b_re.astype(f32)
    bi = b_im.astype(f32)
    bb_re = f_re[..., None] * br - f_im[..., None] * bi
    bb_im = f_re[..., None] * bi + f_im[..., None] * br
    bu_re = jnp.einsum('gph,blgh->blgp', bb_re, ug)
    bu_im = jnp.einsum('gph,blgh->blgp', bb_im, ug)
    a_re_t = jnp.broadcast_to(abar_re, bu_re.shape)
    a_im_t = jnp.broadcast_to(abar_im, bu_re.shape)

    def combine(left, right):
        a1r, a1i, b1r, b1i = left
        a2r, a2i, b2r, b2i = right
        return (a1r * a2r - a1i * a2i,
                a1r * a2i + a1i * a2r,
                a2r * b1r - a2i * b1i + b2r,
                a2r * b1i + a2i * b1r + b2i)

    _, _, s_re, s_im = lax.associative_scan(combine, (a_re_t, a_im_t, bu_re, bu_im), axis=1)
    y = (jnp.einsum('ghp,blgp->blgh', c_re.astype(f32), s_re)
         - jnp.einsum('ghp,blgp->blgh', c_im.astype(f32), s_im))
    y = y.reshape(Bsz, L, SSM_WIDTH) + d_skip.astype(f32) * uf
    yg = jax.nn.gelu(y)
    out = yg * jax.nn.sigmoid(yg @ w_glu.astype(f32) + b_glu.astype(f32))
    return out.astype(u.dtype)


def gmlp_mixer(u, v, w_sp, b_sp):
    Bsz, L, _ = u.shape
    nb = L // GMLP_BLOCK
    vf = v.reshape(Bsz, nb, GMLP_BLOCK, GMLP_HEADS, GMLP_HEAD_DIM).astype(jnp.float32)
    mu = jnp.mean(vf, axis=-1, keepdims=True)
    var = jnp.mean(jnp.square(vf - mu), axis=-1, keepdims=True)
    vn = ((vf - mu) * lax.rsqrt(var + RMS_EPS)).astype(v.dtype)
    chunk_id = jnp.arange(GMLP_BLOCK) // CHUNK
    mask = chunk_id[:, None] >= chunk_id[None, :]
    w = jnp.where(mask[None], w_sp, 0.0)
    mixed = jnp.einsum('hts,bnshd->bnthd', w, vn) + b_sp.T[None, None, :, :, None]
    out = u.reshape(Bsz, nb, GMLP_BLOCK, GMLP_HEADS, GMLP_HEAD_DIM) * mixed
    return out.reshape(Bsz, L, GMLP_WIDTH)


def dsa_mixer(q, c_kv, q_idx, k_idx, w_idx, w_uk, w_uv):
    f32 = jnp.float32
    Bsz, L = q.shape[0], q.shape[1]
    topk = min(TOPK_MAX, L // 4)
    nqb = L // Q_BLOCK
    slopes = jnp.exp2(-8.0 * (jnp.arange(ATT_HEADS, dtype=f32) + 1.0) / ATT_HEADS)
    q_abs = jnp.einsum('blhd,hdr->blhr', q, w_uk) * (ATT_HEAD_DIM ** -0.5)
    w_scaled = w_idx * (IDX_HEADS ** -0.5)
    key_chunk = jnp.arange(L) // CHUNK
    b_ix = jnp.arange(Bsz)[:, None, None]

    def to_blocks(a):
        return jnp.moveaxis(a.reshape((Bsz, nqb, Q_BLOCK) + a.shape[2:]), 1, 0)

    def block_fn(args):
        qa, qi, wi, qpos = args
        s = jnp.einsum('bthd,bsd->bths', qi, k_idx) * (IDX_DIM ** -0.5)
        score = jnp.einsum('bth,bths->bts', wi, jax.nn.relu(s)).astype(f32)
        adm = key_chunk[None, :] <= (qpos // CHUNK)[:, None]
        score = jnp.where(adm[None], score, -jnp.inf)
        sel_score, sel = lax.top_k(score, topk)
        valid = jnp.isfinite(sel_score)
        kv = c_kv[b_ix, sel]
        logits = jnp.einsum('bthr,btkr->bthk', qa, kv).astype(f32)
        dist = jnp.abs(qpos[None, :, None] - sel).astype(f32)
        logits = logits - slopes[None, None, :, None] * dist[:, :, None, :]
        logits = jnp.where(valid[:, :, None, :], logits, -jnp.inf)
        probs = jax.nn.softmax(logits, axis=-1).astype(kv.dtype)
        return jnp.einsum('bthk,btkr->bthr', probs, kv)

    qpos_blocks = jnp.arange(L).reshape(nqb, Q_BLOCK)
    o = lax.map(block_fn, (to_blocks(q_abs), to_blocks(q_idx), to_blocks(w_scaled), qpos_blocks))
    o = jnp.moveaxis(o, 0, 1).reshape(Bsz, L, ATT_HEADS, KV_RANK)
    out = jnp.einsum('blhr,hrd->blhd', o, w_uv)
    return out.reshape(Bsz, L, ATT_WIDTH)


def peer_ffn(h, w_q, sub_k1, sub_k2, peer_u, peer_v):
    f32 = jnp.float32
    Bsz, L, D = h.shape
    half = PEER_KEY_DIM // 2
    q = (h @ w_q).reshape(Bsz, L, PEER_HEADS, 2, half)
    s1 = jnp.einsum('blhd,nd->blhn', q[..., 0, :], sub_k1).astype(f32)
    s2 = jnp.einsum('blhd,nd->blhn', q[..., 1, :], sub_k2).astype(f32)
    v1, i1 = lax.top_k(s1, PEER_TOPK)
    v2, i2 = lax.top_k(s2, PEER_TOPK)
    ncand = PEER_TOPK * PEER_TOPK
    cand = (v1[..., :, None] + v2[..., None, :]).reshape(Bsz, L, PEER_HEADS, ncand)
    cand_idx = (i1[..., :, None] * PEER_N_KEYS + i2[..., None, :]).reshape(Bsz, L, PEER_HEADS, ncand)
    top_s, pos = lax.top_k(cand, PEER_TOPK)
    experts = jnp.take_along_axis(cand_idx, pos, axis=-1)
    gates = jax.nn.softmax(top_s, axis=-1).astype(h.dtype)
    n_tok = Bsz * L
    nb = n_tok // PEER_TOKEN_BLOCK
    hk = PEER_HEADS * PEER_TOPK
    hb = h.reshape(nb, PEER_TOKEN_BLOCK, D)
    eb = experts.reshape(nb, PEER_TOKEN_BLOCK, hk)
    gb = gates.reshape(nb, PEER_TOKEN_BLOCK, hk)

    def block_fn(args):
        hx, e, g = args
        act = jax.nn.gelu(jnp.einsum('tkd,td->tk', peer_u[e], hx))
        return jnp.einsum('tk,tkd->td', g * act, peer_v[e])

    out = lax.map(block_fn, (hb, eb, gb))
    return out.reshape(Bsz, L, D)


def setup_inputs(seed: int = 0) -> dict:
    key = jax.random.key(seed)
    ks = iter(jax.random.split(key, 40))
    D = D_MODEL
    NL = DEPTH

    def nrm(shape, scale):
        return jax.random.normal(next(ks), shape, jnp.float32) * scale

    x = nrm((BATCH, SEQ, D), 1.0)
    c = nrm((BATCH, D), 1.0)
    norm1_g = 1.0 + nrm((NL, D), 0.02)
    norm2_g = 1.0 + nrm((NL, D), 0.02)
    w_mod = nrm((NL, D, 6 * D), 0.5 * D ** -0.5)
    b_mod = nrm((NL, 6 * D), 0.02)
    w_in = nrm((NL, D, IN_WIDTH), D ** -0.5)
    ssm_a_re_log = math.log(0.5) + nrm((NL, SSM_GROUPS, SSM_STATE), 0.01)
    ssm_a_im = math.pi * jnp.arange(SSM_STATE, dtype=jnp.float32)[None, None, :] + nrm((NL, SSM_GROUPS, SSM_STATE), 0.01)
    ssm_b_re = nrm((NL, SSM_GROUPS, SSM_STATE, SSM_GROUP), (2 * SSM_GROUP) ** -0.5)
    ssm_b_im = nrm((NL, SSM_GROUPS, SSM_STATE, SSM_GROUP), (2 * SSM_GROUP) ** -0.5)
    ssm_c_re = nrm((NL, SSM_GROUPS, SSM_GROUP, SSM_STATE), 2.0 * SSM_STATE ** -0.5)
    ssm_c_im = nrm((NL, SSM_GROUPS, SSM_GROUP, SSM_STATE), 2.0 * SSM_STATE ** -0.5)
    ssm_d = nrm((NL, SSM_WIDTH), 0.5)
    ssm_log_dt = jax.random.uniform(next(ks), (NL, SSM_GROUPS), jnp.float32, math.log(1e-3), math.log(1e-1))
    ssm_w_glu = nrm((NL, SSM_WIDTH, SSM_WIDTH), SSM_WIDTH ** -0.5)
    ssm_b_glu = nrm((NL, SSM_WIDTH), 0.02)
    gmlp_w_sp = nrm((NL, GMLP_HEADS, GMLP_BLOCK, GMLP_BLOCK), 0.05)
    gmlp_b_sp = 1.0 + nrm((NL, GMLP_HEADS, GMLP_BLOCK), 0.02)
    kv_norm_g = 1.0 + nrm((NL, KV_RANK), 0.02)
    w_uk = nrm((NL, ATT_HEADS, ATT_HEAD_DIM, KV_RANK), KV_RANK ** -0.5)
    w_uv = nrm((NL, ATT_HEADS, KV_RANK, ATT_HEAD_DIM), KV_RANK ** -0.5)
    w_out = nrm((NL, MIX_WIDTH, D), MIX_WIDTH ** -0.5)
    peer_w_q = nrm((NL, D, PEER_HEADS * PEER_KEY_DIM), D ** -0.5)
    peer_k1 = nrm((NL, PEER_N_KEYS, PEER_KEY_DIM // 2), (PEER_KEY_DIM // 2) ** -0.5)
    peer_k2 = nrm((NL, PEER_N_KEYS, PEER_KEY_DIM // 2), (PEER_KEY_DIM // 2) ** -0.5)
    peer_u = nrm((NL, PEER_N_EXPERTS, D), D ** -0.5)
    peer_v = nrm((NL, PEER_N_EXPERTS, D), 0.3)
    final_g = 1.0 + nrm((D,), 0.02)
    return {"x": x, "c": c, "norm1_g": norm1_g, "norm2_g": norm2_g, "w_mod": w_mod, "b_mod": b_mod,
            "w_in": w_in, "ssm_a_re_log": ssm_a_re_log, "ssm_a_im": ssm_a_im, "ssm_b_re": ssm_b_re,
            "ssm_b_im": ssm_b_im, "ssm_c_re": ssm_c_re, "ssm_c_im": ssm_c_im, "ssm_d": ssm_d,
            "ssm_log_dt": ssm_log_dt, "ssm_w_glu": ssm_w_glu, "ssm_b_glu": ssm_b_glu,
            "gmlp_w_sp": gmlp_w_sp, "gmlp_b_sp": gmlp_b_sp, "kv_norm_g": kv_norm_g, "w_uk": w_uk,
            "w_uv": w_uv, "w_out": w_out, "peer_w_q": peer_w_q, "peer_k1": peer_k1, "peer_k2": peer_k2,
            "peer_u": peer_u, "peer_v": peer_v, "final_g": final_g}


def reference(x, c, norm1_g, norm2_g, w_mod, b_mod, w_in, ssm_a_re_log, ssm_a_im, ssm_b_re, ssm_b_im,
              ssm_c_re, ssm_c_im, ssm_d, ssm_log_dt, ssm_w_glu, ssm_b_glu, gmlp_w_sp, gmlp_b_sp,
              kv_norm_g, w_uk, w_uv, w_out, peer_w_q, peer_k1, peer_k2, peer_u, peer_v, final_g):
    Bsz, L, _ = x.shape
    c_act = jax.nn.silu(c)
    for l in range(DEPTH):
        mod = c_act @ w_mod[l] + b_mod[l]
        sh1, sc1, g1, sh2, sc2, g2 = jnp.split(mod[:, None, :], 6, axis=-1)
        h = rms_norm(x, norm1_g[l]) * (1.0 + sc1) + sh1
        proj = h @ w_in[l]
        u_a, u_b, v_b, q, ckv, qi, ki, wi = jnp.split(proj, IN_SPLITS, axis=-1)
        y_a = ssm_mixer(u_a, ssm_a_re_log[l], ssm_a_im[l], ssm_b_re[l], ssm_b_im[l], ssm_c_re[l],
                        ssm_c_im[l], ssm_d[l], ssm_log_dt[l], ssm_w_glu[l], ssm_b_glu[l])
        y_b = gmlp_mixer(u_b, v_b, gmlp_w_sp[l], gmlp_b_sp[l])
        y_c = dsa_mixer(q.reshape(Bsz, L, ATT_HEADS, ATT_HEAD_DIM), rms_norm(ckv, kv_norm_g[l]),
                        qi.reshape(Bsz, L, IDX_HEADS, IDX_DIM), ki, wi, w_uk[l], w_uv[l])
        mix = jnp.concatenate([y_a, y_b, y_c], axis=-1)
        x = x + g1 * (mix @ w_out[l])
        h = rms_norm(x, norm2_g[l]) * (1.0 + sc2) + sh2
        x = x + g2 * peer_ffn(h, peer_w_q[l], peer_k1[l], peer_k2[l], peer_u[l], peer_v[l])
    return rms_norm(x, final_g)
```

```cpp
#include <hip/hip_runtime.h>
#include <cstdint>
#include <cstdio>

typedef unsigned short bf16;
typedef short bf16x8 __attribute__((ext_vector_type(8)));
typedef short s16x4 __attribute__((ext_vector_type(4)));
typedef float f32x4 __attribute__((ext_vector_type(4)));
typedef unsigned u32x4 __attribute__((ext_vector_type(4)));
typedef unsigned u32x2 __attribute__((ext_vector_type(2)));
typedef __bf16 bf2 __attribute__((ext_vector_type(2)));
#define DI __device__ __forceinline__
#define MFMA16(a, b, c) __builtin_amdgcn_mfma_f32_16x16x32_bf16((a), (b), (c), 0, 0, 0)

constexpr int DM = 1024, NB = 4, SEQ = 4096, NTOK = NB * SEQ;
constexpr int NPROJ = 2304;
constexpr int C_UA = 0, C_UB = 256, C_VB = 512, C_QA = 768, C_CKV = 1792, C_QI = 1920, C_KI = 2176, C_WI = 2240;
constexpr int KMIX = 1536;
constexpr int NEXP = 16384;
constexpr size_t SCORES_PER_BATCH = (size_t)4096 * 2080;

constexpr size_t al256(size_t x) { return (x + 255) & ~(size_t)255; }
constexpr size_t WS_CTL = 0;
constexpr size_t WS_MOD = 65536;
constexpr size_t WS_WTIN = al256(WS_MOD + 2 * 4 * 6144 * 4);
constexpr size_t WS_WTOUT = al256(WS_WTIN + (size_t)2 * NPROJ * 1024 * 2);
constexpr size_t WS_WTQ = al256(WS_WTOUT + (size_t)2 * 1024 * KMIX * 2);
constexpr size_t WS_WTGLU = al256(WS_WTQ + (size_t)2 * 1024 * 1024 * 2);
constexpr size_t WS_GW = al256(WS_WTGLU + (size_t)2 * 256 * 256 * 2);
constexpr size_t WS_PK = al256(WS_GW + (size_t)2 * 4 * 128 * 128 * 2);
constexpr size_t WS_PW = al256(WS_PK + (size_t)2 * 2 * 128 * 64 * 2);
constexpr size_t WS_BB = al256(WS_PW + (size_t)2 * 16 * 65 * 64 * 2 * 4);
constexpr size_t WS_E = al256(WS_BB + (size_t)2 * 16 * 64 * 16 * 2 * 4);
constexpr size_t WS_G = al256(WS_E + (size_t)2 * 16 * 128 * 1024 * 2);
constexpr size_t WS_KT = al256(WS_G + (size_t)2 * 16 * 1024 * 128 * 2);
constexpr size_t WS_UB = al256(WS_KT + (size_t)2 * 16 * 64 * 256 * 2);
constexpr size_t WS_VB = al256(WS_UB + (size_t)NEXP * 1024 * 2);
constexpr size_t WS_H = al256(WS_VB + (size_t)NEXP * 1024 * 2);
constexpr size_t WS_PROJ = al256(WS_H + (size_t)NTOK * 1024 * 2);
constexpr size_t WS_SLOC = al256(WS_PROJ + (size_t)NTOK * NPROJ * 2);
constexpr size_t WS_YG = al256(WS_SLOC + (size_t)256 * 16 * 128 * 4);
constexpr size_t WS_KVN = al256(WS_YG + (size_t)NTOK * 256 * 2);
constexpr size_t WS_SEL = al256(WS_KVN + (size_t)NTOK * 128 * 2);
constexpr size_t WS_MIX = al256(WS_SEL + (size_t)NTOK * 256 * 2);
constexpr size_t WS_X = al256(WS_MIX + (size_t)NTOK * KMIX * 2);
constexpr size_t WS_SCORES = al256(WS_X + (size_t)NTOK * 1024 * 4);
constexpr size_t WS_END = al256(WS_SCORES + (size_t)NB * SCORES_PER_BATCH * 4);

struct Params {
    const float* in[29];
    float* out;
    unsigned char* ws;
};

DI unsigned cvt_pk_bf16(float lo, float hi) { unsigned r; asm("v_cvt_pk_bf16_f32 %0, %1, %2" : "=v"(r) : "v"(lo), "v"(hi)); return r; }
DI bf16 f2bf(float x) { return (bf16)(cvt_pk_bf16(x, 0.f) & 0xffffu); }
DI float bf2f(bf16 b) { return __uint_as_float((unsigned)b << 16); }
DI float bflo(unsigned u) { return __uint_as_float(u << 16); }
DI float bfhi(unsigned u) { return __uint_as_float(u & 0xffff0000u); }
DI float dot2bf(unsigned a, unsigned b, float c) { return __builtin_amdgcn_fdot2_f32_bf16(__builtin_bit_cast(bf2, a), __builtin_bit_cast(bf2, b), c, false); }
DI float gelu_tanh(float x) { const float u = 0.7978845608028654f * (x + 0.044715f * x * x * x); const float e = __expf(2.f * u); const float t = 1.f - 2.f / (e + 1.f); return 0.5f * x * (1.f + t); }
DI float sigmoidf(float x) { return 1.f / (1.f + __expf(-x)); }
DI float wave_sum(float v) { for (int o = 32; o > 0; o >>= 1) v += __shfl_xor(v, o); return v; }
DI unsigned fkey(float v) { const unsigned u = __float_as_uint(v); return (u & 0x80000000u) ? ~u : (u | 0x80000000u); }
DI bf16x8 ld16(const void* p) { return *(const bf16x8*)p; }
DI bf16x8 zero8() { bf16x8 z = {0, 0, 0, 0, 0, 0, 0, 0}; return z; }

__global__ void __launch_bounds__(256) k_mod(Params p) {
    __shared__ float ca[4][1024];
    const float* c = p.in[1];
    for (int i = threadIdx.x; i < 4096; i += 256) { const float v = c[i]; ca[i >> 10][i & 1023] = v / (1.f + __expf(-v)); }
    __syncthreads();
    const int idx = blockIdx.x * 256 + threadIdx.x;
    const int l = idx / 6144, n = idx % 6144;
    const float* w = p.in[4] + (size_t)l * 1024 * 6144 + n;
    float a0 = 0, a1 = 0, a2 = 0, a3 = 0;
#pragma unroll 8
    for (int k = 0; k < 1024; ++k) { const float wv = w[(size_t)k * 6144]; a0 += ca[0][k] * wv; a1 += ca[1][k] * wv; a2 += ca[2][k] * wv; a3 += ca[3][k] * wv; }
    const float bm = p.in[5][l * 6144 + n];
    float* mod = (float*)(p.ws + WS_MOD) + (size_t)l * 4 * 6144 + n;
    mod[0] = a0 + bm; mod[6144] = a1 + bm; mod[2 * 6144] = a2 + bm; mod[3 * 6144] = a3 + bm;
}

struct TrArgs { const float* src; int lds, coff; bf16* dst; int ldd, doff; int K, N; int mode; const float* aux; };
__global__ void __launch_bounds__(256) k_transpose(TrArgs a) {
    __shared__ float t[32][33];
    const int nk = a.K / 32;
    const int kt = blockIdx.x % nk, nt = blockIdx.x / nk;
    const int tx = threadIdx.x & 31, ty = threadIdx.x >> 5;
    for (int r = ty; r < 32; r += 8) {
        const int k = kt * 32 + r, n = nt * 32 + tx;
        float v;
        if (a.mode == 0) v = a.src[(size_t)k * a.lds + n + a.coff];
        else if (a.mode == 1) {
            const int h = n >> 7, rr = n & 127; const float* wi = a.src + (size_t)k * a.lds + 768 + 64 * h; const float* uk = a.aux + (size_t)h * 64 * 128 + rr;
            float s = 0; for (int d = 0; d < 64; ++d) s += wi[d] * uk[d * 128]; v = s * 0.125f;
        } else {
            const int h = k >> 7, rr = k & 127; const float* uv = a.aux + ((size_t)h * 128 + rr) * 64; const float* wo = a.src + (size_t)(512 + 64 * h) * a.lds + n;
            float s = 0; for (int d = 0; d < 64; ++d) s += uv[d] * wo[(size_t)d * a.lds]; v = s;
        }
        t[r][tx] = v;
    }
    __syncthreads();
    for (int r = ty; r < 32; r += 8) {
        const int n = nt * 32 + r, k = kt * 32 + tx;
        a.dst[(size_t)n * a.ldd + a.doff + k] = f2bf(t[tx][r]);
    }
}
__global__ void __launch_bounds__(256) k_zero_bf16(bf16* dst, size_t n) { for (size_t i = (size_t)blockIdx.x * 256 + threadIdx.x; i < n; i += (size_t)gridDim.x * 256) dst[i] = 0; }

__global__ void __launch_bounds__(256) k_conv_bf16(const float* __restrict__ src, bf16* __restrict__ dst, size_t n8) {
    for (size_t i = (size_t)blockIdx.x * 256 + threadIdx.x; i < n8; i += (size_t)gridDim.x * 256) {
        const float4 a = ((const float4*)src)[2 * i], b = ((const float4*)src)[2 * i + 1];
        u32x4 o; o.x = cvt_pk_bf16(a.x, a.y); o.y = cvt_pk_bf16(a.z, a.w); o.z = cvt_pk_bf16(b.x, b.y); o.w = cvt_pk_bf16(b.z, b.w);
        ((u32x4*)dst)[i] = o;
    }
}
__global__ void __launch_bounds__(256) k_gw(Params p) {
    const int idx = blockIdx.x * 256 + threadIdx.x;
    const int s = idx & 127, t = (idx >> 7) & 127;
    const float v = (t >= 64 || s < 64) ? p.in[17][idx] : 0.f;
    ((bf16*)(p.ws + WS_GW))[idx] = f2bf(v);
}
__global__ void __launch_bounds__(256) k_ssm_pw(Params p) {
    const int idx = blockIdx.x * 256 + threadIdx.x;
    if (idx >= 2 * 16 * 64) return;
    const int pp = idx & 63, g = (idx >> 6) & 15, l = idx >> 10;
    const float lre = -__expf(p.in[7][idx]), lim = p.in[8][idx];
    const float dt = __expf(p.in[14][l * 16 + g]);
    float* pw = (float*)(p.ws + WS_PW) + ((size_t)(l * 16 + g) * 65) * 128;
    for (int d = 0; d <= 64; ++d) {
        const float mag = expf(lre * dt * (float)d); float sn, cs; sincosf(lim * dt * (float)d, &sn, &cs);
        pw[d * 128 + pp * 2] = mag * cs; pw[d * 128 + pp * 2 + 1] = mag * sn;
    }
    const float mag = expf(lre * dt); float sn, cs; sincosf(lim * dt, &sn, &cs);
    const float are = mag * cs, aim = mag * sn;
    const float den = lre * lre + lim * lim, P = are - 1.f, Q = aim;
    const float fre = (P * lre + Q * lim) / den, fim = (Q * lre - P * lim) / den;
    float* bb = (float*)(p.ws + WS_BB) + (size_t)idx * 32;
    for (int h = 0; h < 16; ++h) { const float br = p.in[9][(size_t)idx * 16 + h], bi = p.in[10][(size_t)idx * 16 + h]; bb[h * 2] = fre * br - fim * bi; bb[h * 2 + 1] = fre * bi + fim * br; }
}
__global__ void __launch_bounds__(256) k_ssm_tabs(Params p) {
    const size_t idx = (size_t)blockIdx.x * 256 + threadIdx.x;
    const size_t NE = (size_t)2 * 16 * 128 * 1024;
    const float* PW = (const float*)(p.ws + WS_PW); const float* BB = (const float*)(p.ws + WS_BB);
    if (idx < NE) {
        const int kk = idx & 1023, pp = (idx >> 10) & 127; const int lg = (int)(idx >> 17);
        const int i = kk >> 4, hh = kk & 15, pq = pp & 63, part = pp >> 6;
        const float* pw = PW + ((size_t)lg * 65 + (63 - i)) * 128 + pq * 2; const float* bb = BB + ((size_t)lg * 64 + pq) * 32 + hh * 2;
        const float v = part ? (pw[0] * bb[1] + pw[1] * bb[0]) : (pw[0] * bb[0] - pw[1] * bb[1]);
        ((bf16*)(p.ws + WS_E))[idx] = f2bf(v);
    } else if (idx < 2 * NE) {
        const size_t e = idx - NE; const int pp = e & 127, jh = (e >> 7) & 1023; const int lg = (int)(e >> 17);
        const int j = jh >> 4, h = jh & 15, pq = pp & 63, part = pp >> 6;
        const float* pw = PW + ((size_t)lg * 65 + (j + 1)) * 128 + pq * 2;
        const float cr = p.in[11][((size_t)lg * 16 + h) * 64 + pq], ci = p.in[12][((size_t)lg * 16 + h) * 64 + pq];
        const float v = part ? -(cr * pw[1] + ci * pw[0]) : (cr * pw[0] - ci * pw[1]);
        ((bf16*)(p.ws + WS_G))[e] = f2bf(v);
    } else {
        const size_t e = idx - 2 * NE; if (e >= (size_t)2 * 16 * 64 * 256) return;
        const int hh = e & 15, h = (e >> 4) & 15, d = (e >> 8) & 63; const int lg = (int)(e >> 14);
        const float* pw = PW + ((size_t)lg * 65 + d) * 128; const float* bb = BB + (size_t)lg * 64 * 32 + hh * 2;
        const float* cr = p.in[11] + ((size_t)lg * 16 + h) * 64; const float* ci = p.in[12] + ((size_t)lg * 16 + h) * 64;
        float s = 0;
        for (int q = 0; q < 64; ++q) { const float zr = pw[q * 2] * bb[q * 32] - pw[q * 2 + 1] * bb[q * 32 + 1], zi = pw[q * 2] * bb[q * 32 + 1] + pw[q * 2 + 1] * bb[q * 32]; s += cr[q] * zr - ci[q] * zi; }
        ((bf16*)(p.ws + WS_KT))[e] = f2bf(s);
    }
}

DI void norm_mod_row(const float* __restrict__ xrow, const float* __restrict__ g, const float* __restrict__ sh, const float* __restrict__ sc, bf16* __restrict__ hrow, int lane) {
    float4 v[4]; float ss = 0;
#pragma unroll
    for (int j = 0; j < 4; ++j) { v[j] = *(const float4*)(xrow + 4 * lane + 256 * j); ss += v[j].x * v[j].x + v[j].y * v[j].y + v[j].z * v[j].z + v[j].w * v[j].w; }
    ss = wave_sum(ss);
    const float r = rsqrtf(ss * (1.f / 1024.f) + 1e-6f);
#pragma unroll
    for (int j = 0; j < 4; ++j) {
        const int c = 4 * lane + 256 * j;
        const float4 gg = *(const float4*)(g + c), s1 = *(const float4*)(sc + c), s0 = *(const float4*)(sh + c);
        u32x2 o; o.x = cvt_pk_bf16(v[j].x * r * gg.x * (1.f + s1.x) + s0.x, v[j].y * r * gg.y * (1.f + s1.y) + s0.y);
        o.y = cvt_pk_bf16(v[j].z * r * gg.z * (1.f + s1.z) + s0.z, v[j].w * r * gg.w * (1.f + s1.w) + s0.w);
        *(u32x2*)(hrow + c) = o;
    }
}
__global__ void __launch_bounds__(256) k_norm_mod(Params p, const float* x, int l, int which  ) {
    const int lane = threadIdx.x & 63, wave = threadIdx.x >> 6;
    const float* g = p.in[which ? 3 : 2] + l * 1024;
    for (int row = blockIdx.x * 4 + wave; row < NTOK; row += gridDim.x * 4) {
        const float* mod = (const float*)(p.ws + WS_MOD) + ((size_t)l * 4 + (row >> 12)) * 6144 + (which ? 3072 : 0);
        norm_mod_row(x + (size_t)row * 1024, g, mod, mod + 1024, (bf16*)(p.ws + WS_H) + (size_t)row * 1024, lane);
    }
}

constexpr int GP = 72;
template <class Epi>
DI void gemm_tile(const bf16* __restrict__ A, int lda, const bf16* __restrict__ Bt, int ldb, int K, int m0, int n0, bf16* lds, const Epi& epi) {
    bf16* As = lds; bf16* Bs = lds + 128 * GP;
    const int tid = threadIdx.x, lane = tid & 63, wave = tid >> 6, wm = wave >> 1, wn = wave & 1;
    const int fr = lane & 15, fq = lane >> 4;
    const int lrow = tid >> 3, lch = tid & 7;
    f32x4 acc[4][4];
#pragma unroll
    for (int i = 0; i < 4; ++i)
#pragma unroll
        for (int j = 0; j < 4; ++j) acc[i][j] = (f32x4){0.f, 0.f, 0.f, 0.f};
    bf16x8 ra[4], rb[4];
    const bf16* Ag = A + (size_t)(m0 + lrow) * lda + lch * 8;
    const bf16* Bg = Bt + (size_t)(n0 + lrow) * ldb + lch * 8;
#pragma unroll
    for (int i = 0; i < 4; ++i) { ra[i] = ld16(Ag + (size_t)32 * i * lda); rb[i] = ld16(Bg + (size_t)32 * i * ldb); }
    const int nk = K / 64;
    for (int kt = 0; kt < nk; ++kt) {
        __syncthreads();
#pragma unroll
        for (int i = 0; i < 4; ++i) { *(bf16x8*)(As + (lrow + 32 * i) * GP + lch * 8) = ra[i]; *(bf16x8*)(Bs + (lrow + 32 * i) * GP + lch * 8) = rb[i]; }
        __syncthreads();
        if (kt + 1 < nk) {
#pragma unroll
            for (int i = 0; i < 4; ++i) { ra[i] = ld16(Ag + (size_t)32 * i * lda + (kt + 1) * 64); rb[i] = ld16(Bg + (size_t)32 * i * ldb + (kt + 1) * 64); }
        }
#pragma unroll
        for (int ks = 0; ks < 2; ++ks) {
            bf16x8 fa[4], fb[4];
#pragma unroll
            for (int i = 0; i < 4; ++i) { fa[i] = ld16(Bs + (64 * wn + 16 * i + fr) * GP + 32 * ks + 8 * fq); fb[i] = ld16(As + (64 * wm + 16 * i + fr) * GP + 32 * ks + 8 * fq); }
#pragma unroll
            for (int i = 0; i < 4; ++i)
#pragma unroll
                for (int j = 0; j < 4; ++j) acc[i][j] = MFMA16(fa[i], fb[j], acc[i][j]);
        }
    }
#pragma unroll
    for (int i = 0; i < 4; ++i)
#pragma unroll
        for (int j = 0; j < 4; ++j) epi(m0 + 64 * wm + 16 * j + fr, n0 + 64 * wn + 16 * i + 4 * fq, acc[i][j]);
}
struct EpiBf16 { bf16* C; int ldc; DI void operator()(int r, int c, f32x4 v) const { u32x2 o; o.x = cvt_pk_bf16(v[0], v[1]); o.y = cvt_pk_bf16(v[2], v[3]); *(u32x2*)(C + (size_t)r * ldc + c) = o; } };
struct EpiResid { const float* xin; float* xout; const float* gate;
    DI void operator()(int r, int c, f32x4 v) const { const float4 x = *(const float4*)(xin + (size_t)r * 1024 + c); const float4 g = *(const float4*)(gate + (size_t)(r >> 12) * 6144 + c);
        float4 o; o.x = x.x + g.x * v[0]; o.y = x.y + g.y * v[1]; o.z = x.z + g.z * v[2]; o.w = x.w + g.w * v[3]; *(float4*)(xout + (size_t)r * 1024 + c) = o; } };
struct EpiGlu { const bf16* yg; const float* bglu; bf16* mix;
    DI void operator()(int r, int c, f32x4 v) const { const u32x2 y = *(const u32x2*)(yg + (size_t)r * 256 + c); const float4 b = *(const float4*)(bglu + c);
        u32x2 o; o.x = cvt_pk_bf16(bflo(y.x) * sigmoidf(v[0] + b.x), bfhi(y.x) * sigmoidf(v[1] + b.y)); o.y = cvt_pk_bf16(bflo(y.y) * sigmoidf(v[2] + b.z), bfhi(y.y) * sigmoidf(v[3] + b.w));
        *(u32x2*)(mix + (size_t)r * KMIX + c) = o; } };

template <class Epi>
__global__ void __launch_bounds__(256) k_gemm(const bf16* A, int lda, const bf16* Bt, int ldb, int K, int ntn, int ntiles, Epi epi) {
    __shared__ __attribute__((aligned(16))) bf16 lds[2 * 128 * GP];
    for (int t = blockIdx.x; t < ntiles; t += gridDim.x) { gemm_tile(A, lda, Bt, ldb, K, (t / ntn) * 128, (t % ntn) * 128, lds, epi); __syncthreads(); }
}

__global__ void __launch_bounds__(256) k_kvn(Params p, int l) {
    const int lane = threadIdx.x & 63, wave = threadIdx.x >> 6;
    const bf16* proj = (const bf16*)(p.ws + WS_PROJ); bf16* kvn = (bf16*)(p.ws + WS_KVN);
    const float g0 = p.in[19][l * 128 + 2 * lane], g1 = p.in[19][l * 128 + 2 * lane + 1];
    for (int row = blockIdx.x * 4 + wave; row < NTOK; row += gridDim.x * 4) {
        const unsigned u = *(const unsigned*)(proj + (size_t)row * NPROJ + C_CKV + 2 * lane);
        const float a = bflo(u), b = bfhi(u);
        const float ss = wave_sum(a * a + b * b);
        const float r = rsqrtf(ss * (1.f / 128.f) + 1e-6f);
        *(unsigned*)(kvn + (size_t)row * 128 + 2 * lane) = cvt_pk_bf16(a * r * g0, b * r * g1);
    }
}

__global__ void __launch_bounds__(256) k_ssm_a(Params p, int l) {
    const int lane = threadIdx.x & 63, wave = threadIdx.x >> 6, fr = lane & 15, fq = lane >> 4;
    const bf16* proj = (const bf16*)(p.ws + WS_PROJ);
    float* sloc = (float*)(p.ws + WS_SLOC);
    for (int item = blockIdx.x; item < 256; item += gridDim.x) {
        const int g = item & 15, rt = item >> 4;
        const bf16* E = (const bf16*)(p.ws + WS_E) + ((size_t)(l * 16 + g) * 128) * 1024;
        const int R = 16 * rt + fr, b = R >> 6, k = R & 63;
        const bf16* arow = proj + ((size_t)b * 4096 + 64 * k + (fq >> 1)) * NPROJ + C_UA + 16 * g + 8 * (fq & 1);
        f32x4 acc[2] = {(f32x4){0, 0, 0, 0}, (f32x4){0, 0, 0, 0}};
        for (int ks = 0; ks < 32; ++ks) {
            const bf16x8 a = ld16(arow + (size_t)(2 * ks) * NPROJ);
#pragma unroll
            for (int c = 0; c < 2; ++c) { const int ct = 2 * wave + c; const bf16x8 bf = ld16(E + (size_t)(16 * ct + fr) * 1024 + 32 * ks + 8 * fq); acc[c] = MFMA16(a, bf, acc[c]); }
        }
#pragma unroll
        for (int c = 0; c < 2; ++c)
#pragma unroll
            for (int i = 0; i < 4; ++i) sloc[((size_t)(16 * rt + 4 * fq + i) * 16 + g) * 128 + 16 * (2 * wave + c) + fr] = acc[c][i];
    }
}

__global__ void __launch_bounds__(256) k_ssm_c(Params p, int l) {
    __shared__ __attribute__((aligned(16))) bf16 sst[64 * 136];
    const int lane = threadIdx.x & 63, wave = threadIdx.x >> 6, fr = lane & 15, fq = lane >> 4;
    const bf16* proj = (const bf16*)(p.ws + WS_PROJ);
    const float* sloc = (const float*)(p.ws + WS_SLOC);
    bf16* yg = (bf16*)(p.ws + WS_YG);
    for (int item = blockIdx.x; item < 64; item += gridDim.x) {
        const int g = item & 15, b = item >> 4;
        __syncthreads();
        if (wave == 0) {
            const float* pw64 = (const float*)(p.ws + WS_PW) + ((size_t)(l * 16 + g) * 65 + 64) * 128 + lane * 2;
            const float ar = pw64[0], ai = pw64[1];
            float sr = 0, si = 0;
            for (int k = 0; k < 64; ++k) {
                sst[k * 136 + lane] = f2bf(sr); sst[k * 136 + 64 + lane] = f2bf(si);
                const float* s = sloc + ((size_t)(b * 64 + k) * 16 + g) * 128;
                const float lr = s[lane], li = s[64 + lane];
                const float nr = ar * sr - ai * si + lr, ni = ar * si + ai * sr + li;
                sr = nr; si = ni;
            }
        }
        __syncthreads();
        const bf16* KT = (const bf16*)(p.ws + WS_KT) + (size_t)(l * 16 + g) * 64 * 256;
        const bf16* G = (const bf16*)(p.ws + WS_G) + (size_t)(l * 16 + g) * 1024 * 128;
        const int kch = 16 * wave + fr;
        const bf16* arow = proj + ((size_t)b * 4096 + 64 * kch + (fq >> 1)) * NPROJ + C_UA + 16 * g + 8 * (fq & 1);
        const float dsk = p.in[13][l * 256 + 16 * g + fr];
        for (int j = 0; j < 64; ++j) {
            f32x4 acc = {0, 0, 0, 0};
            for (int ks = 0; 2 * ks <= j; ++ks) {
                const bf16x8 a = ld16(arow + (size_t)(2 * ks) * NPROJ);
                const int d = j - 2 * ks - (fq >> 1);
                const bf16x8 bf = d >= 0 ? ld16(KT + ((size_t)d * 16 + fr) * 16 + 8 * (fq & 1)) : zero8();
                acc = MFMA16(a, bf, acc);
            }
#pragma unroll
            for (int ks = 0; ks < 4; ++ks) {
                const bf16x8 a = ld16(sst + kch * 136 + 32 * ks + 8 * fq);
                const bf16x8 bf = ld16(G + ((size_t)(j * 16 + fr)) * 128 + 32 * ks + 8 * fq);
                acc = MFMA16(a, bf, acc);
            }
#pragma unroll
            for (int i = 0; i < 4; ++i) {
                const size_t tok = (size_t)b * 4096 + 64 * (16 * wave + 4 * fq + i) + j;
                const float u = bf2f(proj[tok * NPROJ + C_UA + 16 * g + fr]);
                yg[tok * 256 + 16 * g + fr] = f2bf(gelu_tanh(acc[i] + dsk * u));
            }
        }
    }
}

__global__ void __launch_bounds__(256) k_gmlp(Params p, int l) {
    __shared__ __attribute__((aligned(16))) bf16 vnT[64 * 136];
    const int tid = threadIdx.x, lane = tid & 63, wave = tid >> 6, fr = lane & 15, fq = lane >> 4;
    const bf16* proj = (const bf16*)(p.ws + WS_PROJ); bf16* mix = (bf16*)(p.ws + WS_MIX);
    for (int item = blockIdx.x; item < 512; item += gridDim.x) {
        const int h = item & 3, blk = item >> 2;
        const size_t tok0 = (size_t)blk * 128;
        __syncthreads();
        {
            const int row = tid >> 1, half = tid & 1;
            const bf16* vp = proj + (tok0 + row) * NPROJ + C_VB + 64 * h + 32 * half;
            float v[32]; float s = 0;
#pragma unroll
            for (int q = 0; q < 4; ++q) { const bf16x8 t = ld16(vp + 8 * q);
#pragma unroll
                for (int e = 0; e < 8; ++e) { v[8 * q + e] = bf2f((bf16)t[e]); s += v[8 * q + e]; } }
            s += __shfl_xor(s, 1); const float mu = s * (1.f / 64.f);
            float vs = 0;
#pragma unroll
            for (int e = 0; e < 32; ++e) { const float d = v[e] - mu; vs += d * d; }
            vs += __shfl_xor(vs, 1); const float r = rsqrtf(vs * (1.f / 64.f) + 1e-6f);
#pragma unroll
            for (int e = 0; e < 32; ++e) vnT[(32 * half + e) * 136 + row] = f2bf((v[e] - mu) * r);
        }
        __syncthreads();
        const bf16* W = (const bf16*)(p.ws + WS_GW) + (size_t)(l * 4 + h) * 128 * 128;
        f32x4 acc[4][2];
#pragma unroll
        for (int i = 0; i < 4; ++i) { acc[i][0] = (f32x4){0, 0, 0, 0}; acc[i][1] = (f32x4){0, 0, 0, 0}; }
#pragma unroll
        for (int ks = 0; ks < 4; ++ks) {
            bf16x8 fa[4], fb[2];
#pragma unroll
            for (int i = 0; i < 4; ++i) fa[i] = ld16(vnT + (16 * i + fr) * 136 + 32 * ks + 8 * fq);
#pragma unroll
            for (int j = 0; j < 2; ++j) fb[j] = ld16(W + (size_t)(16 * (2 * wave + j) + fr) * 128 + 32 * ks + 8 * fq);
#pragma unroll
            for (int i = 0; i < 4; ++i)
#pragma unroll
                for (int j = 0; j < 2; ++j) acc[i][j] = MFMA16(fa[i], fb[j], acc[i][j]);
        }
#pragma unroll
        for (int j = 0; j < 2; ++j) {
            const int t = 16 * (2 * wave + j) + fr;
            const float bs = p.in[18][(l * 4 + h) * 128 + t];
#pragma unroll
            for (int i = 0; i < 4; ++i) {
                const int d = 16 * i + 4 * fq;
                const u32x2 u = *(const u32x2*)(proj + (tok0 + t) * NPROJ + C_UB + 64 * h + d);
                u32x2 o; o.x = cvt_pk_bf16(bflo(u.x) * (acc[i][j][0] + bs), bfhi(u.x) * (acc[i][j][1] + bs)); o.y = cvt_pk_bf16(bflo(u.y) * (acc[i][j][2] + bs), bfhi(u.y) * (acc[i][j][3] + bs));
                *(u32x2*)(mix + (tok0 + t) * KMIX + 256 + 64 * h + d) = o;
            }
        }
    }
}

DI size_t score_row_off(int b, int t) { const int c = t >> 6; return (size_t)b * SCORES_PER_BATCH + (size_t)4096 * (c * (c + 1) / 2) + (size_t)(t & 63) * 64 * (c + 1); }
__global__ void __launch_bounds__(256) k_dsa_index(Params p) {
    const int lane = threadIdx.x & 63, wave = threadIdx.x >> 6, fr = lane & 15, fq = lane >> 4;
    const bf16* proj = (const bf16*)(p.ws + WS_PROJ); float* scores = (float*)(p.ws + WS_SCORES);
    for (int item = blockIdx.x; item < 1024; item += gridDim.x) {
        const int c = 63 - (item >> 4), b = (item >> 2) & 3, qg = item & 3;
        const int t = 64 * c + 16 * qg + fr;
        const bf16* qrow = proj + ((size_t)b * 4096 + t) * NPROJ;
        bf16x8 qf[4][2];
#pragma unroll
        for (int hh = 0; hh < 4; ++hh)
#pragma unroll
            for (int ks = 0; ks < 2; ++ks) qf[hh][ks] = ld16(qrow + C_QI + 64 * hh + 32 * ks + 8 * fq);
        float w[4];
        { const u32x2 wv = *(const u32x2*)(qrow + C_WI); w[0] = bflo(wv.x) * 0.0625f; w[1] = bfhi(wv.x) * 0.0625f; w[2] = bflo(wv.y) * 0.0625f; w[3] = bfhi(wv.y) * 0.0625f; }
        float* srow = scores + score_row_off(b, t);
        const int ntile = 4 * (c + 1);
        for (int kt = wave; kt < ntile; kt += 4) {
            const bf16* krow = proj + ((size_t)b * 4096 + 16 * kt + fr) * NPROJ + C_KI + 8 * fq;
            const bf16x8 k0 = ld16(krow), k1 = ld16(krow + 32);
            f32x4 sc = {0, 0, 0, 0};
#pragma unroll
            for (int hh = 0; hh < 4; ++hh) {
                f32x4 a = {0, 0, 0, 0};
                a = MFMA16(k0, qf[hh][0], a); a = MFMA16(k1, qf[hh][1], a);
#pragma unroll
                for (int i = 0; i < 4; ++i) sc[i] += w[hh] * fmaxf(a[i], 0.f);
            }
#pragma unroll
            for (int i = 0; i < 4; ++i) sc[i] += 0.f;
            *(f32x4*)(srow + 16 * kt + 4 * fq) = sc;
        }
    }
}

__global__ void __launch_bounds__(256) k_dsa_select(Params p) {
    const int lane = threadIdx.x & 63, wave = threadIdx.x >> 6;
    const float* scores = (const float*)(p.ws + WS_SCORES); bf16* sel = (bf16*)(p.ws + WS_SEL);
    for (int q = blockIdx.x * 4 + wave; q < NTOK; q += gridDim.x * 4) {
        const int b = q >> 12, t = q & 4095, c = t >> 6, nreg = c + 1;
        bf16* so = sel + (size_t)q * 256;
        if (nreg <= 4) { for (int r = 0; r < nreg; ++r) so[64 * r + lane] = (bf16)(64 * r + lane); continue; }
        const float* srow = scores + score_row_off(b, t);
        unsigned key[64];
#pragma unroll
        for (int r = 0; r < 64; ++r) key[r] = (r < nreg) ? fkey(srow[64 * r + lane]) : 0u;
        unsigned T = 0;
        for (int bit = 31; bit >= 0; --bit) {
            const unsigned cand = T | (1u << bit);
            int cnt = 0;
#pragma unroll
            for (int r = 0; r < 64; ++r) if (r < nreg) cnt += __popcll(__ballot(key[r] >= cand));
            if (cnt >= 256) { T = cand; if (cnt == 256) break; }
        }
        int cgt = 0;
#pragma unroll
        for (int r = 0; r < 64; ++r) if (r < nreg) cgt += __popcll(__ballot(key[r] > T));
        const int need = 256 - cgt;
        int base = 0, eqb = 0;
        const unsigned long long lt = (1ull << lane) - 1ull;
#pragma unroll
        for (int r = 0; r < 64; ++r) if (r < nreg) {
            const unsigned long long me = __ballot(key[r] == T);
            const int erank = eqb + __popcll(me & lt);
            const bool take = (key[r] > T) || (key[r] == T && erank < need);
            const unsigned long long mt = __ballot(take);
            if (take) so[base + __popcll(mt & lt)] = (bf16)(64 * r + lane);
            base += __popcll(mt); eqb += __popcll(me);
        }
    }
}

DI unsigned off_b(unsigned row, unsigned ch) { return 256u * row + 16u * (ch ^ (((row & 3u) << 2) | ((row >> 2) & 3u))); }
#define TR8(o0, o1, o2, o3, o4, o5, o6, o7, a0, a1, a2, a3, a4, a5, a6, a7)                                                                         \
    asm volatile("s_waitcnt lgkmcnt(0)\n\t"                                                                                                         \
                 "ds_read_b64_tr_b16 %0, %8\n\tds_read_b64_tr_b16 %1, %9\n\tds_read_b64_tr_b16 %2, %10\n\tds_read_b64_tr_b16 %3, %11\n\t"           \
                 "ds_read_b64_tr_b16 %4, %12\n\tds_read_b64_tr_b16 %5, %13\n\tds_read_b64_tr_b16 %6, %14\n\tds_read_b64_tr_b16 %7, %15\n\t"         \
                 "s_waitcnt lgkmcnt(0)"                                                                                                             \
                 : "=&v"(o0), "=&v"(o1), "=&v"(o2), "=&v"(o3), "=&v"(o4), "=&v"(o5), "=&v"(o6), "=&v"(o7)                                           \
                 : "v"(a0), "v"(a1), "v"(a2), "v"(a3), "v"(a4), "v"(a5), "v"(a6), "v"(a7)                                                           \
                 : "memory")
__global__ void __launch_bounds__(256) k_dsa_attn(Params p) {
    __shared__ __attribute__((aligned(16))) unsigned char tiles[4][8192];
    const int lane = threadIdx.x & 63, wave = threadIdx.x >> 6, fr = lane & 15, fq = lane >> 4;
    unsigned char* tile = tiles[wave];
    const bf16* proj = (const bf16*)(p.ws + WS_PROJ); const bf16* kvn = (const bf16*)(p.ws + WS_KVN);
    const bf16* sel = (const bf16*)(p.ws + WS_SEL); bf16* mix = (bf16*)(p.ws + WS_MIX);
    unsigned wr_addr[8], rd_addr[2][4], tr_addr[8][2];
#pragma unroll
    for (int i = 0; i < 8; ++i) wr_addr[i] = off_b(4 * i + fq, fr);
#pragma unroll
    for (int rb = 0; rb < 2; ++rb)
#pragma unroll
        for (int s = 0; s < 4; ++s) rd_addr[rb][s] = off_b(8 * (fr >> 2) + 4 * rb + (fr & 3), 4 * s + fq);
    const unsigned tbase = (unsigned)(size_t)tile;
    {
        const unsigned q4 = fr >> 2, p4 = fr & 3;
#pragma unroll
        for (int c = 0; c < 8; ++c)
#pragma unroll
            for (int t = 0; t < 2; ++t) tr_addr[c][t] = tbase + off_b(8 * fq + 4 * t + q4, 2 * c + (p4 >> 1)) + 8 * (p4 & 1);
    }
    const float slope = fr < 8 ? exp2f(-(float)(fr + 1)) : 0.f;
    for (int q = blockIdx.x * 4 + wave; q < NTOK; q += gridDim.x * 4) {
        const int b = q >> 12, t = q & 4095, c = t >> 6;
        const int nsel = (c + 1) * 64 < 256 ? (c + 1) * 64 : 256;
        const bf16* qa = proj + (size_t)q * NPROJ + C_QA;
        bf16x8 qf[4];
#pragma unroll
        for (int s = 0; s < 4; ++s) qf[s] = fr < 8 ? ld16(qa + fr * 128 + 32 * s + 8 * fq) : zero8();
        const bf16* selp = sel + (size_t)q * 256;
        const bf16* kvb = kvn + (size_t)b * 4096 * 128;
        float m_run = -INFINITY, l_run = 0.f;
        f32x4 o[8];
#pragma unroll
        for (int i = 0; i < 8; ++i) o[i] = (f32x4){0, 0, 0, 0};
        for (int ti = 0; ti < nsel / 32; ++ti) {
            bf16x8 gk[8];
#pragma unroll
            for (int i = 0; i < 8; ++i) { const int key = selp[32 * ti + 4 * i + fq]; gk[i] = ld16(kvb + (size_t)key * 128 + 8 * fr); }
            const bf16x8 kp = ld16(selp + 32 * ti + 8 * fq);
#pragma unroll
            for (int i = 0; i < 8; ++i) *(bf16x8*)(tile + wr_addr[i]) = gk[i];
            f32x4 lg[2] = {(f32x4){0, 0, 0, 0}, (f32x4){0, 0, 0, 0}};
#pragma unroll
            for (int rb = 0; rb < 2; ++rb)
#pragma unroll
                for (int s = 0; s < 4; ++s) lg[rb] = MFMA16(ld16(tile + rd_addr[rb][s]), qf[s], lg[rb]);
            float val[8]; float tmax = -INFINITY;
#pragma unroll
            for (int j = 0; j < 8; ++j) { const float dist = fabsf((float)(t - (int)(unsigned short)kp[j])); val[j] = lg[j >> 2][j & 3] - slope * dist; tmax = fmaxf(tmax, val[j]); }
            tmax = fmaxf(tmax, __shfl_xor(tmax, 16)); tmax = fmaxf(tmax, __shfl_xor(tmax, 32));
            const float m_new = fmaxf(m_run, tmax);
            const float scale = __expf(m_run - m_new);
            l_run *= scale;
#pragma unroll
            for (int i = 0; i < 8; ++i) o[i] *= scale;
            float pv[8];
#pragma unroll
            for (int j = 0; j < 8; ++j) { pv[j] = __expf(val[j] - m_new); l_run += pv[j]; }
            m_run = m_new;
            u32x4 pk; pk.x = cvt_pk_bf16(pv[0], pv[1]); pk.y = cvt_pk_bf16(pv[2], pv[3]); pk.z = cvt_pk_bf16(pv[4], pv[5]); pk.w = cvt_pk_bf16(pv[6], pv[7]);
            const bf16x8 pf = __builtin_bit_cast(bf16x8, pk);
            s16x4 tr[8][2];
            TR8(tr[0][0], tr[0][1], tr[1][0], tr[1][1], tr[2][0], tr[2][1], tr[3][0], tr[3][1], tr_addr[0][0], tr_addr[0][1], tr_addr[1][0], tr_addr[1][1], tr_addr[2][0], tr_addr[2][1], tr_addr[3][0], tr_addr[3][1]);
            TR8(tr[4][0], tr[4][1], tr[5][0], tr[5][1], tr[6][0], tr[6][1], tr[7][0], tr[7][1], tr_addr[4][0], tr_addr[4][1], tr_addr[5][0], tr_addr[5][1], tr_addr[6][0], tr_addr[6][1], tr_addr[7][0], tr_addr[7][1]);
#pragma unroll
            for (int cc = 0; cc < 8; ++cc) {
                bf16x8 kf; kf[0] = tr[cc][0][0]; kf[1] = tr[cc][0][1]; kf[2] = tr[cc][0][2]; kf[3] = tr[cc][0][3]; kf[4] = tr[cc][1][0]; kf[5] = tr[cc][1][1]; kf[6] = tr[cc][1][2]; kf[7] = tr[cc][1][3];
                o[cc] = MFMA16(kf, pf, o[cc]);
            }
        }
        float lt = l_run; lt += __shfl_xor(lt, 16); lt += __shfl_xor(lt, 32);
        const float inv = 1.f / lt;
        if (fr < 8) {
#pragma unroll
            for (int cc = 0; cc < 8; ++cc) { u32x2 ov; ov.x = cvt_pk_bf16(o[cc][0] * inv, o[cc][1] * inv); ov.y = cvt_pk_bf16(o[cc][2] * inv, o[cc][3] * inv);
                *(u32x2*)(mix + (size_t)q * KMIX + 512 + fr * 128 + 16 * cc + 4 * fq) = ov; }
        }
    }
}

template <int NV>
DI void select16(const float (&v)[NV], const int (&id)[NV], float* outv, int* outi, int lane) {
    unsigned key[NV];
#pragma unroll
    for (int j = 0; j < NV; ++j) key[j] = fkey(v[j]);
    unsigned T = 0;
    for (int bit = 31; bit >= 0; --bit) {
        const unsigned cand = T | (1u << bit);
        int cnt = 0;
#pragma unroll
        for (int j = 0; j < NV; ++j) cnt += __popcll(__ballot(key[j] >= cand));
        if (cnt >= 16) { T = cand; if (cnt == 16) break; }
    }
    int cgt = 0;
#pragma unroll
    for (int j = 0; j < NV; ++j) cgt += __popcll(__ballot(key[j] > T));
    const int need = 16 - cgt;
    int base = 0, eqb = 0;
    const unsigned long long lt = (1ull << lane) - 1ull;
#pragma unroll
    for (int j = 0; j < NV; ++j) {
        const unsigned long long me = __ballot(key[j] == T);
        const bool take = (key[j] > T) || (key[j] == T && (eqb + __popcll(me & lt)) < need);
        const unsigned long long mt = __ballot(take);
        if (take) { const int pos = base + __popcll(mt & lt); outv[pos] = v[j]; outi[pos] = id[j]; }
        base += __popcll(mt); eqb += __popcll(me);
    }
}

constexpr int KP = 68;
struct PeerLds { bf16 k1[128 * KP]; bf16 k2[128 * KP]; bf16 q[4][1024]; float l1v[4][16]; int l1i[4][16]; float l2v[4][16]; int l2i[4][16]; float cv[4][16]; int ci[4][16]; int pe[4][128]; float pg[4][128]; };
__global__ void __launch_bounds__(256) k_peer(Params p, int l) {
    __shared__ __attribute__((aligned(16))) PeerLds S;
    const int tid = threadIdx.x, lane = tid & 63, wave = tid >> 6;
    const bf16* pk = (const bf16*)(p.ws + WS_PK) + (size_t)l * 2 * 128 * 64;
    for (int i = tid; i < 128 * 64; i += 256) { S.k1[(i >> 6) * KP + (i & 63)] = pk[i]; S.k2[(i >> 6) * KP + (i & 63)] = pk[128 * 64 + i]; }
    __syncthreads();
    const bf16* QP = (const bf16*)(p.ws + WS_PROJ);
    const bf16* H = (const bf16*)(p.ws + WS_H);
    const bf16* UB = (const bf16*)(p.ws + WS_UB); const bf16* VB = (const bf16*)(p.ws + WS_VB);
    float* X = (float*)(p.ws + WS_X);
    const float* modl = (const float*)(p.ws + WS_MOD) + (size_t)l * 4 * 6144;
    for (int tok = blockIdx.x * 4 + wave; tok < NTOK; tok += gridDim.x * 4) {
        const int b = tok >> 12;
        *(bf16x8*)(S.q[wave] + 8 * lane) = ld16(QP + (size_t)tok * 1024 + 8 * lane);
        *(bf16x8*)(S.q[wave] + 512 + 8 * lane) = ld16(QP + (size_t)tok * 1024 + 512 + 8 * lane);
        const u32x4 h0 = *(const u32x4*)(H + (size_t)tok * 1024 + 8 * lane), h1 = *(const u32x4*)(H + (size_t)tok * 1024 + 512 + 8 * lane);
        for (int hp = 0; hp < 8; ++hp) {
            float s1[2] = {0, 0}, s2[2] = {0, 0};
            const bf16* q1 = S.q[wave] + 128 * hp; const bf16* q2 = q1 + 64;
#pragma unroll
            for (int d4 = 0; d4 < 16; ++d4) {
                const u32x2 qa = *(const u32x2*)(q1 + 4 * d4), qb = *(const u32x2*)(q2 + 4 * d4);
#pragma unroll
                for (int j = 0; j < 2; ++j) {
                    const u32x2 ka = *(const u32x2*)(S.k1 + (lane + 64 * j) * KP + 4 * d4), kb = *(const u32x2*)(S.k2 + (lane + 64 * j) * KP + 4 * d4);
                    s1[j] = dot2bf(ka.x, qa.x, s1[j]); s1[j] = dot2bf(ka.y, qa.y, s1[j]);
                    s2[j] = dot2bf(kb.x, qb.x, s2[j]); s2[j] = dot2bf(kb.y, qb.y, s2[j]);
                }
            }
            const int ids[2] = {lane, lane + 64};
            select16<2>(s1, ids, S.l1v[wave], S.l1i[wave], lane);
            select16<2>(s2, ids, S.l2v[wave], S.l2i[wave], lane);
            float cv[4]; int ci[4];
            { const int a = lane >> 2, b4 = (lane & 3) * 4; const float va = S.l1v[wave][a]; const int ia = S.l1i[wave][a];
#pragma unroll
              for (int j = 0; j < 4; ++j) { cv[j] = va + S.l2v[wave][b4 + j]; ci[j] = ia * 128 + S.l2i[wave][b4 + j]; } }
            select16<4>(cv, ci, S.cv[wave], S.ci[wave], lane);
            {
                const float sv = S.cv[wave][lane & 15];
                float mx = sv; for (int o = 8; o > 0; o >>= 1) mx = fmaxf(mx, __shfl_xor(mx, o));
                const float e = __expf(sv - mx); float sm = e; for (int o = 8; o > 0; o >>= 1) sm += __shfl_xor(sm, o);
                if (lane < 16) { S.pe[wave][hp * 16 + lane] = S.ci[wave][lane]; S.pg[wave][hp * 16 + lane] = e / sm; }
            }
        }
        float acc[16];
#pragma unroll
        for (int i = 0; i < 16; ++i) acc[i] = 0.f;
        for (int e0 = 0; e0 < 128; e0 += 4) {
            u32x4 u0[4], u1[4], v0[4], v1[4]; float d[4];
#pragma unroll
            for (int j = 0; j < 4; ++j) {
                const int e = __builtin_amdgcn_readfirstlane(S.pe[wave][e0 + j]);
                u0[j] = *(const u32x4*)(UB + (size_t)e * 1024 + 8 * lane); u1[j] = *(const u32x4*)(UB + (size_t)e * 1024 + 512 + 8 * lane);
                v0[j] = *(const u32x4*)(VB + (size_t)e * 1024 + 8 * lane); v1[j] = *(const u32x4*)(VB + (size_t)e * 1024 + 512 + 8 * lane);
            }
#pragma unroll
            for (int j = 0; j < 4; ++j) {
                float s = 0;
                s = dot2bf(u0[j].x, h0.x, s); s = dot2bf(u0[j].y, h0.y, s); s = dot2bf(u0[j].z, h0.z, s); s = dot2bf(u0[j].w, h0.w, s);
                s = dot2bf(u1[j].x, h1.x, s); s = dot2bf(u1[j].y, h1.y, s); s = dot2bf(u1[j].z, h1.z, s); s = dot2bf(u1[j].w, h1.w, s);
                d[j] = wave_sum(s);
            }
#pragma unroll
            for (int j = 0; j < 4; ++j) {
                const float sc = gelu_tanh(d[j]) * S.pg[wave][e0 + j];
                acc[0] += sc * bflo(v0[j].x); acc[1] += sc * bfhi(v0[j].x); acc[2] += sc * bflo(v0[j].y); acc[3] += sc * bfhi(v0[j].y);
                acc[4] += sc * bflo(v0[j].z); acc[5] += sc * bfhi(v0[j].z); acc[6] += sc * bflo(v0[j].w); acc[7] += sc * bfhi(v0[j].w);
                acc[8] += sc * bflo(v1[j].x); acc[9] += sc * bfhi(v1[j].x); acc[10] += sc * bflo(v1[j].y); acc[11] += sc * bfhi(v1[j].y);
                acc[12] += sc * bflo(v1[j].z); acc[13] += sc * bfhi(v1[j].z); acc[14] += sc * bflo(v1[j].w); acc[15] += sc * bfhi(v1[j].w);
            }
        }
        float xr[16];
        float* xrow = X + (size_t)tok * 1024;
        const float* g2 = modl + (size_t)b * 6144 + 5 * 1024;
        float ss = 0;
#pragma unroll
        for (int hlf = 0; hlf < 2; ++hlf)
#pragma unroll
            for (int q4 = 0; q4 < 2; ++q4) {
                const int c = 512 * hlf + 8 * lane + 4 * q4;
                const float4 xv = *(const float4*)(xrow + c), gv = *(const float4*)(g2 + c);
                float4 o; o.x = xv.x + gv.x * acc[8 * hlf + 4 * q4]; o.y = xv.y + gv.y * acc[8 * hlf + 4 * q4 + 1]; o.z = xv.z + gv.z * acc[8 * hlf + 4 * q4 + 2]; o.w = xv.w + gv.w * acc[8 * hlf + 4 * q4 + 3];
                *(float4*)(xrow + c) = o;
                xr[8 * hlf + 4 * q4] = o.x; xr[8 * hlf + 4 * q4 + 1] = o.y; xr[8 * hlf + 4 * q4 + 2] = o.z; xr[8 * hlf + 4 * q4 + 3] = o.w;
                ss += o.x * o.x + o.y * o.y + o.z * o.z + o.w * o.w;
            }
        ss = wave_sum(ss);
        const float r = rsqrtf(ss * (1.f / 1024.f) + 1e-6f);
        if (l == 1) {
            float* orow = p.out + (size_t)tok * 1024;
#pragma unroll
            for (int hlf = 0; hlf < 2; ++hlf)
#pragma unroll
                for (int q4 = 0; q4 < 2; ++q4) {
                    const int c = 512 * hlf + 8 * lane + 4 * q4; const float4 gv = *(const float4*)(p.in[28] + c);
                    float4 o; o.x = xr[8 * hlf + 4 * q4] * r * gv.x; o.y = xr[8 * hlf + 4 * q4 + 1] * r * gv.y; o.z = xr[8 * hlf + 4 * q4 + 2] * r * gv.z; o.w = xr[8 * hlf + 4 * q4 + 3] * r * gv.w;
                    *(float4*)(orow + c) = o;
                }
        } else {
            const float* g = p.in[2] + 1024; const float* mod1 = (const float*)(p.ws + WS_MOD) + ((size_t)4 + b) * 6144;
            bf16* hrow = (bf16*)(p.ws + WS_H) + (size_t)tok * 1024;
#pragma unroll
            for (int hlf = 0; hlf < 2; ++hlf) {
                const int c = 512 * hlf + 8 * lane; float hv[8];
#pragma unroll
                for (int e = 0; e < 8; ++e) hv[e] = xr[8 * hlf + e] * r * g[c + e] * (1.f + mod1[1024 + c + e]) + mod1[c + e];
                u32x4 o; o.x = cvt_pk_bf16(hv[0], hv[1]); o.y = cvt_pk_bf16(hv[2], hv[3]); o.z = cvt_pk_bf16(hv[4], hv[5]); o.w = cvt_pk_bf16(hv[6], hv[7]);
                *(u32x4*)(hrow + c) = o;
            }
        }
    }
}

extern "C" void kernel_launch(void* const* d_in, const int* in_sizes, int n_in, void* d_out, int out_size, void* d_ws, size_t ws_size, hipStream_t stream) {
    if (n_in != 29 || ws_size < WS_END) { fprintf(stderr, "kernel_launch: bad args (n_in %d, ws %zu, need %zu)\n", n_in, ws_size, (size_t)WS_END); return; }
    Params p{};
    for (int i = 0; i < 29; ++i) p.in[i] = (const float*)d_in[i];
    p.out = (float*)d_out; p.ws = (unsigned char*)d_ws;
    unsigned char* ws = p.ws;
    k_mod<<<48, 256, 0, stream>>>(p);
    for (int l = 0; l < 2; ++l) {
        bf16* wtin = (bf16*)(ws + WS_WTIN) + (size_t)l * NPROJ * 1024;
        const float* win = p.in[6] + (size_t)l * 1024 * 1732;
        TrArgs a{};
        a = TrArgs{win, 1732, 0, wtin, 1024, 0, 1024, 768, 0, nullptr}; k_transpose<<<(1024 / 32) * (768 / 32), 256, 0, stream>>>(a);
        a = TrArgs{win, 1732, 0, wtin + (size_t)768 * 1024, 1024, 0, 1024, 1024, 1, p.in[20] + (size_t)l * 8 * 64 * 128}; k_transpose<<<(1024 / 32) * (1024 / 32), 256, 0, stream>>>(a);
        a = TrArgs{win, 1732, 1280, wtin + (size_t)1792 * 1024, 1024, 0, 1024, 448, 0, nullptr}; k_transpose<<<(1024 / 32) * (448 / 32), 256, 0, stream>>>(a);
        k_zero_bf16<<<64, 256, 0, stream>>>(wtin + (size_t)2240 * 1024, (size_t)64 * 1024);
        a = TrArgs{win, 1732, 1700, wtin + (size_t)2212 * 1024, 1024, 0, 1024, 32, 0, nullptr}; k_transpose<<<(1024 / 32), 256, 0, stream>>>(a);
        bf16* wtout = (bf16*)(ws + WS_WTOUT) + (size_t)l * 1024 * KMIX;
        const float* wout = p.in[22] + (size_t)l * 1024 * 1024;
        a = TrArgs{wout, 1024, 0, wtout, KMIX, 0, 512, 1024, 0, nullptr}; k_transpose<<<(512 / 32) * (1024 / 32), 256, 0, stream>>>(a);
        a = TrArgs{wout, 1024, 0, wtout, KMIX, 512, 1024, 1024, 2, p.in[21] + (size_t)l * 8 * 128 * 64}; k_transpose<<<(1024 / 32) * (1024 / 32), 256, 0, stream>>>(a);
        a = TrArgs{p.in[23] + (size_t)l * 1024 * 1024, 1024, 0, (bf16*)(ws + WS_WTQ) + (size_t)l * 1024 * 1024, 1024, 0, 1024, 1024, 0, nullptr}; k_transpose<<<32 * 32, 256, 0, stream>>>(a);
        a = TrArgs{p.in[15] + (size_t)l * 256 * 256, 256, 0, (bf16*)(ws + WS_WTGLU) + (size_t)l * 256 * 256, 256, 0, 256, 256, 0, nullptr}; k_transpose<<<8 * 8, 256, 0, stream>>>(a);
        k_conv_bf16<<<4, 256, 0, stream>>>(p.in[24] + (size_t)l * 8192, (bf16*)(ws + WS_PK) + (size_t)l * 16384, 1024);
        k_conv_bf16<<<4, 256, 0, stream>>>(p.in[25] + (size_t)l * 8192, (bf16*)(ws + WS_PK) + (size_t)l * 16384 + 8192, 1024);
    }
    k_gw<<<2 * 4 * 128 * 128 / 256, 256, 0, stream>>>(p);
    k_ssm_pw<<<8, 256, 0, stream>>>(p);
    k_ssm_tabs<<<(unsigned)(((size_t)2 * 2 * 16 * 128 * 1024 + (size_t)2 * 16 * 64 * 256) / 256), 256, 0, stream>>>(p);

    const bf16* H = (const bf16*)(ws + WS_H);
    bf16* PROJ = (bf16*)(ws + WS_PROJ);
    float* X = (float*)(ws + WS_X);
    const float* mod = (const float*)(ws + WS_MOD);
    const int NBLK = 1024;
    k_norm_mod<<<NBLK, 256, 0, stream>>>(p, p.in[0], 0, 0);
    for (int l = 0; l < 2; ++l) {
        const float* xin = l == 0 ? p.in[0] : X;
        k_gemm<EpiBf16><<<NBLK, 256, 0, stream>>>(H, 1024, (const bf16*)(ws + WS_WTIN) + (size_t)l * NPROJ * 1024, 1024, 1024, NPROJ / 128, (NTOK / 128) * (NPROJ / 128), EpiBf16{PROJ, NPROJ});
        k_ssm_a<<<256, 256, 0, stream>>>(p, l);
        k_gmlp<<<512, 256, 0, stream>>>(p, l);
        k_kvn<<<NBLK, 256, 0, stream>>>(p, l);
        k_dsa_index<<<1024, 256, 0, stream>>>(p);
        k_dsa_select<<<NBLK, 256, 0, stream>>>(p);
        k_ssm_c<<<64, 256, 0, stream>>>(p, l);
        k_dsa_attn<<<NBLK, 256, 0, stream>>>(p);
        k_gemm<EpiGlu><<<256, 256, 0, stream>>>((const bf16*)(ws + WS_YG), 256, (const bf16*)(ws + WS_WTGLU) + (size_t)l * 256 * 256, 256, 256, 2, (NTOK / 128) * 2,
                                              EpiGlu{(const bf16*)(ws + WS_YG), p.in[16] + l * 256, (bf16*)(ws + WS_MIX)});
        k_gemm<EpiResid><<<NBLK, 256, 0, stream>>>((const bf16*)(ws + WS_MIX), KMIX, (const bf16*)(ws + WS_WTOUT) + (size_t)l * 1024 * KMIX, KMIX, KMIX, 8, (NTOK / 128) * 8,
                                                 EpiResid{xin, X, mod + (size_t)l * 4 * 6144 + 2048});
        k_norm_mod<<<NBLK, 256, 0, stream>>>(p, X, l, 1);
        k_gemm<EpiBf16><<<NBLK, 256, 0, stream>>>(H, 1024, (const bf16*)(ws + WS_WTQ) + (size_t)l * 1024 * 1024, 1024, 1024, 8, (NTOK / 128) * 8, EpiBf16{PROJ, 1024});
        k_conv_bf16<<<2048, 256, 0, stream>>>(p.in[26] + (size_t)l * NEXP * 1024, (bf16*)(ws + WS_UB), (size_t)NEXP * 1024 / 8);
        k_conv_bf16<<<2048, 256, 0, stream>>>(p.in[27] + (size_t)l * NEXP * 1024, (bf16*)(ws + WS_VB), (size_t)NEXP * 1024 / 8);
        k_peer<<<NBLK, 256, 0, stream>>>(p, l);
    }
}
```

```cpp
#include <hip/hip_runtime.h>
#include <cstdint>
#include <cstdio>

typedef unsigned short bf16;
typedef short bf16x8 __attribute__((ext_vector_type(8)));
typedef short s16x4 __attribute__((ext_vector_type(4)));
typedef float f32x4 __attribute__((ext_vector_type(4)));
typedef unsigned u32x4 __attribute__((ext_vector_type(4)));
typedef unsigned u32x2 __attribute__((ext_vector_type(2)));
typedef __bf16 bf2 __attribute__((ext_vector_type(2)));
#define DI __device__ __forceinline__
#define MFMA16(a, b, c) __builtin_amdgcn_mfma_f32_16x16x32_bf16((a), (b), (c), 0, 0, 0)

constexpr int DM = 1024, NB = 4, SEQ = 4096, NTOK = NB * SEQ;
constexpr int NPROJ = 2304;
constexpr int C_UA = 0, C_UB = 256, C_VB = 512, C_QA = 768, C_CKV = 1792, C_QI = 1920, C_KI = 2176, C_WI = 2240;
constexpr int KMIX = 1536;
constexpr int NEXP = 16384;
constexpr size_t SCORES_PER_BATCH = (size_t)4096 * 2080;

constexpr size_t al256(size_t x) { return (x + 255) & ~(size_t)255; }
constexpr size_t WS_CTL = 0;
constexpr size_t WS_MOD = 65536;
constexpr size_t WS_WTIN = al256(WS_MOD + 2 * 4 * 6144 * 4);
constexpr size_t WS_WTOUT = al256(WS_WTIN + (size_t)2 * NPROJ * 1024 * 2);
constexpr size_t WS_WTQ = al256(WS_WTOUT + (size_t)2 * 1024 * KMIX * 2);
constexpr size_t WS_WTGLU = al256(WS_WTQ + (size_t)2 * 1024 * 1024 * 2);
constexpr size_t WS_GW = al256(WS_WTGLU + (size_t)2 * 256 * 256 * 2);
constexpr size_t WS_PK = al256(WS_GW + (size_t)2 * 4 * 128 * 128 * 2);
constexpr size_t WS_PW = al256(WS_PK + (size_t)2 * 2 * 128 * 64 * 2);
constexpr size_t WS_BB = al256(WS_PW + (size_t)2 * 16 * 65 * 64 * 2 * 4);
constexpr size_t WS_E = al256(WS_BB + (size_t)2 * 16 * 64 * 16 * 2 * 4);
constexpr size_t WS_G = al256(WS_E + (size_t)2 * 16 * 128 * 1024 * 2);
constexpr size_t WS_KT = al256(WS_G + (size_t)2 * 16 * 1024 * 128 * 2);
constexpr size_t WS_UB = al256(WS_KT + (size_t)2 * 16 * 64 * 256 * 2);
constexpr size_t WS_VB = al256(WS_UB + (size_t)NEXP * 1024 * 2);
constexpr size_t WS_H = al256(WS_VB + (size_t)NEXP * 1024 * 2);
constexpr size_t WS_PROJ = al256(WS_H + (size_t)NTOK * 1024 * 2);
constexpr size_t WS_SLOC = al256(WS_PROJ + (size_t)NTOK * NPROJ * 2);
constexpr size_t WS_YG = al256(WS_SLOC + (size_t)256 * 16 * 128 * 4);
constexpr size_t WS_KVN = al256(WS_YG + (size_t)NTOK * 256 * 2);
constexpr size_t WS_SEL = al256(WS_KVN + (size_t)NTOK * 128 * 2);
constexpr size_t WS_MIX = al256(WS_SEL + (size_t)NTOK * 256 * 2);
constexpr size_t WS_X = al256(WS_MIX + (size_t)NTOK * KMIX * 2);
constexpr size_t WS_SCORES = al256(WS_X + (size_t)NTOK * 1024 * 4);
constexpr size_t WS_END = al256(WS_SCORES + (size_t)NB * SCORES_PER_BATCH * 4);

struct Params {
    const float* in[29];
    float* out;
    unsigned char* ws;
};

typedef __bf16 bf2v_t __attribute__((ext_vector_type(2)));
typedef float f2v_t __attribute__((ext_vector_type(2)));
DI unsigned cvt_pk_bf16(float lo, float hi) { const f2v_t f = {lo, hi}; const bf2v_t r = __builtin_convertvector(f, bf2v_t); return __builtin_bit_cast(unsigned, r); }
DI bf16 f2bf(float x) { return (bf16)(cvt_pk_bf16(x, 0.f) & 0xffffu); }
DI float bf2f(bf16 b) { return __uint_as_float((unsigned)b << 16); }
DI float bflo(unsigned u) { return __uint_as_float(u << 16); }
DI float bfhi(unsigned u) { return __uint_as_float(u & 0xffff0000u); }
DI float dot2bf(unsigned a, unsigned b, float c) { return __builtin_amdgcn_fdot2_f32_bf16(__builtin_bit_cast(bf2, a), __builtin_bit_cast(bf2, b), c, false); }
DI float gelu_tanh(float x) { const float u = 0.7978845608028654f * (x + 0.044715f * x * x * x); const float e = __expf(2.f * u); const float t = 1.f - 2.f / (e + 1.f); return 0.5f * x * (1.f + t); }
DI float sigmoidf(float x) { return 1.f / (1.f + __expf(-x)); }
DI float wave_sum(float v) { for (int o = 32; o > 0; o >>= 1) v += __shfl_xor(v, o); return v; }
DI unsigned fkey(float v) { const unsigned u = __float_as_uint(v); return (u & 0x80000000u) ? ~u : (u | 0x80000000u); }
DI bf16x8 ld16(const void* p) { return *(const bf16x8*)p; }
DI bf16x8 zero8() { bf16x8 z = {0, 0, 0, 0, 0, 0, 0, 0}; return z; }


#define XB_TMO      128
#define XB_XCNT(j)  (256  + 64 * (j))
#define XB_XSUB(j)  (1280 + 64 * (j))
#define XB_XGEN(j)  (2304 + 64 * (j))
#define XB_TOP      3328
#define XB_TOPGEN   3392
#define XCD_BAR_WORDS 3456
#define XB_SPIN_CAP (1u << 22)
#define LAS __attribute__((address_space(3)))
DI unsigned xb_ld(unsigned* p)              { return __hip_atomic_load(p, __ATOMIC_RELAXED, __HIP_MEMORY_SCOPE_AGENT); }
DI unsigned xb_add(unsigned* p, unsigned v) { return __hip_atomic_fetch_add(p, v, __ATOMIC_RELAXED, __HIP_MEMORY_SCOPE_AGENT); }
DI unsigned xb_xcc_id() { return (unsigned)__builtin_amdgcn_s_getreg((3 << 11) | 20) & 0xFu; }
#define XB_SPIN(cond, bar) do { unsigned _sp = 0; while (cond) { __builtin_amdgcn_s_sleep(1); \
    if ((++_sp & 255u) == 0u) { if (xb_ld(&(bar)[XB_TMO])) break; if (_sp > XB_SPIN_CAP) { atomicAdd(&(bar)[XB_TMO], 1u); break; } } } } while (0)
struct XcdBarrier { unsigned* bar; unsigned x; volatile LAS unsigned* st; };
DI XcdBarrier xcd_barrier_post(unsigned* bar, volatile LAS unsigned* st) {
    XcdBarrier b; b.bar = bar; b.x = xb_xcc_id(); b.st = st;
    if (threadIdx.x == 0) (void)xb_add(&bar[XB_XCNT(b.x)], 1u);
    return b;
}
DI void xcd_barrier_complete(unsigned* bar, unsigned x, unsigned& nloc, unsigned& nx) {
    const unsigned G = gridDim.x * gridDim.y * gridDim.z;
    unsigned sum, cnt, mine, sp = 0u;
    for (;;) {
        sum = 0u; cnt = 0u; mine = 0u;
#pragma unroll
        for (unsigned j = 0; j < 16; ++j) { const unsigned c = xb_ld(&bar[XB_XCNT(j)]); sum += c; cnt += (c > 0u) ? 1u : 0u; mine = (j == x) ? c : mine; }
        if (sum == G) break;
        __builtin_amdgcn_s_sleep(1);
        if ((++sp & 255u) == 0u) { if (xb_ld(&bar[XB_TMO])) break; if (sp > XB_SPIN_CAP) { atomicAdd(&bar[XB_TMO], 1u); break; } }
    }
    nloc = mine > 0u ? mine : 1u; nx = cnt > 0u ? cnt : 1u;
}
DI void xcd_barrier(const XcdBarrier& b) {
    asm volatile("s_waitcnt vmcnt(0)" ::: "memory");
    __syncthreads();
    if (threadIdx.x == 0) {
        unsigned* bar = b.bar;
        __builtin_amdgcn_s_waitcnt(0);
        unsigned nloc = b.st[0], nx = b.st[1];
        if (nloc == 0u) { xcd_barrier_complete(bar, b.x, nloc, nx); b.st[0] = nloc; b.st[1] = nx; }
        const unsigned old = xb_add(&bar[XB_XSUB(b.x)], 1u);
        const unsigned gen = old / nloc;
        if (old + 1u == (gen + 1u) * nloc) {
            __builtin_amdgcn_fence(__ATOMIC_RELEASE, "agent");
            asm volatile("s_waitcnt vmcnt(0)" ::: "memory");
            const unsigned og = xb_add(&bar[XB_TOP], 1u);
            const unsigned tg = og / nx;
            if (og + 1u == (tg + 1u) * nx) xb_add(&bar[XB_TOPGEN], 1u);
            else XB_SPIN(xb_ld(&bar[XB_TOPGEN]) == tg, bar);
            __builtin_amdgcn_fence(__ATOMIC_ACQUIRE, "agent");
            xb_add(&bar[XB_XGEN(b.x)], 1u);
            asm volatile("s_waitcnt vmcnt(0)" ::: "memory");
        } else {
            XB_SPIN(xb_ld(&bar[XB_XGEN(b.x)]) == gen, bar);
            __builtin_amdgcn_fence(__ATOMIC_ACQUIRE, "agent");
            asm volatile("s_waitcnt vmcnt(0)" ::: "memory");
        }
    }
    __syncthreads();
}
DI unsigned char* wsb(const Params& p) {
    const unsigned long long w = (unsigned long long)p.ws;
    unsigned lo = __builtin_amdgcn_readfirstlane((unsigned)w), hi = __builtin_amdgcn_readfirstlane((unsigned)(w >> 32));
    asm volatile("" : "+s"(lo), "+s"(hi));
    return (unsigned char*)(((unsigned long long)hi << 32) | lo);
}
DI int opq_tid() { int t = (int)threadIdx.x; asm volatile("" : "+v"(t)); return t; }
DI int q_next(unsigned* ctr, volatile int* slot) {
    __syncthreads();
    if (threadIdx.x == 0) *slot = (int)__hip_atomic_fetch_add(ctr, 1u, __ATOMIC_RELAXED, __HIP_MEMORY_SCOPE_AGENT);
    __syncthreads();
    return *slot;
}

DI void it_mod(const Params& p, int vb, unsigned char* sm) {
    float (*ca)[1024] = (float (*)[1024])sm;
    const float* c = p.in[1];
    __syncthreads();
    for (int i = opq_tid(); i < 4096; i += 256) { const float v = c[i]; ca[i >> 10][i & 1023] = v / (1.f + __expf(-v)); }
    __syncthreads();
    const int idx = vb * 256 + opq_tid();
    const int l = idx / 6144, n = idx % 6144;
    const float* w = p.in[4] + (size_t)l * 1024 * 6144 + n;
    float a0 = 0, a1 = 0, a2 = 0, a3 = 0;
#pragma unroll 8
    for (int k = 0; k < 1024; ++k) { const float wv = w[(size_t)k * 6144]; a0 += ca[0][k] * wv; a1 += ca[1][k] * wv; a2 += ca[2][k] * wv; a3 += ca[3][k] * wv; }
    const float bm = p.in[5][l * 6144 + n];
    float* mod = (float*)(wsb(p) + WS_MOD) + (size_t)l * 4 * 6144 + n;
    mod[0] = a0 + bm; mod[6144] = a1 + bm; mod[2 * 6144] = a2 + bm; mod[3 * 6144] = a3 + bm;
}

struct TrArgs { const float* src; int lds, coff, nvalid; bf16* dst; int ldd, doff; int K, N; int mode; const float* aux; };
DI void it_transpose(const TrArgs& a, int vb, unsigned char* sm) {
    float (*t)[33] = (float (*)[33])sm;
    const int nk = a.K / 32;
    const int kt = vb % nk, nt = vb / nk;
    const int tx = opq_tid() & 31, ty = opq_tid() >> 5;
    __syncthreads();
    for (int r = ty; r < 32; r += 8) {
        const int k = kt * 32 + r, n = nt * 32 + tx;
        float v;
        if (a.mode == 0) v = (n + a.coff < a.nvalid) ? a.src[(size_t)k * a.lds + n + a.coff] : 0.f;
        else if (a.mode == 1) {
            const int h = n >> 7, rr = n & 127; const float* wi = a.src + (size_t)k * a.lds + 768 + 64 * h; const float* uk = a.aux + (size_t)h * 64 * 128 + rr;
            float s = 0; for (int d = 0; d < 64; ++d) s += wi[d] * uk[d * 128]; v = s * 0.125f;
        } else {
            const int h = k >> 7, rr = k & 127; const float* uv = a.aux + ((size_t)h * 128 + rr) * 64; const float* wo = a.src + (size_t)(512 + 64 * h) * a.lds + n;
            float s = 0; for (int d = 0; d < 64; ++d) s += uv[d] * wo[(size_t)d * a.lds]; v = s;
        }
        t[r][tx] = v;
    }
    __syncthreads();
    for (int r = ty; r < 32; r += 8) {
        const int n = nt * 32 + r, k = kt * 32 + tx;
        a.dst[(size_t)n * a.ldd + a.doff + k] = f2bf(t[tx][r]);
    }
}
DI void conv_chunk(const float* __restrict__ src, bf16* __restrict__ dst, size_t i0, int n8) {
    for (int i = opq_tid(); i < n8; i += 256) {
        const float4 a = ((const float4*)src)[2 * (i0 + i)], b = ((const float4*)src)[2 * (i0 + i) + 1];
        u32x4 o; o.x = cvt_pk_bf16(a.x, a.y); o.y = cvt_pk_bf16(a.z, a.w); o.z = cvt_pk_bf16(b.x, b.y); o.w = cvt_pk_bf16(b.z, b.w);
        ((u32x4*)dst)[i0 + i] = o;
    }
}
DI void it_gw(const Params& p, int vb) {
    for (int e = 0; e < 4; ++e) {
        const int idx = vb * 1024 + e * 256 + opq_tid();
        const int s = idx & 127, t = (idx >> 7) & 127;
        const float v = (t >= 64 || s < 64) ? p.in[17][idx] : 0.f;
        ((bf16*)(wsb(p) + WS_GW))[idx] = f2bf(v);
    }
}
DI void it_ssm_pw(const Params& p, int vb) {
    const int idx = vb * 256 + opq_tid();
    const int pp = idx & 63, g = (idx >> 6) & 15, l = idx >> 10;
    const float lre = -__expf(p.in[7][idx]), lim = p.in[8][idx];
    const float dt = __expf(p.in[14][l * 16 + g]);
    float* pw = (float*)(wsb(p) + WS_PW) + ((size_t)(l * 16 + g) * 65) * 128;
    for (int d = 0; d <= 64; ++d) {
        const float mag = expf(lre * dt * (float)d); float sn, cs; sincosf(lim * dt * (float)d, &sn, &cs);
        pw[d * 128 + pp * 2] = mag * cs; pw[d * 128 + pp * 2 + 1] = mag * sn;
    }
    const float mag = expf(lre * dt); float sn, cs; sincosf(lim * dt, &sn, &cs);
    const float are = mag * cs, aim = mag * sn;
    const float den = lre * lre + lim * lim, P = are - 1.f, Q = aim;
    const float fre = (P * lre + Q * lim) / den, fim = (Q * lre - P * lim) / den;
    float* bb = (float*)(wsb(p) + WS_BB) + (size_t)idx * 32;
    for (int h = 0; h < 16; ++h) { const float br = p.in[9][(size_t)idx * 16 + h], bi = p.in[10][(size_t)idx * 16 + h]; bb[h * 2] = fre * br - fim * bi; bb[h * 2 + 1] = fre * bi + fim * br; }
}
DI void ssm_tab_entry(const Params& p, size_t idx) {
    const size_t NE = (size_t)2 * 16 * 128 * 1024;
    const float* PW = (const float*)(wsb(p) + WS_PW); const float* BB = (const float*)(wsb(p) + WS_BB);
    if (idx < NE) {
        const int kk = idx & 1023, pp = (idx >> 10) & 127; const int lg = (int)(idx >> 17);
        const int i = kk >> 4, hh = kk & 15, pq = pp & 63, part = pp >> 6;
        const float* pw = PW + ((size_t)lg * 65 + (63 - i)) * 128 + pq * 2; const float* bb = BB + ((size_t)lg * 64 + pq) * 32 + hh * 2;
        const float v = part ? (pw[0] * bb[1] + pw[1] * bb[0]) : (pw[0] * bb[0] - pw[1] * bb[1]);
        ((bf16*)(wsb(p) + WS_E))[idx] = f2bf(v);
    } else if (idx < 2 * NE) {
        const size_t e = idx - NE; const int pp = e & 127, jh = (e >> 7) & 1023; const int lg = (int)(e >> 17);
        const int j = jh >> 4, h = jh & 15, pq = pp & 63, part = pp >> 6;
        const float* pw = PW + ((size_t)lg * 65 + (j + 1)) * 128 + pq * 2;
        const float cr = p.in[11][((size_t)lg * 16 + h) * 64 + pq], ci = p.in[12][((size_t)lg * 16 + h) * 64 + pq];
        const float v = part ? -(cr * pw[1] + ci * pw[0]) : (cr * pw[0] - ci * pw[1]);
        ((bf16*)(wsb(p) + WS_G))[e] = f2bf(v);
    } else {
        const size_t e = idx - 2 * NE; if (e >= (size_t)2 * 16 * 64 * 256) return;
        const int hh = e & 15, h = (e >> 4) & 15, d = (e >> 8) & 63; const int lg = (int)(e >> 14);
        const float* pw = PW + ((size_t)lg * 65 + d) * 128; const float* bb = BB + (size_t)lg * 64 * 32 + hh * 2;
        const float* cr = p.in[11] + ((size_t)lg * 16 + h) * 64; const float* ci = p.in[12] + ((size_t)lg * 16 + h) * 64;
        float s = 0;
        for (int q = 0; q < 64; ++q) { const float zr = pw[q * 2] * bb[q * 32] - pw[q * 2 + 1] * bb[q * 32 + 1], zi = pw[q * 2] * bb[q * 32 + 1] + pw[q * 2 + 1] * bb[q * 32]; s += cr[q] * zr - ci[q] * zi; }
        ((bf16*)(wsb(p) + WS_KT))[e] = f2bf(s);
    }
}
DI void norm_mod_row(const float* __restrict__ xrow, const float* __restrict__ g, const float* __restrict__ sh, const float* __restrict__ sc, bf16* __restrict__ hrow, int lane) {
    float4 v[4]; float ss = 0;
#pragma unroll
    for (int j = 0; j < 4; ++j) { v[j] = *(const float4*)(xrow + 4 * lane + 256 * j); ss += v[j].x * v[j].x + v[j].y * v[j].y + v[j].z * v[j].z + v[j].w * v[j].w; }
    ss = wave_sum(ss);
    const float r = rsqrtf(ss * (1.f / 1024.f) + 1e-6f);
#pragma unroll
    for (int j = 0; j < 4; ++j) {
        const int c = 4 * lane + 256 * j;
        const float4 gg = *(const float4*)(g + c), s1 = *(const float4*)(sc + c), s0 = *(const float4*)(sh + c);
        u32x2 o; o.x = cvt_pk_bf16(v[j].x * r * gg.x * (1.f + s1.x) + s0.x, v[j].y * r * gg.y * (1.f + s1.y) + s0.y);
        o.y = cvt_pk_bf16(v[j].z * r * gg.z * (1.f + s1.z) + s0.z, v[j].w * r * gg.w * (1.f + s1.w) + s0.w);
        *(u32x2*)(hrow + c) = o;
    }
}
constexpr int GP = 72;
template <class Epi>
DI void gemm_tile(const bf16* __restrict__ A, int lda, const bf16* __restrict__ Bt, int ldb, int K, int m0, int n0, bf16* lds, const Epi& epi) {
    bf16* As = lds; bf16* Bs = lds + 128 * GP;
    const int tid = opq_tid(), lane = tid & 63, wave = tid >> 6, wm = wave >> 1, wn = wave & 1;
    const int fr = lane & 15, fq = lane >> 4;
    const int lrow = tid >> 3, lch = tid & 7;
    f32x4 acc[4][4];
#pragma unroll
    for (int i = 0; i < 4; ++i)
#pragma unroll
        for (int j = 0; j < 4; ++j) acc[i][j] = (f32x4){0.f, 0.f, 0.f, 0.f};
    bf16x8 ra[4], rb[4];
    const bf16* Ag = A + (size_t)(m0 + lrow) * lda + lch * 8;
    const bf16* Bg = Bt + (size_t)(n0 + lrow) * ldb + lch * 8;
#pragma unroll
    for (int i = 0; i < 4; ++i) { ra[i] = ld16(Ag + (size_t)32 * i * lda); rb[i] = ld16(Bg + (size_t)32 * i * ldb); }
    const int nk = K / 64;
    for (int kt = 0; kt < nk; ++kt) {
        __syncthreads();
#pragma unroll
        for (int i = 0; i < 4; ++i) { *(bf16x8*)(As + (lrow + 32 * i) * GP + lch * 8) = ra[i]; *(bf16x8*)(Bs + (lrow + 32 * i) * GP + lch * 8) = rb[i]; }
        __syncthreads();
        if (kt + 1 < nk) {
#pragma unroll
            for (int i = 0; i < 4; ++i) { ra[i] = ld16(Ag + (size_t)32 * i * lda + (kt + 1) * 64); rb[i] = ld16(Bg + (size_t)32 * i * ldb + (kt + 1) * 64); }
        }
#pragma unroll
        for (int ks = 0; ks < 2; ++ks) {
            bf16x8 fa[4], fb[4];
#pragma unroll
            for (int i = 0; i < 4; ++i) { fa[i] = ld16(Bs + (64 * wn + 16 * i + fr) * GP + 32 * ks + 8 * fq); fb[i] = ld16(As + (64 * wm + 16 * i + fr) * GP + 32 * ks + 8 * fq); }
#pragma unroll
            for (int i = 0; i < 4; ++i)
#pragma unroll
                for (int j = 0; j < 4; ++j) acc[i][j] = MFMA16(fa[i], fb[j], acc[i][j]);
        }
    }
#pragma unroll
    for (int i = 0; i < 4; ++i)
#pragma unroll
        for (int j = 0; j < 4; ++j) epi(m0 + 64 * wm + 16 * j + fr, n0 + 64 * wn + 16 * i + 4 * fq, acc[i][j]);
}
struct EpiBf16 { bf16* C; int ldc; DI void operator()(int r, int c, f32x4 v) const { u32x2 o; o.x = cvt_pk_bf16(v[0], v[1]); o.y = cvt_pk_bf16(v[2], v[3]); *(u32x2*)(C + (size_t)r * ldc + c) = o; } };
struct EpiResid { const float* xin; float* xout; const float* gate;
    DI void operator()(int r, int c, f32x4 v) const { const float4 x = *(const float4*)(xin + (size_t)r * 1024 + c); const float4 g = *(const float4*)(gate + (size_t)(r >> 12) * 6144 + c);
        float4 o; o.x = x.x + g.x * v[0]; o.y = x.y + g.y * v[1]; o.z = x.z + g.z * v[2]; o.w = x.w + g.w * v[3]; *(float4*)(xout + (size_t)r * 1024 + c) = o; } };
struct EpiGlu { const bf16* yg; const float* bglu; bf16* mix;
    DI void operator()(int r, int c, f32x4 v) const { const u32x2 y = *(const u32x2*)(yg + (size_t)r * 256 + c); const float4 b = *(const float4*)(bglu + c);
        u32x2 o; o.x = cvt_pk_bf16(bflo(y.x) * sigmoidf(v[0] + b.x), bfhi(y.x) * sigmoidf(v[1] + b.y)); o.y = cvt_pk_bf16(bflo(y.y) * sigmoidf(v[2] + b.z), bfhi(y.y) * sigmoidf(v[3] + b.w));
        *(u32x2*)(mix + (size_t)r * KMIX + c) = o; } };

template <int NV>
DI void select16(const float (&v)[NV], const int (&id)[NV], float* outv, int* outi, int lane) {
    unsigned key[NV];
#pragma unroll
    for (int j = 0; j < NV; ++j) key[j] = fkey(v[j]);
    unsigned T = 0;
    for (int bit = 31; bit >= 0; --bit) {
        const unsigned cand = T | (1u << bit);
        int cnt = 0;
#pragma unroll
        for (int j = 0; j < NV; ++j) cnt += __popcll(__ballot(key[j] >= cand));
        if (cnt >= 16) { T = cand; if (cnt == 16) break; }
    }
    int cgt = 0;
#pragma unroll
    for (int j = 0; j < NV; ++j) cgt += __popcll(__ballot(key[j] > T));
    const int need = 16 - cgt;
    int base = 0, eqb = 0;
    const unsigned long long lt = (1ull << lane) - 1ull;
#pragma unroll
    for (int j = 0; j < NV; ++j) {
        const unsigned long long me = __ballot(key[j] == T);
        const bool take = (key[j] > T) || (key[j] == T && (eqb + __popcll(me & lt)) < need);
        const unsigned long long mt = __ballot(take);
        if (take) { const int pos = base + __popcll(mt & lt); outv[pos] = v[j]; outi[pos] = id[j]; }
        base += __popcll(mt); eqb += __popcll(me);
    }
}

constexpr int KP = 68;
struct PeerLds { bf16 k1[128 * KP]; bf16 k2[128 * KP]; bf16 q[4][1024]; float l1v[4][16]; int l1i[4][16]; float l2v[4][16]; int l2i[4][16]; float cv[4][16]; int ci[4][16]; int pe[4][128]; float pg[4][128]; };
DI unsigned off_b(unsigned row, unsigned ch) { return 256u * row + 16u * (ch ^ (((row & 3u) << 2) | ((row >> 2) & 3u))); }
#define TR8(o0, o1, o2, o3, o4, o5, o6, o7, a0, a1, a2, a3, a4, a5, a6, a7)                                                                         \
    asm volatile("s_waitcnt lgkmcnt(0)\n\t"                                                                                                         \
                 "ds_read_b64_tr_b16 %0, %8\n\tds_read_b64_tr_b16 %1, %9\n\tds_read_b64_tr_b16 %2, %10\n\tds_read_b64_tr_b16 %3, %11\n\t"           \
                 "ds_read_b64_tr_b16 %4, %12\n\tds_read_b64_tr_b16 %5, %13\n\tds_read_b64_tr_b16 %6, %14\n\tds_read_b64_tr_b16 %7, %15\n\t"         \
                 "s_waitcnt lgkmcnt(0)"                                                                                                             \
                 : "=&v"(o0), "=&v"(o1), "=&v"(o2), "=&v"(o3), "=&v"(o4), "=&v"(o5), "=&v"(o6), "=&v"(o7)                                           \
                 : "v"(a0), "v"(a1), "v"(a2), "v"(a3), "v"(a4), "v"(a5), "v"(a6), "v"(a7)                                                           \
                 : "memory")

DI void it_kvn(const Params& p, int l, int vb) {
    const int lane = opq_tid() & 63, wave = opq_tid() >> 6;
    const bf16* proj = (const bf16*)(wsb(p) + WS_PROJ); bf16* kvn = (bf16*)(wsb(p) + WS_KVN);
    const float g0 = p.in[19][l * 128 + 2 * lane], g1 = p.in[19][l * 128 + 2 * lane + 1];
    for (int i = 0; i < 16; ++i) {
        const int row = vb * 64 + i * 4 + wave;
        const unsigned u = *(const unsigned*)(proj + (size_t)row * NPROJ + C_CKV + 2 * lane);
        const float a = bflo(u), b = bfhi(u);
        const float ss = wave_sum(a * a + b * b);
        const float r = rsqrtf(ss * (1.f / 128.f) + 1e-6f);
        *(unsigned*)(kvn + (size_t)row * 128 + 2 * lane) = cvt_pk_bf16(a * r * g0, b * r * g1);
    }
}

DI void it_ssm_a(const Params& p, int l, int item) {
    const int lane = opq_tid() & 63, wave = opq_tid() >> 6, fr = lane & 15, fq = lane >> 4;
    const bf16* proj = (const bf16*)(wsb(p) + WS_PROJ);
    float* sloc = (float*)(wsb(p) + WS_SLOC);
    const int g = item & 15, rt = item >> 4;
    const bf16* E = (const bf16*)(wsb(p) + WS_E) + ((size_t)(l * 16 + g) * 128) * 1024;
    const int R = 16 * rt + fr, b = R >> 6, k = R & 63;
    const bf16* arow = proj + ((size_t)b * 4096 + 64 * k + (fq >> 1)) * NPROJ + C_UA + 16 * g + 8 * (fq & 1);
    f32x4 acc[2] = {(f32x4){0, 0, 0, 0}, (f32x4){0, 0, 0, 0}};
    for (int ks = 0; ks < 32; ++ks) {
        const bf16x8 a = ld16(arow + (size_t)(2 * ks) * NPROJ);
#pragma unroll
        for (int c = 0; c < 2; ++c) { const int ct = 2 * wave + c; const bf16x8 bf = ld16(E + (size_t)(16 * ct + fr) * 1024 + 32 * ks + 8 * fq); acc[c] = MFMA16(a, bf, acc[c]); }
    }
#pragma unroll
    for (int c = 0; c < 2; ++c)
#pragma unroll
        for (int i = 0; i < 4; ++i) sloc[((size_t)(16 * rt + 4 * fq + i) * 16 + g) * 128 + 16 * (2 * wave + c) + fr] = acc[c][i];
}

DI void it_ssm_c(const Params& p, int l, int item, unsigned char* sm) {
    bf16* sst = (bf16*)sm;
    const int lane = opq_tid() & 63, wave = opq_tid() >> 6, fr = lane & 15, fq = lane >> 4;
    const bf16* proj = (const bf16*)(wsb(p) + WS_PROJ);
    const float* sloc = (const float*)(wsb(p) + WS_SLOC);
    bf16* yg = (bf16*)(wsb(p) + WS_YG);
    const int jq = item & 3, g = (item >> 2) & 15, b = item >> 6;
    __syncthreads();
    if (wave == 0) {
        const float* pw64 = (const float*)(wsb(p) + WS_PW) + ((size_t)(l * 16 + g) * 65 + 64) * 128 + lane * 2;
        const float ar = pw64[0], ai = pw64[1];
        float sr = 0, si = 0;
        const float* s = sloc + ((size_t)(b * 64) * 16 + g) * 128;
#pragma unroll 8
        for (int k = 0; k < 64; ++k) {
            sst[k * 136 + lane] = f2bf(sr); sst[k * 136 + 64 + lane] = f2bf(si);
            const float lr = s[(size_t)k * 2048 + lane], li = s[(size_t)k * 2048 + 64 + lane];
            const float nr = ar * sr - ai * si + lr, ni = ar * si + ai * sr + li;
            sr = nr; si = ni;
        }
    }
    __syncthreads();
    const bf16* KT = (const bf16*)(wsb(p) + WS_KT) + (size_t)(l * 16 + g) * 64 * 256;
    const bf16* G = (const bf16*)(wsb(p) + WS_G) + (size_t)(l * 16 + g) * 1024 * 128;
    const int kch = 16 * wave + fr;
    const bf16* arow = proj + ((size_t)b * 4096 + 64 * kch + (fq >> 1)) * NPROJ + C_UA + 16 * g + 8 * (fq & 1);
    const float dsk = p.in[13][l * 256 + 16 * g + fr];
    for (int j = 16 * jq; j < 16 * jq + 16; ++j) {
        f32x4 acc = {0, 0, 0, 0};
        for (int ks = 0; 2 * ks <= j; ++ks) {
            const bf16x8 a = ld16(arow + (size_t)(2 * ks) * NPROJ);
            const int d = j - 2 * ks - (fq >> 1);
            const bf16x8 bf = d >= 0 ? ld16(KT + ((size_t)d * 16 + fr) * 16 + 8 * (fq & 1)) : zero8();
            acc = MFMA16(a, bf, acc);
        }
#pragma unroll
        for (int ks = 0; ks < 4; ++ks) {
            const bf16x8 a = ld16(sst + kch * 136 + 32 * ks + 8 * fq);
            const bf16x8 bf = ld16(G + ((size_t)(j * 16 + fr)) * 128 + 32 * ks + 8 * fq);
            acc = MFMA16(a, bf, acc);
        }
#pragma unroll
        for (int i = 0; i < 4; ++i) {
            const size_t tok = (size_t)b * 4096 + 64 * (16 * wave + 4 * fq + i) + j;
            const float u = bf2f(proj[tok * NPROJ + C_UA + 16 * g + fr]);
            yg[tok * 256 + 16 * g + fr] = f2bf(gelu_tanh(acc[i] + dsk * u));
        }
    }
}

DI void it_gmlp(const Params& p, int l, int item, unsigned char* sm) {
    bf16* vnT = (bf16*)sm;
    const int tid = opq_tid(), lane = tid & 63, wave = tid >> 6, fr = lane & 15, fq = lane >> 4;
    const bf16* proj = (const bf16*)(wsb(p) + WS_PROJ); bf16* mix = (bf16*)(wsb(p) + WS_MIX);
    const int h = item & 3, blk = item >> 2;
    const size_t tok0 = (size_t)blk * 128;
    __syncthreads();
    {
        const int row = tid >> 1, half = tid & 1;
        const bf16* vp = proj + (tok0 + row) * NPROJ + C_VB + 64 * h + 32 * half;
        float v[32]; float s = 0;
#pragma unroll
        for (int q = 0; q < 4; ++q) { const bf16x8 t = ld16(vp + 8 * q);
#pragma unroll
            for (int e = 0; e < 8; ++e) { v[8 * q + e] = bf2f((bf16)t[e]); s += v[8 * q + e]; } }
        s += __shfl_xor(s, 1); const float mu = s * (1.f / 64.f);
        float vs = 0;
#pragma unroll
        for (int e = 0; e < 32; ++e) { const float d = v[e] - mu; vs += d * d; }
        vs += __shfl_xor(vs, 1); const float r = rsqrtf(vs * (1.f / 64.f) + 1e-6f);
#pragma unroll
        for (int e = 0; e < 32; ++e) vnT[(32 * half + e) * 136 + row] = f2bf((v[e] - mu) * r);
    }
    __syncthreads();
    const bf16* W = (const bf16*)(wsb(p) + WS_GW) + (size_t)(l * 4 + h) * 128 * 128;
    f32x4 acc[4][2];
#pragma unroll
    for (int i = 0; i < 4; ++i) { acc[i][0] = (f32x4){0, 0, 0, 0}; acc[i][1] = (f32x4){0, 0, 0, 0}; }
#pragma unroll
    for (int ks = 0; ks < 4; ++ks) {
        bf16x8 fa[4], fb[2];
#pragma unroll
        for (int i = 0; i < 4; ++i) fa[i] = ld16(vnT + (16 * i + fr) * 136 + 32 * ks + 8 * fq);
#pragma unroll
        for (int j = 0; j < 2; ++j) fb[j] = ld16(W + (size_t)(16 * (2 * wave + j) + fr) * 128 + 32 * ks + 8 * fq);
#pragma unroll
        for (int i = 0; i < 4; ++i)
#pragma unroll
            for (int j = 0; j < 2; ++j) acc[i][j] = MFMA16(fa[i], fb[j], acc[i][j]);
    }
#pragma unroll
    for (int j = 0; j < 2; ++j) {
        const int t = 16 * (2 * wave + j) + fr;
        const float bs = p.in[18][(l * 4 + h) * 128 + t];
#pragma unroll
        for (int i = 0; i < 4; ++i) {
            const int d = 16 * i + 4 * fq;
            const u32x2 u = *(const u32x2*)(proj + (tok0 + t) * NPROJ + C_UB + 64 * h + d);
            u32x2 o; o.x = cvt_pk_bf16(bflo(u.x) * (acc[i][j][0] + bs), bfhi(u.x) * (acc[i][j][1] + bs)); o.y = cvt_pk_bf16(bflo(u.y) * (acc[i][j][2] + bs), bfhi(u.y) * (acc[i][j][3] + bs));
            *(u32x2*)(mix + (tok0 + t) * KMIX + 256 + 64 * h + d) = o;
        }
    }
}

DI size_t score_row_off(int b, int t) { const int c = t >> 6; return (size_t)b * SCORES_PER_BATCH + (size_t)4096 * (c * (c + 1) / 2) + (size_t)(t & 63) * 64 * (c + 1); }
DI void dsa_select_query(const Params& p, int q, int lane) {
    const float* scores = (const float*)(wsb(p) + WS_SCORES); bf16* sel = (bf16*)(wsb(p) + WS_SEL);
    const int b = q >> 12, t = q & 4095, c = t >> 6, nreg = c + 1;
    bf16* so = sel + (size_t)q * 256;
    if (nreg <= 4) { for (int r = 0; r < nreg; ++r) so[64 * r + lane] = (bf16)(64 * r + lane); return; }
    const float* srow = scores + score_row_off(b, t);
    unsigned key[64];
#pragma unroll
    for (int r = 0; r < 64; ++r) key[r] = (r < nreg) ? fkey(srow[64 * r + lane]) : 0u;
    unsigned T = 0;
    for (int bit = 31; bit >= 0; --bit) {
        const unsigned cand = T | (1u << bit);
        int cnt = 0;
#pragma unroll
        for (int r = 0; r < 64; ++r) if (r < nreg) cnt += __popcll(__ballot(key[r] >= cand));
        if (cnt >= 256) { T = cand; if (cnt == 256) break; }
    }
    int cgt = 0;
#pragma unroll
    for (int r = 0; r < 64; ++r) if (r < nreg) cgt += __popcll(__ballot(key[r] > T));
    const int need = 256 - cgt;
    int base = 0, eqb = 0;
    const unsigned long long lt = (1ull << lane) - 1ull;
#pragma unroll
    for (int r = 0; r < 64; ++r) if (r < nreg) {
        const unsigned long long me = __ballot(key[r] == T);
        const int erank = eqb + __popcll(me & lt);
        const bool take = (key[r] > T) || (key[r] == T && erank < need);
        const unsigned long long mt = __ballot(take);
        if (take) so[base + __popcll(mt & lt)] = (bf16)(64 * r + lane);
        base += __popcll(mt); eqb += __popcll(me);
    }
}
DI void it_dsa_index_select(const Params& p, int item) {
    const int lane = opq_tid() & 63, wave = opq_tid() >> 6, fr = lane & 15, fq = lane >> 4;
    const bf16* proj = (const bf16*)(wsb(p) + WS_PROJ); float* scores = (float*)(wsb(p) + WS_SCORES);
    const int c = 63 - (item >> 4), b = (item >> 2) & 3, qg = item & 3;
    if (c >= 4) {
        const int t = 64 * c + 16 * qg + fr;
        const bf16* qrow = proj + ((size_t)b * 4096 + t) * NPROJ;
        bf16x8 qf[4][2];
#pragma unroll
        for (int hh = 0; hh < 4; ++hh)
#pragma unroll
            for (int ks = 0; ks < 2; ++ks) qf[hh][ks] = ld16(qrow + C_QI + 64 * hh + 32 * ks + 8 * fq);
        float w[4];
        { const u32x2 wv = *(const u32x2*)(qrow + C_WI); w[0] = bflo(wv.x) * 0.0625f; w[1] = bfhi(wv.x) * 0.0625f; w[2] = bflo(wv.y) * 0.0625f; w[3] = bfhi(wv.y) * 0.0625f; }
        float* srow = scores + score_row_off(b, t);
        const int ntile = 4 * (c + 1);
        for (int kt = wave; kt < ntile; kt += 4) {
            const bf16* krow = proj + ((size_t)b * 4096 + 16 * kt + fr) * NPROJ + C_KI + 8 * fq;
            const bf16x8 k0 = ld16(krow), k1 = ld16(krow + 32);
            f32x4 sc = {0, 0, 0, 0};
#pragma unroll
            for (int hh = 0; hh < 4; ++hh) {
                f32x4 a = {0, 0, 0, 0};
                a = MFMA16(k0, qf[hh][0], a); a = MFMA16(k1, qf[hh][1], a);
#pragma unroll
                for (int i = 0; i < 4; ++i) sc[i] += w[hh] * fmaxf(a[i], 0.f);
            }
#pragma unroll
            for (int i = 0; i < 4; ++i) sc[i] += 0.f;
            *(f32x4*)(srow + 16 * kt + 4 * fq) = sc;
        }
        asm volatile("s_waitcnt vmcnt(0)" ::: "memory");
    }
    __syncthreads();
    for (int i = 0; i < 4; ++i) dsa_select_query(p, b * 4096 + 64 * c + 16 * qg + 4 * wave + i, lane);
}
DI void it_dsa_attn(const Params& p, int item, unsigned char* sm) {
    const int lane = opq_tid() & 63, wave = opq_tid() >> 6, fr = lane & 15, fq = lane >> 4;
    unsigned char* tile = sm + wave * 8192;
    const bf16* proj = (const bf16*)(wsb(p) + WS_PROJ); const bf16* kvn = (const bf16*)(wsb(p) + WS_KVN);
    const bf16* sel = (const bf16*)(wsb(p) + WS_SEL); bf16* mix = (bf16*)(wsb(p) + WS_MIX);
    unsigned wr_addr[8], rd_addr[2][4], tr_addr[8][2];
#pragma unroll
    for (int i = 0; i < 8; ++i) wr_addr[i] = off_b(4 * i + fq, fr);
#pragma unroll
    for (int rb = 0; rb < 2; ++rb)
#pragma unroll
        for (int s = 0; s < 4; ++s) rd_addr[rb][s] = off_b(8 * (fr >> 2) + 4 * rb + (fr & 3), 4 * s + fq);
    const unsigned tbase = (unsigned)(size_t)tile;
    {
        const unsigned q4 = fr >> 2, p4 = fr & 3;
#pragma unroll
        for (int c = 0; c < 8; ++c)
#pragma unroll
            for (int t = 0; t < 2; ++t) tr_addr[c][t] = tbase + off_b(8 * fq + 4 * t + q4, 2 * c + (p4 >> 1)) + 8 * (p4 & 1);
    }
    const float slope = fr < 8 ? exp2f(-(float)(fr + 1)) : 0.f;
    for (int qi = 0; qi < 4; ++qi) {
        const int q = item * 16 + wave * 4 + qi;
        const int b = q >> 12, t = q & 4095, c = t >> 6;
        const int nsel = (c + 1) * 64 < 256 ? (c + 1) * 64 : 256;
        const bf16* qa = proj + (size_t)q * NPROJ + C_QA;
        bf16x8 qf[4];
#pragma unroll
        for (int s = 0; s < 4; ++s) qf[s] = fr < 8 ? ld16(qa + fr * 128 + 32 * s + 8 * fq) : zero8();
        const bf16* selp = sel + (size_t)q * 256;
        const bf16* kvb = kvn + (size_t)b * 4096 * 128;
        float m_run = -INFINITY, l_run = 0.f;
        f32x4 o[8];
#pragma unroll
        for (int i = 0; i < 8; ++i) o[i] = (f32x4){0, 0, 0, 0};
        for (int ti = 0; ti < nsel / 32; ++ti) {
            bf16x8 gk[8];
#pragma unroll
            for (int i = 0; i < 8; ++i) { const int key = selp[32 * ti + 4 * i + fq]; gk[i] = ld16(kvb + (size_t)key * 128 + 8 * fr); }
            const bf16x8 kp = ld16(selp + 32 * ti + 8 * fq);
#pragma unroll
            for (int i = 0; i < 8; ++i) *(bf16x8*)(tile + wr_addr[i]) = gk[i];
            f32x4 lg[2] = {(f32x4){0, 0, 0, 0}, (f32x4){0, 0, 0, 0}};
#pragma unroll
            for (int rb = 0; rb < 2; ++rb)
#pragma unroll
                for (int s = 0; s < 4; ++s) lg[rb] = MFMA16(ld16(tile + rd_addr[rb][s]), qf[s], lg[rb]);
            float val[8]; float tmax = -INFINITY;
#pragma unroll
            for (int j = 0; j < 8; ++j) { const float dist = fabsf((float)(t - (int)(unsigned short)kp[j])); val[j] = lg[j >> 2][j & 3] - slope * dist; tmax = fmaxf(tmax, val[j]); }
            tmax = fmaxf(tmax, __shfl_xor(tmax, 16)); tmax = fmaxf(tmax, __shfl_xor(tmax, 32));
            const float m_new = fmaxf(m_run, tmax);
            const float scale = __expf(m_run - m_new);
            l_run *= scale;
#pragma unroll
            for (int i = 0; i < 8; ++i) o[i] *= scale;
            float pv[8];
#pragma unroll
            for (int j = 0; j < 8; ++j) { pv[j] = __expf(val[j] - m_new); l_run += pv[j]; }
            m_run = m_new;
            u32x4 pk; pk.x = cvt_pk_bf16(pv[0], pv[1]); pk.y = cvt_pk_bf16(pv[2], pv[3]); pk.z = cvt_pk_bf16(pv[4], pv[5]); pk.w = cvt_pk_bf16(pv[6], pv[7]);
            const bf16x8 pf = __builtin_bit_cast(bf16x8, pk);
            s16x4 tr[8][2];
            TR8(tr[0][0], tr[0][1], tr[1][0], tr[1][1], tr[2][0], tr[2][1], tr[3][0], tr[3][1], tr_addr[0][0], tr_addr[0][1], tr_addr[1][0], tr_addr[1][1], tr_addr[2][0], tr_addr[2][1], tr_addr[3][0], tr_addr[3][1]);
            TR8(tr[4][0], tr[4][1], tr[5][0], tr[5][1], tr[6][0], tr[6][1], tr[7][0], tr[7][1], tr_addr[4][0], tr_addr[4][1], tr_addr[5][0], tr_addr[5][1], tr_addr[6][0], tr_addr[6][1], tr_addr[7][0], tr_addr[7][1]);
#pragma unroll
            for (int cc = 0; cc < 8; ++cc) {
                bf16x8 kf; kf[0] = tr[cc][0][0]; kf[1] = tr[cc][0][1]; kf[2] = tr[cc][0][2]; kf[3] = tr[cc][0][3]; kf[4] = tr[cc][1][0]; kf[5] = tr[cc][1][1]; kf[6] = tr[cc][1][2]; kf[7] = tr[cc][1][3];
                o[cc] = MFMA16(kf, pf, o[cc]);
            }
        }
        float lt = l_run; lt += __shfl_xor(lt, 16); lt += __shfl_xor(lt, 32);
        const float inv = 1.f / lt;
        if (fr < 8) {
#pragma unroll
            for (int cc = 0; cc < 8; ++cc) { u32x2 ov; ov.x = cvt_pk_bf16(o[cc][0] * inv, o[cc][1] * inv); ov.y = cvt_pk_bf16(o[cc][2] * inv, o[cc][3] * inv);
                *(u32x2*)(mix + (size_t)q * KMIX + 512 + fr * 128 + 16 * cc + 4 * fq) = ov; }
        }
    }
}
DI void peer_load_keys(const Params& p, int l, PeerLds& S) {
    const bf16* pk = (const bf16*)(wsb(p) + WS_PK) + (size_t)l * 2 * 128 * 64;
    __syncthreads();
    for (int i = opq_tid(); i < 128 * 64; i += 256) { S.k1[(i >> 6) * KP + (i & 63)] = pk[i]; S.k2[(i >> 6) * KP + (i & 63)] = pk[128 * 64 + i]; }
    __syncthreads();
}
DI void peer_token(const Params& p, int l, int tok4, PeerLds& S) {
    const int tid_ = opq_tid(), lane = tid_ & 63, wave = tid_ >> 6; const int tok = tok4 + wave;
    const bf16* QP = (const bf16*)(wsb(p) + WS_PROJ);
    const bf16* H = (const bf16*)(wsb(p) + WS_H);
    const bf16* UB = (const bf16*)(wsb(p) + WS_UB); const bf16* VB = (const bf16*)(wsb(p) + WS_VB);
    float* X = (float*)(wsb(p) + WS_X);
    const float* modl = (const float*)(wsb(p) + WS_MOD) + (size_t)l * 4 * 6144;
    const int b = tok >> 12;
    *(bf16x8*)(S.q[wave] + 8 * lane) = ld16(QP + (size_t)tok * 1024 + 8 * lane);
    *(bf16x8*)(S.q[wave] + 512 + 8 * lane) = ld16(QP + (size_t)tok * 1024 + 512 + 8 * lane);
    const u32x4 h0 = *(const u32x4*)(H + (size_t)tok * 1024 + 8 * lane), h1 = *(const u32x4*)(H + (size_t)tok * 1024 + 512 + 8 * lane);
    for (int hp = 0; hp < 8; ++hp) {
        float s1[2] = {0, 0}, s2[2] = {0, 0};
        const bf16* q1 = S.q[wave] + 128 * hp; const bf16* q2 = q1 + 64;
#pragma unroll
        for (int d4 = 0; d4 < 16; ++d4) {
            const u32x2 qa = *(const u32x2*)(q1 + 4 * d4), qb = *(const u32x2*)(q2 + 4 * d4);
#pragma unroll
            for (int j = 0; j < 2; ++j) {
                const u32x2 ka = *(const u32x2*)(S.k1 + (lane + 64 * j) * KP + 4 * d4), kb = *(const u32x2*)(S.k2 + (lane + 64 * j) * KP + 4 * d4);
                s1[j] = dot2bf(ka.x, qa.x, s1[j]); s1[j] = dot2bf(ka.y, qa.y, s1[j]);
                s2[j] = dot2bf(kb.x, qb.x, s2[j]); s2[j] = dot2bf(kb.y, qb.y, s2[j]);
            }
        }
        const int ids[2] = {lane, lane + 64};
        select16<2>(s1, ids, S.l1v[wave], S.l1i[wave], lane);
        select16<2>(s2, ids, S.l2v[wave], S.l2i[wave], lane);
        float cv[4]; int ci[4];
        { const int a = lane >> 2, b4 = (lane & 3) * 4; const float va = S.l1v[wave][a]; const int ia = S.l1i[wave][a];
#pragma unroll
          for (int j = 0; j < 4; ++j) { cv[j] = va + S.l2v[wave][b4 + j]; ci[j] = ia * 128 + S.l2i[wave][b4 + j]; } }
        select16<4>(cv, ci, S.cv[wave], S.ci[wave], lane);
        {
            const float sv = S.cv[wave][lane & 15];
            float mx = sv; for (int o = 8; o > 0; o >>= 1) mx = fmaxf(mx, __shfl_xor(mx, o));
            const float e = __expf(sv - mx); float sm = e; for (int o = 8; o > 0; o >>= 1) sm += __shfl_xor(sm, o);
            if (lane < 16) { S.pe[wave][hp * 16 + lane] = S.ci[wave][lane]; S.pg[wave][hp * 16 + lane] = e / sm; }
        }
    }
    float acc[16];
#pragma unroll
    for (int i = 0; i < 16; ++i) acc[i] = 0.f;
    for (int e0 = 0; e0 < 128; e0 += 2) {
        u32x4 u0[2], u1[2], v0[2], v1[2]; float d[2];
#pragma unroll
        for (int j = 0; j < 2; ++j) {
            const int e = __builtin_amdgcn_readfirstlane(S.pe[wave][e0 + j]);
            u0[j] = *(const u32x4*)(UB + (size_t)e * 1024 + 8 * lane); u1[j] = *(const u32x4*)(UB + (size_t)e * 1024 + 512 + 8 * lane);
            v0[j] = *(const u32x4*)(VB + (size_t)e * 1024 + 8 * lane); v1[j] = *(const u32x4*)(VB + (size_t)e * 1024 + 512 + 8 * lane);
        }
#pragma unroll
        for (int j = 0; j < 2; ++j) {
            float s = 0;
            s = dot2bf(u0[j].x, h0.x, s); s = dot2bf(u0[j].y, h0.y, s); s = dot2bf(u0[j].z, h0.z, s); s = dot2bf(u0[j].w, h0.w, s);
            s = dot2bf(u1[j].x, h1.x, s); s = dot2bf(u1[j].y, h1.y, s); s = dot2bf(u1[j].z, h1.z, s); s = dot2bf(u1[j].w, h1.w, s);
            d[j] = wave_sum(s);
        }
#pragma unroll
        for (int j = 0; j < 2; ++j) {
            const float sc = gelu_tanh(d[j]) * S.pg[wave][e0 + j];
            acc[0] += sc * bflo(v0[j].x); acc[1] += sc * bfhi(v0[j].x); acc[2] += sc * bflo(v0[j].y); acc[3] += sc * bfhi(v0[j].y);
            acc[4] += sc * bflo(v0[j].z); acc[5] += sc * bfhi(v0[j].z); acc[6] += sc * bflo(v0[j].w); acc[7] += sc * bfhi(v0[j].w);
            acc[8] += sc * bflo(v1[j].x); acc[9] += sc * bfhi(v1[j].x); acc[10] += sc * bflo(v1[j].y); acc[11] += sc * bfhi(v1[j].y);
            acc[12] += sc * bflo(v1[j].z); acc[13] += sc * bfhi(v1[j].z); acc[14] += sc * bflo(v1[j].w); acc[15] += sc * bfhi(v1[j].w);
        }
    }
    float xr[16];
    float* xrow = X + (size_t)tok * 1024;
    const float* g2 = modl + (size_t)b * 6144 + 5 * 1024;
    float ss = 0;
#pragma unroll
    for (int hlf = 0; hlf < 2; ++hlf)
#pragma unroll
        for (int q4 = 0; q4 < 2; ++q4) {
            const int c = 512 * hlf + 8 * lane + 4 * q4;
            const float4 xv = *(const float4*)(xrow + c), gv = *(const float4*)(g2 + c);
            float4 o; o.x = xv.x + gv.x * acc[8 * hlf + 4 * q4]; o.y = xv.y + gv.y * acc[8 * hlf + 4 * q4 + 1]; o.z = xv.z + gv.z * acc[8 * hlf + 4 * q4 + 2]; o.w = xv.w + gv.w * acc[8 * hlf + 4 * q4 + 3];
            if (l == 0) *(float4*)(xrow + c) = o;
            xr[8 * hlf + 4 * q4] = o.x; xr[8 * hlf + 4 * q4 + 1] = o.y; xr[8 * hlf + 4 * q4 + 2] = o.z; xr[8 * hlf + 4 * q4 + 3] = o.w;
            ss += o.x * o.x + o.y * o.y + o.z * o.z + o.w * o.w;
        }
    ss = wave_sum(ss);
    const float r = rsqrtf(ss * (1.f / 1024.f) + 1e-6f);
    if (l == 1) {
        float* orow = p.out + (size_t)tok * 1024;
#pragma unroll
        for (int hlf = 0; hlf < 2; ++hlf)
#pragma unroll
            for (int q4 = 0; q4 < 2; ++q4) {
                const int c = 512 * hlf + 8 * lane + 4 * q4; const float4 gv = *(const float4*)(p.in[28] + c);
                float4 o; o.x = xr[8 * hlf + 4 * q4] * r * gv.x; o.y = xr[8 * hlf + 4 * q4 + 1] * r * gv.y; o.z = xr[8 * hlf + 4 * q4 + 2] * r * gv.z; o.w = xr[8 * hlf + 4 * q4 + 3] * r * gv.w;
                *(float4*)(orow + c) = o;
            }
    } else {
        const float* g = p.in[2] + 1024; const float* mod1 = (const float*)(wsb(p) + WS_MOD) + ((size_t)4 + b) * 6144;
        bf16* hrow = (bf16*)(wsb(p) + WS_H) + (size_t)tok * 1024;
#pragma unroll
        for (int hlf = 0; hlf < 2; ++hlf) {
            const int c = 512 * hlf + 8 * lane; float hv[8];
#pragma unroll
            for (int e = 0; e < 8; ++e) hv[e] = xr[8 * hlf + e] * r * g[c + e] * (1.f + mod1[1024 + c + e]) + mod1[c + e];
            u32x4 o; o.x = cvt_pk_bf16(hv[0], hv[1]); o.y = cvt_pk_bf16(hv[2], hv[3]); o.z = cvt_pk_bf16(hv[4], hv[5]); o.w = cvt_pk_bf16(hv[6], hv[7]);
            *(u32x4*)(hrow + c) = o;
        }
    }
}

constexpr int SMEM_BYTES = 64 + 48640;
constexpr int NQ_CTR = 8;
__global__ void __launch_bounds__(256, 2) fwd_megakernel(Params p) {
    __shared__ __attribute__((aligned(16))) unsigned char smem[SMEM_BYTES];
    const int tid = opq_tid(), lane = tid & 63, wave = tid >> 6;
    const int G = gridDim.x, bid = blockIdx.x;
    unsigned char* sm = smem + 64;
    volatile int* qslot = (volatile int*)(smem + 16);
    if (tid < 16) ((unsigned*)smem)[tid] = 0u;
    __syncthreads();
    unsigned* ctl = (unsigned*)(p.ws + WS_CTL);
    unsigned* qctr = ctl + 4096;
    XcdBarrier bar = xcd_barrier_post(ctl, (volatile LAS unsigned*)smem);
    unsigned char* ws = p.ws;
    const bf16* H = (const bf16*)(ws + WS_H);
    bf16* PROJ = (bf16*)(ws + WS_PROJ);
    float* X = (float*)(ws + WS_X);
    const float* mod = (const float*)(ws + WS_MOD);

    {
        constexpr int N_MOD = 48, N_LAYER = 768 + 1024 + 512 + 512 + 1024 + 1024 + 64, N_PK = 4, N_GW = 128, N_PW = 8;
        constexpr int NV = N_MOD + 2 * N_LAYER + N_PK + N_GW + N_PW;
        for (int vb = bid; vb < NV; vb += G) {
            int v = vb;
            if (v < N_MOD) { it_mod(p, v, sm); continue; }
            v -= N_MOD;
            if (v < 2 * N_LAYER) {
                const int l = v / N_LAYER; v -= l * N_LAYER;
                bf16* wtin = (bf16*)(ws + WS_WTIN) + (size_t)l * NPROJ * 1024;
                const float* win = p.in[6] + (size_t)l * 1024 * 1732;
                bf16* wtout = (bf16*)(ws + WS_WTOUT) + (size_t)l * 1024 * KMIX;
                const float* wout = p.in[22] + (size_t)l * 1024 * 1024;
                if (v < 768) { it_transpose(TrArgs{win, 1732, 0, 1732, wtin, 1024, 0, 1024, 768, 0, nullptr}, v, sm); }
                else if ((v -= 768) < 1024) { it_transpose(TrArgs{win, 1732, 0, 1732, wtin + (size_t)768 * 1024, 1024, 0, 1024, 1024, 1, p.in[20] + (size_t)l * 8 * 64 * 128}, v, sm); }
                else if ((v -= 1024) < 512) { it_transpose(TrArgs{win, 1732, 1280, 1732, wtin + (size_t)1792 * 1024, 1024, 0, 1024, 512, 0, nullptr}, v, sm); }
                else if ((v -= 512) < 512) { it_transpose(TrArgs{wout, 1024, 0, 1024, wtout, KMIX, 0, 512, 1024, 0, nullptr}, v, sm); }
                else if ((v -= 512) < 1024) { it_transpose(TrArgs{wout, 1024, 0, 1024, wtout, KMIX, 512, 1024, 1024, 2, p.in[21] + (size_t)l * 8 * 128 * 64}, v, sm); }
                else if ((v -= 1024) < 1024) { it_transpose(TrArgs{p.in[23] + (size_t)l * 1024 * 1024, 1024, 0, 1024, (bf16*)(ws + WS_WTQ) + (size_t)l * 1024 * 1024, 1024, 0, 1024, 1024, 0, nullptr}, v, sm); }
                else { v -= 1024; it_transpose(TrArgs{p.in[15] + (size_t)l * 256 * 256, 256, 0, 256, (bf16*)(ws + WS_WTGLU) + (size_t)l * 256 * 256, 256, 0, 256, 256, 0, nullptr}, v, sm); }
                continue;
            }
            v -= 2 * N_LAYER;
            if (v < N_PK) { const int l = v >> 1, w = v & 1; conv_chunk(p.in[24 + w] + (size_t)l * 8192, (bf16*)(ws + WS_PK) + (size_t)l * 16384 + w * 8192, 0, 1024); continue; }
            v -= N_PK;
            if (v < N_GW) { it_gw(p, v); continue; }
            v -= N_GW;
            it_ssm_pw(p, v);
        }
    }
    xcd_barrier(bar);
    {
        constexpr int N_NORM = NTOK / 4, N_TAB = 4352;
        for (int vb = bid; vb < N_NORM + N_TAB; vb += G) {
            if (vb < N_NORM) {
                const int t_ = opq_tid(); const int row = vb * 4 + (t_ >> 6);
                const float* m0 = (const float*)(wsb(p) + WS_MOD) + (size_t)(row >> 12) * 6144;
                norm_mod_row(p.in[0] + (size_t)row * 1024, p.in[2], m0, m0 + 1024, (bf16*)(wsb(p) + WS_H) + (size_t)row * 1024, t_ & 63);
            } else {
                const size_t base = (size_t)(vb - N_NORM) * 2048;
                for (int e = 0; e < 8; ++e) ssm_tab_entry(p, base + e * 256 + opq_tid());
            }
        }
    }
    xcd_barrier(bar);

    for (int l = 0; l < 2; ++l) {
        const float* xin = l == 0 ? p.in[0] : X;
        {
            const EpiBf16 epi{PROJ, NPROJ};
            const bf16* Bt = (const bf16*)(ws + WS_WTIN) + (size_t)l * NPROJ * 1024;
            for (int t = bid; t < (NTOK / 128) * (NPROJ / 128); t += G) { gemm_tile(H, 1024, Bt, 1024, 1024, (t / (NPROJ / 128)) * 128, (t % (NPROJ / 128)) * 128, (bf16*)sm, epi); __syncthreads(); }
        }
        xcd_barrier(bar);
        {
            unsigned* ctr = qctr + 64 * (l * 2 + 0);
            for (;;) {
                const int it = q_next(ctr, qslot);
                if (it >= 2048) break;
                if (it < 1024) it_dsa_index_select(p, it);
                else if (it < 1536) it_gmlp(p, l, it - 1024, sm);
                else if (it < 1792) it_ssm_a(p, l, it - 1536);
                else it_kvn(p, l, it - 1792);
            }
        }
        xcd_barrier(bar);
        {
            unsigned* ctr = qctr + 64 * (l * 2 + 1);
            for (;;) {
                const int it = q_next(ctr, qslot);
                if (it >= 256 + 1024 + 512) break;
                if (it < 256) it_ssm_c(p, l, it, sm);
                else if (it < 1280) it_dsa_attn(p, it - 256, sm);
                else {
                    const int v = it - 1280, w = v >> 8, ch = v & 255;
                    conv_chunk(p.in[26 + w] + (size_t)l * NEXP * 1024, (bf16*)(ws + (w ? WS_VB : WS_UB)), (size_t)ch * 8192, 8192);
                }
            }
        }
        xcd_barrier(bar);
        {
            const EpiGlu epi{(const bf16*)(ws + WS_YG), p.in[16] + l * 256, (bf16*)(ws + WS_MIX)};
            const bf16* Bt = (const bf16*)(ws + WS_WTGLU) + (size_t)l * 256 * 256;
            for (int t = bid; t < (NTOK / 128) * 2; t += G) { gemm_tile((const bf16*)(ws + WS_YG), 256, Bt, 256, 256, (t >> 1) * 128, (t & 1) * 128, (bf16*)sm, epi); __syncthreads(); }
        }
        xcd_barrier(bar);
        {
            const EpiResid epi{xin, X, mod + (size_t)l * 4 * 6144 + 2048};
            const bf16* Bt = (const bf16*)(ws + WS_WTOUT) + (size_t)l * 1024 * KMIX;
            for (int t = bid; t < (NTOK / 128) * 8; t += G) { gemm_tile((const bf16*)(ws + WS_MIX), KMIX, Bt, KMIX, KMIX, (t >> 3) * 128, (t & 7) * 128, (bf16*)sm, epi); __syncthreads(); }
        }
        xcd_barrier(bar);
        for (int vb = bid; vb < NTOK / 4; vb += G) {
            const int t_ = opq_tid(); const int row = vb * 4 + (t_ >> 6);
            const float* m0 = (const float*)(wsb(p) + WS_MOD) + ((size_t)l * 4 + (row >> 12)) * 6144 + 3072;
            norm_mod_row((const float*)(wsb(p) + WS_X) + (size_t)row * 1024, p.in[3] + l * 1024, m0, m0 + 1024, (bf16*)(wsb(p) + WS_H) + (size_t)row * 1024, t_ & 63);
        }
        xcd_barrier(bar);
        {
            const EpiBf16 epi{PROJ, 1024};
            const bf16* Bt = (const bf16*)(ws + WS_WTQ) + (size_t)l * 1024 * 1024;
            for (int t = bid; t < (NTOK / 128) * 8; t += G) { gemm_tile(H, 1024, Bt, 1024, 1024, (t >> 3) * 128, (t & 7) * 128, (bf16*)sm, epi); __syncthreads(); }
        }
        xcd_barrier(bar);
        {
            PeerLds& S = *(PeerLds*)sm;
            peer_load_keys(p, l, S);
            for (int vb = bid; vb < NTOK / 4; vb += G) peer_token(p, l, vb * 4, S);
        }
        if (l == 0) xcd_barrier(bar);
    }
}

extern "C" void kernel_launch(void* const* d_in, const int* in_sizes, int n_in, void* d_out, int out_size, void* d_ws, size_t ws_size, hipStream_t stream) {
    if (n_in != 29 || ws_size < WS_END) { fprintf(stderr, "kernel_launch: bad args (n_in %d, ws %zu, need %zu)\n", n_in, ws_size, (size_t)WS_END); return; }
    static int grid = 0;
    if (grid == 0) {
        int dev = 0, cus = 0, per_cu = 0;
        if (hipGetDevice(&dev) != hipSuccess || hipDeviceGetAttribute(&cus, hipDeviceAttributeMultiprocessorCount, dev) != hipSuccess) { grid = -1; return; }
        if (hipOccupancyMaxActiveBlocksPerMultiprocessor(&per_cu, (const void*)fwd_megakernel, 256, 0) != hipSuccess || per_cu < 1) { fprintf(stderr, "kernel_launch: occupancy query failed (%d)\n", per_cu); grid = -1; return; }
        const int use = per_cu < 2 ? per_cu : 2;
        grid = cus * use;
    }
    if (grid < 0) return;
    if (hipMemsetAsync((char*)d_ws + WS_CTL, 0, 65536, stream) != hipSuccess) { fprintf(stderr, "kernel_launch: memset failed\n"); return; }
    Params p{};
    for (int i = 0; i < 29; ++i) p.in[i] = (const float*)d_in[i];
    p.out = (float*)d_out; p.ws = (unsigned char*)d_ws;
    void* args[] = {&p};
    const hipError_t e = hipLaunchCooperativeKernel((const void*)fwd_megakernel, dim3(grid), dim3(256), args, 0, stream);
    if (e != hipSuccess) fprintf(stderr, "kernel_launch: cooperative launch failed: %s (grid %d)\n", hipGetErrorString(e), grid);
}
```

```cpp
#include <hip/hip_runtime.h>
#include <cstdint>
#include <cstdio>

typedef unsigned short bf16;
typedef short bf16x8 __attribute__((ext_vector_type(8)));
typedef short s16x4 __attribute__((ext_vector_type(4)));
typedef float f32x4 __attribute__((ext_vector_type(4)));
typedef unsigned u32x4 __attribute__((ext_vector_type(4)));
typedef unsigned u32x2 __attribute__((ext_vector_type(2)));
typedef __bf16 bf2 __attribute__((ext_vector_type(2)));
#define DI __device__ __forceinline__
#define MFMA16(a, b, c) __builtin_amdgcn_mfma_f32_16x16x32_bf16((a), (b), (c), 0, 0, 0)

constexpr int DM = 1024, NB = 4, SEQ = 4096, NTOK = NB * SEQ;
constexpr int NPROJ = 2304;
constexpr int C_UA = 0, C_UB = 256, C_VB = 512, C_QA = 768, C_CKV = 1792, C_QI = 1920, C_KI = 2176, C_WI = 2240;
constexpr int KMIX = 1536;
constexpr int NEXP = 16384;
constexpr size_t SCORES_PER_BATCH = (size_t)4096 * 2080;

constexpr size_t al256(size_t x) { return (x + 255) & ~(size_t)255; }
constexpr size_t WS_CTL = 0;
constexpr size_t WS_MOD = 65536;
constexpr size_t WS_WTIN = al256(WS_MOD + 2 * 4 * 6144 * 4);
constexpr size_t WS_WTOUT = al256(WS_WTIN + (size_t)2 * NPROJ * 1024 * 2);
constexpr size_t WS_WTQ = al256(WS_WTOUT + (size_t)2 * 1024 * KMIX * 2);
constexpr size_t WS_WTGLU = al256(WS_WTQ + (size_t)2 * 1024 * 1024 * 2);
constexpr size_t WS_GW = al256(WS_WTGLU + (size_t)2 * 256 * 256 * 2);
constexpr size_t WS_PK = al256(WS_GW + (size_t)2 * 4 * 128 * 128 * 2);
constexpr size_t WS_PW = al256(WS_PK + (size_t)2 * 2 * 128 * 64 * 2);
constexpr size_t WS_BB = al256(WS_PW + (size_t)2 * 16 * 65 * 64 * 2 * 4);
constexpr size_t WS_E = al256(WS_BB + (size_t)2 * 16 * 64 * 16 * 2 * 4);
constexpr size_t WS_G = al256(WS_E + (size_t)2 * 16 * 128 * 1024 * 2);
constexpr size_t WS_KT = al256(WS_G + (size_t)2 * 16 * 1024 * 128 * 2);
constexpr size_t WS_UB = al256(WS_KT + (size_t)2 * 16 * 64 * 256 * 2);
constexpr size_t WS_VB = al256(WS_UB + (size_t)NEXP * 1024 * 2);
constexpr size_t WS_H = al256(WS_VB + (size_t)NEXP * 1024 * 2);
constexpr size_t WS_PROJ = al256(WS_H + (size_t)NTOK * 1024 * 2);
constexpr size_t WS_SLOC = al256(WS_PROJ + (size_t)NTOK * NPROJ * 2);
constexpr size_t WS_YG = al256(WS_SLOC + (size_t)256 * 16 * 128 * 4);
constexpr size_t WS_KVN = al256(WS_YG + (size_t)NTOK * 256 * 2);
constexpr size_t WS_SEL = al256(WS_KVN + (size_t)NTOK * 128 * 2);
constexpr size_t WS_MIX = al256(WS_SEL + (size_t)NTOK * 256 * 2);
constexpr size_t WS_X = al256(WS_MIX + (size_t)NTOK * KMIX * 2);
constexpr size_t WS_SCORES = al256(WS_X + (size_t)NTOK * 1024 * 4);
constexpr size_t WS_H2 = al256(WS_SCORES + (size_t)NB * SCORES_PER_BATCH * 4);
constexpr size_t WS_END = al256(WS_H2 + (size_t)NTOK * 1024 * 2);

struct Params {
    const float* in[29];
    float* out;
    unsigned char* ws;
};

typedef __bf16 bf2v_t __attribute__((ext_vector_type(2)));
typedef float f2v_t __attribute__((ext_vector_type(2)));
DI unsigned cvt_pk_bf16(float lo, float hi) { const f2v_t f = {lo, hi}; const bf2v_t r = __builtin_convertvector(f, bf2v_t); return __builtin_bit_cast(unsigned, r); }
DI bf16 f2bf(float x) { return (bf16)(cvt_pk_bf16(x, 0.f) & 0xffffu); }
DI float bf2f(bf16 b) { return __uint_as_float((unsigned)b << 16); }
DI float bflo(unsigned u) { return __uint_as_float(u << 16); }
DI float bfhi(unsigned u) { return __uint_as_float(u & 0xffff0000u); }
DI float dot2bf(unsigned a, unsigned b, float c) { return __builtin_amdgcn_fdot2_f32_bf16(__builtin_bit_cast(bf2, a), __builtin_bit_cast(bf2, b), c, false); }
DI float gelu_tanh(float x) { const float u = 0.7978845608028654f * (x + 0.044715f * x * x * x); const float e = __expf(2.f * u); const float t = 1.f - 2.f / (e + 1.f); return 0.5f * x * (1.f + t); }
DI float sigmoidf(float x) { return 1.f / (1.f + __expf(-x)); }
DI float wave_sum(float v) { for (int o = 32; o > 0; o >>= 1) v += __shfl_xor(v, o); return v; }
DI unsigned fkey(float v) { const unsigned u = __float_as_uint(v); return (u & 0x80000000u) ? ~u : (u | 0x80000000u); }
DI bf16x8 ld16(const void* p) { return *(const bf16x8*)p; }
DI bf16x8 zero8() { bf16x8 z = {0, 0, 0, 0, 0, 0, 0, 0}; return z; }


#define XB_TMO      128
#define XB_XCNT(j)  (256  + 64 * (j))
#define XB_XSUB(j)  (1280 + 64 * (j))
#define XB_XGEN(j)  (2304 + 64 * (j))
#define XB_TOP      3328
#define XB_TOPGEN   3392
#define XCD_BAR_WORDS 3456
#define XB_SPIN_CAP (1u << 22)
#define LAS __attribute__((address_space(3)))
DI unsigned xb_ld(unsigned* p)              { return __hip_atomic_load(p, __ATOMIC_RELAXED, __HIP_MEMORY_SCOPE_AGENT); }
DI unsigned xb_add(unsigned* p, unsigned v) { return __hip_atomic_fetch_add(p, v, __ATOMIC_RELAXED, __HIP_MEMORY_SCOPE_AGENT); }
DI unsigned xb_xcc_id() { return (unsigned)__builtin_amdgcn_s_getreg((3 << 11) | 20) & 0xFu; }
#define XB_SPIN(cond, bar) do { unsigned _sp = 0; while (cond) { __builtin_amdgcn_s_sleep(1); \
    if ((++_sp & 255u) == 0u) { if (xb_ld(&(bar)[XB_TMO])) break; if (_sp > XB_SPIN_CAP) { atomicAdd(&(bar)[XB_TMO], 1u); break; } } } } while (0)
struct XcdBarrier { unsigned* bar; unsigned x; volatile LAS unsigned* st; };
DI XcdBarrier xcd_barrier_post(unsigned* bar, volatile LAS unsigned* st) {
    XcdBarrier b; b.bar = bar; b.x = xb_xcc_id(); b.st = st;
    if (threadIdx.x == 0) (void)xb_add(&bar[XB_XCNT(b.x)], 1u);
    return b;
}
DI void xcd_barrier_complete(unsigned* bar, unsigned x, unsigned& nloc, unsigned& nx) {
    const unsigned G = gridDim.x * gridDim.y * gridDim.z;
    unsigned sum, cnt, mine, sp = 0u;
    for (;;) {
        sum = 0u; cnt = 0u; mine = 0u;
#pragma unroll
        for (unsigned j = 0; j < 16; ++j) { const unsigned c = xb_ld(&bar[XB_XCNT(j)]); sum += c; cnt += (c > 0u) ? 1u : 0u; mine = (j == x) ? c : mine; }
        if (sum == G) break;
        __builtin_amdgcn_s_sleep(1);
        if ((++sp & 255u) == 0u) { if (xb_ld(&bar[XB_TMO])) break; if (sp > XB_SPIN_CAP) { atomicAdd(&bar[XB_TMO], 1u); break; } }
    }
    nloc = mine > 0u ? mine : 1u; nx = cnt > 0u ? cnt : 1u;
}
DI void xcd_barrier(const XcdBarrier& b) {
    asm volatile("s_waitcnt vmcnt(0)" ::: "memory");
    __syncthreads();
    if (threadIdx.x == 0) {
        unsigned* bar = b.bar;
        __builtin_amdgcn_s_waitcnt(0);
        unsigned nloc = b.st[0], nx = b.st[1];
        if (nloc == 0u) { xcd_barrier_complete(bar, b.x, nloc, nx); b.st[0] = nloc; b.st[1] = nx; }
        const unsigned old = xb_add(&bar[XB_XSUB(b.x)], 1u);
        const unsigned gen = old / nloc;
        if (old + 1u == (gen + 1u) * nloc) {
            __builtin_amdgcn_fence(__ATOMIC_RELEASE, "agent");
            asm volatile("s_waitcnt vmcnt(0)" ::: "memory");
            const unsigned og = xb_add(&bar[XB_TOP], 1u);
            const unsigned tg = og / nx;
            if (og + 1u == (tg + 1u) * nx) xb_add(&bar[XB_TOPGEN], 1u);
            else XB_SPIN(xb_ld(&bar[XB_TOPGEN]) == tg, bar);
            __builtin_amdgcn_fence(__ATOMIC_ACQUIRE, "agent");
            xb_add(&bar[XB_XGEN(b.x)], 1u);
            asm volatile("s_waitcnt vmcnt(0)" ::: "memory");
        } else {
            XB_SPIN(xb_ld(&bar[XB_XGEN(b.x)]) == gen, bar);
            __builtin_amdgcn_fence(__ATOMIC_ACQUIRE, "agent");
            asm volatile("s_waitcnt vmcnt(0)" ::: "memory");
        }
    }
    __syncthreads();
}
typedef __attribute__((address_space(1))) unsigned char g_uc;
DI unsigned char* wsb(const Params& p) {
    const unsigned long long w = (unsigned long long)p.ws;
    unsigned lo = __builtin_amdgcn_readfirstlane((unsigned)w), hi = __builtin_amdgcn_readfirstlane((unsigned)(w >> 32));
    asm volatile("" : "+s"(lo), "+s"(hi));
    return (unsigned char*)(g_uc*)(((unsigned long long)hi << 32) | lo);
}
DI int opq_tid() { int t = (int)threadIdx.x; asm volatile("" : "+v"(t)); return t; }
DI int q_next(unsigned* ctr, volatile int* slot) {
    __syncthreads();
    if (threadIdx.x == 0) *slot = (int)__hip_atomic_fetch_add(ctr, 1u, __ATOMIC_RELAXED, __HIP_MEMORY_SCOPE_AGENT);
    __syncthreads();
    return *slot;
}

DI void it_mod(const Params& p, int vb, unsigned char* sm) {
    float (*ca)[1024] = (float (*)[1024])sm;
    const float* c = p.in[1];
    __syncthreads();
    for (int i = opq_tid(); i < 4096; i += 256) { const float v = c[i]; ca[i >> 10][i & 1023] = v / (1.f + __expf(-v)); }
    __syncthreads();
    const int idx = vb * 256 + opq_tid();
    const int l = idx / 6144, n = idx % 6144;
    const float* w = p.in[4] + (size_t)l * 1024 * 6144 + n;
    float a0 = 0, a1 = 0, a2 = 0, a3 = 0;
#pragma unroll 8
    for (int k = 0; k < 1024; ++k) { const float wv = w[(size_t)k * 6144]; a0 += ca[0][k] * wv; a1 += ca[1][k] * wv; a2 += ca[2][k] * wv; a3 += ca[3][k] * wv; }
    const float bm = p.in[5][l * 6144 + n];
    float* mod = (float*)(wsb(p) + WS_MOD) + (size_t)l * 4 * 6144 + n;
    mod[0] = a0 + bm; mod[6144] = a1 + bm; mod[2 * 6144] = a2 + bm; mod[3 * 6144] = a3 + bm;
}

struct TrArgs { const float* src; int lds, coff, nvalid; bf16* dst; int ldd, doff; int K, N; int mode; const float* aux; };
DI void it_transpose(const TrArgs& a, int vb, unsigned char* sm) {
    float (*t)[33] = (float (*)[33])sm;
    const int nk = a.K / 32;
    const int kt = vb % nk, nt = vb / nk;
    const int tx = opq_tid() & 31, ty = opq_tid() >> 5;
    __syncthreads();
    for (int r = ty; r < 32; r += 8) {
        const int k = kt * 32 + r, n = nt * 32 + tx;
        float v;
        if (a.mode == 0) v = (n + a.coff < a.nvalid) ? a.src[(size_t)k * a.lds + n + a.coff] : 0.f;
        else if (a.mode == 1) {
            const int h = n >> 7, rr = n & 127; const float* wi = a.src + (size_t)k * a.lds + 768 + 64 * h; const float* uk = a.aux + (size_t)h * 64 * 128 + rr;
            float s = 0; for (int d = 0; d < 64; ++d) s += wi[d] * uk[d * 128]; v = s * 0.125f;
        } else {
            const int h = k >> 7, rr = k & 127; const float* uv = a.aux + ((size_t)h * 128 + rr) * 64; const float* wo = a.src + (size_t)(512 + 64 * h) * a.lds + n;
            float s = 0; for (int d = 0; d < 64; ++d) s += uv[d] * wo[(size_t)d * a.lds]; v = s;
        }
        t[r][tx] = v;
    }
    __syncthreads();
    for (int r = ty; r < 32; r += 8) {
        const int n = nt * 32 + r, k = kt * 32 + tx;
        a.dst[(size_t)n * a.ldd + a.doff + k] = f2bf(t[tx][r]);
    }
}
DI void conv_chunk(const float* __restrict__ src, bf16* __restrict__ dst, size_t i0, int n8) {
    for (int i = opq_tid(); i < n8; i += 256) {
        const float4 a = ((const float4*)src)[2 * (i0 + i)], b = ((const float4*)src)[2 * (i0 + i) + 1];
        u32x4 o; o.x = cvt_pk_bf16(a.x, a.y); o.y = cvt_pk_bf16(a.z, a.w); o.z = cvt_pk_bf16(b.x, b.y); o.w = cvt_pk_bf16(b.z, b.w);
        ((u32x4*)dst)[i0 + i] = o;
    }
}
DI void it_gw(const Params& p, int vb) {
    for (int e = 0; e < 4; ++e) {
        const int idx = vb * 1024 + e * 256 + opq_tid();
        const int s = idx & 127, t = (idx >> 7) & 127;
        const float v = (t >= 64 || s < 64) ? p.in[17][idx] : 0.f;
        ((bf16*)(wsb(p) + WS_GW))[idx] = f2bf(v);
    }
}
DI void it_ssm_pw(const Params& p, int vb) {
    const int idx = vb * 256 + opq_tid();
    const int pp = idx & 63, g = (idx >> 6) & 15, l = idx >> 10;
    const float lre = -__expf(p.in[7][idx]), lim = p.in[8][idx];
    const float dt = __expf(p.in[14][l * 16 + g]);
    float* pw = (float*)(wsb(p) + WS_PW) + ((size_t)(l * 16 + g) * 65) * 128;
    for (int d = 0; d <= 64; ++d) {
        const float mag = expf(lre * dt * (float)d); float sn, cs; sincosf(lim * dt * (float)d, &sn, &cs);
        pw[d * 128 + pp * 2] = mag * cs; pw[d * 128 + pp * 2 + 1] = mag * sn;
    }
    const float mag = expf(lre * dt); float sn, cs; sincosf(lim * dt, &sn, &cs);
    const float are = mag * cs, aim = mag * sn;
    const float den = lre * lre + lim * lim, P = are - 1.f, Q = aim;
    const float fre = (P * lre + Q * lim) / den, fim = (Q * lre - P * lim) / den;
    float* bb = (float*)(wsb(p) + WS_BB) + (size_t)idx * 32;
    for (int h = 0; h < 16; ++h) { const float br = p.in[9][(size_t)idx * 16 + h], bi = p.in[10][(size_t)idx * 16 + h]; bb[h * 2] = fre * br - fim * bi; bb[h * 2 + 1] = fre * bi + fim * br; }
}
DI void ssm_tab_entry(const Params& p, size_t idx) {
    const size_t NE = (size_t)2 * 16 * 128 * 1024;
    const float* PW = (const float*)(wsb(p) + WS_PW); const float* BB = (const float*)(wsb(p) + WS_BB);
    if (idx < NE) {
        const int kk = idx & 1023, pp = (idx >> 10) & 127; const int lg = (int)(idx >> 17);
        const int i = kk >> 4, hh = kk & 15, pq = pp & 63, part = pp >> 6;
        const float* pw = PW + ((size_t)lg * 65 + (63 - i)) * 128 + pq * 2; const float* bb = BB + ((size_t)lg * 64 + pq) * 32 + hh * 2;
        const float v = part ? (pw[0] * bb[1] + pw[1] * bb[0]) : (pw[0] * bb[0] - pw[1] * bb[1]);
        ((bf16*)(wsb(p) + WS_E))[idx] = f2bf(v);
    } else if (idx < 2 * NE) {
        const size_t e = idx - NE; const int pp = e & 127, jh = (e >> 7) & 1023; const int lg = (int)(e >> 17);
        const int j = jh >> 4, h = jh & 15, pq = pp & 63, part = pp >> 6;
        const float* pw = PW + ((size_t)lg * 65 + (j + 1)) * 128 + pq * 2;
        const float cr = p.in[11][((size_t)lg * 16 + h) * 64 + pq], ci = p.in[12][((size_t)lg * 16 + h) * 64 + pq];
        const float v = part ? -(cr * pw[1] + ci * pw[0]) : (cr * pw[0] - ci * pw[1]);
        ((bf16*)(wsb(p) + WS_G))[e] = f2bf(v);
    } else {
        const size_t e = idx - 2 * NE; if (e >= (size_t)2 * 16 * 64 * 256) return;
        const int hh = e & 15, h = (e >> 4) & 15, d = (e >> 8) & 63; const int lg = (int)(e >> 14);
        const float* pw = PW + ((size_t)lg * 65 + d) * 128; const float* bb = BB + (size_t)lg * 64 * 32 + hh * 2;
        const float* cr = p.in[11] + ((size_t)lg * 16 + h) * 64; const float* ci = p.in[12] + ((size_t)lg * 16 + h) * 64;
        float s = 0;
        for (int q = 0; q < 64; ++q) { const float zr = pw[q * 2] * bb[q * 32] - pw[q * 2 + 1] * bb[q * 32 + 1], zi = pw[q * 2] * bb[q * 32 + 1] + pw[q * 2 + 1] * bb[q * 32]; s += cr[q] * zr - ci[q] * zi; }
        ((bf16*)(wsb(p) + WS_KT))[e] = f2bf(s);
    }
}
DI void norm_mod_row(const float* __restrict__ xrow, const float* __restrict__ g, const float* __restrict__ sh, const float* __restrict__ sc, bf16* __restrict__ hrow, int lane) {
    float4 v[4]; float ss = 0;
#pragma unroll
    for (int j = 0; j < 4; ++j) { v[j] = *(const float4*)(xrow + 4 * lane + 256 * j); ss += v[j].x * v[j].x + v[j].y * v[j].y + v[j].z * v[j].z + v[j].w * v[j].w; }
    ss = wave_sum(ss);
    const float r = rsqrtf(ss * (1.f / 1024.f) + 1e-6f);
#pragma unroll
    for (int j = 0; j < 4; ++j) {
        const int c = 4 * lane + 256 * j;
        const float4 gg = *(const float4*)(g + c), s1 = *(const float4*)(sc + c), s0 = *(const float4*)(sh + c);
        u32x2 o; o.x = cvt_pk_bf16(v[j].x * r * gg.x * (1.f + s1.x) + s0.x, v[j].y * r * gg.y * (1.f + s1.y) + s0.y);
        o.y = cvt_pk_bf16(v[j].z * r * gg.z * (1.f + s1.z) + s0.z, v[j].w * r * gg.w * (1.f + s1.w) + s0.w);
        *(u32x2*)(hrow + c) = o;
    }
}
constexpr int GP = 72;
template <class Epi>
DI void gemm_tile(const bf16* __restrict__ A, int lda, const bf16* __restrict__ Bt, int ldb, int K, int m0, int n0, bf16* lds, const Epi& epi) {
    bf16* As = lds; bf16* Bs = lds + 128 * GP;
    const int tid = opq_tid(), lane = tid & 63, wave = tid >> 6, wm = wave >> 1, wn = wave & 1;
    const int fr = lane & 15, fq = lane >> 4;
    const int lrow = tid >> 3, lch = tid & 7;
    f32x4 acc[4][4];
#pragma unroll
    for (int i = 0; i < 4; ++i)
#pragma unroll
        for (int j = 0; j < 4; ++j) acc[i][j] = (f32x4){0.f, 0.f, 0.f, 0.f};
    bf16x8 ra[4], rb[4];
    const bf16* Ag = A + (size_t)(m0 + lrow) * lda + lch * 8;
    const bf16* Bg = Bt + (size_t)(n0 + lrow) * ldb + lch * 8;
#pragma unroll
    for (int i = 0; i < 4; ++i) { ra[i] = ld16(Ag + (size_t)32 * i * lda); rb[i] = ld16(Bg + (size_t)32 * i * ldb); }
    const int nk = K / 64;
    for (int kt = 0; kt < nk; ++kt) {
        __syncthreads();
#pragma unroll
        for (int i = 0; i < 4; ++i) { *(bf16x8*)(As + (lrow + 32 * i) * GP + lch * 8) = ra[i]; *(bf16x8*)(Bs + (lrow + 32 * i) * GP + lch * 8) = rb[i]; }
        __syncthreads();
        if (kt + 1 < nk) {
#pragma unroll
            for (int i = 0; i < 4; ++i) { ra[i] = ld16(Ag + (size_t)32 * i * lda + (kt + 1) * 64); rb[i] = ld16(Bg + (size_t)32 * i * ldb + (kt + 1) * 64); }
        }
#pragma unroll
        for (int ks = 0; ks < 2; ++ks) {
            bf16x8 fa[4], fb[4];
#pragma unroll
            for (int i = 0; i < 4; ++i) { fa[i] = ld16(Bs + (64 * wn + 16 * i + fr) * GP + 32 * ks + 8 * fq); fb[i] = ld16(As + (64 * wm + 16 * i + fr) * GP + 32 * ks + 8 * fq); }
#pragma unroll
            for (int i = 0; i < 4; ++i)
#pragma unroll
                for (int j = 0; j < 4; ++j) acc[i][j] = MFMA16(fa[i], fb[j], acc[i][j]);
        }
    }
#pragma unroll
    for (int i = 0; i < 4; ++i)
#pragma unroll
        for (int j = 0; j < 4; ++j) epi(m0 + 64 * wm + 16 * j + fr, n0 + 64 * wn + 16 * i + 4 * fq, acc[i][j]);
}
struct EpiBf16 { bf16* C; int ldc; DI void operator()(int r, int c, f32x4 v) const { u32x2 o; o.x = cvt_pk_bf16(v[0], v[1]); o.y = cvt_pk_bf16(v[2], v[3]); *(u32x2*)(C + (size_t)r * ldc + c) = o; } };
struct EpiResid { const float* xin; float* xout; const float* gate;
    DI void operator()(int r, int c, f32x4 v) const { const float4 x = *(const float4*)(xin + (size_t)r * 1024 + c); const float4 g = *(const float4*)(gate + (size_t)(r >> 12) * 6144 + c);
        float4 o; o.x = x.x + g.x * v[0]; o.y = x.y + g.y * v[1]; o.z = x.z + g.z * v[2]; o.w = x.w + g.w * v[3]; *(float4*)(xout + (size_t)r * 1024 + c) = o; } };
struct EpiGlu { const bf16* yg; const float* bglu; bf16* mix;
    DI void operator()(int r, int c, f32x4 v) const { const u32x2 y = *(const u32x2*)(yg + (size_t)r * 256 + c); const float4 b = *(const float4*)(bglu + c);
        u32x2 o; o.x = cvt_pk_bf16(bflo(y.x) * sigmoidf(v[0] + b.x), bfhi(y.x) * sigmoidf(v[1] + b.y)); o.y = cvt_pk_bf16(bflo(y.y) * sigmoidf(v[2] + b.z), bfhi(y.y) * sigmoidf(v[3] + b.w));
        *(u32x2*)(mix + (size_t)r * KMIX + c) = o; } };

template <int NV>
DI void select16(const float (&v)[NV], const int (&id)[NV], float* outv, int* outi, int lane) {
    unsigned key[NV];
#pragma unroll
    for (int j = 0; j < NV; ++j) key[j] = fkey(v[j]);
    unsigned T = 0;
    for (int bit = 31; bit >= 0; --bit) {
        const unsigned cand = T | (1u << bit);
        int cnt = 0;
#pragma unroll
        for (int j = 0; j < NV; ++j) cnt += __popcll(__ballot(key[j] >= cand));
        if (cnt >= 16) { T = cand; if (cnt == 16) break; }
    }
    int cgt = 0;
#pragma unroll
    for (int j = 0; j < NV; ++j) cgt += __popcll(__ballot(key[j] > T));
    const int need = 16 - cgt;
    int base = 0, eqb = 0;
    const unsigned long long lt = (1ull << lane) - 1ull;
#pragma unroll
    for (int j = 0; j < NV; ++j) {
        const unsigned long long me = __ballot(key[j] == T);
        const bool take = (key[j] > T) || (key[j] == T && (eqb + __popcll(me & lt)) < need);
        const unsigned long long mt = __ballot(take);
        if (take) { const int pos = base + __popcll(mt & lt); outv[pos] = v[j]; outi[pos] = id[j]; }
        base += __popcll(mt); eqb += __popcll(me);
    }
}

constexpr int KP = 68;
struct PeerLds { bf16 k1[128 * KP]; bf16 k2[128 * KP]; bf16 q[4][1024]; float l1v[4][16]; int l1i[4][16]; float l2v[4][16]; int l2i[4][16]; float cv[4][16]; int ci[4][16]; int pe[4][128]; float pg[4][128]; };
DI unsigned off_b(unsigned row, unsigned ch) { return 256u * row + 16u * (ch ^ (((row & 3u) << 2) | ((row >> 2) & 3u))); }
#define TR8(o0, o1, o2, o3, o4, o5, o6, o7, a0, a1, a2, a3, a4, a5, a6, a7)                                                                         \
    asm volatile("s_waitcnt lgkmcnt(0)\n\t"                                                                                                         \
                 "ds_read_b64_tr_b16 %0, %8\n\tds_read_b64_tr_b16 %1, %9\n\tds_read_b64_tr_b16 %2, %10\n\tds_read_b64_tr_b16 %3, %11\n\t"           \
                 "ds_read_b64_tr_b16 %4, %12\n\tds_read_b64_tr_b16 %5, %13\n\tds_read_b64_tr_b16 %6, %14\n\tds_read_b64_tr_b16 %7, %15\n\t"         \
                 "s_waitcnt lgkmcnt(0)"                                                                                                             \
                 : "=&v"(o0), "=&v"(o1), "=&v"(o2), "=&v"(o3), "=&v"(o4), "=&v"(o5), "=&v"(o6), "=&v"(o7)                                           \
                 : "v"(a0), "v"(a1), "v"(a2), "v"(a3), "v"(a4), "v"(a5), "v"(a6), "v"(a7)                                                           \
                 : "memory")

DI void it_kvn(const Params& p, int l, int vb) {
    const int lane = opq_tid() & 63, wave = opq_tid() >> 6;
    const bf16* proj = (const bf16*)(wsb(p) + WS_PROJ); bf16* kvn = (bf16*)(wsb(p) + WS_KVN);
    const float g0 = p.in[19][l * 128 + 2 * lane], g1 = p.in[19][l * 128 + 2 * lane + 1];
    for (int i = 0; i < 16; ++i) {
        const int row = vb * 64 + i * 4 + wave;
        const unsigned u = *(const unsigned*)(proj + (size_t)row * NPROJ + C_CKV + 2 * lane);
        const float a = bflo(u), b = bfhi(u);
        const float ss = wave_sum(a * a + b * b);
        const float r = rsqrtf(ss * (1.f / 128.f) + 1e-6f);
        *(unsigned*)(kvn + (size_t)row * 128 + 2 * lane) = cvt_pk_bf16(a * r * g0, b * r * g1);
    }
}

DI void it_ssm_a(const Params& p, int l, int item) {
    const int lane = opq_tid() & 63, wave = opq_tid() >> 6, fr = lane & 15, fq = lane >> 4;
    const bf16* proj = (const bf16*)(wsb(p) + WS_PROJ);
    float* sloc = (float*)(wsb(p) + WS_SLOC);
    const int g = item & 15, rt = item >> 4;
    const bf16* E = (const bf16*)(wsb(p) + WS_E) + ((size_t)(l * 16 + g) * 128) * 1024;
    const int R = 16 * rt + fr, b = R >> 6, k = R & 63;
    const bf16* arow = proj + ((size_t)b * 4096 + 64 * k + (fq >> 1)) * NPROJ + C_UA + 16 * g + 8 * (fq & 1);
    f32x4 acc[2] = {(f32x4){0, 0, 0, 0}, (f32x4){0, 0, 0, 0}};
    for (int ks = 0; ks < 32; ++ks) {
        const bf16x8 a = ld16(arow + (size_t)(2 * ks) * NPROJ);
#pragma unroll
        for (int c = 0; c < 2; ++c) { const int ct = 2 * wave + c; const bf16x8 bf = ld16(E + (size_t)(16 * ct + fr) * 1024 + 32 * ks + 8 * fq); acc[c] = MFMA16(a, bf, acc[c]); }
    }
#pragma unroll
    for (int c = 0; c < 2; ++c)
#pragma unroll
        for (int i = 0; i < 4; ++i) sloc[((size_t)(16 * rt + 4 * fq + i) * 16 + g) * 128 + 16 * (2 * wave + c) + fr] = acc[c][i];
}

DI void it_ssm_c(const Params& p, int l, int item, unsigned char* sm) {
    bf16* sst = (bf16*)sm;
    const int lane = opq_tid() & 63, wave = opq_tid() >> 6, fr = lane & 15, fq = lane >> 4;
    const bf16* proj = (const bf16*)(wsb(p) + WS_PROJ);
    const float* sloc = (const float*)(wsb(p) + WS_SLOC);
    bf16* yg = (bf16*)(wsb(p) + WS_YG);
    const int jq = item & 3, g = (item >> 2) & 15, b = item >> 6;
    __syncthreads();
    if (wave == 0) {
        const float* pw64 = (const float*)(wsb(p) + WS_PW) + ((size_t)(l * 16 + g) * 65 + 64) * 128 + lane * 2;
        const float ar = pw64[0], ai = pw64[1];
        float sr = 0, si = 0;
        const float* s = sloc + ((size_t)(b * 64) * 16 + g) * 128;
#pragma unroll 8
        for (int k = 0; k < 64; ++k) {
            sst[k * 136 + lane] = f2bf(sr); sst[k * 136 + 64 + lane] = f2bf(si);
            const float lr = s[(size_t)k * 2048 + lane], li = s[(size_t)k * 2048 + 64 + lane];
            const float nr = ar * sr - ai * si + lr, ni = ar * si + ai * sr + li;
            sr = nr; si = ni;
        }
    }
    __syncthreads();
    const bf16* KT = (const bf16*)(wsb(p) + WS_KT) + (size_t)(l * 16 + g) * 64 * 256;
    const bf16* G = (const bf16*)(wsb(p) + WS_G) + (size_t)(l * 16 + g) * 1024 * 128;
    const int kch = 16 * wave + fr;
    const bf16* arow = proj + ((size_t)b * 4096 + 64 * kch + (fq >> 1)) * NPROJ + C_UA + 16 * g + 8 * (fq & 1);
    const float dsk = p.in[13][l * 256 + 16 * g + fr];
    for (int j = 16 * jq; j < 16 * jq + 16; ++j) {
        f32x4 acc = {0, 0, 0, 0};
        for (int ks = 0; 2 * ks <= j; ++ks) {
            const bf16x8 a = ld16(arow + (size_t)(2 * ks) * NPROJ);
            const int d = j - 2 * ks - (fq >> 1);
            const bf16x8 bf = d >= 0 ? ld16(KT + ((size_t)d * 16 + fr) * 16 + 8 * (fq & 1)) : zero8();
            acc = MFMA16(a, bf, acc);
        }
#pragma unroll
        for (int ks = 0; ks < 4; ++ks) {
            const bf16x8 a = ld16(sst + kch * 136 + 32 * ks + 8 * fq);
            const bf16x8 bf = ld16(G + ((size_t)(j * 16 + fr)) * 128 + 32 * ks + 8 * fq);
            acc = MFMA16(a, bf, acc);
        }
#pragma unroll
        for (int i = 0; i < 4; ++i) {
            const size_t tok = (size_t)b * 4096 + 64 * (16 * wave + 4 * fq + i) + j;
            const float u = bf2f(proj[tok * NPROJ + C_UA + 16 * g + fr]);
            yg[tok * 256 + 16 * g + fr] = f2bf(gelu_tanh(acc[i] + dsk * u));
        }
    }
}

DI void it_gmlp(const Params& p, int l, int item, unsigned char* sm) {
    bf16* vnT = (bf16*)sm;
    const int tid = opq_tid(), lane = tid & 63, wave = tid >> 6, fr = lane & 15, fq = lane >> 4;
    const bf16* proj = (const bf16*)(wsb(p) + WS_PROJ); bf16* mix = (bf16*)(wsb(p) + WS_MIX);
    const int h = item & 3, blk = item >> 2;
    const size_t tok0 = (size_t)blk * 128;
    __syncthreads();
    {
        const int row = tid >> 1, half = tid & 1;
        const bf16* vp = proj + (tok0 + row) * NPROJ + C_VB + 64 * h + 32 * half;
        float v[32]; float s = 0;
#pragma unroll
        for (int q = 0; q < 4; ++q) { const bf16x8 t = ld16(vp + 8 * q);
#pragma unroll
            for (int e = 0; e < 8; ++e) { v[8 * q + e] = bf2f((bf16)t[e]); s += v[8 * q + e]; } }
        s += __shfl_xor(s, 1); const float mu = s * (1.f / 64.f);
        float vs = 0;
#pragma unroll
        for (int e = 0; e < 32; ++e) { const float d = v[e] - mu; vs += d * d; }
        vs += __shfl_xor(vs, 1); const float r = rsqrtf(vs * (1.f / 64.f) + 1e-6f);
#pragma unroll
        for (int e = 0; e < 32; ++e) vnT[(32 * half + e) * 136 + row] = f2bf((v[e] - mu) * r);
    }
    __syncthreads();
    const bf16* W = (const bf16*)(wsb(p) + WS_GW) + (size_t)(l * 4 + h) * 128 * 128;
    f32x4 acc[4][2];
#pragma unroll
    for (int i = 0; i < 4; ++i) { acc[i][0] = (f32x4){0, 0, 0, 0}; acc[i][1] = (f32x4){0, 0, 0, 0}; }
#pragma unroll
    for (int ks = 0; ks < 4; ++ks) {
        bf16x8 fa[4], fb[2];
#pragma unroll
        for (int i = 0; i < 4; ++i) fa[i] = ld16(vnT + (16 * i + fr) * 136 + 32 * ks + 8 * fq);
#pragma unroll
        for (int j = 0; j < 2; ++j) fb[j] = ld16(W + (size_t)(16 * (2 * wave + j) + fr) * 128 + 32 * ks + 8 * fq);
#pragma unroll
        for (int i = 0; i < 4; ++i)
#pragma unroll
            for (int j = 0; j < 2; ++j) acc[i][j] = MFMA16(fa[i], fb[j], acc[i][j]);
    }
#pragma unroll
    for (int j = 0; j < 2; ++j) {
        const int t = 16 * (2 * wave + j) + fr;
        const float bs = p.in[18][(l * 4 + h) * 128 + t];
#pragma unroll
        for (int i = 0; i < 4; ++i) {
            const int d = 16 * i + 4 * fq;
            const u32x2 u = *(const u32x2*)(proj + (tok0 + t) * NPROJ + C_UB + 64 * h + d);
            u32x2 o; o.x = cvt_pk_bf16(bflo(u.x) * (acc[i][j][0] + bs), bfhi(u.x) * (acc[i][j][1] + bs)); o.y = cvt_pk_bf16(bflo(u.y) * (acc[i][j][2] + bs), bfhi(u.y) * (acc[i][j][3] + bs));
            *(u32x2*)(mix + (tok0 + t) * KMIX + 256 + 64 * h + d) = o;
        }
    }
}

DI size_t score_row_off(int b, int t) { const int c = t >> 6; return (size_t)b * SCORES_PER_BATCH + (size_t)4096 * (c * (c + 1) / 2) + (size_t)(t & 63) * 64 * (c + 1); }
DI void dsa_select_query(const Params& p, int q, int lane) {
    const float* scores = (const float*)(wsb(p) + WS_SCORES); bf16* sel = (bf16*)(wsb(p) + WS_SEL);
    const int b = q >> 12, t = q & 4095, c = t >> 6, nreg = c + 1;
    bf16* so = sel + (size_t)q * 256;
    if (nreg <= 4) { for (int r = 0; r < nreg; ++r) so[64 * r + lane] = (bf16)(64 * r + lane); return; }
    const float* srow = scores + score_row_off(b, t);
    unsigned key[64];
#pragma unroll
    for (int r = 0; r < 64; ++r) key[r] = (r < nreg) ? fkey(srow[64 * r + lane]) : 0u;
    unsigned T = 0;
    for (int bit = 31; bit >= 0; --bit) {
        const unsigned cand = T | (1u << bit);
        int cnt = 0;
#pragma unroll
        for (int r = 0; r < 64; ++r) if (r < nreg) cnt += __popcll(__ballot(key[r] >= cand));
        if (cnt >= 256) { T = cand; if (cnt == 256) break; }
    }
    int cgt = 0;
#pragma unroll
    for (int r = 0; r < 64; ++r) if (r < nreg) cgt += __popcll(__ballot(key[r] > T));
    const int need = 256 - cgt;
    int base = 0, eqb = 0;
    const unsigned long long lt = (1ull << lane) - 1ull;
#pragma unroll
    for (int r = 0; r < 64; ++r) if (r < nreg) {
        const unsigned long long me = __ballot(key[r] == T);
        const int erank = eqb + __popcll(me & lt);
        const bool take = (key[r] > T) || (key[r] == T && erank < need);
        const unsigned long long mt = __ballot(take);
        if (take) so[base + __popcll(mt & lt)] = (bf16)(64 * r + lane);
        base += __popcll(mt); eqb += __popcll(me);
    }
}
DI void it_dsa_index_select(const Params& p, int item) {
    const int lane = opq_tid() & 63, wave = opq_tid() >> 6, fr = lane & 15, fq = lane >> 4;
    const bf16* proj = (const bf16*)(wsb(p) + WS_PROJ); float* scores = (float*)(wsb(p) + WS_SCORES);
    const int c = 63 - (item >> 4), b = (item >> 2) & 3, qg = item & 3;
    if (c >= 4) {
        const int t = 64 * c + 16 * qg + fr;
        const bf16* qrow = proj + ((size_t)b * 4096 + t) * NPROJ;
        bf16x8 qf[4][2];
#pragma unroll
        for (int hh = 0; hh < 4; ++hh)
#pragma unroll
            for (int ks = 0; ks < 2; ++ks) qf[hh][ks] = ld16(qrow + C_QI + 64 * hh + 32 * ks + 8 * fq);
        float w[4];
        { const u32x2 wv = *(const u32x2*)(qrow + C_WI); w[0] = bflo(wv.x) * 0.0625f; w[1] = bfhi(wv.x) * 0.0625f; w[2] = bflo(wv.y) * 0.0625f; w[3] = bfhi(wv.y) * 0.0625f; }
        float* srow = scores + score_row_off(b, t);
        const int ntile = 4 * (c + 1);
        for (int kt = wave; kt < ntile; kt += 4) {
            const bf16* krow = proj + ((size_t)b * 4096 + 16 * kt + fr) * NPROJ + C_KI + 8 * fq;
            const bf16x8 k0 = ld16(krow), k1 = ld16(krow + 32);
            f32x4 sc = {0, 0, 0, 0};
#pragma unroll
            for (int hh = 0; hh < 4; ++hh) {
                f32x4 a = {0, 0, 0, 0};
                a = MFMA16(k0, qf[hh][0], a); a = MFMA16(k1, qf[hh][1], a);
#pragma unroll
                for (int i = 0; i < 4; ++i) sc[i] += w[hh] * fmaxf(a[i], 0.f);
            }
#pragma unroll
            for (int i = 0; i < 4; ++i) sc[i] += 0.f;
            *(f32x4*)(srow + 16 * kt + 4 * fq) = sc;
        }
        asm volatile("s_waitcnt vmcnt(0)" ::: "memory");
    }
    __syncthreads();
    for (int i = 0; i < 4; ++i) dsa_select_query(p, b * 4096 + 64 * c + 16 * qg + 4 * wave + i, lane);
}
DI void it_dsa_attn(const Params& p, int item, unsigned char* sm) {
    const int lane = opq_tid() & 63, wave = opq_tid() >> 6, fr = lane & 15, fq = lane >> 4;
    unsigned char* tile = sm + wave * 8192;
    const bf16* proj = (const bf16*)(wsb(p) + WS_PROJ); const bf16* kvn = (const bf16*)(wsb(p) + WS_KVN);
    const bf16* sel = (const bf16*)(wsb(p) + WS_SEL); bf16* mix = (bf16*)(wsb(p) + WS_MIX);
    unsigned wr_addr[8], rd_addr[2][4], tr_addr[8][2];
#pragma unroll
    for (int i = 0; i < 8; ++i) wr_addr[i] = off_b(4 * i + fq, fr);
#pragma unroll
    for (int rb = 0; rb < 2; ++rb)
#pragma unroll
        for (int s = 0; s < 4; ++s) rd_addr[rb][s] = off_b(8 * (fr >> 2) + 4 * rb + (fr & 3), 4 * s + fq);
    const unsigned tbase = (unsigned)(size_t)tile;
    {
        const unsigned q4 = fr >> 2, p4 = fr & 3;
#pragma unroll
        for (int c = 0; c < 8; ++c)
#pragma unroll
            for (int t = 0; t < 2; ++t) tr_addr[c][t] = tbase + off_b(8 * fq + 4 * t + q4, 2 * c + (p4 >> 1)) + 8 * (p4 & 1);
    }
    const float slope = fr < 8 ? exp2f(-(float)(fr + 1)) : 0.f;
    for (int qi = 0; qi < 4; ++qi) {
        const int q = item * 16 + wave * 4 + qi;
        const int b = q >> 12, t = q & 4095, c = t >> 6;
        const int nsel = (c + 1) * 64 < 256 ? (c + 1) * 64 : 256;
        const bf16* qa = proj + (size_t)q * NPROJ + C_QA;
        bf16x8 qf[4];
#pragma unroll
        for (int s = 0; s < 4; ++s) qf[s] = fr < 8 ? ld16(qa + fr * 128 + 32 * s + 8 * fq) : zero8();
        const bf16* selp = sel + (size_t)q * 256;
        const bf16* kvb = kvn + (size_t)b * 4096 * 128;
        float m_run = -INFINITY, l_run = 0.f;
        f32x4 o[8];
#pragma unroll
        for (int i = 0; i < 8; ++i) o[i] = (f32x4){0, 0, 0, 0};
        for (int ti = 0; ti < nsel / 32; ++ti) {
            bf16x8 gk[8];
#pragma unroll
            for (int i = 0; i < 8; ++i) { const int key = selp[32 * ti + 4 * i + fq]; gk[i] = ld16(kvb + (size_t)key * 128 + 8 * fr); }
            const bf16x8 kp = ld16(selp + 32 * ti + 8 * fq);
#pragma unroll
            for (int i = 0; i < 8; ++i) *(bf16x8*)(tile + wr_addr[i]) = gk[i];
            f32x4 lg[2] = {(f32x4){0, 0, 0, 0}, (f32x4){0, 0, 0, 0}};
#pragma unroll
            for (int rb = 0; rb < 2; ++rb)
#pragma unroll
                for (int s = 0; s < 4; ++s) lg[rb] = MFMA16(ld16(tile + rd_addr[rb][s]), qf[s], lg[rb]);
            float val[8]; float tmax = -INFINITY;
#pragma unroll
            for (int j = 0; j < 8; ++j) { const float dist = fabsf((float)(t - (int)(unsigned short)kp[j])); val[j] = lg[j >> 2][j & 3] - slope * dist; tmax = fmaxf(tmax, val[j]); }
            tmax = fmaxf(tmax, __shfl_xor(tmax, 16)); tmax = fmaxf(tmax, __shfl_xor(tmax, 32));
            const float m_new = fmaxf(m_run, tmax);
            const float scale = __expf(m_run - m_new);
            l_run *= scale;
#pragma unroll
            for (int i = 0; i < 8; ++i) o[i] *= scale;
            float pv[8];
#pragma unroll
            for (int j = 0; j < 8; ++j) { pv[j] = __expf(val[j] - m_new); l_run += pv[j]; }
            m_run = m_new;
            u32x4 pk; pk.x = cvt_pk_bf16(pv[0], pv[1]); pk.y = cvt_pk_bf16(pv[2], pv[3]); pk.z = cvt_pk_bf16(pv[4], pv[5]); pk.w = cvt_pk_bf16(pv[6], pv[7]);
            const bf16x8 pf = __builtin_bit_cast(bf16x8, pk);
            s16x4 tr[8][2];
            TR8(tr[0][0], tr[0][1], tr[1][0], tr[1][1], tr[2][0], tr[2][1], tr[3][0], tr[3][1], tr_addr[0][0], tr_addr[0][1], tr_addr[1][0], tr_addr[1][1], tr_addr[2][0], tr_addr[2][1], tr_addr[3][0], tr_addr[3][1]);
            TR8(tr[4][0], tr[4][1], tr[5][0], tr[5][1], tr[6][0], tr[6][1], tr[7][0], tr[7][1], tr_addr[4][0], tr_addr[4][1], tr_addr[5][0], tr_addr[5][1], tr_addr[6][0], tr_addr[6][1], tr_addr[7][0], tr_addr[7][1]);
#pragma unroll
            for (int cc = 0; cc < 8; ++cc) {
                bf16x8 kf; kf[0] = tr[cc][0][0]; kf[1] = tr[cc][0][1]; kf[2] = tr[cc][0][2]; kf[3] = tr[cc][0][3]; kf[4] = tr[cc][1][0]; kf[5] = tr[cc][1][1]; kf[6] = tr[cc][1][2]; kf[7] = tr[cc][1][3];
                o[cc] = MFMA16(kf, pf, o[cc]);
            }
        }
        float lt = l_run; lt += __shfl_xor(lt, 16); lt += __shfl_xor(lt, 32);
        const float inv = 1.f / lt;
        if (fr < 8) {
#pragma unroll
            for (int cc = 0; cc < 8; ++cc) { u32x2 ov; ov.x = cvt_pk_bf16(o[cc][0] * inv, o[cc][1] * inv); ov.y = cvt_pk_bf16(o[cc][2] * inv, o[cc][3] * inv);
                *(u32x2*)(mix + (size_t)q * KMIX + 512 + fr * 128 + 16 * cc + 4 * fq) = ov; }
        }
    }
}
DI void peer_load_keys(const Params& p, int l, PeerLds& S) {
    const bf16* pk = (const bf16*)(wsb(p) + WS_PK) + (size_t)l * 2 * 128 * 64;
    __syncthreads();
    for (int i = opq_tid(); i < 128 * 64; i += 256) { S.k1[(i >> 6) * KP + (i & 63)] = pk[i]; S.k2[(i >> 6) * KP + (i & 63)] = pk[128 * 64 + i]; }
    __syncthreads();
}
typedef float f2 __attribute__((ext_vector_type(2)));
#ifndef PEER_FP8_MASK
#define PEER_FP8_MASK 3
#endif
constexpr float U_SCALE = 64.f, V_SCALE = 8.f;
DI unsigned pack4_fp8(float a, float b, float c, float d) { int p = __builtin_amdgcn_cvt_pk_fp8_f32(a, b, 0, false); p = __builtin_amdgcn_cvt_pk_fp8_f32(c, d, p, true); return (unsigned)p; }
DI void conv_chunk_fp8(const float* __restrict__ src, unsigned char* __restrict__ dst, size_t i0, int n16, float sc) {
    for (int i = opq_tid(); i < n16; i += 256) {
        const float4* s4 = (const float4*)src + 4 * (i0 + i);
        const float4 a = s4[0], b = s4[1], c = s4[2], d = s4[3];
        u32x4 o; o.x = pack4_fp8(a.x * sc, a.y * sc, a.z * sc, a.w * sc); o.y = pack4_fp8(b.x * sc, b.y * sc, b.z * sc, b.w * sc);
        o.z = pack4_fp8(c.x * sc, c.y * sc, c.z * sc, c.w * sc); o.w = pack4_fp8(d.x * sc, d.y * sc, d.z * sc, d.w * sc);
        ((u32x4*)dst)[i0 + i] = o;
    }
}
template <bool FP8>
DI void peer_token(const Params& p, int l, int tok4, PeerLds& S) {
    const int tid_ = opq_tid(), lane = tid_ & 63, wave = tid_ >> 6; const int tok = tok4 + wave;
    const bf16* QP = (const bf16*)(wsb(p) + WS_PROJ);
    const bf16* H = (const bf16*)(wsb(p) + WS_H);
    const unsigned char* UB = wsb(p) + WS_UB; const unsigned char* VB = wsb(p) + WS_VB;
    const float* X = (const float*)(wsb(p) + WS_X);
    const float* modl = (const float*)(wsb(p) + WS_MOD) + (size_t)l * 4 * 6144;
    const int b = tok >> 12;
    *(bf16x8*)(S.q[wave] + 8 * lane) = ld16(QP + (size_t)tok * 1024 + 8 * lane);
    *(bf16x8*)(S.q[wave] + 512 + 8 * lane) = ld16(QP + (size_t)tok * 1024 + 512 + 8 * lane);
    f2 hp[8];
    u32x4 h0, h1;
    {
        h0 = *(const u32x4*)(H + (size_t)tok * 1024 + 16 * lane); h1 = *(const u32x4*)(H + (size_t)tok * 1024 + 16 * lane + 8);
        hp[0] = (f2){bflo(h0.x), bfhi(h0.x)}; hp[1] = (f2){bflo(h0.y), bfhi(h0.y)}; hp[2] = (f2){bflo(h0.z), bfhi(h0.z)}; hp[3] = (f2){bflo(h0.w), bfhi(h0.w)};
        hp[4] = (f2){bflo(h1.x), bfhi(h1.x)}; hp[5] = (f2){bflo(h1.y), bfhi(h1.y)}; hp[6] = (f2){bflo(h1.z), bfhi(h1.z)}; hp[7] = (f2){bflo(h1.w), bfhi(h1.w)};
    }
    for (int hp_ = 0; hp_ < 8; ++hp_) {
        float s1[2] = {0, 0}, s2[2] = {0, 0};
        const bf16* q1 = S.q[wave] + 128 * hp_; const bf16* q2 = q1 + 64;
#pragma unroll
        for (int d4 = 0; d4 < 16; ++d4) {
            const u32x2 qa = *(const u32x2*)(q1 + 4 * d4), qb = *(const u32x2*)(q2 + 4 * d4);
#pragma unroll
            for (int j = 0; j < 2; ++j) {
                const u32x2 ka = *(const u32x2*)(S.k1 + (lane + 64 * j) * KP + 4 * d4), kb = *(const u32x2*)(S.k2 + (lane + 64 * j) * KP + 4 * d4);
                s1[j] = dot2bf(ka.x, qa.x, s1[j]); s1[j] = dot2bf(ka.y, qa.y, s1[j]);
                s2[j] = dot2bf(kb.x, qb.x, s2[j]); s2[j] = dot2bf(kb.y, qb.y, s2[j]);
            }
        }
        const int ids[2] = {lane, lane + 64};
        select16<2>(s1, ids, S.l1v[wave], S.l1i[wave], lane);
        select16<2>(s2, ids, S.l2v[wave], S.l2i[wave], lane);
        float cv[4]; int ci[4];
        { const int a = lane >> 2, b4 = (lane & 3) * 4; const float va = S.l1v[wave][a]; const int ia = S.l1i[wave][a];
#pragma unroll
          for (int j = 0; j < 4; ++j) { cv[j] = va + S.l2v[wave][b4 + j]; ci[j] = ia * 128 + S.l2i[wave][b4 + j]; } }
        select16<4>(cv, ci, S.cv[wave], S.ci[wave], lane);
        {
            const float sv = S.cv[wave][lane & 15];
            float mx = sv; for (int o = 8; o > 0; o >>= 1) mx = fmaxf(mx, __shfl_xor(mx, o));
            const float e = __expf(sv - mx); float sm = e; for (int o = 8; o > 0; o >>= 1) sm += __shfl_xor(sm, o);
            if (lane < 16) { S.pe[wave][hp_ * 16 + lane] = S.ci[wave][lane]; S.pg[wave][hp_ * 16 + lane] = e / sm; }
        }
    }
    f2 acc[8];
#pragma unroll
    for (int i = 0; i < 8; ++i) acc[i] = (f2){0.f, 0.f};
    const bool b5 = (lane & 32) != 0, b4_ = (lane & 16) != 0, b3 = (lane & 8) != 0;
    const int eidx = (b3 ? 4 : 0) + (b4_ ? 2 : 0) + (b5 ? 1 : 0);
    if constexpr (FP8) {
    for (int e0 = 0; e0 < 128; e0 += 8) {
        u32x4 ur[8], vr[8];
#pragma unroll
        for (int j = 0; j < 8; ++j) {
            const int e = __builtin_amdgcn_readfirstlane(S.pe[wave][e0 + j]);
            ur[j] = *(const u32x4*)(UB + (size_t)e * 1024 + 16 * lane);
            vr[j] = *(const u32x4*)(VB + (size_t)e * 1024 + 16 * lane);
        }
        float d[8];
#pragma unroll
        for (int j = 0; j < 8; ++j) {
            f2 s2 = {0.f, 0.f};
#pragma unroll
            for (int k = 0; k < 4; ++k) {
                const f2 lo = __builtin_amdgcn_cvt_pk_f32_fp8((int)ur[j][k], false), hi = __builtin_amdgcn_cvt_pk_f32_fp8((int)ur[j][k], true);
                s2 = lo * hp[2 * k] + s2; s2 = hi * hp[2 * k + 1] + s2;
            }
            d[j] = s2.x + s2.y;
        }
        float w[4], x2[2], y;
#pragma unroll
        for (int i = 0; i < 4; ++i) { const float keep = b5 ? d[2 * i + 1] : d[2 * i], send = b5 ? d[2 * i] : d[2 * i + 1]; w[i] = keep + __shfl_xor(send, 32); }
#pragma unroll
        for (int i = 0; i < 2; ++i) { const float keep = b4_ ? w[2 * i + 1] : w[2 * i], send = b4_ ? w[2 * i] : w[2 * i + 1]; x2[i] = keep + __shfl_xor(send, 16); }
        { const float keep = b3 ? x2[1] : x2[0], send = b3 ? x2[0] : x2[1]; y = keep + __shfl_xor(send, 8); }
        y += __shfl_xor(y, 4); y += __shfl_xor(y, 2); y += __shfl_xor(y, 1);
        const float sc = gelu_tanh(y * (1.f / U_SCALE)) * S.pg[wave][e0 + eidx] * (1.f / V_SCALE);
#pragma unroll
        for (int j = 0; j < 8; ++j) {
            const float sj = __uint_as_float((unsigned)__builtin_amdgcn_readlane((int)__float_as_uint(sc), 32 * (j & 1) + 16 * ((j >> 1) & 1) + 8 * ((j >> 2) & 1)));
            const f2 sj2 = {sj, sj};
#pragma unroll
            for (int k = 0; k < 4; ++k) {
                const f2 lo = __builtin_amdgcn_cvt_pk_f32_fp8((int)vr[j][k], false), hi = __builtin_amdgcn_cvt_pk_f32_fp8((int)vr[j][k], true);
                acc[2 * k] = lo * sj2 + acc[2 * k]; acc[2 * k + 1] = hi * sj2 + acc[2 * k + 1];
            }
        }
    }
    } else {
    for (int e0 = 0; e0 < 128; e0 += 4) {
        const bf16* UBb = (const bf16*)UB; const bf16* VBb = (const bf16*)VB;
        u32x4 ur[4][2], vr[4][2];
#pragma unroll
        for (int j = 0; j < 4; ++j) {
            const int e = __builtin_amdgcn_readfirstlane(S.pe[wave][e0 + j]);
            ur[j][0] = *(const u32x4*)(UBb + (size_t)e * 1024 + 16 * lane); ur[j][1] = *(const u32x4*)(UBb + (size_t)e * 1024 + 16 * lane + 8);
            vr[j][0] = *(const u32x4*)(VBb + (size_t)e * 1024 + 16 * lane); vr[j][1] = *(const u32x4*)(VBb + (size_t)e * 1024 + 16 * lane + 8);
        }
        float d[4];
#pragma unroll
        for (int j = 0; j < 4; ++j) {
            float sa = 0.f, sb = 0.f;
            sa = dot2bf(ur[j][0].x, h0.x, sa); sb = dot2bf(ur[j][0].y, h0.y, sb); sa = dot2bf(ur[j][0].z, h0.z, sa); sb = dot2bf(ur[j][0].w, h0.w, sb);
            sa = dot2bf(ur[j][1].x, h1.x, sa); sb = dot2bf(ur[j][1].y, h1.y, sb); sa = dot2bf(ur[j][1].z, h1.z, sa); sb = dot2bf(ur[j][1].w, h1.w, sb);
            d[j] = sa + sb;
        }
        float w[2], y;
#pragma unroll
        for (int i = 0; i < 2; ++i) { const float keep = b5 ? d[2 * i + 1] : d[2 * i], send = b5 ? d[2 * i] : d[2 * i + 1]; w[i] = keep + __shfl_xor(send, 32); }
        { const float keep = b4_ ? w[1] : w[0], send = b4_ ? w[0] : w[1]; y = keep + __shfl_xor(send, 16); }
        y += __shfl_xor(y, 8); y += __shfl_xor(y, 4); y += __shfl_xor(y, 2); y += __shfl_xor(y, 1);
        const float sc = gelu_tanh(y) * S.pg[wave][e0 + (b4_ ? 2 : 0) + (b5 ? 1 : 0)];
#pragma unroll
        for (int j = 0; j < 4; ++j) {
            const float sj = __uint_as_float((unsigned)__builtin_amdgcn_readlane((int)__float_as_uint(sc), 32 * (j & 1) + 16 * ((j >> 1) & 1)));
            const f2 sj2 = {sj, sj};
#pragma unroll
            for (int hh = 0; hh < 2; ++hh)
#pragma unroll
                for (int k = 0; k < 4; ++k) { const unsigned dw = vr[j][hh][k]; const f2 vv = {bflo(dw), bfhi(dw)}; acc[4 * hh + k] = vv * sj2 + acc[4 * hh + k]; }
        }
    }
    }
    float xr[16];
    const float* xrow = X + (size_t)tok * 1024 + 16 * lane;
    float* xorow = p.out + (size_t)tok * 1024 + 16 * lane;
    const float* g2 = modl + (size_t)b * 6144 + 5 * 1024 + 16 * lane;
    float ss = 0;
#pragma unroll
    for (int q4 = 0; q4 < 4; ++q4) {
        const float4 xv = *(const float4*)(xrow + 4 * q4), gv = *(const float4*)(g2 + 4 * q4);
        float4 o; o.x = xv.x + gv.x * acc[2 * q4].x; o.y = xv.y + gv.y * acc[2 * q4].y; o.z = xv.z + gv.z * acc[2 * q4 + 1].x; o.w = xv.w + gv.w * acc[2 * q4 + 1].y;
        if (l == 0) *(float4*)(xorow + 4 * q4) = o;
        xr[4 * q4] = o.x; xr[4 * q4 + 1] = o.y; xr[4 * q4 + 2] = o.z; xr[4 * q4 + 3] = o.w;
        ss += o.x * o.x + o.y * o.y + o.z * o.z + o.w * o.w;
    }
    ss = wave_sum(ss);
    const float r = rsqrtf(ss * (1.f / 1024.f) + 1e-6f);
    if (l == 1) {
#pragma unroll
        for (int q4 = 0; q4 < 4; ++q4) {
            const float4 gv = *(const float4*)(p.in[28] + 16 * lane + 4 * q4);
            float4 o; o.x = xr[4 * q4] * r * gv.x; o.y = xr[4 * q4 + 1] * r * gv.y; o.z = xr[4 * q4 + 2] * r * gv.z; o.w = xr[4 * q4 + 3] * r * gv.w;
            *(float4*)(xorow + 4 * q4) = o;
        }
    } else {
        const float* g = p.in[2] + 1024 + 16 * lane; const float* mod1 = (const float*)(wsb(p) + WS_MOD) + ((size_t)4 + b) * 6144 + 16 * lane;
        bf16* hrow = (bf16*)(wsb(p) + WS_H2) + (size_t)tok * 1024 + 16 * lane;
        float hv[16];
#pragma unroll
        for (int q4 = 0; q4 < 4; ++q4) {
            const float4 gg = *(const float4*)(g + 4 * q4), s1 = *(const float4*)(mod1 + 1024 + 4 * q4), s0 = *(const float4*)(mod1 + 4 * q4);
            hv[4 * q4] = xr[4 * q4] * r * gg.x * (1.f + s1.x) + s0.x; hv[4 * q4 + 1] = xr[4 * q4 + 1] * r * gg.y * (1.f + s1.y) + s0.y;
            hv[4 * q4 + 2] = xr[4 * q4 + 2] * r * gg.z * (1.f + s1.z) + s0.z; hv[4 * q4 + 3] = xr[4 * q4 + 3] * r * gg.w * (1.f + s1.w) + s0.w;
        }
        u32x4 o0, o1;
        o0.x = cvt_pk_bf16(hv[0], hv[1]); o0.y = cvt_pk_bf16(hv[2], hv[3]); o0.z = cvt_pk_bf16(hv[4], hv[5]); o0.w = cvt_pk_bf16(hv[6], hv[7]);
        o1.x = cvt_pk_bf16(hv[8], hv[9]); o1.y = cvt_pk_bf16(hv[10], hv[11]); o1.z = cvt_pk_bf16(hv[12], hv[13]); o1.w = cvt_pk_bf16(hv[14], hv[15]);
        *(u32x4*)(hrow) = o0; *(u32x4*)(hrow + 8) = o1;
    }
}

constexpr int SMEM_BYTES = 64 + 48640;
#ifndef REP_ID
#define REP_ID -1
#endif
#ifndef REP_N
#define REP_N 1
#endif
#define NREP(id) ((id) == REP_ID ? REP_N : 1)
__global__ void __launch_bounds__(256, 2) fwd_megakernel(Params p) {
    __shared__ __attribute__((aligned(16))) unsigned char smem[SMEM_BYTES];
    const int tid = threadIdx.x;
    const int G = gridDim.x, bid = blockIdx.x;
    unsigned char* sm = smem + 64;
    volatile int* qslot = (volatile int*)(smem + 16);
    if (tid < 16) ((unsigned*)smem)[tid] = 0u;
    __syncthreads();
    unsigned* ctl = (unsigned*)(p.ws + WS_CTL);
    unsigned* qctr = ctl + 4096;
    XcdBarrier bar = xcd_barrier_post(ctl, (volatile LAS unsigned*)smem);
    unsigned char* ws = p.ws;
    const bf16* H = (const bf16*)(ws + WS_H);
    bf16* PROJ = (bf16*)(ws + WS_PROJ);
    float* X = (float*)(ws + WS_X);
    const float* mod = (const float*)(ws + WS_MOD);
    int qn = 0;

    for (int rep = 0; rep < NREP(0); ++rep) {
        constexpr int N_MOD = 48, N_LAYER = 768 + 1024 + 512 + 512 + 1024 + 1024 + 64, N_PK = 4, N_GW = 128, N_PW = 8;
        constexpr int NV = N_MOD + 2 * N_LAYER + N_PK + N_GW + N_PW;
        for (int vb = bid; vb < NV; vb += G) {
            int v = vb;
            if (v < N_MOD) { it_mod(p, v, sm); continue; }
            v -= N_MOD;
            if (v < 2 * N_LAYER) {
                const int l = v / N_LAYER; v -= l * N_LAYER;
                bf16* wtin = (bf16*)(ws + WS_WTIN) + (size_t)l * NPROJ * 1024;
                const float* win = p.in[6] + (size_t)l * 1024 * 1732;
                bf16* wtout = (bf16*)(ws + WS_WTOUT) + (size_t)l * 1024 * KMIX;
                const float* wout = p.in[22] + (size_t)l * 1024 * 1024;
                if (v < 768) { it_transpose(TrArgs{win, 1732, 0, 1732, wtin, 1024, 0, 1024, 768, 0, nullptr}, v, sm); }
                else if ((v -= 768) < 1024) { it_transpose(TrArgs{win, 1732, 0, 1732, wtin + (size_t)768 * 1024, 1024, 0, 1024, 1024, 1, p.in[20] + (size_t)l * 8 * 64 * 128}, v, sm); }
                else if ((v -= 1024) < 512) { it_transpose(TrArgs{win, 1732, 1280, 1732, wtin + (size_t)1792 * 1024, 1024, 0, 1024, 512, 0, nullptr}, v, sm); }
                else if ((v -= 512) < 512) { it_transpose(TrArgs{wout, 1024, 0, 1024, wtout, KMIX, 0, 512, 1024, 0, nullptr}, v, sm); }
                else if ((v -= 512) < 1024) { it_transpose(TrArgs{wout, 1024, 0, 1024, wtout, KMIX, 512, 1024, 1024, 2, p.in[21] + (size_t)l * 8 * 128 * 64}, v, sm); }
                else if ((v -= 1024) < 1024) { it_transpose(TrArgs{p.in[23] + (size_t)l * 1024 * 1024, 1024, 0, 1024, (bf16*)(ws + WS_WTQ) + (size_t)l * 1024 * 1024, 1024, 0, 1024, 1024, 0, nullptr}, v, sm); }
                else { v -= 1024; it_transpose(TrArgs{p.in[15] + (size_t)l * 256 * 256, 256, 0, 256, (bf16*)(ws + WS_WTGLU) + (size_t)l * 256 * 256, 256, 0, 256, 256, 0, nullptr}, v, sm); }
                continue;
            }
            v -= 2 * N_LAYER;
            if (v < N_PK) { const int l = v >> 1, w = v & 1; conv_chunk(p.in[24 + w] + (size_t)l * 8192, (bf16*)(ws + WS_PK) + (size_t)l * 16384 + w * 8192, 0, 1024); continue; }
            v -= N_PK;
            if (v < N_GW) { it_gw(p, v); continue; }
            v -= N_GW;
            it_ssm_pw(p, v);
        }
        xcd_barrier(bar);
    }
    for (int rep = 0; rep < NREP(1); ++rep) {
        constexpr int N_NORM = NTOK / 4, N_TAB = 4352;
        for (int vb = bid; vb < N_NORM + N_TAB; vb += G) {
            if (vb < N_NORM) {
                const int t_ = opq_tid(); const int row = vb * 4 + (t_ >> 6);
                const float* m0 = (const float*)(wsb(p) + WS_MOD) + (size_t)(row >> 12) * 6144;
                norm_mod_row(p.in[0] + (size_t)row * 1024, p.in[2], m0, m0 + 1024, (bf16*)(wsb(p) + WS_H) + (size_t)row * 1024, t_ & 63);
            } else {
                const size_t base = (size_t)(vb - N_NORM) * 2048;
                for (int e = 0; e < 8; ++e) ssm_tab_entry(p, base + e * 256 + opq_tid());
            }
        }
        xcd_barrier(bar);
    }

    for (int l = 0; l < 2; ++l) {
        const float* xin = l == 0 ? p.in[0] : p.out;
        for (int rep = 0; rep < NREP(2 + 8 * l); ++rep) {
            const EpiBf16 epi{PROJ, NPROJ};
            const bf16* Bt = (const bf16*)(ws + WS_WTIN) + (size_t)l * NPROJ * 1024;
            const bf16* Hin = l == 0 ? H : (const bf16*)(ws + WS_H2);
            for (int t = bid; t < (NTOK / 128) * (NPROJ / 128); t += G) { gemm_tile(Hin, 1024, Bt, 1024, 1024, (t / (NPROJ / 128)) * 128, (t % (NPROJ / 128)) * 128, (bf16*)sm, epi); __syncthreads(); }
            xcd_barrier(bar);
        }
        for (int rep = 0; rep < NREP(3 + 8 * l); ++rep) {
            unsigned* ctr = qctr + 64 * (qn++);
            for (;;) {
                const int it = q_next(ctr, qslot);
                if (it >= 2048) break;
                if (it < 1024) it_dsa_index_select(p, it);
                else if (it < 1536) it_gmlp(p, l, it - 1024, sm);
                else if (it < 1792) it_ssm_a(p, l, it - 1536);
                else it_kvn(p, l, it - 1792);
            }
            xcd_barrier(bar);
        }
        for (int rep = 0; rep < NREP(4 + 8 * l); ++rep) {
            unsigned* ctr = qctr + 64 * (qn++);
            for (;;) {
                const int it = q_next(ctr, qslot);
                if (it >= 256 + 1024 + 512) break;
                if (it < 256) it_ssm_c(p, l, it, sm);
                else if (it < 1280) it_dsa_attn(p, it - 256, sm);
                else {
                    const int v = it - 1280, w = v >> 8, ch = v & 255;
                    if (!(PEER_FP8_MASK & (1 << l))) conv_chunk(p.in[26 + w] + (size_t)l * NEXP * 1024, (bf16*)(ws + (w ? WS_VB : WS_UB)), (size_t)ch * 8192, 8192);
                    else conv_chunk_fp8(p.in[26 + w] + (size_t)l * NEXP * 1024, ws + (w ? WS_VB : WS_UB), (size_t)ch * 4096, 4096, w ? V_SCALE : U_SCALE);
                }
            }
            xcd_barrier(bar);
        }
        for (int rep = 0; rep < NREP(5 + 8 * l); ++rep) {
            const EpiGlu epi{(const bf16*)(ws + WS_YG), p.in[16] + l * 256, (bf16*)(ws + WS_MIX)};
            const bf16* Bt = (const bf16*)(ws + WS_WTGLU) + (size_t)l * 256 * 256;
            for (int t = bid; t < (NTOK / 128) * 2; t += G) { gemm_tile((const bf16*)(ws + WS_YG), 256, Bt, 256, 256, (t >> 1) * 128, (t & 1) * 128, (bf16*)sm, epi); __syncthreads(); }
            xcd_barrier(bar);
        }
        for (int rep = 0; rep < NREP(6 + 8 * l); ++rep) {
            const EpiResid epi{xin, X, mod + (size_t)l * 4 * 6144 + 2048};
            const bf16* Bt = (const bf16*)(ws + WS_WTOUT) + (size_t)l * 1024 * KMIX;
            for (int t = bid; t < (NTOK / 128) * 8; t += G) { gemm_tile((const bf16*)(ws + WS_MIX), KMIX, Bt, KMIX, KMIX, (t >> 3) * 128, (t & 7) * 128, (bf16*)sm, epi); __syncthreads(); }
            xcd_barrier(bar);
        }
        for (int rep = 0; rep < NREP(7 + 8 * l); ++rep) {
            for (int vb = bid; vb < NTOK / 4; vb += G) {
                const int t_ = opq_tid(); const int row = vb * 4 + (t_ >> 6);
                const float* m0 = (const float*)(wsb(p) + WS_MOD) + ((size_t)l * 4 + (row >> 12)) * 6144 + 3072;
                norm_mod_row((const float*)(wsb(p) + WS_X) + (size_t)row * 1024, p.in[3] + l * 1024, m0, m0 + 1024, (bf16*)(wsb(p) + WS_H) + (size_t)row * 1024, t_ & 63);
            }
            xcd_barrier(bar);
        }
        for (int rep = 0; rep < NREP(8 + 8 * l); ++rep) {
            const EpiBf16 epi{PROJ, 1024};
            const bf16* Bt = (const bf16*)(ws + WS_WTQ) + (size_t)l * 1024 * 1024;
            for (int t = bid; t < (NTOK / 128) * 8; t += G) { gemm_tile(H, 1024, Bt, 1024, 1024, (t >> 3) * 128, (t & 7) * 128, (bf16*)sm, epi); __syncthreads(); }
            xcd_barrier(bar);
        }
        for (int rep = 0; rep < NREP(9 + 8 * l); ++rep) {
            PeerLds& S = *(PeerLds*)sm;
            peer_load_keys(p, l, S);
            if (PEER_FP8_MASK & (1 << l)) { for (int vb = bid; vb < NTOK / 4; vb += G) peer_token<true>(p, l, vb * 4, S); }
            else { for (int vb = bid; vb < NTOK / 4; vb += G) peer_token<false>(p, l, vb * 4, S); }
            if (l == 0 || rep + 1 < NREP(9 + 8 * l)) xcd_barrier(bar);
        }
    }
}

extern "C" void kernel_launch(void* const* d_in, const int* in_sizes, int n_in, void* d_out, int out_size, void* d_ws, size_t ws_size, hipStream_t stream) {
    if (n_in != 29 || ws_size < WS_END) { fprintf(stderr, "kernel_launch: bad args (n_in %d, ws %zu, need %zu)\n", n_in, ws_size, (size_t)WS_END); return; }
    static int grid = 0;
    if (grid == 0) {
        int dev = 0, cus = 0, per_cu = 0;
        if (hipGetDevice(&dev) != hipSuccess || hipDeviceGetAttribute(&cus, hipDeviceAttributeMultiprocessorCount, dev) != hipSuccess) { grid = -1; return; }
        if (hipOccupancyMaxActiveBlocksPerMultiprocessor(&per_cu, (const void*)fwd_megakernel, 256, 0) != hipSuccess || per_cu < 1) { fprintf(stderr, "kernel_launch: occupancy query failed (%d)\n", per_cu); grid = -1; return; }
        const int use = per_cu < 2 ? per_cu : 2;
        grid = cus * use;
    }
    if (grid < 0) return;
    if (hipMemsetAsync((char*)d_ws + WS_CTL, 0, 65536, stream) != hipSuccess) { fprintf(stderr, "kernel_launch: memset failed\n"); return; }
    Params p{};
    for (int i = 0; i < 29; ++i) p.in[i] = (const float*)d_in[i];
    p.out = (float*)d_out; p.ws = (unsigned char*)d_ws;
    void* args[] = {&p};
    const hipError_t e = hipLaunchCooperativeKernel((const void*)fwd_megakernel, dim3(grid), dim3(256), args, 0, stream);
    if (e != hipSuccess) fprintf(stderr, "kernel_launch: cooperative launch failed: %s (grid %d)\n", hipGetErrorString(e), grid);
}
```

```cpp
#include <hip/hip_runtime.h>
#include <cstdint>
#include <cstdio>

typedef unsigned short bf16;
typedef short bf16x8 __attribute__((ext_vector_type(8)));
typedef short s16x4 __attribute__((ext_vector_type(4)));
typedef float f32x4 __attribute__((ext_vector_type(4)));
typedef unsigned u32x4 __attribute__((ext_vector_type(4)));
typedef unsigned u32x2 __attribute__((ext_vector_type(2)));
typedef __bf16 bf2 __attribute__((ext_vector_type(2)));
#define DI __device__ __forceinline__
#define MFMA16(a, b, c) __builtin_amdgcn_mfma_f32_16x16x32_bf16((a), (b), (c), 0, 0, 0)

constexpr int DM = 1024, NB = 4, SEQ = 4096, NTOK = NB * SEQ;
constexpr int NPROJ = 2304;
constexpr int C_UA = 0, C_UB = 256, C_VB = 512, C_QA = 768, C_CKV = 1792, C_QI = 1920, C_KI = 2176, C_WI = 2240;
constexpr int KMIX = 1536;
constexpr int NEXP = 16384;
constexpr size_t SCORES_PER_BATCH = (size_t)4096 * 2080;

constexpr size_t al256(size_t x) { return (x + 255) & ~(size_t)255; }
constexpr size_t WS_CTL = 0;
constexpr size_t WS_MOD = 65536;
constexpr size_t WS_WTIN = al256(WS_MOD + 2 * 4 * 6144 * 4);
constexpr size_t WS_WTOUT = al256(WS_WTIN + (size_t)2 * NPROJ * 1024 * 2);
constexpr size_t WS_WTQ = al256(WS_WTOUT + (size_t)2 * 1024 * KMIX * 2);
constexpr size_t WS_WTGLU = al256(WS_WTQ + (size_t)2 * 1024 * 1024 * 2);
constexpr size_t WS_GW = al256(WS_WTGLU + (size_t)2 * 256 * 256 * 2);
constexpr size_t WS_PK = al256(WS_GW + (size_t)2 * 4 * 128 * 128 * 2);
constexpr size_t WS_PW = al256(WS_PK + (size_t)2 * 2 * 128 * 64 * 2);
constexpr size_t WS_BB = al256(WS_PW + (size_t)2 * 16 * 65 * 64 * 2 * 4);
constexpr size_t WS_E = al256(WS_BB + (size_t)2 * 16 * 64 * 16 * 2 * 4);
constexpr size_t WS_G = al256(WS_E + (size_t)2 * 16 * 128 * 1024 * 2);
constexpr size_t WS_KT = al256(WS_G + (size_t)2 * 16 * 1024 * 128 * 2);
constexpr size_t WS_UB = al256(WS_KT + (size_t)2 * 16 * 64 * 256 * 2);
constexpr size_t WS_VB = al256(WS_UB + (size_t)NEXP * 1024 * 2);
constexpr size_t WS_H = al256(WS_VB + (size_t)NEXP * 1024 * 2);
constexpr size_t WS_PROJ = al256(WS_H + (size_t)NTOK * 1024 * 2);
constexpr size_t WS_SLOC = al256(WS_PROJ + (size_t)NTOK * NPROJ * 2);
constexpr size_t WS_YG = al256(WS_SLOC + (size_t)256 * 16 * 128 * 4);
constexpr size_t WS_KVN = al256(WS_YG + (size_t)NTOK * 256 * 2);
constexpr size_t WS_SEL = al256(WS_KVN + (size_t)NTOK * 128 * 2);
constexpr size_t WS_MIX = al256(WS_SEL + (size_t)NTOK * 256 * 2);
constexpr size_t WS_X = al256(WS_MIX + (size_t)NTOK * KMIX * 2);
constexpr size_t WS_SCORES = al256(WS_X + (size_t)NTOK * 1024 * 4);
constexpr size_t WS_H2 = al256(WS_SCORES + (size_t)NB * SCORES_PER_BATCH * 4);
constexpr size_t WS_END = al256(WS_H2 + (size_t)NTOK * 1024 * 2);

struct Params {
    const float* in[29];
    float* out;
    unsigned char* ws;
};

typedef __bf16 bf2v_t __attribute__((ext_vector_type(2)));
typedef float f2v_t __attribute__((ext_vector_type(2)));
DI unsigned cvt_pk_bf16(float lo, float hi) { const f2v_t f = {lo, hi}; const bf2v_t r = __builtin_convertvector(f, bf2v_t); return __builtin_bit_cast(unsigned, r); }
DI bf16 f2bf(float x) { return (bf16)(cvt_pk_bf16(x, 0.f) & 0xffffu); }
DI float bf2f(bf16 b) { return __uint_as_float((unsigned)b << 16); }
DI float bflo(unsigned u) { return __uint_as_float(u << 16); }
DI float bfhi(unsigned u) { return __uint_as_float(u & 0xffff0000u); }
DI float dot2bf(unsigned a, unsigned b, float c) { return __builtin_amdgcn_fdot2_f32_bf16(__builtin_bit_cast(bf2, a), __builtin_bit_cast(bf2, b), c, false); }
DI float gelu_tanh(float x) { const float u = 0.7978845608028654f * (x + 0.044715f * x * x * x); const float e = __expf(2.f * u); const float t = 1.f - 2.f / (e + 1.f); return 0.5f * x * (1.f + t); }
DI float sigmoidf(float x) { return 1.f / (1.f + __expf(-x)); }
DI float wave_sum(float v) { for (int o = 32; o > 0; o >>= 1) v += __shfl_xor(v, o); return v; }
DI unsigned wave_sum_u32(unsigned v) {
    int x = (int)v;
    x += __builtin_amdgcn_update_dpp(0, x, 0xB1, 0xf, 0xf, true);
    x += __builtin_amdgcn_update_dpp(0, x, 0x4E, 0xf, 0xf, true);
    x += __builtin_amdgcn_update_dpp(0, x, 0x141, 0xf, 0xf, true);
    x += __builtin_amdgcn_update_dpp(0, x, 0x140, 0xf, 0xf, true);
    x += __builtin_amdgcn_update_dpp(0, x, 0x142, 0xa, 0xf, true);
    x += __builtin_amdgcn_update_dpp(0, x, 0x143, 0xc, 0xf, true);
    return (unsigned)__builtin_amdgcn_readlane(x, 63);
}
DI unsigned fkey(float v) { const unsigned u = __float_as_uint(v); return (u & 0x80000000u) ? ~u : (u | 0x80000000u); }
DI bf16x8 ld16(const void* p) { return *(const bf16x8*)p; }
DI bf16x8 zero8() { bf16x8 z = {0, 0, 0, 0, 0, 0, 0, 0}; return z; }


#define XB_TMO      128
#define XB_XCNT(j)  (256  + 64 * (j))
#define XB_XSUB(j)  (1280 + 64 * (j))
#define XB_XGEN(j)  (2304 + 64 * (j))
#define XB_TOP      3328
#define XB_TOPGEN   3392
#define XCD_BAR_WORDS 3456
#define XB_SPIN_CAP (1u << 22)
#define LAS __attribute__((address_space(3)))
DI unsigned xb_ld(unsigned* p)              { return __hip_atomic_load(p, __ATOMIC_RELAXED, __HIP_MEMORY_SCOPE_AGENT); }
DI unsigned xb_add(unsigned* p, unsigned v) { return __hip_atomic_fetch_add(p, v, __ATOMIC_RELAXED, __HIP_MEMORY_SCOPE_AGENT); }
DI unsigned xb_xcc_id() { return (unsigned)__builtin_amdgcn_s_getreg((3 << 11) | 20) & 0xFu; }
#define XB_SPIN(cond, bar) do { unsigned _sp = 0; while (cond) { __builtin_amdgcn_s_sleep(1); \
    if ((++_sp & 255u) == 0u) { if (xb_ld(&(bar)[XB_TMO])) break; if (_sp > XB_SPIN_CAP) { atomicAdd(&(bar)[XB_TMO], 1u); break; } } } } while (0)
struct XcdBarrier { unsigned* bar; unsigned x; volatile LAS unsigned* st; };
DI XcdBarrier xcd_barrier_post(unsigned* bar, volatile LAS unsigned* st) {
    XcdBarrier b; b.bar = bar; b.x = xb_xcc_id(); b.st = st;
    if (threadIdx.x == 0) (void)xb_add(&bar[XB_XCNT(b.x)], 1u);
    return b;
}
DI void xcd_barrier_complete(unsigned* bar, unsigned x, unsigned& nloc, unsigned& nx) {
    const unsigned G = gridDim.x * gridDim.y * gridDim.z;
    unsigned sum, cnt, mine, sp = 0u;
    for (;;) {
        sum = 0u; cnt = 0u; mine = 0u;
#pragma unroll
        for (unsigned j = 0; j < 16; ++j) { const unsigned c = xb_ld(&bar[XB_XCNT(j)]); sum += c; cnt += (c > 0u) ? 1u : 0u; mine = (j == x) ? c : mine; }
        if (sum == G) break;
        __builtin_amdgcn_s_sleep(1);
        if ((++sp & 255u) == 0u) { if (xb_ld(&bar[XB_TMO])) break; if (sp > XB_SPIN_CAP) { atomicAdd(&bar[XB_TMO], 1u); break; } }
    }
    nloc = mine > 0u ? mine : 1u; nx = cnt > 0u ? cnt : 1u;
}
DI void xcd_barrier(const XcdBarrier& b) {
    asm volatile("s_waitcnt vmcnt(0)" ::: "memory");
    __syncthreads();
    if (threadIdx.x == 0) {
        unsigned* bar = b.bar;
        __builtin_amdgcn_s_waitcnt(0);
        unsigned nloc = b.st[0], nx = b.st[1];
        if (nloc == 0u) { xcd_barrier_complete(bar, b.x, nloc, nx); b.st[0] = nloc; b.st[1] = nx; }
        const unsigned old = xb_add(&bar[XB_XSUB(b.x)], 1u);
        const unsigned gen = old / nloc;
        if (old + 1u == (gen + 1u) * nloc) {
            __builtin_amdgcn_fence(__ATOMIC_RELEASE, "agent");
            asm volatile("s_waitcnt vmcnt(0)" ::: "memory");
            const unsigned og = xb_add(&bar[XB_TOP], 1u);
            const unsigned tg = og / nx;
            if (og + 1u == (tg + 1u) * nx) xb_add(&bar[XB_TOPGEN], 1u);
            else XB_SPIN(xb_ld(&bar[XB_TOPGEN]) == tg, bar);
            __builtin_amdgcn_fence(__ATOMIC_ACQUIRE, "agent");
            xb_add(&bar[XB_XGEN(b.x)], 1u);
            asm volatile("s_waitcnt vmcnt(0)" ::: "memory");
        } else {
            XB_SPIN(xb_ld(&bar[XB_XGEN(b.x)]) == gen, bar);
            __builtin_amdgcn_fence(__ATOMIC_ACQUIRE, "agent");
            asm volatile("s_waitcnt vmcnt(0)" ::: "memory");
        }
    }
    __syncthreads();
}
typedef __attribute__((address_space(1))) unsigned char g_uc;
DI unsigned char* wsb(const Params& p) {
    const unsigned long long w = (unsigned long long)p.ws;
    unsigned lo = __builtin_amdgcn_readfirstlane((unsigned)w), hi = __builtin_amdgcn_readfirstlane((unsigned)(w >> 32));
    asm volatile("" : "+s"(lo), "+s"(hi));
    return (unsigned char*)(g_uc*)(((unsigned long long)hi << 32) | lo);
}
DI int opq_tid() { int t = (int)threadIdx.x; asm volatile("" : "+v"(t)); return t; }
DI int q_next(unsigned* ctr, volatile int* slot) {
    __syncthreads();
    if (threadIdx.x == 0) *slot = (int)__hip_atomic_fetch_add(ctr, 1u, __ATOMIC_RELAXED, __HIP_MEMORY_SCOPE_AGENT);
    __syncthreads();
    return *slot;
}

DI void it_mod(const Params& p, int vb, unsigned char* sm) {
    float (*ca)[1024] = (float (*)[1024])sm;
    const float* c = p.in[1];
    __syncthreads();
    for (int i = opq_tid(); i < 4096; i += 256) { const float v = c[i]; ca[i >> 10][i & 1023] = v / (1.f + __expf(-v)); }
    __syncthreads();
    const int idx = vb * 256 + opq_tid();
    const int l = idx / 6144, n = idx % 6144;
    const float* w = p.in[4] + (size_t)l * 1024 * 6144 + n;
    float a0 = 0, a1 = 0, a2 = 0, a3 = 0;
#pragma unroll 8
    for (int k = 0; k < 1024; ++k) { const float wv = w[(size_t)k * 6144]; a0 += ca[0][k] * wv; a1 += ca[1][k] * wv; a2 += ca[2][k] * wv; a3 += ca[3][k] * wv; }
    const float bm = p.in[5][l * 6144 + n];
    float* mod = (float*)(wsb(p) + WS_MOD) + (size_t)l * 4 * 6144 + n;
    mod[0] = a0 + bm; mod[6144] = a1 + bm; mod[2 * 6144] = a2 + bm; mod[3 * 6144] = a3 + bm;
}

struct TrArgs { const float* src; int lds, coff, nvalid; bf16* dst; int ldd, doff; int K, N; int mode; const float* aux; };
DI void it_transpose(const TrArgs& a, int vb, unsigned char* sm) {
    float (*t)[33] = (float (*)[33])sm;
    const int nk = a.K / 32;
    const int kt = vb % nk, nt = vb / nk;
    const int tx = opq_tid() & 31, ty = opq_tid() >> 5;
    __syncthreads();
    for (int r = ty; r < 32; r += 8) {
        const int k = kt * 32 + r, n = nt * 32 + tx;
        float v;
        if (a.mode == 0) v = (n + a.coff < a.nvalid) ? a.src[(size_t)k * a.lds + n + a.coff] : 0.f;
        else if (a.mode == 1) {
            const int h = n >> 7, rr = n & 127; const float* wi = a.src + (size_t)k * a.lds + 768 + 64 * h; const float* uk = a.aux + (size_t)h * 64 * 128 + rr;
            float s = 0; for (int d = 0; d < 64; ++d) s += wi[d] * uk[d * 128]; v = s * 0.125f;
        } else {
            const int h = k >> 7, rr = k & 127; const float* uv = a.aux + ((size_t)h * 128 + rr) * 64; const float* wo = a.src + (size_t)(512 + 64 * h) * a.lds + n;
            float s = 0; for (int d = 0; d < 64; ++d) s += uv[d] * wo[(size_t)d * a.lds]; v = s;
        }
        t[r][tx] = v;
    }
    __syncthreads();
    for (int r = ty; r < 32; r += 8) {
        const int n = nt * 32 + r, k = kt * 32 + tx;
        a.dst[(size_t)n * a.ldd + a.doff + k] = f2bf(t[tx][r]);
    }
}
DI void conv_chunk(const float* __restrict__ src, bf16* __restrict__ dst, size_t i0, int n8) {
    for (int i = opq_tid(); i < n8; i += 256) {
        const float4 a = ((const float4*)src)[2 * (i0 + i)], b = ((const float4*)src)[2 * (i0 + i) + 1];
        u32x4 o; o.x = cvt_pk_bf16(a.x, a.y); o.y = cvt_pk_bf16(a.z, a.w); o.z = cvt_pk_bf16(b.x, b.y); o.w = cvt_pk_bf16(b.z, b.w);
        ((u32x4*)dst)[i0 + i] = o;
    }
}
DI void it_gw(const Params& p, int vb) {
    for (int e = 0; e < 4; ++e) {
        const int idx = vb * 1024 + e * 256 + opq_tid();
        const int s = idx & 127, t = (idx >> 7) & 127;
        const float v = (t >= 64 || s < 64) ? p.in[17][idx] : 0.f;
        ((bf16*)(wsb(p) + WS_GW))[idx] = f2bf(v);
    }
}
DI void it_ssm_pw(const Params& p, int vb) {
    const int idx = vb * 256 + opq_tid();
    const int pp = idx & 63, g = (idx >> 6) & 15, l = idx >> 10;
    const float lre = -__expf(p.in[7][idx]), lim = p.in[8][idx];
    const float dt = __expf(p.in[14][l * 16 + g]);
    float* pw = (float*)(wsb(p) + WS_PW) + ((size_t)(l * 16 + g) * 65) * 128;
    for (int d = 0; d <= 64; ++d) {
        const float mag = expf(lre * dt * (float)d); float sn, cs; sincosf(lim * dt * (float)d, &sn, &cs);
        pw[d * 128 + pp * 2] = mag * cs; pw[d * 128 + pp * 2 + 1] = mag * sn;
    }
    const float mag = expf(lre * dt); float sn, cs; sincosf(lim * dt, &sn, &cs);
    const float are = mag * cs, aim = mag * sn;
    const float den = lre * lre + lim * lim, P = are - 1.f, Q = aim;
    const float fre = (P * lre + Q * lim) / den, fim = (Q * lre - P * lim) / den;
    float* bb = (float*)(wsb(p) + WS_BB) + (size_t)idx * 32;
    for (int h = 0; h < 16; ++h) { const float br = p.in[9][(size_t)idx * 16 + h], bi = p.in[10][(size_t)idx * 16 + h]; bb[h * 2] = fre * br - fim * bi; bb[h * 2 + 1] = fre * bi + fim * br; }
}
DI void ssm_tab_entry(const Params& p, size_t idx) {
    const size_t NE = (size_t)2 * 16 * 128 * 1024;
    const float* PW = (const float*)(wsb(p) + WS_PW); const float* BB = (const float*)(wsb(p) + WS_BB);
    if (idx < NE) {
        const int kk = idx & 1023, pp = (idx >> 10) & 127; const int lg = (int)(idx >> 17);
        const int i = kk >> 4, hh = kk & 15, pq = pp & 63, part = pp >> 6;
        const float* pw = PW + ((size_t)lg * 65 + (63 - i)) * 128 + pq * 2; const float* bb = BB + ((size_t)lg * 64 + pq) * 32 + hh * 2;
        const float v = part ? (pw[0] * bb[1] + pw[1] * bb[0]) : (pw[0] * bb[0] - pw[1] * bb[1]);
        ((bf16*)(wsb(p) + WS_E))[idx] = f2bf(v);
    } else if (idx < 2 * NE) {
        const size_t e = idx - NE; const int pp = e & 127, jh = (e >> 7) & 1023; const int lg = (int)(e >> 17);
        const int j = jh >> 4, h = jh & 15, pq = pp & 63, part = pp >> 6;
        const float* pw = PW + ((size_t)lg * 65 + (j + 1)) * 128 + pq * 2;
        const float cr = p.in[11][((size_t)lg * 16 + h) * 64 + pq], ci = p.in[12][((size_t)lg * 16 + h) * 64 + pq];
        const float v = part ? -(cr * pw[1] + ci * pw[0]) : (cr * pw[0] - ci * pw[1]);
        ((bf16*)(wsb(p) + WS_G))[e] = f2bf(v);
    } else {
        const size_t e = idx - 2 * NE; if (e >= (size_t)2 * 16 * 64 * 256) return;
        const int hh = e & 15, h = (e >> 4) & 15, d = (e >> 8) & 63; const int lg = (int)(e >> 14);
        const float* pw = PW + ((size_t)lg * 65 + d) * 128; const float* bb = BB + (size_t)lg * 64 * 32 + hh * 2;
        const float* cr = p.in[11] + ((size_t)lg * 16 + h) * 64; const float* ci = p.in[12] + ((size_t)lg * 16 + h) * 64;
        float s = 0;
        for (int q = 0; q < 64; ++q) { const float zr = pw[q * 2] * bb[q * 32] - pw[q * 2 + 1] * bb[q * 32 + 1], zi = pw[q * 2] * bb[q * 32 + 1] + pw[q * 2 + 1] * bb[q * 32]; s += cr[q] * zr - ci[q] * zi; }
        ((bf16*)(wsb(p) + WS_KT))[e] = f2bf(s);
    }
}
DI void norm_mod_row(const float* __restrict__ xrow, const float* __restrict__ g, const float* __restrict__ sh, const float* __restrict__ sc, bf16* __restrict__ hrow, int lane) {
    float4 v[4]; float ss = 0;
#pragma unroll
    for (int j = 0; j < 4; ++j) { v[j] = *(const float4*)(xrow + 4 * lane + 256 * j); ss += v[j].x * v[j].x + v[j].y * v[j].y + v[j].z * v[j].z + v[j].w * v[j].w; }
    ss = wave_sum(ss);
    const float r = rsqrtf(ss * (1.f / 1024.f) + 1e-6f);
#pragma unroll
    for (int j = 0; j < 4; ++j) {
        const int c = 4 * lane + 256 * j;
        const float4 gg = *(const float4*)(g + c), s1 = *(const float4*)(sc + c), s0 = *(const float4*)(sh + c);
        u32x2 o; o.x = cvt_pk_bf16(v[j].x * r * gg.x * (1.f + s1.x) + s0.x, v[j].y * r * gg.y * (1.f + s1.y) + s0.y);
        o.y = cvt_pk_bf16(v[j].z * r * gg.z * (1.f + s1.z) + s0.z, v[j].w * r * gg.w * (1.f + s1.w) + s0.w);
        *(u32x2*)(hrow + c) = o;
    }
}
constexpr int GP = 72;
template <class Epi>
DI void gemm_tile(const bf16* __restrict__ A, int lda, const bf16* __restrict__ Bt, int ldb, int K, int m0, int n0, bf16* lds, const Epi& epi) {
    bf16* As = lds; bf16* Bs = lds + 128 * GP;
    const int tid = opq_tid(), lane = tid & 63, wave = tid >> 6, wm = wave >> 1, wn = wave & 1;
    const int fr = lane & 15, fq = lane >> 4;
    const int lrow = tid >> 3, lch = tid & 7;
    f32x4 acc[4][4];
#pragma unroll
    for (int i = 0; i < 4; ++i)
#pragma unroll
        for (int j = 0; j < 4; ++j) acc[i][j] = (f32x4){0.f, 0.f, 0.f, 0.f};
    bf16x8 ra[4], rb[4];
    const bf16* Ag = A + (size_t)(m0 + lrow) * lda + lch * 8;
    const bf16* Bg = Bt + (size_t)(n0 + lrow) * ldb + lch * 8;
#pragma unroll
    for (int i = 0; i < 4; ++i) { ra[i] = ld16(Ag + (size_t)32 * i * lda); rb[i] = ld16(Bg + (size_t)32 * i * ldb); }
    const int nk = K / 64;
    for (int kt = 0; kt < nk; ++kt) {
        __syncthreads();
#pragma unroll
        for (int i = 0; i < 4; ++i) { *(bf16x8*)(As + (lrow + 32 * i) * GP + lch * 8) = ra[i]; *(bf16x8*)(Bs + (lrow + 32 * i) * GP + lch * 8) = rb[i]; }
        __syncthreads();
        if (kt + 1 < nk) {
#pragma unroll
            for (int i = 0; i < 4; ++i) { ra[i] = ld16(Ag + (size_t)32 * i * lda + (kt + 1) * 64); rb[i] = ld16(Bg + (size_t)32 * i * ldb + (kt + 1) * 64); }
        }
#pragma unroll
        for (int ks = 0; ks < 2; ++ks) {
            bf16x8 fa[4], fb[4];
#pragma unroll
            for (int i = 0; i < 4; ++i) { fa[i] = ld16(Bs + (64 * wn + 16 * i + fr) * GP + 32 * ks + 8 * fq); fb[i] = ld16(As + (64 * wm + 16 * i + fr) * GP + 32 * ks + 8 * fq); }
#pragma unroll
            for (int i = 0; i < 4; ++i)
#pragma unroll
                for (int j = 0; j < 4; ++j) acc[i][j] = MFMA16(fa[i], fb[j], acc[i][j]);
        }
    }
#pragma unroll
    for (int i = 0; i < 4; ++i)
#pragma unroll
        for (int j = 0; j < 4; ++j) epi(m0 + 64 * wm + 16 * j + fr, n0 + 64 * wn + 16 * i + 4 * fq, acc[i][j]);
}
struct EpiBf16 { bf16* C; int ldc; DI void operator()(int r, int c, f32x4 v) const { u32x2 o; o.x = cvt_pk_bf16(v[0], v[1]); o.y = cvt_pk_bf16(v[2], v[3]); *(u32x2*)(C + (size_t)r * ldc + c) = o; } };
struct EpiResid { const float* xin; float* xout; const float* gate;
    DI void operator()(int r, int c, f32x4 v) const { const float4 x = *(const float4*)(xin + (size_t)r * 1024 + c); const float4 g = *(const float4*)(gate + (size_t)(r >> 12) * 6144 + c);
        float4 o; o.x = x.x + g.x * v[0]; o.y = x.y + g.y * v[1]; o.z = x.z + g.z * v[2]; o.w = x.w + g.w * v[3]; *(float4*)(xout + (size_t)r * 1024 + c) = o; } };
struct EpiGlu { const bf16* yg; const float* bglu; bf16* mix;
    DI void operator()(int r, int c, f32x4 v) const { const u32x2 y = *(const u32x2*)(yg + (size_t)r * 256 + c); const float4 b = *(const float4*)(bglu + c);
        u32x2 o; o.x = cvt_pk_bf16(bflo(y.x) * sigmoidf(v[0] + b.x), bfhi(y.x) * sigmoidf(v[1] + b.y)); o.y = cvt_pk_bf16(bflo(y.y) * sigmoidf(v[2] + b.z), bfhi(y.y) * sigmoidf(v[3] + b.w));
        *(u32x2*)(mix + (size_t)r * KMIX + c) = o; } };

DI unsigned off_b(unsigned row, unsigned ch) { return 256u * row + 16u * (ch ^ (((row & 3u) << 2) | ((row >> 2) & 3u))); }
#define TR8(o0, o1, o2, o3, o4, o5, o6, o7, a0, a1, a2, a3, a4, a5, a6, a7)                                                                         \
    asm volatile("s_waitcnt lgkmcnt(0)\n\t"                                                                                                         \
                 "ds_read_b64_tr_b16 %0, %8\n\tds_read_b64_tr_b16 %1, %9\n\tds_read_b64_tr_b16 %2, %10\n\tds_read_b64_tr_b16 %3, %11\n\t"           \
                 "ds_read_b64_tr_b16 %4, %12\n\tds_read_b64_tr_b16 %5, %13\n\tds_read_b64_tr_b16 %6, %14\n\tds_read_b64_tr_b16 %7, %15\n\t"         \
                 "s_waitcnt lgkmcnt(0)"                                                                                                             \
                 : "=&v"(o0), "=&v"(o1), "=&v"(o2), "=&v"(o3), "=&v"(o4), "=&v"(o5), "=&v"(o6), "=&v"(o7)                                           \
                 : "v"(a0), "v"(a1), "v"(a2), "v"(a3), "v"(a4), "v"(a5), "v"(a6), "v"(a7)                                                           \
                 : "memory")

DI void it_kvn(const Params& p, int l, int vb) {
    const int lane = opq_tid() & 63, wave = opq_tid() >> 6;
    const bf16* proj = (const bf16*)(wsb(p) + WS_PROJ); bf16* kvn = (bf16*)(wsb(p) + WS_KVN);
    const float g0 = p.in[19][l * 128 + 2 * lane], g1 = p.in[19][l * 128 + 2 * lane + 1];
    for (int i = 0; i < 16; ++i) {
        const int row = vb * 64 + i * 4 + wave;
        const unsigned u = *(const unsigned*)(proj + (size_t)row * NPROJ + C_CKV + 2 * lane);
        const float a = bflo(u), b = bfhi(u);
        const float ss = wave_sum(a * a + b * b);
        const float r = rsqrtf(ss * (1.f / 128.f) + 1e-6f);
        *(unsigned*)(kvn + (size_t)row * 128 + 2 * lane) = cvt_pk_bf16(a * r * g0, b * r * g1);
    }
}

DI void it_ssm_a(const Params& p, int l, int item) {
    const int lane = opq_tid() & 63, wave = opq_tid() >> 6, fr = lane & 15, fq = lane >> 4;
    const bf16* proj = (const bf16*)(wsb(p) + WS_PROJ);
    float* sloc = (float*)(wsb(p) + WS_SLOC);
    const int g = item & 15, rt = item >> 4;
    const bf16* E = (const bf16*)(wsb(p) + WS_E) + ((size_t)(l * 16 + g) * 128) * 1024;
    const int R = 16 * rt + fr, b = R >> 6, k = R & 63;
    const bf16* arow = proj + ((size_t)b * 4096 + 64 * k + (fq >> 1)) * NPROJ + C_UA + 16 * g + 8 * (fq & 1);
    f32x4 acc[2] = {(f32x4){0, 0, 0, 0}, (f32x4){0, 0, 0, 0}};
#pragma unroll 4
    for (int ks = 0; ks < 32; ++ks) {
        const bf16x8 a = ld16(arow + (size_t)(2 * ks) * NPROJ);
#pragma unroll
        for (int c = 0; c < 2; ++c) { const int ct = 2 * wave + c; const bf16x8 bf = ld16(E + (size_t)(16 * ct + fr) * 1024 + 32 * ks + 8 * fq); acc[c] = MFMA16(a, bf, acc[c]); }
    }
#pragma unroll
    for (int c = 0; c < 2; ++c)
#pragma unroll
        for (int i = 0; i < 4; ++i) sloc[((size_t)(16 * rt + 4 * fq + i) * 16 + g) * 128 + 16 * (2 * wave + c) + fr] = acc[c][i];
}

DI void it_ssm_c(const Params& p, int l, int item, unsigned char* sm) {
    bf16* sst = (bf16*)sm;
    bf16* ktl = (bf16*)(sm + 17408);
    const int tid = opq_tid(), lane = tid & 63, wave = tid >> 6, fr = lane & 15, fq = lane >> 4;
    const bf16* proj = (const bf16*)(wsb(p) + WS_PROJ);
    const float* sloc = (const float*)(wsb(p) + WS_SLOC);
    bf16* yg = (bf16*)(wsb(p) + WS_YG);
    const int jq = item & 3, g = (item >> 2) & 15, b = item >> 6;
    const bf16* KT = (const bf16*)(wsb(p) + WS_KT) + (size_t)(l * 16 + g) * 64 * 256;
    __syncthreads();
#pragma unroll
    for (int i = 0; i < 8; ++i) *(bf16x8*)(ktl + (i * 256 + tid) * 8) = ld16(KT + (size_t)(i * 256 + tid) * 8);
    if (wave == 0) {
        const float* pw64 = (const float*)(wsb(p) + WS_PW) + ((size_t)(l * 16 + g) * 65 + 64) * 128 + lane * 2;
        const float ar = pw64[0], ai = pw64[1];
        float sr = 0, si = 0;
        const float* s = sloc + ((size_t)(b * 64) * 16 + g) * 128;
#pragma unroll 8
        for (int k = 0; k < 64; ++k) {
            sst[k * 136 + lane] = f2bf(sr); sst[k * 136 + 64 + lane] = f2bf(si);
            const float lr = s[(size_t)k * 2048 + lane], li = s[(size_t)k * 2048 + 64 + lane];
            const float nr = ar * sr - ai * si + lr, ni = ar * si + ai * sr + li;
            sr = nr; si = ni;
        }
    }
    __syncthreads();
    const bf16* G = (const bf16*)(wsb(p) + WS_G) + (size_t)(l * 16 + g) * 1024 * 128;
    const int kch = 16 * wave + fr;
    const bf16* arow = proj + ((size_t)b * 4096 + 64 * kch + (fq >> 1)) * NPROJ + C_UA + 16 * g + 8 * (fq & 1);
    const int j0 = 16 * jq;
    f32x4 acc[16];
#pragma unroll
    for (int jj = 0; jj < 16; ++jj) acc[jj] = (f32x4){0, 0, 0, 0};
    const int nks = (j0 + 15) / 2 + 1;
    bf16x8 a_cur = ld16(arow);
    for (int ks = 0; ks < nks; ++ks) {
        const bf16x8 a_nxt = (ks + 1 < nks) ? ld16(arow + (size_t)(2 * ks + 2) * NPROJ) : zero8();
#pragma unroll
        for (int jj = 0; jj < 16; ++jj) {
            const int j = j0 + jj;
            if (2 * ks <= j) {
                const int d = j - 2 * ks - (fq >> 1);
                const bf16x8 bl = ld16(ktl + ((d < 0 ? 0 : d) * 16 + fr) * 16 + 8 * (fq & 1));
                const bf16x8 bf = d >= 0 ? bl : zero8();
                acc[jj] = MFMA16(a_cur, bf, acc[jj]);
            }
        }
        a_cur = a_nxt;
    }
#pragma unroll
    for (int ks = 0; ks < 4; ++ks) {
        const bf16x8 a = ld16(sst + kch * 136 + 32 * ks + 8 * fq);
        bf16x8 bfr[16];
#pragma unroll
        for (int jj = 0; jj < 16; ++jj) bfr[jj] = ld16(G + ((size_t)((j0 + jj) * 16 + fr)) * 128 + 32 * ks + 8 * fq);
#pragma unroll
        for (int jj = 0; jj < 16; ++jj) acc[jj] = MFMA16(a, bfr[jj], acc[jj]);
    }
    const float dsk = p.in[13][l * 256 + 16 * g + fr];
#pragma unroll
    for (int jj = 0; jj < 16; ++jj) {
#pragma unroll
        for (int i = 0; i < 4; ++i) {
            const size_t tok = (size_t)b * 4096 + 64 * (16 * wave + 4 * fq + i) + j0 + jj;
            const float u = bf2f(proj[tok * NPROJ + C_UA + 16 * g + fr]);
            yg[tok * 256 + 16 * g + fr] = f2bf(gelu_tanh(acc[jj][i] + dsk * u));
        }
    }
}

DI void it_gmlp(const Params& p, int l, int item, unsigned char* sm) {
    bf16* vnT = (bf16*)sm;
    const int tid = opq_tid(), lane = tid & 63, wave = tid >> 6, fr = lane & 15, fq = lane >> 4;
    const bf16* proj = (const bf16*)(wsb(p) + WS_PROJ); bf16* mix = (bf16*)(wsb(p) + WS_MIX);
    const int h = item & 3, blk = item >> 2;
    const size_t tok0 = (size_t)blk * 128;
    __syncthreads();
    {
        const int row = tid >> 1, half = tid & 1;
        const bf16* vp = proj + (tok0 + row) * NPROJ + C_VB + 64 * h + 32 * half;
        float v[32]; float s = 0;
#pragma unroll
        for (int q = 0; q < 4; ++q) { const bf16x8 t = ld16(vp + 8 * q);
#pragma unroll
            for (int e = 0; e < 8; ++e) { v[8 * q + e] = bf2f((bf16)t[e]); s += v[8 * q + e]; } }
        s += __shfl_xor(s, 1); const float mu = s * (1.f / 64.f);
        float vs = 0;
#pragma unroll
        for (int e = 0; e < 32; ++e) { const float d = v[e] - mu; vs += d * d; }
        vs += __shfl_xor(vs, 1); const float r = rsqrtf(vs * (1.f / 64.f) + 1e-6f);
#pragma unroll
        for (int e = 0; e < 32; ++e) vnT[(32 * half + e) * 136 + row] = f2bf((v[e] - mu) * r);
    }
    __syncthreads();
    const bf16* W = (const bf16*)(wsb(p) + WS_GW) + (size_t)(l * 4 + h) * 128 * 128;
    f32x4 acc[4][2];
#pragma unroll
    for (int i = 0; i < 4; ++i) { acc[i][0] = (f32x4){0, 0, 0, 0}; acc[i][1] = (f32x4){0, 0, 0, 0}; }
#pragma unroll
    for (int ks = 0; ks < 4; ++ks) {
        bf16x8 fa[4], fb[2];
#pragma unroll
        for (int i = 0; i < 4; ++i) fa[i] = ld16(vnT + (16 * i + fr) * 136 + 32 * ks + 8 * fq);
#pragma unroll
        for (int j = 0; j < 2; ++j) fb[j] = ld16(W + (size_t)(16 * (2 * wave + j) + fr) * 128 + 32 * ks + 8 * fq);
#pragma unroll
        for (int i = 0; i < 4; ++i)
#pragma unroll
            for (int j = 0; j < 2; ++j) acc[i][j] = MFMA16(fa[i], fb[j], acc[i][j]);
    }
#pragma unroll
    for (int j = 0; j < 2; ++j) {
        const int t = 16 * (2 * wave + j) + fr;
        const float bs = p.in[18][(l * 4 + h) * 128 + t];
#pragma unroll
        for (int i = 0; i < 4; ++i) {
            const int d = 16 * i + 4 * fq;
            const u32x2 u = *(const u32x2*)(proj + (tok0 + t) * NPROJ + C_UB + 64 * h + d);
            u32x2 o; o.x = cvt_pk_bf16(bflo(u.x) * (acc[i][j][0] + bs), bfhi(u.x) * (acc[i][j][1] + bs)); o.y = cvt_pk_bf16(bflo(u.y) * (acc[i][j][2] + bs), bfhi(u.y) * (acc[i][j][3] + bs));
            *(u32x2*)(mix + (tok0 + t) * KMIX + 256 + 64 * h + d) = o;
        }
    }
}

DI size_t score_row_off(int b, int t) { const int c = t >> 6; return (size_t)b * SCORES_PER_BATCH + (size_t)4096 * (c * (c + 1) / 2) + (size_t)(t & 63) * 64 * (c + 1); }
template <int NR>
DI void dsa_select_impl(const float* __restrict__ srow, int nreg, bf16* __restrict__ so, int lane) {
    unsigned key[NR];
#pragma unroll
    for (int r = 0; r < NR; ++r) { const float v = srow[64 * r + lane]; key[r] = (r < nreg) ? fkey(v) : 0u; }
    unsigned T = 0;
    for (int bit = 31; bit >= 0; --bit) {
        const unsigned cand = T | (1u << bit);
        unsigned c = 0;
#pragma unroll
        for (int r = 0; r < NR; ++r) c += (key[r] >= cand) ? 1u : 0u;
        const unsigned cnt = wave_sum_u32(c);
        if (cnt >= 256u) { T = cand; if (cnt == 256u) break; }
    }
    unsigned c = 0;
#pragma unroll
    for (int r = 0; r < NR; ++r) c += (key[r] > T) ? 1u : 0u;
    const int need = 256 - (int)wave_sum_u32(c);
    int base = 0, eqb = 0;
    const unsigned long long lt = (1ull << lane) - 1ull;
#pragma unroll
    for (int r = 0; r < NR; ++r) {
        const unsigned long long me = __ballot(key[r] == T);
        const int erank = eqb + __popcll(me & lt);
        const bool take = (key[r] > T) || (key[r] == T && erank < need);
        const unsigned long long mt = __ballot(take);
        if (take) so[base + __popcll(mt & lt)] = (bf16)(64 * r + lane);
        base += __popcll(mt); eqb += __popcll(me);
    }
}
DI void dsa_select_query(const Params& p, int q, int lane) {
    const float* scores = (const float*)(wsb(p) + WS_SCORES); bf16* sel = (bf16*)(wsb(p) + WS_SEL);
    const int b = q >> 12, t = q & 4095, c = t >> 6, nreg = c + 1;
    bf16* so = sel + (size_t)q * 256;
    if (nreg <= 4) { for (int r = 0; r < nreg; ++r) so[64 * r + lane] = (bf16)(64 * r + lane); return; }
    const float* srow = scores + score_row_off(b, t);
    if (nreg <= 16) dsa_select_impl<16>(srow, nreg, so, lane);
    else if (nreg <= 32) dsa_select_impl<32>(srow, nreg, so, lane);
    else if (nreg <= 48) dsa_select_impl<48>(srow, nreg, so, lane);
    else dsa_select_impl<64>(srow, nreg, so, lane);
}
DI void it_dsa_index_select(const Params& p, int item) {
    const int lane = opq_tid() & 63, wave = opq_tid() >> 6, fr = lane & 15, fq = lane >> 4;
    const bf16* proj = (const bf16*)(wsb(p) + WS_PROJ); float* scores = (float*)(wsb(p) + WS_SCORES);
    const int c = 63 - (item >> 4), b = (item >> 2) & 3, qg = item & 3;
    if (c >= 4) {
        const int t = 64 * c + 16 * qg + fr;
        const bf16* qrow = proj + ((size_t)b * 4096 + t) * NPROJ;
        bf16x8 qf[4][2];
#pragma unroll
        for (int hh = 0; hh < 4; ++hh)
#pragma unroll
            for (int ks = 0; ks < 2; ++ks) qf[hh][ks] = ld16(qrow + C_QI + 64 * hh + 32 * ks + 8 * fq);
        float w[4];
        { const u32x2 wv = *(const u32x2*)(qrow + C_WI); w[0] = bflo(wv.x) * 0.0625f; w[1] = bfhi(wv.x) * 0.0625f; w[2] = bflo(wv.y) * 0.0625f; w[3] = bfhi(wv.y) * 0.0625f; }
        float* srow = scores + score_row_off(b, t);
        const int ntile = 4 * (c + 1);
        const bf16* kbase = proj + ((size_t)b * 4096 + fr) * NPROJ + C_KI + 8 * fq;
        bf16x8 k0[4], k1[4];
#pragma unroll
        for (int u = 0; u < 4; ++u) { const bf16* krow = kbase + (size_t)16 * (wave + 4 * u) * NPROJ; k0[u] = ld16(krow); k1[u] = ld16(krow + 32); }
        for (int base = wave; base < ntile; base += 16) {
            bf16x8 n0[4], n1[4];
            const bool more = base + 16 < ntile;
            if (more) {
#pragma unroll
                for (int u = 0; u < 4; ++u) { const bf16* krow = kbase + (size_t)16 * (base + 16 + 4 * u) * NPROJ; n0[u] = ld16(krow); n1[u] = ld16(krow + 32); }
            }
#pragma unroll
            for (int u = 0; u < 4; ++u) {
                const int kt = base + 4 * u;
                if (kt >= ntile) break;
                f32x4 sc = {0, 0, 0, 0};
#pragma unroll
                for (int hh = 0; hh < 4; ++hh) {
                    f32x4 a = {0, 0, 0, 0};
                    a = MFMA16(k0[u], qf[hh][0], a); a = MFMA16(k1[u], qf[hh][1], a);
#pragma unroll
                    for (int i = 0; i < 4; ++i) sc[i] += w[hh] * fmaxf(a[i], 0.f);
                }
#pragma unroll
                for (int i = 0; i < 4; ++i) sc[i] += 0.f;
                *(f32x4*)(srow + 16 * kt + 4 * fq) = sc;
            }
            if (more) {
#pragma unroll
                for (int u = 0; u < 4; ++u) { k0[u] = n0[u]; k1[u] = n1[u]; }
            }
        }
        asm volatile("s_waitcnt vmcnt(0)" ::: "memory");
    }
    __syncthreads();
    for (int i = 0; i < 4; ++i) dsa_select_query(p, b * 4096 + 64 * c + 16 * qg + 4 * wave + i, lane);
}
DI void it_dsa_attn(const Params& p, int item, unsigned char* sm) {
    const int lane = opq_tid() & 63, wave = opq_tid() >> 6, fr = lane & 15, fq = lane >> 4;
    unsigned char* tile = sm + wave * 8192;
    bf16* selw = (bf16*)(sm + 32768 + wave * 512);
    const bf16* proj = (const bf16*)(wsb(p) + WS_PROJ); const bf16* kvn = (const bf16*)(wsb(p) + WS_KVN);
    const bf16* sel = (const bf16*)(wsb(p) + WS_SEL); bf16* mix = (bf16*)(wsb(p) + WS_MIX);
    unsigned wr_addr[8], rd_addr[2][4], tr_addr[8][2];
#pragma unroll
    for (int i = 0; i < 8; ++i) wr_addr[i] = off_b(4 * i + fq, fr);
#pragma unroll
    for (int rb = 0; rb < 2; ++rb)
#pragma unroll
        for (int s = 0; s < 4; ++s) rd_addr[rb][s] = off_b(8 * (fr >> 2) + 4 * rb + (fr & 3), 4 * s + fq);
    const unsigned tbase = (unsigned)(size_t)tile;
    {
        const unsigned q4 = fr >> 2, p4 = fr & 3;
#pragma unroll
        for (int c = 0; c < 8; ++c)
#pragma unroll
            for (int t = 0; t < 2; ++t) tr_addr[c][t] = tbase + off_b(8 * fq + 4 * t + q4, 2 * c + (p4 >> 1)) + 8 * (p4 & 1);
    }
    const float slope = fr < 8 ? exp2f(-(float)(fr + 1)) : 0.f;
    for (int qi = 0; qi < 4; ++qi) {
        const int q = item * 16 + wave * 4 + qi;
        const int b = q >> 12, t = q & 4095, c = t >> 6;
        const int nsel = (c + 1) * 64 < 256 ? (c + 1) * 64 : 256;
        const bf16* qa = proj + (size_t)q * NPROJ + C_QA;
        bf16x8 qf[4];
#pragma unroll
        for (int s = 0; s < 4; ++s) qf[s] = fr < 8 ? ld16(qa + fr * 128 + 32 * s + 8 * fq) : zero8();
        const bf16* selp = sel + (size_t)q * 256;
        const bf16* kvb = kvn + (size_t)b * 4096 * 128;
        if (4 * lane < nsel) *(u32x2*)(selw + 4 * lane) = *(const u32x2*)(selp + 4 * lane);
        float m_run = -INFINITY, l_run = 0.f;
        f32x4 o[8];
#pragma unroll
        for (int i = 0; i < 8; ++i) o[i] = (f32x4){0, 0, 0, 0};
        bf16x8 gk[8];
#pragma unroll
        for (int i = 0; i < 8; ++i) { const int key = selw[4 * i + fq]; gk[i] = ld16(kvb + (size_t)key * 128 + 8 * fr); }
        const int nt = nsel / 32;
        for (int ti = 0; ti < nt; ++ti) {
            const bf16x8 kp = ld16(selw + 32 * ti + 8 * fq);
#pragma unroll
            for (int i = 0; i < 8; ++i) *(bf16x8*)(tile + wr_addr[i]) = gk[i];
            if (ti + 1 < nt) {
#pragma unroll
                for (int i = 0; i < 8; ++i) { const int key = selw[32 * (ti + 1) + 4 * i + fq]; gk[i] = ld16(kvb + (size_t)key * 128 + 8 * fr); }
            }
            f32x4 lg[2] = {(f32x4){0, 0, 0, 0}, (f32x4){0, 0, 0, 0}};
#pragma unroll
            for (int rb = 0; rb < 2; ++rb)
#pragma unroll
                for (int s = 0; s < 4; ++s) lg[rb] = MFMA16(ld16(tile + rd_addr[rb][s]), qf[s], lg[rb]);
            float val[8]; float tmax = -INFINITY;
#pragma unroll
            for (int j = 0; j < 8; ++j) { const float dist = fabsf((float)(t - (int)(unsigned short)kp[j])); val[j] = lg[j >> 2][j & 3] - slope * dist; tmax = fmaxf(tmax, val[j]); }
            tmax = fmaxf(tmax, __shfl_xor(tmax, 16)); tmax = fmaxf(tmax, __shfl_xor(tmax, 32));
            const float m_new = fmaxf(m_run, tmax);
            const float scale = __expf(m_run - m_new);
            l_run *= scale;
#pragma unroll
            for (int i = 0; i < 8; ++i) o[i] *= scale;
            float pv[8];
#pragma unroll
            for (int j = 0; j < 8; ++j) { pv[j] = __expf(val[j] - m_new); l_run += pv[j]; }
            m_run = m_new;
            u32x4 pk; pk.x = cvt_pk_bf16(pv[0], pv[1]); pk.y = cvt_pk_bf16(pv[2], pv[3]); pk.z = cvt_pk_bf16(pv[4], pv[5]); pk.w = cvt_pk_bf16(pv[6], pv[7]);
            const bf16x8 pf = __builtin_bit_cast(bf16x8, pk);
            s16x4 tr[8][2];
            TR8(tr[0][0], tr[0][1], tr[1][0], tr[1][1], tr[2][0], tr[2][1], tr[3][0], tr[3][1], tr_addr[0][0], tr_addr[0][1], tr_addr[1][0], tr_addr[1][1], tr_addr[2][0], tr_addr[2][1], tr_addr[3][0], tr_addr[3][1]);
            TR8(tr[4][0], tr[4][1], tr[5][0], tr[5][1], tr[6][0], tr[6][1], tr[7][0], tr[7][1], tr_addr[4][0], tr_addr[4][1], tr_addr[5][0], tr_addr[5][1], tr_addr[6][0], tr_addr[6][1], tr_addr[7][0], tr_addr[7][1]);
#pragma unroll
            for (int cc = 0; cc < 8; ++cc) {
                bf16x8 kf; kf[0] = tr[cc][0][0]; kf[1] = tr[cc][0][1]; kf[2] = tr[cc][0][2]; kf[3] = tr[cc][0][3]; kf[4] = tr[cc][1][0]; kf[5] = tr[cc][1][1]; kf[6] = tr[cc][1][2]; kf[7] = tr[cc][1][3];
                o[cc] = MFMA16(kf, pf, o[cc]);
            }
        }
        float lt = l_run; lt += __shfl_xor(lt, 16); lt += __shfl_xor(lt, 32);
        const float inv = 1.f / lt;
        if (fr < 8) {
#pragma unroll
            for (int cc = 0; cc < 8; ++cc) { u32x2 ov; ov.x = cvt_pk_bf16(o[cc][0] * inv, o[cc][1] * inv); ov.y = cvt_pk_bf16(o[cc][2] * inv, o[cc][3] * inv);
                *(u32x2*)(mix + (size_t)q * KMIX + 512 + fr * 128 + 16 * cc + 4 * fq) = ov; }
        }
    }
}
typedef float f2 __attribute__((ext_vector_type(2)));
#ifndef PEER_FP8_MASK
#define PEER_FP8_MASK 3
#endif
constexpr float U_SCALE = 64.f, V_SCALE = 8.f;
DI unsigned pack4_fp8(float a, float b, float c, float d) { int p = __builtin_amdgcn_cvt_pk_fp8_f32(a, b, 0, false); p = __builtin_amdgcn_cvt_pk_fp8_f32(c, d, p, true); return (unsigned)p; }
DI void conv_chunk_fp8(const float* __restrict__ src, unsigned char* __restrict__ dst, size_t i0, int n16, float sc) {
    for (int i = opq_tid(); i < n16; i += 256) {
        const float4* s4 = (const float4*)src + 4 * (i0 + i);
        const float4 a = s4[0], b = s4[1], c = s4[2], d = s4[3];
        u32x4 o; o.x = pack4_fp8(a.x * sc, a.y * sc, a.z * sc, a.w * sc); o.y = pack4_fp8(b.x * sc, b.y * sc, b.z * sc, b.w * sc);
        o.z = pack4_fp8(c.x * sc, c.y * sc, c.z * sc, c.w * sc); o.w = pack4_fp8(d.x * sc, d.y * sc, d.z * sc, d.w * sc);
        ((u32x4*)dst)[i0 + i] = o;
    }
}
struct PeerLds2 {
    float trans[4][1024];
    unsigned char li[4][2][64][16];
    unsigned short pe[4][8][128];
    float pg[4][8][128];
};
DI unsigned unkey(unsigned k) { return (k & 0x80000000u) ? (k & 0x7fffffffu) : ~k; }
template <int OFF, int NK>
DI void sort16_desc(unsigned (&k)[NK]) {
#pragma unroll
    for (int size = 2; size <= 16; size <<= 1)
#pragma unroll
        for (int stride = size >> 1; stride > 0; stride >>= 1)
#pragma unroll
            for (int i = 0; i < 16; ++i) {
                const int j = i ^ stride;
                if (j > i) {
                    const bool desc = ((i & size) == 0);
                    const unsigned a = k[OFF + i], b = k[OFF + j];
                    const unsigned hi = a > b ? a : b, lo = a > b ? b : a;
                    k[OFF + i] = desc ? hi : lo; k[OFF + j] = desc ? lo : hi;
                }
            }
}
template <int OA, int OB, int NK>
DI void merge_top16(unsigned (&k)[NK]) {
#pragma unroll
    for (int i = 0; i < 16; ++i) { const unsigned a = k[OA + i], b = k[OB + 15 - i]; k[OA + i] = a > b ? a : b; }
#pragma unroll
    for (int stride = 8; stride > 0; stride >>= 1)
#pragma unroll
        for (int i = 0; i < 16; ++i) {
            const int j = i ^ stride;
            if (j > i) { const unsigned a = k[OA + i], b = k[OA + j]; k[OA + i] = a > b ? a : b; k[OA + j] = a > b ? b : a; }
        }
}
DI void peer_retrieve(const Params& p, int l, int tok0, PeerLds2& S, int lane, int wave) {
    const int fr = lane & 15, fq = lane >> 4;
    const bf16* QP = (const bf16*)(wsb(p) + WS_PROJ);
    const bf16* PK = (const bf16*)(wsb(p) + WS_PK) + (size_t)l * 2 * 128 * 64;
    float* trans = S.trans[wave];
    unsigned K1[16], K2[16];
#pragma unroll
    for (int L = 0; L < 2; ++L) {
        f32x4 acc[4][8];
#pragma unroll
        for (int ct = 0; ct < 4; ++ct)
#pragma unroll
            for (int kt = 0; kt < 8; ++kt) acc[ct][kt] = (f32x4){0, 0, 0, 0};
        bf16x8 bq[4][2];
#pragma unroll
        for (int ct = 0; ct < 4; ++ct) {
            const bf16* qrow = QP + (size_t)(tok0 + 2 * ct + (fr >> 3)) * 1024 + 128 * (fr & 7) + 64 * L + 8 * fq;
            bq[ct][0] = ld16(qrow); bq[ct][1] = ld16(qrow + 32);
        }
#pragma unroll
        for (int kt = 0; kt < 8; ++kt) {
            const bf16* krow = PK + (size_t)L * 8192 + (size_t)(16 * kt + fr) * 64 + 8 * fq;
            const bf16x8 a0 = ld16(krow), a1 = ld16(krow + 32);
#pragma unroll
            for (int ct = 0; ct < 4; ++ct) { acc[ct][kt] = MFMA16(a0, bq[ct][0], acc[ct][kt]); acc[ct][kt] = MFMA16(a1, bq[ct][1], acc[ct][kt]); }
        }
        unsigned k[128];
#define PEER_ROUND(kt)                                                                                                                            \
        {                                                                                                                                         \
            _Pragma("unroll") for (int ct = 0; ct < 4; ++ct) *(f32x4*)(trans + ((ct * 4 + fq) * 16 + fr) * 4) = acc[ct][kt];                       \
            _Pragma("unroll") for (int sq = 0; sq < 4; ++sq) {                                                                                     \
                const f32x4 v = *(const f32x4*)(trans + ((fq * 4 + sq) * 16 + fr) * 4);                                                            \
                _Pragma("unroll") for (int i = 0; i < 4; ++i) k[16 * (kt) + sq * 4 + i] = (fkey(v[i]) & ~0x7fu) | (unsigned)(16 * (kt) + 4 * sq + i); \
            }                                                                                                                                     \
            sort16_desc<16 * (kt)>(k);                                                                                                            \
        }
        PEER_ROUND(0) PEER_ROUND(1) merge_top16<0, 16>(k);
        PEER_ROUND(2) PEER_ROUND(3) merge_top16<32, 48>(k); merge_top16<0, 32>(k);
        PEER_ROUND(4) PEER_ROUND(5) merge_top16<64, 80>(k);
        PEER_ROUND(6) PEER_ROUND(7) merge_top16<96, 112>(k); merge_top16<64, 96>(k);
        merge_top16<0, 64>(k);
#undef PEER_ROUND
        u32x4 ib;
        ib.x = (k[0] & 127u) | ((k[1] & 127u) << 8) | ((k[2] & 127u) << 16) | ((k[3] & 127u) << 24);
        ib.y = (k[4] & 127u) | ((k[5] & 127u) << 8) | ((k[6] & 127u) << 16) | ((k[7] & 127u) << 24);
        ib.z = (k[8] & 127u) | ((k[9] & 127u) << 8) | ((k[10] & 127u) << 16) | ((k[11] & 127u) << 24);
        ib.w = (k[12] & 127u) | ((k[13] & 127u) << 8) | ((k[14] & 127u) << 16) | ((k[15] & 127u) << 24);
        *(u32x4*)(S.li[wave][L][lane]) = ib;
#pragma unroll
        for (int i = 0; i < 16; ++i) { if (L == 0) K1[i] = k[i]; else K2[i] = k[i]; }
    }
    float v1[16], v2[16];
#pragma unroll
    for (int i = 0; i < 16; ++i) { v1[i] = __uint_as_float(unkey(K1[i] & ~0x7fu)); v2[i] = __uint_as_float(unkey(K2[i] & ~0x7fu)); }
    unsigned c[64];
    {
        int idx = 0;
#pragma unroll
        for (int a = 0; a < 16; ++a)
#pragma unroll
            for (int b = 0; b < 16; ++b)
                if ((a + 1) * (b + 1) <= 16) { c[idx] = (fkey(v1[a] + v2[b]) & ~0xffu) | (unsigned)(a * 16 + b); ++idx; }
#pragma unroll
        for (int i = 50; i < 64; ++i) c[i] = 0u;
    }
    sort16_desc<0>(c); sort16_desc<16>(c); sort16_desc<32>(c); sort16_desc<48>(c);
    merge_top16<0, 16>(c); merge_top16<32, 48>(c); merge_top16<0, 32>(c);
    float sc[16]; float sum = 0.f;
    {
        const float m = __uint_as_float(unkey(c[0] & ~0xffu));
#pragma unroll
        for (int i = 0; i < 16; ++i) { sc[i] = __expf(__uint_as_float(unkey(c[i] & ~0xffu)) - m); sum += sc[i]; }
    }
    const float inv = 1.f / sum;
    const int tt = 2 * fq + (fr >> 3), head = fr & 7;
    const unsigned char* l1 = S.li[wave][0][lane]; const unsigned char* l2 = S.li[wave][1][lane];
#pragma unroll
    for (int i = 0; i < 16; ++i) {
        const unsigned ab = c[i] & 0xffu;
        const unsigned e = (unsigned)l1[ab >> 4] * 128u + (unsigned)l2[ab & 15u];
        S.pe[wave][tt][head * 16 + i] = (unsigned short)e; S.pg[wave][tt][head * 16 + i] = sc[i] * inv;
    }
}
template <bool FP8>
DI void peer_experts(const Params& p, int l, int tok, int tt, PeerLds2& S, int lane, int wave) {
    const bf16* H = (const bf16*)(wsb(p) + WS_H);
    const unsigned char* UB = wsb(p) + WS_UB; const unsigned char* VB = wsb(p) + WS_VB;
    const float* X = (const float*)(wsb(p) + WS_X);
    const float* modl = (const float*)(wsb(p) + WS_MOD) + (size_t)l * 4 * 6144;
    const int b = tok >> 12;
    const unsigned short* pe = S.pe[wave][tt]; const float* pg = S.pg[wave][tt];
    f2 hp[8];
    u32x4 h0, h1;
    {
        h0 = *(const u32x4*)(H + (size_t)tok * 1024 + 16 * lane); h1 = *(const u32x4*)(H + (size_t)tok * 1024 + 16 * lane + 8);
        hp[0] = (f2){bflo(h0.x), bfhi(h0.x)}; hp[1] = (f2){bflo(h0.y), bfhi(h0.y)}; hp[2] = (f2){bflo(h0.z), bfhi(h0.z)}; hp[3] = (f2){bflo(h0.w), bfhi(h0.w)};
        hp[4] = (f2){bflo(h1.x), bfhi(h1.x)}; hp[5] = (f2){bflo(h1.y), bfhi(h1.y)}; hp[6] = (f2){bflo(h1.z), bfhi(h1.z)}; hp[7] = (f2){bflo(h1.w), bfhi(h1.w)};
    }
    f2 acc[8];
#pragma unroll
    for (int i = 0; i < 8; ++i) acc[i] = (f2){0.f, 0.f};
    const bool b5 = (lane & 32) != 0, b4_ = (lane & 16) != 0, b3 = (lane & 8) != 0;
    const int eidx = (b3 ? 4 : 0) + (b4_ ? 2 : 0) + (b5 ? 1 : 0);
    if constexpr (FP8) {
    for (int e0 = 0; e0 < 128; e0 += 8) {
        u32x4 ur[8], vr[8];
#pragma unroll
        for (int j = 0; j < 8; ++j) {
            const int e = __builtin_amdgcn_readfirstlane((int)pe[e0 + j]);
            ur[j] = *(const u32x4*)(UB + (size_t)e * 1024 + 16 * lane);
            vr[j] = *(const u32x4*)(VB + (size_t)e * 1024 + 16 * lane);
        }
        float d[8];
#pragma unroll
        for (int j = 0; j < 8; ++j) {
            f2 s2 = {0.f, 0.f};
#pragma unroll
            for (int k = 0; k < 4; ++k) {
                const f2 lo = __builtin_amdgcn_cvt_pk_f32_fp8((int)ur[j][k], false), hi = __builtin_amdgcn_cvt_pk_f32_fp8((int)ur[j][k], true);
                s2 = lo * hp[2 * k] + s2; s2 = hi * hp[2 * k + 1] + s2;
            }
            d[j] = s2.x + s2.y;
        }
        float w[4], x2[2], y;
#pragma unroll
        for (int i = 0; i < 4; ++i) { const float keep = b5 ? d[2 * i + 1] : d[2 * i], send = b5 ? d[2 * i] : d[2 * i + 1]; w[i] = keep + __shfl_xor(send, 32); }
#pragma unroll
        for (int i = 0; i < 2; ++i) { const float keep = b4_ ? w[2 * i + 1] : w[2 * i], send = b4_ ? w[2 * i] : w[2 * i + 1]; x2[i] = keep + __shfl_xor(send, 16); }
        { const float keep = b3 ? x2[1] : x2[0], send = b3 ? x2[0] : x2[1]; y = keep + __shfl_xor(send, 8); }
        y += __shfl_xor(y, 4); y += __shfl_xor(y, 2); y += __shfl_xor(y, 1);
        const float sc = gelu_tanh(y * (1.f / U_SCALE)) * pg[e0 + eidx] * (1.f / V_SCALE);
#pragma unroll
        for (int j = 0; j < 8; ++j) {
            const float sj = __uint_as_float((unsigned)__builtin_amdgcn_readlane((int)__float_as_uint(sc), 32 * (j & 1) + 16 * ((j >> 1) & 1) + 8 * ((j >> 2) & 1)));
            const f2 sj2 = {sj, sj};
#pragma unroll
            for (int k = 0; k < 4; ++k) {
                const f2 lo = __builtin_amdgcn_cvt_pk_f32_fp8((int)vr[j][k], false), hi = __builtin_amdgcn_cvt_pk_f32_fp8((int)vr[j][k], true);
                acc[2 * k] = lo * sj2 + acc[2 * k]; acc[2 * k + 1] = hi * sj2 + acc[2 * k + 1];
            }
        }
    }
    } else {
    for (int e0 = 0; e0 < 128; e0 += 4) {
        const bf16* UBb = (const bf16*)UB; const bf16* VBb = (const bf16*)VB;
        u32x4 ur[4][2], vr[4][2];
#pragma unroll
        for (int j = 0; j < 4; ++j) {
            const int e = __builtin_amdgcn_readfirstlane((int)pe[e0 + j]);
            ur[j][0] = *(const u32x4*)(UBb + (size_t)e * 1024 + 16 * lane); ur[j][1] = *(const u32x4*)(UBb + (size_t)e * 1024 + 16 * lane + 8);
            vr[j][0] = *(const u32x4*)(VBb + (size_t)e * 1024 + 16 * lane); vr[j][1] = *(const u32x4*)(VBb + (size_t)e * 1024 + 16 * lane + 8);
        }
        float d[4];
#pragma unroll
        for (int j = 0; j < 4; ++j) {
            float sa = 0.f, sb = 0.f;
            sa = dot2bf(ur[j][0].x, h0.x, sa); sb = dot2bf(ur[j][0].y, h0.y, sb); sa = dot2bf(ur[j][0].z, h0.z, sa); sb = dot2bf(ur[j][0].w, h0.w, sb);
            sa = dot2bf(ur[j][1].x, h1.x, sa); sb = dot2bf(ur[j][1].y, h1.y, sb); sa = dot2bf(ur[j][1].z, h1.z, sa); sb = dot2bf(ur[j][1].w, h1.w, sb);
            d[j] = sa + sb;
        }
        float w[2], y;
#pragma unroll
        for (int i = 0; i < 2; ++i) { const float keep = b5 ? d[2 * i + 1] : d[2 * i], send = b5 ? d[2 * i] : d[2 * i + 1]; w[i] = keep + __shfl_xor(send, 32); }
        { const float keep = b4_ ? w[1] : w[0], send = b4_ ? w[0] : w[1]; y = keep + __shfl_xor(send, 16); }
        y += __shfl_xor(y, 8); y += __shfl_xor(y, 4); y += __shfl_xor(y, 2); y += __shfl_xor(y, 1);
        const float sc = gelu_tanh(y) * pg[e0 + (b4_ ? 2 : 0) + (b5 ? 1 : 0)];
#pragma unroll
        for (int j = 0; j < 4; ++j) {
            const float sj = __uint_as_float((unsigned)__builtin_amdgcn_readlane((int)__float_as_uint(sc), 32 * (j & 1) + 16 * ((j >> 1) & 1)));
            const f2 sj2 = {sj, sj};
#pragma unroll
            for (int hh = 0; hh < 2; ++hh)
#pragma unroll
                for (int k = 0; k < 4; ++k) { const unsigned dw = vr[j][hh][k]; const f2 vv = {bflo(dw), bfhi(dw)}; acc[4 * hh + k] = vv * sj2 + acc[4 * hh + k]; }
        }
    }
    }
    float xr[16];
    const float* xrow = X + (size_t)tok * 1024 + 16 * lane;
    float* xorow = p.out + (size_t)tok * 1024 + 16 * lane;
    const float* g2 = modl + (size_t)b * 6144 + 5 * 1024 + 16 * lane;
    float ss = 0;
#pragma unroll
    for (int q4 = 0; q4 < 4; ++q4) {
        const float4 xv = *(const float4*)(xrow + 4 * q4), gv = *(const float4*)(g2 + 4 * q4);
        float4 o; o.x = xv.x + gv.x * acc[2 * q4].x; o.y = xv.y + gv.y * acc[2 * q4].y; o.z = xv.z + gv.z * acc[2 * q4 + 1].x; o.w = xv.w + gv.w * acc[2 * q4 + 1].y;
        if (l == 0) *(float4*)(xorow + 4 * q4) = o;
        xr[4 * q4] = o.x; xr[4 * q4 + 1] = o.y; xr[4 * q4 + 2] = o.z; xr[4 * q4 + 3] = o.w;
        ss += o.x * o.x + o.y * o.y + o.z * o.z + o.w * o.w;
    }
    ss = wave_sum(ss);
    const float r = rsqrtf(ss * (1.f / 1024.f) + 1e-6f);
    if (l == 1) {
#pragma unroll
        for (int q4 = 0; q4 < 4; ++q4) {
            const float4 gv = *(const float4*)(p.in[28] + 16 * lane + 4 * q4);
            float4 o; o.x = xr[4 * q4] * r * gv.x; o.y = xr[4 * q4 + 1] * r * gv.y; o.z = xr[4 * q4 + 2] * r * gv.z; o.w = xr[4 * q4 + 3] * r * gv.w;
            *(float4*)(xorow + 4 * q4) = o;
        }
    } else {
        const float* g = p.in[2] + 1024 + 16 * lane; const float* mod1 = (const float*)(wsb(p) + WS_MOD) + ((size_t)4 + b) * 6144 + 16 * lane;
        bf16* hrow = (bf16*)(wsb(p) + WS_H2) + (size_t)tok * 1024 + 16 * lane;
        float hv[16];
#pragma unroll
        for (int q4 = 0; q4 < 4; ++q4) {
            const float4 gg = *(const float4*)(g + 4 * q4), s1 = *(const float4*)(mod1 + 1024 + 4 * q4), s0 = *(const float4*)(mod1 + 4 * q4);
            hv[4 * q4] = xr[4 * q4] * r * gg.x * (1.f + s1.x) + s0.x; hv[4 * q4 + 1] = xr[4 * q4 + 1] * r * gg.y * (1.f + s1.y) + s0.y;
            hv[4 * q4 + 2] = xr[4 * q4 + 2] * r * gg.z * (1.f + s1.z) + s0.z; hv[4 * q4 + 3] = xr[4 * q4 + 3] * r * gg.w * (1.f + s1.w) + s0.w;
        }
        u32x4 o0, o1;
        o0.x = cvt_pk_bf16(hv[0], hv[1]); o0.y = cvt_pk_bf16(hv[2], hv[3]); o0.z = cvt_pk_bf16(hv[4], hv[5]); o0.w = cvt_pk_bf16(hv[6], hv[7]);
        o1.x = cvt_pk_bf16(hv[8], hv[9]); o1.y = cvt_pk_bf16(hv[10], hv[11]); o1.z = cvt_pk_bf16(hv[12], hv[13]); o1.w = cvt_pk_bf16(hv[14], hv[15]);
        *(u32x4*)(hrow) = o0; *(u32x4*)(hrow + 8) = o1;
    }
}

constexpr int SMEM_BYTES = 64 + 17408 + 32768;
#ifndef REP_ID
#define REP_ID -1
#endif
#ifndef REP_N
#define REP_N 1
#endif
#define NREP(id) ((id) == REP_ID ? REP_N : 1)
__global__ void __launch_bounds__(256, 2) fwd_megakernel(Params p) {
    __shared__ __attribute__((aligned(16))) unsigned char smem[SMEM_BYTES];
    const int tid = threadIdx.x;
    const int G = gridDim.x, bid = blockIdx.x;
    unsigned char* sm = smem + 64;
    volatile int* qslot = (volatile int*)(smem + 16);
    if (tid < 16) ((unsigned*)smem)[tid] = 0u;
    __syncthreads();
    unsigned* ctl = (unsigned*)(p.ws + WS_CTL);
    unsigned* qctr = ctl + 4096;
    XcdBarrier bar = xcd_barrier_post(ctl, (volatile LAS unsigned*)smem);
    unsigned char* ws = p.ws;
    const bf16* H = (const bf16*)(ws + WS_H);
    bf16* PROJ = (bf16*)(ws + WS_PROJ);
    float* X = (float*)(ws + WS_X);
    const float* mod = (const float*)(ws + WS_MOD);
    int qn = 0;

    for (int rep = 0; rep < NREP(0); ++rep) {
        constexpr int N_MOD = 48, N_LAYER = 768 + 1024 + 512 + 512 + 1024 + 1024 + 64, N_PK = 4, N_GW = 128, N_PW = 8;
        constexpr int NV = N_MOD + 2 * N_LAYER + N_PK + N_GW + N_PW;
        for (int vb = bid; vb < NV; vb += G) {
            int v = vb;
            if (v < N_MOD) { it_mod(p, v, sm); continue; }
            v -= N_MOD;
            if (v < 2 * N_LAYER) {
                const int l = v / N_LAYER; v -= l * N_LAYER;
                bf16* wtin = (bf16*)(ws + WS_WTIN) + (size_t)l * NPROJ * 1024;
                const float* win = p.in[6] + (size_t)l * 1024 * 1732;
                bf16* wtout = (bf16*)(ws + WS_WTOUT) + (size_t)l * 1024 * KMIX;
                const float* wout = p.in[22] + (size_t)l * 1024 * 1024;
                if (v < 768) { it_transpose(TrArgs{win, 1732, 0, 1732, wtin, 1024, 0, 1024, 768, 0, nullptr}, v, sm); }
                else if ((v -= 768) < 1024) { it_transpose(TrArgs{win, 1732, 0, 1732, wtin + (size_t)768 * 1024, 1024, 0, 1024, 1024, 1, p.in[20] + (size_t)l * 8 * 64 * 128}, v, sm); }
                else if ((v -= 1024) < 512) { it_transpose(TrArgs{win, 1732, 1280, 1732, wtin + (size_t)1792 * 1024, 1024, 0, 1024, 512, 0, nullptr}, v, sm); }
                else if ((v -= 512) < 512) { it_transpose(TrArgs{wout, 1024, 0, 1024, wtout, KMIX, 0, 512, 1024, 0, nullptr}, v, sm); }
                else if ((v -= 512) < 1024) { it_transpose(TrArgs{wout, 1024, 0, 1024, wtout, KMIX, 512, 1024, 1024, 2, p.in[21] + (size_t)l * 8 * 128 * 64}, v, sm); }
                else if ((v -= 1024) < 1024) { it_transpose(TrArgs{p.in[23] + (size_t)l * 1024 * 1024, 1024, 0, 1024, (bf16*)(ws + WS_WTQ) + (size_t)l * 1024 * 1024, 1024, 0, 1024, 1024, 0, nullptr}, v, sm); }
                else { v -= 1024; it_transpose(TrArgs{p.in[15] + (size_t)l * 256 * 256, 256, 0, 256, (bf16*)(ws + WS_WTGLU) + (size_t)l * 256 * 256, 256, 0, 256, 256, 0, nullptr}, v, sm); }
                continue;
            }
            v -= 2 * N_LAYER;
            if (v < N_PK) { const int l = v >> 1, w = v & 1; conv_chunk(p.in[24 + w] + (size_t)l * 8192, (bf16*)(ws + WS_PK) + (size_t)l * 16384 + w * 8192, 0, 1024); continue; }
            v -= N_PK;
            if (v < N_GW) { it_gw(p, v); continue; }
            v -= N_GW;
            it_ssm_pw(p, v);
        }
        xcd_barrier(bar);
    }
    for (int rep = 0; rep < NREP(1); ++rep) {
        constexpr int N_NORM = NTOK / 4, N_TAB = 4352;
        for (int vb = bid; vb < N_NORM + N_TAB; vb += G) {
            if (vb < N_NORM) {
                const int t_ = opq_tid(); const int row = vb * 4 + (t_ >> 6);
                const float* m0 = (const float*)(wsb(p) + WS_MOD) + (size_t)(row >> 12) * 6144;
                norm_mod_row(p.in[0] + (size_t)row * 1024, p.in[2], m0, m0 + 1024, (bf16*)(wsb(p) + WS_H) + (size_t)row * 1024, t_ & 63);
            } else {
                const size_t base = (size_t)(vb - N_NORM) * 2048;
                for (int e = 0; e < 8; ++e) ssm_tab_entry(p, base + e * 256 + opq_tid());
            }
        }
        xcd_barrier(bar);
    }

    for (int l = 0; l < 2; ++l) {
        const float* xin = l == 0 ? p.in[0] : p.out;
        for (int rep = 0; rep < NREP(2 + 8 * l); ++rep) {
            const EpiBf16 epi{PROJ, NPROJ};
            const bf16* Bt = (const bf16*)(ws + WS_WTIN) + (size_t)l * NPROJ * 1024;
            const bf16* Hin = l == 0 ? H : (const bf16*)(ws + WS_H2);
            for (int t = bid; t < (NTOK / 128) * (NPROJ / 128); t += G) { gemm_tile(Hin, 1024, Bt, 1024, 1024, (t / (NPROJ / 128)) * 128, (t % (NPROJ / 128)) * 128, (bf16*)sm, epi); __syncthreads(); }
            xcd_barrier(bar);
        }
        for (int rep = 0; rep < NREP(3 + 8 * l); ++rep) {
            unsigned* ctr = qctr + 64 * (qn++);
            for (;;) {
                const int it = q_next(ctr, qslot);
                if (it >= 2048) break;
                if (it < 1024) it_dsa_index_select(p, it);
                else if (it < 1536) it_gmlp(p, l, it - 1024, sm);
                else if (it < 1792) it_ssm_a(p, l, it - 1536);
                else it_kvn(p, l, it - 1792);
            }
            xcd_barrier(bar);
        }
        for (int rep = 0; rep < NREP(4 + 8 * l); ++rep) {
            unsigned* ctr = qctr + 64 * (qn++);
            for (;;) {
                const int it = q_next(ctr, qslot);
                if (it >= 256 + 1024 + 512) break;
                if (it < 256) it_ssm_c(p, l, it, sm);
                else if (it < 1280) it_dsa_attn(p, it - 256, sm);
                else {
                    const int v = it - 1280, w = v >> 8, ch = v & 255;
                    if (!(PEER_FP8_MASK & (1 << l))) conv_chunk(p.in[26 + w] + (size_t)l * NEXP * 1024, (bf16*)(ws + (w ? WS_VB : WS_UB)), (size_t)ch * 8192, 8192);
                    else conv_chunk_fp8(p.in[26 + w] + (size_t)l * NEXP * 1024, ws + (w ? WS_VB : WS_UB), (size_t)ch * 4096, 4096, w ? V_SCALE : U_SCALE);
                }
            }
            xcd_barrier(bar);
        }
        for (int rep = 0; rep < NREP(5 + 8 * l); ++rep) {
            const EpiGlu epi{(const bf16*)(ws + WS_YG), p.in[16] + l * 256, (bf16*)(ws + WS_MIX)};
            const bf16* Bt = (const bf16*)(ws + WS_WTGLU) + (size_t)l * 256 * 256;
            for (int t = bid; t < (NTOK / 128) * 2; t += G) { gemm_tile((const bf16*)(ws + WS_YG), 256, Bt, 256, 256, (t >> 1) * 128, (t & 1) * 128, (bf16*)sm, epi); __syncthreads(); }
            xcd_barrier(bar);
        }
        for (int rep = 0; rep < NREP(6 + 8 * l); ++rep) {
            const EpiResid epi{xin, X, mod + (size_t)l * 4 * 6144 + 2048};
            const bf16* Bt = (const bf16*)(ws + WS_WTOUT) + (size_t)l * 1024 * KMIX;
            for (int t = bid; t < (NTOK / 128) * 8; t += G) { gemm_tile((const bf16*)(ws + WS_MIX), KMIX, Bt, KMIX, KMIX, (t >> 3) * 128, (t & 7) * 128, (bf16*)sm, epi); __syncthreads(); }
            xcd_barrier(bar);
        }
        for (int rep = 0; rep < NREP(7 + 8 * l); ++rep) {
            for (int vb = bid; vb < NTOK / 4; vb += G) {
                const int t_ = opq_tid(); const int row = vb * 4 + (t_ >> 6);
                const float* m0 = (const float*)(wsb(p) + WS_MOD) + ((size_t)l * 4 + (row >> 12)) * 6144 + 3072;
                norm_mod_row((const float*)(wsb(p) + WS_X) + (size_t)row * 1024, p.in[3] + l * 1024, m0, m0 + 1024, (bf16*)(wsb(p) + WS_H) + (size_t)row * 1024, t_ & 63);
            }
            xcd_barrier(bar);
        }
        for (int rep = 0; rep < NREP(8 + 8 * l); ++rep) {
            const EpiBf16 epi{PROJ, 1024};
            const bf16* Bt = (const bf16*)(ws + WS_WTQ) + (size_t)l * 1024 * 1024;
            for (int t = bid; t < (NTOK / 128) * 8; t += G) { gemm_tile(H, 1024, Bt, 1024, 1024, (t >> 3) * 128, (t & 7) * 128, (bf16*)sm, epi); __syncthreads(); }
            xcd_barrier(bar);
        }
        for (int rep = 0; rep < NREP(9 + 8 * l); ++rep) {
            PeerLds2& S = *(PeerLds2*)sm;
            __syncthreads();
            const int t_ = opq_tid(), lane_ = t_ & 63, wave_ = t_ >> 6;
            for (int wb = bid * 4 + wave_; wb < NTOK / 8; wb += G * 4) {
                peer_retrieve(p, l, wb * 8, S, lane_, wave_);
                for (int tt = 0; tt < 8; ++tt) {
                    if (PEER_FP8_MASK & (1 << l)) peer_experts<true>(p, l, wb * 8 + tt, tt, S, lane_, wave_);
                    else peer_experts<false>(p, l, wb * 8 + tt, tt, S, lane_, wave_);
                }
            }
            if (l == 0 || rep + 1 < NREP(9 + 8 * l)) xcd_barrier(bar);
        }
    }
}

extern "C" void kernel_launch(void* const* d_in, const int* in_sizes, int n_in, void* d_out, int out_size, void* d_ws, size_t ws_size, hipStream_t stream) {
    if (n_in != 29 || ws_size < WS_END) { fprintf(stderr, "kernel_launch: bad args (n_in %d, ws %zu, need %zu)\n", n_in, ws_size, (size_t)WS_END); return; }
    static int grid = 0;
    if (grid == 0) {
        int dev = 0, cus = 0, per_cu = 0;
        if (hipGetDevice(&dev) != hipSuccess || hipDeviceGetAttribute(&cus, hipDeviceAttributeMultiprocessorCount, dev) != hipSuccess) { grid = -1; return; }
        if (hipOccupancyMaxActiveBlocksPerMultiprocessor(&per_cu, (const void*)fwd_megakernel, 256, 0) != hipSuccess || per_cu < 1) { fprintf(stderr, "kernel_launch: occupancy query failed (%d)\n", per_cu); grid = -1; return; }
        const int use = per_cu < 2 ? per_cu : 2;
        grid = cus * use;
    }
    if (grid < 0) return;
    if (hipMemsetAsync((char*)d_ws + WS_CTL, 0, 65536, stream) != hipSuccess) { fprintf(stderr, "kernel_launch: memset failed\n"); return; }
    Params p{};
    for (int i = 0; i < 29; ++i) p.in[i] = (const float*)d_in[i];
    p.out = (float*)d_out; p.ws = (unsigned char*)d_ws;
    void* args[] = {&p};
    const hipError_t e = hipLaunchCooperativeKernel((const void*)fwd_megakernel, dim3(grid), dim3(256), args, 0, stream);
    if (e != hipSuccess) fprintf(stderr, "kernel_launch: cooperative launch failed: %s (grid %d)\n", hipGetErrorString(e), grid);
}
```

```cpp
#include <hip/hip_runtime.h>
#include <cstdint>
#include <cstdio>

typedef unsigned short bf16;
typedef short bf16x8 __attribute__((ext_vector_type(8)));
typedef short s16x4 __attribute__((ext_vector_type(4)));
typedef float f32x4 __attribute__((ext_vector_type(4)));
typedef unsigned u32x4 __attribute__((ext_vector_type(4)));
typedef unsigned u32x2 __attribute__((ext_vector_type(2)));
typedef __bf16 bf2 __attribute__((ext_vector_type(2)));
#define DI __device__ __forceinline__
#define MFMA16(a, b, c) __builtin_amdgcn_mfma_f32_16x16x32_bf16((a), (b), (c), 0, 0, 0)

constexpr int DM = 1024, NB = 4, SEQ = 4096, NTOK = NB * SEQ;
constexpr int NPROJ = 2304;
constexpr int C_UA = 0, C_UB = 256, C_VB = 512, C_QA = 768, C_CKV = 1792, C_QI = 1920, C_KI = 2176, C_WI = 2240;
constexpr int KMIX = 1536;
constexpr int NEXP = 16384;
constexpr size_t SCORES_PER_BATCH = (size_t)4096 * 2080;

constexpr size_t al256(size_t x) { return (x + 255) & ~(size_t)255; }
constexpr size_t WS_CTL = 0;
constexpr size_t WS_MOD = 65536;
constexpr size_t WS_WTIN = al256(WS_MOD + 2 * 4 * 6144 * 4);
constexpr size_t WS_WTOUT = al256(WS_WTIN + (size_t)2 * NPROJ * 1024 * 2);
constexpr size_t WS_WTQ = al256(WS_WTOUT + (size_t)2 * 1024 * KMIX * 2);
constexpr size_t WS_WTGLU = al256(WS_WTQ + (size_t)2 * 1024 * 1024 * 2);
constexpr size_t WS_GW = al256(WS_WTGLU + (size_t)2 * 256 * 256 * 2);
constexpr size_t WS_PK = al256(WS_GW + (size_t)2 * 4 * 128 * 128 * 2);
constexpr size_t WS_PW = al256(WS_PK + (size_t)2 * 2 * 128 * 64 * 2);
constexpr size_t WS_BB = al256(WS_PW + (size_t)2 * 16 * 65 * 64 * 2 * 4);
constexpr size_t WS_E = al256(WS_BB + (size_t)2 * 16 * 64 * 16 * 2 * 4);
constexpr size_t WS_G = al256(WS_E + (size_t)2 * 16 * 128 * 1024 * 2);
constexpr size_t WS_KT = al256(WS_G + (size_t)2 * 16 * 1024 * 128 * 2);
constexpr size_t WS_UB = al256(WS_KT + (size_t)2 * 16 * 64 * 256 * 2);
constexpr size_t WS_VB = al256(WS_UB + (size_t)NEXP * 1024 * 2);
constexpr size_t WS_H = al256(WS_VB + (size_t)NEXP * 1024 * 2);
constexpr size_t WS_PROJ = al256(WS_H + (size_t)NTOK * 1024 * 2);
constexpr size_t WS_SLOC = al256(WS_PROJ + (size_t)NTOK * NPROJ * 2);
constexpr size_t WS_YG = al256(WS_SLOC + (size_t)256 * 16 * 128 * 4);
constexpr size_t WS_KVN = al256(WS_YG + (size_t)NTOK * 256 * 2);
constexpr size_t WS_SEL = al256(WS_KVN + (size_t)NTOK * 128 * 2);
constexpr size_t WS_MIX = al256(WS_SEL + (size_t)NTOK * 256 * 2);
constexpr size_t WS_X = al256(WS_MIX + (size_t)NTOK * KMIX * 2);
constexpr size_t WS_SCORES = al256(WS_X + (size_t)NTOK * 1024 * 4);
constexpr size_t WS_H2 = al256(WS_SCORES + (size_t)NB * SCORES_PER_BATCH * 4);
constexpr size_t WS_END = al256(WS_H2 + (size_t)NTOK * 1024 * 2);

struct Params {
    const float* in[29];
    float* out;
    unsigned char* ws;
};

typedef __bf16 bf2v_t __attribute__((ext_vector_type(2)));
typedef float f2v_t __attribute__((ext_vector_type(2)));
DI unsigned cvt_pk_bf16(float lo, float hi) { const f2v_t f = {lo, hi}; const bf2v_t r = __builtin_convertvector(f, bf2v_t); return __builtin_bit_cast(unsigned, r); }
DI bf16 f2bf(float x) { return (bf16)(cvt_pk_bf16(x, 0.f) & 0xffffu); }
DI float bf2f(bf16 b) { return __uint_as_float((unsigned)b << 16); }
DI float bflo(unsigned u) { return __uint_as_float(u << 16); }
DI float bfhi(unsigned u) { return __uint_as_float(u & 0xffff0000u); }
DI float dot2bf(unsigned a, unsigned b, float c) { return __builtin_amdgcn_fdot2_f32_bf16(__builtin_bit_cast(bf2, a), __builtin_bit_cast(bf2, b), c, false); }
DI float gelu_tanh(float x) { const float u = 0.7978845608028654f * (x + 0.044715f * x * x * x); const float e = __expf(2.f * u); const float t = 1.f - 2.f / (e + 1.f); return 0.5f * x * (1.f + t); }
DI float sigmoidf(float x) { return 1.f / (1.f + __expf(-x)); }
DI float wave_sum(float v) { for (int o = 32; o > 0; o >>= 1) v += __shfl_xor(v, o); return v; }
DI unsigned wave_sum_u32(unsigned v) {
    int x = (int)v;
    x += __builtin_amdgcn_update_dpp(0, x, 0xB1, 0xf, 0xf, true);
    x += __builtin_amdgcn_update_dpp(0, x, 0x4E, 0xf, 0xf, true);
    x += __builtin_amdgcn_update_dpp(0, x, 0x141, 0xf, 0xf, true);
    x += __builtin_amdgcn_update_dpp(0, x, 0x140, 0xf, 0xf, true);
    x += __builtin_amdgcn_update_dpp(0, x, 0x142, 0xa, 0xf, true);
    x += __builtin_amdgcn_update_dpp(0, x, 0x143, 0xc, 0xf, true);
    return (unsigned)__builtin_amdgcn_readlane(x, 63);
}
DI unsigned wave_scan_incl_u32(unsigned v) {
    int x = (int)v;
    x += __builtin_amdgcn_update_dpp(0, x, 0x111, 0xf, 0xf, true);
    x += __builtin_amdgcn_update_dpp(0, x, 0x112, 0xf, 0xf, true);
    x += __builtin_amdgcn_update_dpp(0, x, 0x114, 0xf, 0xf, true);
    x += __builtin_amdgcn_update_dpp(0, x, 0x118, 0xf, 0xf, true);
    x += __builtin_amdgcn_update_dpp(0, x, 0x142, 0xa, 0xf, true);
    x += __builtin_amdgcn_update_dpp(0, x, 0x143, 0xc, 0xf, true);
    return (unsigned)x;
}
DI unsigned fkey(float v) { const unsigned u = __float_as_uint(v); return (u & 0x80000000u) ? ~u : (u | 0x80000000u); }
DI unsigned unkey(unsigned k) { return (k & 0x80000000u) ? (k & 0x7fffffffu) : ~k; }
DI bf16x8 ld16(const void* p) { return *(const bf16x8*)p; }
DI bf16x8 zero8() { bf16x8 z = {0, 0, 0, 0, 0, 0, 0, 0}; return z; }


#define XB_TMO      128
#define XB_XCNT(j)  (256  + 64 * (j))
#define XB_XSUB(j)  (1280 + 64 * (j))
#define XB_XGEN(j)  (2304 + 64 * (j))
#define XB_TOP      3328
#define XB_TOPGEN   3392
#define XCD_BAR_WORDS 3456
#define XB_SPIN_CAP (1u << 22)
#define LAS __attribute__((address_space(3)))
DI unsigned xb_ld(unsigned* p)              { return __hip_atomic_load(p, __ATOMIC_RELAXED, __HIP_MEMORY_SCOPE_AGENT); }
DI unsigned xb_add(unsigned* p, unsigned v) { return __hip_atomic_fetch_add(p, v, __ATOMIC_RELAXED, __HIP_MEMORY_SCOPE_AGENT); }
DI unsigned xb_xcc_id() { return (unsigned)__builtin_amdgcn_s_getreg((3 << 11) | 20) & 0xFu; }
#define XB_SPIN(cond, bar) do { unsigned _sp = 0; while (cond) { __builtin_amdgcn_s_sleep(1); \
    if ((++_sp & 255u) == 0u) { if (xb_ld(&(bar)[XB_TMO])) break; if (_sp > XB_SPIN_CAP) { atomicAdd(&(bar)[XB_TMO], 1u); break; } } } } while (0)
struct XcdBarrier { unsigned* bar; unsigned x; volatile LAS unsigned* st; };
DI XcdBarrier xcd_barrier_post(unsigned* bar, volatile LAS unsigned* st) {
    XcdBarrier b; b.bar = bar; b.x = xb_xcc_id(); b.st = st;
    if (threadIdx.x == 0) (void)xb_add(&bar[XB_XCNT(b.x)], 1u);
    return b;
}
DI void xcd_barrier_complete(unsigned* bar, unsigned x, unsigned& nloc, unsigned& nx) {
    const unsigned G = gridDim.x * gridDim.y * gridDim.z;
    unsigned sum, cnt, mine, sp = 0u;
    for (;;) {
        sum = 0u; cnt = 0u; mine = 0u;
#pragma unroll
        for (unsigned j = 0; j < 16; ++j) { const unsigned c = xb_ld(&bar[XB_XCNT(j)]); sum += c; cnt += (c > 0u) ? 1u : 0u; mine = (j == x) ? c : mine; }
        if (sum == G) break;
        __builtin_amdgcn_s_sleep(1);
        if ((++sp & 255u) == 0u) { if (xb_ld(&bar[XB_TMO])) break; if (sp > XB_SPIN_CAP) { atomicAdd(&bar[XB_TMO], 1u); break; } }
    }
    nloc = mine > 0u ? mine : 1u; nx = cnt > 0u ? cnt : 1u;
}
DI void xcd_barrier(const XcdBarrier& b) {
    asm volatile("s_waitcnt vmcnt(0)" ::: "memory");
    __syncthreads();
    if (threadIdx.x == 0) {
        unsigned* bar = b.bar;
        __builtin_amdgcn_s_waitcnt(0);
        unsigned nloc = b.st[0], nx = b.st[1];
        if (nloc == 0u) { xcd_barrier_complete(bar, b.x, nloc, nx); b.st[0] = nloc; b.st[1] = nx; }
        const unsigned old = xb_add(&bar[XB_XSUB(b.x)], 1u);
        const unsigned gen = old / nloc;
        if (old + 1u == (gen + 1u) * nloc) {
            __builtin_amdgcn_fence(__ATOMIC_RELEASE, "agent");
            asm volatile("s_waitcnt vmcnt(0)" ::: "memory");
            const unsigned og = xb_add(&bar[XB_TOP], 1u);
            const unsigned tg = og / nx;
            if (og + 1u == (tg + 1u) * nx) xb_add(&bar[XB_TOPGEN], 1u);
            else XB_SPIN(xb_ld(&bar[XB_TOPGEN]) == tg, bar);
            __builtin_amdgcn_fence(__ATOMIC_ACQUIRE, "agent");
            xb_add(&bar[XB_XGEN(b.x)], 1u);
            asm volatile("s_waitcnt vmcnt(0)" ::: "memory");
        } else {
            XB_SPIN(xb_ld(&bar[XB_XGEN(b.x)]) == gen, bar);
            __builtin_amdgcn_fence(__ATOMIC_ACQUIRE, "agent");
            asm volatile("s_waitcnt vmcnt(0)" ::: "memory");
        }
    }
    __syncthreads();
}
typedef __attribute__((address_space(1))) unsigned char g_uc;
DI unsigned char* wsb(const Params& p) {
    const unsigned long long w = (unsigned long long)p.ws;
    unsigned lo = __builtin_amdgcn_readfirstlane((unsigned)w), hi = __builtin_amdgcn_readfirstlane((unsigned)(w >> 32));
    asm volatile("" : "+s"(lo), "+s"(hi));
    return (unsigned char*)(g_uc*)(((unsigned long long)hi << 32) | lo);
}
DI int opq_tid() { int t = (int)threadIdx.x; asm volatile("" : "+v"(t)); return t; }
DI int q_next(unsigned* ctr, volatile int* slot) {
    __syncthreads();
    if (threadIdx.x == 0) *slot = (int)__hip_atomic_fetch_add(ctr, 1u, __ATOMIC_RELAXED, __HIP_MEMORY_SCOPE_AGENT);
    __syncthreads();
    return *slot;
}

DI void it_mod(const Params& p, int vb, unsigned char* sm) {
    float (*ca)[1024] = (float (*)[1024])sm;
    float (*part)[4][64] = (float (*)[4][64])(sm + 16384);
    const float* c = p.in[1];
    const int tid = opq_tid();
    __syncthreads();
    for (int i = tid; i < 4096; i += 256) { const float v = c[i]; ca[i >> 10][i & 1023] = v / (1.f + __expf(-v)); }
    __syncthreads();
    const int col = tid & 63, sl = tid >> 6;
    const int idx = vb * 64 + col;
    const int l = idx / 6144, n = idx % 6144;
    const float* w = p.in[4] + (size_t)l * 1024 * 6144 + n + (size_t)(256 * sl) * 6144;
    float a0 = 0, a1 = 0, a2 = 0, a3 = 0;
#pragma unroll 8
    for (int k = 0; k < 256; ++k) { const float wv = w[(size_t)k * 6144]; const int kk = 256 * sl + k; a0 += ca[0][kk] * wv; a1 += ca[1][kk] * wv; a2 += ca[2][kk] * wv; a3 += ca[3][kk] * wv; }
    part[sl][0][col] = a0; part[sl][1][col] = a1; part[sl][2][col] = a2; part[sl][3][col] = a3;
    __syncthreads();
    {
        const int bb = tid >> 6;
        const float v = part[0][bb][col] + part[1][bb][col] + part[2][bb][col] + part[3][bb][col] + p.in[5][l * 6144 + n];
        ((float*)(wsb(p) + WS_MOD))[((size_t)l * 4 + bb) * 6144 + n] = v;
    }
}

struct TrArgs { const float* src; int lds, coff, nvalid; bf16* dst; int ldd, doff; int K, N; int mode; const float* aux; };
DI void it_transpose(const TrArgs& a, int vb, unsigned char* sm) {
    float (*t)[33] = (float (*)[33])sm;
    float (*ta)[65] = (float (*)[65])(sm + 4352);
    float (*tb)[33] = (float (*)[33])(sm + 4352 + 8320);
    const int nk = a.K / 32;
    const int kt = vb % nk, nt = vb / nk;
    const int tid = opq_tid(), tx = tid & 31, ty = tid >> 5;
    __syncthreads();
    if (a.mode == 0) {
        for (int r = ty; r < 32; r += 8) {
            const int k = kt * 32 + r, n = nt * 32 + tx;
            t[r][tx] = (n + a.coff < a.nvalid) ? a.src[(size_t)k * a.lds + n + a.coff] : 0.f;
        }
    } else if (a.mode == 1) {
        const int h = (nt * 32) >> 7, r0 = (nt * 32) & 127;
        for (int i = tid; i < 32 * 64; i += 256) { const int kk = i >> 6, d = i & 63; ta[kk][d] = a.src[(size_t)(kt * 32 + kk) * a.lds + 768 + 64 * h + d]; }
        for (int i = tid; i < 64 * 32; i += 256) { const int d = i >> 5, rr = i & 31; tb[d][rr] = a.aux[((size_t)h * 64 + d) * 128 + r0 + rr]; }
        __syncthreads();
        for (int r = ty; r < 32; r += 8) { float s = 0; _Pragma("unroll 16") for (int d = 0; d < 64; ++d) s += ta[r][d] * tb[d][tx]; t[r][tx] = s * 0.125f; }
    } else {
        const int h = (kt * 32) >> 7, r0 = (kt * 32) & 127;
        for (int i = tid; i < 32 * 64; i += 256) { const int rr = i >> 6, d = i & 63; ta[rr][d] = a.aux[((size_t)h * 128 + r0 + rr) * 64 + d]; }
        for (int i = tid; i < 64 * 32; i += 256) { const int d = i >> 5, nn = i & 31; tb[d][nn] = a.src[(size_t)(512 + 64 * h + d) * a.lds + nt * 32 + nn]; }
        __syncthreads();
        for (int r = ty; r < 32; r += 8) { float s = 0; _Pragma("unroll 16") for (int d = 0; d < 64; ++d) s += ta[r][d] * tb[d][tx]; t[r][tx] = s; }
    }
    __syncthreads();
    for (int r = ty; r < 32; r += 8) {
        const int n = nt * 32 + r, k = kt * 32 + tx;
        a.dst[(size_t)n * a.ldd + a.doff + k] = f2bf(t[tx][r]);
    }
}
DI void conv_chunk(const float* __restrict__ src, bf16* __restrict__ dst, size_t i0, int n8) {
    for (int i = opq_tid(); i < n8; i += 256) {
        const float4 a = ((const float4*)src)[2 * (i0 + i)], b = ((const float4*)src)[2 * (i0 + i) + 1];
        u32x4 o; o.x = cvt_pk_bf16(a.x, a.y); o.y = cvt_pk_bf16(a.z, a.w); o.z = cvt_pk_bf16(b.x, b.y); o.w = cvt_pk_bf16(b.z, b.w);
        ((u32x4*)dst)[i0 + i] = o;
    }
}
DI void it_gw(const Params& p, int vb) {
    for (int e = 0; e < 4; ++e) {
        const int idx = vb * 1024 + e * 256 + opq_tid();
        const int s = idx & 127, t = (idx >> 7) & 127;
        const float v = (t >= 64 || s < 64) ? p.in[17][idx] : 0.f;
        ((bf16*)(wsb(p) + WS_GW))[idx] = f2bf(v);
    }
}
DI void it_ssm_pw(const Params& p, int vb) {
    const int idx = vb * 256 + opq_tid();
    const int pp = idx & 63, g = (idx >> 6) & 15, l = idx >> 10;
    const float lre = -__expf(p.in[7][idx]), lim = p.in[8][idx];
    const float dt = __expf(p.in[14][l * 16 + g]);
    float* pw = (float*)(wsb(p) + WS_PW) + ((size_t)(l * 16 + g) * 65) * 128;
    for (int d = 0; d <= 64; ++d) {
        const float mag = expf(lre * dt * (float)d); float sn, cs; sincosf(lim * dt * (float)d, &sn, &cs);
        pw[d * 128 + pp * 2] = mag * cs; pw[d * 128 + pp * 2 + 1] = mag * sn;
    }
    const float mag = expf(lre * dt); float sn, cs; sincosf(lim * dt, &sn, &cs);
    const float are = mag * cs, aim = mag * sn;
    const float den = lre * lre + lim * lim, P = are - 1.f, Q = aim;
    const float fre = (P * lre + Q * lim) / den, fim = (Q * lre - P * lim) / den;
    float* bb = (float*)(wsb(p) + WS_BB) + (size_t)idx * 32;
    for (int h = 0; h < 16; ++h) { const float br = p.in[9][(size_t)idx * 16 + h], bi = p.in[10][(size_t)idx * 16 + h]; bb[h * 2] = fre * br - fim * bi; bb[h * 2 + 1] = fre * bi + fim * br; }
}
DI void it_ssm_kt(const Params& p, int vb, unsigned char* sm) {
    float* cz = (float*)sm;
    float* bz = (float*)(sm + 8192);
    float* pz = (float*)(sm + 16384);
    const int tid = opq_tid();
    const int lg = vb >> 3, d0 = (vb & 7) * 8;
    const float* PW = (const float*)(wsb(p) + WS_PW) + ((size_t)lg * 65 + d0) * 128;
    const float* BB = (const float*)(wsb(p) + WS_BB) + (size_t)lg * 64 * 32;
    __syncthreads();
    for (int i = tid; i < 1024; i += 256) { const int q = i >> 4, h = i & 15; cz[i * 2] = p.in[11][((size_t)lg * 16 + h) * 64 + q]; cz[i * 2 + 1] = p.in[12][((size_t)lg * 16 + h) * 64 + q]; }
    for (int i = tid; i < 2048; i += 256) bz[i] = BB[i];
    for (int i = tid; i < 1024; i += 256) pz[i] = PW[i];
    __syncthreads();
    const int h = tid >> 4, hh = tid & 15;
    float acc[8];
#pragma unroll
    for (int d = 0; d < 8; ++d) acc[d] = 0.f;
    for (int q = 0; q < 64; ++q) {
        const float cr = cz[(q * 16 + h) * 2], ci = cz[(q * 16 + h) * 2 + 1], br = bz[(q * 16 + hh) * 2], bi = bz[(q * 16 + hh) * 2 + 1];
        const float xr = cr * br - ci * bi, xi = cr * bi + ci * br;
#pragma unroll
        for (int d = 0; d < 8; ++d) acc[d] += xr * pz[(d * 64 + q) * 2] - xi * pz[(d * 64 + q) * 2 + 1];
    }
    bf16* KT = (bf16*)(wsb(p) + WS_KT) + ((size_t)lg * 64 + d0) * 256;
#pragma unroll
    for (int d = 0; d < 8; ++d) KT[d * 256 + tid] = f2bf(acc[d]);
    __syncthreads();
}
DI void ssm_tab_entry(const Params& p, size_t idx) {
    const size_t NE = (size_t)2 * 16 * 128 * 1024;
    const float* PW = (const float*)(wsb(p) + WS_PW); const float* BB = (const float*)(wsb(p) + WS_BB);
    if (idx < NE) {
        const int kk = idx & 1023, pp = (idx >> 10) & 127; const int lg = (int)(idx >> 17);
        const int i = kk >> 4, hh = kk & 15, pq = pp & 63, part = pp >> 6;
        const float* pw = PW + ((size_t)lg * 65 + (63 - i)) * 128 + pq * 2; const float* bb = BB + ((size_t)lg * 64 + pq) * 32 + hh * 2;
        const float v = part ? (pw[0] * bb[1] + pw[1] * bb[0]) : (pw[0] * bb[0] - pw[1] * bb[1]);
        ((bf16*)(wsb(p) + WS_E))[idx] = f2bf(v);
    } else if (idx < 2 * NE) {
        const size_t e = idx - NE; const int pp = e & 127, jh = (e >> 7) & 1023; const int lg = (int)(e >> 17);
        const int j = jh >> 4, h = jh & 15, pq = pp & 63, part = pp >> 6;
        const float* pw = PW + ((size_t)lg * 65 + (j + 1)) * 128 + pq * 2;
        const float cr = p.in[11][((size_t)lg * 16 + h) * 64 + pq], ci = p.in[12][((size_t)lg * 16 + h) * 64 + pq];
        const float v = part ? -(cr * pw[1] + ci * pw[0]) : (cr * pw[0] - ci * pw[1]);
        ((bf16*)(wsb(p) + WS_G))[e] = f2bf(v);
    } else {
        const size_t e = idx - 2 * NE; if (e >= (size_t)2 * 16 * 64 * 256) return;
        const int hh = e & 15, h = (e >> 4) & 15, d = (e >> 8) & 63; const int lg = (int)(e >> 14);
        const float* pw = PW + ((size_t)lg * 65 + d) * 128; const float* bb = BB + (size_t)lg * 64 * 32 + hh * 2;
        const float* cr = p.in[11] + ((size_t)lg * 16 + h) * 64; const float* ci = p.in[12] + ((size_t)lg * 16 + h) * 64;
        float s = 0;
        for (int q = 0; q < 64; ++q) { const float zr = pw[q * 2] * bb[q * 32] - pw[q * 2 + 1] * bb[q * 32 + 1], zi = pw[q * 2] * bb[q * 32 + 1] + pw[q * 2 + 1] * bb[q * 32]; s += cr[q] * zr - ci[q] * zi; }
        ((bf16*)(wsb(p) + WS_KT))[e] = f2bf(s);
    }
}
DI void norm_mod_row(const float* __restrict__ xrow, const float* __restrict__ g, const float* __restrict__ sh, const float* __restrict__ sc, bf16* __restrict__ hrow, int lane) {
    float4 v[4]; float ss = 0;
#pragma unroll
    for (int j = 0; j < 4; ++j) { v[j] = *(const float4*)(xrow + 4 * lane + 256 * j); ss += v[j].x * v[j].x + v[j].y * v[j].y + v[j].z * v[j].z + v[j].w * v[j].w; }
    ss = wave_sum(ss);
    const float r = rsqrtf(ss * (1.f / 1024.f) + 1e-6f);
#pragma unroll
    for (int j = 0; j < 4; ++j) {
        const int c = 4 * lane + 256 * j;
        const float4 gg = *(const float4*)(g + c), s1 = *(const float4*)(sc + c), s0 = *(const float4*)(sh + c);
        u32x2 o; o.x = cvt_pk_bf16(v[j].x * r * gg.x * (1.f + s1.x) + s0.x, v[j].y * r * gg.y * (1.f + s1.y) + s0.y);
        o.y = cvt_pk_bf16(v[j].z * r * gg.z * (1.f + s1.z) + s0.z, v[j].w * r * gg.w * (1.f + s1.w) + s0.w);
        *(u32x2*)(hrow + c) = o;
    }
}
constexpr int GP = 72;
template <class Epi>
DI void gemm_tile(const bf16* __restrict__ A, int lda, const bf16* __restrict__ Bt, int ldb, int K, int m0, int n0, bf16* lds, const Epi& epi) {
    bf16* As = lds; bf16* Bs = lds + 128 * GP;
    const int tid = opq_tid(), lane = tid & 63, wave = tid >> 6, wm = wave >> 1, wn = wave & 1;
    const int fr = lane & 15, fq = lane >> 4;
    const int lrow = tid >> 3, lch = tid & 7;
    f32x4 acc[4][4];
#pragma unroll
    for (int i = 0; i < 4; ++i)
#pragma unroll
        for (int j = 0; j < 4; ++j) acc[i][j] = (f32x4){0.f, 0.f, 0.f, 0.f};
    bf16x8 ra[4], rb[4];
    const bf16* Ag = A + (size_t)(m0 + lrow) * lda + lch * 8;
    const bf16* Bg = Bt + (size_t)(n0 + lrow) * ldb + lch * 8;
#pragma unroll
    for (int i = 0; i < 4; ++i) { ra[i] = ld16(Ag + (size_t)32 * i * lda); rb[i] = ld16(Bg + (size_t)32 * i * ldb); }
    const int nk = K / 64;
    for (int kt = 0; kt < nk; ++kt) {
        __syncthreads();
#pragma unroll
        for (int i = 0; i < 4; ++i) { *(bf16x8*)(As + (lrow + 32 * i) * GP + lch * 8) = ra[i]; *(bf16x8*)(Bs + (lrow + 32 * i) * GP + lch * 8) = rb[i]; }
        __syncthreads();
        if (kt + 1 < nk) {
#pragma unroll
            for (int i = 0; i < 4; ++i) { ra[i] = ld16(Ag + (size_t)32 * i * lda + (kt + 1) * 64); rb[i] = ld16(Bg + (size_t)32 * i * ldb + (kt + 1) * 64); }
        }
#pragma unroll
        for (int ks = 0; ks < 2; ++ks) {
            bf16x8 fa[4], fb[4];
#pragma unroll
            for (int i = 0; i < 4; ++i) { fa[i] = ld16(Bs + (64 * wn + 16 * i + fr) * GP + 32 * ks + 8 * fq); fb[i] = ld16(As + (64 * wm + 16 * i + fr) * GP + 32 * ks + 8 * fq); }
#pragma unroll
            for (int i = 0; i < 4; ++i)
#pragma unroll
                for (int j = 0; j < 4; ++j) acc[i][j] = MFMA16(fa[i], fb[j], acc[i][j]);
        }
    }
#pragma unroll
    for (int i = 0; i < 4; ++i)
#pragma unroll
        for (int j = 0; j < 4; ++j) epi(m0 + 64 * wm + 16 * j + fr, n0 + 64 * wn + 16 * i + 4 * fq, acc[i][j]);
}
struct EpiBf16 { bf16* C; int ldc; DI void operator()(int r, int c, f32x4 v) const { u32x2 o; o.x = cvt_pk_bf16(v[0], v[1]); o.y = cvt_pk_bf16(v[2], v[3]); *(u32x2*)(C + (size_t)r * ldc + c) = o; } };
struct EpiResid { const float* xin; float* xout; const float* gate;
    DI void operator()(int r, int c, f32x4 v) const { const float4 x = *(const float4*)(xin + (size_t)r * 1024 + c); const float4 g = *(const float4*)(gate + (size_t)(r >> 12) * 6144 + c);
        float4 o; o.x = x.x + g.x * v[0]; o.y = x.y + g.y * v[1]; o.z = x.z + g.z * v[2]; o.w = x.w + g.w * v[3]; *(float4*)(xout + (size_t)r * 1024 + c) = o; } };
struct EpiGlu { const bf16* yg; const float* bglu; bf16* mix;
    DI void operator()(int r, int c, f32x4 v) const { const u32x2 y = *(const u32x2*)(yg + (size_t)r * 256 + c); const float4 b = *(const float4*)(bglu + c);
        u32x2 o; o.x = cvt_pk_bf16(bflo(y.x) * sigmoidf(v[0] + b.x), bfhi(y.x) * sigmoidf(v[1] + b.y)); o.y = cvt_pk_bf16(bflo(y.y) * sigmoidf(v[2] + b.z), bfhi(y.y) * sigmoidf(v[3] + b.w));
        *(u32x2*)(mix + (size_t)r * KMIX + c) = o; } };

DI unsigned off_b(unsigned row, unsigned ch) { return 256u * row + 16u * (ch ^ (((row & 3u) << 2) | ((row >> 2) & 3u))); }
#define TR8(o0, o1, o2, o3, o4, o5, o6, o7, a0, a1, a2, a3, a4, a5, a6, a7)                                                                         \
    asm volatile("s_waitcnt lgkmcnt(0)\n\t"                                                                                                         \
                 "ds_read_b64_tr_b16 %0, %8\n\tds_read_b64_tr_b16 %1, %9\n\tds_read_b64_tr_b16 %2, %10\n\tds_read_b64_tr_b16 %3, %11\n\t"           \
                 "ds_read_b64_tr_b16 %4, %12\n\tds_read_b64_tr_b16 %5, %13\n\tds_read_b64_tr_b16 %6, %14\n\tds_read_b64_tr_b16 %7, %15\n\t"         \
                 "s_waitcnt lgkmcnt(0)"                                                                                                             \
                 : "=&v"(o0), "=&v"(o1), "=&v"(o2), "=&v"(o3), "=&v"(o4), "=&v"(o5), "=&v"(o6), "=&v"(o7)                                           \
                 : "v"(a0), "v"(a1), "v"(a2), "v"(a3), "v"(a4), "v"(a5), "v"(a6), "v"(a7)                                                           \
                 : "memory")

DI void it_kvn(const Params& p, int l, int vb) {
    const int lane = opq_tid() & 63, wave = opq_tid() >> 6;
    const bf16* proj = (const bf16*)(wsb(p) + WS_PROJ); bf16* kvn = (bf16*)(wsb(p) + WS_KVN);
    const float g0 = p.in[19][l * 128 + 2 * lane], g1 = p.in[19][l * 128 + 2 * lane + 1];
    for (int i = 0; i < 16; ++i) {
        const int row = vb * 64 + i * 4 + wave;
        const unsigned u = *(const unsigned*)(proj + (size_t)row * NPROJ + C_CKV + 2 * lane);
        const float a = bflo(u), b = bfhi(u);
        const float ss = wave_sum(a * a + b * b);
        const float r = rsqrtf(ss * (1.f / 128.f) + 1e-6f);
        *(unsigned*)(kvn + (size_t)row * 128 + 2 * lane) = cvt_pk_bf16(a * r * g0, b * r * g1);
    }
}

DI void it_ssm_a(const Params& p, int l, int item) {
    const int lane = opq_tid() & 63, wave = opq_tid() >> 6, fr = lane & 15, fq = lane >> 4;
    const bf16* proj = (const bf16*)(wsb(p) + WS_PROJ);
    float* sloc = (float*)(wsb(p) + WS_SLOC);
    const int g = item & 15, rt = item >> 4;
    const bf16* E = (const bf16*)(wsb(p) + WS_E) + ((size_t)(l * 16 + g) * 128) * 1024;
    const int R = 16 * rt + fr, b = R >> 6, k = R & 63;
    const bf16* arow = proj + ((size_t)b * 4096 + 64 * k + (fq >> 1)) * NPROJ + C_UA + 16 * g + 8 * (fq & 1);
    f32x4 acc[2] = {(f32x4){0, 0, 0, 0}, (f32x4){0, 0, 0, 0}};
#pragma unroll 4
    for (int ks = 0; ks < 32; ++ks) {
        const bf16x8 a = ld16(arow + (size_t)(2 * ks) * NPROJ);
#pragma unroll
        for (int c = 0; c < 2; ++c) { const int ct = 2 * wave + c; const bf16x8 bf = ld16(E + (size_t)(16 * ct + fr) * 1024 + 32 * ks + 8 * fq); acc[c] = MFMA16(a, bf, acc[c]); }
    }
#pragma unroll
    for (int c = 0; c < 2; ++c)
#pragma unroll
        for (int i = 0; i < 4; ++i) sloc[((size_t)(16 * rt + 4 * fq + i) * 16 + g) * 128 + 16 * (2 * wave + c) + fr] = acc[c][i];
}

DI void it_ssm_c(const Params& p, int l, int item, unsigned char* sm) {
    bf16* sst = (bf16*)sm;
    bf16* ktl = (bf16*)(sm + 17408);
    const int tid = opq_tid(), lane = tid & 63, wave = tid >> 6, fr = lane & 15, fq = lane >> 4;
    const bf16* proj = (const bf16*)(wsb(p) + WS_PROJ);
    const float* sloc = (const float*)(wsb(p) + WS_SLOC);
    bf16* yg = (bf16*)(wsb(p) + WS_YG);
    const int jq = item & 3, g = (item >> 2) & 15, b = item >> 6;
    const bf16* KT = (const bf16*)(wsb(p) + WS_KT) + (size_t)(l * 16 + g) * 64 * 256;
    __syncthreads();
#pragma unroll
    for (int i = 0; i < 8; ++i) *(bf16x8*)(ktl + (i * 256 + tid) * 8) = ld16(KT + (size_t)(i * 256 + tid) * 8);
    if (wave == 0) {
        const float* pw64 = (const float*)(wsb(p) + WS_PW) + ((size_t)(l * 16 + g) * 65 + 64) * 128 + lane * 2;
        const float ar = pw64[0], ai = pw64[1];
        float sr = 0, si = 0;
        const float* s = sloc + ((size_t)(b * 64) * 16 + g) * 128;
#pragma unroll 8
        for (int k = 0; k < 64; ++k) {
            sst[k * 136 + lane] = f2bf(sr); sst[k * 136 + 64 + lane] = f2bf(si);
            const float lr = s[(size_t)k * 2048 + lane], li = s[(size_t)k * 2048 + 64 + lane];
            const float nr = ar * sr - ai * si + lr, ni = ar * si + ai * sr + li;
            sr = nr; si = ni;
        }
    }
    __syncthreads();
    const bf16* G = (const bf16*)(wsb(p) + WS_G) + (size_t)(l * 16 + g) * 1024 * 128;
    const int kch = 16 * wave + fr;
    const bf16* arow = proj + ((size_t)b * 4096 + 64 * kch + (fq >> 1)) * NPROJ + C_UA + 16 * g + 8 * (fq & 1);
    const int j0 = 16 * jq;
    f32x4 acc[16];
#pragma unroll
    for (int jj = 0; jj < 16; ++jj) acc[jj] = (f32x4){0, 0, 0, 0};
    const int nks = (j0 + 15) / 2 + 1;
    bf16x8 a_cur = ld16(arow);
    for (int ks = 0; ks < nks; ++ks) {
        const bf16x8 a_nxt = (ks + 1 < nks) ? ld16(arow + (size_t)(2 * ks + 2) * NPROJ) : zero8();
#pragma unroll
        for (int jj = 0; jj < 16; ++jj) {
            const int j = j0 + jj;
            if (2 * ks <= j) {
                const int d = j - 2 * ks - (fq >> 1);
                const bf16x8 bl = ld16(ktl + ((d < 0 ? 0 : d) * 16 + fr) * 16 + 8 * (fq & 1));
                const bf16x8 bf = d >= 0 ? bl : zero8();
                acc[jj] = MFMA16(a_cur, bf, acc[jj]);
            }
        }
        a_cur = a_nxt;
    }
#pragma unroll
    for (int ks = 0; ks < 4; ++ks) {
        const bf16x8 a = ld16(sst + kch * 136 + 32 * ks + 8 * fq);
        bf16x8 bfr[16];
#pragma unroll
        for (int jj = 0; jj < 16; ++jj) bfr[jj] = ld16(G + ((size_t)((j0 + jj) * 16 + fr)) * 128 + 32 * ks + 8 * fq);
#pragma unroll
        for (int jj = 0; jj < 16; ++jj) acc[jj] = MFMA16(a, bfr[jj], acc[jj]);
    }
    const float dsk = p.in[13][l * 256 + 16 * g + fr];
#pragma unroll
    for (int jj = 0; jj < 16; ++jj) {
#pragma unroll
        for (int i = 0; i < 4; ++i) {
            const size_t tok = (size_t)b * 4096 + 64 * (16 * wave + 4 * fq + i) + j0 + jj;
            const float u = bf2f(proj[tok * NPROJ + C_UA + 16 * g + fr]);
            yg[tok * 256 + 16 * g + fr] = f2bf(gelu_tanh(acc[jj][i] + dsk * u));
        }
    }
}

DI void it_gmlp(const Params& p, int l, int item, unsigned char* sm) {
    bf16* vnT = (bf16*)sm;
    const int tid = opq_tid(), lane = tid & 63, wave = tid >> 6, fr = lane & 15, fq = lane >> 4;
    const bf16* proj = (const bf16*)(wsb(p) + WS_PROJ); bf16* mix = (bf16*)(wsb(p) + WS_MIX);
    const int h = item & 3, blk = item >> 2;
    const size_t tok0 = (size_t)blk * 128;
    __syncthreads();
    {
        const int row = tid >> 1, half = tid & 1;
        const bf16* vp = proj + (tok0 + row) * NPROJ + C_VB + 64 * h + 32 * half;
        float v[32]; float s = 0;
#pragma unroll
        for (int q = 0; q < 4; ++q) { const bf16x8 t = ld16(vp + 8 * q);
#pragma unroll
            for (int e = 0; e < 8; ++e) { v[8 * q + e] = bf2f((bf16)t[e]); s += v[8 * q + e]; } }
        s += __shfl_xor(s, 1); const float mu = s * (1.f / 64.f);
        float vs = 0;
#pragma unroll
        for (int e = 0; e < 32; ++e) { const float d = v[e] - mu; vs += d * d; }
        vs += __shfl_xor(vs, 1); const float r = rsqrtf(vs * (1.f / 64.f) + 1e-6f);
#pragma unroll
        for (int e = 0; e < 32; ++e) vnT[(32 * half + e) * 136 + row] = f2bf((v[e] - mu) * r);
    }
    __syncthreads();
    const bf16* W = (const bf16*)(wsb(p) + WS_GW) + (size_t)(l * 4 + h) * 128 * 128;
    f32x4 acc[4][2];
#pragma unroll
    for (int i = 0; i < 4; ++i) { acc[i][0] = (f32x4){0, 0, 0, 0}; acc[i][1] = (f32x4){0, 0, 0, 0}; }
#pragma unroll
    for (int ks = 0; ks < 4; ++ks) {
        bf16x8 fa[4], fb[2];
#pragma unroll
        for (int i = 0; i < 4; ++i) fa[i] = ld16(vnT + (16 * i + fr) * 136 + 32 * ks + 8 * fq);
#pragma unroll
        for (int j = 0; j < 2; ++j) fb[j] = ld16(W + (size_t)(16 * (2 * wave + j) + fr) * 128 + 32 * ks + 8 * fq);
#pragma unroll
        for (int i = 0; i < 4; ++i)
#pragma unroll
            for (int j = 0; j < 2; ++j) acc[i][j] = MFMA16(fa[i], fb[j], acc[i][j]);
    }
#pragma unroll
    for (int j = 0; j < 2; ++j) {
        const int t = 16 * (2 * wave + j) + fr;
        const float bs = p.in[18][(l * 4 + h) * 128 + t];
#pragma unroll
        for (int i = 0; i < 4; ++i) {
            const int d = 16 * i + 4 * fq;
            const u32x2 u = *(const u32x2*)(proj + (tok0 + t) * NPROJ + C_UB + 64 * h + d);
            u32x2 o; o.x = cvt_pk_bf16(bflo(u.x) * (acc[i][j][0] + bs), bfhi(u.x) * (acc[i][j][1] + bs)); o.y = cvt_pk_bf16(bflo(u.y) * (acc[i][j][2] + bs), bfhi(u.y) * (acc[i][j][3] + bs));
            *(u32x2*)(mix + (tok0 + t) * KMIX + 256 + 64 * h + d) = o;
        }
    }
}

DI size_t score_row_off(int b, int t) { const int c = t >> 6; return (size_t)b * SCORES_PER_BATCH + (size_t)4096 * (c * (c + 1) / 2) + (size_t)(t & 63) * 64 * (c + 1); }
template <int NR>
DI void dsa_select_impl(const float* __restrict__ srow, int nreg, bf16* __restrict__ so, int lane, unsigned* hist) {
    (void)hist;
    unsigned key[NR];
#pragma unroll
    for (int r = 0; r < NR; ++r) { const float v = srow[64 * r + lane]; key[r] = (r < nreg) ? fkey(v + 0.f) : 0u; }
    unsigned T = 0;
#pragma unroll 1
    for (int bit = 31; bit >= 0; --bit) {
        const unsigned cand = T | (1u << bit);
        unsigned c = 0;
#pragma unroll
        for (int r = 0; r < NR; ++r) asm("v_cmp_ge_u32 vcc, %1, %2\n\tv_addc_co_u32 %0, vcc, 0, %0, vcc" : "+v"(c) : "v"(key[r]), "v"(cand) : "vcc");
        const unsigned cnt = wave_sum_u32(c);
        if (cnt >= 256u) { T = cand; if (cnt == 256u) break; }
    }
    unsigned c = 0;
#pragma unroll
    for (int r = 0; r < NR; ++r) asm("v_cmp_gt_u32 vcc, %1, %2\n\tv_addc_co_u32 %0, vcc, 0, %0, vcc" : "+v"(c) : "v"(key[r]), "v"(T) : "vcc");
    const int need = 256 - (int)wave_sum_u32(c);
    int base = 0, eqb = 0;
    const unsigned long long lt = (1ull << lane) - 1ull;
#pragma unroll
    for (int r = 0; r < NR; ++r) {
        const unsigned long long me = __ballot(key[r] == T);
        const int erank = eqb + __popcll(me & lt);
        const bool take = (key[r] > T) || (key[r] == T && erank < need);
        const unsigned long long mt = __ballot(take);
        if (take) so[base + __popcll(mt & lt)] = (bf16)(64 * r + lane);
        base += __popcll(mt); eqb += __popcll(me);
    }
}
DI void dsa_select_query(const Params& p, int q, int lane, unsigned* hist) {
    const float* scores = (const float*)(wsb(p) + WS_SCORES); bf16* sel = (bf16*)(wsb(p) + WS_SEL);
    const int b = q >> 12, t = q & 4095, c = t >> 6, nreg = c + 1;
    bf16* so = sel + (size_t)q * 256;
    if (nreg <= 4) { for (int r = 0; r < nreg; ++r) so[64 * r + lane] = (bf16)(64 * r + lane); return; }
    const float* srow = scores + score_row_off(b, t);
    if (nreg <= 16) dsa_select_impl<16>(srow, nreg, so, lane, hist);
    else if (nreg <= 32) dsa_select_impl<32>(srow, nreg, so, lane, hist);
    else if (nreg <= 48) dsa_select_impl<48>(srow, nreg, so, lane, hist);
    else dsa_select_impl<64>(srow, nreg, so, lane, hist);
}
DI void it_dsa_index_select(const Params& p, int item, unsigned char* sm) {
    const int lane = opq_tid() & 63, wave = opq_tid() >> 6, fr = lane & 15, fq = lane >> 4;
    const bf16* proj = (const bf16*)(wsb(p) + WS_PROJ); float* scores = (float*)(wsb(p) + WS_SCORES);
    const int c = 63 - (item >> 4), b = (item >> 2) & 3, qg = item & 3;
    if (c >= 4) {
        const int t = 64 * c + 16 * qg + fr;
        const bf16* qrow = proj + ((size_t)b * 4096 + t) * NPROJ;
        bf16x8 qf[4][2];
#pragma unroll
        for (int hh = 0; hh < 4; ++hh)
#pragma unroll
            for (int ks = 0; ks < 2; ++ks) qf[hh][ks] = ld16(qrow + C_QI + 64 * hh + 32 * ks + 8 * fq);
        float w[4];
        { const u32x2 wv = *(const u32x2*)(qrow + C_WI); w[0] = bflo(wv.x) * 0.0625f; w[1] = bfhi(wv.x) * 0.0625f; w[2] = bflo(wv.y) * 0.0625f; w[3] = bfhi(wv.y) * 0.0625f; }
        float* srow = scores + score_row_off(b, t);
        const int ntile = 4 * (c + 1);
        const bf16* kbase = proj + ((size_t)b * 4096 + fr) * NPROJ + C_KI + 8 * fq;
        bf16x8 k0[4], k1[4];
#pragma unroll
        for (int u = 0; u < 4; ++u) { const bf16* krow = kbase + (size_t)16 * (wave + 4 * u) * NPROJ; k0[u] = ld16(krow); k1[u] = ld16(krow + 32); }
        for (int base = wave; base < ntile; base += 16) {
            bf16x8 n0[4], n1[4];
            const bool more = base + 16 < ntile;
            if (more) {
#pragma unroll
                for (int u = 0; u < 4; ++u) { const bf16* krow = kbase + (size_t)16 * (base + 16 + 4 * u) * NPROJ; n0[u] = ld16(krow); n1[u] = ld16(krow + 32); }
            }
#pragma unroll
            for (int u = 0; u < 4; ++u) {
                const int kt = base + 4 * u;
                if (kt >= ntile) break;
                f32x4 sc = {0, 0, 0, 0};
#pragma unroll
                for (int hh = 0; hh < 4; ++hh) {
                    f32x4 a = {0, 0, 0, 0};
                    a = MFMA16(k0[u], qf[hh][0], a); a = MFMA16(k1[u], qf[hh][1], a);
#pragma unroll
                    for (int i = 0; i < 4; ++i) sc[i] += w[hh] * fmaxf(a[i], 0.f);
                }
#pragma unroll
                for (int i = 0; i < 4; ++i) sc[i] += 0.f;
                *(f32x4*)(srow + 16 * kt + 4 * fq) = sc;
            }
            if (more) {
#pragma unroll
                for (int u = 0; u < 4; ++u) { k0[u] = n0[u]; k1[u] = n1[u]; }
            }
        }
        asm volatile("s_waitcnt vmcnt(0)" ::: "memory");
    }
    __syncthreads();
    for (int i = 0; i < 4; ++i) dsa_select_query(p, b * 4096 + 64 * c + 16 * qg + 4 * wave + i, lane, (unsigned*)sm + 1024 * wave);
}
DI void it_dsa_attn(const Params& p, int item, unsigned char* sm) {
    const int lane = opq_tid() & 63, wave = opq_tid() >> 6, fr = lane & 15, fq = lane >> 4;
    unsigned char* tile = sm + wave * 8192;
    bf16* selw = (bf16*)(sm + 32768 + wave * 512);
    const bf16* proj = (const bf16*)(wsb(p) + WS_PROJ); const bf16* kvn = (const bf16*)(wsb(p) + WS_KVN);
    const bf16* sel = (const bf16*)(wsb(p) + WS_SEL); bf16* mix = (bf16*)(wsb(p) + WS_MIX);
    unsigned wr_addr[8], rd_addr[2][4], tr_addr[8][2];
#pragma unroll
    for (int i = 0; i < 8; ++i) wr_addr[i] = off_b(4 * i + fq, fr);
#pragma unroll
    for (int rb = 0; rb < 2; ++rb)
#pragma unroll
        for (int s = 0; s < 4; ++s) rd_addr[rb][s] = off_b(8 * (fr >> 2) + 4 * rb + (fr & 3), 4 * s + fq);
    const unsigned tbase = (unsigned)(size_t)tile;
    {
        const unsigned q4 = fr >> 2, p4 = fr & 3;
#pragma unroll
        for (int c = 0; c < 8; ++c)
#pragma unroll
            for (int t = 0; t < 2; ++t) tr_addr[c][t] = tbase + off_b(8 * fq + 4 * t + q4, 2 * c + (p4 >> 1)) + 8 * (p4 & 1);
    }
    const float slope = fr < 8 ? exp2f(-(float)(fr + 1)) : 0.f;
    for (int qi = 0; qi < 4; ++qi) {
        const int q = item * 16 + wave * 4 + qi;
        const int b = q >> 12, t = q & 4095, c = t >> 6;
        const int nsel = (c + 1) * 64 < 256 ? (c + 1) * 64 : 256;
        const bf16* qa = proj + (size_t)q * NPROJ + C_QA;
        bf16x8 qf[4];
#pragma unroll
        for (int s = 0; s < 4; ++s) qf[s] = fr < 8 ? ld16(qa + fr * 128 + 32 * s + 8 * fq) : zero8();
        const bf16* selp = sel + (size_t)q * 256;
        const bf16* kvb = kvn + (size_t)b * 4096 * 128;
        if (4 * lane < nsel) *(u32x2*)(selw + 4 * lane) = *(const u32x2*)(selp + 4 * lane);
        float m_run = -INFINITY, l_run = 0.f;
        f32x4 o[8];
#pragma unroll
        for (int i = 0; i < 8; ++i) o[i] = (f32x4){0, 0, 0, 0};
        bf16x8 gk[8];
#pragma unroll
        for (int i = 0; i < 8; ++i) { const int key = selw[4 * i + fq]; gk[i] = ld16(kvb + (size_t)key * 128 + 8 * fr); }
        const int nt = nsel / 32;
        for (int ti = 0; ti < nt; ++ti) {
            const bf16x8 kp = ld16(selw + 32 * ti + 8 * fq);
#pragma unroll
            for (int i = 0; i < 8; ++i) *(bf16x8*)(tile + wr_addr[i]) = gk[i];
            if (ti + 1 < nt) {
#pragma unroll
                for (int i = 0; i < 8; ++i) { const int key = selw[32 * (ti + 1) + 4 * i + fq]; gk[i] = ld16(kvb + (size_t)key * 128 + 8 * fr); }
            }
            f32x4 lg[2] = {(f32x4){0, 0, 0, 0}, (f32x4){0, 0, 0, 0}};
#pragma unroll
            for (int rb = 0; rb < 2; ++rb)
#pragma unroll
                for (int s = 0; s < 4; ++s) lg[rb] = MFMA16(ld16(tile + rd_addr[rb][s]), qf[s], lg[rb]);
            float val[8]; float tmax = -INFINITY;
#pragma unroll
            for (int j = 0; j < 8; ++j) { const float dist = fabsf((float)(t - (int)(unsigned short)kp[j])); val[j] = lg[j >> 2][j & 3] - slope * dist; tmax = fmaxf(tmax, val[j]); }
            tmax = fmaxf(tmax, __shfl_xor(tmax, 16)); tmax = fmaxf(tmax, __shfl_xor(tmax, 32));
            const float m_new = fmaxf(m_run, tmax);
            const float scale = __expf(m_run - m_new);
            l_run *= scale;
#pragma unroll
            for (int i = 0; i < 8; ++i) o[i] *= scale;
            float pv[8];
#pragma unroll
            for (int j = 0; j < 8; ++j) { pv[j] = __expf(val[j] - m_new); l_run += pv[j]; }
            m_run = m_new;
            u32x4 pk; pk.x = cvt_pk_bf16(pv[0], pv[1]); pk.y = cvt_pk_bf16(pv[2], pv[3]); pk.z = cvt_pk_bf16(pv[4], pv[5]); pk.w = cvt_pk_bf16(pv[6], pv[7]);
            const bf16x8 pf = __builtin_bit_cast(bf16x8, pk);
            s16x4 tr[8][2];
            TR8(tr[0][0], tr[0][1], tr[1][0], tr[1][1], tr[2][0], tr[2][1], tr[3][0], tr[3][1], tr_addr[0][0], tr_addr[0][1], tr_addr[1][0], tr_addr[1][1], tr_addr[2][0], tr_addr[2][1], tr_addr[3][0], tr_addr[3][1]);
            TR8(tr[4][0], tr[4][1], tr[5][0], tr[5][1], tr[6][0], tr[6][1], tr[7][0], tr[7][1], tr_addr[4][0], tr_addr[4][1], tr_addr[5][0], tr_addr[5][1], tr_addr[6][0], tr_addr[6][1], tr_addr[7][0], tr_addr[7][1]);
#pragma unroll
            for (int cc = 0; cc < 8; ++cc) {
                bf16x8 kf; kf[0] = tr[cc][0][0]; kf[1] = tr[cc][0][1]; kf[2] = tr[cc][0][2]; kf[3] = tr[cc][0][3]; kf[4] = tr[cc][1][0]; kf[5] = tr[cc][1][1]; kf[6] = tr[cc][1][2]; kf[7] = tr[cc][1][3];
                o[cc] = MFMA16(kf, pf, o[cc]);
            }
        }
        float lt = l_run; lt += __shfl_xor(lt, 16); lt += __shfl_xor(lt, 32);
        const float inv = 1.f / lt;
        if (fr < 8) {
#pragma unroll
            for (int cc = 0; cc < 8; ++cc) { u32x2 ov; ov.x = cvt_pk_bf16(o[cc][0] * inv, o[cc][1] * inv); ov.y = cvt_pk_bf16(o[cc][2] * inv, o[cc][3] * inv);
                *(u32x2*)(mix + (size_t)q * KMIX + 512 + fr * 128 + 16 * cc + 4 * fq) = ov; }
        }
    }
}
typedef float f2 __attribute__((ext_vector_type(2)));
#ifndef PEER_FP8_MASK
#define PEER_FP8_MASK 3
#endif
constexpr float U_SCALE = 64.f, V_SCALE = 8.f;
DI unsigned pack4_fp8(float a, float b, float c, float d) { int p = __builtin_amdgcn_cvt_pk_fp8_f32(a, b, 0, false); p = __builtin_amdgcn_cvt_pk_fp8_f32(c, d, p, true); return (unsigned)p; }
DI void conv_chunk_fp8(const float* __restrict__ src, unsigned char* __restrict__ dst, size_t i0, int n16, float sc) {
    for (int i = opq_tid(); i < n16; i += 256) {
        const float4* s4 = (const float4*)src + 4 * (i0 + i);
        const float4 a = s4[0], b = s4[1], c = s4[2], d = s4[3];
        u32x4 o; o.x = pack4_fp8(a.x * sc, a.y * sc, a.z * sc, a.w * sc); o.y = pack4_fp8(b.x * sc, b.y * sc, b.z * sc, b.w * sc);
        o.z = pack4_fp8(c.x * sc, c.y * sc, c.z * sc, c.w * sc); o.w = pack4_fp8(d.x * sc, d.y * sc, d.z * sc, d.w * sc);
        ((u32x4*)dst)[i0 + i] = o;
    }
}
struct PeerLds2 {
    float trans[4][1024];
    unsigned char li[4][2][64][16];
    unsigned short pe[4][8][128];
    float pg[4][8][128];
};
template <int OFF, int NK>
DI void sort16_desc(unsigned (&k)[NK]) {
#pragma unroll
    for (int size = 2; size <= 16; size <<= 1)
#pragma unroll
        for (int stride = size >> 1; stride > 0; stride >>= 1)
#pragma unroll
            for (int i = 0; i < 16; ++i) {
                const int j = i ^ stride;
                if (j > i) {
                    const bool desc = ((i & size) == 0);
                    const unsigned a = k[OFF + i], b = k[OFF + j];
                    const unsigned hi = a > b ? a : b, lo = a > b ? b : a;
                    k[OFF + i] = desc ? hi : lo; k[OFF + j] = desc ? lo : hi;
                }
            }
}
template <int OA, int OB, int NK>
DI void merge_top16(unsigned (&k)[NK]) {
#pragma unroll
    for (int i = 0; i < 16; ++i) { const unsigned a = k[OA + i], b = k[OB + 15 - i]; k[OA + i] = a > b ? a : b; }
#pragma unroll
    for (int stride = 8; stride > 0; stride >>= 1)
#pragma unroll
        for (int i = 0; i < 16; ++i) {
            const int j = i ^ stride;
            if (j > i) { const unsigned a = k[OA + i], b = k[OA + j]; k[OA + i] = a > b ? a : b; k[OA + j] = a > b ? b : a; }
        }
}
DI void peer_retrieve(const Params& p, int l, int tok0, PeerLds2& S, int lane, int wave) {
    const int fr = lane & 15, fq = lane >> 4;
    const bf16* QP = (const bf16*)(wsb(p) + WS_PROJ);
    const bf16* PK = (const bf16*)(wsb(p) + WS_PK) + (size_t)l * 2 * 128 * 64;
    float* trans = S.trans[wave];
    unsigned K1[16], K2[16];
#pragma unroll
    for (int L = 0; L < 2; ++L) {
        f32x4 acc[4][8];
#pragma unroll
        for (int ct = 0; ct < 4; ++ct)
#pragma unroll
            for (int kt = 0; kt < 8; ++kt) acc[ct][kt] = (f32x4){0, 0, 0, 0};
#pragma unroll
        for (int kt = 0; kt < 8; ++kt) {
            const bf16* krow = PK + (size_t)L * 8192 + (size_t)(16 * kt + fr) * 64 + 8 * fq;
            const bf16x8 a0 = ld16(krow), a1 = ld16(krow + 32);
#pragma unroll
            for (int ct = 0; ct < 4; ++ct) {
                const bf16* qrow = QP + (size_t)(tok0 + 2 * ct + (fr >> 3)) * 1024 + 128 * (fr & 7) + 64 * L + 8 * fq;
                acc[ct][kt] = MFMA16(a0, ld16(qrow), acc[ct][kt]); acc[ct][kt] = MFMA16(a1, ld16(qrow + 32), acc[ct][kt]);
            }
        }
        unsigned k[128];
#define PEER_ROUND(kt)                                                                                                                            \
        {                                                                                                                                         \
            _Pragma("unroll") for (int ct = 0; ct < 4; ++ct) *(f32x4*)(trans + ((ct * 4 + fq) * 16 + fr) * 4) = acc[ct][kt];                       \
            _Pragma("unroll") for (int sq = 0; sq < 4; ++sq) {                                                                                     \
                const f32x4 v = *(const f32x4*)(trans + ((fq * 4 + sq) * 16 + fr) * 4);                                                            \
                _Pragma("unroll") for (int i = 0; i < 4; ++i) k[16 * (kt) + sq * 4 + i] = (fkey(v[i]) & ~0x7fu) | (unsigned)(16 * (kt) + 4 * sq + i); \
            }                                                                                                                                     \
            sort16_desc<16 * (kt)>(k);                                                                                                            \
        }
        PEER_ROUND(0) PEER_ROUND(1) merge_top16<0, 16>(k);
        PEER_ROUND(2) PEER_ROUND(3) merge_top16<32, 48>(k); merge_top16<0, 32>(k);
        PEER_ROUND(4) PEER_ROUND(5) merge_top16<64, 80>(k);
        PEER_ROUND(6) PEER_ROUND(7) merge_top16<96, 112>(k); merge_top16<64, 96>(k);
        merge_top16<0, 64>(k);
#undef PEER_ROUND
        u32x4 ib;
        ib.x = (k[0] & 127u) | ((k[1] & 127u) << 8) | ((k[2] & 127u) << 16) | ((k[3] & 127u) << 24);
        ib.y = (k[4] & 127u) | ((k[5] & 127u) << 8) | ((k[6] & 127u) << 16) | ((k[7] & 127u) << 24);
        ib.z = (k[8] & 127u) | ((k[9] & 127u) << 8) | ((k[10] & 127u) << 16) | ((k[11] & 127u) << 24);
        ib.w = (k[12] & 127u) | ((k[13] & 127u) << 8) | ((k[14] & 127u) << 16) | ((k[15] & 127u) << 24);
        *(u32x4*)(S.li[wave][L][lane]) = ib;
#pragma unroll
        for (int i = 0; i < 16; ++i) { if (L == 0) K1[i] = k[i]; else K2[i] = k[i]; }
    }
    float v1[16], v2[16];
#pragma unroll
    for (int i = 0; i < 16; ++i) { v1[i] = __uint_as_float(unkey(K1[i] & ~0x7fu)); v2[i] = __uint_as_float(unkey(K2[i] & ~0x7fu)); }
    unsigned c[64];
    {
        int idx = 0;
#pragma unroll
        for (int a = 0; a < 16; ++a)
#pragma unroll
            for (int b = 0; b < 16; ++b)
                if ((a + 1) * (b + 1) <= 16) { c[idx] = (fkey(v1[a] + v2[b]) & ~0xffu) | (unsigned)(a * 16 + b); ++idx; }
#pragma unroll
        for (int i = 50; i < 64; ++i) c[i] = 0u;
    }
    sort16_desc<0>(c); sort16_desc<16>(c); sort16_desc<32>(c); sort16_desc<48>(c);
    merge_top16<0, 16>(c); merge_top16<32, 48>(c); merge_top16<0, 32>(c);
    float sc[16]; float sum = 0.f;
    {
        const float m = __uint_as_float(unkey(c[0] & ~0xffu));
#pragma unroll
        for (int i = 0; i < 16; ++i) { sc[i] = __expf(__uint_as_float(unkey(c[i] & ~0xffu)) - m); sum += sc[i]; }
    }
    const float inv = 1.f / sum;
    const int tt = 2 * fq + (fr >> 3), head = fr & 7;
    const unsigned char* l1 = S.li[wave][0][lane]; const unsigned char* l2 = S.li[wave][1][lane];
#pragma unroll
    for (int i = 0; i < 16; ++i) {
        const unsigned ab = c[i] & 0xffu;
        const unsigned e = (unsigned)l1[ab >> 4] * 128u + (unsigned)l2[ab & 15u];
        S.pe[wave][tt][head * 16 + i] = (unsigned short)e; S.pg[wave][tt][head * 16 + i] = sc[i] * inv;
    }
}
template <bool FP8>
DI void peer_experts(const Params& p, int l, int tok, int tt, PeerLds2& S, int lane, int wave) {
    const bf16* H = (const bf16*)(wsb(p) + WS_H);
    const unsigned char* UB = wsb(p) + WS_UB; const unsigned char* VB = wsb(p) + WS_VB;
    const float* X = (const float*)(wsb(p) + WS_X);
    const float* modl = (const float*)(wsb(p) + WS_MOD) + (size_t)l * 4 * 6144;
    const int b = tok >> 12;
    const unsigned short* pe = S.pe[wave][tt]; const float* pg = S.pg[wave][tt];
    f2 hp[8];
    u32x4 h0, h1;
    {
        h0 = *(const u32x4*)(H + (size_t)tok * 1024 + 16 * lane); h1 = *(const u32x4*)(H + (size_t)tok * 1024 + 16 * lane + 8);
        hp[0] = (f2){bflo(h0.x), bfhi(h0.x)}; hp[1] = (f2){bflo(h0.y), bfhi(h0.y)}; hp[2] = (f2){bflo(h0.z), bfhi(h0.z)}; hp[3] = (f2){bflo(h0.w), bfhi(h0.w)};
        hp[4] = (f2){bflo(h1.x), bfhi(h1.x)}; hp[5] = (f2){bflo(h1.y), bfhi(h1.y)}; hp[6] = (f2){bflo(h1.z), bfhi(h1.z)}; hp[7] = (f2){bflo(h1.w), bfhi(h1.w)};
    }
    f2 acc[8];
#pragma unroll
    for (int i = 0; i < 8; ++i) acc[i] = (f2){0.f, 0.f};
    const bool b5 = (lane & 32) != 0, b4_ = (lane & 16) != 0, b3 = (lane & 8) != 0;
    const int eidx = (b3 ? 4 : 0) + (b4_ ? 2 : 0) + (b5 ? 1 : 0);
    if constexpr (FP8) {
    for (int e0 = 0; e0 < 128; e0 += 8) {
        u32x4 ur[8], vr[8];
#pragma unroll
        for (int j = 0; j < 8; ++j) {
            const int e = __builtin_amdgcn_readfirstlane((int)pe[e0 + j]);
            ur[j] = *(const u32x4*)(UB + (size_t)e * 1024 + 16 * lane);
            vr[j] = *(const u32x4*)(VB + (size_t)e * 1024 + 16 * lane);
        }
        float d[8];
#pragma unroll
        for (int j = 0; j < 8; ++j) {
            f2 s2 = {0.f, 0.f};
#pragma unroll
            for (int k = 0; k < 4; ++k) {
                const f2 lo = __builtin_amdgcn_cvt_pk_f32_fp8((int)ur[j][k], false), hi = __builtin_amdgcn_cvt_pk_f32_fp8((int)ur[j][k], true);
                s2 = lo * hp[2 * k] + s2; s2 = hi * hp[2 * k + 1] + s2;
            }
            d[j] = s2.x + s2.y;
        }
        float w[4], x2[2], y;
#pragma unroll
        for (int i = 0; i < 4; ++i) { const float keep = b5 ? d[2 * i + 1] : d[2 * i], send = b5 ? d[2 * i] : d[2 * i + 1]; w[i] = keep + __shfl_xor(send, 32); }
#pragma unroll
        for (int i = 0; i < 2; ++i) { const float keep = b4_ ? w[2 * i + 1] : w[2 * i], send = b4_ ? w[2 * i] : w[2 * i + 1]; x2[i] = keep + __shfl_xor(send, 16); }
        { const float keep = b3 ? x2[1] : x2[0], send = b3 ? x2[0] : x2[1]; y = keep + __shfl_xor(send, 8); }
        y += __shfl_xor(y, 4); y += __shfl_xor(y, 2); y += __shfl_xor(y, 1);
        const float sc = gelu_tanh(y * (1.f / U_SCALE)) * pg[e0 + eidx] * (1.f / V_SCALE);
#pragma unroll
        for (int j = 0; j < 8; ++j) {
            const float sj = __uint_as_float((unsigned)__builtin_amdgcn_readlane((int)__float_as_uint(sc), 32 * (j & 1) + 16 * ((j >> 1) & 1) + 8 * ((j >> 2) & 1)));
            const f2 sj2 = {sj, sj};
#pragma unroll
            for (int k = 0; k < 4; ++k) {
                const f2 lo = __builtin_amdgcn_cvt_pk_f32_fp8((int)vr[j][k], false), hi = __builtin_amdgcn_cvt_pk_f32_fp8((int)vr[j][k], true);
                acc[2 * k] = lo * sj2 + acc[2 * k]; acc[2 * k + 1] = hi * sj2 + acc[2 * k + 1];
            }
        }
    }
    } else {
    for (int e0 = 0; e0 < 128; e0 += 4) {
        const bf16* UBb = (const bf16*)UB; const bf16* VBb = (const bf16*)VB;
        u32x4 ur[4][2], vr[4][2];
#pragma unroll
        for (int j = 0; j < 4; ++j) {
            const int e = __builtin_amdgcn_readfirstlane((int)pe[e0 + j]);
            ur[j][0] = *(const u32x4*)(UBb + (size_t)e * 1024 + 16 * lane); ur[j][1] = *(const u32x4*)(UBb + (size_t)e * 1024 + 16 * lane + 8);
            vr[j][0] = *(const u32x4*)(VBb + (size_t)e * 1024 + 16 * lane); vr[j][1] = *(const u32x4*)(VBb + (size_t)e * 1024 + 16 * lane + 8);
        }
        float d[4];
#pragma unroll
        for (int j = 0; j < 4; ++j) {
            float sa = 0.f, sb = 0.f;
            sa = dot2bf(ur[j][0].x, h0.x, sa); sb = dot2bf(ur[j][0].y, h0.y, sb); sa = dot2bf(ur[j][0].z, h0.z, sa); sb = dot2bf(ur[j][0].w, h0.w, sb);
            sa = dot2bf(ur[j][1].x, h1.x, sa); sb = dot2bf(ur[j][1].y, h1.y, sb); sa = dot2bf(ur[j][1].z, h1.z, sa); sb = dot2bf(ur[j][1].w, h1.w, sb);
            d[j] = sa + sb;
        }
        float w[2], y;
#pragma unroll
        for (int i = 0; i < 2; ++i) { const float keep = b5 ? d[2 * i + 1] : d[2 * i], send = b5 ? d[2 * i] : d[2 * i + 1]; w[i] = keep + __shfl_xor(send, 32); }
        { const float keep = b4_ ? w[1] : w[0], send = b4_ ? w[0] : w[1]; y = keep + __shfl_xor(send, 16); }
        y += __shfl_xor(y, 8); y += __shfl_xor(y, 4); y += __shfl_xor(y, 2); y += __shfl_xor(y, 1);
        const float sc = gelu_tanh(y) * pg[e0 + (b4_ ? 2 : 0) + (b5 ? 1 : 0)];
#pragma unroll
        for (int j = 0; j < 4; ++j) {
            const float sj = __uint_as_float((unsigned)__builtin_amdgcn_readlane((int)__float_as_uint(sc), 32 * (j & 1) + 16 * ((j >> 1) & 1)));
            const f2 sj2 = {sj, sj};
#pragma unroll
            for (int hh = 0; hh < 2; ++hh)
#pragma unroll
                for (int k = 0; k < 4; ++k) { const unsigned dw = vr[j][hh][k]; const f2 vv = {bflo(dw), bfhi(dw)}; acc[4 * hh + k] = vv * sj2 + acc[4 * hh + k]; }
        }
    }
    }
    float xr[16];
    const float* xrow = X + (size_t)tok * 1024 + 16 * lane;
    float* xorow = p.out + (size_t)tok * 1024 + 16 * lane;
    const float* g2 = modl + (size_t)b * 6144 + 5 * 1024 + 16 * lane;
    float ss = 0;
#pragma unroll
    for (int q4 = 0; q4 < 4; ++q4) {
        const float4 xv = *(const float4*)(xrow + 4 * q4), gv = *(const float4*)(g2 + 4 * q4);
        float4 o; o.x = xv.x + gv.x * acc[2 * q4].x; o.y = xv.y + gv.y * acc[2 * q4].y; o.z = xv.z + gv.z * acc[2 * q4 + 1].x; o.w = xv.w + gv.w * acc[2 * q4 + 1].y;
        if (l == 0) *(float4*)(xorow + 4 * q4) = o;
        xr[4 * q4] = o.x; xr[4 * q4 + 1] = o.y; xr[4 * q4 + 2] = o.z; xr[4 * q4 + 3] = o.w;
        ss += o.x * o.x + o.y * o.y + o.z * o.z + o.w * o.w;
    }
    ss = wave_sum(ss);
    const float r = rsqrtf(ss * (1.f / 1024.f) + 1e-6f);
    if (l == 1) {
#pragma unroll
        for (int q4 = 0; q4 < 4; ++q4) {
            const float4 gv = *(const float4*)(p.in[28] + 16 * lane + 4 * q4);
            float4 o; o.x = xr[4 * q4] * r * gv.x; o.y = xr[4 * q4 + 1] * r * gv.y; o.z = xr[4 * q4 + 2] * r * gv.z; o.w = xr[4 * q4 + 3] * r * gv.w;
            *(float4*)(xorow + 4 * q4) = o;
        }
    } else {
        const float* g = p.in[2] + 1024 + 16 * lane; const float* mod1 = (const float*)(wsb(p) + WS_MOD) + ((size_t)4 + b) * 6144 + 16 * lane;
        bf16* hrow = (bf16*)(wsb(p) + WS_H2) + (size_t)tok * 1024 + 16 * lane;
        float hv[16];
#pragma unroll
        for (int q4 = 0; q4 < 4; ++q4) {
            const float4 gg = *(const float4*)(g + 4 * q4), s1 = *(const float4*)(mod1 + 1024 + 4 * q4), s0 = *(const float4*)(mod1 + 4 * q4);
            hv[4 * q4] = xr[4 * q4] * r * gg.x * (1.f + s1.x) + s0.x; hv[4 * q4 + 1] = xr[4 * q4 + 1] * r * gg.y * (1.f + s1.y) + s0.y;
            hv[4 * q4 + 2] = xr[4 * q4 + 2] * r * gg.z * (1.f + s1.z) + s0.z; hv[4 * q4 + 3] = xr[4 * q4 + 3] * r * gg.w * (1.f + s1.w) + s0.w;
        }
        u32x4 o0, o1;
        o0.x = cvt_pk_bf16(hv[0], hv[1]); o0.y = cvt_pk_bf16(hv[2], hv[3]); o0.z = cvt_pk_bf16(hv[4], hv[5]); o0.w = cvt_pk_bf16(hv[6], hv[7]);
        o1.x = cvt_pk_bf16(hv[8], hv[9]); o1.y = cvt_pk_bf16(hv[10], hv[11]); o1.z = cvt_pk_bf16(hv[12], hv[13]); o1.w = cvt_pk_bf16(hv[14], hv[15]);
        *(u32x4*)(hrow) = o0; *(u32x4*)(hrow + 8) = o1;
    }
}

constexpr int SMEM_BYTES = 64 + 17408 + 32768;
#ifndef REP_ID
#define REP_ID -1
#endif
#ifndef REP_N
#define REP_N 1
#endif
#define NREP(id) ((id) == REP_ID ? REP_N : 1)
__global__ void __launch_bounds__(256, 2) fwd_megakernel(Params p) {
    __shared__ __attribute__((aligned(16))) unsigned char smem[SMEM_BYTES];
    const int tid = threadIdx.x;
    const int G = gridDim.x, bid = blockIdx.x;
    unsigned char* sm = smem + 64;
    volatile int* qslot = (volatile int*)(smem + 16);
    if (tid < 16) ((unsigned*)smem)[tid] = 0u;
    __syncthreads();
    unsigned* ctl = (unsigned*)(wsb(p) + WS_CTL);
    unsigned* qctr = ctl + 4096;
    XcdBarrier bar = xcd_barrier_post(ctl, (volatile LAS unsigned*)smem);
#define PHASE_PTRS unsigned char* ws = wsb(p); const bf16* H = (const bf16*)(ws + WS_H); bf16* PROJ = (bf16*)(ws + WS_PROJ); float* X = (float*)(ws + WS_X); const float* mod = (const float*)(ws + WS_MOD); (void)H; (void)PROJ; (void)X; (void)mod;
    int qn = 0;

    for (int rep = 0; rep < NREP(0); ++rep) {
            PHASE_PTRS
        constexpr int N_MOD = 192, N_LAYER = 768 + 1024 + 512 + 512 + 1024 + 1024 + 64, N_PK = 4, N_GW = 128, N_PW = 8;
        constexpr int NV = N_MOD + 2 * N_LAYER + N_PK + N_GW + N_PW;
        for (int vb = bid; vb < NV; vb += G) {
            int v = vb;
            if (v < N_MOD) { it_mod(p, v, sm); continue; }
            v -= N_MOD;
            if (v < 2 * N_LAYER) {
                const int l = v / N_LAYER; v -= l * N_LAYER;
                bf16* wtin = (bf16*)(ws + WS_WTIN) + (size_t)l * NPROJ * 1024;
                const float* win = p.in[6] + (size_t)l * 1024 * 1732;
                bf16* wtout = (bf16*)(ws + WS_WTOUT) + (size_t)l * 1024 * KMIX;
                const float* wout = p.in[22] + (size_t)l * 1024 * 1024;
                if (v < 768) { it_transpose(TrArgs{win, 1732, 0, 1732, wtin, 1024, 0, 1024, 768, 0, nullptr}, v, sm); }
                else if ((v -= 768) < 1024) { it_transpose(TrArgs{win, 1732, 0, 1732, wtin + (size_t)768 * 1024, 1024, 0, 1024, 1024, 1, p.in[20] + (size_t)l * 8 * 64 * 128}, v, sm); }
                else if ((v -= 1024) < 512) { it_transpose(TrArgs{win, 1732, 1280, 1732, wtin + (size_t)1792 * 1024, 1024, 0, 1024, 512, 0, nullptr}, v, sm); }
                else if ((v -= 512) < 512) { it_transpose(TrArgs{wout, 1024, 0, 1024, wtout, KMIX, 0, 512, 1024, 0, nullptr}, v, sm); }
                else if ((v -= 512) < 1024) { it_transpose(TrArgs{wout, 1024, 0, 1024, wtout, KMIX, 512, 1024, 1024, 2, p.in[21] + (size_t)l * 8 * 128 * 64}, v, sm); }
                else if ((v -= 1024) < 1024) { it_transpose(TrArgs{p.in[23] + (size_t)l * 1024 * 1024, 1024, 0, 1024, (bf16*)(ws + WS_WTQ) + (size_t)l * 1024 * 1024, 1024, 0, 1024, 1024, 0, nullptr}, v, sm); }
                else { v -= 1024; it_transpose(TrArgs{p.in[15] + (size_t)l * 256 * 256, 256, 0, 256, (bf16*)(ws + WS_WTGLU) + (size_t)l * 256 * 256, 256, 0, 256, 256, 0, nullptr}, v, sm); }
                continue;
            }
            v -= 2 * N_LAYER;
            if (v < N_PK) { const int l = v >> 1, w = v & 1; conv_chunk(p.in[24 + w] + (size_t)l * 8192, (bf16*)(ws + WS_PK) + (size_t)l * 16384 + w * 8192, 0, 1024); continue; }
            v -= N_PK;
            if (v < N_GW) { it_gw(p, v); continue; }
            v -= N_GW;
            it_ssm_pw(p, v);
        }
        xcd_barrier(bar);
    }
    for (int rep = 0; rep < NREP(1); ++rep) {
            PHASE_PTRS
        constexpr int N_NORM = NTOK / 4, N_TAB = 4096, N_KT = 256;
        for (int vb = bid; vb < N_NORM + N_TAB + N_KT; vb += G) {
            if (vb < N_KT) { it_ssm_kt(p, vb, sm); continue; }
            if (vb - N_KT < N_NORM) {
                const int t_ = opq_tid(); const int row = (vb - N_KT) * 4 + (t_ >> 6);
                const float* m0 = (const float*)(wsb(p) + WS_MOD) + (size_t)(row >> 12) * 6144;
                norm_mod_row(p.in[0] + (size_t)row * 1024, p.in[2], m0, m0 + 1024, (bf16*)(wsb(p) + WS_H) + (size_t)row * 1024, t_ & 63);
            } else {
                const size_t base = (size_t)(vb - N_KT - N_NORM) * 2048;
                for (int e = 0; e < 8; ++e) ssm_tab_entry(p, base + e * 256 + opq_tid());
            }
        }
        xcd_barrier(bar);
    }

    for (int l = 0; l < 2; ++l) {
        const float* xin = l == 0 ? p.in[0] : p.out;
        for (int rep = 0; rep < NREP(2 + 8 * l); ++rep) {
            PHASE_PTRS
            const EpiBf16 epi{PROJ, NPROJ};
            const bf16* Bt = (const bf16*)(ws + WS_WTIN) + (size_t)l * NPROJ * 1024;
            const bf16* Hin = l == 0 ? H : (const bf16*)(ws + WS_H2);
            for (int t = bid; t < (NTOK / 128) * (NPROJ / 128); t += G) { gemm_tile(Hin, 1024, Bt, 1024, 1024, (t / (NPROJ / 128)) * 128, (t % (NPROJ / 128)) * 128, (bf16*)sm, epi); __syncthreads(); }
            xcd_barrier(bar);
        }
        for (int rep = 0; rep < NREP(3 + 8 * l); ++rep) {
            PHASE_PTRS
            unsigned* ctr = qctr + 64 * (qn++);
            for (;;) {
                const int it = q_next(ctr, qslot);
                if (it >= 2048) break;
                if (it < 1024) it_dsa_index_select(p, it, sm);
                else if (it < 1536) it_gmlp(p, l, it - 1024, sm);
                else if (it < 1792) it_ssm_a(p, l, it - 1536);
                else it_kvn(p, l, it - 1792);
            }
            xcd_barrier(bar);
        }
        for (int rep = 0; rep < NREP(4 + 8 * l); ++rep) {
            PHASE_PTRS
            unsigned* ctr = qctr + 64 * (qn++);
            for (;;) {
                const int it = q_next(ctr, qslot);
                if (it >= 256 + 1024 + 512) break;
                if (it < 256) it_ssm_c(p, l, it, sm);
                else if (it < 1280) it_dsa_attn(p, it - 256, sm);
                else {
                    const int v = it - 1280, w = v >> 8, ch = v & 255;
                    if (!(PEER_FP8_MASK & (1 << l))) conv_chunk(p.in[26 + w] + (size_t)l * NEXP * 1024, (bf16*)(ws + (w ? WS_VB : WS_UB)), (size_t)ch * 8192, 8192);
                    else conv_chunk_fp8(p.in[26 + w] + (size_t)l * NEXP * 1024, ws + (w ? WS_VB : WS_UB), (size_t)ch * 4096, 4096, w ? V_SCALE : U_SCALE);
                }
            }
            xcd_barrier(bar);
        }
        for (int rep = 0; rep < NREP(5 + 8 * l); ++rep) {
            PHASE_PTRS
            const EpiGlu epi{(const bf16*)(ws + WS_YG), p.in[16] + l * 256, (bf16*)(ws + WS_MIX)};
            const bf16* Bt = (const bf16*)(ws + WS_WTGLU) + (size_t)l * 256 * 256;
            for (int t = bid; t < (NTOK / 128) * 2; t += G) { gemm_tile((const bf16*)(ws + WS_YG), 256, Bt, 256, 256, (t >> 1) * 128, (t & 1) * 128, (bf16*)sm, epi); __syncthreads(); }
            xcd_barrier(bar);
        }
        for (int rep = 0; rep < NREP(6 + 8 * l); ++rep) {
            PHASE_PTRS
            const EpiResid epi{xin, X, mod + (size_t)l * 4 * 6144 + 2048};
            const bf16* Bt = (const bf16*)(ws + WS_WTOUT) + (size_t)l * 1024 * KMIX;
            for (int t = bid; t < (NTOK / 128) * 8; t += G) { gemm_tile((const bf16*)(ws + WS_MIX), KMIX, Bt, KMIX, KMIX, (t >> 3) * 128, (t & 7) * 128, (bf16*)sm, epi); __syncthreads(); }
            xcd_barrier(bar);
        }
        for (int rep = 0; rep < NREP(7 + 8 * l); ++rep) {
            PHASE_PTRS
            for (int vb = bid; vb < NTOK / 4; vb += G) {
                const int t_ = opq_tid(); const int row = vb * 4 + (t_ >> 6);
                const float* m0 = (const float*)(wsb(p) + WS_MOD) + ((size_t)l * 4 + (row >> 12)) * 6144 + 3072;
                norm_mod_row((const float*)(wsb(p) + WS_X) + (size_t)row * 1024, p.in[3] + l * 1024, m0, m0 + 1024, (bf16*)(wsb(p) + WS_H) + (size_t)row * 1024, t_ & 63);
            }
            xcd_barrier(bar);
        }
        for (int rep = 0; rep < NREP(8 + 8 * l); ++rep) {
            PHASE_PTRS
            const EpiBf16 epi{PROJ, 1024};
            const bf16* Bt = (const bf16*)(ws + WS_WTQ) + (size_t)l * 1024 * 1024;
            for (int t = bid; t < (NTOK / 128) * 8; t += G) { gemm_tile(H, 1024, Bt, 1024, 1024, (t >> 3) * 128, (t & 7) * 128, (bf16*)sm, epi); __syncthreads(); }
            xcd_barrier(bar);
        }
        for (int rep = 0; rep < NREP(9 + 8 * l); ++rep) {
            PHASE_PTRS
            PeerLds2& S = *(PeerLds2*)sm;
            __syncthreads();
            const int t_ = opq_tid(), lane_ = t_ & 63, wave_ = t_ >> 6;
            for (int wb = bid * 4 + wave_; wb < NTOK / 8; wb += G * 4) {
                peer_retrieve(p, l, wb * 8, S, lane_, wave_);
                for (int tt = 0; tt < 8; ++tt) {
                    if (PEER_FP8_MASK & (1 << l)) peer_experts<true>(p, l, wb * 8 + tt, tt, S, lane_, wave_);
                    else peer_experts<false>(p, l, wb * 8 + tt, tt, S, lane_, wave_);
                }
            }
            if (l == 0 || rep + 1 < NREP(9 + 8 * l)) xcd_barrier(bar);
        }
    }
}

extern "C" void kernel_launch(void* const* d_in, const int* in_sizes, int n_in, void* d_out, int out_size, void* d_ws, size_t ws_size, hipStream_t stream) {
    if (n_in != 29 || ws_size < WS_END) { fprintf(stderr, "kernel_launch: bad args (n_in %d, ws %zu, need %zu)\n", n_in, ws_size, (size_t)WS_END); return; }
    static int grid = 0;
    if (grid == 0) {
        int dev = 0, cus = 0, per_cu = 0;
        if (hipGetDevice(&dev) != hipSuccess || hipDeviceGetAttribute(&cus, hipDeviceAttributeMultiprocessorCount, dev) != hipSuccess) { grid = -1; return; }
        if (hipOccupancyMaxActiveBlocksPerMultiprocessor(&per_cu, (const void*)fwd_megakernel, 256, 0) != hipSuccess || per_cu < 1) { fprintf(stderr, "kernel_launch: occupancy query failed (%d)\n", per_cu); grid = -1; return; }
        const int use = per_cu < 2 ? per_cu : 2;
        grid = cus * use;
    }
    if (grid < 0) return;
    if (hipMemsetAsync((char*)d_ws + WS_CTL, 0, 65536, stream) != hipSuccess) { fprintf(stderr, "kernel_launch: memset failed\n"); return; }
    Params p{};
    for (int i = 0; i < 29; ++i) p.in[i] = (const float*)d_in[i];
    p.out = (float*)d_out; p.ws = (unsigned char*)d_ws;
    void* args[] = {&p};
    const hipError_t e = hipLaunchCooperativeKernel((const void*)fwd_megakernel, dim3(grid), dim3(256), args, 0, stream);
    if (e != hipSuccess) fprintf(stderr, "kernel_launch: cooperative launch failed: %s (grid %d)\n", hipGetErrorString(e), grid);
}
```

```cpp
#include <hip/hip_runtime.h>
#include <cstdint>
#include <cstdio>

typedef unsigned short bf16;
typedef short bf16x8 __attribute__((ext_vector_type(8)));
typedef short s16x4 __attribute__((ext_vector_type(4)));
typedef float f32x4 __attribute__((ext_vector_type(4)));
typedef unsigned u32x4 __attribute__((ext_vector_type(4)));
typedef unsigned u32x2 __attribute__((ext_vector_type(2)));
typedef __bf16 bf2 __attribute__((ext_vector_type(2)));
#define DI __device__ __forceinline__
#define MFMA16(a, b, c) __builtin_amdgcn_mfma_f32_16x16x32_bf16((a), (b), (c), 0, 0, 0)

constexpr int DM = 1024, NB = 4, SEQ = 4096, NTOK = NB * SEQ;
constexpr int NPROJ = 2304;
constexpr int C_UA = 0, C_UB = 256, C_VB = 512, C_QA = 768, C_CKV = 1792, C_QI = 1920, C_KI = 2176, C_WI = 2240;
constexpr int KMIX = 1536;
constexpr int NEXP = 16384;
constexpr size_t SCORES_PER_BATCH = (size_t)4096 * 2080;

constexpr size_t al256(size_t x) { return (x + 255) & ~(size_t)255; }
constexpr size_t WS_CTL = 0;
constexpr size_t WS_MOD = 65536;
constexpr size_t WS_WTIN = al256(WS_MOD + 2 * 4 * 6144 * 4);
constexpr size_t WS_WTOUT = al256(WS_WTIN + (size_t)2 * NPROJ * 1024 * 2);
constexpr size_t WS_WTQ = al256(WS_WTOUT + (size_t)2 * 1024 * KMIX * 2);
constexpr size_t WS_WTGLU = al256(WS_WTQ + (size_t)2 * 1024 * 1024 * 2);
constexpr size_t WS_GW = al256(WS_WTGLU + (size_t)2 * 256 * 256 * 2);
constexpr size_t WS_PK = al256(WS_GW + (size_t)2 * 4 * 128 * 128 * 2);
constexpr size_t WS_PW = al256(WS_PK + (size_t)2 * 2 * 128 * 64 * 2);
constexpr size_t WS_BB = al256(WS_PW + (size_t)2 * 16 * 65 * 64 * 2 * 4);
constexpr size_t WS_E = al256(WS_BB + (size_t)2 * 16 * 64 * 16 * 2 * 4);
constexpr size_t WS_G = al256(WS_E + (size_t)2 * 16 * 128 * 1024 * 2);
constexpr size_t WS_KT = al256(WS_G + (size_t)2 * 16 * 1024 * 128 * 2);
constexpr size_t WS_UB = al256(WS_KT + (size_t)2 * 16 * 64 * 256 * 2);
constexpr size_t WS_VB = al256(WS_UB + (size_t)NEXP * 1024 * 2);
constexpr size_t WS_H = al256(WS_VB + (size_t)NEXP * 1024 * 2);
constexpr size_t WS_PROJ = al256(WS_H + (size_t)NTOK * 1024 * 2);
constexpr size_t WS_SLOC = al256(WS_PROJ + (size_t)NTOK * NPROJ * 2);
constexpr size_t WS_YG = al256(WS_SLOC + (size_t)256 * 16 * 128 * 4);
constexpr size_t WS_KVN = al256(WS_YG + (size_t)NTOK * 256 * 2);
constexpr size_t WS_SEL = al256(WS_KVN + (size_t)NTOK * 128 * 2);
constexpr size_t WS_MIX = al256(WS_SEL + (size_t)NTOK * 256 * 2);
constexpr size_t WS_X = al256(WS_MIX + (size_t)NTOK * KMIX * 2);
constexpr size_t WS_SCORES = al256(WS_X + (size_t)NTOK * 1024 * 4);
constexpr size_t WS_H2 = al256(WS_SCORES + (size_t)NB * SCORES_PER_BATCH * 4);
constexpr size_t WS_END = al256(WS_H2 + (size_t)NTOK * 1024 * 2);

struct Params {
    const float* in[29];
    float* out;
    unsigned char* ws;
};

typedef __bf16 bf2v_t __attribute__((ext_vector_type(2)));
typedef float f2v_t __attribute__((ext_vector_type(2)));
DI unsigned cvt_pk_bf16(float lo, float hi) { const f2v_t f = {lo, hi}; const bf2v_t r = __builtin_convertvector(f, bf2v_t); return __builtin_bit_cast(unsigned, r); }
DI bf16 f2bf(float x) { return (bf16)(cvt_pk_bf16(x, 0.f) & 0xffffu); }
DI float bf2f(bf16 b) { return __uint_as_float((unsigned)b << 16); }
DI float bflo(unsigned u) { return __uint_as_float(u << 16); }
DI float bfhi(unsigned u) { return __uint_as_float(u & 0xffff0000u); }
DI float dot2bf(unsigned a, unsigned b, float c) { return __builtin_amdgcn_fdot2_f32_bf16(__builtin_bit_cast(bf2, a), __builtin_bit_cast(bf2, b), c, false); }
DI float gelu_tanh(float x) { const float u = 0.7978845608028654f * (x + 0.044715f * x * x * x); const float e = __expf(2.f * u); const float t = 1.f - 2.f / (e + 1.f); return 0.5f * x * (1.f + t); }
DI float sigmoidf(float x) { return 1.f / (1.f + __expf(-x)); }
DI float wave_sum(float v) { for (int o = 32; o > 0; o >>= 1) v += __shfl_xor(v, o); return v; }
DI unsigned wave_sum_u32(unsigned v) {
    int x = (int)v;
    x += __builtin_amdgcn_update_dpp(0, x, 0xB1, 0xf, 0xf, true);
    x += __builtin_amdgcn_update_dpp(0, x, 0x4E, 0xf, 0xf, true);
    x += __builtin_amdgcn_update_dpp(0, x, 0x141, 0xf, 0xf, true);
    x += __builtin_amdgcn_update_dpp(0, x, 0x140, 0xf, 0xf, true);
    x += __builtin_amdgcn_update_dpp(0, x, 0x142, 0xa, 0xf, true);
    x += __builtin_amdgcn_update_dpp(0, x, 0x143, 0xc, 0xf, true);
    return (unsigned)__builtin_amdgcn_readlane(x, 63);
}
DI unsigned wave_scan_incl_u32(unsigned v) {
    int x = (int)v;
    x += __builtin_amdgcn_update_dpp(0, x, 0x111, 0xf, 0xf, true);
    x += __builtin_amdgcn_update_dpp(0, x, 0x112, 0xf, 0xf, true);
    x += __builtin_amdgcn_update_dpp(0, x, 0x114, 0xf, 0xf, true);
    x += __builtin_amdgcn_update_dpp(0, x, 0x118, 0xf, 0xf, true);
    x += __builtin_amdgcn_update_dpp(0, x, 0x142, 0xa, 0xf, true);
    x += __builtin_amdgcn_update_dpp(0, x, 0x143, 0xc, 0xf, true);
    return (unsigned)x;
}
DI unsigned fkey(float v) { const unsigned u = __float_as_uint(v); return (u & 0x80000000u) ? ~u : (u | 0x80000000u); }
DI unsigned unkey(unsigned k) { return (k & 0x80000000u) ? (k & 0x7fffffffu) : ~k; }
DI bf16x8 ld16(const void* p) { return *(const bf16x8*)p; }
DI bf16x8 zero8() { bf16x8 z = {0, 0, 0, 0, 0, 0, 0, 0}; return z; }


#define XB_TMO      128
#define XB_XCNT(j)  (256  + 64 * (j))
#define XB_XSUB(j)  (1280 + 64 * (j))
#define XB_XGEN(j)  (2304 + 64 * (j))
#define XB_TOP      3328
#define XB_TOPGEN   3392
#define XCD_BAR_WORDS 3456
#define XB_SPIN_CAP (1u << 22)
#define LAS __attribute__((address_space(3)))
DI unsigned xb_ld(unsigned* p)              { return __hip_atomic_load(p, __ATOMIC_RELAXED, __HIP_MEMORY_SCOPE_AGENT); }
DI unsigned xb_add(unsigned* p, unsigned v) { return __hip_atomic_fetch_add(p, v, __ATOMIC_RELAXED, __HIP_MEMORY_SCOPE_AGENT); }
DI unsigned xb_xcc_id() { return (unsigned)__builtin_amdgcn_s_getreg((3 << 11) | 20) & 0xFu; }
#define XB_SPIN(cond, bar) do { unsigned _sp = 0; while (cond) { __builtin_amdgcn_s_sleep(1); \
    if ((++_sp & 255u) == 0u) { if (xb_ld(&(bar)[XB_TMO])) break; if (_sp > XB_SPIN_CAP) { atomicAdd(&(bar)[XB_TMO], 1u); break; } } } } while (0)
struct XcdBarrier { unsigned* bar; unsigned x; volatile LAS unsigned* st; };
DI XcdBarrier xcd_barrier_post(unsigned* bar, volatile LAS unsigned* st) {
    XcdBarrier b; b.bar = bar; b.x = xb_xcc_id(); b.st = st;
    if (threadIdx.x == 0) (void)xb_add(&bar[XB_XCNT(b.x)], 1u);
    return b;
}
DI void xcd_barrier_complete(unsigned* bar, unsigned x, unsigned& nloc, unsigned& nx) {
    const unsigned G = gridDim.x * gridDim.y * gridDim.z;
    unsigned sum, cnt, mine, sp = 0u;
    for (;;) {
        sum = 0u; cnt = 0u; mine = 0u;
#pragma unroll
        for (unsigned j = 0; j < 16; ++j) { const unsigned c = xb_ld(&bar[XB_XCNT(j)]); sum += c; cnt += (c > 0u) ? 1u : 0u; mine = (j == x) ? c : mine; }
        if (sum == G) break;
        __builtin_amdgcn_s_sleep(1);
        if ((++sp & 255u) == 0u) { if (xb_ld(&bar[XB_TMO])) break; if (sp > XB_SPIN_CAP) { atomicAdd(&bar[XB_TMO], 1u); break; } }
    }
    nloc = mine > 0u ? mine : 1u; nx = cnt > 0u ? cnt : 1u;
}
DI void xcd_barrier(const XcdBarrier& b) {
    asm volatile("s_waitcnt vmcnt(0)" ::: "memory");
    __syncthreads();
    if (threadIdx.x == 0) {
        unsigned* bar = b.bar;
        __builtin_amdgcn_s_waitcnt(0);
        unsigned nloc = b.st[0], nx = b.st[1];
        if (nloc == 0u) { xcd_barrier_complete(bar, b.x, nloc, nx); b.st[0] = nloc; b.st[1] = nx; }
        const unsigned old = xb_add(&bar[XB_XSUB(b.x)], 1u);
        const unsigned gen = old / nloc;
        if (old + 1u == (gen + 1u) * nloc) {
            __builtin_amdgcn_fence(__ATOMIC_RELEASE, "agent");
            asm volatile("s_waitcnt vmcnt(0)" ::: "memory");
            const unsigned og = xb_add(&bar[XB_TOP], 1u);
            const unsigned tg = og / nx;
            if (og + 1u == (tg + 1u) * nx) xb_add(&bar[XB_TOPGEN], 1u);
            else XB_SPIN(xb_ld(&bar[XB_TOPGEN]) == tg, bar);
            __builtin_amdgcn_fence(__ATOMIC_ACQUIRE, "agent");
            xb_add(&bar[XB_XGEN(b.x)], 1u);
            asm volatile("s_waitcnt vmcnt(0)" ::: "memory");
        } else {
            XB_SPIN(xb_ld(&bar[XB_XGEN(b.x)]) == gen, bar);
            __builtin_amdgcn_fence(__ATOMIC_ACQUIRE, "agent");
            asm volatile("s_waitcnt vmcnt(0)" ::: "memory");
        }
    }
    __syncthreads();
}
typedef __attribute__((address_space(1))) unsigned char g_uc;
DI unsigned char* wsb(const Params& p) {
    const unsigned long long w = (unsigned long long)p.ws;
    unsigned lo = __builtin_amdgcn_readfirstlane((unsigned)w), hi = __builtin_amdgcn_readfirstlane((unsigned)(w >> 32));
    asm volatile("" : "+s"(lo), "+s"(hi));
    return (unsigned char*)(g_uc*)(((unsigned long long)hi << 32) | lo);
}
DI int opq_tid() { int t = (int)threadIdx.x; asm volatile("" : "+v"(t)); return t; }
DI int q_next(unsigned* ctr, volatile int* slot) {
    __syncthreads();
    if (threadIdx.x == 0) *slot = (int)__hip_atomic_fetch_add(ctr, 1u, __ATOMIC_RELAXED, __HIP_MEMORY_SCOPE_AGENT);
    __syncthreads();
    return *slot;
}

DI void it_mod(const Params& p, int vb, unsigned char* sm) {
    float (*ca)[1024] = (float (*)[1024])sm;
    float (*part)[4][64] = (float (*)[4][64])(sm + 16384);
    const float* c = p.in[1];
    const int tid = opq_tid();
    __syncthreads();
    for (int i = tid; i < 4096; i += 256) { const float v = c[i]; ca[i >> 10][i & 1023] = v / (1.f + __expf(-v)); }
    __syncthreads();
    const int col = tid & 63, sl = tid >> 6;
    const int idx = vb * 64 + col;
    const int l = idx / 6144, n = idx % 6144;
    const float* w = p.in[4] + (size_t)l * 1024 * 6144 + n + (size_t)(256 * sl) * 6144;
    float a0 = 0, a1 = 0, a2 = 0, a3 = 0;
#pragma unroll 8
    for (int k = 0; k < 256; ++k) { const float wv = w[(size_t)k * 6144]; const int kk = 256 * sl + k; a0 += ca[0][kk] * wv; a1 += ca[1][kk] * wv; a2 += ca[2][kk] * wv; a3 += ca[3][kk] * wv; }
    part[sl][0][col] = a0; part[sl][1][col] = a1; part[sl][2][col] = a2; part[sl][3][col] = a3;
    __syncthreads();
    {
        const int bb = tid >> 6;
        const float v = part[0][bb][col] + part[1][bb][col] + part[2][bb][col] + part[3][bb][col] + p.in[5][l * 6144 + n];
        ((float*)(wsb(p) + WS_MOD))[((size_t)l * 4 + bb) * 6144 + n] = v;
    }
}

struct TrArgs { const float* src; int lds, coff, nvalid; bf16* dst; int ldd, doff; int K, N; int mode; const float* aux; };
DI void it_transpose(const TrArgs& a, int vb, unsigned char* sm) {
    float (*t)[33] = (float (*)[33])sm;
    float (*ta)[65] = (float (*)[65])(sm + 4352);
    float (*tb)[33] = (float (*)[33])(sm + 4352 + 8320);
    const int nk = a.K / 32;
    const int kt = vb % nk, nt = vb / nk;
    const int tid = opq_tid(), tx = tid & 31, ty = tid >> 5;
    __syncthreads();
    if (a.mode == 0) {
        for (int r = ty; r < 32; r += 8) {
            const int k = kt * 32 + r, n = nt * 32 + tx;
            t[r][tx] = (n + a.coff < a.nvalid) ? a.src[(size_t)k * a.lds + n + a.coff] : 0.f;
        }
    } else if (a.mode == 1) {
        const int h = (nt * 32) >> 7, r0 = (nt * 32) & 127;
        for (int i = tid; i < 32 * 64; i += 256) { const int kk = i >> 6, d = i & 63; ta[kk][d] = a.src[(size_t)(kt * 32 + kk) * a.lds + 768 + 64 * h + d]; }
        for (int i = tid; i < 64 * 32; i += 256) { const int d = i >> 5, rr = i & 31; tb[d][rr] = a.aux[((size_t)h * 64 + d) * 128 + r0 + rr]; }
        __syncthreads();
        for (int r = ty; r < 32; r += 8) { float s = 0; _Pragma("unroll 16") for (int d = 0; d < 64; ++d) s += ta[r][d] * tb[d][tx]; t[r][tx] = s * 0.125f; }
    } else {
        const int h = (kt * 32) >> 7, r0 = (kt * 32) & 127;
        for (int i = tid; i < 32 * 64; i += 256) { const int rr = i >> 6, d = i & 63; ta[rr][d] = a.aux[((size_t)h * 128 + r0 + rr) * 64 + d]; }
        for (int i = tid; i < 64 * 32; i += 256) { const int d = i >> 5, nn = i & 31; tb[d][nn] = a.src[(size_t)(512 + 64 * h + d) * a.lds + nt * 32 + nn]; }
        __syncthreads();
        for (int r = ty; r < 32; r += 8) { float s = 0; _Pragma("unroll 16") for (int d = 0; d < 64; ++d) s += ta[r][d] * tb[d][tx]; t[r][tx] = s; }
    }
    __syncthreads();
    for (int r = ty; r < 32; r += 8) {
        const int n = nt * 32 + r, k = kt * 32 + tx;
        a.dst[(size_t)n * a.ldd + a.doff + k] = f2bf(t[tx][r]);
    }
}
DI void conv_chunk(const float* __restrict__ src, bf16* __restrict__ dst, size_t i0, int n8) {
    for (int i = opq_tid(); i < n8; i += 256) {
        const float4 a = ((const float4*)src)[2 * (i0 + i)], b = ((const float4*)src)[2 * (i0 + i) + 1];
        u32x4 o; o.x = cvt_pk_bf16(a.x, a.y); o.y = cvt_pk_bf16(a.z, a.w); o.z = cvt_pk_bf16(b.x, b.y); o.w = cvt_pk_bf16(b.z, b.w);
        ((u32x4*)dst)[i0 + i] = o;
    }
}
DI void it_gw(const Params& p, int vb) {
    for (int e = 0; e < 4; ++e) {
        const int idx = vb * 1024 + e * 256 + opq_tid();
        const int s = idx & 127, t = (idx >> 7) & 127;
        const float v = (t >= 64 || s < 64) ? p.in[17][idx] : 0.f;
        ((bf16*)(wsb(p) + WS_GW))[idx] = f2bf(v);
    }
}
DI void it_ssm_pw(const Params& p, int vb) {
    const int idx = vb * 256 + opq_tid();
    const int pp = idx & 63, g = (idx >> 6) & 15, l = idx >> 10;
    const float lre = -__expf(p.in[7][idx]), lim = p.in[8][idx];
    const float dt = __expf(p.in[14][l * 16 + g]);
    float* pw = (float*)(wsb(p) + WS_PW) + ((size_t)(l * 16 + g) * 65) * 128;
    for (int d = 0; d <= 64; ++d) {
        const float mag = expf(lre * dt * (float)d); float sn, cs; sincosf(lim * dt * (float)d, &sn, &cs);
        pw[d * 128 + pp * 2] = mag * cs; pw[d * 128 + pp * 2 + 1] = mag * sn;
    }
    const float mag = expf(lre * dt); float sn, cs; sincosf(lim * dt, &sn, &cs);
    const float are = mag * cs, aim = mag * sn;
    const float den = lre * lre + lim * lim, P = are - 1.f, Q = aim;
    const float fre = (P * lre + Q * lim) / den, fim = (Q * lre - P * lim) / den;
    float* bb = (float*)(wsb(p) + WS_BB) + (size_t)idx * 32;
    for (int h = 0; h < 16; ++h) { const float br = p.in[9][(size_t)idx * 16 + h], bi = p.in[10][(size_t)idx * 16 + h]; bb[h * 2] = fre * br - fim * bi; bb[h * 2 + 1] = fre * bi + fim * br; }
}
DI void it_ssm_kt(const Params& p, int vb, unsigned char* sm) {
    float* cz = (float*)sm;
    float* bz = (float*)(sm + 8192);
    float* pz = (float*)(sm + 16384);
    const int tid = opq_tid();
    const int lg = vb >> 3, d0 = (vb & 7) * 8;
    const float* PW = (const float*)(wsb(p) + WS_PW) + ((size_t)lg * 65 + d0) * 128;
    const float* BB = (const float*)(wsb(p) + WS_BB) + (size_t)lg * 64 * 32;
    __syncthreads();
    for (int i = tid; i < 1024; i += 256) { const int q = i >> 4, h = i & 15; cz[i * 2] = p.in[11][((size_t)lg * 16 + h) * 64 + q]; cz[i * 2 + 1] = p.in[12][((size_t)lg * 16 + h) * 64 + q]; }
    for (int i = tid; i < 2048; i += 256) bz[i] = BB[i];
    for (int i = tid; i < 1024; i += 256) pz[i] = PW[i];
    __syncthreads();
    const int h = tid >> 4, hh = tid & 15;
    float acc[8];
#pragma unroll
    for (int d = 0; d < 8; ++d) acc[d] = 0.f;
    for (int q = 0; q < 64; ++q) {
        const float cr = cz[(q * 16 + h) * 2], ci = cz[(q * 16 + h) * 2 + 1], br = bz[(q * 16 + hh) * 2], bi = bz[(q * 16 + hh) * 2 + 1];
        const float xr = cr * br - ci * bi, xi = cr * bi + ci * br;
#pragma unroll
        for (int d = 0; d < 8; ++d) acc[d] += xr * pz[(d * 64 + q) * 2] - xi * pz[(d * 64 + q) * 2 + 1];
    }
    bf16* KT = (bf16*)(wsb(p) + WS_KT) + ((size_t)lg * 64 + d0) * 256;
    if (d0 == 0 && h == hh) acc[0] += p.in[13][(size_t)lg * 16 + h];
#pragma unroll
    for (int d = 0; d < 8; ++d) KT[d * 256 + tid] = f2bf(acc[d]);
    __syncthreads();
}
DI void ssm_tab_entry(const Params& p, size_t idx) {
    const size_t NE = (size_t)2 * 16 * 128 * 1024;
    const float* PW = (const float*)(wsb(p) + WS_PW); const float* BB = (const float*)(wsb(p) + WS_BB);
    if (idx < NE) {
        const int kk = idx & 1023, pp = (idx >> 10) & 127; const int lg = (int)(idx >> 17);
        const int i = kk >> 4, hh = kk & 15, pq = pp & 63, part = pp >> 6;
        const float* pw = PW + ((size_t)lg * 65 + (63 - i)) * 128 + pq * 2; const float* bb = BB + ((size_t)lg * 64 + pq) * 32 + hh * 2;
        const float v = part ? (pw[0] * bb[1] + pw[1] * bb[0]) : (pw[0] * bb[0] - pw[1] * bb[1]);
        ((bf16*)(wsb(p) + WS_E))[idx] = f2bf(v);
    } else if (idx < 2 * NE) {
        const size_t e = idx - NE; const int pp = e & 127, jh = (e >> 7) & 1023; const int lg = (int)(e >> 17);
        const int j = jh >> 4, h = jh & 15, pq = pp & 63, part = pp >> 6;
        const float* pw = PW + ((size_t)lg * 65 + (j + 1)) * 128 + pq * 2;
        const float cr = p.in[11][((size_t)lg * 16 + h) * 64 + pq], ci = p.in[12][((size_t)lg * 16 + h) * 64 + pq];
        const float v = part ? -(cr * pw[1] + ci * pw[0]) : (cr * pw[0] - ci * pw[1]);
        ((bf16*)(wsb(p) + WS_G))[e] = f2bf(v);
    } else {
        const size_t e = idx - 2 * NE; if (e >= (size_t)2 * 16 * 64 * 256) return;
        const int hh = e & 15, h = (e >> 4) & 15, d = (e >> 8) & 63; const int lg = (int)(e >> 14);
        const float* pw = PW + ((size_t)lg * 65 + d) * 128; const float* bb = BB + (size_t)lg * 64 * 32 + hh * 2;
        const float* cr = p.in[11] + ((size_t)lg * 16 + h) * 64; const float* ci = p.in[12] + ((size_t)lg * 16 + h) * 64;
        float s = 0;
        for (int q = 0; q < 64; ++q) { const float zr = pw[q * 2] * bb[q * 32] - pw[q * 2 + 1] * bb[q * 32 + 1], zi = pw[q * 2] * bb[q * 32 + 1] + pw[q * 2 + 1] * bb[q * 32]; s += cr[q] * zr - ci[q] * zi; }
        ((bf16*)(wsb(p) + WS_KT))[e] = f2bf(s);
    }
}
DI void norm_mod_row(const float* __restrict__ xrow, const float* __restrict__ g, const float* __restrict__ sh, const float* __restrict__ sc, bf16* __restrict__ hrow, int lane) {
    float4 v[4]; float ss = 0;
#pragma unroll
    for (int j = 0; j < 4; ++j) { v[j] = *(const float4*)(xrow + 4 * lane + 256 * j); ss += v[j].x * v[j].x + v[j].y * v[j].y + v[j].z * v[j].z + v[j].w * v[j].w; }
    ss = wave_sum(ss);
    const float r = rsqrtf(ss * (1.f / 1024.f) + 1e-6f);
#pragma unroll
    for (int j = 0; j < 4; ++j) {
        const int c = 4 * lane + 256 * j;
        const float4 gg = *(const float4*)(g + c), s1 = *(const float4*)(sc + c), s0 = *(const float4*)(sh + c);
        u32x2 o; o.x = cvt_pk_bf16(v[j].x * r * gg.x * (1.f + s1.x) + s0.x, v[j].y * r * gg.y * (1.f + s1.y) + s0.y);
        o.y = cvt_pk_bf16(v[j].z * r * gg.z * (1.f + s1.z) + s0.z, v[j].w * r * gg.w * (1.f + s1.w) + s0.w);
        *(u32x2*)(hrow + c) = o;
    }
}
constexpr int GP = 72;
template <class Epi>
DI void gemm_tile(const bf16* __restrict__ A, int lda, const bf16* __restrict__ Bt, int ldb, int K, int m0, int n0, bf16* lds, const Epi& epi) {
    bf16* As = lds; bf16* Bs = lds + 128 * GP;
    const int tid = opq_tid(), lane = tid & 63, wave = tid >> 6, wm = wave >> 1, wn = wave & 1;
    const int fr = lane & 15, fq = lane >> 4;
    const int lrow = tid >> 3, lch = tid & 7;
    f32x4 acc[4][4];
#pragma unroll
    for (int i = 0; i < 4; ++i)
#pragma unroll
        for (int j = 0; j < 4; ++j) acc[i][j] = (f32x4){0.f, 0.f, 0.f, 0.f};
    bf16x8 ra[4], rb[4];
    const bf16* Ag = A + (size_t)(m0 + lrow) * lda + lch * 8;
    const bf16* Bg = Bt + (size_t)(n0 + lrow) * ldb + lch * 8;
#pragma unroll
    for (int i = 0; i < 4; ++i) { ra[i] = ld16(Ag + (size_t)32 * i * lda); rb[i] = ld16(Bg + (size_t)32 * i * ldb); }
    const int nk = K / 64;
    for (int kt = 0; kt < nk; ++kt) {
        __syncthreads();
#pragma unroll
        for (int i = 0; i < 4; ++i) { *(bf16x8*)(As + (lrow + 32 * i) * GP + lch * 8) = ra[i]; *(bf16x8*)(Bs + (lrow + 32 * i) * GP + lch * 8) = rb[i]; }
        __syncthreads();
        if (kt + 1 < nk) {
#pragma unroll
            for (int i = 0; i < 4; ++i) { ra[i] = ld16(Ag + (size_t)32 * i * lda + (kt + 1) * 64); rb[i] = ld16(Bg + (size_t)32 * i * ldb + (kt + 1) * 64); }
        }
#pragma unroll
        for (int ks = 0; ks < 2; ++ks) {
            bf16x8 fa[4], fb[4];
#pragma unroll
            for (int i = 0; i < 4; ++i) { fa[i] = ld16(Bs + (64 * wn + 16 * i + fr) * GP + 32 * ks + 8 * fq); fb[i] = ld16(As + (64 * wm + 16 * i + fr) * GP + 32 * ks + 8 * fq); }
#pragma unroll
            for (int i = 0; i < 4; ++i)
#pragma unroll
                for (int j = 0; j < 4; ++j) acc[i][j] = MFMA16(fa[i], fb[j], acc[i][j]);
        }
    }
#pragma unroll
    for (int i = 0; i < 4; ++i)
#pragma unroll
        for (int j = 0; j < 4; ++j) epi(m0 + 64 * wm + 16 * j + fr, n0 + 64 * wn + 16 * i + 4 * fq, acc[i][j]);
}
struct EpiBf16 { bf16* C; int ldc; DI void operator()(int r, int c, f32x4 v) const { u32x2 o; o.x = cvt_pk_bf16(v[0], v[1]); o.y = cvt_pk_bf16(v[2], v[3]); *(u32x2*)(C + (size_t)r * ldc + c) = o; } };
struct EpiResid { const float* xin; float* xout; const float* gate;
    DI void operator()(int r, int c, f32x4 v) const { const float4 x = *(const float4*)(xin + (size_t)r * 1024 + c); const float4 g = *(const float4*)(gate + (size_t)(r >> 12) * 6144 + c);
        float4 o; o.x = x.x + g.x * v[0]; o.y = x.y + g.y * v[1]; o.z = x.z + g.z * v[2]; o.w = x.w + g.w * v[3]; *(float4*)(xout + (size_t)r * 1024 + c) = o; } };
struct EpiGlu { const bf16* yg; const float* bglu; bf16* mix;
    DI void operator()(int r, int c, f32x4 v) const { const u32x2 y = *(const u32x2*)(yg + (size_t)r * 256 + c); const float4 b = *(const float4*)(bglu + c);
        u32x2 o; o.x = cvt_pk_bf16(bflo(y.x) * sigmoidf(v[0] + b.x), bfhi(y.x) * sigmoidf(v[1] + b.y)); o.y = cvt_pk_bf16(bflo(y.y) * sigmoidf(v[2] + b.z), bfhi(y.y) * sigmoidf(v[3] + b.w));
        *(u32x2*)(mix + (size_t)r * KMIX + c) = o; } };

DI unsigned off_b(unsigned row, unsigned ch) { return 256u * row + 16u * (ch ^ (((row & 3u) << 2) | ((row >> 2) & 3u))); }
#define TR8(o0, o1, o2, o3, o4, o5, o6, o7, a0, a1, a2, a3, a4, a5, a6, a7)                                                                         \
    asm volatile("s_waitcnt lgkmcnt(0)\n\t"                                                                                                         \
                 "ds_read_b64_tr_b16 %0, %8\n\tds_read_b64_tr_b16 %1, %9\n\tds_read_b64_tr_b16 %2, %10\n\tds_read_b64_tr_b16 %3, %11\n\t"           \
                 "ds_read_b64_tr_b16 %4, %12\n\tds_read_b64_tr_b16 %5, %13\n\tds_read_b64_tr_b16 %6, %14\n\tds_read_b64_tr_b16 %7, %15\n\t"         \
                 "s_waitcnt lgkmcnt(0)"                                                                                                             \
                 : "=&v"(o0), "=&v"(o1), "=&v"(o2), "=&v"(o3), "=&v"(o4), "=&v"(o5), "=&v"(o6), "=&v"(o7)                                           \
                 : "v"(a0), "v"(a1), "v"(a2), "v"(a3), "v"(a4), "v"(a5), "v"(a6), "v"(a7)                                                           \
                 : "memory")

DI void it_kvn(const Params& p, int l, int vb) {
    const int lane = opq_tid() & 63, wave = opq_tid() >> 6;
    const bf16* proj = (const bf16*)(wsb(p) + WS_PROJ); bf16* kvn = (bf16*)(wsb(p) + WS_KVN);
    const float g0 = p.in[19][l * 128 + 2 * lane], g1 = p.in[19][l * 128 + 2 * lane + 1];
    for (int i = 0; i < 16; ++i) {
        const int row = vb * 64 + i * 4 + wave;
        const unsigned u = *(const unsigned*)(proj + (size_t)row * NPROJ + C_CKV + 2 * lane);
        const float a = bflo(u), b = bfhi(u);
        const float ss = wave_sum(a * a + b * b);
        const float r = rsqrtf(ss * (1.f / 128.f) + 1e-6f);
        *(unsigned*)(kvn + (size_t)row * 128 + 2 * lane) = cvt_pk_bf16(a * r * g0, b * r * g1);
    }
}

DI void it_ssm_a(const Params& p, int l, int item) {
    const int lane = opq_tid() & 63, wave = opq_tid() >> 6, fr = lane & 15, fq = lane >> 4;
    const bf16* proj = (const bf16*)(wsb(p) + WS_PROJ);
    float* sloc = (float*)(wsb(p) + WS_SLOC);
    const int g = item & 15, rt = item >> 4;
    const bf16* E = (const bf16*)(wsb(p) + WS_E) + ((size_t)(l * 16 + g) * 128) * 1024;
    const int R = 16 * rt + fr, b = R >> 6, k = R & 63;
    const bf16* arow = proj + ((size_t)b * 4096 + 64 * k + (fq >> 1)) * NPROJ + C_UA + 16 * g + 8 * (fq & 1);
    f32x4 acc[2] = {(f32x4){0, 0, 0, 0}, (f32x4){0, 0, 0, 0}};
#pragma unroll 4
    for (int ks = 0; ks < 32; ++ks) {
        const bf16x8 a = ld16(arow + (size_t)(2 * ks) * NPROJ);
#pragma unroll
        for (int c = 0; c < 2; ++c) { const int ct = 2 * wave + c; const bf16x8 bf = ld16(E + (size_t)(16 * ct + fr) * 1024 + 32 * ks + 8 * fq); acc[c] = MFMA16(a, bf, acc[c]); }
    }
#pragma unroll
    for (int c = 0; c < 2; ++c)
#pragma unroll
        for (int i = 0; i < 4; ++i) sloc[((size_t)(16 * rt + 4 * fq + i) * 16 + g) * 128 + 16 * (2 * wave + c) + fr] = acc[c][i];
}

DI void it_ssm_c(const Params& p, int l, int item, unsigned char* sm) {
    bf16* sst = (bf16*)sm;
    bf16* ktl = (bf16*)(sm + 17408);
    const int tid = opq_tid(), lane = tid & 63, wave = tid >> 6, fr = lane & 15, fq = lane >> 4;
    const bf16* proj = (const bf16*)(wsb(p) + WS_PROJ);
    const float* sloc = (const float*)(wsb(p) + WS_SLOC);
    bf16* yg = (bf16*)(wsb(p) + WS_YG);
    const int jq = item & 3, g = (item >> 2) & 15, b = item >> 6;
    const bf16* KT = (const bf16*)(wsb(p) + WS_KT) + (size_t)(l * 16 + g) * 64 * 256;
    __syncthreads();
#pragma unroll
    for (int i = 0; i < 8; ++i) *(bf16x8*)(ktl + (i * 256 + tid) * 8) = ld16(KT + (size_t)(i * 256 + tid) * 8);
    if (wave == 0) {
        const float* pw64 = (const float*)(wsb(p) + WS_PW) + ((size_t)(l * 16 + g) * 65 + 64) * 128 + lane * 2;
        const float ar = pw64[0], ai = pw64[1];
        float sr = 0, si = 0;
        const float* s = sloc + ((size_t)(b * 64) * 16 + g) * 128;
#pragma unroll 8
        for (int k = 0; k < 64; ++k) {
            sst[k * 136 + lane] = f2bf(sr); sst[k * 136 + 64 + lane] = f2bf(si);
            const float lr = s[(size_t)k * 2048 + lane], li = s[(size_t)k * 2048 + 64 + lane];
            const float nr = ar * sr - ai * si + lr, ni = ar * si + ai * sr + li;
            sr = nr; si = ni;
        }
    }
    __syncthreads();
    const bf16* G = (const bf16*)(wsb(p) + WS_G) + (size_t)(l * 16 + g) * 1024 * 128;
    const int kch = 16 * wave + fr;
    const bf16* arow = proj + ((size_t)b * 4096 + 64 * kch + (fq >> 1)) * NPROJ + C_UA + 16 * g + 8 * (fq & 1);
    const int j0 = 16 * jq;
    f32x4 acc[16];
#pragma unroll
    for (int jj = 0; jj < 16; ++jj) acc[jj] = (f32x4){0, 0, 0, 0};
    const int nks = (j0 + 15) / 2 + 1;
    bf16x8 a_cur = ld16(arow);
    for (int ks = 0; ks < nks; ++ks) {
        const bf16x8 a_nxt = (ks + 1 < nks) ? ld16(arow + (size_t)(2 * ks + 2) * NPROJ) : zero8();
#pragma unroll
        for (int jj = 0; jj < 16; ++jj) {
            const int j = j0 + jj;
            if (2 * ks <= j) {
                const int d = j - 2 * ks - (fq >> 1);
                const bf16x8 bl = ld16(ktl + ((d < 0 ? 0 : d) * 16 + fr) * 16 + 8 * (fq & 1));
                const bf16x8 bf = d >= 0 ? bl : zero8();
                acc[jj] = MFMA16(bf, a_cur, acc[jj]);
            }
        }
        a_cur = a_nxt;
    }
#pragma unroll
    for (int ks = 0; ks < 4; ++ks) {
        const bf16x8 a = ld16(sst + kch * 136 + 32 * ks + 8 * fq);
        bf16x8 bfr[16];
#pragma unroll
        for (int jj = 0; jj < 16; ++jj) bfr[jj] = ld16(G + ((size_t)((j0 + jj) * 16 + fr)) * 128 + 32 * ks + 8 * fq);
#pragma unroll
        for (int jj = 0; jj < 16; ++jj) acc[jj] = MFMA16(bfr[jj], a, acc[jj]);
    }
#pragma unroll
    for (int jj = 0; jj < 16; ++jj) {
        const size_t tok = (size_t)b * 4096 + 64 * (16 * wave + fr) + j0 + jj;
        u32x2 o; o.x = cvt_pk_bf16(gelu_tanh(acc[jj][0]), gelu_tanh(acc[jj][1])); o.y = cvt_pk_bf16(gelu_tanh(acc[jj][2]), gelu_tanh(acc[jj][3]));
        *(u32x2*)(yg + tok * 256 + 16 * g + 4 * fq) = o;
    }
}

DI void it_gmlp(const Params& p, int l, int item, unsigned char* sm) {
    bf16* vnT = (bf16*)sm;
    const int tid = opq_tid(), lane = tid & 63, wave = tid >> 6, fr = lane & 15, fq = lane >> 4;
    const bf16* proj = (const bf16*)(wsb(p) + WS_PROJ); bf16* mix = (bf16*)(wsb(p) + WS_MIX);
    const int h = item & 3, blk = item >> 2;
    const size_t tok0 = (size_t)blk * 128;
    __syncthreads();
    {
        const int row = tid >> 1, half = tid & 1;
        const bf16* vp = proj + (tok0 + row) * NPROJ + C_VB + 64 * h + 32 * half;
        float v[32]; float s = 0;
#pragma unroll
        for (int q = 0; q < 4; ++q) { const bf16x8 t = ld16(vp + 8 * q);
#pragma unroll
            for (int e = 0; e < 8; ++e) { v[8 * q + e] = bf2f((bf16)t[e]); s += v[8 * q + e]; } }
        s += __shfl_xor(s, 1); const float mu = s * (1.f / 64.f);
        float vs = 0;
#pragma unroll
        for (int e = 0; e < 32; ++e) { const float d = v[e] - mu; vs += d * d; }
        vs += __shfl_xor(vs, 1); const float r = rsqrtf(vs * (1.f / 64.f) + 1e-6f);
#pragma unroll
        for (int e = 0; e < 32; ++e) vnT[(32 * half + e) * 136 + row] = f2bf((v[e] - mu) * r);
    }
    __syncthreads();
    const bf16* W = (const bf16*)(wsb(p) + WS_GW) + (size_t)(l * 4 + h) * 128 * 128;
    f32x4 acc[4][2];
#pragma unroll
    for (int i = 0; i < 4; ++i) { acc[i][0] = (f32x4){0, 0, 0, 0}; acc[i][1] = (f32x4){0, 0, 0, 0}; }
#pragma unroll
    for (int ks = 0; ks < 4; ++ks) {
        bf16x8 fa[4], fb[2];
#pragma unroll
        for (int i = 0; i < 4; ++i) fa[i] = ld16(vnT + (16 * i + fr) * 136 + 32 * ks + 8 * fq);
#pragma unroll
        for (int j = 0; j < 2; ++j) fb[j] = ld16(W + (size_t)(16 * (2 * wave + j) + fr) * 128 + 32 * ks + 8 * fq);
#pragma unroll
        for (int i = 0; i < 4; ++i)
#pragma unroll
            for (int j = 0; j < 2; ++j) acc[i][j] = MFMA16(fa[i], fb[j], acc[i][j]);
    }
#pragma unroll
    for (int j = 0; j < 2; ++j) {
        const int t = 16 * (2 * wave + j) + fr;
        const float bs = p.in[18][(l * 4 + h) * 128 + t];
#pragma unroll
        for (int i = 0; i < 4; ++i) {
            const int d = 16 * i + 4 * fq;
            const u32x2 u = *(const u32x2*)(proj + (tok0 + t) * NPROJ + C_UB + 64 * h + d);
            u32x2 o; o.x = cvt_pk_bf16(bflo(u.x) * (acc[i][j][0] + bs), bfhi(u.x) * (acc[i][j][1] + bs)); o.y = cvt_pk_bf16(bflo(u.y) * (acc[i][j][2] + bs), bfhi(u.y) * (acc[i][j][3] + bs));
            *(u32x2*)(mix + (tok0 + t) * KMIX + 256 + 64 * h + d) = o;
        }
    }
}

DI size_t score_row_off(int b, int t) { const int c = t >> 6; return (size_t)b * SCORES_PER_BATCH + (size_t)4096 * (c * (c + 1) / 2) + (size_t)(t & 63) * 64 * (c + 1); }
template <int NR>
DI void dsa_select_impl(const float* __restrict__ srow, int nreg, bf16* __restrict__ so, int lane, unsigned* hist) {
    (void)hist;
    unsigned key[NR];
#pragma unroll
    for (int r = 0; r < NR; ++r) { const float v = srow[64 * r + lane]; key[r] = (r < nreg) ? fkey(v + 0.f) : 0u; }
    unsigned T = 0;
#pragma unroll 1
    for (int bit = 31; bit >= 0; --bit) {
        const unsigned cand = T | (1u << bit);
        unsigned c = 0;
#pragma unroll
        for (int r = 0; r < NR; ++r) asm("v_cmp_ge_u32 vcc, %1, %2\n\tv_addc_co_u32 %0, vcc, 0, %0, vcc" : "+v"(c) : "v"(key[r]), "v"(cand) : "vcc");
        const unsigned cnt = wave_sum_u32(c);
        if (cnt >= 256u) { T = cand; if (cnt == 256u) break; }
    }
    unsigned c = 0;
#pragma unroll
    for (int r = 0; r < NR; ++r) asm("v_cmp_gt_u32 vcc, %1, %2\n\tv_addc_co_u32 %0, vcc, 0, %0, vcc" : "+v"(c) : "v"(key[r]), "v"(T) : "vcc");
    const int need = 256 - (int)wave_sum_u32(c);
    int base = 0, eqb = 0;
    const unsigned long long lt = (1ull << lane) - 1ull;
#pragma unroll
    for (int r = 0; r < NR; ++r) {
        const unsigned long long me = __ballot(key[r] == T);
        const int erank = eqb + __popcll(me & lt);
        const bool take = (key[r] > T) || (key[r] == T && erank < need);
        const unsigned long long mt = __ballot(take);
        if (take) so[base + __popcll(mt & lt)] = (bf16)(64 * r + lane);
        base += __popcll(mt); eqb += __popcll(me);
    }
}
DI void dsa_select_query(const Params& p, int q, int lane, unsigned* hist) {
    const float* scores = (const float*)(wsb(p) + WS_SCORES); bf16* sel = (bf16*)(wsb(p) + WS_SEL);
    const int b = q >> 12, t = q & 4095, c = t >> 6, nreg = c + 1;
    bf16* so = sel + (size_t)q * 256;
    if (nreg <= 4) { for (int r = 0; r < nreg; ++r) so[64 * r + lane] = (bf16)(64 * r + lane); return; }
    const float* srow = scores + score_row_off(b, t);
    if (nreg <= 16) dsa_select_impl<16>(srow, nreg, so, lane, hist);
    else if (nreg <= 32) dsa_select_impl<32>(srow, nreg, so, lane, hist);
    else if (nreg <= 48) dsa_select_impl<48>(srow, nreg, so, lane, hist);
    else dsa_select_impl<64>(srow, nreg, so, lane, hist);
}
DI void it_dsa_index_select(const Params& p, int item, unsigned char* sm) {
    const int lane = opq_tid() & 63, wave = opq_tid() >> 6, fr = lane & 15, fq = lane >> 4;
    const bf16* proj = (const bf16*)(wsb(p) + WS_PROJ); float* scores = (float*)(wsb(p) + WS_SCORES);
    const int c = 63 - (item >> 4), b = (item >> 2) & 3, qg = item & 3;
    if (c >= 4) {
        const int t = 64 * c + 16 * qg + fr;
        const bf16* qrow = proj + ((size_t)b * 4096 + t) * NPROJ;
        bf16x8 qf[4][2];
#pragma unroll
        for (int hh = 0; hh < 4; ++hh)
#pragma unroll
            for (int ks = 0; ks < 2; ++ks) qf[hh][ks] = ld16(qrow + C_QI + 64 * hh + 32 * ks + 8 * fq);
        float w[4];
        { const u32x2 wv = *(const u32x2*)(qrow + C_WI); w[0] = bflo(wv.x) * 0.0625f; w[1] = bfhi(wv.x) * 0.0625f; w[2] = bflo(wv.y) * 0.0625f; w[3] = bfhi(wv.y) * 0.0625f; }
        float* srow = scores + score_row_off(b, t);
        const int ntile = 4 * (c + 1);
        const bf16* kbase = proj + ((size_t)b * 4096 + fr) * NPROJ + C_KI + 8 * fq;
        bf16x8 k0[4], k1[4];
#pragma unroll
        for (int u = 0; u < 4; ++u) { const bf16* krow = kbase + (size_t)16 * (wave + 4 * u) * NPROJ; k0[u] = ld16(krow); k1[u] = ld16(krow + 32); }
        for (int base = wave; base < ntile; base += 16) {
            bf16x8 n0[4], n1[4];
            const bool more = base + 16 < ntile;
            if (more) {
#pragma unroll
                for (int u = 0; u < 4; ++u) { const bf16* krow = kbase + (size_t)16 * (base + 16 + 4 * u) * NPROJ; n0[u] = ld16(krow); n1[u] = ld16(krow + 32); }
            }
#pragma unroll
            for (int u = 0; u < 4; ++u) {
                const int kt = base + 4 * u;
                if (kt >= ntile) break;
                f32x4 sc = {0, 0, 0, 0};
#pragma unroll
                for (int hh = 0; hh < 4; ++hh) {
                    f32x4 a = {0, 0, 0, 0};
                    a = MFMA16(k0[u], qf[hh][0], a); a = MFMA16(k1[u], qf[hh][1], a);
#pragma unroll
                    for (int i = 0; i < 4; ++i) sc[i] += w[hh] * fmaxf(a[i], 0.f);
                }
#pragma unroll
                for (int i = 0; i < 4; ++i) sc[i] += 0.f;
                *(f32x4*)(srow + 16 * kt + 4 * fq) = sc;
            }
            if (more) {
#pragma unroll
                for (int u = 0; u < 4; ++u) { k0[u] = n0[u]; k1[u] = n1[u]; }
            }
        }
        asm volatile("s_waitcnt vmcnt(0)" ::: "memory");
    }
    __syncthreads();
    for (int i = 0; i < 4; ++i) dsa_select_query(p, b * 4096 + 64 * c + 16 * qg + 4 * wave + i, lane, (unsigned*)sm + 1024 * wave);
}
DI void it_dsa_attn(const Params& p, int item, unsigned char* sm) {
    const int lane = opq_tid() & 63, wave = opq_tid() >> 6, fr = lane & 15, fq = lane >> 4;
    unsigned char* tile = sm + wave * 8192;
    bf16* selw = (bf16*)(sm + 32768 + wave * 512);
    const bf16* proj = (const bf16*)(wsb(p) + WS_PROJ); const bf16* kvn = (const bf16*)(wsb(p) + WS_KVN);
    const bf16* sel = (const bf16*)(wsb(p) + WS_SEL); bf16* mix = (bf16*)(wsb(p) + WS_MIX);
    unsigned wr_addr[8], rd_addr[2][4], tr_addr[8][2];
#pragma unroll
    for (int i = 0; i < 8; ++i) wr_addr[i] = off_b(4 * i + fq, fr);
#pragma unroll
    for (int rb = 0; rb < 2; ++rb)
#pragma unroll
        for (int s = 0; s < 4; ++s) rd_addr[rb][s] = off_b(8 * (fr >> 2) + 4 * rb + (fr & 3), 4 * s + fq);
    const unsigned tbase = (unsigned)(size_t)tile;
    {
        const unsigned q4 = fr >> 2, p4 = fr & 3;
#pragma unroll
        for (int c = 0; c < 8; ++c)
#pragma unroll
            for (int t = 0; t < 2; ++t) tr_addr[c][t] = tbase + off_b(8 * fq + 4 * t + q4, 2 * c + (p4 >> 1)) + 8 * (p4 & 1);
    }
    const float slope = fr < 8 ? exp2f(-(float)(fr + 1)) : 0.f;
    for (int qi = 0; qi < 4; ++qi) {
        const int q = item * 16 + wave * 4 + qi;
        const int b = q >> 12, t = q & 4095, c = t >> 6;
        const int nsel = (c + 1) * 64 < 256 ? (c + 1) * 64 : 256;
        const bf16* qa = proj + (size_t)q * NPROJ + C_QA;
        bf16x8 qf[4];
#pragma unroll
        for (int s = 0; s < 4; ++s) qf[s] = fr < 8 ? ld16(qa + fr * 128 + 32 * s + 8 * fq) : zero8();
        const bf16* selp = sel + (size_t)q * 256;
        const bf16* kvb = kvn + (size_t)b * 4096 * 128;
        if (4 * lane < nsel) *(u32x2*)(selw + 4 * lane) = *(const u32x2*)(selp + 4 * lane);
        float m_run = -INFINITY, l_run = 0.f;
        f32x4 o[8];
#pragma unroll
        for (int i = 0; i < 8; ++i) o[i] = (f32x4){0, 0, 0, 0};
        bf16x8 gk[8];
#pragma unroll
        for (int i = 0; i < 8; ++i) { const int key = selw[4 * i + fq]; gk[i] = ld16(kvb + (size_t)key * 128 + 8 * fr); }
        const int nt = nsel / 32;
        for (int ti = 0; ti < nt; ++ti) {
            const bf16x8 kp = ld16(selw + 32 * ti + 8 * fq);
#pragma unroll
            for (int i = 0; i < 8; ++i) *(bf16x8*)(tile + wr_addr[i]) = gk[i];
            if (ti + 1 < nt) {
#pragma unroll
                for (int i = 0; i < 8; ++i) { const int key = selw[32 * (ti + 1) + 4 * i + fq]; gk[i] = ld16(kvb + (size_t)key * 128 + 8 * fr); }
            }
            f32x4 lg[2] = {(f32x4){0, 0, 0, 0}, (f32x4){0, 0, 0, 0}};
#pragma unroll
            for (int rb = 0; rb < 2; ++rb)
#pragma unroll
                for (int s = 0; s < 4; ++s) lg[rb] = MFMA16(ld16(tile + rd_addr[rb][s]), qf[s], lg[rb]);
            float val[8]; float tmax = -INFINITY;
#pragma unroll
            for (int j = 0; j < 8; ++j) { const float dist = fabsf((float)(t - (int)(unsigned short)kp[j])); val[j] = lg[j >> 2][j & 3] - slope * dist; tmax = fmaxf(tmax, val[j]); }
            tmax = fmaxf(tmax, __shfl_xor(tmax, 16)); tmax = fmaxf(tmax, __shfl_xor(tmax, 32));
            const float m_new = fmaxf(m_run, tmax);
            const float scale = __expf(m_run - m_new);
            l_run *= scale;
#pragma unroll
            for (int i = 0; i < 8; ++i) o[i] *= scale;
            float pv[8];
#pragma unroll
            for (int j = 0; j < 8; ++j) { pv[j] = __expf(val[j] - m_new); l_run += pv[j]; }
            m_run = m_new;
            u32x4 pk; pk.x = cvt_pk_bf16(pv[0], pv[1]); pk.y = cvt_pk_bf16(pv[2], pv[3]); pk.z = cvt_pk_bf16(pv[4], pv[5]); pk.w = cvt_pk_bf16(pv[6], pv[7]);
            const bf16x8 pf = __builtin_bit_cast(bf16x8, pk);
            s16x4 tr[8][2];
            TR8(tr[0][0], tr[0][1], tr[1][0], tr[1][1], tr[2][0], tr[2][1], tr[3][0], tr[3][1], tr_addr[0][0], tr_addr[0][1], tr_addr[1][0], tr_addr[1][1], tr_addr[2][0], tr_addr[2][1], tr_addr[3][0], tr_addr[3][1]);
            TR8(tr[4][0], tr[4][1], tr[5][0], tr[5][1], tr[6][0], tr[6][1], tr[7][0], tr[7][1], tr_addr[4][0], tr_addr[4][1], tr_addr[5][0], tr_addr[5][1], tr_addr[6][0], tr_addr[6][1], tr_addr[7][0], tr_addr[7][1]);
#pragma unroll
            for (int cc = 0; cc < 8; ++cc) {
                bf16x8 kf; kf[0] = tr[cc][0][0]; kf[1] = tr[cc][0][1]; kf[2] = tr[cc][0][2]; kf[3] = tr[cc][0][3]; kf[4] = tr[cc][1][0]; kf[5] = tr[cc][1][1]; kf[6] = tr[cc][1][2]; kf[7] = tr[cc][1][3];
                o[cc] = MFMA16(kf, pf, o[cc]);
            }
        }
        float lt = l_run; lt += __shfl_xor(lt, 16); lt += __shfl_xor(lt, 32);
        const float inv = 1.f / lt;
        if (fr < 8) {
#pragma unroll
            for (int cc = 0; cc < 8; ++cc) { u32x2 ov; ov.x = cvt_pk_bf16(o[cc][0] * inv, o[cc][1] * inv); ov.y = cvt_pk_bf16(o[cc][2] * inv, o[cc][3] * inv);
                *(u32x2*)(mix + (size_t)q * KMIX + 512 + fr * 128 + 16 * cc + 4 * fq) = ov; }
        }
    }
}
typedef float f2 __attribute__((ext_vector_type(2)));
#ifndef PEER_FP8_MASK
#define PEER_FP8_MASK 3
#endif
constexpr float U_SCALE = 64.f, V_SCALE = 8.f;
DI unsigned pack4_fp8(float a, float b, float c, float d) { int p = __builtin_amdgcn_cvt_pk_fp8_f32(a, b, 0, false); p = __builtin_amdgcn_cvt_pk_fp8_f32(c, d, p, true); return (unsigned)p; }
DI void conv_chunk_fp8(const float* __restrict__ src, unsigned char* __restrict__ dst, size_t i0, int n16, float sc) {
    for (int i = opq_tid(); i < n16; i += 256) {
        const float4* s4 = (const float4*)src + 4 * (i0 + i);
        const float4 a = s4[0], b = s4[1], c = s4[2], d = s4[3];
        u32x4 o; o.x = pack4_fp8(a.x * sc, a.y * sc, a.z * sc, a.w * sc); o.y = pack4_fp8(b.x * sc, b.y * sc, b.z * sc, b.w * sc);
        o.z = pack4_fp8(c.x * sc, c.y * sc, c.z * sc, c.w * sc); o.w = pack4_fp8(d.x * sc, d.y * sc, d.z * sc, d.w * sc);
        ((u32x4*)dst)[i0 + i] = o;
    }
}
struct PeerLds2 {
    float trans[4][1024];
    unsigned char li[4][2][64][16];
    unsigned short pe[4][8][128];
    float pg[4][8][128];
};
template <int OFF, int NK>
DI void sort16_desc(unsigned (&k)[NK]) {
#pragma unroll
    for (int size = 2; size <= 16; size <<= 1)
#pragma unroll
        for (int stride = size >> 1; stride > 0; stride >>= 1)
#pragma unroll
            for (int i = 0; i < 16; ++i) {
                const int j = i ^ stride;
                if (j > i) {
                    const bool desc = ((i & size) == 0);
                    const unsigned a = k[OFF + i], b = k[OFF + j];
                    const unsigned hi = a > b ? a : b, lo = a > b ? b : a;
                    k[OFF + i] = desc ? hi : lo; k[OFF + j] = desc ? lo : hi;
                }
            }
}
template <int OA, int OB, int NK>
DI void merge_top16(unsigned (&k)[NK]) {
#pragma unroll
    for (int i = 0; i < 16; ++i) { const unsigned a = k[OA + i], b = k[OB + 15 - i]; k[OA + i] = a > b ? a : b; }
#pragma unroll
    for (int stride = 8; stride > 0; stride >>= 1)
#pragma unroll
        for (int i = 0; i < 16; ++i) {
            const int j = i ^ stride;
            if (j > i) { const unsigned a = k[OA + i], b = k[OA + j]; k[OA + i] = a > b ? a : b; k[OA + j] = a > b ? b : a; }
        }
}
DI void peer_retrieve(const Params& p, int l, int tok0, PeerLds2& S, int lane, int wave) {
    const int fr = lane & 15, fq = lane >> 4;
    const bf16* QP = (const bf16*)(wsb(p) + WS_PROJ);
    const bf16* PK = (const bf16*)(wsb(p) + WS_PK) + (size_t)l * 2 * 128 * 64;
    float* trans = S.trans[wave];
    unsigned K1[16], K2[16];
#pragma unroll
    for (int L = 0; L < 2; ++L) {
        f32x4 acc[4][8];
#pragma unroll
        for (int ct = 0; ct < 4; ++ct)
#pragma unroll
            for (int kt = 0; kt < 8; ++kt) acc[ct][kt] = (f32x4){0, 0, 0, 0};
#pragma unroll
        for (int kt = 0; kt < 8; ++kt) {
            const bf16* krow = PK + (size_t)L * 8192 + (size_t)(16 * kt + fr) * 64 + 8 * fq;
            const bf16x8 a0 = ld16(krow), a1 = ld16(krow + 32);
#pragma unroll
            for (int ct = 0; ct < 4; ++ct) {
                const bf16* qrow = QP + (size_t)(tok0 + 2 * ct + (fr >> 3)) * 1024 + 128 * (fr & 7) + 64 * L + 8 * fq;
                acc[ct][kt] = MFMA16(a0, ld16(qrow), acc[ct][kt]); acc[ct][kt] = MFMA16(a1, ld16(qrow + 32), acc[ct][kt]);
            }
        }
        unsigned k[128];
#define PEER_ROUND(kt)                                                                                                                            \
        {                                                                                                                                         \
            _Pragma("unroll") for (int ct = 0; ct < 4; ++ct) *(f32x4*)(trans + ((ct * 4 + fq) * 16 + fr) * 4) = acc[ct][kt];                       \
            _Pragma("unroll") for (int sq = 0; sq < 4; ++sq) {                                                                                     \
                const f32x4 v = *(const f32x4*)(trans + ((fq * 4 + sq) * 16 + fr) * 4);                                                            \
                _Pragma("unroll") for (int i = 0; i < 4; ++i) k[16 * (kt) + sq * 4 + i] = (fkey(v[i]) & ~0x7fu) | (unsigned)(16 * (kt) + 4 * sq + i); \
            }                                                                                                                                     \
            sort16_desc<16 * (kt)>(k);                                                                                                            \
        }
        PEER_ROUND(0) PEER_ROUND(1) merge_top16<0, 16>(k);
        PEER_ROUND(2) PEER_ROUND(3) merge_top16<32, 48>(k); merge_top16<0, 32>(k);
        PEER_ROUND(4) PEER_ROUND(5) merge_top16<64, 80>(k);
        PEER_ROUND(6) PEER_ROUND(7) merge_top16<96, 112>(k); merge_top16<64, 96>(k);
        merge_top16<0, 64>(k);
#undef PEER_ROUND
        u32x4 ib;
        ib.x = (k[0] & 127u) | ((k[1] & 127u) << 8) | ((k[2] & 127u) << 16) | ((k[3] & 127u) << 24);
        ib.y = (k[4] & 127u) | ((k[5] & 127u) << 8) | ((k[6] & 127u) << 16) | ((k[7] & 127u) << 24);
        ib.z = (k[8] & 127u) | ((k[9] & 127u) << 8) | ((k[10] & 127u) << 16) | ((k[11] & 127u) << 24);
        ib.w = (k[12] & 127u) | ((k[13] & 127u) << 8) | ((k[14] & 127u) << 16) | ((k[15] & 127u) << 24);
        *(u32x4*)(S.li[wave][L][lane]) = ib;
#pragma unroll
        for (int i = 0; i < 16; ++i) { if (L == 0) K1[i] = k[i]; else K2[i] = k[i]; }
    }
    float v1[16], v2[16];
#pragma unroll
    for (int i = 0; i < 16; ++i) { v1[i] = __uint_as_float(unkey(K1[i] & ~0x7fu)); v2[i] = __uint_as_float(unkey(K2[i] & ~0x7fu)); }
    unsigned c[64];
    {
        int idx = 0;
#pragma unroll
        for (int a = 0; a < 16; ++a)
#pragma unroll
            for (int b = 0; b < 16; ++b)
                if ((a + 1) * (b + 1) <= 16) { c[idx] = (fkey(v1[a] + v2[b]) & ~0xffu) | (unsigned)(a * 16 + b); ++idx; }
#pragma unroll
        for (int i = 50; i < 64; ++i) c[i] = 0u;
    }
    sort16_desc<0>(c); sort16_desc<16>(c); sort16_desc<32>(c); sort16_desc<48>(c);
    merge_top16<0, 16>(c); merge_top16<32, 48>(c); merge_top16<0, 32>(c);
    float sc[16]; float sum = 0.f;
    {
        const float m = __uint_as_float(unkey(c[0] & ~0xffu));
#pragma unroll
        for (int i = 0; i < 16; ++i) { sc[i] = __expf(__uint_as_float(unkey(c[i] & ~0xffu)) - m); sum += sc[i]; }
    }
    const float inv = 1.f / sum;
    const int tt = 2 * fq + (fr >> 3), head = fr & 7;
    const unsigned char* l1 = S.li[wave][0][lane]; const unsigned char* l2 = S.li[wave][1][lane];
#pragma unroll
    for (int i = 0; i < 16; ++i) {
        const unsigned ab = c[i] & 0xffu;
        const unsigned e = (unsigned)l1[ab >> 4] * 128u + (unsigned)l2[ab & 15u];
        S.pe[wave][tt][head * 16 + i] = (unsigned short)e; S.pg[wave][tt][head * 16 + i] = sc[i] * inv;
    }
}
template <bool FP8>
DI void peer_experts(const Params& p, int l, int tok, int tt, PeerLds2& S, int lane, int wave) {
    const bf16* H = (const bf16*)(wsb(p) + WS_H);
    const unsigned char* UB = wsb(p) + WS_UB; const unsigned char* VB = wsb(p) + WS_VB;
    const float* X = (const float*)(wsb(p) + WS_X);
    const float* modl = (const float*)(wsb(p) + WS_MOD) + (size_t)l * 4 * 6144;
    const int b = tok >> 12;
    const unsigned short* pe = S.pe[wave][tt]; const float* pg = S.pg[wave][tt];
    f2 hp[8];
    u32x4 h0, h1;
    {
        h0 = *(const u32x4*)(H + (size_t)tok * 1024 + 16 * lane); h1 = *(const u32x4*)(H + (size_t)tok * 1024 + 16 * lane + 8);
        hp[0] = (f2){bflo(h0.x), bfhi(h0.x)}; hp[1] = (f2){bflo(h0.y), bfhi(h0.y)}; hp[2] = (f2){bflo(h0.z), bfhi(h0.z)}; hp[3] = (f2){bflo(h0.w), bfhi(h0.w)};
        hp[4] = (f2){bflo(h1.x), bfhi(h1.x)}; hp[5] = (f2){bflo(h1.y), bfhi(h1.y)}; hp[6] = (f2){bflo(h1.z), bfhi(h1.z)}; hp[7] = (f2){bflo(h1.w), bfhi(h1.w)};
    }
    f2 acc[8];
#pragma unroll
    for (int i = 0; i < 8; ++i) acc[i] = (f2){0.f, 0.f};
    const bool b5 = (lane & 32) != 0, b4_ = (lane & 16) != 0, b3 = (lane & 8) != 0;
    const int eidx = (b3 ? 4 : 0) + (b4_ ? 2 : 0) + (b5 ? 1 : 0);
    if constexpr (FP8) {
    for (int e0 = 0; e0 < 128; e0 += 8) {
        u32x4 ur[8], vr[8];
#pragma unroll
        for (int j = 0; j < 8; ++j) {
            const int e = __builtin_amdgcn_readfirstlane((int)pe[e0 + j]);
            ur[j] = *(const u32x4*)(UB + (size_t)e * 1024 + 16 * lane);
            vr[j] = *(const u32x4*)(VB + (size_t)e * 1024 + 16 * lane);
        }
        float d[8];
#pragma unroll
        for (int j = 0; j < 8; ++j) {
            f2 s2 = {0.f, 0.f};
#pragma unroll
            for (int k = 0; k < 4; ++k) {
                const f2 lo = __builtin_amdgcn_cvt_pk_f32_fp8((int)ur[j][k], false), hi = __builtin_amdgcn_cvt_pk_f32_fp8((int)ur[j][k], true);
                s2 = lo * hp[2 * k] + s2; s2 = hi * hp[2 * k + 1] + s2;
            }
            d[j] = s2.x + s2.y;
        }
        float w[4], x2[2], y;
#pragma unroll
        for (int i = 0; i < 4; ++i) { const float keep = b5 ? d[2 * i + 1] : d[2 * i], send = b5 ? d[2 * i] : d[2 * i + 1]; w[i] = keep + __shfl_xor(send, 32); }
#pragma unroll
        for (int i = 0; i < 2; ++i) { const float keep = b4_ ? w[2 * i + 1] : w[2 * i], send = b4_ ? w[2 * i] : w[2 * i + 1]; x2[i] = keep + __shfl_xor(send, 16); }
        { const float keep = b3 ? x2[1] : x2[0], send = b3 ? x2[0] : x2[1]; y = keep + __shfl_xor(send, 8); }
        y += __shfl_xor(y, 4); y += __shfl_xor(y, 2); y += __shfl_xor(y, 1);
        const float sc = gelu_tanh(y * (1.f / U_SCALE)) * pg[e0 + eidx] * (1.f / V_SCALE);
#pragma unroll
        for (int j = 0; j < 8; ++j) {
            const float sj = __uint_as_float((unsigned)__builtin_amdgcn_readlane((int)__float_as_uint(sc), 32 * (j & 1) + 16 * ((j >> 1) & 1) + 8 * ((j >> 2) & 1)));
            const f2 sj2 = {sj, sj};
#pragma unroll
            for (int k = 0; k < 4; ++k) {
                const f2 lo = __builtin_amdgcn_cvt_pk_f32_fp8((int)vr[j][k], false), hi = __builtin_amdgcn_cvt_pk_f32_fp8((int)vr[j][k], true);
                acc[2 * k] = lo * sj2 + acc[2 * k]; acc[2 * k + 1] = hi * sj2 + acc[2 * k + 1];
            }
        }
    }
    } else {
    for (int e0 = 0; e0 < 128; e0 += 4) {
        const bf16* UBb = (const bf16*)UB; const bf16* VBb = (const bf16*)VB;
        u32x4 ur[4][2], vr[4][2];
#pragma unroll
        for (int j = 0; j < 4; ++j) {
            const int e = __builtin_amdgcn_readfirstlane((int)pe[e0 + j]);
            ur[j][0] = *(const u32x4*)(UBb + (size_t)e * 1024 + 16 * lane); ur[j][1] = *(const u32x4*)(UBb + (size_t)e * 1024 + 16 * lane + 8);
            vr[j][0] = *(const u32x4*)(VBb + (size_t)e * 1024 + 16 * lane); vr[j][1] = *(const u32x4*)(VBb + (size_t)e * 1024 + 16 * lane + 8);
        }
        float d[4];
#pragma unroll
        for (int j = 0; j < 4; ++j) {
            float sa = 0.f, sb = 0.f;
            sa = dot2bf(ur[j][0].x, h0.x, sa); sb = dot2bf(ur[j][0].y, h0.y, sb); sa = dot2bf(ur[j][0].z, h0.z, sa); sb = dot2bf(ur[j][0].w, h0.w, sb);
            sa = dot2bf(ur[j][1].x, h1.x, sa); sb = dot2bf(ur[j][1].y, h1.y, sb); sa = dot2bf(ur[j][1].z, h1.z, sa); sb = dot2bf(ur[j][1].w, h1.w, sb);
            d[j] = sa + sb;
        }
        float w[2], y;
#pragma unroll
        for (int i = 0; i < 2; ++i) { const float keep = b5 ? d[2 * i + 1] : d[2 * i], send = b5 ? d[2 * i] : d[2 * i + 1]; w[i] = keep + __shfl_xor(send, 32); }
        { const float keep = b4_ ? w[1] : w[0], send = b4_ ? w[0] : w[1]; y = keep + __shfl_xor(send, 16); }
        y += __shfl_xor(y, 8); y += __shfl_xor(y, 4); y += __shfl_xor(y, 2); y += __shfl_xor(y, 1);
        const float sc = gelu_tanh(y) * pg[e0 + (b4_ ? 2 : 0) + (b5 ? 1 : 0)];
#pragma unroll
        for (int j = 0; j < 4; ++j) {
            const float sj = __uint_as_float((unsigned)__builtin_amdgcn_readlane((int)__float_as_uint(sc), 32 * (j & 1) + 16 * ((j >> 1) & 1)));
            const f2 sj2 = {sj, sj};
#pragma unroll
            for (int hh = 0; hh < 2; ++hh)
#pragma unroll
                for (int k = 0; k < 4; ++k) { const unsigned dw = vr[j][hh][k]; const f2 vv = {bflo(dw), bfhi(dw)}; acc[4 * hh + k] = vv * sj2 + acc[4 * hh + k]; }
        }
    }
    }
    float xr[16];
    const float* xrow = X + (size_t)tok * 1024 + 16 * lane;
    float* xorow = p.out + (size_t)tok * 1024 + 16 * lane;
    const float* g2 = modl + (size_t)b * 6144 + 5 * 1024 + 16 * lane;
    float ss = 0;
#pragma unroll
    for (int q4 = 0; q4 < 4; ++q4) {
        const float4 xv = *(const float4*)(xrow + 4 * q4), gv = *(const float4*)(g2 + 4 * q4);
        float4 o; o.x = xv.x + gv.x * acc[2 * q4].x; o.y = xv.y + gv.y * acc[2 * q4].y; o.z = xv.z + gv.z * acc[2 * q4 + 1].x; o.w = xv.w + gv.w * acc[2 * q4 + 1].y;
        if (l == 0) *(float4*)(xorow + 4 * q4) = o;
        xr[4 * q4] = o.x; xr[4 * q4 + 1] = o.y; xr[4 * q4 + 2] = o.z; xr[4 * q4 + 3] = o.w;
        ss += o.x * o.x + o.y * o.y + o.z * o.z + o.w * o.w;
    }
    ss = wave_sum(ss);
    const float r = rsqrtf(ss * (1.f / 1024.f) + 1e-6f);
    if (l == 1) {
#pragma unroll
        for (int q4 = 0; q4 < 4; ++q4) {
            const float4 gv = *(const float4*)(p.in[28] + 16 * lane + 4 * q4);
            float4 o; o.x = xr[4 * q4] * r * gv.x; o.y = xr[4 * q4 + 1] * r * gv.y; o.z = xr[4 * q4 + 2] * r * gv.z; o.w = xr[4 * q4 + 3] * r * gv.w;
            *(float4*)(xorow + 4 * q4) = o;
        }
    } else {
        const float* g = p.in[2] + 1024 + 16 * lane; const float* mod1 = (const float*)(wsb(p) + WS_MOD) + ((size_t)4 + b) * 6144 + 16 * lane;
        bf16* hrow = (bf16*)(wsb(p) + WS_H2) + (size_t)tok * 1024 + 16 * lane;
        float hv[16];
#pragma unroll
        for (int q4 = 0; q4 < 4; ++q4) {
            const float4 gg = *(const float4*)(g + 4 * q4), s1 = *(const float4*)(mod1 + 1024 + 4 * q4), s0 = *(const float4*)(mod1 + 4 * q4);
            hv[4 * q4] = xr[4 * q4] * r * gg.x * (1.f + s1.x) + s0.x; hv[4 * q4 + 1] = xr[4 * q4 + 1] * r * gg.y * (1.f + s1.y) + s0.y;
            hv[4 * q4 + 2] = xr[4 * q4 + 2] * r * gg.z * (1.f + s1.z) + s0.z; hv[4 * q4 + 3] = xr[4 * q4 + 3] * r * gg.w * (1.f + s1.w) + s0.w;
        }
        u32x4 o0, o1;
        o0.x = cvt_pk_bf16(hv[0], hv[1]); o0.y = cvt_pk_bf16(hv[2], hv[3]); o0.z = cvt_pk_bf16(hv[4], hv[5]); o0.w = cvt_pk_bf16(hv[6], hv[7]);
        o1.x = cvt_pk_bf16(hv[8], hv[9]); o1.y = cvt_pk_bf16(hv[10], hv[11]); o1.z = cvt_pk_bf16(hv[12], hv[13]); o1.w = cvt_pk_bf16(hv[14], hv[15]);
        *(u32x4*)(hrow) = o0; *(u32x4*)(hrow + 8) = o1;
    }
}

constexpr int SMEM_BYTES = 64 + 17408 + 32768;
#ifndef REP_ID
#define REP_ID -1
#endif
#ifndef REP_N
#define REP_N 1
#endif
#define NREP(id) ((id) == REP_ID ? REP_N : 1)
__global__ void __launch_bounds__(256, 2) fwd_megakernel(Params p) {
    __shared__ __attribute__((aligned(16))) unsigned char smem[SMEM_BYTES];
    const int tid = threadIdx.x;
    const int G = gridDim.x, bid = blockIdx.x;
    unsigned char* sm = smem + 64;
    volatile int* qslot = (volatile int*)(smem + 16);
    if (tid < 16) ((unsigned*)smem)[tid] = 0u;
    __syncthreads();
    unsigned* ctl = (unsigned*)(wsb(p) + WS_CTL);
    unsigned* qctr = ctl + 4096;
    XcdBarrier bar = xcd_barrier_post(ctl, (volatile LAS unsigned*)smem);
#define PHASE_PTRS unsigned char* ws = wsb(p); const bf16* H = (const bf16*)(ws + WS_H); bf16* PROJ = (bf16*)(ws + WS_PROJ); float* X = (float*)(ws + WS_X); const float* mod = (const float*)(ws + WS_MOD); (void)H; (void)PROJ; (void)X; (void)mod;
    int qn = 0;

    for (int rep = 0; rep < NREP(0); ++rep) {
            PHASE_PTRS
        constexpr int N_MOD = 192, N_LAYER = 768 + 1024 + 512 + 512 + 1024 + 1024 + 64, N_PK = 4, N_GW = 128, N_PW = 8;
        constexpr int NV = N_MOD + 2 * N_LAYER + N_PK + N_GW + N_PW;
        for (int vb = bid; vb < NV; vb += G) {
            int v = vb;
            if (v < N_MOD) { it_mod(p, v, sm); continue; }
            v -= N_MOD;
            if (v < 2 * N_LAYER) {
                const int l = v / N_LAYER; v -= l * N_LAYER;
                bf16* wtin = (bf16*)(ws + WS_WTIN) + (size_t)l * NPROJ * 1024;
                const float* win = p.in[6] + (size_t)l * 1024 * 1732;
                bf16* wtout = (bf16*)(ws + WS_WTOUT) + (size_t)l * 1024 * KMIX;
                const float* wout = p.in[22] + (size_t)l * 1024 * 1024;
                if (v < 768) { it_transpose(TrArgs{win, 1732, 0, 1732, wtin, 1024, 0, 1024, 768, 0, nullptr}, v, sm); }
                else if ((v -= 768) < 1024) { it_transpose(TrArgs{win, 1732, 0, 1732, wtin + (size_t)768 * 1024, 1024, 0, 1024, 1024, 1, p.in[20] + (size_t)l * 8 * 64 * 128}, v, sm); }
                else if ((v -= 1024) < 512) { it_transpose(TrArgs{win, 1732, 1280, 1732, wtin + (size_t)1792 * 1024, 1024, 0, 1024, 512, 0, nullptr}, v, sm); }
                else if ((v -= 512) < 512) { it_transpose(TrArgs{wout, 1024, 0, 1024, wtout, KMIX, 0, 512, 1024, 0, nullptr}, v, sm); }
                else if ((v -= 512) < 1024) { it_transpose(TrArgs{wout, 1024, 0, 1024, wtout, KMIX, 512, 1024, 1024, 2, p.in[21] + (size_t)l * 8 * 128 * 64}, v, sm); }
                else if ((v -= 1024) < 1024) { it_transpose(TrArgs{p.in[23] + (size_t)l * 1024 * 1024, 1024, 0, 1024, (bf16*)(ws + WS_WTQ) + (size_t)l * 1024 * 1024, 1024, 0, 1024, 1024, 0, nullptr}, v, sm); }
                else { v -= 1024; it_transpose(TrArgs{p.in[15] + (size_t)l * 256 * 256, 256, 0, 256, (bf16*)(ws + WS_WTGLU) + (size_t)l * 256 * 256, 256, 0, 256, 256, 0, nullptr}, v, sm); }
                continue;
            }
            v -= 2 * N_LAYER;
            if (v < N_PK) { const int l = v >> 1, w = v & 1; conv_chunk(p.in[24 + w] + (size_t)l * 8192, (bf16*)(ws + WS_PK) + (size_t)l * 16384 + w * 8192, 0, 1024); continue; }
            v -= N_PK;
            if (v < N_GW) { it_gw(p, v); continue; }
            v -= N_GW;
            it_ssm_pw(p, v);
        }
        xcd_barrier(bar);
    }
    for (int rep = 0; rep < NREP(1); ++rep) {
            PHASE_PTRS
        constexpr int N_NORM = NTOK / 4, N_TAB = 4096, N_KT = 256;
        for (int vb = bid; vb < N_NORM + N_TAB + N_KT; vb += G) {
            if (vb < N_KT) { it_ssm_kt(p, vb, sm); continue; }
            if (vb - N_KT < N_NORM) {
                const int t_ = opq_tid(); const int row = (vb - N_KT) * 4 + (t_ >> 6);
                const float* m0 = (const float*)(wsb(p) + WS_MOD) + (size_t)(row >> 12) * 6144;
                norm_mod_row(p.in[0] + (size_t)row * 1024, p.in[2], m0, m0 + 1024, (bf16*)(wsb(p) + WS_H) + (size_t)row * 1024, t_ & 63);
            } else {
                const size_t base = (size_t)(vb - N_KT - N_NORM) * 2048;
                for (int e = 0; e < 8; ++e) ssm_tab_entry(p, base + e * 256 + opq_tid());
            }
        }
        xcd_barrier(bar);
    }

    for (int l = 0; l < 2; ++l) {
        const float* xin = l == 0 ? p.in[0] : p.out;
        for (int rep = 0; rep < NREP(2 + 8 * l); ++rep) {
            PHASE_PTRS
            const EpiBf16 epi{PROJ, NPROJ};
            const bf16* Bt = (const bf16*)(ws + WS_WTIN) + (size_t)l * NPROJ * 1024;
            const bf16* Hin = l == 0 ? H : (const bf16*)(ws + WS_H2);
            for (int t = bid; t < (NTOK / 128) * (NPROJ / 128); t += G) { gemm_tile(Hin, 1024, Bt, 1024, 1024, (t / (NPROJ / 128)) * 128, (t % (NPROJ / 128)) * 128, (bf16*)sm, epi); __syncthreads(); }
            xcd_barrier(bar);
        }
        for (int rep = 0; rep < NREP(3 + 8 * l); ++rep) {
            PHASE_PTRS
            unsigned* ctr = qctr + 64 * (qn++);
            for (;;) {
                const int it = q_next(ctr, qslot);
                if (it >= 2048) break;
                if (it < 1024) it_dsa_index_select(p, it, sm);
                else if (it < 1536) it_gmlp(p, l, it - 1024, sm);
                else if (it < 1792) it_ssm_a(p, l, it - 1536);
                else it_kvn(p, l, it - 1792);
            }
            xcd_barrier(bar);
        }
        for (int rep = 0; rep < NREP(4 + 8 * l); ++rep) {
            PHASE_PTRS
            unsigned* ctr = qctr + 64 * (qn++);
            for (;;) {
                const int it = q_next(ctr, qslot);
                if (it >= 256 + 1024 + 512) break;
                if (it < 256) it_ssm_c(p, l, it, sm);
                else if (it < 1280) it_dsa_attn(p, it - 256, sm);
                else {
                    const int v = it - 1280, w = v >> 8, ch = v & 255;
                    if (!(PEER_FP8_MASK & (1 << l))) conv_chunk(p.in[26 + w] + (size_t)l * NEXP * 1024, (bf16*)(ws + (w ? WS_VB : WS_UB)), (size_t)ch * 8192, 8192);
                    else conv_chunk_fp8(p.in[26 + w] + (size_t)l * NEXP * 1024, ws + (w ? WS_VB : WS_UB), (size_t)ch * 4096, 4096, w ? V_SCALE : U_SCALE);
                }
            }
            xcd_barrier(bar);
        }
        for (int rep = 0; rep < NREP(5 + 8 * l); ++rep) {
            PHASE_PTRS
            const EpiGlu epi{(const bf16*)(ws + WS_YG), p.in[16] + l * 256, (bf16*)(ws + WS_MIX)};
            const bf16* Bt = (const bf16*)(ws + WS_WTGLU) + (size_t)l * 256 * 256;
            for (int t = bid; t < (NTOK / 128) * 2; t += G) { gemm_tile((const bf16*)(ws + WS_YG), 256, Bt, 256, 256, (t >> 1) * 128, (t & 1) * 128, (bf16*)sm, epi); __syncthreads(); }
            xcd_barrier(bar);
        }
        for (int rep = 0; rep < NREP(6 + 8 * l); ++rep) {
            PHASE_PTRS
            const EpiResid epi{xin, X, mod + (size_t)l * 4 * 6144 + 2048};
            const bf16* Bt = (const bf16*)(ws + WS_WTOUT) + (size_t)l * 1024 * KMIX;
            for (int t = bid; t < (NTOK / 128) * 8; t += G) { gemm_tile((const bf16*)(ws + WS_MIX), KMIX, Bt, KMIX, KMIX, (t >> 3) * 128, (t & 7) * 128, (bf16*)sm, epi); __syncthreads(); }
            xcd_barrier(bar);
        }
        for (int rep = 0; rep < NREP(7 + 8 * l); ++rep) {
            PHASE_PTRS
            for (int vb = bid; vb < NTOK / 4; vb += G) {
                const int t_ = opq_tid(); const int row = vb * 4 + (t_ >> 6);
                const float* m0 = (const float*)(wsb(p) + WS_MOD) + ((size_t)l * 4 + (row >> 12)) * 6144 + 3072;
                norm_mod_row((const float*)(wsb(p) + WS_X) + (size_t)row * 1024, p.in[3] + l * 1024, m0, m0 + 1024, (bf16*)(wsb(p) + WS_H) + (size_t)row * 1024, t_ & 63);
            }
            xcd_barrier(bar);
        }
        for (int rep = 0; rep < NREP(8 + 8 * l); ++rep) {
            PHASE_PTRS
            const EpiBf16 epi{PROJ, 1024};
            const bf16* Bt = (const bf16*)(ws + WS_WTQ) + (size_t)l * 1024 * 1024;
            for (int t = bid; t < (NTOK / 128) * 8; t += G) { gemm_tile(H, 1024, Bt, 1024, 1024, (t >> 3) * 128, (t & 7) * 128, (bf16*)sm, epi); __syncthreads(); }
            xcd_barrier(bar);
        }
        for (int rep = 0; rep < NREP(9 + 8 * l); ++rep) {
            PHASE_PTRS
            PeerLds2& S = *(PeerLds2*)sm;
            __syncthreads();
            const int t_ = opq_tid(), lane_ = t_ & 63, wave_ = t_ >> 6;
            for (int wb = bid * 4 + wave_; wb < NTOK / 8; wb += G * 4) {
                peer_retrieve(p, l, wb * 8, S, lane_, wave_);
                for (int tt = 0; tt < 8; ++tt) {
                    if (PEER_FP8_MASK & (1 << l)) peer_experts<true>(p, l, wb * 8 + tt, tt, S, lane_, wave_);
                    else peer_experts<false>(p, l, wb * 8 + tt, tt, S, lane_, wave_);
                }
            }
            if (l == 0 || rep + 1 < NREP(9 + 8 * l)) xcd_barrier(bar);
        }
    }
}

extern "C" void kernel_launch(void* const* d_in, const int* in_sizes, int n_in, void* d_out, int out_size, void* d_ws, size_t ws_size, hipStream_t stream) {
    if (n_in != 29 || ws_size < WS_END) { fprintf(stderr, "kernel_launch: bad args (n_in %d, ws %zu, need %zu)\n", n_in, ws_size, (size_t)WS_END); return; }
    static int grid = 0;
    if (grid == 0) {
        int dev = 0, cus = 0, per_cu = 0;
        if (hipGetDevice(&dev) != hipSuccess || hipDeviceGetAttribute(&cus, hipDeviceAttributeMultiprocessorCount, dev) != hipSuccess) { grid = -1; return; }
        if (hipOccupancyMaxActiveBlocksPerMultiprocessor(&per_cu, (const void*)fwd_megakernel, 256, 0) != hipSuccess || per_cu < 1) { fprintf(stderr, "kernel_launch: occupancy query failed (%d)\n", per_cu); grid = -1; return; }
        const int use = per_cu < 2 ? per_cu : 2;
        grid = cus * use;
    }
    if (grid < 0) return;
    if (hipMemsetAsync((char*)d_ws + WS_CTL, 0, 65536, stream) != hipSuccess) { fprintf(stderr, "kernel_launch: memset failed\n"); return; }
    Params p{};
    for (int i = 0; i < 29; ++i) p.in[i] = (const float*)d_in[i];
    p.out = (float*)d_out; p.ws = (unsigned char*)d_ws;
    void* args[] = {&p};
    const hipError_t e = hipLaunchCooperativeKernel((const void*)fwd_megakernel, dim3(grid), dim3(256), args, 0, stream);
    if (e != hipSuccess) fprintf(stderr, "kernel_launch: cooperative launch failed: %s (grid %d)\n", hipGetErrorString(e), grid);
}
```

```cpp
#include <hip/hip_runtime.h>
#include <cstdint>
#include <cstdio>

typedef unsigned short bf16;
typedef short bf16x8 __attribute__((ext_vector_type(8)));
typedef short s16x4 __attribute__((ext_vector_type(4)));
typedef float f32x4 __attribute__((ext_vector_type(4)));
typedef unsigned u32x4 __attribute__((ext_vector_type(4)));
typedef unsigned u32x2 __attribute__((ext_vector_type(2)));
typedef __bf16 bf2 __attribute__((ext_vector_type(2)));
#define DI __device__ __forceinline__
#define MFMA16(a, b, c) __builtin_amdgcn_mfma_f32_16x16x32_bf16((a), (b), (c), 0, 0, 0)

constexpr int DM = 1024, NB = 4, SEQ = 4096, NTOK = NB * SEQ;
constexpr int NPROJ = 2304;
constexpr int C_UA = 0, C_UB = 256, C_VB = 512, C_QA = 768, C_CKV = 1792, C_QI = 1920, C_KI = 2176, C_WI = 2240;
constexpr int KMIX = 1536;
constexpr int NEXP = 16384;
constexpr size_t SCORES_PER_BATCH = (size_t)4096 * 2080;

constexpr size_t al256(size_t x) { return (x + 255) & ~(size_t)255; }
constexpr size_t WS_CTL = 0;
constexpr size_t WS_MOD = 65536;
constexpr size_t WS_WTIN = al256(WS_MOD + 2 * 4 * 6144 * 4);
constexpr size_t WS_WTOUT = al256(WS_WTIN + (size_t)2 * NPROJ * 1024 * 2);
constexpr size_t WS_WTQ = al256(WS_WTOUT + (size_t)2 * 1024 * KMIX * 2);
constexpr size_t WS_WTGLU = al256(WS_WTQ + (size_t)2 * 1024 * 1024 * 2);
constexpr size_t WS_GW = al256(WS_WTGLU + (size_t)2 * 256 * 256 * 2);
constexpr size_t WS_PK = al256(WS_GW + (size_t)2 * 4 * 128 * 128 * 2);
constexpr size_t WS_PW = al256(WS_PK + (size_t)2 * 2 * 128 * 64 * 2);
constexpr size_t WS_BB = al256(WS_PW + (size_t)2 * 16 * 65 * 64 * 2 * 4);
constexpr size_t WS_E = al256(WS_BB + (size_t)2 * 16 * 64 * 16 * 2 * 4);
constexpr size_t WS_G = al256(WS_E + (size_t)2 * 16 * 128 * 1024 * 2);
constexpr size_t WS_KT = al256(WS_G + (size_t)2 * 16 * 1024 * 128 * 2);
constexpr size_t WS_UB = al256(WS_KT + (size_t)2 * 16 * 64 * 256 * 2);
constexpr size_t WS_VB = al256(WS_UB + (size_t)NEXP * 1024 * 2);
constexpr size_t WS_H = al256(WS_VB + (size_t)NEXP * 1024 * 2);
constexpr size_t WS_PROJ = al256(WS_H + (size_t)NTOK * 1024 * 2);
constexpr size_t WS_SLOC = al256(WS_PROJ + (size_t)NTOK * NPROJ * 2);
constexpr size_t WS_YG = al256(WS_SLOC + (size_t)256 * 16 * 128 * 4);
constexpr size_t WS_KVN = al256(WS_YG + (size_t)NTOK * 256 * 2);
constexpr size_t WS_SEL = al256(WS_KVN + (size_t)NTOK * 128 * 2);
constexpr size_t WS_MIX = al256(WS_SEL + (size_t)NTOK * 256 * 2);
constexpr size_t WS_X = al256(WS_MIX + (size_t)NTOK * KMIX * 2);
constexpr size_t WS_SCORES = al256(WS_X + (size_t)NTOK * 1024 * 4);
constexpr size_t WS_H2 = al256(WS_SCORES + (size_t)NB * SCORES_PER_BATCH * 4);
constexpr size_t WS_END = al256(WS_H2 + (size_t)NTOK * 1024 * 2);

struct Params {
    const float* in[29];
    float* out;
    unsigned char* ws;
};

typedef __bf16 bf2v_t __attribute__((ext_vector_type(2)));
typedef float f2v_t __attribute__((ext_vector_type(2)));
DI unsigned cvt_pk_bf16(float lo, float hi) { const f2v_t f = {lo, hi}; const bf2v_t r = __builtin_convertvector(f, bf2v_t); return __builtin_bit_cast(unsigned, r); }
DI bf16 f2bf(float x) { return (bf16)(cvt_pk_bf16(x, 0.f) & 0xffffu); }
DI float bf2f(bf16 b) { return __uint_as_float((unsigned)b << 16); }
DI float bflo(unsigned u) { return __uint_as_float(u << 16); }
DI float bfhi(unsigned u) { return __uint_as_float(u & 0xffff0000u); }
DI float dot2bf(unsigned a, unsigned b, float c) { return __builtin_amdgcn_fdot2_f32_bf16(__builtin_bit_cast(bf2, a), __builtin_bit_cast(bf2, b), c, false); }
DI float gelu_tanh(float x) { const float u = 0.7978845608028654f * (x + 0.044715f * x * x * x); const float e = __expf(2.f * u); const float t = 1.f - 2.f / (e + 1.f); return 0.5f * x * (1.f + t); }
DI float sigmoidf(float x) { return 1.f / (1.f + __expf(-x)); }
DI float wave_sum(float v) { for (int o = 32; o > 0; o >>= 1) v += __shfl_xor(v, o); return v; }
DI unsigned wave_sum_u32(unsigned v) {
    int x = (int)v;
    x += __builtin_amdgcn_update_dpp(0, x, 0xB1, 0xf, 0xf, true);
    x += __builtin_amdgcn_update_dpp(0, x, 0x4E, 0xf, 0xf, true);
    x += __builtin_amdgcn_update_dpp(0, x, 0x141, 0xf, 0xf, true);
    x += __builtin_amdgcn_update_dpp(0, x, 0x140, 0xf, 0xf, true);
    x += __builtin_amdgcn_update_dpp(0, x, 0x142, 0xa, 0xf, true);
    x += __builtin_amdgcn_update_dpp(0, x, 0x143, 0xc, 0xf, true);
    return (unsigned)__builtin_amdgcn_readlane(x, 63);
}
DI unsigned wave_scan_incl_u32(unsigned v) {
    int x = (int)v;
    x += __builtin_amdgcn_update_dpp(0, x, 0x111, 0xf, 0xf, true);
    x += __builtin_amdgcn_update_dpp(0, x, 0x112, 0xf, 0xf, true);
    x += __builtin_amdgcn_update_dpp(0, x, 0x114, 0xf, 0xf, true);
    x += __builtin_amdgcn_update_dpp(0, x, 0x118, 0xf, 0xf, true);
    x += __builtin_amdgcn_update_dpp(0, x, 0x142, 0xa, 0xf, true);
    x += __builtin_amdgcn_update_dpp(0, x, 0x143, 0xc, 0xf, true);
    return (unsigned)x;
}
DI unsigned fkey(float v) { const unsigned u = __float_as_uint(v); return (u & 0x80000000u) ? ~u : (u | 0x80000000u); }
DI unsigned unkey(unsigned k) { return (k & 0x80000000u) ? (k & 0x7fffffffu) : ~k; }
DI bf16x8 ld16(const void* p) { return *(const bf16x8*)p; }
DI bf16x8 zero8() { bf16x8 z = {0, 0, 0, 0, 0, 0, 0, 0}; return z; }


#define XB_TMO      128
#define XB_XCNT(j)  (256  + 64 * (j))
#define XB_XSUB(j)  (1280 + 64 * (j))
#define XB_XGEN(j)  (2304 + 64 * (j))
#define XB_TOP      3328
#define XB_TOPGEN   3392
#define XCD_BAR_WORDS 3456
#define XB_SPIN_CAP (1u << 22)
#define LAS __attribute__((address_space(3)))
DI unsigned xb_ld(unsigned* p)              { return __hip_atomic_load(p, __ATOMIC_RELAXED, __HIP_MEMORY_SCOPE_AGENT); }
DI unsigned xb_add(unsigned* p, unsigned v) { return __hip_atomic_fetch_add(p, v, __ATOMIC_RELAXED, __HIP_MEMORY_SCOPE_AGENT); }
DI unsigned xb_xcc_id() { return (unsigned)__builtin_amdgcn_s_getreg((3 << 11) | 20) & 0xFu; }
#define XB_SPIN(cond, bar) do { unsigned _sp = 0; while (cond) { __builtin_amdgcn_s_sleep(1); \
    if ((++_sp & 255u) == 0u) { if (xb_ld(&(bar)[XB_TMO])) break; if (_sp > XB_SPIN_CAP) { atomicAdd(&(bar)[XB_TMO], 1u); break; } } } } while (0)
struct XcdBarrier { unsigned* bar; unsigned x; volatile LAS unsigned* st; };
DI XcdBarrier xcd_barrier_post(unsigned* bar, volatile LAS unsigned* st) {
    XcdBarrier b; b.bar = bar; b.x = xb_xcc_id(); b.st = st;
    if (threadIdx.x == 0) (void)xb_add(&bar[XB_XCNT(b.x)], 1u);
    return b;
}
DI void xcd_barrier_complete(unsigned* bar, unsigned x, unsigned& nloc, unsigned& nx) {
    const unsigned G = gridDim.x * gridDim.y * gridDim.z;
    unsigned sum, cnt, mine, sp = 0u;
    for (;;) {
        sum = 0u; cnt = 0u; mine = 0u;
#pragma unroll
        for (unsigned j = 0; j < 16; ++j) { const unsigned c = xb_ld(&bar[XB_XCNT(j)]); sum += c; cnt += (c > 0u) ? 1u : 0u; mine = (j == x) ? c : mine; }
        if (sum == G) break;
        __builtin_amdgcn_s_sleep(1);
        if ((++sp & 255u) == 0u) { if (xb_ld(&bar[XB_TMO])) break; if (sp > XB_SPIN_CAP) { atomicAdd(&bar[XB_TMO], 1u); break; } }
    }
    nloc = mine > 0u ? mine : 1u; nx = cnt > 0u ? cnt : 1u;
}
DI void xcd_barrier(const XcdBarrier& b) {
    asm volatile("s_waitcnt vmcnt(0)" ::: "memory");
    __syncthreads();
    if (threadIdx.x == 0) {
        unsigned* bar = b.bar;
        __builtin_amdgcn_s_waitcnt(0);
        unsigned nloc = b.st[0], nx = b.st[1];
        if (nloc == 0u) { xcd_barrier_complete(bar, b.x, nloc, nx); b.st[0] = nloc; b.st[1] = nx; }
        const unsigned old = xb_add(&bar[XB_XSUB(b.x)], 1u);
        const unsigned gen = old / nloc;
        if (old + 1u == (gen + 1u) * nloc) {
            __builtin_amdgcn_fence(__ATOMIC_RELEASE, "agent");
            asm volatile("s_waitcnt vmcnt(0)" ::: "memory");
            const unsigned og = xb_add(&bar[XB_TOP], 1u);
            const unsigned tg = og / nx;
            if (og + 1u == (tg + 1u) * nx) xb_add(&bar[XB_TOPGEN], 1u);
            else XB_SPIN(xb_ld(&bar[XB_TOPGEN]) == tg, bar);
            __builtin_amdgcn_fence(__ATOMIC_ACQUIRE, "agent");
            xb_add(&bar[XB_XGEN(b.x)], 1u);
            asm volatile("s_waitcnt vmcnt(0)" ::: "memory");
        } else {
            XB_SPIN(xb_ld(&bar[XB_XGEN(b.x)]) == gen, bar);
            __builtin_amdgcn_fence(__ATOMIC_ACQUIRE, "agent");
            asm volatile("s_waitcnt vmcnt(0)" ::: "memory");
        }
    }
    __syncthreads();
}
typedef __attribute__((address_space(1))) unsigned char g_uc;
DI unsigned char* wsb(const Params& p) {
    typedef const unsigned long long __attribute__((address_space(4))) karg_u64;
    const unsigned long long w = *(karg_u64*)((const char __attribute__((address_space(4)))*)__builtin_amdgcn_kernarg_segment_ptr() + __builtin_offsetof(Params, ws));
    unsigned lo = (unsigned)w, hi = (unsigned)(w >> 32);
    asm volatile("" : "+s"(lo), "+s"(hi));
    return (unsigned char*)(g_uc*)(((unsigned long long)hi << 32) | lo);
}
extern __shared__ __attribute__((aligned(1024))) unsigned char g_lds[];
constexpr int LDS_CTL = 131072, LDS_BYTES = 131072 + 256;
DI int opq_tid() { int t = (int)(threadIdx.x & 255u); asm volatile("" : "+v"(t)); return t; }
DI void hsync() {
    asm volatile("s_waitcnt lgkmcnt(0)" ::: "memory");
    LAS unsigned* ctr = (LAS unsigned*)(g_lds + LDS_CTL + 32) + (threadIdx.x >> 8);
    unsigned old = 0u;
    if ((threadIdx.x & 63u) == 0u) old = __hip_atomic_fetch_add(ctr, 1u, __ATOMIC_RELAXED, __HIP_MEMORY_SCOPE_WORKGROUP);
    old = (unsigned)__builtin_amdgcn_readfirstlane((int)old);
    const unsigned target = (old & ~3u) + 4u;
    while (__hip_atomic_load(ctr, __ATOMIC_RELAXED, __HIP_MEMORY_SCOPE_WORKGROUP) < target) __builtin_amdgcn_s_sleep(1);
    asm volatile("" ::: "memory");
}
DI void hsync_g() { asm volatile("s_waitcnt vmcnt(0)" ::: "memory"); hsync(); }
DI int q_next(unsigned* ctr, volatile int* slot) {
    hsync();
    if ((threadIdx.x & 255u) == 0u) *slot = (int)__hip_atomic_fetch_add(ctr, 1u, __ATOMIC_RELAXED, __HIP_MEMORY_SCOPE_AGENT);
    hsync();
    return *slot;
}
DI void it_mod(const Params& p, int vb, unsigned char* sm) {
    float (*ca)[1024] = (float (*)[1024])sm;
    float (*part)[4][64] = (float (*)[4][64])(sm + 16384);
    const float* c = p.in[1];
    const int tid = opq_tid();
    hsync();
    for (int i = tid; i < 4096; i += 256) { const float v = c[i]; ca[i >> 10][i & 1023] = v / (1.f + __expf(-v)); }
    hsync();
    const int col = tid & 63, sl = tid >> 6;
    const int idx = vb * 64 + col;
    const int l = idx / 6144, n = idx % 6144;
    const float* w = p.in[4] + (size_t)l * 1024 * 6144 + n + (size_t)(256 * sl) * 6144;
    float a0 = 0, a1 = 0, a2 = 0, a3 = 0;
#pragma unroll 8
    for (int k = 0; k < 256; ++k) { const float wv = w[(size_t)k * 6144]; const int kk = 256 * sl + k; a0 += ca[0][kk] * wv; a1 += ca[1][kk] * wv; a2 += ca[2][kk] * wv; a3 += ca[3][kk] * wv; }
    part[sl][0][col] = a0; part[sl][1][col] = a1; part[sl][2][col] = a2; part[sl][3][col] = a3;
    hsync();
    {
        const int bb = tid >> 6;
        const float v = part[0][bb][col] + part[1][bb][col] + part[2][bb][col] + part[3][bb][col] + p.in[5][l * 6144 + n];
        ((float*)(wsb(p) + WS_MOD))[((size_t)l * 4 + bb) * 6144 + n] = v;
    }
}

struct TrArgs { const float* src; int lds, coff, nvalid; bf16* dst; int ldd, doff; int K, N; int mode; const float* aux; };
DI void it_transpose(const TrArgs& a, int vb, unsigned char* sm) {
    float (*t)[33] = (float (*)[33])sm;
    float (*ta)[65] = (float (*)[65])(sm + 4352);
    float (*tb)[33] = (float (*)[33])(sm + 4352 + 8320);
    const int nk = a.K / 32;
    const int kt = vb % nk, nt = vb / nk;
    const int tid = opq_tid(), tx = tid & 31, ty = tid >> 5;
    hsync();
    if (a.mode == 0) {
        for (int r = ty; r < 32; r += 8) {
            const int k = kt * 32 + r, n = nt * 32 + tx;
            t[r][tx] = (n + a.coff < a.nvalid) ? a.src[(size_t)k * a.lds + n + a.coff] : 0.f;
        }
    } else if (a.mode == 1) {
        const int h = (nt * 32) >> 7, r0 = (nt * 32) & 127;
        for (int i = tid; i < 32 * 64; i += 256) { const int kk = i >> 6, d = i & 63; ta[kk][d] = a.src[(size_t)(kt * 32 + kk) * a.lds + 768 + 64 * h + d]; }
        for (int i = tid; i < 64 * 32; i += 256) { const int d = i >> 5, rr = i & 31; tb[d][rr] = a.aux[((size_t)h * 64 + d) * 128 + r0 + rr]; }
        hsync();
        for (int r = ty; r < 32; r += 8) { float s = 0; _Pragma("unroll 16") for (int d = 0; d < 64; ++d) s += ta[r][d] * tb[d][tx]; t[r][tx] = s * 0.125f; }
    } else {
        const int h = (kt * 32) >> 7, r0 = (kt * 32) & 127;
        for (int i = tid; i < 32 * 64; i += 256) { const int rr = i >> 6, d = i & 63; ta[rr][d] = a.aux[((size_t)h * 128 + r0 + rr) * 64 + d]; }
        for (int i = tid; i < 64 * 32; i += 256) { const int d = i >> 5, nn = i & 31; tb[d][nn] = a.src[(size_t)(512 + 64 * h + d) * a.lds + nt * 32 + nn]; }
        hsync();
        for (int r = ty; r < 32; r += 8) { float s = 0; _Pragma("unroll 16") for (int d = 0; d < 64; ++d) s += ta[r][d] * tb[d][tx]; t[r][tx] = s; }
    }
    hsync();
    for (int r = ty; r < 32; r += 8) {
        const int n = nt * 32 + r, k = kt * 32 + tx;
        a.dst[(size_t)n * a.ldd + a.doff + k] = f2bf(t[tx][r]);
    }
}
DI void conv_chunk(const float* __restrict__ src, bf16* __restrict__ dst, size_t i0, int n8) {
    for (int i = opq_tid(); i < n8; i += 256) {
        const float4 a = ((const float4*)src)[2 * (i0 + i)], b = ((const float4*)src)[2 * (i0 + i) + 1];
        u32x4 o; o.x = cvt_pk_bf16(a.x, a.y); o.y = cvt_pk_bf16(a.z, a.w); o.z = cvt_pk_bf16(b.x, b.y); o.w = cvt_pk_bf16(b.z, b.w);
        ((u32x4*)dst)[i0 + i] = o;
    }
}
DI void it_gw(const Params& p, int vb) {
    for (int e = 0; e < 4; ++e) {
        const int idx = vb * 1024 + e * 256 + opq_tid();
        const int s = idx & 127, t = (idx >> 7) & 127;
        const float v = (t >= 64 || s < 64) ? p.in[17][idx] : 0.f;
        ((bf16*)(wsb(p) + WS_GW))[idx] = f2bf(v);
    }
}
DI void it_ssm_pw(const Params& p, int vb) {
    const int idx = vb * 256 + opq_tid();
    const int pp = idx & 63, g = (idx >> 6) & 15, l = idx >> 10;
    const float lre = -__expf(p.in[7][idx]), lim = p.in[8][idx];
    const float dt = __expf(p.in[14][l * 16 + g]);
    float* pw = (float*)(wsb(p) + WS_PW) + ((size_t)(l * 16 + g) * 65) * 128;
    for (int d = 0; d <= 64; ++d) {
        const float mag = expf(lre * dt * (float)d); float sn, cs; sincosf(lim * dt * (float)d, &sn, &cs);
        pw[d * 128 + pp * 2] = mag * cs; pw[d * 128 + pp * 2 + 1] = mag * sn;
    }
    const float mag = expf(lre * dt); float sn, cs; sincosf(lim * dt, &sn, &cs);
    const float are = mag * cs, aim = mag * sn;
    const float den = lre * lre + lim * lim, P = are - 1.f, Q = aim;
    const float fre = (P * lre + Q * lim) / den, fim = (Q * lre - P * lim) / den;
    float* bb = (float*)(wsb(p) + WS_BB) + (size_t)idx * 32;
    for (int h = 0; h < 16; ++h) { const float br = p.in[9][(size_t)idx * 16 + h], bi = p.in[10][(size_t)idx * 16 + h]; bb[h * 2] = fre * br - fim * bi; bb[h * 2 + 1] = fre * bi + fim * br; }
}
DI void it_ssm_kt(const Params& p, int vb, unsigned char* sm) {
    float* cz = (float*)sm;
    float* bz = (float*)(sm + 8192);
    float* pz = (float*)(sm + 16384);
    const int tid = opq_tid();
    const int lg = vb >> 3, d0 = (vb & 7) * 8;
    const float* PW = (const float*)(wsb(p) + WS_PW) + ((size_t)lg * 65 + d0) * 128;
    const float* BB = (const float*)(wsb(p) + WS_BB) + (size_t)lg * 64 * 32;
    hsync();
    for (int i = tid; i < 1024; i += 256) { const int q = i >> 4, h = i & 15; cz[i * 2] = p.in[11][((size_t)lg * 16 + h) * 64 + q]; cz[i * 2 + 1] = p.in[12][((size_t)lg * 16 + h) * 64 + q]; }
    for (int i = tid; i < 2048; i += 256) bz[i] = BB[i];
    for (int i = tid; i < 1024; i += 256) pz[i] = PW[i];
    hsync();
    const int h = tid >> 4, hh = tid & 15;
    float acc[8];
#pragma unroll
    for (int d = 0; d < 8; ++d) acc[d] = 0.f;
    for (int q = 0; q < 64; ++q) {
        const float cr = cz[(q * 16 + h) * 2], ci = cz[(q * 16 + h) * 2 + 1], br = bz[(q * 16 + hh) * 2], bi = bz[(q * 16 + hh) * 2 + 1];
        const float xr = cr * br - ci * bi, xi = cr * bi + ci * br;
#pragma unroll
        for (int d = 0; d < 8; ++d) acc[d] += xr * pz[(d * 64 + q) * 2] - xi * pz[(d * 64 + q) * 2 + 1];
    }
    bf16* KT = (bf16*)(wsb(p) + WS_KT) + ((size_t)lg * 64 + d0) * 256;
    if (d0 == 0 && h == hh) acc[0] += p.in[13][(size_t)lg * 16 + h];
#pragma unroll
    for (int d = 0; d < 8; ++d) KT[d * 256 + tid] = f2bf(acc[d]);
    hsync();
}
DI void ssm_tab_entry(const Params& p, size_t idx) {
    const size_t NE = (size_t)2 * 16 * 128 * 1024;
    const float* PW = (const float*)(wsb(p) + WS_PW); const float* BB = (const float*)(wsb(p) + WS_BB);
    if (idx < NE) {
        const int kk = idx & 1023, pp = (idx >> 10) & 127; const int lg = (int)(idx >> 17);
        const int i = kk >> 4, hh = kk & 15, pq = pp & 63, part = pp >> 6;
        const float* pw = PW + ((size_t)lg * 65 + (63 - i)) * 128 + pq * 2; const float* bb = BB + ((size_t)lg * 64 + pq) * 32 + hh * 2;
        const float v = part ? (pw[0] * bb[1] + pw[1] * bb[0]) : (pw[0] * bb[0] - pw[1] * bb[1]);
        ((bf16*)(wsb(p) + WS_E))[idx] = f2bf(v);
    } else if (idx < 2 * NE) {
        const size_t e = idx - NE; const int pp = e & 127, jh = (e >> 7) & 1023; const int lg = (int)(e >> 17);
        const int j = jh >> 4, h = jh & 15, pq = pp & 63, part = pp >> 6;
        const float* pw = PW + ((size_t)lg * 65 + (j + 1)) * 128 + pq * 2;
        const float cr = p.in[11][((size_t)lg * 16 + h) * 64 + pq], ci = p.in[12][((size_t)lg * 16 + h) * 64 + pq];
        const float v = part ? -(cr * pw[1] + ci * pw[0]) : (cr * pw[0] - ci * pw[1]);
        ((bf16*)(wsb(p) + WS_G))[e] = f2bf(v);
    } else {
        const size_t e = idx - 2 * NE; if (e >= (size_t)2 * 16 * 64 * 256) return;
        const int hh = e & 15, h = (e >> 4) & 15, d = (e >> 8) & 63; const int lg = (int)(e >> 14);
        const float* pw = PW + ((size_t)lg * 65 + d) * 128; const float* bb = BB + (size_t)lg * 64 * 32 + hh * 2;
        const float* cr = p.in[11] + ((size_t)lg * 16 + h) * 64; const float* ci = p.in[12] + ((size_t)lg * 16 + h) * 64;
        float s = 0;
        for (int q = 0; q < 64; ++q) { const float zr = pw[q * 2] * bb[q * 32] - pw[q * 2 + 1] * bb[q * 32 + 1], zi = pw[q * 2] * bb[q * 32 + 1] + pw[q * 2 + 1] * bb[q * 32]; s += cr[q] * zr - ci[q] * zi; }
        ((bf16*)(wsb(p) + WS_KT))[e] = f2bf(s);
    }
}
DI void norm_mod_row(const float* __restrict__ xrow, const float* __restrict__ g, const float* __restrict__ sh, const float* __restrict__ sc, bf16* __restrict__ hrow, int lane) {
    float4 v[4]; float ss = 0;
#pragma unroll
    for (int j = 0; j < 4; ++j) { v[j] = *(const float4*)(xrow + 4 * lane + 256 * j); ss += v[j].x * v[j].x + v[j].y * v[j].y + v[j].z * v[j].z + v[j].w * v[j].w; }
    ss = wave_sum(ss);
    const float r = rsqrtf(ss * (1.f / 1024.f) + 1e-6f);
#pragma unroll
    for (int j = 0; j < 4; ++j) {
        const int c = 4 * lane + 256 * j;
        const float4 gg = *(const float4*)(g + c), s1 = *(const float4*)(sc + c), s0 = *(const float4*)(sh + c);
        u32x2 o; o.x = cvt_pk_bf16(v[j].x * r * gg.x * (1.f + s1.x) + s0.x, v[j].y * r * gg.y * (1.f + s1.y) + s0.y);
        o.y = cvt_pk_bf16(v[j].z * r * gg.z * (1.f + s1.z) + s0.z, v[j].w * r * gg.w * (1.f + s1.w) + s0.w);
        *(u32x2*)(hrow + c) = o;
    }
}
namespace pg8 {
#define PG8_LAS __attribute__((address_space(3)))
typedef unsigned short bf16_t;
constexpr int BM = 256, BK = 64, HALF = 128, HTB = HALF * BK * 2  , STAGE_BYTES = 8 * HTB, NXCD = 8, WGM = 8;
__host__ __device__ __forceinline__ int lds_byte(int r, int c) { const int st = (r >> 4) * 2 + (c >> 5), rr = r & 15, cc = c & 31, ob = rr * 64 + cc * 2; return st * 1024 + (ob ^ (((ob >> 9) & 1) << 5)); }
__host__ __device__ __forceinline__ void stage_rc(int b, int& R, int& C) { const int st = b / 1024, sb = b % 1024, swz = sb ^ (((sb >> 9) & 1) << 5); R = (st >> 1) * 16 + swz / 64; C = (st & 1) * 32 + (swz % 64) / 2; }
__host__ __device__ __forceinline__ int perm32(int rho) { const int n = rho >> 4, i = rho & 15; return 8 * (i >> 2) + 4 * n + (i & 3); }

struct Unit { int pm, pn; };
struct Gemm { const bf16_t* A; const bf16_t* Bt; int M, N, K; };

struct StaticOrder {
    int nM, nN, nwg, G, c;
    __host__ __device__ void init(int M, int N, int G_, int c_) { nM = M / BM; nN = N / BM; nwg = nM * nN; G = G_; c = c_; }
    __host__ __device__ bool next(int i, Unit& u) const {
        const long L = (long)i * G + c; if (L >= nwg) return false;
        int wgid = (int)L; { const int q = nwg / NXCD, r = nwg % NXCD, xcd = wgid % NXCD, off = wgid / NXCD; wgid = (xcd < r ? xcd * (q + 1) : r * (q + 1) + (xcd - r) * q) + off; }
        const int nig = WGM * nN, gid = wgid / nig, fm = gid * WGM, gsz = (nM - fm) < WGM ? (nM - fm) : WGM;
        u.pm = fm + ((wgid % nig) % gsz); u.pn = (wgid % nig) / gsz; return true;
    }
    __device__ __forceinline__ void a_ready(const Unit&) const {}
    __device__ __forceinline__ void done(const Unit&) const {}
};

template <class Epi, class Sched, bool ALIGN_EPI = false, bool SP2 = false>
__device__ __forceinline__ void gemm_phase(PG8_LAS unsigned char* lds, const Gemm g, const Sched& S, const Epi& E) {
    int tid = (int)threadIdx.x; asm volatile("" : "+v"(tid));
    const int wid = __builtin_amdgcn_readfirstlane(tid >> 6), lane = tid & 63, wr = wid >> 2, wc = wid & 3, fr = lane & 15, fq = lane >> 4;
    const int K = g.K, nt = K / BK;
    unsigned voffA[2], voffB[2];
#pragma unroll
    for (int i = 0; i < 2; ++i) { int R, C; stage_rc(tid * 16 + i * 8192, R, C); const int Rb = Epi::PERM ? ((R & ~31) + perm32(R & 31)) : R;
        voffA[i] = (unsigned)(R * K + C) * 2u; voffB[i] = (unsigned)(Rb * K + C) * 2u; }
    const size_t kstep = (size_t)(BK * 2);
    const size_t hstep = (size_t)HALF * K * 2;
    const size_t tstep = 2 * hstep;
    const unsigned ldsw = (unsigned)wid * 1024u;
    const int aoff = lds_byte(wr * 64 + fr, fq * 8), boff = lds_byte(wc * 32 + fr, fq * 8);
#define PG8_SA(b, h) (((b) * 2 + (h)) * HTB)
#define PG8_SB(b, h) ((4 + (b) * 2 + (h)) * HTB)
#define PG8_STAGE(bufoff, gbase, voff) do { _Pragma("unroll") for (int _i = 0; _i < 2; ++_i) \
        __builtin_amdgcn_global_load_lds((const unsigned*)((const char*)(gbase) + (voff)[_i]), (PG8_LAS unsigned*)(lds + (bufoff) + ldsw + _i * 8192), 16, 0, 0); } while (0)
#define PG8_LDA(dst, b, h) do { _Pragma("unroll") for (int m = 0; m < 4; ++m) _Pragma("unroll") for (int k = 0; k < 2; ++k) dst[m][k] = *(const PG8_LAS bf16x8*)(lds + PG8_SA(b, h) + aoff + m * 2048 + k * 1024); } while (0)
#define PG8_LDB(dst, b, h) do { _Pragma("unroll") for (int n = 0; n < 2; ++n) _Pragma("unroll") for (int k = 0; k < 2; ++k) dst[n][k] = *(const PG8_LAS bf16x8*)(lds + PG8_SB(b, h) + boff + n * 2048 + k * 1024); } while (0)
#define PG8_MMA(ai, bj, At, Bt) do { __builtin_amdgcn_s_setprio(1); _Pragma("unroll") for (int m = 0; m < 4; ++m) _Pragma("unroll") for (int n = 0; n < 2; ++n) _Pragma("unroll") for (int k = 0; k < 2; ++k) \
        acc[ai][bj][m][n] = __builtin_amdgcn_mfma_f32_16x16x32_bf16(Bt[n][k], At[m][k], acc[ai][bj][m][n], 0, 0, 0); __builtin_amdgcn_s_setprio(0); } while (0)
#define PG8_WAIT_V(n) asm volatile("s_waitcnt vmcnt(" #n ")" ::: "memory")
#define PG8_WAIT_L(n) asm volatile("s_waitcnt lgkmcnt(" #n ")" ::: "memory")
#define PG8_BAR __builtin_amdgcn_s_barrier()
#define PG8_SCHED __builtin_amdgcn_sched_barrier(0)
    Unit cur, nxt; int ui = 0;
    if (!S.next(0, cur)) return;
    f32x4 acc[2][2][4][2];
#pragma unroll
    for (int a = 0; a < 2; ++a)
#pragma unroll
        for (int b = 0; b < 2; ++b)
#pragma unroll
            for (int m = 0; m < 4; ++m)
#pragma unroll
                for (int n = 0; n < 2; ++n) acc[a][b][m][n] = (f32x4){0.f, 0.f, 0.f, 0.f};
    bf16x8 At[4][2], B0[2][2], B1[2][2];
    const char* cA = (const char*)g.A + (size_t)cur.pm * tstep; const char* cB = (const char*)g.Bt + (size_t)cur.pn * tstep;
    S.a_ready(cur);
    if constexpr (SP2) {
        PG8_STAGE(PG8_SB(0, 0), cB, voffB); PG8_STAGE(PG8_SB(0, 1), cB + hstep, voffB); PG8_STAGE(PG8_SA(0, 0), cA, voffA); PG8_STAGE(PG8_SA(0, 1), cA + hstep, voffA);
        if (wr == 1) PG8_BAR;
        PG8_WAIT_V(2); PG8_BAR;
        PG8_STAGE(PG8_SB(1, 0), cB + kstep, voffB); PG8_STAGE(PG8_SA(1, 0), cA + kstep, voffA); PG8_STAGE(PG8_SB(1, 1), cB + hstep + kstep, voffB);
        PG8_WAIT_V(6); PG8_BAR;
    } else {
        PG8_STAGE(PG8_SB(0, 0), cB, voffB); PG8_STAGE(PG8_SA(0, 0), cA, voffA); PG8_STAGE(PG8_SB(0, 1), cB + hstep, voffB); PG8_STAGE(PG8_SA(0, 1), cA + hstep, voffA);
        if (wr == 1) PG8_BAR;
        PG8_WAIT_V(4); PG8_BAR;
        PG8_STAGE(PG8_SB(1, 0), cB + kstep, voffB); PG8_STAGE(PG8_SA(1, 0), cA + kstep, voffA); PG8_STAGE(PG8_SB(1, 1), cB + hstep + kstep, voffB);
        PG8_WAIT_V(6); PG8_BAR;
    }
    for (;;) {
        const bool has_next = S.next(ui + 1, nxt);
        const char* nA = has_next ? (const char*)g.A + (size_t)nxt.pm * tstep : cA; const char* nB = has_next ? (const char*)g.Bt + (size_t)nxt.pn * tstep : cB;
        for (int t = 0; t < nt; t += 2) {
            const bool last = (t == nt - 2);
            const char* a1 = cA + (size_t)(t + 1) * kstep;
            const char* a2 = last ? nA : cA + (size_t)(t + 2) * kstep; const char* b2 = last ? nB : cB + (size_t)(t + 2) * kstep;
            const char* a3 = a2 + kstep; const char* b3 = b2 + kstep;
            if (last && has_next) S.a_ready(nxt);
            if constexpr (SP2) {
            PG8_LDB(B0, 0, 0); PG8_LDB(B1, 0, 1); PG8_SCHED; PG8_LDA(At, 0, 0); PG8_STAGE(PG8_SA(1, 1), a1 + hstep, voffA);
            PG8_WAIT_V(8); PG8_WAIT_L(0); PG8_BAR; PG8_MMA(0, 0, At, B0); PG8_MMA(0, 1, At, B1); PG8_BAR; PG8_SCHED;
            PG8_LDA(At, 0, 1); PG8_STAGE(PG8_SB(0, 0), b2, voffB); PG8_STAGE(PG8_SB(0, 1), b2 + hstep, voffB); PG8_STAGE(PG8_SA(0, 0), a2, voffA);
            PG8_WAIT_V(8); PG8_WAIT_L(0); PG8_BAR; PG8_MMA(1, 0, At, B0); PG8_MMA(1, 1, At, B1); PG8_BAR; PG8_SCHED;
            PG8_LDB(B0, 1, 0); PG8_LDB(B1, 1, 1); PG8_SCHED; PG8_LDA(At, 1, 0); PG8_STAGE(PG8_SA(0, 1), a2 + hstep, voffA);
            PG8_WAIT_V(8); PG8_WAIT_L(0); PG8_BAR; PG8_MMA(0, 0, At, B0); PG8_MMA(0, 1, At, B1); PG8_BAR; PG8_SCHED;
            PG8_LDA(At, 1, 1); PG8_STAGE(PG8_SB(1, 0), b3, voffB); PG8_STAGE(PG8_SB(1, 1), b3 + hstep, voffB); PG8_STAGE(PG8_SA(1, 0), a3, voffA);
            PG8_WAIT_V(8); PG8_WAIT_L(0); PG8_BAR; PG8_MMA(1, 0, At, B0); PG8_MMA(1, 1, At, B1); PG8_BAR; PG8_SCHED;
            } else {
            PG8_LDB(B0, 0, 0); PG8_SCHED; PG8_LDA(At, 0, 0); PG8_STAGE(PG8_SA(1, 1), a1 + hstep, voffA);
            PG8_WAIT_L(8); PG8_BAR; PG8_WAIT_L(0); PG8_MMA(0, 0, At, B0); PG8_BAR; PG8_SCHED;
            PG8_LDB(B1, 0, 1); PG8_STAGE(PG8_SB(0, 0), b2, voffB);
            PG8_BAR; PG8_WAIT_L(0); PG8_MMA(0, 1, At, B1); PG8_BAR;
            PG8_LDA(At, 0, 1); PG8_STAGE(PG8_SA(0, 0), a2, voffA);
            PG8_BAR; PG8_WAIT_L(0); PG8_MMA(1, 0, At, B0); PG8_BAR; PG8_SCHED;
            PG8_STAGE(PG8_SB(0, 1), b2 + hstep, voffB);
            PG8_WAIT_V(6); PG8_BAR; PG8_MMA(1, 1, At, B1); PG8_BAR;
            PG8_LDB(B0, 1, 0); PG8_SCHED; PG8_LDA(At, 1, 0); PG8_STAGE(PG8_SA(0, 1), a2 + hstep, voffA);
            PG8_WAIT_L(8); PG8_BAR; PG8_WAIT_L(0); PG8_MMA(0, 0, At, B0); PG8_BAR; PG8_SCHED;
            PG8_LDB(B1, 1, 1); PG8_STAGE(PG8_SB(1, 0), b3, voffB);
            PG8_BAR; PG8_WAIT_L(0); PG8_MMA(0, 1, At, B1); PG8_BAR;
            PG8_LDA(At, 1, 1); PG8_STAGE(PG8_SA(1, 0), a3, voffA);
            PG8_BAR; PG8_WAIT_L(0); PG8_MMA(1, 0, At, B0); PG8_BAR; PG8_SCHED;
            PG8_STAGE(PG8_SB(1, 1), b3 + hstep, voffB);
            PG8_WAIT_V(6); PG8_BAR; PG8_MMA(1, 1, At, B1); PG8_BAR;
            }
        }
        if constexpr (ALIGN_EPI) { if (wr == 0) PG8_BAR; }
        if constexpr (!Epi::AFTER_DRAIN) { E(acc, cur, wr, wc, fr, fq); S.done(cur); }
        if (!has_next) break;
#pragma unroll
        for (int a = 0; a < 2; ++a)
#pragma unroll
            for (int b = 0; b < 2; ++b)
#pragma unroll
                for (int m = 0; m < 4; ++m)
#pragma unroll
                    for (int n = 0; n < 2; ++n) acc[a][b][m][n] = (f32x4){0.f, 0.f, 0.f, 0.f};
        cur = nxt; cA = nA; cB = nB; ++ui;
        if constexpr (ALIGN_EPI) { if (wr == 1) PG8_BAR; }
    }
    PG8_WAIT_V(0);
    if constexpr (!ALIGN_EPI) { if (wr == 0) PG8_BAR; }
    PG8_BAR;
    if constexpr (Epi::AFTER_DRAIN) { E.fused(acc, cur, wr, wc, fr, fq, lds, wid, lane); S.done(cur); }
#undef PG8_SA
#undef PG8_SB
#undef PG8_STAGE
#undef PG8_LDA
#undef PG8_LDB
#undef PG8_MMA
#undef PG8_WAIT_V
#undef PG8_WAIT_L
#undef PG8_BAR
#undef PG8_SCHED
}
}
struct EpiBf16 { bf16* C; int ldc; DI void operator()(int r, int c, f32x4 v) const { u32x2 o; o.x = cvt_pk_bf16(v[0], v[1]); o.y = cvt_pk_bf16(v[2], v[3]); *(u32x2*)(C + (size_t)r * ldc + c) = o; } };
struct EpiResid { const float* xin; float* xout; const float* gate;
    DI void operator()(int r, int c, f32x4 v) const { const float4 x = *(const float4*)(xin + (size_t)r * 1024 + c); const float4 g = *(const float4*)(gate + (size_t)(r >> 12) * 6144 + c);
        float4 o; o.x = x.x + g.x * v[0]; o.y = x.y + g.y * v[1]; o.z = x.z + g.z * v[2]; o.w = x.w + g.w * v[3]; *(float4*)(xout + (size_t)r * 1024 + c) = o; } };
struct EpiGlu { const bf16* yg; const float* bglu; bf16* mix;
    DI void operator()(int r, int c, f32x4 v) const { const u32x2 y = *(const u32x2*)(yg + (size_t)r * 256 + c); const float4 b = *(const float4*)(bglu + c);
        u32x2 o; o.x = cvt_pk_bf16(bflo(y.x) * sigmoidf(v[0] + b.x), bfhi(y.x) * sigmoidf(v[1] + b.y)); o.y = cvt_pk_bf16(bflo(y.y) * sigmoidf(v[2] + b.z), bfhi(y.y) * sigmoidf(v[3] + b.w));
        *(u32x2*)(mix + (size_t)r * KMIX + c) = o; } };
template <class F> struct Epi256 {
    static constexpr bool PERM = false, AFTER_DRAIN = false;
    F f;
    DI void operator()(const f32x4 (&acc)[2][2][4][2], const pg8::Unit& u, int wr, int wc, int fr, int fq) const {
#pragma unroll
        for (int ai = 0; ai < 2; ++ai)
#pragma unroll
            for (int m = 0; m < 4; ++m)
#pragma unroll
                for (int bj = 0; bj < 2; ++bj)
#pragma unroll
                    for (int n = 0; n < 2; ++n) f(u.pm * 256 + ai * 128 + wr * 64 + m * 16 + fr, u.pn * 256 + bj * 128 + wc * 32 + n * 16 + 4 * fq, acc[ai][bj][m][n]);
    }
};

DI unsigned off_b(unsigned row, unsigned ch) { return 256u * row + 16u * (ch ^ (((row & 3u) << 2) | ((row >> 2) & 3u))); }
#define TR8(o0, o1, o2, o3, o4, o5, o6, o7, a0, a1, a2, a3, a4, a5, a6, a7)                                                                         \
    asm volatile("s_waitcnt lgkmcnt(0)\n\t"                                                                                                         \
                 "ds_read_b64_tr_b16 %0, %8\n\tds_read_b64_tr_b16 %1, %9\n\tds_read_b64_tr_b16 %2, %10\n\tds_read_b64_tr_b16 %3, %11\n\t"           \
                 "ds_read_b64_tr_b16 %4, %12\n\tds_read_b64_tr_b16 %5, %13\n\tds_read_b64_tr_b16 %6, %14\n\tds_read_b64_tr_b16 %7, %15\n\t"         \
                 "s_waitcnt lgkmcnt(0)"                                                                                                             \
                 : "=&v"(o0), "=&v"(o1), "=&v"(o2), "=&v"(o3), "=&v"(o4), "=&v"(o5), "=&v"(o6), "=&v"(o7)                                           \
                 : "v"(a0), "v"(a1), "v"(a2), "v"(a3), "v"(a4), "v"(a5), "v"(a6), "v"(a7)                                                           \
                 : "memory")

DI void it_kvn(const Params& p, int l, int vb) {
    const int lane = opq_tid() & 63, wave = opq_tid() >> 6;
    const bf16* proj = (const bf16*)(wsb(p) + WS_PROJ); bf16* kvn = (bf16*)(wsb(p) + WS_KVN);
    const float g0 = p.in[19][l * 128 + 2 * lane], g1 = p.in[19][l * 128 + 2 * lane + 1];
    for (int i = 0; i < 16; ++i) {
        const int row = vb * 64 + i * 4 + wave;
        const unsigned u = *(const unsigned*)(proj + (size_t)row * NPROJ + C_CKV + 2 * lane);
        const float a = bflo(u), b = bfhi(u);
        const float ss = wave_sum(a * a + b * b);
        const float r = rsqrtf(ss * (1.f / 128.f) + 1e-6f);
        *(unsigned*)(kvn + (size_t)row * 128 + 2 * lane) = cvt_pk_bf16(a * r * g0, b * r * g1);
    }
}

DI void it_ssm_a(const Params& p, int l, int item) {
    const int lane = opq_tid() & 63, wave = opq_tid() >> 6, fr = lane & 15, fq = lane >> 4;
    const bf16* proj = (const bf16*)(wsb(p) + WS_PROJ);
    float* sloc = (float*)(wsb(p) + WS_SLOC);
    const int g = item & 15, rt = item >> 4;
    const bf16* E = (const bf16*)(wsb(p) + WS_E) + ((size_t)(l * 16 + g) * 128) * 1024;
    const int R = 16 * rt + fr, b = R >> 6, k = R & 63;
    const bf16* arow = proj + ((size_t)b * 4096 + 64 * k + (fq >> 1)) * NPROJ + C_UA + 16 * g + 8 * (fq & 1);
    f32x4 acc[2] = {(f32x4){0, 0, 0, 0}, (f32x4){0, 0, 0, 0}};
#pragma unroll 4
    for (int ks = 0; ks < 32; ++ks) {
        const bf16x8 a = ld16(arow + (size_t)(2 * ks) * NPROJ);
#pragma unroll
        for (int c = 0; c < 2; ++c) { const int ct = 2 * wave + c; const bf16x8 bf = ld16(E + (size_t)(16 * ct + fr) * 1024 + 32 * ks + 8 * fq); acc[c] = MFMA16(a, bf, acc[c]); }
    }
#pragma unroll
    for (int c = 0; c < 2; ++c)
#pragma unroll
        for (int i = 0; i < 4; ++i) sloc[((size_t)(16 * rt + 4 * fq + i) * 16 + g) * 128 + 16 * (2 * wave + c) + fr] = acc[c][i];
}

DI void it_ssm_c(const Params& p, int l, int item, unsigned char* sm) {
    bf16* sst = (bf16*)sm;
    bf16* ktl = (bf16*)(sm + 17408);
    const int tid = opq_tid(), lane = tid & 63, wave = tid >> 6, fr = lane & 15, fq = lane >> 4;
    const bf16* proj = (const bf16*)(wsb(p) + WS_PROJ);
    const float* sloc = (const float*)(wsb(p) + WS_SLOC);
    bf16* yg = (bf16*)(wsb(p) + WS_YG);
    const int jq = item & 3, g = (item >> 2) & 15, b = item >> 6;
    const bf16* KT = (const bf16*)(wsb(p) + WS_KT) + (size_t)(l * 16 + g) * 64 * 256;
    hsync();
#pragma unroll
    for (int i = 0; i < 8; ++i) *(bf16x8*)(ktl + (i * 256 + tid) * 8) = ld16(KT + (size_t)(i * 256 + tid) * 8);
    if (wave == 0) {
        const float* pw64 = (const float*)(wsb(p) + WS_PW) + ((size_t)(l * 16 + g) * 65 + 64) * 128 + lane * 2;
        const float ar = pw64[0], ai = pw64[1];
        float sr = 0, si = 0;
        const float* s = sloc + ((size_t)(b * 64) * 16 + g) * 128;
#pragma unroll 8
        for (int k = 0; k < 64; ++k) {
            sst[k * 136 + lane] = f2bf(sr); sst[k * 136 + 64 + lane] = f2bf(si);
            const float lr = s[(size_t)k * 2048 + lane], li = s[(size_t)k * 2048 + 64 + lane];
            const float nr = ar * sr - ai * si + lr, ni = ar * si + ai * sr + li;
            sr = nr; si = ni;
        }
    }
    hsync();
    const bf16* G = (const bf16*)(wsb(p) + WS_G) + (size_t)(l * 16 + g) * 1024 * 128;
    const int kch = 16 * wave + fr;
    const bf16* arow = proj + ((size_t)b * 4096 + 64 * kch + (fq >> 1)) * NPROJ + C_UA + 16 * g + 8 * (fq & 1);
    const int j0 = 16 * jq;
    f32x4 acc[16];
#pragma unroll
    for (int jj = 0; jj < 16; ++jj) acc[jj] = (f32x4){0, 0, 0, 0};
    const int nks = (j0 + 15) / 2 + 1;
    bf16x8 a_cur = ld16(arow);
    for (int ks = 0; ks < nks; ++ks) {
        const bf16x8 a_nxt = (ks + 1 < nks) ? ld16(arow + (size_t)(2 * ks + 2) * NPROJ) : zero8();
#pragma unroll
        for (int jj = 0; jj < 16; ++jj) {
            const int j = j0 + jj;
            if (2 * ks <= j) {
                const int d = j - 2 * ks - (fq >> 1);
                const bf16x8 bl = ld16(ktl + ((d < 0 ? 0 : d) * 16 + fr) * 16 + 8 * (fq & 1));
                const bf16x8 bf = d >= 0 ? bl : zero8();
                acc[jj] = MFMA16(bf, a_cur, acc[jj]);
            }
        }
        a_cur = a_nxt;
    }
#pragma unroll
    for (int ks = 0; ks < 4; ++ks) {
        const bf16x8 a = ld16(sst + kch * 136 + 32 * ks + 8 * fq);
        bf16x8 bfr[16];
#pragma unroll
        for (int jj = 0; jj < 16; ++jj) bfr[jj] = ld16(G + ((size_t)((j0 + jj) * 16 + fr)) * 128 + 32 * ks + 8 * fq);
#pragma unroll
        for (int jj = 0; jj < 16; ++jj) acc[jj] = MFMA16(bfr[jj], a, acc[jj]);
    }
#pragma unroll
    for (int jj = 0; jj < 16; ++jj) {
        const size_t tok = (size_t)b * 4096 + 64 * (16 * wave + fr) + j0 + jj;
        u32x2 o; o.x = cvt_pk_bf16(gelu_tanh(acc[jj][0]), gelu_tanh(acc[jj][1])); o.y = cvt_pk_bf16(gelu_tanh(acc[jj][2]), gelu_tanh(acc[jj][3]));
        *(u32x2*)(yg + tok * 256 + 16 * g + 4 * fq) = o;
    }
}

DI void it_gmlp(const Params& p, int l, int item, unsigned char* sm) {
    bf16* vnT = (bf16*)sm;
    const int tid = opq_tid(), lane = tid & 63, wave = tid >> 6, fr = lane & 15, fq = lane >> 4;
    const bf16* proj = (const bf16*)(wsb(p) + WS_PROJ); bf16* mix = (bf16*)(wsb(p) + WS_MIX);
    const int h = item & 3, blk = item >> 2;
    const size_t tok0 = (size_t)blk * 128;
    hsync();
    {
        const int row = tid >> 1, half = tid & 1;
        const bf16* vp = proj + (tok0 + row) * NPROJ + C_VB + 64 * h + 32 * half;
        float v[32]; float s = 0;
#pragma unroll
        for (int q = 0; q < 4; ++q) { const bf16x8 t = ld16(vp + 8 * q);
#pragma unroll
            for (int e = 0; e < 8; ++e) { v[8 * q + e] = bf2f((bf16)t[e]); s += v[8 * q + e]; } }
        s += __shfl_xor(s, 1); const float mu = s * (1.f / 64.f);
        float vs = 0;
#pragma unroll
        for (int e = 0; e < 32; ++e) { const float d = v[e] - mu; vs += d * d; }
        vs += __shfl_xor(vs, 1); const float r = rsqrtf(vs * (1.f / 64.f) + 1e-6f);
#pragma unroll
        for (int e = 0; e < 32; ++e) vnT[(32 * half + e) * 136 + row] = f2bf((v[e] - mu) * r);
    }
    hsync();
    const bf16* W = (const bf16*)(wsb(p) + WS_GW) + (size_t)(l * 4 + h) * 128 * 128;
    f32x4 acc[4][2];
#pragma unroll
    for (int i = 0; i < 4; ++i) { acc[i][0] = (f32x4){0, 0, 0, 0}; acc[i][1] = (f32x4){0, 0, 0, 0}; }
#pragma unroll
    for (int ks = 0; ks < 4; ++ks) {
        bf16x8 fa[4], fb[2];
#pragma unroll
        for (int i = 0; i < 4; ++i) fa[i] = ld16(vnT + (16 * i + fr) * 136 + 32 * ks + 8 * fq);
#pragma unroll
        for (int j = 0; j < 2; ++j) fb[j] = ld16(W + (size_t)(16 * (2 * wave + j) + fr) * 128 + 32 * ks + 8 * fq);
#pragma unroll
        for (int i = 0; i < 4; ++i)
#pragma unroll
            for (int j = 0; j < 2; ++j) acc[i][j] = MFMA16(fa[i], fb[j], acc[i][j]);
    }
#pragma unroll
    for (int j = 0; j < 2; ++j) {
        const int t = 16 * (2 * wave + j) + fr;
        const float bs = p.in[18][(l * 4 + h) * 128 + t];
#pragma unroll
        for (int i = 0; i < 4; ++i) {
            const int d = 16 * i + 4 * fq;
            const u32x2 u = *(const u32x2*)(proj + (tok0 + t) * NPROJ + C_UB + 64 * h + d);
            u32x2 o; o.x = cvt_pk_bf16(bflo(u.x) * (acc[i][j][0] + bs), bfhi(u.x) * (acc[i][j][1] + bs)); o.y = cvt_pk_bf16(bflo(u.y) * (acc[i][j][2] + bs), bfhi(u.y) * (acc[i][j][3] + bs));
            *(u32x2*)(mix + (tok0 + t) * KMIX + 256 + 64 * h + d) = o;
        }
    }
}

DI size_t score_row_off(int b, int t) { const int c = t >> 6; return (size_t)b * SCORES_PER_BATCH + (size_t)4096 * (c * (c + 1) / 2) + (size_t)(t & 63) * 64 * (c + 1); }
template <int NR>
DI void dsa_select_impl(const float* __restrict__ srow, int nreg, bf16* __restrict__ so, int lane, unsigned* hist) {
    (void)hist;
    unsigned key[NR];
#pragma unroll
    for (int r = 0; r < NR; ++r) { const float v = srow[64 * r + lane]; key[r] = (r < nreg) ? fkey(v + 0.f) : 0u; }
    unsigned T = 0;
#pragma unroll 1
    for (int bit = 31; bit >= 0; --bit) {
        const unsigned cand = T | (1u << bit);
        unsigned c = 0;
#pragma unroll
        for (int r = 0; r < NR; ++r) asm("v_cmp_ge_u32 vcc, %1, %2\n\tv_addc_co_u32 %0, vcc, 0, %0, vcc" : "+v"(c) : "v"(key[r]), "v"(cand) : "vcc");
        const unsigned cnt = wave_sum_u32(c);
        if (cnt >= 256u) { T = cand; if (cnt == 256u) break; }
    }
    unsigned c = 0;
#pragma unroll
    for (int r = 0; r < NR; ++r) asm("v_cmp_gt_u32 vcc, %1, %2\n\tv_addc_co_u32 %0, vcc, 0, %0, vcc" : "+v"(c) : "v"(key[r]), "v"(T) : "vcc");
    const int need = 256 - (int)wave_sum_u32(c);
    int base = 0, eqb = 0;
    const unsigned long long lt = (1ull << lane) - 1ull;
#pragma unroll
    for (int r = 0; r < NR; ++r) {
        const unsigned long long me = __ballot(key[r] == T);
        const int erank = eqb + __popcll(me & lt);
        const bool take = (key[r] > T) || (key[r] == T && erank < need);
        const unsigned long long mt = __ballot(take);
        if (take) so[base + __popcll(mt & lt)] = (bf16)(64 * r + lane);
        base += __popcll(mt); eqb += __popcll(me);
    }
}
DI void dsa_select_query(const Params& p, int q, int lane, unsigned* hist) {
    const float* scores = (const float*)(wsb(p) + WS_SCORES); bf16* sel = (bf16*)(wsb(p) + WS_SEL);
    const int b = q >> 12, t = q & 4095, c = t >> 6, nreg = c + 1;
    bf16* so = sel + (size_t)q * 256;
    if (nreg <= 4) { for (int r = 0; r < nreg; ++r) so[64 * r + lane] = (bf16)(64 * r + lane); return; }
    const float* srow = scores + score_row_off(b, t);
    if (nreg <= 16) dsa_select_impl<16>(srow, nreg, so, lane, hist);
    else if (nreg <= 32) dsa_select_impl<32>(srow, nreg, so, lane, hist);
    else if (nreg <= 48) dsa_select_impl<48>(srow, nreg, so, lane, hist);
    else dsa_select_impl<64>(srow, nreg, so, lane, hist);
}
DI void it_dsa_index_select(const Params& p, int item, unsigned char* sm) {
    const int lane = opq_tid() & 63, wave = opq_tid() >> 6, fr = lane & 15, fq = lane >> 4;
    const bf16* proj = (const bf16*)(wsb(p) + WS_PROJ); float* scores = (float*)(wsb(p) + WS_SCORES);
    const int c = 63 - (item >> 4), b = (item >> 2) & 3, qg = item & 3;
    if (c >= 4) {
        const int t = 64 * c + 16 * qg + fr;
        const bf16* qrow = proj + ((size_t)b * 4096 + t) * NPROJ;
        bf16x8 qf[4][2];
#pragma unroll
        for (int hh = 0; hh < 4; ++hh)
#pragma unroll
            for (int ks = 0; ks < 2; ++ks) qf[hh][ks] = ld16(qrow + C_QI + 64 * hh + 32 * ks + 8 * fq);
        float w[4];
        { const u32x2 wv = *(const u32x2*)(qrow + C_WI); w[0] = bflo(wv.x) * 0.0625f; w[1] = bfhi(wv.x) * 0.0625f; w[2] = bflo(wv.y) * 0.0625f; w[3] = bfhi(wv.y) * 0.0625f; }
        float* srow = scores + score_row_off(b, t);
        const int ntile = 4 * (c + 1);
        const bf16* kbase = proj + ((size_t)b * 4096 + fr) * NPROJ + C_KI + 8 * fq;
        bf16x8 k0[4], k1[4];
#pragma unroll
        for (int u = 0; u < 4; ++u) { const bf16* krow = kbase + (size_t)16 * (wave + 4 * u) * NPROJ; k0[u] = ld16(krow); k1[u] = ld16(krow + 32); }
        for (int base = wave; base < ntile; base += 16) {
            bf16x8 n0[4], n1[4];
            const bool more = base + 16 < ntile;
            if (more) {
#pragma unroll
                for (int u = 0; u < 4; ++u) { const bf16* krow = kbase + (size_t)16 * (base + 16 + 4 * u) * NPROJ; n0[u] = ld16(krow); n1[u] = ld16(krow + 32); }
            }
#pragma unroll
            for (int u = 0; u < 4; ++u) {
                const int kt = base + 4 * u;
                if (kt >= ntile) break;
                f32x4 sc = {0, 0, 0, 0};
#pragma unroll
                for (int hh = 0; hh < 4; ++hh) {
                    f32x4 a = {0, 0, 0, 0};
                    a = MFMA16(k0[u], qf[hh][0], a); a = MFMA16(k1[u], qf[hh][1], a);
#pragma unroll
                    for (int i = 0; i < 4; ++i) sc[i] += w[hh] * fmaxf(a[i], 0.f);
                }
#pragma unroll
                for (int i = 0; i < 4; ++i) sc[i] += 0.f;
                *(f32x4*)(srow + 16 * kt + 4 * fq) = sc;
            }
            if (more) {
#pragma unroll
                for (int u = 0; u < 4; ++u) { k0[u] = n0[u]; k1[u] = n1[u]; }
            }
        }
    }
    hsync_g();
    for (int i = 0; i < 4; ++i) dsa_select_query(p, b * 4096 + 64 * c + 16 * qg + 4 * wave + i, lane, (unsigned*)sm + 1024 * wave);
}
DI void it_dsa_attn(const Params& p, int item, unsigned char* sm) {
    const int lane = opq_tid() & 63, wave = opq_tid() >> 6, fr = lane & 15, fq = lane >> 4;
    unsigned char* tile = sm + wave * 8192;
    bf16* selw = (bf16*)(sm + 32768 + wave * 512);
    const bf16* proj = (const bf16*)(wsb(p) + WS_PROJ); const bf16* kvn = (const bf16*)(wsb(p) + WS_KVN);
    const bf16* sel = (const bf16*)(wsb(p) + WS_SEL); bf16* mix = (bf16*)(wsb(p) + WS_MIX);
    unsigned wr_addr[8], rd_addr[2][4], tr_addr[8][2];
#pragma unroll
    for (int i = 0; i < 8; ++i) wr_addr[i] = off_b(4 * i + fq, fr);
#pragma unroll
    for (int rb = 0; rb < 2; ++rb)
#pragma unroll
        for (int s = 0; s < 4; ++s) rd_addr[rb][s] = off_b(8 * (fr >> 2) + 4 * rb + (fr & 3), 4 * s + fq);
    const unsigned tbase = (unsigned)(size_t)tile;
    {
        const unsigned q4 = fr >> 2, p4 = fr & 3;
#pragma unroll
        for (int c = 0; c < 8; ++c)
#pragma unroll
            for (int t = 0; t < 2; ++t) tr_addr[c][t] = tbase + off_b(8 * fq + 4 * t + q4, 2 * c + (p4 >> 1)) + 8 * (p4 & 1);
    }
    const float slope = fr < 8 ? exp2f(-(float)(fr + 1)) : 0.f;
    for (int qi = 0; qi < 4; ++qi) {
        const int q = item * 16 + wave * 4 + qi;
        const int b = q >> 12, t = q & 4095, c = t >> 6;
        const int nsel = (c + 1) * 64 < 256 ? (c + 1) * 64 : 256;
        const bf16* qa = proj + (size_t)q * NPROJ + C_QA;
        bf16x8 qf[4];
#pragma unroll
        for (int s = 0; s < 4; ++s) qf[s] = fr < 8 ? ld16(qa + fr * 128 + 32 * s + 8 * fq) : zero8();
        const bf16* selp = sel + (size_t)q * 256;
        const bf16* kvb = kvn + (size_t)b * 4096 * 128;
        if (4 * lane < nsel) *(u32x2*)(selw + 4 * lane) = *(const u32x2*)(selp + 4 * lane);
        float m_run = -INFINITY, l_run = 0.f;
        f32x4 o[8];
#pragma unroll
        for (int i = 0; i < 8; ++i) o[i] = (f32x4){0, 0, 0, 0};
        bf16x8 gk[8];
#pragma unroll
        for (int i = 0; i < 8; ++i) { const int key = selw[4 * i + fq]; gk[i] = ld16(kvb + (size_t)key * 128 + 8 * fr); }
        const int nt = nsel / 32;
        for (int ti = 0; ti < nt; ++ti) {
            const bf16x8 kp = ld16(selw + 32 * ti + 8 * fq);
#pragma unroll
            for (int i = 0; i < 8; ++i) *(bf16x8*)(tile + wr_addr[i]) = gk[i];
            if (ti + 1 < nt) {
#pragma unroll
                for (int i = 0; i < 8; ++i) { const int key = selw[32 * (ti + 1) + 4 * i + fq]; gk[i] = ld16(kvb + (size_t)key * 128 + 8 * fr); }
            }
            f32x4 lg[2] = {(f32x4){0, 0, 0, 0}, (f32x4){0, 0, 0, 0}};
#pragma unroll
            for (int rb = 0; rb < 2; ++rb)
#pragma unroll
                for (int s = 0; s < 4; ++s) lg[rb] = MFMA16(ld16(tile + rd_addr[rb][s]), qf[s], lg[rb]);
            float val[8]; float tmax = -INFINITY;
#pragma unroll
            for (int j = 0; j < 8; ++j) { const float dist = fabsf((float)(t - (int)(unsigned short)kp[j])); val[j] = lg[j >> 2][j & 3] - slope * dist; tmax = fmaxf(tmax, val[j]); }
            tmax = fmaxf(tmax, __shfl_xor(tmax, 16)); tmax = fmaxf(tmax, __shfl_xor(tmax, 32));
            const float m_new = fmaxf(m_run, tmax);
            const float scale = __expf(m_run - m_new);
            l_run *= scale;
#pragma unroll
            for (int i = 0; i < 8; ++i) o[i] *= scale;
            float pv[8];
#pragma unroll
            for (int j = 0; j < 8; ++j) { pv[j] = __expf(val[j] - m_new); l_run += pv[j]; }
            m_run = m_new;
            u32x4 pk; pk.x = cvt_pk_bf16(pv[0], pv[1]); pk.y = cvt_pk_bf16(pv[2], pv[3]); pk.z = cvt_pk_bf16(pv[4], pv[5]); pk.w = cvt_pk_bf16(pv[6], pv[7]);
            const bf16x8 pf = __builtin_bit_cast(bf16x8, pk);
            s16x4 tr[8][2];
            TR8(tr[0][0], tr[0][1], tr[1][0], tr[1][1], tr[2][0], tr[2][1], tr[3][0], tr[3][1], tr_addr[0][0], tr_addr[0][1], tr_addr[1][0], tr_addr[1][1], tr_addr[2][0], tr_addr[2][1], tr_addr[3][0], tr_addr[3][1]);
            TR8(tr[4][0], tr[4][1], tr[5][0], tr[5][1], tr[6][0], tr[6][1], tr[7][0], tr[7][1], tr_addr[4][0], tr_addr[4][1], tr_addr[5][0], tr_addr[5][1], tr_addr[6][0], tr_addr[6][1], tr_addr[7][0], tr_addr[7][1]);
#pragma unroll
            for (int cc = 0; cc < 8; ++cc) {
                bf16x8 kf; kf[0] = tr[cc][0][0]; kf[1] = tr[cc][0][1]; kf[2] = tr[cc][0][2]; kf[3] = tr[cc][0][3]; kf[4] = tr[cc][1][0]; kf[5] = tr[cc][1][1]; kf[6] = tr[cc][1][2]; kf[7] = tr[cc][1][3];
                o[cc] = MFMA16(kf, pf, o[cc]);
            }
        }
        float lt = l_run; lt += __shfl_xor(lt, 16); lt += __shfl_xor(lt, 32);
        const float inv = 1.f / lt;
        if (fr < 8) {
#pragma unroll
            for (int cc = 0; cc < 8; ++cc) { u32x2 ov; ov.x = cvt_pk_bf16(o[cc][0] * inv, o[cc][1] * inv); ov.y = cvt_pk_bf16(o[cc][2] * inv, o[cc][3] * inv);
                *(u32x2*)(mix + (size_t)q * KMIX + 512 + fr * 128 + 16 * cc + 4 * fq) = ov; }
        }
    }
}
typedef float f2 __attribute__((ext_vector_type(2)));
#ifndef PEER_FP8_MASK
#define PEER_FP8_MASK 3
#endif
constexpr float U_SCALE = 64.f, V_SCALE = 8.f;
DI unsigned pack4_fp8(float a, float b, float c, float d) { int p = __builtin_amdgcn_cvt_pk_fp8_f32(a, b, 0, false); p = __builtin_amdgcn_cvt_pk_fp8_f32(c, d, p, true); return (unsigned)p; }
DI void conv_chunk_fp8(const float* __restrict__ src, unsigned char* __restrict__ dst, size_t i0, int n16, float sc) {
    for (int i = opq_tid(); i < n16; i += 256) {
        const float4* s4 = (const float4*)src + 4 * (i0 + i);
        const float4 a = s4[0], b = s4[1], c = s4[2], d = s4[3];
        u32x4 o; o.x = pack4_fp8(a.x * sc, a.y * sc, a.z * sc, a.w * sc); o.y = pack4_fp8(b.x * sc, b.y * sc, b.z * sc, b.w * sc);
        o.z = pack4_fp8(c.x * sc, c.y * sc, c.z * sc, c.w * sc); o.w = pack4_fp8(d.x * sc, d.y * sc, d.z * sc, d.w * sc);
        ((u32x4*)dst)[i0 + i] = o;
    }
}
struct PeerLds2 {
    float trans[4][1024];
    unsigned char li[4][2][64][16];
    unsigned short pe[4][8][128];
    float pg[4][8][128];
};
template <int OFF, int NK>
DI void sort16_desc(unsigned (&k)[NK]) {
#pragma unroll
    for (int size = 2; size <= 16; size <<= 1)
#pragma unroll
        for (int stride = size >> 1; stride > 0; stride >>= 1)
#pragma unroll
            for (int i = 0; i < 16; ++i) {
                const int j = i ^ stride;
                if (j > i) {
                    const bool desc = ((i & size) == 0);
                    const unsigned a = k[OFF + i], b = k[OFF + j];
                    const unsigned hi = a > b ? a : b, lo = a > b ? b : a;
                    k[OFF + i] = desc ? hi : lo; k[OFF + j] = desc ? lo : hi;
                }
            }
}
template <int OA, int OB, int NK>
DI void merge_top16(unsigned (&k)[NK]) {
#pragma unroll
    for (int i = 0; i < 16; ++i) { const unsigned a = k[OA + i], b = k[OB + 15 - i]; k[OA + i] = a > b ? a : b; }
#pragma unroll
    for (int stride = 8; stride > 0; stride >>= 1)
#pragma unroll
        for (int i = 0; i < 16; ++i) {
            const int j = i ^ stride;
            if (j > i) { const unsigned a = k[OA + i], b = k[OA + j]; k[OA + i] = a > b ? a : b; k[OA + j] = a > b ? b : a; }
        }
}
DI void peer_retrieve(const Params& p, int l, int tok0, PeerLds2& S, int lane, int wave) {
    const int fr = lane & 15, fq = lane >> 4;
    const bf16* QP = (const bf16*)(wsb(p) + WS_PROJ);
    const bf16* PK = (const bf16*)(wsb(p) + WS_PK) + (size_t)l * 2 * 128 * 64;
    float* trans = S.trans[wave];
    unsigned K1[16], K2[16];
#pragma unroll
    for (int L = 0; L < 2; ++L) {
        f32x4 acc[4][8];
#pragma unroll
        for (int ct = 0; ct < 4; ++ct)
#pragma unroll
            for (int kt = 0; kt < 8; ++kt) acc[ct][kt] = (f32x4){0, 0, 0, 0};
#pragma unroll
        for (int kt = 0; kt < 8; ++kt) {
            const bf16* krow = PK + (size_t)L * 8192 + (size_t)(16 * kt + fr) * 64 + 8 * fq;
            const bf16x8 a0 = ld16(krow), a1 = ld16(krow + 32);
#pragma unroll
            for (int ct = 0; ct < 4; ++ct) {
                const bf16* qrow = QP + (size_t)(tok0 + 2 * ct + (fr >> 3)) * 1024 + 128 * (fr & 7) + 64 * L + 8 * fq;
                acc[ct][kt] = MFMA16(a0, ld16(qrow), acc[ct][kt]); acc[ct][kt] = MFMA16(a1, ld16(qrow + 32), acc[ct][kt]);
            }
        }
        unsigned k[128];
#define PEER_ROUND(kt)                                                                                                                            \
        {                                                                                                                                         \
            _Pragma("unroll") for (int ct = 0; ct < 4; ++ct) *(f32x4*)(trans + ((ct * 4 + fq) * 16 + fr) * 4) = acc[ct][kt];                       \
            _Pragma("unroll") for (int sq = 0; sq < 4; ++sq) {                                                                                     \
                const f32x4 v = *(const f32x4*)(trans + ((fq * 4 + sq) * 16 + fr) * 4);                                                            \
                _Pragma("unroll") for (int i = 0; i < 4; ++i) k[16 * (kt) + sq * 4 + i] = (fkey(v[i]) & ~0x7fu) | (unsigned)(16 * (kt) + 4 * sq + i); \
            }                                                                                                                                     \
            sort16_desc<16 * (kt)>(k);                                                                                                            \
        }
        PEER_ROUND(0) PEER_ROUND(1) merge_top16<0, 16>(k);
        PEER_ROUND(2) PEER_ROUND(3) merge_top16<32, 48>(k); merge_top16<0, 32>(k);
        PEER_ROUND(4) PEER_ROUND(5) merge_top16<64, 80>(k);
        PEER_ROUND(6) PEER_ROUND(7) merge_top16<96, 112>(k); merge_top16<64, 96>(k);
        merge_top16<0, 64>(k);
#undef PEER_ROUND
        u32x4 ib;
        ib.x = (k[0] & 127u) | ((k[1] & 127u) << 8) | ((k[2] & 127u) << 16) | ((k[3] & 127u) << 24);
        ib.y = (k[4] & 127u) | ((k[5] & 127u) << 8) | ((k[6] & 127u) << 16) | ((k[7] & 127u) << 24);
        ib.z = (k[8] & 127u) | ((k[9] & 127u) << 8) | ((k[10] & 127u) << 16) | ((k[11] & 127u) << 24);
        ib.w = (k[12] & 127u) | ((k[13] & 127u) << 8) | ((k[14] & 127u) << 16) | ((k[15] & 127u) << 24);
        *(u32x4*)(S.li[wave][L][lane]) = ib;
#pragma unroll
        for (int i = 0; i < 16; ++i) { if (L == 0) K1[i] = k[i]; else K2[i] = k[i]; }
    }
    float v1[16], v2[16];
#pragma unroll
    for (int i = 0; i < 16; ++i) { v1[i] = __uint_as_float(unkey(K1[i] & ~0x7fu)); v2[i] = __uint_as_float(unkey(K2[i] & ~0x7fu)); }
    unsigned c[64];
    {
        int idx = 0;
#pragma unroll
        for (int a = 0; a < 16; ++a)
#pragma unroll
            for (int b = 0; b < 16; ++b)
                if ((a + 1) * (b + 1) <= 16) { c[idx] = (fkey(v1[a] + v2[b]) & ~0xffu) | (unsigned)(a * 16 + b); ++idx; }
#pragma unroll
        for (int i = 50; i < 64; ++i) c[i] = 0u;
    }
    sort16_desc<0>(c); sort16_desc<16>(c); sort16_desc<32>(c); sort16_desc<48>(c);
    merge_top16<0, 16>(c); merge_top16<32, 48>(c); merge_top16<0, 32>(c);
    float sc[16]; float sum = 0.f;
    {
        const float m = __uint_as_float(unkey(c[0] & ~0xffu));
#pragma unroll
        for (int i = 0; i < 16; ++i) { sc[i] = __expf(__uint_as_float(unkey(c[i] & ~0xffu)) - m); sum += sc[i]; }
    }
    const float inv = 1.f / sum;
    const int tt = 2 * fq + (fr >> 3), head = fr & 7;
    const unsigned char* l1 = S.li[wave][0][lane]; const unsigned char* l2 = S.li[wave][1][lane];
#pragma unroll
    for (int i = 0; i < 16; ++i) {
        const unsigned ab = c[i] & 0xffu;
        const unsigned e = (unsigned)l1[ab >> 4] * 128u + (unsigned)l2[ab & 15u];
        S.pe[wave][tt][head * 16 + i] = (unsigned short)e; S.pg[wave][tt][head * 16 + i] = sc[i] * inv;
    }
}
template <bool FP8>
DI void peer_experts(const Params& p, int l, int tok, int tt, PeerLds2& S, int lane, int wave) {
    const bf16* H = (const bf16*)(wsb(p) + WS_H);
    const unsigned char* UB = wsb(p) + WS_UB; const unsigned char* VB = wsb(p) + WS_VB;
    const float* X = (const float*)(wsb(p) + WS_X);
    const float* modl = (const float*)(wsb(p) + WS_MOD) + (size_t)l * 4 * 6144;
    const int b = tok >> 12;
    const unsigned short* pe = S.pe[wave][tt]; const float* pg = S.pg[wave][tt];
    f2 hp[8];
    u32x4 h0, h1;
    {
        h0 = *(const u32x4*)(H + (size_t)tok * 1024 + 16 * lane); h1 = *(const u32x4*)(H + (size_t)tok * 1024 + 16 * lane + 8);
        hp[0] = (f2){bflo(h0.x), bfhi(h0.x)}; hp[1] = (f2){bflo(h0.y), bfhi(h0.y)}; hp[2] = (f2){bflo(h0.z), bfhi(h0.z)}; hp[3] = (f2){bflo(h0.w), bfhi(h0.w)};
        hp[4] = (f2){bflo(h1.x), bfhi(h1.x)}; hp[5] = (f2){bflo(h1.y), bfhi(h1.y)}; hp[6] = (f2){bflo(h1.z), bfhi(h1.z)}; hp[7] = (f2){bflo(h1.w), bfhi(h1.w)};
    }
    f2 acc[8];
#pragma unroll
    for (int i = 0; i < 8; ++i) acc[i] = (f2){0.f, 0.f};
    const bool b5 = (lane & 32) != 0, b4_ = (lane & 16) != 0, b3 = (lane & 8) != 0;
    const int eidx = (b3 ? 4 : 0) + (b4_ ? 2 : 0) + (b5 ? 1 : 0);
    if constexpr (FP8) {
    for (int e0 = 0; e0 < 128; e0 += 8) {
        u32x4 ur[8], vr[8];
#pragma unroll
        for (int j = 0; j < 8; ++j) {
            const int e = __builtin_amdgcn_readfirstlane((int)pe[e0 + j]);
            ur[j] = *(const u32x4*)(UB + (size_t)e * 1024 + 16 * lane);
            vr[j] = *(const u32x4*)(VB + (size_t)e * 1024 + 16 * lane);
        }
        float d[8];
#pragma unroll
        for (int j = 0; j < 8; ++j) {
            f2 s2 = {0.f, 0.f};
#pragma unroll
            for (int k = 0; k < 4; ++k) {
                const f2 lo = __builtin_amdgcn_cvt_pk_f32_fp8((int)ur[j][k], false), hi = __builtin_amdgcn_cvt_pk_f32_fp8((int)ur[j][k], true);
                s2 = lo * hp[2 * k] + s2; s2 = hi * hp[2 * k + 1] + s2;
            }
            d[j] = s2.x + s2.y;
        }
        float w[4], x2[2], y;
#pragma unroll
        for (int i = 0; i < 4; ++i) { const float keep = b5 ? d[2 * i + 1] : d[2 * i], send = b5 ? d[2 * i] : d[2 * i + 1]; w[i] = keep + __shfl_xor(send, 32); }
#pragma unroll
        for (int i = 0; i < 2; ++i) { const float keep = b4_ ? w[2 * i + 1] : w[2 * i], send = b4_ ? w[2 * i] : w[2 * i + 1]; x2[i] = keep + __shfl_xor(send, 16); }
        { const float keep = b3 ? x2[1] : x2[0], send = b3 ? x2[0] : x2[1]; y = keep + __shfl_xor(send, 8); }
        y += __shfl_xor(y, 4); y += __shfl_xor(y, 2); y += __shfl_xor(y, 1);
        const float sc = gelu_tanh(y * (1.f / U_SCALE)) * pg[e0 + eidx] * (1.f / V_SCALE);
#pragma unroll
        for (int j = 0; j < 8; ++j) {
            const float sj = __uint_as_float((unsigned)__builtin_amdgcn_readlane((int)__float_as_uint(sc), 32 * (j & 1) + 16 * ((j >> 1) & 1) + 8 * ((j >> 2) & 1)));
            const f2 sj2 = {sj, sj};
#pragma unroll
            for (int k = 0; k < 4; ++k) {
                const f2 lo = __builtin_amdgcn_cvt_pk_f32_fp8((int)vr[j][k], false), hi = __builtin_amdgcn_cvt_pk_f32_fp8((int)vr[j][k], true);
                acc[2 * k] = lo * sj2 + acc[2 * k]; acc[2 * k + 1] = hi * sj2 + acc[2 * k + 1];
            }
        }
    }
    } else {
    for (int e0 = 0; e0 < 128; e0 += 4) {
        const bf16* UBb = (const bf16*)UB; const bf16* VBb = (const bf16*)VB;
        u32x4 ur[4][2], vr[4][2];
#pragma unroll
        for (int j = 0; j < 4; ++j) {
            const int e = __builtin_amdgcn_readfirstlane((int)pe[e0 + j]);
            ur[j][0] = *(const u32x4*)(UBb + (size_t)e * 1024 + 16 * lane); ur[j][1] = *(const u32x4*)(UBb + (size_t)e * 1024 + 16 * lane + 8);
            vr[j][0] = *(const u32x4*)(VBb + (size_t)e * 1024 + 16 * lane); vr[j][1] = *(const u32x4*)(VBb + (size_t)e * 1024 + 16 * lane + 8);
        }
        float d[4];
#pragma unroll
        for (int j = 0; j < 4; ++j) {
            float sa = 0.f, sb = 0.f;
            sa = dot2bf(ur[j][0].x, h0.x, sa); sb = dot2bf(ur[j][0].y, h0.y, sb); sa = dot2bf(ur[j][0].z, h0.z, sa); sb = dot2bf(ur[j][0].w, h0.w, sb);
            sa = dot2bf(ur[j][1].x, h1.x, sa); sb = dot2bf(ur[j][1].y, h1.y, sb); sa = dot2bf(ur[j][1].z, h1.z, sa); sb = dot2bf(ur[j][1].w, h1.w, sb);
            d[j] = sa + sb;
        }
        float w[2], y;
#pragma unroll
        for (int i = 0; i < 2; ++i) { const float keep = b5 ? d[2 * i + 1] : d[2 * i], send = b5 ? d[2 * i] : d[2 * i + 1]; w[i] = keep + __shfl_xor(send, 32); }
        { const float keep = b4_ ? w[1] : w[0], send = b4_ ? w[0] : w[1]; y = keep + __shfl_xor(send, 16); }
        y += __shfl_xor(y, 8); y += __shfl_xor(y, 4); y += __shfl_xor(y, 2); y += __shfl_xor(y, 1);
        const float sc = gelu_tanh(y) * pg[e0 + (b4_ ? 2 : 0) + (b5 ? 1 : 0)];
#pragma unroll
        for (int j = 0; j < 4; ++j) {
            const float sj = __uint_as_float((unsigned)__builtin_amdgcn_readlane((int)__float_as_uint(sc), 32 * (j & 1) + 16 * ((j >> 1) & 1)));
            const f2 sj2 = {sj, sj};
#pragma unroll
            for (int hh = 0; hh < 2; ++hh)
#pragma unroll
                for (int k = 0; k < 4; ++k) { const unsigned dw = vr[j][hh][k]; const f2 vv = {bflo(dw), bfhi(dw)}; acc[4 * hh + k] = vv * sj2 + acc[4 * hh + k]; }
        }
    }
    }
    float xr[16];
    const float* xrow = X + (size_t)tok * 1024 + 16 * lane;
    float* xorow = p.out + (size_t)tok * 1024 + 16 * lane;
    const float* g2 = modl + (size_t)b * 6144 + 5 * 1024 + 16 * lane;
    float ss = 0;
#pragma unroll
    for (int q4 = 0; q4 < 4; ++q4) {
        const float4 xv = *(const float4*)(xrow + 4 * q4), gv = *(const float4*)(g2 + 4 * q4);
        float4 o; o.x = xv.x + gv.x * acc[2 * q4].x; o.y = xv.y + gv.y * acc[2 * q4].y; o.z = xv.z + gv.z * acc[2 * q4 + 1].x; o.w = xv.w + gv.w * acc[2 * q4 + 1].y;
        if (l == 0) *(float4*)(xorow + 4 * q4) = o;
        xr[4 * q4] = o.x; xr[4 * q4 + 1] = o.y; xr[4 * q4 + 2] = o.z; xr[4 * q4 + 3] = o.w;
        ss += o.x * o.x + o.y * o.y + o.z * o.z + o.w * o.w;
    }
    ss = wave_sum(ss);
    const float r = rsqrtf(ss * (1.f / 1024.f) + 1e-6f);
    if (l == 1) {
#pragma unroll
        for (int q4 = 0; q4 < 4; ++q4) {
            const float4 gv = *(const float4*)(p.in[28] + 16 * lane + 4 * q4);
            float4 o; o.x = xr[4 * q4] * r * gv.x; o.y = xr[4 * q4 + 1] * r * gv.y; o.z = xr[4 * q4 + 2] * r * gv.z; o.w = xr[4 * q4 + 3] * r * gv.w;
            *(float4*)(xorow + 4 * q4) = o;
        }
    } else {
        const float* g = p.in[2] + 1024 + 16 * lane; const float* mod1 = (const float*)(wsb(p) + WS_MOD) + ((size_t)4 + b) * 6144 + 16 * lane;
        bf16* hrow = (bf16*)(wsb(p) + WS_H2) + (size_t)tok * 1024 + 16 * lane;
        float hv[16];
#pragma unroll
        for (int q4 = 0; q4 < 4; ++q4) {
            const float4 gg = *(const float4*)(g + 4 * q4), s1 = *(const float4*)(mod1 + 1024 + 4 * q4), s0 = *(const float4*)(mod1 + 4 * q4);
            hv[4 * q4] = xr[4 * q4] * r * gg.x * (1.f + s1.x) + s0.x; hv[4 * q4 + 1] = xr[4 * q4 + 1] * r * gg.y * (1.f + s1.y) + s0.y;
            hv[4 * q4 + 2] = xr[4 * q4 + 2] * r * gg.z * (1.f + s1.z) + s0.z; hv[4 * q4 + 3] = xr[4 * q4 + 3] * r * gg.w * (1.f + s1.w) + s0.w;
        }
        u32x4 o0, o1;
        o0.x = cvt_pk_bf16(hv[0], hv[1]); o0.y = cvt_pk_bf16(hv[2], hv[3]); o0.z = cvt_pk_bf16(hv[4], hv[5]); o0.w = cvt_pk_bf16(hv[6], hv[7]);
        o1.x = cvt_pk_bf16(hv[8], hv[9]); o1.y = cvt_pk_bf16(hv[10], hv[11]); o1.z = cvt_pk_bf16(hv[12], hv[13]); o1.w = cvt_pk_bf16(hv[14], hv[15]);
        *(u32x4*)(hrow) = o0; *(u32x4*)(hrow + 8) = o1;
    }
}

constexpr int SMEM_BYTES = LDS_BYTES;
#ifndef REP_ID
#define REP_ID -1
#endif
#ifndef REP_N
#define REP_N 1
#endif
#define NREP(id) ((id) == REP_ID ? REP_N : 1)
__global__ void __launch_bounds__(512, 2) fwd_megakernel(Params p) {
    unsigned char* smem = g_lds;
    const int tid = threadIdx.x, half = __builtin_amdgcn_readfirstlane(tid >> 8);
    const int Gp = gridDim.x, bidp = blockIdx.x;
    const int G = Gp * 2, bid = bidp * 2 + half;
    unsigned char* sm = smem + half * 65536;
    volatile int* qslot = (volatile int*)(smem + LDS_CTL + 16) + half;
    if (tid < 64) ((unsigned*)(smem + LDS_CTL))[tid] = 0u;
    __syncthreads();
    unsigned* ctl = (unsigned*)(wsb(p) + WS_CTL);
    unsigned* qctr = ctl + 4096;
    XcdBarrier bar = xcd_barrier_post(ctl, (volatile LAS unsigned*)(smem + LDS_CTL));
#define PHASE_PTRS unsigned char* ws = wsb(p); const bf16* H = (const bf16*)(ws + WS_H); bf16* PROJ = (bf16*)(ws + WS_PROJ); float* X = (float*)(ws + WS_X); const float* mod = (const float*)(ws + WS_MOD); (void)H; (void)PROJ; (void)X; (void)mod;
    int qn = 0;

    for (int rep = 0; rep < NREP(0); ++rep) {
            PHASE_PTRS
        constexpr int N_MOD = 192, N_LAYER = 768 + 1024 + 512 + 512 + 1024 + 1024 + 64, N_PK = 4, N_GW = 128, N_PW = 8;
        constexpr int NV = N_MOD + 2 * N_LAYER + N_PK + N_GW + N_PW;
        for (int vb = bid; vb < NV; vb += G) {
            int v = vb;
            if (v < N_MOD) { it_mod(p, v, sm); continue; }
            v -= N_MOD;
            if (v < 2 * N_LAYER) {
                const int l = v / N_LAYER; v -= l * N_LAYER;
                bf16* wtin = (bf16*)(ws + WS_WTIN) + (size_t)l * NPROJ * 1024;
                const float* win = p.in[6] + (size_t)l * 1024 * 1732;
                bf16* wtout = (bf16*)(ws + WS_WTOUT) + (size_t)l * 1024 * KMIX;
                const float* wout = p.in[22] + (size_t)l * 1024 * 1024;
                if (v < 768) { it_transpose(TrArgs{win, 1732, 0, 1732, wtin, 1024, 0, 1024, 768, 0, nullptr}, v, sm); }
                else if ((v -= 768) < 1024) { it_transpose(TrArgs{win, 1732, 0, 1732, wtin + (size_t)768 * 1024, 1024, 0, 1024, 1024, 1, p.in[20] + (size_t)l * 8 * 64 * 128}, v, sm); }
                else if ((v -= 1024) < 512) { it_transpose(TrArgs{win, 1732, 1280, 1732, wtin + (size_t)1792 * 1024, 1024, 0, 1024, 512, 0, nullptr}, v, sm); }
                else if ((v -= 512) < 512) { it_transpose(TrArgs{wout, 1024, 0, 1024, wtout, KMIX, 0, 512, 1024, 0, nullptr}, v, sm); }
                else if ((v -= 512) < 1024) { it_transpose(TrArgs{wout, 1024, 0, 1024, wtout, KMIX, 512, 1024, 1024, 2, p.in[21] + (size_t)l * 8 * 128 * 64}, v, sm); }
                else if ((v -= 1024) < 1024) { it_transpose(TrArgs{p.in[23] + (size_t)l * 1024 * 1024, 1024, 0, 1024, (bf16*)(ws + WS_WTQ) + (size_t)l * 1024 * 1024, 1024, 0, 1024, 1024, 0, nullptr}, v, sm); }
                else { v -= 1024; it_transpose(TrArgs{p.in[15] + (size_t)l * 256 * 256, 256, 0, 256, (bf16*)(ws + WS_WTGLU) + (size_t)l * 256 * 256, 256, 0, 256, 256, 0, nullptr}, v, sm); }
                continue;
            }
            v -= 2 * N_LAYER;
            if (v < N_PK) { const int l = v >> 1, w = v & 1; conv_chunk(p.in[24 + w] + (size_t)l * 8192, (bf16*)(ws + WS_PK) + (size_t)l * 16384 + w * 8192, 0, 1024); continue; }
            v -= N_PK;
            if (v < N_GW) { it_gw(p, v); continue; }
            v -= N_GW;
            it_ssm_pw(p, v);
        }
        xcd_barrier(bar);
    }
    for (int rep = 0; rep < NREP(1); ++rep) {
            PHASE_PTRS
        constexpr int N_NORM = NTOK / 4, N_TAB = 4096, N_KT = 256;
        for (int vb = bid; vb < N_NORM + N_TAB + N_KT; vb += G) {
            if (vb < N_KT) { it_ssm_kt(p, vb, sm); continue; }
            if (vb - N_KT < N_NORM) {
                const int t_ = opq_tid(); const int row = (vb - N_KT) * 4 + (t_ >> 6);
                const float* m0 = (const float*)(wsb(p) + WS_MOD) + (size_t)(row >> 12) * 6144;
                norm_mod_row(p.in[0] + (size_t)row * 1024, p.in[2], m0, m0 + 1024, (bf16*)(wsb(p) + WS_H) + (size_t)row * 1024, t_ & 63);
            } else {
                const size_t base = (size_t)(vb - N_KT - N_NORM) * 2048;
                for (int e = 0; e < 8; ++e) ssm_tab_entry(p, base + e * 256 + opq_tid());
            }
        }
        xcd_barrier(bar);
    }

    for (int l = 0; l < 2; ++l) {
        const float* xin = l == 0 ? p.in[0] : p.out;
        for (int rep = 0; rep < NREP(2 + 8 * l); ++rep) {
            PHASE_PTRS
            const bf16* Hin = l == 0 ? H : (const bf16*)(ws + WS_H2);
            pg8::StaticOrder S; S.init(NTOK, NPROJ, Gp, bidp);
            pg8::gemm_phase<Epi256<EpiBf16>, pg8::StaticOrder, false, true>((PG8_LAS unsigned char*)g_lds, pg8::Gemm{Hin, (const bf16*)(ws + WS_WTIN) + (size_t)l * NPROJ * 1024, NTOK, NPROJ, 1024}, S, Epi256<EpiBf16>{EpiBf16{PROJ, NPROJ}});
            xcd_barrier(bar);
        }
        for (int rep = 0; rep < NREP(3 + 8 * l); ++rep) {
            PHASE_PTRS
            unsigned* ctr = qctr + 64 * (qn++);
            for (;;) {
                const int it = q_next(ctr, qslot);
                if (it >= 2048) break;
                if (it < 1024) it_dsa_index_select(p, it, sm);
                else if (it < 1536) it_gmlp(p, l, it - 1024, sm);
                else if (it < 1792) it_ssm_a(p, l, it - 1536);
                else it_kvn(p, l, it - 1792);
            }
            xcd_barrier(bar);
        }
        for (int rep = 0; rep < NREP(4 + 8 * l); ++rep) {
            PHASE_PTRS
            unsigned* ctr = qctr + 64 * (qn++);
            for (;;) {
                const int it = q_next(ctr, qslot);
                if (it >= 256 + 1024 + 512) break;
                if (it < 256) it_ssm_c(p, l, it, sm);
                else if (it < 1280) it_dsa_attn(p, it - 256, sm);
                else {
                    const int v = it - 1280, w = v >> 8, ch = v & 255;
                    if (!(PEER_FP8_MASK & (1 << l))) conv_chunk(p.in[26 + w] + (size_t)l * NEXP * 1024, (bf16*)(ws + (w ? WS_VB : WS_UB)), (size_t)ch * 8192, 8192);
                    else conv_chunk_fp8(p.in[26 + w] + (size_t)l * NEXP * 1024, ws + (w ? WS_VB : WS_UB), (size_t)ch * 4096, 4096, w ? V_SCALE : U_SCALE);
                }
            }
            xcd_barrier(bar);
        }
        for (int rep = 0; rep < NREP(5 + 8 * l); ++rep) {
            PHASE_PTRS
            pg8::StaticOrder S; S.init(NTOK, 256, Gp, bidp);
            pg8::gemm_phase<Epi256<EpiGlu>, pg8::StaticOrder, false, true>((PG8_LAS unsigned char*)g_lds, pg8::Gemm{(const bf16*)(ws + WS_YG), (const bf16*)(ws + WS_WTGLU) + (size_t)l * 256 * 256, NTOK, 256, 256}, S, Epi256<EpiGlu>{EpiGlu{(const bf16*)(ws + WS_YG), p.in[16] + l * 256, (bf16*)(ws + WS_MIX)}});
            xcd_barrier(bar);
        }
        for (int rep = 0; rep < NREP(6 + 8 * l); ++rep) {
            PHASE_PTRS
            pg8::StaticOrder S; S.init(NTOK, 1024, Gp, bidp);
            pg8::gemm_phase<Epi256<EpiResid>, pg8::StaticOrder, false, true>((PG8_LAS unsigned char*)g_lds, pg8::Gemm{(const bf16*)(ws + WS_MIX), (const bf16*)(ws + WS_WTOUT) + (size_t)l * 1024 * KMIX, NTOK, 1024, KMIX}, S, Epi256<EpiResid>{EpiResid{xin, X, mod + (size_t)l * 4 * 6144 + 2048}});
            xcd_barrier(bar);
        }
        for (int rep = 0; rep < NREP(7 + 8 * l); ++rep) {
            PHASE_PTRS
            for (int vb = bid; vb < NTOK / 4; vb += G) {
                const int t_ = opq_tid(); const int row = vb * 4 + (t_ >> 6);
                const float* m0 = (const float*)(wsb(p) + WS_MOD) + ((size_t)l * 4 + (row >> 12)) * 6144 + 3072;
                norm_mod_row((const float*)(wsb(p) + WS_X) + (size_t)row * 1024, p.in[3] + l * 1024, m0, m0 + 1024, (bf16*)(wsb(p) + WS_H) + (size_t)row * 1024, t_ & 63);
            }
            xcd_barrier(bar);
        }
        for (int rep = 0; rep < NREP(8 + 8 * l); ++rep) {
            PHASE_PTRS
            pg8::StaticOrder S; S.init(NTOK, 1024, Gp, bidp);
            pg8::gemm_phase<Epi256<EpiBf16>, pg8::StaticOrder, false, true>((PG8_LAS unsigned char*)g_lds, pg8::Gemm{H, (const bf16*)(ws + WS_WTQ) + (size_t)l * 1024 * 1024, NTOK, 1024, 1024}, S, Epi256<EpiBf16>{EpiBf16{PROJ, 1024}});
            xcd_barrier(bar);
        }
        for (int rep = 0; rep < NREP(9 + 8 * l); ++rep) {
            PHASE_PTRS
            PeerLds2& S = *(PeerLds2*)sm;
            hsync();
            const int t_ = opq_tid(), lane_ = t_ & 63, wave_ = t_ >> 6;
            for (int wb = bid * 4 + wave_; wb < NTOK / 8; wb += G * 4) {
                peer_retrieve(p, l, wb * 8, S, lane_, wave_);
                for (int tt = 0; tt < 8; ++tt) {
                    if (PEER_FP8_MASK & (1 << l)) peer_experts<true>(p, l, wb * 8 + tt, tt, S, lane_, wave_);
                    else peer_experts<false>(p, l, wb * 8 + tt, tt, S, lane_, wave_);
                }
            }
            if (l == 0 || rep + 1 < NREP(9 + 8 * l)) xcd_barrier(bar);
        }
    }
}

extern "C" void kernel_launch(void* const* d_in, const int* in_sizes, int n_in, void* d_out, int out_size, void* d_ws, size_t ws_size, hipStream_t stream) {
    if (n_in != 29 || ws_size < WS_END) { fprintf(stderr, "kernel_launch: bad args (n_in %d, ws %zu, need %zu)\n", n_in, ws_size, (size_t)WS_END); return; }
    static int grid = 0;
    if (grid == 0) {
        int dev = 0, cus = 0, per_cu = 0;
        if (hipGetDevice(&dev) != hipSuccess || hipDeviceGetAttribute(&cus, hipDeviceAttributeMultiprocessorCount, dev) != hipSuccess) { grid = -1; return; }
        if (hipFuncSetAttribute((const void*)fwd_megakernel, hipFuncAttributeMaxDynamicSharedMemorySize, LDS_BYTES) != hipSuccess) { fprintf(stderr, "kernel_launch: hipFuncSetAttribute failed\n"); grid = -1; return; }
        if (hipOccupancyMaxActiveBlocksPerMultiprocessor(&per_cu, (const void*)fwd_megakernel, 512, LDS_BYTES) != hipSuccess || per_cu < 1) { fprintf(stderr, "kernel_launch: occupancy query failed (%d)\n", per_cu); grid = -1; return; }
        grid = cus;
    }
    if (grid < 0) return;
    if (hipMemsetAsync((char*)d_ws + WS_CTL, 0, 65536, stream) != hipSuccess) { fprintf(stderr, "kernel_launch: memset failed\n"); return; }
    Params p{};
    for (int i = 0; i < 29; ++i) p.in[i] = (const float*)d_in[i];
    p.out = (float*)d_out; p.ws = (unsigned char*)d_ws;
    void* args[] = {&p};
    const hipError_t e = hipLaunchCooperativeKernel((const void*)fwd_megakernel, dim3(grid), dim3(512), args, LDS_BYTES, stream);
    if (e != hipSuccess) fprintf(stderr, "kernel_launch: cooperative launch failed: %s (grid %d)\n", hipGetErrorString(e), grid);
}
```

```cpp
#include <hip/hip_runtime.h>
#include <cstdint>
#include <cstdio>

typedef unsigned short bf16;
typedef short bf16x8 __attribute__((ext_vector_type(8)));
typedef short s16x4 __attribute__((ext_vector_type(4)));
typedef float f32x4 __attribute__((ext_vector_type(4)));
typedef unsigned u32x4 __attribute__((ext_vector_type(4)));
typedef unsigned u32x2 __attribute__((ext_vector_type(2)));
typedef __bf16 bf2 __attribute__((ext_vector_type(2)));
#define DI __device__ __forceinline__
#define MFMA16(a, b, c) __builtin_amdgcn_mfma_f32_16x16x32_bf16((a), (b), (c), 0, 0, 0)

constexpr int DM = 1024, NB = 4, SEQ = 4096, NTOK = NB * SEQ;
constexpr int NPROJ = 2304;
constexpr int C_UA = 0, C_UB = 256, C_VB = 512, C_QA = 768, C_CKV = 1792, C_QI = 1920, C_KI = 2176, C_WI = 2240;
constexpr int KMIX = 1536;
constexpr int NEXP = 16384;
constexpr size_t SCORES_PER_BATCH = (size_t)4096 * 2080;

constexpr size_t al256(size_t x) { return (x + 255) & ~(size_t)255; }
constexpr size_t WS_CTL = 0;
constexpr size_t WS_MOD = 65536;
constexpr size_t WS_WTIN = al256(WS_MOD + 2 * 4 * 6144 * 4);
constexpr size_t WS_WTOUT = al256(WS_WTIN + (size_t)2 * NPROJ * 1024 * 2);
constexpr size_t WS_WTQ = al256(WS_WTOUT + (size_t)2 * 1024 * KMIX * 2);
constexpr size_t WS_WTGLU = al256(WS_WTQ + (size_t)2 * 1024 * 1024 * 2);
constexpr size_t WS_GW = al256(WS_WTGLU + (size_t)2 * 256 * 256 * 2);
constexpr size_t WS_PK = al256(WS_GW + (size_t)2 * 4 * 128 * 128 * 2);
constexpr size_t WS_PW = al256(WS_PK + (size_t)2 * 2 * 128 * 64 * 2);
constexpr size_t WS_BB = al256(WS_PW + (size_t)2 * 16 * 65 * 64 * 2 * 4);
constexpr size_t WS_E = al256(WS_BB + (size_t)2 * 16 * 64 * 16 * 2 * 4);
constexpr size_t WS_G = al256(WS_E + (size_t)2 * 16 * 128 * 1024 * 2);
constexpr size_t WS_KT = al256(WS_G + (size_t)2 * 16 * 1024 * 128 * 2);
constexpr size_t WS_UB = al256(WS_KT + (size_t)2 * 16 * 64 * 256 * 2);
constexpr size_t WS_VB = al256(WS_UB + (size_t)NEXP * 1024 * 2);
constexpr size_t WS_H = al256(WS_VB + (size_t)NEXP * 1024 * 2);
constexpr size_t WS_PROJ = al256(WS_H + (size_t)NTOK * 1024 * 2);
constexpr size_t WS_SLOC = al256(WS_PROJ + (size_t)NTOK * NPROJ * 2);
constexpr size_t WS_YG = al256(WS_SLOC + (size_t)256 * 16 * 128 * 4);
constexpr size_t WS_KVN = al256(WS_YG + (size_t)NTOK * 256 * 2);
constexpr size_t WS_SEL = al256(WS_KVN + (size_t)NTOK * 128 * 2);
constexpr size_t WS_MIX = al256(WS_SEL + (size_t)NTOK * 256 * 2);
constexpr size_t WS_X = al256(WS_MIX + (size_t)NTOK * KMIX * 2);
constexpr size_t WS_SCORES = al256(WS_X + (size_t)NTOK * 1024 * 4);
constexpr size_t WS_H2 = al256(WS_SCORES + (size_t)NB * SCORES_PER_BATCH * 4);
constexpr size_t WS_END = al256(WS_H2 + (size_t)NTOK * 1024 * 2);

struct Params {
    const float* in[29];
    float* out;
    unsigned char* ws;
};

typedef __bf16 bf2v_t __attribute__((ext_vector_type(2)));
typedef float f2v_t __attribute__((ext_vector_type(2)));
DI unsigned cvt_pk_bf16(float lo, float hi) { const f2v_t f = {lo, hi}; const bf2v_t r = __builtin_convertvector(f, bf2v_t); return __builtin_bit_cast(unsigned, r); }
DI bf16 f2bf(float x) { return (bf16)(cvt_pk_bf16(x, 0.f) & 0xffffu); }
DI float bf2f(bf16 b) { return __uint_as_float((unsigned)b << 16); }
DI float bflo(unsigned u) { return __uint_as_float(u << 16); }
DI float bfhi(unsigned u) { return __uint_as_float(u & 0xffff0000u); }
DI float dot2bf(unsigned a, unsigned b, float c) { return __builtin_amdgcn_fdot2_f32_bf16(__builtin_bit_cast(bf2, a), __builtin_bit_cast(bf2, b), c, false); }
DI float gelu_tanh(float x) { const float u = 0.7978845608028654f * (x + 0.044715f * x * x * x); const float e = __expf(2.f * u); const float t = 1.f - 2.f / (e + 1.f); return 0.5f * x * (1.f + t); }
DI float sigmoidf(float x) { return 1.f / (1.f + __expf(-x)); }
DI float wave_sum(float v) { for (int o = 32; o > 0; o >>= 1) v += __shfl_xor(v, o); return v; }
DI unsigned wave_sum_u32(unsigned v) {
    int x = (int)v;
    x += __builtin_amdgcn_update_dpp(0, x, 0xB1, 0xf, 0xf, true);
    x += __builtin_amdgcn_update_dpp(0, x, 0x4E, 0xf, 0xf, true);
    x += __builtin_amdgcn_update_dpp(0, x, 0x141, 0xf, 0xf, true);
    x += __builtin_amdgcn_update_dpp(0, x, 0x140, 0xf, 0xf, true);
    x += __builtin_amdgcn_update_dpp(0, x, 0x142, 0xa, 0xf, true);
    x += __builtin_amdgcn_update_dpp(0, x, 0x143, 0xc, 0xf, true);
    return (unsigned)__builtin_amdgcn_readlane(x, 63);
}
DI unsigned wave_scan_incl_u32(unsigned v) {
    int x = (int)v;
    x += __builtin_amdgcn_update_dpp(0, x, 0x111, 0xf, 0xf, true);
    x += __builtin_amdgcn_update_dpp(0, x, 0x112, 0xf, 0xf, true);
    x += __builtin_amdgcn_update_dpp(0, x, 0x114, 0xf, 0xf, true);
    x += __builtin_amdgcn_update_dpp(0, x, 0x118, 0xf, 0xf, true);
    x += __builtin_amdgcn_update_dpp(0, x, 0x142, 0xa, 0xf, true);
    x += __builtin_amdgcn_update_dpp(0, x, 0x143, 0xc, 0xf, true);
    return (unsigned)x;
}
DI unsigned fkey(float v) { const unsigned u = __float_as_uint(v); return (u & 0x80000000u) ? ~u : (u | 0x80000000u); }
DI unsigned unkey(unsigned k) { return (k & 0x80000000u) ? (k & 0x7fffffffu) : ~k; }
DI bf16x8 ld16(const void* p) { return *(const bf16x8*)p; }
DI bf16x8 zero8() { bf16x8 z = {0, 0, 0, 0, 0, 0, 0, 0}; return z; }


#define XB_TMO      128
#define XB_XCNT(j)  (256  + 64 * (j))
#define XB_XSUB(j)  (1280 + 64 * (j))
#define XB_XGEN(j)  (2304 + 64 * (j))
#define XB_TOP      3328
#define XB_TOPGEN   3392
#define XCD_BAR_WORDS 3456
#define XB_SPIN_CAP (1u << 22)
#define LAS __attribute__((address_space(3)))
DI unsigned xb_ld(unsigned* p)              { return __hip_atomic_load(p, __ATOMIC_RELAXED, __HIP_MEMORY_SCOPE_AGENT); }
DI unsigned xb_add(unsigned* p, unsigned v) { return __hip_atomic_fetch_add(p, v, __ATOMIC_RELAXED, __HIP_MEMORY_SCOPE_AGENT); }
DI unsigned xb_xcc_id() { return (unsigned)__builtin_amdgcn_s_getreg((3 << 11) | 20) & 0xFu; }
#define XB_SPIN(cond, bar) do { unsigned _sp = 0; while (cond) { __builtin_amdgcn_s_sleep(1); \
    if ((++_sp & 255u) == 0u) { if (xb_ld(&(bar)[XB_TMO])) break; if (_sp > XB_SPIN_CAP) { atomicAdd(&(bar)[XB_TMO], 1u); break; } } } } while (0)
struct XcdBarrier { unsigned* bar; unsigned x; volatile LAS unsigned* st; };
DI XcdBarrier xcd_barrier_post(unsigned* bar, volatile LAS unsigned* st) {
    XcdBarrier b; b.bar = bar; b.x = xb_xcc_id(); b.st = st;
    if (threadIdx.x == 0) (void)xb_add(&bar[XB_XCNT(b.x)], 1u);
    return b;
}
DI void xcd_barrier_complete(unsigned* bar, unsigned x, unsigned& nloc, unsigned& nx) {
    const unsigned G = gridDim.x * gridDim.y * gridDim.z;
    unsigned sum, cnt, mine, sp = 0u;
    for (;;) {
        sum = 0u; cnt = 0u; mine = 0u;
#pragma unroll
        for (unsigned j = 0; j < 16; ++j) { const unsigned c = xb_ld(&bar[XB_XCNT(j)]); sum += c; cnt += (c > 0u) ? 1u : 0u; mine = (j == x) ? c : mine; }
        if (sum == G) break;
        __builtin_amdgcn_s_sleep(1);
        if ((++sp & 255u) == 0u) { if (xb_ld(&bar[XB_TMO])) break; if (sp > XB_SPIN_CAP) { atomicAdd(&bar[XB_TMO], 1u); break; } }
    }
    nloc = mine > 0u ? mine : 1u; nx = cnt > 0u ? cnt : 1u;
}
DI void xcd_barrier(const XcdBarrier& b) {
    asm volatile("s_waitcnt vmcnt(0)" ::: "memory");
    __syncthreads();
    if (threadIdx.x == 0) {
        unsigned* bar = b.bar;
        __builtin_amdgcn_s_waitcnt(0);
        unsigned nloc = b.st[0], nx = b.st[1];
        if (nloc == 0u) { xcd_barrier_complete(bar, b.x, nloc, nx); b.st[0] = nloc; b.st[1] = nx; }
        const unsigned old = xb_add(&bar[XB_XSUB(b.x)], 1u);
        const unsigned gen = old / nloc;
        if (old + 1u == (gen + 1u) * nloc) {
            __builtin_amdgcn_fence(__ATOMIC_RELEASE, "agent");
            asm volatile("s_waitcnt vmcnt(0)" ::: "memory");
            const unsigned og = xb_add(&bar[XB_TOP], 1u);
            const unsigned tg = og / nx;
            if (og + 1u == (tg + 1u) * nx) xb_add(&bar[XB_TOPGEN], 1u);
            else XB_SPIN(xb_ld(&bar[XB_TOPGEN]) == tg, bar);
            __builtin_amdgcn_fence(__ATOMIC_ACQUIRE, "agent");
            xb_add(&bar[XB_XGEN(b.x)], 1u);
            asm volatile("s_waitcnt vmcnt(0)" ::: "memory");
        } else {
            XB_SPIN(xb_ld(&bar[XB_XGEN(b.x)]) == gen, bar);
            __builtin_amdgcn_fence(__ATOMIC_ACQUIRE, "agent");
            asm volatile("s_waitcnt vmcnt(0)" ::: "memory");
        }
    }
    __syncthreads();
}
typedef __attribute__((address_space(1))) unsigned char g_uc;
DI unsigned char* wsb(const Params& p) {
    typedef const unsigned long long __attribute__((address_space(4))) karg_u64;
    const unsigned long long w = *(karg_u64*)((const char __attribute__((address_space(4)))*)__builtin_amdgcn_kernarg_segment_ptr() + __builtin_offsetof(Params, ws));
    unsigned lo = (unsigned)w, hi = (unsigned)(w >> 32);
    asm volatile("" : "+s"(lo), "+s"(hi));
    return (unsigned char*)(g_uc*)(((unsigned long long)hi << 32) | lo);
}
extern __shared__ __attribute__((aligned(1024))) unsigned char g_lds[];
constexpr int LDS_CTL = 131072, LDS_BYTES = 131072 + 256;
DI int opq_tid() { int t = (int)(threadIdx.x & 255u); asm volatile("" : "+v"(t)); return t; }
DI void hsync() {
    asm volatile("s_waitcnt lgkmcnt(0)" ::: "memory");
    LAS unsigned* ctr = (LAS unsigned*)(g_lds + LDS_CTL + 32) + (threadIdx.x >> 8);
    unsigned old = 0u;
    if ((threadIdx.x & 63u) == 0u) old = __hip_atomic_fetch_add(ctr, 1u, __ATOMIC_RELAXED, __HIP_MEMORY_SCOPE_WORKGROUP);
    old = (unsigned)__builtin_amdgcn_readfirstlane((int)old);
    const unsigned target = (old & ~3u) + 4u;
    while (__hip_atomic_load(ctr, __ATOMIC_RELAXED, __HIP_MEMORY_SCOPE_WORKGROUP) < target) __builtin_amdgcn_s_sleep(1);
    asm volatile("" ::: "memory");
}
DI void hsync_g() { asm volatile("s_waitcnt vmcnt(0)" ::: "memory"); hsync(); }
DI int q_next(unsigned* ctr, volatile int* slot) {
    hsync();
    if ((threadIdx.x & 255u) == 0u) *slot = (int)__hip_atomic_fetch_add(ctr, 1u, __ATOMIC_RELAXED, __HIP_MEMORY_SCOPE_AGENT);
    hsync();
    return *slot;
}
DI void it_mod(const Params& p, int vb, unsigned char* sm) {
    float (*ca)[1024] = (float (*)[1024])sm;
    float (*part)[4][64] = (float (*)[4][64])(sm + 16384);
    const float* c = p.in[1];
    const int tid = opq_tid();
    hsync();
    for (int i = tid; i < 4096; i += 256) { const float v = c[i]; ca[i >> 10][i & 1023] = v / (1.f + __expf(-v)); }
    hsync();
    const int col = tid & 63, sl = tid >> 6;
    const int idx = vb * 64 + col;
    const int l = idx / 6144, n = idx % 6144;
    const float* w = p.in[4] + (size_t)l * 1024 * 6144 + n + (size_t)(256 * sl) * 6144;
    float a0 = 0, a1 = 0, a2 = 0, a3 = 0;
#pragma unroll 8
    for (int k = 0; k < 256; ++k) { const float wv = w[(size_t)k * 6144]; const int kk = 256 * sl + k; a0 += ca[0][kk] * wv; a1 += ca[1][kk] * wv; a2 += ca[2][kk] * wv; a3 += ca[3][kk] * wv; }
    part[sl][0][col] = a0; part[sl][1][col] = a1; part[sl][2][col] = a2; part[sl][3][col] = a3;
    hsync();
    {
        const int bb = tid >> 6;
        const float v = part[0][bb][col] + part[1][bb][col] + part[2][bb][col] + part[3][bb][col] + p.in[5][l * 6144 + n];
        ((float*)(wsb(p) + WS_MOD))[((size_t)l * 4 + bb) * 6144 + n] = v;
    }
}

struct TrArgs { const float* src; int lds, coff, nvalid; bf16* dst; int ldd, doff; int K, N; int mode; const float* aux; };
DI void it_transpose(const TrArgs& a, int vb, unsigned char* sm) {
    float (*t)[33] = (float (*)[33])sm;
    float (*ta)[65] = (float (*)[65])(sm + 4352);
    float (*tb)[33] = (float (*)[33])(sm + 4352 + 8320);
    const int nk = a.K / 32;
    const int kt = vb % nk, nt = vb / nk;
    const int tid = opq_tid(), tx = tid & 31, ty = tid >> 5;
    hsync();
    if (a.mode == 0) {
        for (int r = ty; r < 32; r += 8) {
            const int k = kt * 32 + r, n = nt * 32 + tx;
            t[r][tx] = (n + a.coff < a.nvalid) ? a.src[(size_t)k * a.lds + n + a.coff] : 0.f;
        }
    } else if (a.mode == 1) {
        const int h = (nt * 32) >> 7, r0 = (nt * 32) & 127;
        for (int i = tid; i < 32 * 64; i += 256) { const int kk = i >> 6, d = i & 63; ta[kk][d] = a.src[(size_t)(kt * 32 + kk) * a.lds + 768 + 64 * h + d]; }
        for (int i = tid; i < 64 * 32; i += 256) { const int d = i >> 5, rr = i & 31; tb[d][rr] = a.aux[((size_t)h * 64 + d) * 128 + r0 + rr]; }
        hsync();
        for (int r = ty; r < 32; r += 8) { float s = 0; _Pragma("unroll 16") for (int d = 0; d < 64; ++d) s += ta[r][d] * tb[d][tx]; t[r][tx] = s * 0.125f; }
    } else {
        const int h = (kt * 32) >> 7, r0 = (kt * 32) & 127;
        for (int i = tid; i < 32 * 64; i += 256) { const int rr = i >> 6, d = i & 63; ta[rr][d] = a.aux[((size_t)h * 128 + r0 + rr) * 64 + d]; }
        for (int i = tid; i < 64 * 32; i += 256) { const int d = i >> 5, nn = i & 31; tb[d][nn] = a.src[(size_t)(512 + 64 * h + d) * a.lds + nt * 32 + nn]; }
        hsync();
        for (int r = ty; r < 32; r += 8) { float s = 0; _Pragma("unroll 16") for (int d = 0; d < 64; ++d) s += ta[r][d] * tb[d][tx]; t[r][tx] = s; }
    }
    hsync();
    for (int r = ty; r < 32; r += 8) {
        const int n = nt * 32 + r, k = kt * 32 + tx;
        a.dst[(size_t)n * a.ldd + a.doff + k] = f2bf(t[tx][r]);
    }
}
DI void conv_chunk(const float* __restrict__ src, bf16* __restrict__ dst, size_t i0, int n8) {
    for (int i = opq_tid(); i < n8; i += 256) {
        const float4 a = ((const float4*)src)[2 * (i0 + i)], b = ((const float4*)src)[2 * (i0 + i) + 1];
        u32x4 o; o.x = cvt_pk_bf16(a.x, a.y); o.y = cvt_pk_bf16(a.z, a.w); o.z = cvt_pk_bf16(b.x, b.y); o.w = cvt_pk_bf16(b.z, b.w);
        ((u32x4*)dst)[i0 + i] = o;
    }
}
DI void it_gw(const Params& p, int vb) {
    for (int e = 0; e < 4; ++e) {
        const int idx = vb * 1024 + e * 256 + opq_tid();
        const int s = idx & 127, t = (idx >> 7) & 127;
        const float v = (t >= 64 || s < 64) ? p.in[17][idx] : 0.f;
        ((bf16*)(wsb(p) + WS_GW))[idx] = f2bf(v);
    }
}
DI void it_ssm_pw(const Params& p, int vb) {
    const int idx = vb * 256 + opq_tid();
    const int pp = idx & 63, g = (idx >> 6) & 15, l = idx >> 10;
    const float lre = -__expf(p.in[7][idx]), lim = p.in[8][idx];
    const float dt = __expf(p.in[14][l * 16 + g]);
    float* pw = (float*)(wsb(p) + WS_PW) + ((size_t)(l * 16 + g) * 65) * 128;
    for (int d = 0; d <= 64; ++d) {
        const float mag = expf(lre * dt * (float)d); float sn, cs; sincosf(lim * dt * (float)d, &sn, &cs);
        pw[d * 128 + pp * 2] = mag * cs; pw[d * 128 + pp * 2 + 1] = mag * sn;
    }
    const float mag = expf(lre * dt); float sn, cs; sincosf(lim * dt, &sn, &cs);
    const float are = mag * cs, aim = mag * sn;
    const float den = lre * lre + lim * lim, P = are - 1.f, Q = aim;
    const float fre = (P * lre + Q * lim) / den, fim = (Q * lre - P * lim) / den;
    float* bb = (float*)(wsb(p) + WS_BB) + (size_t)idx * 32;
    for (int h = 0; h < 16; ++h) { const float br = p.in[9][(size_t)idx * 16 + h], bi = p.in[10][(size_t)idx * 16 + h]; bb[h * 2] = fre * br - fim * bi; bb[h * 2 + 1] = fre * bi + fim * br; }
}
DI void it_ssm_kt(const Params& p, int vb, unsigned char* sm) {
    float* cz = (float*)sm;
    float* bz = (float*)(sm + 8192);
    float* pz = (float*)(sm + 16384);
    const int tid = opq_tid();
    const int lg = vb >> 3, d0 = (vb & 7) * 8;
    const float* PW = (const float*)(wsb(p) + WS_PW) + ((size_t)lg * 65 + d0) * 128;
    const float* BB = (const float*)(wsb(p) + WS_BB) + (size_t)lg * 64 * 32;
    hsync();
    for (int i = tid; i < 1024; i += 256) { const int q = i >> 4, h = i & 15; cz[i * 2] = p.in[11][((size_t)lg * 16 + h) * 64 + q]; cz[i * 2 + 1] = p.in[12][((size_t)lg * 16 + h) * 64 + q]; }
    for (int i = tid; i < 2048; i += 256) bz[i] = BB[i];
    for (int i = tid; i < 1024; i += 256) pz[i] = PW[i];
    hsync();
    const int h = tid >> 4, hh = tid & 15;
    float acc[8];
#pragma unroll
    for (int d = 0; d < 8; ++d) acc[d] = 0.f;
    for (int q = 0; q < 64; ++q) {
        const float cr = cz[(q * 16 + h) * 2], ci = cz[(q * 16 + h) * 2 + 1], br = bz[(q * 16 + hh) * 2], bi = bz[(q * 16 + hh) * 2 + 1];
        const float xr = cr * br - ci * bi, xi = cr * bi + ci * br;
#pragma unroll
        for (int d = 0; d < 8; ++d) acc[d] += xr * pz[(d * 64 + q) * 2] - xi * pz[(d * 64 + q) * 2 + 1];
    }
    bf16* KT = (bf16*)(wsb(p) + WS_KT) + ((size_t)lg * 64 + d0) * 256;
    if (d0 == 0 && h == hh) acc[0] += p.in[13][(size_t)lg * 16 + h];
#pragma unroll
    for (int d = 0; d < 8; ++d) KT[d * 256 + tid] = f2bf(acc[d]);
    hsync();
}
DI void ssm_tab_entry(const Params& p, size_t idx) {
    const size_t NE = (size_t)2 * 16 * 128 * 1024;
    const float* PW = (const float*)(wsb(p) + WS_PW); const float* BB = (const float*)(wsb(p) + WS_BB);
    if (idx < NE) {
        const int kk = idx & 1023, pp = (idx >> 10) & 127; const int lg = (int)(idx >> 17);
        const int i = kk >> 4, hh = kk & 15, pq = pp & 63, part = pp >> 6;
        const float* pw = PW + ((size_t)lg * 65 + (63 - i)) * 128 + pq * 2; const float* bb = BB + ((size_t)lg * 64 + pq) * 32 + hh * 2;
        const float v = part ? (pw[0] * bb[1] + pw[1] * bb[0]) : (pw[0] * bb[0] - pw[1] * bb[1]);
        ((bf16*)(wsb(p) + WS_E))[idx] = f2bf(v);
    } else if (idx < 2 * NE) {
        const size_t e = idx - NE; const int pp = e & 127, jh = (e >> 7) & 1023; const int lg = (int)(e >> 17);
        const int j = jh >> 4, h = jh & 15, pq = pp & 63, part = pp >> 6;
        const float* pw = PW + ((size_t)lg * 65 + (j + 1)) * 128 + pq * 2;
        const float cr = p.in[11][((size_t)lg * 16 + h) * 64 + pq], ci = p.in[12][((size_t)lg * 16 + h) * 64 + pq];
        const float v = part ? -(cr * pw[1] + ci * pw[0]) : (cr * pw[0] - ci * pw[1]);
        ((bf16*)(wsb(p) + WS_G))[e] = f2bf(v);
    } else {
        const size_t e = idx - 2 * NE; if (e >= (size_t)2 * 16 * 64 * 256) return;
        const int hh = e & 15, h = (e >> 4) & 15, d = (e >> 8) & 63; const int lg = (int)(e >> 14);
        const float* pw = PW + ((size_t)lg * 65 + d) * 128; const float* bb = BB + (size_t)lg * 64 * 32 + hh * 2;
        const float* cr = p.in[11] + ((size_t)lg * 16 + h) * 64; const float* ci = p.in[12] + ((size_t)lg * 16 + h) * 64;
        float s = 0;
        for (int q = 0; q < 64; ++q) { const float zr = pw[q * 2] * bb[q * 32] - pw[q * 2 + 1] * bb[q * 32 + 1], zi = pw[q * 2] * bb[q * 32 + 1] + pw[q * 2 + 1] * bb[q * 32]; s += cr[q] * zr - ci[q] * zi; }
        ((bf16*)(wsb(p) + WS_KT))[e] = f2bf(s);
    }
}
DI void norm_mod_row(const float* __restrict__ xrow, const float* __restrict__ g, const float* __restrict__ sh, const float* __restrict__ sc, bf16* __restrict__ hrow, int lane) {
    float4 v[4]; float ss = 0;
#pragma unroll
    for (int j = 0; j < 4; ++j) { v[j] = *(const float4*)(xrow + 4 * lane + 256 * j); ss += v[j].x * v[j].x + v[j].y * v[j].y + v[j].z * v[j].z + v[j].w * v[j].w; }
    ss = wave_sum(ss);
    const float r = rsqrtf(ss * (1.f / 1024.f) + 1e-6f);
#pragma unroll
    for (int j = 0; j < 4; ++j) {
        const int c = 4 * lane + 256 * j;
        const float4 gg = *(const float4*)(g + c), s1 = *(const float4*)(sc + c), s0 = *(const float4*)(sh + c);
        u32x2 o; o.x = cvt_pk_bf16(v[j].x * r * gg.x * (1.f + s1.x) + s0.x, v[j].y * r * gg.y * (1.f + s1.y) + s0.y);
        o.y = cvt_pk_bf16(v[j].z * r * gg.z * (1.f + s1.z) + s0.z, v[j].w * r * gg.w * (1.f + s1.w) + s0.w);
        *(u32x2*)(hrow + c) = o;
    }
}
namespace pg8 {
#define PG8_LAS __attribute__((address_space(3)))
typedef unsigned short bf16_t;
constexpr int BM = 256, BK = 64, HALF = 128, HTB = HALF * BK * 2  , STAGE_BYTES = 8 * HTB, NXCD = 8, WGM = 8;
__host__ __device__ __forceinline__ int lds_byte(int r, int c) { const int st = (r >> 4) * 2 + (c >> 5), rr = r & 15, cc = c & 31, ob = rr * 64 + cc * 2; return st * 1024 + (ob ^ (((ob >> 9) & 1) << 5)); }
__host__ __device__ __forceinline__ void stage_rc(int b, int& R, int& C) { const int st = b / 1024, sb = b % 1024, swz = sb ^ (((sb >> 9) & 1) << 5); R = (st >> 1) * 16 + swz / 64; C = (st & 1) * 32 + (swz % 64) / 2; }
__host__ __device__ __forceinline__ int perm32(int rho) { const int n = rho >> 4, i = rho & 15; return 8 * (i >> 2) + 4 * n + (i & 3); }

struct Unit { int pm, pn; };
struct Gemm { const bf16_t* A; const bf16_t* Bt; int M, N, K; };

struct StaticOrder {
    int nM, nN, nwg, G, c;
    __host__ __device__ void init(int M, int N, int G_, int c_) { nM = M / BM; nN = N / BM; nwg = nM * nN; G = G_; c = c_; }
    __host__ __device__ bool next(int i, Unit& u) const {
        const long L = (long)i * G + c; if (L >= nwg) return false;
        int wgid = (int)L; { const int q = nwg / NXCD, r = nwg % NXCD, xcd = wgid % NXCD, off = wgid / NXCD; wgid = (xcd < r ? xcd * (q + 1) : r * (q + 1) + (xcd - r) * q) + off; }
        const int nig = WGM * nN, gid = wgid / nig, fm = gid * WGM, gsz = (nM - fm) < WGM ? (nM - fm) : WGM;
        u.pm = fm + ((wgid % nig) % gsz); u.pn = (wgid % nig) / gsz; return true;
    }
    __device__ __forceinline__ void a_ready(const Unit&) const {}
    __device__ __forceinline__ void done(const Unit&) const {}
};

template <class Epi, class Sched, bool ALIGN_EPI = false, bool SP2 = false>
__device__ __forceinline__ void gemm_phase(PG8_LAS unsigned char* lds, const Gemm g, const Sched& S, const Epi& E) {
    int tid = (int)threadIdx.x; asm volatile("" : "+v"(tid));
    const int wid = __builtin_amdgcn_readfirstlane(tid >> 6), lane = tid & 63, wr = wid >> 2, wc = wid & 3, fr = lane & 15, fq = lane >> 4;
    const int K = g.K, nt = K / BK;
    unsigned voffA[2], voffB[2];
#pragma unroll
    for (int i = 0; i < 2; ++i) { int R, C; stage_rc(tid * 16 + i * 8192, R, C); const int Rb = Epi::PERM ? ((R & ~31) + perm32(R & 31)) : R;
        voffA[i] = (unsigned)(R * K + C) * 2u; voffB[i] = (unsigned)(Rb * K + C) * 2u; }
    const size_t kstep = (size_t)(BK * 2);
    const size_t hstep = (size_t)HALF * K * 2;
    const size_t tstep = 2 * hstep;
    const unsigned ldsw = (unsigned)wid * 1024u;
    const int aoff = lds_byte(wr * 64 + fr, fq * 8), boff = lds_byte(wc * 32 + fr, fq * 8);
#define PG8_SA(b, h) (((b) * 2 + (h)) * HTB)
#define PG8_SB(b, h) ((4 + (b) * 2 + (h)) * HTB)
#define PG8_STAGE(bufoff, gbase, voff) do { _Pragma("unroll") for (int _i = 0; _i < 2; ++_i) \
        __builtin_amdgcn_global_load_lds((const unsigned*)((const char*)(gbase) + (voff)[_i]), (PG8_LAS unsigned*)(lds + (bufoff) + ldsw + _i * 8192), 16, 0, 0); } while (0)
#define PG8_LDA(dst, b, h) do { _Pragma("unroll") for (int m = 0; m < 4; ++m) _Pragma("unroll") for (int k = 0; k < 2; ++k) dst[m][k] = *(const PG8_LAS bf16x8*)(lds + PG8_SA(b, h) + aoff + m * 2048 + k * 1024); } while (0)
#define PG8_LDB(dst, b, h) do { _Pragma("unroll") for (int n = 0; n < 2; ++n) _Pragma("unroll") for (int k = 0; k < 2; ++k) dst[n][k] = *(const PG8_LAS bf16x8*)(lds + PG8_SB(b, h) + boff + n * 2048 + k * 1024); } while (0)
#define PG8_MMA(ai, bj, At, Bt) do { __builtin_amdgcn_s_setprio(1); _Pragma("unroll") for (int m = 0; m < 4; ++m) _Pragma("unroll") for (int n = 0; n < 2; ++n) _Pragma("unroll") for (int k = 0; k < 2; ++k) \
        acc[ai][bj][m][n] = __builtin_amdgcn_mfma_f32_16x16x32_bf16(Bt[n][k], At[m][k], acc[ai][bj][m][n], 0, 0, 0); __builtin_amdgcn_s_setprio(0); } while (0)
#define PG8_WAIT_V(n) asm volatile("s_waitcnt vmcnt(" #n ")" ::: "memory")
#define PG8_WAIT_L(n) asm volatile("s_waitcnt lgkmcnt(" #n ")" ::: "memory")
#define PG8_BAR __builtin_amdgcn_s_barrier()
#define PG8_SCHED __builtin_amdgcn_sched_barrier(0)
    Unit cur, nxt; int ui = 0;
    if (!S.next(0, cur)) return;
    f32x4 acc[2][2][4][2];
#pragma unroll
    for (int a = 0; a < 2; ++a)
#pragma unroll
        for (int b = 0; b < 2; ++b)
#pragma unroll
            for (int m = 0; m < 4; ++m)
#pragma unroll
                for (int n = 0; n < 2; ++n) acc[a][b][m][n] = (f32x4){0.f, 0.f, 0.f, 0.f};
    bf16x8 At[4][2], B0[2][2], B1[2][2];
    const char* cA = (const char*)g.A + (size_t)cur.pm * tstep; const char* cB = (const char*)g.Bt + (size_t)cur.pn * tstep;
    S.a_ready(cur);
    if constexpr (SP2) {
        PG8_STAGE(PG8_SB(0, 0), cB, voffB); PG8_STAGE(PG8_SB(0, 1), cB + hstep, voffB); PG8_STAGE(PG8_SA(0, 0), cA, voffA); PG8_STAGE(PG8_SA(0, 1), cA + hstep, voffA);
        if (wr == 1) PG8_BAR;
        PG8_WAIT_V(2); PG8_BAR;
        PG8_STAGE(PG8_SB(1, 0), cB + kstep, voffB); PG8_STAGE(PG8_SA(1, 0), cA + kstep, voffA); PG8_STAGE(PG8_SB(1, 1), cB + hstep + kstep, voffB);
        PG8_WAIT_V(6); PG8_BAR;
    } else {
        PG8_STAGE(PG8_SB(0, 0), cB, voffB); PG8_STAGE(PG8_SA(0, 0), cA, voffA); PG8_STAGE(PG8_SB(0, 1), cB + hstep, voffB); PG8_STAGE(PG8_SA(0, 1), cA + hstep, voffA);
        if (wr == 1) PG8_BAR;
        PG8_WAIT_V(4); PG8_BAR;
        PG8_STAGE(PG8_SB(1, 0), cB + kstep, voffB); PG8_STAGE(PG8_SA(1, 0), cA + kstep, voffA); PG8_STAGE(PG8_SB(1, 1), cB + hstep + kstep, voffB);
        PG8_WAIT_V(6); PG8_BAR;
    }
    for (;;) {
        const bool has_next = S.next(ui + 1, nxt);
        const char* nA = has_next ? (const char*)g.A + (size_t)nxt.pm * tstep : cA; const char* nB = has_next ? (const char*)g.Bt + (size_t)nxt.pn * tstep : cB;
        for (int t = 0; t < nt; t += 2) {
            const bool last = (t == nt - 2);
            const char* a1 = cA + (size_t)(t + 1) * kstep;
            const char* a2 = last ? nA : cA + (size_t)(t + 2) * kstep; const char* b2 = last ? nB : cB + (size_t)(t + 2) * kstep;
            const char* a3 = a2 + kstep; const char* b3 = b2 + kstep;
            if (last && has_next) S.a_ready(nxt);
            if constexpr (SP2) {
            PG8_LDB(B0, 0, 0); PG8_LDB(B1, 0, 1); PG8_SCHED; PG8_LDA(At, 0, 0); PG8_STAGE(PG8_SA(1, 1), a1 + hstep, voffA);
            PG8_WAIT_V(8); PG8_WAIT_L(0); PG8_BAR; PG8_MMA(0, 0, At, B0); PG8_MMA(0, 1, At, B1); PG8_BAR; PG8_SCHED;
            PG8_LDA(At, 0, 1); PG8_STAGE(PG8_SB(0, 0), b2, voffB); PG8_STAGE(PG8_SB(0, 1), b2 + hstep, voffB); PG8_STAGE(PG8_SA(0, 0), a2, voffA);
            PG8_WAIT_V(8); PG8_WAIT_L(0); PG8_BAR; PG8_MMA(1, 0, At, B0); PG8_MMA(1, 1, At, B1); PG8_BAR; PG8_SCHED;
            PG8_LDB(B0, 1, 0); PG8_LDB(B1, 1, 1); PG8_SCHED; PG8_LDA(At, 1, 0); PG8_STAGE(PG8_SA(0, 1), a2 + hstep, voffA);
            PG8_WAIT_V(8); PG8_WAIT_L(0); PG8_BAR; PG8_MMA(0, 0, At, B0); PG8_MMA(0, 1, At, B1); PG8_BAR; PG8_SCHED;
            PG8_LDA(At, 1, 1); PG8_STAGE(PG8_SB(1, 0), b3, voffB); PG8_STAGE(PG8_SB(1, 1), b3 + hstep, voffB); PG8_STAGE(PG8_SA(1, 0), a3, voffA);
            PG8_WAIT_V(8); PG8_WAIT_L(0); PG8_BAR; PG8_MMA(1, 0, At, B0); PG8_MMA(1, 1, At, B1); PG8_BAR; PG8_SCHED;
            } else {
            PG8_LDB(B0, 0, 0); PG8_SCHED; PG8_LDA(At, 0, 0); PG8_STAGE(PG8_SA(1, 1), a1 + hstep, voffA);
            PG8_WAIT_L(8); PG8_BAR; PG8_WAIT_L(0); PG8_MMA(0, 0, At, B0); PG8_BAR; PG8_SCHED;
            PG8_LDB(B1, 0, 1); PG8_STAGE(PG8_SB(0, 0), b2, voffB);
            PG8_BAR; PG8_WAIT_L(0); PG8_MMA(0, 1, At, B1); PG8_BAR;
            PG8_LDA(At, 0, 1); PG8_STAGE(PG8_SA(0, 0), a2, voffA);
            PG8_BAR; PG8_WAIT_L(0); PG8_MMA(1, 0, At, B0); PG8_BAR; PG8_SCHED;
            PG8_STAGE(PG8_SB(0, 1), b2 + hstep, voffB);
            PG8_WAIT_V(6); PG8_BAR; PG8_MMA(1, 1, At, B1); PG8_BAR;
            PG8_LDB(B0, 1, 0); PG8_SCHED; PG8_LDA(At, 1, 0); PG8_STAGE(PG8_SA(0, 1), a2 + hstep, voffA);
            PG8_WAIT_L(8); PG8_BAR; PG8_WAIT_L(0); PG8_MMA(0, 0, At, B0); PG8_BAR; PG8_SCHED;
            PG8_LDB(B1, 1, 1); PG8_STAGE(PG8_SB(1, 0), b3, voffB);
            PG8_BAR; PG8_WAIT_L(0); PG8_MMA(0, 1, At, B1); PG8_BAR;
            PG8_LDA(At, 1, 1); PG8_STAGE(PG8_SA(1, 0), a3, voffA);
            PG8_BAR; PG8_WAIT_L(0); PG8_MMA(1, 0, At, B0); PG8_BAR; PG8_SCHED;
            PG8_STAGE(PG8_SB(1, 1), b3 + hstep, voffB);
            PG8_WAIT_V(6); PG8_BAR; PG8_MMA(1, 1, At, B1); PG8_BAR;
            }
        }
        if constexpr (ALIGN_EPI) { if (wr == 0) PG8_BAR; }
        if constexpr (!Epi::AFTER_DRAIN) { E(acc, cur, wr, wc, fr, fq); S.done(cur); }
        if (!has_next) break;
#pragma unroll
        for (int a = 0; a < 2; ++a)
#pragma unroll
            for (int b = 0; b < 2; ++b)
#pragma unroll
                for (int m = 0; m < 4; ++m)
#pragma unroll
                    for (int n = 0; n < 2; ++n) acc[a][b][m][n] = (f32x4){0.f, 0.f, 0.f, 0.f};
        cur = nxt; cA = nA; cB = nB; ++ui;
        if constexpr (ALIGN_EPI) { if (wr == 1) PG8_BAR; }
    }
    PG8_WAIT_V(0);
    if constexpr (!ALIGN_EPI) { if (wr == 0) PG8_BAR; }
    PG8_BAR;
    if constexpr (Epi::AFTER_DRAIN) { E.fused(acc, cur, wr, wc, fr, fq, lds, wid, lane); S.done(cur); }
#undef PG8_SA
#undef PG8_SB
#undef PG8_STAGE
#undef PG8_LDA
#undef PG8_LDB
#undef PG8_MMA
#undef PG8_WAIT_V
#undef PG8_WAIT_L
#undef PG8_BAR
#undef PG8_SCHED
}
}
struct EpiBf16 { bf16* C; int ldc; DI void operator()(int r, int c, f32x4 v) const { u32x2 o; o.x = cvt_pk_bf16(v[0], v[1]); o.y = cvt_pk_bf16(v[2], v[3]); *(u32x2*)(C + (size_t)r * ldc + c) = o; } };
struct EpiResid { const float* xin; float* xout; const float* gate;
    DI void operator()(int r, int c, f32x4 v) const { const float4 x = *(const float4*)(xin + (size_t)r * 1024 + c); const float4 g = *(const float4*)(gate + (size_t)(r >> 12) * 6144 + c);
        float4 o; o.x = x.x + g.x * v[0]; o.y = x.y + g.y * v[1]; o.z = x.z + g.z * v[2]; o.w = x.w + g.w * v[3]; *(float4*)(xout + (size_t)r * 1024 + c) = o; } };
struct EpiGlu { const bf16* yg; const float* bglu; bf16* mix;
    DI void operator()(int r, int c, f32x4 v) const { const u32x2 y = *(const u32x2*)(yg + (size_t)r * 256 + c); const float4 b = *(const float4*)(bglu + c);
        u32x2 o; o.x = cvt_pk_bf16(bflo(y.x) * sigmoidf(v[0] + b.x), bfhi(y.x) * sigmoidf(v[1] + b.y)); o.y = cvt_pk_bf16(bflo(y.y) * sigmoidf(v[2] + b.z), bfhi(y.y) * sigmoidf(v[3] + b.w));
        *(u32x2*)(mix + (size_t)r * KMIX + c) = o; } };
constexpr int GP = 72;
template <class Epi>
DI void gemm_tile64(const bf16* __restrict__ A, int lda, const bf16* __restrict__ Bt, int ldb, int K, int m0, int n0, bf16* lds, const Epi& epi) {
    bf16* As = lds; bf16* Bs = lds + 64 * GP;
    const int tid = opq_tid(), lane = tid & 63, wave = tid >> 6, wm = wave >> 1, wn = wave & 1;
    const int fr = lane & 15, fq = lane >> 4;
    const int lrow = tid >> 3, lch = tid & 7;
    f32x4 acc[4][2];
#pragma unroll
    for (int i = 0; i < 4; ++i)
#pragma unroll
        for (int j = 0; j < 2; ++j) acc[i][j] = (f32x4){0.f, 0.f, 0.f, 0.f};
    bf16x8 ra[2], rb[4];
    const bf16* Ag = A + (size_t)(m0 + lrow) * lda + lch * 8;
    const bf16* Bg = Bt + (size_t)(n0 + lrow) * ldb + lch * 8;
#pragma unroll
    for (int i = 0; i < 4; ++i) { if (i < 2) ra[i] = ld16(Ag + (size_t)32 * i * lda); rb[i] = ld16(Bg + (size_t)32 * i * ldb); }
    const int nk = K / 64;
    for (int kt = 0; kt < nk; ++kt) {
        hsync();
#pragma unroll
        for (int i = 0; i < 4; ++i) { if (i < 2) *(bf16x8*)(As + (lrow + 32 * i) * GP + lch * 8) = ra[i]; *(bf16x8*)(Bs + (lrow + 32 * i) * GP + lch * 8) = rb[i]; }
        hsync();
        if (kt + 1 < nk) {
#pragma unroll
            for (int i = 0; i < 4; ++i) { if (i < 2) ra[i] = ld16(Ag + (size_t)32 * i * lda + (kt + 1) * 64); rb[i] = ld16(Bg + (size_t)32 * i * ldb + (kt + 1) * 64); }
        }
#pragma unroll
        for (int ks = 0; ks < 2; ++ks) {
            bf16x8 fa[4], fb[2];
#pragma unroll
            for (int i = 0; i < 4; ++i) fa[i] = ld16(Bs + (64 * wn + 16 * i + fr) * GP + 32 * ks + 8 * fq);
#pragma unroll
            for (int j = 0; j < 2; ++j) fb[j] = ld16(As + (32 * wm + 16 * j + fr) * GP + 32 * ks + 8 * fq);
#pragma unroll
            for (int i = 0; i < 4; ++i)
#pragma unroll
                for (int j = 0; j < 2; ++j) acc[i][j] = MFMA16(fa[i], fb[j], acc[i][j]);
        }
    }
#pragma unroll
    for (int i = 0; i < 4; ++i)
#pragma unroll
        for (int j = 0; j < 2; ++j) epi(m0 + 32 * wm + 16 * j + fr, n0 + 64 * wn + 16 * i + 4 * fq, acc[i][j]);
}
template <class F> struct Epi256 {
    static constexpr bool PERM = false, AFTER_DRAIN = false;
    F f;
    DI void operator()(const f32x4 (&acc)[2][2][4][2], const pg8::Unit& u, int wr, int wc, int, int) const {
        int t_ = (int)threadIdx.x; asm volatile("" : "+v"(t_));
        const int fr = t_ & 15, fq = (t_ >> 4) & 3;
#pragma unroll
        for (int ai = 0; ai < 2; ++ai)
#pragma unroll
            for (int m = 0; m < 4; ++m)
#pragma unroll
                for (int bj = 0; bj < 2; ++bj)
#pragma unroll
                    for (int n = 0; n < 2; ++n) f(u.pm * 256 + ai * 128 + wr * 64 + m * 16 + fr, u.pn * 256 + bj * 128 + wc * 32 + n * 16 + 4 * fq, acc[ai][bj][m][n]);
    }
};

DI unsigned off_b(unsigned row, unsigned ch) { return 256u * row + 16u * (ch ^ (((row & 3u) << 2) | ((row >> 2) & 3u))); }
#define TR8(o0, o1, o2, o3, o4, o5, o6, o7, a0, a1, a2, a3, a4, a5, a6, a7)                                                                         \
    asm volatile("s_waitcnt lgkmcnt(0)\n\t"                                                                                                         \
                 "ds_read_b64_tr_b16 %0, %8\n\tds_read_b64_tr_b16 %1, %9\n\tds_read_b64_tr_b16 %2, %10\n\tds_read_b64_tr_b16 %3, %11\n\t"           \
                 "ds_read_b64_tr_b16 %4, %12\n\tds_read_b64_tr_b16 %5, %13\n\tds_read_b64_tr_b16 %6, %14\n\tds_read_b64_tr_b16 %7, %15\n\t"         \
                 "s_waitcnt lgkmcnt(0)"                                                                                                             \
                 : "=&v"(o0), "=&v"(o1), "=&v"(o2), "=&v"(o3), "=&v"(o4), "=&v"(o5), "=&v"(o6), "=&v"(o7)                                           \
                 : "v"(a0), "v"(a1), "v"(a2), "v"(a3), "v"(a4), "v"(a5), "v"(a6), "v"(a7)                                                           \
                 : "memory")

DI void it_kvn(const Params& p, int l, int vb) {
    const int lane = opq_tid() & 63, wave = opq_tid() >> 6;
    const bf16* proj = (const bf16*)(wsb(p) + WS_PROJ); bf16* kvn = (bf16*)(wsb(p) + WS_KVN);
    const float g0 = p.in[19][l * 128 + 2 * lane], g1 = p.in[19][l * 128 + 2 * lane + 1];
    for (int i = 0; i < 16; ++i) {
        const int row = vb * 64 + i * 4 + wave;
        const unsigned u = *(const unsigned*)(proj + (size_t)row * NPROJ + C_CKV + 2 * lane);
        const float a = bflo(u), b = bfhi(u);
        const float ss = wave_sum(a * a + b * b);
        const float r = rsqrtf(ss * (1.f / 128.f) + 1e-6f);
        *(unsigned*)(kvn + (size_t)row * 128 + 2 * lane) = cvt_pk_bf16(a * r * g0, b * r * g1);
    }
}

DI void it_ssm_a(const Params& p, int l, int item) {
    const int lane = opq_tid() & 63, wave = opq_tid() >> 6, fr = lane & 15, fq = lane >> 4;
    const bf16* proj = (const bf16*)(wsb(p) + WS_PROJ);
    float* sloc = (float*)(wsb(p) + WS_SLOC);
    const int g = item & 15, rt = item >> 4;
    const bf16* E = (const bf16*)(wsb(p) + WS_E) + ((size_t)(l * 16 + g) * 128) * 1024;
    const int R = 16 * rt + fr, b = R >> 6, k = R & 63;
    const bf16* arow = proj + ((size_t)b * 4096 + 64 * k + (fq >> 1)) * NPROJ + C_UA + 16 * g + 8 * (fq & 1);
    f32x4 acc[2] = {(f32x4){0, 0, 0, 0}, (f32x4){0, 0, 0, 0}};
#pragma unroll 4
    for (int ks = 0; ks < 32; ++ks) {
        const bf16x8 a = ld16(arow + (size_t)(2 * ks) * NPROJ);
#pragma unroll
        for (int c = 0; c < 2; ++c) { const int ct = 2 * wave + c; const bf16x8 bf = ld16(E + (size_t)(16 * ct + fr) * 1024 + 32 * ks + 8 * fq); acc[c] = MFMA16(a, bf, acc[c]); }
    }
#pragma unroll
    for (int c = 0; c < 2; ++c)
#pragma unroll
        for (int i = 0; i < 4; ++i) sloc[((size_t)(16 * rt + 4 * fq + i) * 16 + g) * 128 + 16 * (2 * wave + c) + fr] = acc[c][i];
}

DI void it_ssm_c(const Params& p, int l, int item, unsigned char* sm) {
    bf16* sst = (bf16*)sm;
    bf16* ktl = (bf16*)(sm + 17408);
    const int tid = opq_tid(), lane = tid & 63, wave = tid >> 6, fr = lane & 15, fq = lane >> 4;
    const bf16* proj = (const bf16*)(wsb(p) + WS_PROJ);
    const float* sloc = (const float*)(wsb(p) + WS_SLOC);
    bf16* yg = (bf16*)(wsb(p) + WS_YG);
    const int jq = item & 3, g = (item >> 2) & 15, b = item >> 6;
    const bf16* KT = (const bf16*)(wsb(p) + WS_KT) + (size_t)(l * 16 + g) * 64 * 256;
    hsync();
#pragma unroll
    for (int i = 0; i < 8; ++i) *(bf16x8*)(ktl + (i * 256 + tid) * 8) = ld16(KT + (size_t)(i * 256 + tid) * 8);
    if (wave == 0) {
        const float* pw64 = (const float*)(wsb(p) + WS_PW) + ((size_t)(l * 16 + g) * 65 + 64) * 128 + lane * 2;
        const float ar = pw64[0], ai = pw64[1];
        float sr = 0, si = 0;
        const float* s = sloc + ((size_t)(b * 64) * 16 + g) * 128;
#pragma unroll 8
        for (int k = 0; k < 64; ++k) {
            sst[k * 136 + lane] = f2bf(sr); sst[k * 136 + 64 + lane] = f2bf(si);
            const float lr = s[(size_t)k * 2048 + lane], li = s[(size_t)k * 2048 + 64 + lane];
            const float nr = ar * sr - ai * si + lr, ni = ar * si + ai * sr + li;
            sr = nr; si = ni;
        }
    }
    hsync();
    const bf16* G = (const bf16*)(wsb(p) + WS_G) + (size_t)(l * 16 + g) * 1024 * 128;
    const int kch = 16 * wave + fr;
    const bf16* arow = proj + ((size_t)b * 4096 + 64 * kch + (fq >> 1)) * NPROJ + C_UA + 16 * g + 8 * (fq & 1);
    const int j0 = 16 * jq;
    f32x4 acc[16];
#pragma unroll
    for (int jj = 0; jj < 16; ++jj) acc[jj] = (f32x4){0, 0, 0, 0};
    const int nks = (j0 + 15) / 2 + 1;
    bf16x8 a_cur[8], a_nxt[8];
#pragma unroll
    for (int i = 0; i < 8; ++i) a_cur[i] = ld16(arow + (size_t)(2 * i) * NPROJ);
    for (int k0 = 0; k0 < nks; k0 += 8) {
        const bool more = k0 + 8 < nks;
#pragma unroll
        for (int i = 0; i < 8; ++i) a_nxt[i] = more ? ld16(arow + (size_t)(2 * (k0 + 8 + i)) * NPROJ) : zero8();
#pragma unroll
        for (int i = 0; i < 8; ++i) {
            const int ks = k0 + i;
#pragma unroll
            for (int jj = 0; jj < 16; ++jj) {
                const int j = j0 + jj;
                if (2 * ks <= j) {
                    const int d = j - 2 * ks - (fq >> 1);
                    const bf16x8 bl = ld16(ktl + ((d < 0 ? 0 : d) * 16 + fr) * 16 + 8 * (fq & 1));
                    const bf16x8 bf = d >= 0 ? bl : zero8();
                    acc[jj] = MFMA16(bf, a_cur[i], acc[jj]);
                }
            }
        }
#pragma unroll
        for (int i = 0; i < 8; ++i) a_cur[i] = a_nxt[i];
    }
#pragma unroll
    for (int ks = 0; ks < 4; ++ks) {
        const bf16x8 a = ld16(sst + kch * 136 + 32 * ks + 8 * fq);
        bf16x8 bfr[16];
#pragma unroll
        for (int jj = 0; jj < 16; ++jj) bfr[jj] = ld16(G + ((size_t)((j0 + jj) * 16 + fr)) * 128 + 32 * ks + 8 * fq);
#pragma unroll
        for (int jj = 0; jj < 16; ++jj) acc[jj] = MFMA16(bfr[jj], a, acc[jj]);
    }
#pragma unroll
    for (int jj = 0; jj < 16; ++jj) {
        const size_t tok = (size_t)b * 4096 + 64 * (16 * wave + fr) + j0 + jj;
        u32x2 o; o.x = cvt_pk_bf16(gelu_tanh(acc[jj][0]), gelu_tanh(acc[jj][1])); o.y = cvt_pk_bf16(gelu_tanh(acc[jj][2]), gelu_tanh(acc[jj][3]));
        *(u32x2*)(yg + tok * 256 + 16 * g + 4 * fq) = o;
    }
}

DI void it_gmlp(const Params& p, int l, int item, unsigned char* sm) {
    bf16* vnT = (bf16*)sm;
    const int tid = opq_tid(), lane = tid & 63, wave = tid >> 6, fr = lane & 15, fq = lane >> 4;
    const bf16* proj = (const bf16*)(wsb(p) + WS_PROJ); bf16* mix = (bf16*)(wsb(p) + WS_MIX);
    const int h = item & 3, blk = item >> 2;
    const size_t tok0 = (size_t)blk * 128;
    hsync();
    {
        const int row = tid >> 1, half = tid & 1;
        const bf16* vp = proj + (tok0 + row) * NPROJ + C_VB + 64 * h + 32 * half;
        float v[32]; float s = 0;
#pragma unroll
        for (int q = 0; q < 4; ++q) { const bf16x8 t = ld16(vp + 8 * q);
#pragma unroll
            for (int e = 0; e < 8; ++e) { v[8 * q + e] = bf2f((bf16)t[e]); s += v[8 * q + e]; } }
        s += __shfl_xor(s, 1); const float mu = s * (1.f / 64.f);
        float vs = 0;
#pragma unroll
        for (int e = 0; e < 32; ++e) { const float d = v[e] - mu; vs += d * d; }
        vs += __shfl_xor(vs, 1); const float r = rsqrtf(vs * (1.f / 64.f) + 1e-6f);
#pragma unroll
        for (int e = 0; e < 32; ++e) vnT[(32 * half + e) * 136 + row] = f2bf((v[e] - mu) * r);
    }
    hsync();
    const bf16* W = (const bf16*)(wsb(p) + WS_GW) + (size_t)(l * 4 + h) * 128 * 128;
    f32x4 acc[4][2];
#pragma unroll
    for (int i = 0; i < 4; ++i) { acc[i][0] = (f32x4){0, 0, 0, 0}; acc[i][1] = (f32x4){0, 0, 0, 0}; }
#pragma unroll
    for (int ks = 0; ks < 4; ++ks) {
        bf16x8 fa[4], fb[2];
#pragma unroll
        for (int i = 0; i < 4; ++i) fa[i] = ld16(vnT + (16 * i + fr) * 136 + 32 * ks + 8 * fq);
#pragma unroll
        for (int j = 0; j < 2; ++j) fb[j] = ld16(W + (size_t)(16 * (2 * wave + j) + fr) * 128 + 32 * ks + 8 * fq);
#pragma unroll
        for (int i = 0; i < 4; ++i)
#pragma unroll
            for (int j = 0; j < 2; ++j) acc[i][j] = MFMA16(fa[i], fb[j], acc[i][j]);
    }
#pragma unroll
    for (int j = 0; j < 2; ++j) {
        const int t = 16 * (2 * wave + j) + fr;
        const float bs = p.in[18][(l * 4 + h) * 128 + t];
#pragma unroll
        for (int i = 0; i < 4; ++i) {
            const int d = 16 * i + 4 * fq;
            const u32x2 u = *(const u32x2*)(proj + (tok0 + t) * NPROJ + C_UB + 64 * h + d);
            u32x2 o; o.x = cvt_pk_bf16(bflo(u.x) * (acc[i][j][0] + bs), bfhi(u.x) * (acc[i][j][1] + bs)); o.y = cvt_pk_bf16(bflo(u.y) * (acc[i][j][2] + bs), bfhi(u.y) * (acc[i][j][3] + bs));
            *(u32x2*)(mix + (tok0 + t) * KMIX + 256 + 64 * h + d) = o;
        }
    }
}

DI size_t score_row_off(int b, int t) { const int c = t >> 6; return (size_t)b * SCORES_PER_BATCH + (size_t)4096 * (c * (c + 1) / 2) + (size_t)(t & 63) * 64 * (c + 1); }
template <int NR>
DI void dsa_select_impl(const float* __restrict__ srow, int nreg, bf16* __restrict__ so, int lane, unsigned* hist) {
    (void)hist;
    unsigned key[NR];
#pragma unroll
    for (int r = 0; r < NR; ++r) { const float v = srow[64 * r + lane]; key[r] = (r < nreg) ? fkey(v + 0.f) : 0u; }
    unsigned T = 0;
#pragma unroll 1
    for (int bit = 31; bit >= 0; --bit) {
        const unsigned cand = T | (1u << bit);
        unsigned c = 0;
#pragma unroll
        for (int r = 0; r < NR; ++r) asm("v_cmp_ge_u32 vcc, %1, %2\n\tv_addc_co_u32 %0, vcc, 0, %0, vcc" : "+v"(c) : "v"(key[r]), "v"(cand) : "vcc");
        const unsigned cnt = wave_sum_u32(c);
        if (cnt >= 256u) { T = cand; if (cnt == 256u) break; }
    }
    unsigned c = 0;
#pragma unroll
    for (int r = 0; r < NR; ++r) asm("v_cmp_gt_u32 vcc, %1, %2\n\tv_addc_co_u32 %0, vcc, 0, %0, vcc" : "+v"(c) : "v"(key[r]), "v"(T) : "vcc");
    const int need = 256 - (int)wave_sum_u32(c);
    int base = 0, eqb = 0;
    const unsigned long long lt = (1ull << lane) - 1ull;
#pragma unroll
    for (int r = 0; r < NR; ++r) {
        const unsigned long long me = __ballot(key[r] == T);
        const int erank = eqb + __popcll(me & lt);
        const bool take = (key[r] > T) || (key[r] == T && erank < need);
        const unsigned long long mt = __ballot(take);
        if (take) so[base + __popcll(mt & lt)] = (bf16)(64 * r + lane);
        base += __popcll(mt); eqb += __popcll(me);
    }
}
DI void dsa_select_query(const Params& p, int q, int lane, unsigned* hist) {
    const float* scores = (const float*)(wsb(p) + WS_SCORES); bf16* sel = (bf16*)(wsb(p) + WS_SEL);
    const int b = q >> 12, t = q & 4095, c = t >> 6, nreg = c + 1;
    bf16* so = sel + (size_t)q * 256;
    if (nreg <= 4) { for (int r = 0; r < nreg; ++r) so[64 * r + lane] = (bf16)(64 * r + lane); return; }
    const float* srow = scores + score_row_off(b, t);
    if (nreg <= 16) dsa_select_impl<16>(srow, nreg, so, lane, hist);
    else if (nreg <= 32) dsa_select_impl<32>(srow, nreg, so, lane, hist);
    else if (nreg <= 48) dsa_select_impl<48>(srow, nreg, so, lane, hist);
    else dsa_select_impl<64>(srow, nreg, so, lane, hist);
}
DI void it_dsa_index_select(const Params& p, int item, unsigned char* sm, int mode = 3) {
    const int lane = opq_tid() & 63, wave = opq_tid() >> 6, fr = lane & 15, fq = lane >> 4;
    const bf16* proj = (const bf16*)(wsb(p) + WS_PROJ); float* scores = (float*)(wsb(p) + WS_SCORES);
    const int c = 63 - (item >> 4), b = (item >> 2) & 3, qg = item & 3;
    if (c >= 4 && (mode & 1)) {
        const int t = 64 * c + 16 * qg + fr;
        const bf16* qrow = proj + ((size_t)b * 4096 + t) * NPROJ;
        bf16x8 qf[4][2];
#pragma unroll
        for (int hh = 0; hh < 4; ++hh)
#pragma unroll
            for (int ks = 0; ks < 2; ++ks) qf[hh][ks] = ld16(qrow + C_QI + 64 * hh + 32 * ks + 8 * fq);
        float w[4];
        { const u32x2 wv = *(const u32x2*)(qrow + C_WI); w[0] = bflo(wv.x) * 0.0625f; w[1] = bfhi(wv.x) * 0.0625f; w[2] = bflo(wv.y) * 0.0625f; w[3] = bfhi(wv.y) * 0.0625f; }
        float* srow = scores + score_row_off(b, t);
        const int ntile = 4 * (c + 1);
        const bf16* kbase = proj + ((size_t)b * 4096 + fr) * NPROJ + C_KI + 8 * fq;
        bf16x8 k0[4], k1[4];
#pragma unroll
        for (int u = 0; u < 4; ++u) { const bf16* krow = kbase + (size_t)16 * (wave + 4 * u) * NPROJ; k0[u] = ld16(krow); k1[u] = ld16(krow + 32); }
        for (int base = wave; base < ntile; base += 16) {
            bf16x8 n0[4], n1[4];
            const bool more = base + 16 < ntile;
            if (more) {
#pragma unroll
                for (int u = 0; u < 4; ++u) { const bf16* krow = kbase + (size_t)16 * (base + 16 + 4 * u) * NPROJ; n0[u] = ld16(krow); n1[u] = ld16(krow + 32); }
            }
#pragma unroll
            for (int u = 0; u < 4; ++u) {
                const int kt = base + 4 * u;
                if (kt >= ntile) break;
                f32x4 sc = {0, 0, 0, 0};
#pragma unroll
                for (int hh = 0; hh < 4; ++hh) {
                    f32x4 a = {0, 0, 0, 0};
                    a = MFMA16(k0[u], qf[hh][0], a); a = MFMA16(k1[u], qf[hh][1], a);
#pragma unroll
                    for (int i = 0; i < 4; ++i) sc[i] += w[hh] * fmaxf(a[i], 0.f);
                }
#pragma unroll
                for (int i = 0; i < 4; ++i) sc[i] += 0.f;
                *(f32x4*)(srow + 16 * kt + 4 * fq) = sc;
            }
            if (more) {
#pragma unroll
                for (int u = 0; u < 4; ++u) { k0[u] = n0[u]; k1[u] = n1[u]; }
            }
        }
    }
    hsync_g();
    if (mode & 2) for (int i = 0; i < 4; ++i) dsa_select_query(p, b * 4096 + 64 * c + 16 * qg + 4 * wave + i, lane, (unsigned*)sm + 1024 * wave);
}
DI void it_dsa_attn(const Params& p, int item, unsigned char* sm) {
    const int lane = opq_tid() & 63, wave = opq_tid() >> 6, fr = lane & 15, fq = lane >> 4;
    unsigned char* tile = sm + wave * 8192;
    bf16* selw = (bf16*)(sm + 32768 + wave * 512);
    const bf16* proj = (const bf16*)(wsb(p) + WS_PROJ); const bf16* kvn = (const bf16*)(wsb(p) + WS_KVN);
    const bf16* sel = (const bf16*)(wsb(p) + WS_SEL); bf16* mix = (bf16*)(wsb(p) + WS_MIX);
    unsigned wr_addr[8], rd_addr[2][4], tr_addr[8][2];
#pragma unroll
    for (int i = 0; i < 8; ++i) wr_addr[i] = off_b(4 * i + fq, fr);
#pragma unroll
    for (int rb = 0; rb < 2; ++rb)
#pragma unroll
        for (int s = 0; s < 4; ++s) rd_addr[rb][s] = off_b(8 * (fr >> 2) + 4 * rb + (fr & 3), 4 * s + fq);
    const unsigned tbase = (unsigned)(size_t)tile;
    {
        const unsigned q4 = fr >> 2, p4 = fr & 3;
#pragma unroll
        for (int c = 0; c < 8; ++c)
#pragma unroll
            for (int t = 0; t < 2; ++t) tr_addr[c][t] = tbase + off_b(8 * fq + 4 * t + q4, 2 * c + (p4 >> 1)) + 8 * (p4 & 1);
    }
    const float slope = fr < 8 ? exp2f(-(float)(fr + 1)) : 0.f;
    for (int qi = 0; qi < 4; ++qi) {
        const int q = item * 16 + wave * 4 + qi;
        const int b = q >> 12, t = q & 4095, c = t >> 6;
        const int nsel = (c + 1) * 64 < 256 ? (c + 1) * 64 : 256;
        const bf16* qa = proj + (size_t)q * NPROJ + C_QA;
        bf16x8 qf[4];
#pragma unroll
        for (int s = 0; s < 4; ++s) qf[s] = fr < 8 ? ld16(qa + fr * 128 + 32 * s + 8 * fq) : zero8();
        const bf16* selp = sel + (size_t)q * 256;
        const bf16* kvb = kvn + (size_t)b * 4096 * 128;
        if (4 * lane < nsel) *(u32x2*)(selw + 4 * lane) = *(const u32x2*)(selp + 4 * lane);
        float m_run = -INFINITY, l_run = 0.f;
        f32x4 o[8];
#pragma unroll
        for (int i = 0; i < 8; ++i) o[i] = (f32x4){0, 0, 0, 0};
        bf16x8 gk[8];
#pragma unroll
        for (int i = 0; i < 8; ++i) { const int key = selw[4 * i + fq]; gk[i] = ld16(kvb + (size_t)key * 128 + 8 * fr); }
        const int nt = nsel / 32;
        for (int ti = 0; ti < nt; ++ti) {
            const bf16x8 kp = ld16(selw + 32 * ti + 8 * fq);
#pragma unroll
            for (int i = 0; i < 8; ++i) *(bf16x8*)(tile + wr_addr[i]) = gk[i];
            if (ti + 1 < nt) {
#pragma unroll
                for (int i = 0; i < 8; ++i) { const int key = selw[32 * (ti + 1) + 4 * i + fq]; gk[i] = ld16(kvb + (size_t)key * 128 + 8 * fr); }
            }
            f32x4 lg[2] = {(f32x4){0, 0, 0, 0}, (f32x4){0, 0, 0, 0}};
#pragma unroll
            for (int rb = 0; rb < 2; ++rb)
#pragma unroll
                for (int s = 0; s < 4; ++s) lg[rb] = MFMA16(ld16(tile + rd_addr[rb][s]), qf[s], lg[rb]);
            float val[8]; float tmax = -INFINITY;
#pragma unroll
            for (int j = 0; j < 8; ++j) { const float dist = fabsf((float)(t - (int)(unsigned short)kp[j])); val[j] = lg[j >> 2][j & 3] - slope * dist; tmax = fmaxf(tmax, val[j]); }
            tmax = fmaxf(tmax, __shfl_xor(tmax, 16)); tmax = fmaxf(tmax, __shfl_xor(tmax, 32));
            const float m_new = fmaxf(m_run, tmax);
            const float scale = __expf(m_run - m_new);
            l_run *= scale;
#pragma unroll
            for (int i = 0; i < 8; ++i) o[i] *= scale;
            float pv[8];
#pragma unroll
            for (int j = 0; j < 8; ++j) { pv[j] = __expf(val[j] - m_new); l_run += pv[j]; }
            m_run = m_new;
            u32x4 pk; pk.x = cvt_pk_bf16(pv[0], pv[1]); pk.y = cvt_pk_bf16(pv[2], pv[3]); pk.z = cvt_pk_bf16(pv[4], pv[5]); pk.w = cvt_pk_bf16(pv[6], pv[7]);
            const bf16x8 pf = __builtin_bit_cast(bf16x8, pk);
            s16x4 tr[8][2];
            TR8(tr[0][0], tr[0][1], tr[1][0], tr[1][1], tr[2][0], tr[2][1], tr[3][0], tr[3][1], tr_addr[0][0], tr_addr[0][1], tr_addr[1][0], tr_addr[1][1], tr_addr[2][0], tr_addr[2][1], tr_addr[3][0], tr_addr[3][1]);
            TR8(tr[4][0], tr[4][1], tr[5][0], tr[5][1], tr[6][0], tr[6][1], tr[7][0], tr[7][1], tr_addr[4][0], tr_addr[4][1], tr_addr[5][0], tr_addr[5][1], tr_addr[6][0], tr_addr[6][1], tr_addr[7][0], tr_addr[7][1]);
#pragma unroll
            for (int cc = 0; cc < 8; ++cc) {
                bf16x8 kf; kf[0] = tr[cc][0][0]; kf[1] = tr[cc][0][1]; kf[2] = tr[cc][0][2]; kf[3] = tr[cc][0][3]; kf[4] = tr[cc][1][0]; kf[5] = tr[cc][1][1]; kf[6] = tr[cc][1][2]; kf[7] = tr[cc][1][3];
                o[cc] = MFMA16(kf, pf, o[cc]);
            }
        }
        float lt = l_run; lt += __shfl_xor(lt, 16); lt += __shfl_xor(lt, 32);
        const float inv = 1.f / lt;
        if (fr < 8) {
#pragma unroll
            for (int cc = 0; cc < 8; ++cc) { u32x2 ov; ov.x = cvt_pk_bf16(o[cc][0] * inv, o[cc][1] * inv); ov.y = cvt_pk_bf16(o[cc][2] * inv, o[cc][3] * inv);
                *(u32x2*)(mix + (size_t)q * KMIX + 512 + fr * 128 + 16 * cc + 4 * fq) = ov; }
        }
    }
}
typedef float f2 __attribute__((ext_vector_type(2)));
#ifndef PEER_FP8_MASK
#define PEER_FP8_MASK 3
#endif
constexpr float U_SCALE = 64.f, V_SCALE = 8.f;
DI unsigned pack4_fp8(float a, float b, float c, float d) { int p = __builtin_amdgcn_cvt_pk_fp8_f32(a, b, 0, false); p = __builtin_amdgcn_cvt_pk_fp8_f32(c, d, p, true); return (unsigned)p; }
DI void conv_chunk_fp8(const float* __restrict__ src, unsigned char* __restrict__ dst, size_t i0, int n16, float sc) {
    for (int i = opq_tid(); i < n16; i += 256) {
        const float4* s4 = (const float4*)src + 4 * (i0 + i);
        const float4 a = s4[0], b = s4[1], c = s4[2], d = s4[3];
        u32x4 o; o.x = pack4_fp8(a.x * sc, a.y * sc, a.z * sc, a.w * sc); o.y = pack4_fp8(b.x * sc, b.y * sc, b.z * sc, b.w * sc);
        o.z = pack4_fp8(c.x * sc, c.y * sc, c.z * sc, c.w * sc); o.w = pack4_fp8(d.x * sc, d.y * sc, d.z * sc, d.w * sc);
        ((u32x4*)dst)[i0 + i] = o;
    }
}
struct PeerLds2 {
    float trans[4][1024];
    unsigned char li[4][2][64][16];
    unsigned short pe[4][8][128];
    float pg[4][8][128];
};
template <int OFF, int NK>
DI void sort16_desc(unsigned (&k)[NK]) {
#pragma unroll
    for (int size = 2; size <= 16; size <<= 1)
#pragma unroll
        for (int stride = size >> 1; stride > 0; stride >>= 1)
#pragma unroll
            for (int i = 0; i < 16; ++i) {
                const int j = i ^ stride;
                if (j > i) {
                    const bool desc = ((i & size) == 0);
                    const unsigned a = k[OFF + i], b = k[OFF + j];
                    const unsigned hi = a > b ? a : b, lo = a > b ? b : a;
                    k[OFF + i] = desc ? hi : lo; k[OFF + j] = desc ? lo : hi;
                }
            }
}
template <int OA, int OB, int NK>
DI void merge_top16(unsigned (&k)[NK]) {
#pragma unroll
    for (int i = 0; i < 16; ++i) { const unsigned a = k[OA + i], b = k[OB + 15 - i]; k[OA + i] = a > b ? a : b; }
#pragma unroll
    for (int stride = 8; stride > 0; stride >>= 1)
#pragma unroll
        for (int i = 0; i < 16; ++i) {
            const int j = i ^ stride;
            if (j > i) { const unsigned a = k[OA + i], b = k[OA + j]; k[OA + i] = a > b ? a : b; k[OA + j] = a > b ? b : a; }
        }
}
DI void peer_retrieve(const Params& p, int l, int tok0, PeerLds2& S, int lane, int wave) {
    const int fr = lane & 15, fq = lane >> 4;
    const bf16* QP = (const bf16*)(wsb(p) + WS_PROJ);
    const bf16* PK = (const bf16*)(wsb(p) + WS_PK) + (size_t)l * 2 * 128 * 64;
    float* trans = S.trans[wave];
    unsigned K1[16], K2[16];
#pragma unroll
    for (int L = 0; L < 2; ++L) {
        f32x4 acc[4][8];
#pragma unroll
        for (int ct = 0; ct < 4; ++ct)
#pragma unroll
            for (int kt = 0; kt < 8; ++kt) acc[ct][kt] = (f32x4){0, 0, 0, 0};
#pragma unroll
        for (int kt = 0; kt < 8; ++kt) {
            const bf16* krow = PK + (size_t)L * 8192 + (size_t)(16 * kt + fr) * 64 + 8 * fq;
            const bf16x8 a0 = ld16(krow), a1 = ld16(krow + 32);
#pragma unroll
            for (int ct = 0; ct < 4; ++ct) {
                const bf16* qrow = QP + (size_t)(tok0 + 2 * ct + (fr >> 3)) * 1024 + 128 * (fr & 7) + 64 * L + 8 * fq;
                acc[ct][kt] = MFMA16(a0, ld16(qrow), acc[ct][kt]); acc[ct][kt] = MFMA16(a1, ld16(qrow + 32), acc[ct][kt]);
            }
        }
        unsigned k[128];
#define PEER_ROUND(kt)                                                                                                                            \
        {                                                                                                                                         \
            _Pragma("unroll") for (int ct = 0; ct < 4; ++ct) *(f32x4*)(trans + ((ct * 4 + fq) * 16 + fr) * 4) = acc[ct][kt];                       \
            _Pragma("unroll") for (int sq = 0; sq < 4; ++sq) {                                                                                     \
                const f32x4 v = *(const f32x4*)(trans + ((fq * 4 + sq) * 16 + fr) * 4);                                                            \
                _Pragma("unroll") for (int i = 0; i < 4; ++i) k[16 * (kt) + sq * 4 + i] = (fkey(v[i]) & ~0x7fu) | (unsigned)(16 * (kt) + 4 * sq + i); \
            }                                                                                                                                     \
            sort16_desc<16 * (kt)>(k);                                                                                                            \
        }
        PEER_ROUND(0) PEER_ROUND(1) merge_top16<0, 16>(k);
        PEER_ROUND(2) PEER_ROUND(3) merge_top16<32, 48>(k); merge_top16<0, 32>(k);
        PEER_ROUND(4) PEER_ROUND(5) merge_top16<64, 80>(k);
        PEER_ROUND(6) PEER_ROUND(7) merge_top16<96, 112>(k); merge_top16<64, 96>(k);
        merge_top16<0, 64>(k);
#undef PEER_ROUND
        u32x4 ib;
        ib.x = (k[0] & 127u) | ((k[1] & 127u) << 8) | ((k[2] & 127u) << 16) | ((k[3] & 127u) << 24);
        ib.y = (k[4] & 127u) | ((k[5] & 127u) << 8) | ((k[6] & 127u) << 16) | ((k[7] & 127u) << 24);
        ib.z = (k[8] & 127u) | ((k[9] & 127u) << 8) | ((k[10] & 127u) << 16) | ((k[11] & 127u) << 24);
        ib.w = (k[12] & 127u) | ((k[13] & 127u) << 8) | ((k[14] & 127u) << 16) | ((k[15] & 127u) << 24);
        *(u32x4*)(S.li[wave][L][lane]) = ib;
#pragma unroll
        for (int i = 0; i < 16; ++i) { if (L == 0) K1[i] = k[i]; else K2[i] = k[i]; }
    }
    float v1[16], v2[16];
#pragma unroll
    for (int i = 0; i < 16; ++i) { v1[i] = __uint_as_float(unkey(K1[i] & ~0x7fu)); v2[i] = __uint_as_float(unkey(K2[i] & ~0x7fu)); }
    unsigned c[64];
    {
        int idx = 0;
#pragma unroll
        for (int a = 0; a < 16; ++a)
#pragma unroll
            for (int b = 0; b < 16; ++b)
                if ((a + 1) * (b + 1) <= 16) { c[idx] = (fkey(v1[a] + v2[b]) & ~0xffu) | (unsigned)(a * 16 + b); ++idx; }
#pragma unroll
        for (int i = 50; i < 64; ++i) c[i] = 0u;
    }
    sort16_desc<0>(c); sort16_desc<16>(c); sort16_desc<32>(c); sort16_desc<48>(c);
    merge_top16<0, 16>(c); merge_top16<32, 48>(c); merge_top16<0, 32>(c);
    float sc[16]; float sum = 0.f;
    {
        const float m = __uint_as_float(unkey(c[0] & ~0xffu));
#pragma unroll
        for (int i = 0; i < 16; ++i) { sc[i] = __expf(__uint_as_float(unkey(c[i] & ~0xffu)) - m); sum += sc[i]; }
    }
    const float inv = 1.f / sum;
    const int tt = 2 * fq + (fr >> 3), head = fr & 7;
    const unsigned char* l1 = S.li[wave][0][lane]; const unsigned char* l2 = S.li[wave][1][lane];
#pragma unroll
    for (int i = 0; i < 16; ++i) {
        const unsigned ab = c[i] & 0xffu;
        const unsigned e = (unsigned)l1[ab >> 4] * 128u + (unsigned)l2[ab & 15u];
        S.pe[wave][tt][head * 16 + i] = (unsigned short)e; S.pg[wave][tt][head * 16 + i] = sc[i] * inv;
    }
}
template <bool FP8>
DI void peer_experts(const Params& p, int l, int tok, int tt, PeerLds2& S, int lane, int wave) {
    const bf16* H = (const bf16*)(wsb(p) + WS_H);
    const unsigned char* UB = wsb(p) + WS_UB; const unsigned char* VB = wsb(p) + WS_VB;
    const float* X = (const float*)(wsb(p) + WS_X);
    const float* modl = (const float*)(wsb(p) + WS_MOD) + (size_t)l * 4 * 6144;
    const int b = tok >> 12;
    const unsigned short* pe = S.pe[wave][tt]; const float* pg = S.pg[wave][tt];
    f2 hp[8];
    u32x4 h0, h1;
    {
        h0 = *(const u32x4*)(H + (size_t)tok * 1024 + 16 * lane); h1 = *(const u32x4*)(H + (size_t)tok * 1024 + 16 * lane + 8);
        hp[0] = (f2){bflo(h0.x), bfhi(h0.x)}; hp[1] = (f2){bflo(h0.y), bfhi(h0.y)}; hp[2] = (f2){bflo(h0.z), bfhi(h0.z)}; hp[3] = (f2){bflo(h0.w), bfhi(h0.w)};
        hp[4] = (f2){bflo(h1.x), bfhi(h1.x)}; hp[5] = (f2){bflo(h1.y), bfhi(h1.y)}; hp[6] = (f2){bflo(h1.z), bfhi(h1.z)}; hp[7] = (f2){bflo(h1.w), bfhi(h1.w)};
    }
    f2 acc[8];
#pragma unroll
    for (int i = 0; i < 8; ++i) acc[i] = (f2){0.f, 0.f};
    const bool b5 = (lane & 32) != 0, b4_ = (lane & 16) != 0, b3 = (lane & 8) != 0;
    const int eidx = (b3 ? 4 : 0) + (b4_ ? 2 : 0) + (b5 ? 1 : 0);
    if constexpr (FP8) {
    for (int e0 = 0; e0 < 128; e0 += 8) {
        u32x4 ur[8], vr[8];
#pragma unroll
        for (int j = 0; j < 8; ++j) {
            const int e = __builtin_amdgcn_readfirstlane((int)pe[e0 + j]);
            ur[j] = *(const u32x4*)(UB + (size_t)e * 1024 + 16 * lane);
            vr[j] = *(const u32x4*)(VB + (size_t)e * 1024 + 16 * lane);
        }
        float d[8];
#pragma unroll
        for (int j = 0; j < 8; ++j) {
            f2 s2 = {0.f, 0.f};
#pragma unroll
            for (int k = 0; k < 4; ++k) {
                const f2 lo = __builtin_amdgcn_cvt_pk_f32_fp8((int)ur[j][k], false), hi = __builtin_amdgcn_cvt_pk_f32_fp8((int)ur[j][k], true);
                s2 = lo * hp[2 * k] + s2; s2 = hi * hp[2 * k + 1] + s2;
            }
            d[j] = s2.x + s2.y;
        }
        float w[4], x2[2], y;
#pragma unroll
        for (int i = 0; i < 4; ++i) { const float keep = b5 ? d[2 * i + 1] : d[2 * i], send = b5 ? d[2 * i] : d[2 * i + 1]; w[i] = keep + __shfl_xor(send, 32); }
#pragma unroll
        for (int i = 0; i < 2; ++i) { const float keep = b4_ ? w[2 * i + 1] : w[2 * i], send = b4_ ? w[2 * i] : w[2 * i + 1]; x2[i] = keep + __shfl_xor(send, 16); }
        { const float keep = b3 ? x2[1] : x2[0], send = b3 ? x2[0] : x2[1]; y = keep + __shfl_xor(send, 8); }
        y += __shfl_xor(y, 4); y += __shfl_xor(y, 2); y += __shfl_xor(y, 1);
        const float sc = gelu_tanh(y * (1.f / U_SCALE)) * pg[e0 + eidx] * (1.f / V_SCALE);
#pragma unroll
        for (int j = 0; j < 8; ++j) {
            const float sj = __uint_as_float((unsigned)__builtin_amdgcn_readlane((int)__float_as_uint(sc), 32 * (j & 1) + 16 * ((j >> 1) & 1) + 8 * ((j >> 2) & 1)));
            const f2 sj2 = {sj, sj};
#pragma unroll
            for (int k = 0; k < 4; ++k) {
                const f2 lo = __builtin_amdgcn_cvt_pk_f32_fp8((int)vr[j][k], false), hi = __builtin_amdgcn_cvt_pk_f32_fp8((int)vr[j][k], true);
                acc[2 * k] = lo * sj2 + acc[2 * k]; acc[2 * k + 1] = hi * sj2 + acc[2 * k + 1];
            }
        }
    }
    } else {
    for (int e0 = 0; e0 < 128; e0 += 4) {
        const bf16* UBb = (const bf16*)UB; const bf16* VBb = (const bf16*)VB;
        u32x4 ur[4][2], vr[4][2];
#pragma unroll
        for (int j = 0; j < 4; ++j) {
            const int e = __builtin_amdgcn_readfirstlane((int)pe[e0 + j]);
            ur[j][0] = *(const u32x4*)(UBb + (size_t)e * 1024 + 16 * lane); ur[j][1] = *(const u32x4*)(UBb + (size_t)e * 1024 + 16 * lane + 8);
            vr[j][0] = *(const u32x4*)(VBb + (size_t)e * 1024 + 16 * lane); vr[j][1] = *(const u32x4*)(VBb + (size_t)e * 1024 + 16 * lane + 8);
        }
        float d[4];
#pragma unroll
        for (int j = 0; j < 4; ++j) {
            float sa = 0.f, sb = 0.f;
            sa = dot2bf(ur[j][0].x, h0.x, sa); sb = dot2bf(ur[j][0].y, h0.y, sb); sa = dot2bf(ur[j][0].z, h0.z, sa); sb = dot2bf(ur[j][0].w, h0.w, sb);
            sa = dot2bf(ur[j][1].x, h1.x, sa); sb = dot2bf(ur[j][1].y, h1.y, sb); sa = dot2bf(ur[j][1].z, h1.z, sa); sb = dot2bf(ur[j][1].w, h1.w, sb);
            d[j] = sa + sb;
        }
        float w[2], y;
#pragma unroll
        for (int i = 0; i < 2; ++i) { const float keep = b5 ? d[2 * i + 1] : d[2 * i], send = b5 ? d[2 * i] : d[2 * i + 1]; w[i] = keep + __shfl_xor(send, 32); }
        { const float keep = b4_ ? w[1] : w[0], send = b4_ ? w[0] : w[1]; y = keep + __shfl_xor(send, 16); }
        y += __shfl_xor(y, 8); y += __shfl_xor(y, 4); y += __shfl_xor(y, 2); y += __shfl_xor(y, 1);
        const float sc = gelu_tanh(y) * pg[e0 + (b4_ ? 2 : 0) + (b5 ? 1 : 0)];
#pragma unroll
        for (int j = 0; j < 4; ++j) {
            const float sj = __uint_as_float((unsigned)__builtin_amdgcn_readlane((int)__float_as_uint(sc), 32 * (j & 1) + 16 * ((j >> 1) & 1)));
            const f2 sj2 = {sj, sj};
#pragma unroll
            for (int hh = 0; hh < 2; ++hh)
#pragma unroll
                for (int k = 0; k < 4; ++k) { const unsigned dw = vr[j][hh][k]; const f2 vv = {bflo(dw), bfhi(dw)}; acc[4 * hh + k] = vv * sj2 + acc[4 * hh + k]; }
        }
    }
    }
    float xr[16];
    const float* xrow = X + (size_t)tok * 1024 + 16 * lane;
    float* xorow = p.out + (size_t)tok * 1024 + 16 * lane;
    const float* g2 = modl + (size_t)b * 6144 + 5 * 1024 + 16 * lane;
    float ss = 0;
#pragma unroll
    for (int q4 = 0; q4 < 4; ++q4) {
        const float4 xv = *(const float4*)(xrow + 4 * q4), gv = *(const float4*)(g2 + 4 * q4);
        float4 o; o.x = xv.x + gv.x * acc[2 * q4].x; o.y = xv.y + gv.y * acc[2 * q4].y; o.z = xv.z + gv.z * acc[2 * q4 + 1].x; o.w = xv.w + gv.w * acc[2 * q4 + 1].y;
        if (l == 0) *(float4*)(xorow + 4 * q4) = o;
        xr[4 * q4] = o.x; xr[4 * q4 + 1] = o.y; xr[4 * q4 + 2] = o.z; xr[4 * q4 + 3] = o.w;
        ss += o.x * o.x + o.y * o.y + o.z * o.z + o.w * o.w;
    }
    ss = wave_sum(ss);
    const float r = rsqrtf(ss * (1.f / 1024.f) + 1e-6f);
    if (l == 1) {
#pragma unroll
        for (int q4 = 0; q4 < 4; ++q4) {
            const float4 gv = *(const float4*)(p.in[28] + 16 * lane + 4 * q4);
            float4 o; o.x = xr[4 * q4] * r * gv.x; o.y = xr[4 * q4 + 1] * r * gv.y; o.z = xr[4 * q4 + 2] * r * gv.z; o.w = xr[4 * q4 + 3] * r * gv.w;
            *(float4*)(xorow + 4 * q4) = o;
        }
    } else {
        const float* g = p.in[2] + 1024 + 16 * lane; const float* mod1 = (const float*)(wsb(p) + WS_MOD) + ((size_t)4 + b) * 6144 + 16 * lane;
        bf16* hrow = (bf16*)(wsb(p) + WS_H2) + (size_t)tok * 1024 + 16 * lane;
        float hv[16];
#pragma unroll
        for (int q4 = 0; q4 < 4; ++q4) {
            const float4 gg = *(const float4*)(g + 4 * q4), s1 = *(const float4*)(mod1 + 1024 + 4 * q4), s0 = *(const float4*)(mod1 + 4 * q4);
            hv[4 * q4] = xr[4 * q4] * r * gg.x * (1.f + s1.x) + s0.x; hv[4 * q4 + 1] = xr[4 * q4 + 1] * r * gg.y * (1.f + s1.y) + s0.y;
            hv[4 * q4 + 2] = xr[4 * q4 + 2] * r * gg.z * (1.f + s1.z) + s0.z; hv[4 * q4 + 3] = xr[4 * q4 + 3] * r * gg.w * (1.f + s1.w) + s0.w;
        }
        u32x4 o0, o1;
        o0.x = cvt_pk_bf16(hv[0], hv[1]); o0.y = cvt_pk_bf16(hv[2], hv[3]); o0.z = cvt_pk_bf16(hv[4], hv[5]); o0.w = cvt_pk_bf16(hv[6], hv[7]);
        o1.x = cvt_pk_bf16(hv[8], hv[9]); o1.y = cvt_pk_bf16(hv[10], hv[11]); o1.z = cvt_pk_bf16(hv[12], hv[13]); o1.w = cvt_pk_bf16(hv[14], hv[15]);
        *(u32x4*)(hrow) = o0; *(u32x4*)(hrow + 8) = o1;
    }
}

constexpr int SMEM_BYTES = LDS_BYTES;
#ifndef REP_MASK
#define REP_MASK 0xffff
#endif
#ifndef REP_ID
#define REP_ID -1
#endif
#ifndef REP_N
#define REP_N 1
#endif
#define NREP(id) ((id) == REP_ID ? REP_N : 1)
__global__ void __launch_bounds__(512, 2) fwd_megakernel(Params p) {
    unsigned char* smem = g_lds;
    const int tid = threadIdx.x, half = __builtin_amdgcn_readfirstlane(tid >> 8);
    const int Gp = gridDim.x, bidp = blockIdx.x;
    const int G = Gp * 2, bid = bidp + half * Gp;
    unsigned char* sm = smem + half * 65536;
    volatile int* qslot = (volatile int*)(smem + LDS_CTL + 16) + half;
    if (tid < 64) ((unsigned*)(smem + LDS_CTL))[tid] = 0u;
    __syncthreads();
    unsigned* ctl = (unsigned*)(wsb(p) + WS_CTL);
    unsigned* qctr = ctl + 4096;
    XcdBarrier bar = xcd_barrier_post(ctl, (volatile LAS unsigned*)(smem + LDS_CTL));
#define PHASE_PTRS unsigned char* ws = wsb(p); const bf16* H = (const bf16*)(ws + WS_H); bf16* PROJ = (bf16*)(ws + WS_PROJ); float* X = (float*)(ws + WS_X); const float* mod = (const float*)(ws + WS_MOD); (void)H; (void)PROJ; (void)X; (void)mod;
    int qn = 0;

    for (int rep = 0; rep < NREP(0); ++rep) {
            PHASE_PTRS
        constexpr int N_MOD = 192, N_LAYER = 768 + 1024 + 512 + 512 + 1024 + 1024 + 64, N_PK = 4, N_GW = 128, N_PW = 8;
        constexpr int NV = N_MOD + 2 * N_LAYER + N_PK + N_GW + N_PW;
        for (int vb = bid; vb < NV; vb += G) {
            int v = vb;
            if (v < N_MOD) { it_mod(p, v, sm); continue; }
            v -= N_MOD;
            if (v < 2 * N_LAYER) {
                const int l = v / N_LAYER; v -= l * N_LAYER;
                bf16* wtin = (bf16*)(ws + WS_WTIN) + (size_t)l * NPROJ * 1024;
                const float* win = p.in[6] + (size_t)l * 1024 * 1732;
                bf16* wtout = (bf16*)(ws + WS_WTOUT) + (size_t)l * 1024 * KMIX;
                const float* wout = p.in[22] + (size_t)l * 1024 * 1024;
                if (v < 768) { it_transpose(TrArgs{win, 1732, 0, 1732, wtin, 1024, 0, 1024, 768, 0, nullptr}, v, sm); }
                else if ((v -= 768) < 1024) { it_transpose(TrArgs{win, 1732, 0, 1732, wtin + (size_t)768 * 1024, 1024, 0, 1024, 1024, 1, p.in[20] + (size_t)l * 8 * 64 * 128}, v, sm); }
                else if ((v -= 1024) < 512) { it_transpose(TrArgs{win, 1732, 1280, 1732, wtin + (size_t)1792 * 1024, 1024, 0, 1024, 512, 0, nullptr}, v, sm); }
                else if ((v -= 512) < 512) { it_transpose(TrArgs{wout, 1024, 0, 1024, wtout, KMIX, 0, 512, 1024, 0, nullptr}, v, sm); }
                else if ((v -= 512) < 1024) { it_transpose(TrArgs{wout, 1024, 0, 1024, wtout, KMIX, 512, 1024, 1024, 2, p.in[21] + (size_t)l * 8 * 128 * 64}, v, sm); }
                else if ((v -= 1024) < 1024) { it_transpose(TrArgs{p.in[23] + (size_t)l * 1024 * 1024, 1024, 0, 1024, (bf16*)(ws + WS_WTQ) + (size_t)l * 1024 * 1024, 1024, 0, 1024, 1024, 0, nullptr}, v, sm); }
                else { v -= 1024; it_transpose(TrArgs{p.in[15] + (size_t)l * 256 * 256, 256, 0, 256, (bf16*)(ws + WS_WTGLU) + (size_t)l * 256 * 256, 256, 0, 256, 256, 0, nullptr}, v, sm); }
                continue;
            }
            v -= 2 * N_LAYER;
            if (v < N_PK) { const int l = v >> 1, w = v & 1; conv_chunk(p.in[24 + w] + (size_t)l * 8192, (bf16*)(ws + WS_PK) + (size_t)l * 16384 + w * 8192, 0, 1024); continue; }
            v -= N_PK;
            if (v < N_GW) { it_gw(p, v); continue; }
            v -= N_GW;
            it_ssm_pw(p, v);
        }
        xcd_barrier(bar);
    }
    for (int rep = 0; rep < NREP(1); ++rep) {
            PHASE_PTRS
        constexpr int N_NORM = NTOK / 4, N_TAB = 4096, N_KT = 256;
        for (int vb = bid; vb < N_NORM + N_TAB + N_KT; vb += G) {
            if (vb < N_KT) { it_ssm_kt(p, vb, sm); continue; }
            if (vb - N_KT < N_NORM) {
                const int t_ = opq_tid(); const int row = (vb - N_KT) * 4 + (t_ >> 6);
                const float* m0 = (const float*)(wsb(p) + WS_MOD) + (size_t)(row >> 12) * 6144;
                norm_mod_row(p.in[0] + (size_t)row * 1024, p.in[2], m0, m0 + 1024, (bf16*)(wsb(p) + WS_H) + (size_t)row * 1024, t_ & 63);
            } else {
                const size_t base = (size_t)(vb - N_KT - N_NORM) * 2048;
                for (int e = 0; e < 8; ++e) ssm_tab_entry(p, base + e * 256 + opq_tid());
            }
        }
        xcd_barrier(bar);
    }

    for (int l = 0; l < 2; ++l) {
        const float* xin = l == 0 ? p.in[0] : p.out;
        for (int rep = 0; rep < NREP(2 + 8 * l); ++rep) {
            PHASE_PTRS
            const bf16* Hin = l == 0 ? H : (const bf16*)(ws + WS_H2);
            pg8::StaticOrder S; S.init(NTOK, NPROJ, Gp, bidp);
            pg8::gemm_phase<Epi256<EpiBf16>, pg8::StaticOrder, true, true>((PG8_LAS unsigned char*)g_lds, pg8::Gemm{Hin, (const bf16*)(ws + WS_WTIN) + (size_t)l * NPROJ * 1024, NTOK, NPROJ, 1024}, S, Epi256<EpiBf16>{EpiBf16{PROJ, NPROJ}});
            xcd_barrier(bar);
        }
        for (int rep = 0; rep < NREP(3 + 8 * l); ++rep) {
            PHASE_PTRS
            unsigned* ctr = qctr + 64 * (qn++);
            for (;;) {
                const int it = q_next(ctr, qslot);
                if (it >= 2048) break;
                const bool extra = rep + 1 < NREP(3 + 8 * l);
                const int ty = it < 1024 ? 0 : it < 1536 ? 1 : it < 1792 ? 2 : 3;
                if (extra && !((REP_MASK >> ty) & 1)) continue;
                if (it < 1024) it_dsa_index_select(p, it, sm, extra ? ((REP_MASK >> 4) & 3) : 3);
                else if (it < 1536) it_gmlp(p, l, it - 1024, sm);
                else if (it < 1792) it_ssm_a(p, l, it - 1536);
                else it_kvn(p, l, it - 1792);
            }
            xcd_barrier(bar);
        }
        for (int rep = 0; rep < NREP(4 + 8 * l); ++rep) {
            PHASE_PTRS
            unsigned* ctr = qctr + 64 * (qn++);
            for (;;) {
                const int it = q_next(ctr, qslot);
                if (it >= 256 + 1024 + 512) break;
                { const bool extra = rep + 1 < NREP(4 + 8 * l); const int ty = it < 256 ? 0 : it < 1280 ? 1 : 2; if (extra && !((REP_MASK >> (8 + ty)) & 1)) continue; }
                if (it < 256) it_ssm_c(p, l, it, sm);
                else if (it < 1280) it_dsa_attn(p, it - 256, sm);
                else {
                    const int v = it - 1280, w = v >> 8, ch = v & 255;
                    if (!(PEER_FP8_MASK & (1 << l))) conv_chunk(p.in[26 + w] + (size_t)l * NEXP * 1024, (bf16*)(ws + (w ? WS_VB : WS_UB)), (size_t)ch * 8192, 8192);
                    else conv_chunk_fp8(p.in[26 + w] + (size_t)l * NEXP * 1024, ws + (w ? WS_VB : WS_UB), (size_t)ch * 4096, 4096, w ? V_SCALE : U_SCALE);
                }
            }
            xcd_barrier(bar);
        }
        for (int rep = 0; rep < NREP(5 + 8 * l); ++rep) {
            PHASE_PTRS
            const EpiGlu epi{(const bf16*)(ws + WS_YG), p.in[16] + l * 256, (bf16*)(ws + WS_MIX)};
            const bf16* Bt = (const bf16*)(ws + WS_WTGLU) + (size_t)l * 256 * 256;
            for (int t = bid; t < (NTOK / 64) * 2; t += G) gemm_tile64((const bf16*)(ws + WS_YG), 256, Bt, 256, 256, (t >> 1) * 64, (t & 1) * 128, (bf16*)sm, epi);
            xcd_barrier(bar);
        }
        for (int rep = 0; rep < NREP(6 + 8 * l); ++rep) {
            PHASE_PTRS
            pg8::StaticOrder S; S.init(NTOK, 1024, Gp, bidp);
            pg8::gemm_phase<Epi256<EpiResid>, pg8::StaticOrder, false, true>((PG8_LAS unsigned char*)g_lds, pg8::Gemm{(const bf16*)(ws + WS_MIX), (const bf16*)(ws + WS_WTOUT) + (size_t)l * 1024 * KMIX, NTOK, 1024, KMIX}, S, Epi256<EpiResid>{EpiResid{xin, X, mod + (size_t)l * 4 * 6144 + 2048}});
            xcd_barrier(bar);
        }
        for (int rep = 0; rep < NREP(7 + 8 * l); ++rep) {
            PHASE_PTRS
            for (int vb = bid; vb < NTOK / 4; vb += G) {
                const int t_ = opq_tid(); const int row = vb * 4 + (t_ >> 6);
                const float* m0 = (const float*)(wsb(p) + WS_MOD) + ((size_t)l * 4 + (row >> 12)) * 6144 + 3072;
                norm_mod_row((const float*)(wsb(p) + WS_X) + (size_t)row * 1024, p.in[3] + l * 1024, m0, m0 + 1024, (bf16*)(wsb(p) + WS_H) + (size_t)row * 1024, t_ & 63);
            }
            xcd_barrier(bar);
        }
        for (int rep = 0; rep < NREP(8 + 8 * l); ++rep) {
            PHASE_PTRS
            pg8::StaticOrder S; S.init(NTOK, 1024, Gp, bidp);
            pg8::gemm_phase<Epi256<EpiBf16>, pg8::StaticOrder, false, true>((PG8_LAS unsigned char*)g_lds, pg8::Gemm{H, (const bf16*)(ws + WS_WTQ) + (size_t)l * 1024 * 1024, NTOK, 1024, 1024}, S, Epi256<EpiBf16>{EpiBf16{PROJ, 1024}});
            xcd_barrier(bar);
        }
        for (int rep = 0; rep < NREP(9 + 8 * l); ++rep) {
            PHASE_PTRS
            PeerLds2& S = *(PeerLds2*)sm;
            hsync();
            const int t_ = opq_tid(), lane_ = t_ & 63, wave_ = t_ >> 6;
            for (int wb = bid * 4 + wave_; wb < NTOK / 8; wb += G * 4) {
                peer_retrieve(p, l, wb * 8, S, lane_, wave_);
                for (int tt = 0; tt < 8; ++tt) {
                    if (PEER_FP8_MASK & (1 << l)) peer_experts<true>(p, l, wb * 8 + tt, tt, S, lane_, wave_);
                    else peer_experts<false>(p, l, wb * 8 + tt, tt, S, lane_, wave_);
                }
            }
            if (l == 0 || rep + 1 < NREP(9 + 8 * l)) xcd_barrier(bar);
        }
    }
}

extern "C" void kernel_launch(void* const* d_in, const int* in_sizes, int n_in, void* d_out, int out_size, void* d_ws, size_t ws_size, hipStream_t stream) {
    if (n_in != 29 || ws_size < WS_END) { fprintf(stderr, "kernel_launch: bad args (n_in %d, ws %zu, need %zu)\n", n_in, ws_size, (size_t)WS_END); return; }
    static int grid = 0;
    if (grid == 0) {
        int dev = 0, cus = 0, per_cu = 0;
        if (hipGetDevice(&dev) != hipSuccess || hipDeviceGetAttribute(&cus, hipDeviceAttributeMultiprocessorCount, dev) != hipSuccess) { grid = -1; return; }
        if (hipFuncSetAttribute((const void*)fwd_megakernel, hipFuncAttributeMaxDynamicSharedMemorySize, LDS_BYTES) != hipSuccess) { fprintf(stderr, "kernel_launch: hipFuncSetAttribute failed\n"); grid = -1; return; }
        if (hipOccupancyMaxActiveBlocksPerMultiprocessor(&per_cu, (const void*)fwd_megakernel, 512, LDS_BYTES) != hipSuccess || per_cu < 1) { fprintf(stderr, "kernel_launch: occupancy query failed (%d)\n", per_cu); grid = -1; return; }
        grid = cus;
    }
    if (grid < 0) return;
    if (hipMemsetAsync((char*)d_ws + WS_CTL, 0, 65536, stream) != hipSuccess) { fprintf(stderr, "kernel_launch: memset failed\n"); return; }
    Params p{};
    for (int i = 0; i < 29; ++i) p.in[i] = (const float*)d_in[i];
    p.out = (float*)d_out; p.ws = (unsigned char*)d_ws;
    void* args[] = {&p};
    const hipError_t e = hipLaunchCooperativeKernel((const void*)fwd_megakernel, dim3(grid), dim3(512), args, LDS_BYTES, stream);
    if (e != hipSuccess) fprintf(stderr, "kernel_launch: cooperative launch failed: %s (grid %d)\n", hipGetErrorString(e), grid);
}
```

```cpp
#include <hip/hip_runtime.h>
#include <cstdint>
#include <cstdio>

typedef unsigned short bf16;
typedef short bf16x8 __attribute__((ext_vector_type(8)));
typedef short s16x4 __attribute__((ext_vector_type(4)));
typedef float f32x4 __attribute__((ext_vector_type(4)));
typedef unsigned u32x4 __attribute__((ext_vector_type(4)));
typedef unsigned u32x2 __attribute__((ext_vector_type(2)));
typedef __bf16 bf2 __attribute__((ext_vector_type(2)));
#define DI __device__ __forceinline__
#define MFMA16(a, b, c) __builtin_amdgcn_mfma_f32_16x16x32_bf16((a), (b), (c), 0, 0, 0)

constexpr int DM = 1024, NB = 4, SEQ = 4096, NTOK = NB * SEQ;
constexpr int NPROJ = 2304;
constexpr int C_UA = 0, C_UB = 256, C_VB = 512, C_QA = 768, C_CKV = 1792, C_QI = 1920, C_KI = 2176, C_WI = 2240;
constexpr int KMIX = 1536;
constexpr int NEXP = 16384;
constexpr size_t SCORES_PER_BATCH = (size_t)4096 * 2080;

constexpr size_t al256(size_t x) { return (x + 255) & ~(size_t)255; }
constexpr size_t WS_CTL = 0;
constexpr size_t WS_MOD = 65536;
constexpr size_t WS_WTIN = al256(WS_MOD + 2 * 4 * 6144 * 4);
constexpr size_t WS_WTOUT = al256(WS_WTIN + (size_t)2 * NPROJ * 1024 * 2);
constexpr size_t WS_WTQ = al256(WS_WTOUT + (size_t)2 * 1024 * KMIX * 2);
constexpr size_t WS_WTGLU = al256(WS_WTQ + (size_t)2 * 1024 * 1024 * 2);
constexpr size_t WS_GW = al256(WS_WTGLU + (size_t)2 * 256 * 256 * 2);
constexpr size_t WS_PK = al256(WS_GW + (size_t)2 * 4 * 128 * 128 * 2);
constexpr size_t WS_PW = al256(WS_PK + (size_t)2 * 2 * 128 * 64 * 2);
constexpr size_t WS_BB = al256(WS_PW + (size_t)2 * 16 * 65 * 64 * 2 * 4);
constexpr size_t WS_E = al256(WS_BB + (size_t)2 * 16 * 64 * 16 * 2 * 4);
constexpr size_t WS_G = al256(WS_E + (size_t)2 * 16 * 128 * 1024 * 2);
constexpr size_t WS_KT = al256(WS_G + (size_t)2 * 16 * 1024 * 128 * 2);
constexpr size_t WS_UB = al256(WS_KT + (size_t)2 * 16 * 64 * 256 * 2);
constexpr size_t WS_VB = al256(WS_UB + (size_t)NEXP * 1024 * 2);
constexpr size_t WS_H = al256(WS_VB + (size_t)NEXP * 1024 * 2);
constexpr size_t WS_PROJ = al256(WS_H + (size_t)NTOK * 1024 * 2);
constexpr size_t WS_SLOC = al256(WS_PROJ + (size_t)NTOK * NPROJ * 2);
constexpr size_t WS_YG = al256(WS_SLOC + (size_t)256 * 16 * 128 * 4);
constexpr size_t WS_KVN = al256(WS_YG + (size_t)NTOK * 256 * 2);
constexpr size_t WS_SEL = al256(WS_KVN + (size_t)NTOK * 128 * 2);
constexpr size_t WS_MIX = al256(WS_SEL + (size_t)NTOK * 256 * 2);
constexpr size_t WS_X = al256(WS_MIX + (size_t)NTOK * KMIX * 2);
constexpr size_t WS_SCORES = al256(WS_X + (size_t)NTOK * 1024 * 4);
constexpr size_t WS_H2 = al256(WS_SCORES + (size_t)NB * SCORES_PER_BATCH * 4);
constexpr size_t WS_END = al256(WS_H2 + (size_t)NTOK * 1024 * 2);

struct Params {
    const float* in[29];
    float* out;
    unsigned char* ws;
};

typedef __bf16 bf2v_t __attribute__((ext_vector_type(2)));
typedef float f2v_t __attribute__((ext_vector_type(2)));
DI unsigned cvt_pk_bf16(float lo, float hi) { const f2v_t f = {lo, hi}; const bf2v_t r = __builtin_convertvector(f, bf2v_t); return __builtin_bit_cast(unsigned, r); }
DI bf16 f2bf(float x) { return (bf16)(cvt_pk_bf16(x, 0.f) & 0xffffu); }
DI float bf2f(bf16 b) { return __uint_as_float((unsigned)b << 16); }
DI float bflo(unsigned u) { return __uint_as_float(u << 16); }
DI float bfhi(unsigned u) { return __uint_as_float(u & 0xffff0000u); }
DI float dot2bf(unsigned a, unsigned b, float c) { return __builtin_amdgcn_fdot2_f32_bf16(__builtin_bit_cast(bf2, a), __builtin_bit_cast(bf2, b), c, false); }
DI float gelu_tanh(float x) { const float u = 0.7978845608028654f * (x + 0.044715f * x * x * x); const float e = __expf(2.f * u); const float t = 1.f - 2.f / (e + 1.f); return 0.5f * x * (1.f + t); }
DI float sigmoidf(float x) { return 1.f / (1.f + __expf(-x)); }
DI float wave_sum(float v) { for (int o = 32; o > 0; o >>= 1) v += __shfl_xor(v, o); return v; }
DI unsigned wave_sum_u32(unsigned v) {
    int x = (int)v;
    x += __builtin_amdgcn_update_dpp(0, x, 0xB1, 0xf, 0xf, true);
    x += __builtin_amdgcn_update_dpp(0, x, 0x4E, 0xf, 0xf, true);
    x += __builtin_amdgcn_update_dpp(0, x, 0x141, 0xf, 0xf, true);
    x += __builtin_amdgcn_update_dpp(0, x, 0x140, 0xf, 0xf, true);
    x += __builtin_amdgcn_update_dpp(0, x, 0x142, 0xa, 0xf, true);
    x += __builtin_amdgcn_update_dpp(0, x, 0x143, 0xc, 0xf, true);
    return (unsigned)__builtin_amdgcn_readlane(x, 63);
}
DI unsigned wave_scan_incl_u32(unsigned v) {
    int x = (int)v;
    x += __builtin_amdgcn_update_dpp(0, x, 0x111, 0xf, 0xf, true);
    x += __builtin_amdgcn_update_dpp(0, x, 0x112, 0xf, 0xf, true);
    x += __builtin_amdgcn_update_dpp(0, x, 0x114, 0xf, 0xf, true);
    x += __builtin_amdgcn_update_dpp(0, x, 0x118, 0xf, 0xf, true);
    x += __builtin_amdgcn_update_dpp(0, x, 0x142, 0xa, 0xf, true);
    x += __builtin_amdgcn_update_dpp(0, x, 0x143, 0xc, 0xf, true);
    return (unsigned)x;
}
DI unsigned fkey(float v) { const unsigned u = __float_as_uint(v); return (u & 0x80000000u) ? ~u : (u | 0x80000000u); }
DI unsigned unkey(unsigned k) { return (k & 0x80000000u) ? (k & 0x7fffffffu) : ~k; }
DI bf16x8 ld16(const void* p) { return *(const bf16x8*)p; }
DI bf16x8 zero8() { bf16x8 z = {0, 0, 0, 0, 0, 0, 0, 0}; return z; }


#define XB_TMO      128
#define XB_XCNT(j)  (256  + 64 * (j))
#define XB_XSUB(j)  (1280 + 64 * (j))
#define XB_XGEN(j)  (2304 + 64 * (j))
#define XB_TOP      3328
#define XB_TOPGEN   3392
#define XCD_BAR_WORDS 3456
#define XB_SPIN_CAP (1u << 22)
#define LAS __attribute__((address_space(3)))
DI unsigned xb_ld(unsigned* p)              { return __hip_atomic_load(p, __ATOMIC_RELAXED, __HIP_MEMORY_SCOPE_AGENT); }
DI unsigned xb_add(unsigned* p, unsigned v) { return __hip_atomic_fetch_add(p, v, __ATOMIC_RELAXED, __HIP_MEMORY_SCOPE_AGENT); }
DI unsigned xb_xcc_id() { return (unsigned)__builtin_amdgcn_s_getreg((3 << 11) | 20) & 0xFu; }
#define XB_SPIN(cond, bar) do { unsigned _sp = 0; while (cond) { __builtin_amdgcn_s_sleep(1); \
    if ((++_sp & 255u) == 0u) { if (xb_ld(&(bar)[XB_TMO])) break; if (_sp > XB_SPIN_CAP) { atomicAdd(&(bar)[XB_TMO], 1u); break; } } } } while (0)
struct XcdBarrier { unsigned* bar; unsigned x; volatile LAS unsigned* st; };
DI XcdBarrier xcd_barrier_post(unsigned* bar, volatile LAS unsigned* st) {
    XcdBarrier b; b.bar = bar; b.x = xb_xcc_id(); b.st = st;
    if (threadIdx.x == 0) (void)xb_add(&bar[XB_XCNT(b.x)], 1u);
    return b;
}
DI void xcd_barrier_complete(unsigned* bar, unsigned x, unsigned& nloc, unsigned& nx) {
    const unsigned G = gridDim.x * gridDim.y * gridDim.z;
    unsigned sum, cnt, mine, sp = 0u;
    for (;;) {
        sum = 0u; cnt = 0u; mine = 0u;
#pragma unroll
        for (unsigned j = 0; j < 16; ++j) { const unsigned c = xb_ld(&bar[XB_XCNT(j)]); sum += c; cnt += (c > 0u) ? 1u : 0u; mine = (j == x) ? c : mine; }
        if (sum == G) break;
        __builtin_amdgcn_s_sleep(1);
        if ((++sp & 255u) == 0u) { if (xb_ld(&bar[XB_TMO])) break; if (sp > XB_SPIN_CAP) { atomicAdd(&bar[XB_TMO], 1u); break; } }
    }
    nloc = mine > 0u ? mine : 1u; nx = cnt > 0u ? cnt : 1u;
}
DI void xcd_barrier(const XcdBarrier& b) {
    asm volatile("s_waitcnt vmcnt(0)" ::: "memory");
    __syncthreads();
    if (threadIdx.x == 0) {
        unsigned* bar = b.bar;
        __builtin_amdgcn_s_waitcnt(0);
        unsigned nloc = b.st[0], nx = b.st[1];
        if (nloc == 0u) { xcd_barrier_complete(bar, b.x, nloc, nx); b.st[0] = nloc; b.st[1] = nx; }
        const unsigned old = xb_add(&bar[XB_XSUB(b.x)], 1u);
        const unsigned gen = old / nloc;
        if (old + 1u == (gen + 1u) * nloc) {
            __builtin_amdgcn_fence(__ATOMIC_RELEASE, "agent");
            asm volatile("s_waitcnt vmcnt(0)" ::: "memory");
            const unsigned og = xb_add(&bar[XB_TOP], 1u);
            const unsigned tg = og / nx;
            if (og + 1u == (tg + 1u) * nx) xb_add(&bar[XB_TOPGEN], 1u);
            else XB_SPIN(xb_ld(&bar[XB_TOPGEN]) == tg, bar);
            __builtin_amdgcn_fence(__ATOMIC_ACQUIRE, "agent");
            xb_add(&bar[XB_XGEN(b.x)], 1u);
            asm volatile("s_waitcnt vmcnt(0)" ::: "memory");
        } else {
            XB_SPIN(xb_ld(&bar[XB_XGEN(b.x)]) == gen, bar);
            __builtin_amdgcn_fence(__ATOMIC_ACQUIRE, "agent");
            asm volatile("s_waitcnt vmcnt(0)" ::: "memory");
        }
    }
    __syncthreads();
}
typedef __attribute__((address_space(1))) unsigned char g_uc;
DI unsigned char* wsb(const Params& p) {
    typedef const unsigned long long __attribute__((address_space(4))) karg_u64;
    const unsigned long long w = *(karg_u64*)((const char __attribute__((address_space(4)))*)__builtin_amdgcn_kernarg_segment_ptr() + __builtin_offsetof(Params, ws));
    unsigned lo = (unsigned)w, hi = (unsigned)(w >> 32);
    asm volatile("" : "+s"(lo), "+s"(hi));
    return (unsigned char*)(g_uc*)(((unsigned long long)hi << 32) | lo);
}
extern __shared__ __attribute__((aligned(1024))) unsigned char g_lds[];
constexpr int LDS_CTL = 131072, LDS_BYTES = 131072 + 256;
DI int opq_tid() { int t = (int)(threadIdx.x & 255u); asm volatile("" : "+v"(t)); return t; }
DI void hsync() {
    asm volatile("s_waitcnt lgkmcnt(0)" ::: "memory");
    LAS unsigned* ctr = (LAS unsigned*)(g_lds + LDS_CTL + 32) + (threadIdx.x >> 8);
    unsigned old = 0u;
    if ((threadIdx.x & 63u) == 0u) old = __hip_atomic_fetch_add(ctr, 1u, __ATOMIC_RELAXED, __HIP_MEMORY_SCOPE_WORKGROUP);
    old = (unsigned)__builtin_amdgcn_readfirstlane((int)old);
    const unsigned target = (old & ~3u) + 4u;
    while (__hip_atomic_load(ctr, __ATOMIC_RELAXED, __HIP_MEMORY_SCOPE_WORKGROUP) < target) __builtin_amdgcn_s_sleep(1);
    asm volatile("" ::: "memory");
}
DI void hsync_g() { asm volatile("s_waitcnt vmcnt(0)" ::: "memory"); hsync(); }
DI int q_next(unsigned* ctr, volatile int* slot) {
    hsync();
    if ((threadIdx.x & 255u) == 0u) *slot = (int)__hip_atomic_fetch_add(ctr, 1u, __ATOMIC_RELAXED, __HIP_MEMORY_SCOPE_AGENT);
    hsync();
    return *slot;
}
DI void it_mod(const Params& p, int vb, unsigned char* sm) {
    float (*ca)[1024] = (float (*)[1024])sm;
    float (*part)[4][64] = (float (*)[4][64])(sm + 16384);
    const float* c = p.in[1];
    const int tid = opq_tid();
    hsync();
    for (int i = tid; i < 4096; i += 256) { const float v = c[i]; ca[i >> 10][i & 1023] = v / (1.f + __expf(-v)); }
    hsync();
    const int col = tid & 63, sl = tid >> 6;
    const int idx = vb * 64 + col;
    const int l = idx / 6144, n = idx % 6144;
    const float* w = p.in[4] + (size_t)l * 1024 * 6144 + n + (size_t)(256 * sl) * 6144;
    float a0 = 0, a1 = 0, a2 = 0, a3 = 0;
#pragma unroll 32
    for (int k = 0; k < 256; ++k) { const float wv = w[(size_t)k * 6144]; const int kk = 256 * sl + k; a0 += ca[0][kk] * wv; a1 += ca[1][kk] * wv; a2 += ca[2][kk] * wv; a3 += ca[3][kk] * wv; }
    part[sl][0][col] = a0; part[sl][1][col] = a1; part[sl][2][col] = a2; part[sl][3][col] = a3;
    hsync();
    {
        const int bb = tid >> 6;
        const float v = part[0][bb][col] + part[1][bb][col] + part[2][bb][col] + part[3][bb][col] + p.in[5][l * 6144 + n];
        ((float*)(wsb(p) + WS_MOD))[((size_t)l * 4 + bb) * 6144 + n] = v;
    }
}

struct TrArgs { const float* src; int lds, coff, nvalid; bf16* dst; int ldd, doff; int K, N; int mode; const float* aux; };
DI void it_transpose(const TrArgs& a, int vb4, unsigned char* sm) {
    const int tid = opq_tid(), lane = tid & 63, wave = tid >> 6, tx = lane & 31, ty = lane >> 5;
    float (*t)[33] = (float (*)[33])(sm + wave * 4224);
    float (*ta)[65] = (float (*)[65])(sm + 16896 + wave * 8320);
    float (*tb)[33] = (float (*)[33])(sm + 16896 + 33280);
    const int nk = a.K / 32;
    const int vb = vb4 * 4 + wave, kt = vb % nk, nt = vb / nk;
    hsync();
    if (a.mode == 0) {
        float v[16];
#pragma unroll
        for (int i = 0; i < 16; ++i) { const int k = kt * 32 + ty + 2 * i, n = nt * 32 + tx; v[i] = (n + a.coff < a.nvalid) ? a.src[(size_t)k * a.lds + n + a.coff] : 0.f; }
#pragma unroll
        for (int i = 0; i < 16; ++i) t[ty + 2 * i][tx] = v[i];
    } else if (a.mode == 1) {
        const int h = (nt * 32) >> 7, r0 = (nt * 32) & 127;
        float va[32], vb_[8];
#pragma unroll
        for (int i = 0; i < 32; ++i) va[i] = a.src[(size_t)(kt * 32 + i) * a.lds + 768 + 64 * h + lane];
#pragma unroll
        for (int i = 0; i < 8; ++i) { const int e = tid + 256 * i, d = e >> 5, rr = e & 31; vb_[i] = a.aux[((size_t)h * 64 + d) * 128 + r0 + rr]; }
#pragma unroll
        for (int i = 0; i < 32; ++i) ta[i][lane] = va[i];
#pragma unroll
        for (int i = 0; i < 8; ++i) { const int e = tid + 256 * i; tb[e >> 5][e & 31] = vb_[i]; }
        hsync();
#pragma unroll 2
        for (int r = ty; r < 32; r += 2) { float s = 0; _Pragma("unroll 16") for (int d = 0; d < 64; ++d) s += ta[r][d] * tb[d][tx]; t[r][tx] = s * 0.125f; }
    } else {
        const int h = (kt * 32) >> 7, r0 = (kt * 32) & 127;
        float va[32], vb_[8];
#pragma unroll
        for (int i = 0; i < 32; ++i) va[i] = a.aux[((size_t)h * 128 + r0 + i) * 64 + lane];
#pragma unroll
        for (int i = 0; i < 8; ++i) { const int e = tid + 256 * i, d = e >> 5, nn = e & 31; vb_[i] = a.src[(size_t)(512 + 64 * h + d) * a.lds + nt * 32 + nn]; }
#pragma unroll
        for (int i = 0; i < 32; ++i) ta[i][lane] = va[i];
#pragma unroll
        for (int i = 0; i < 8; ++i) { const int e = tid + 256 * i; tb[e >> 5][e & 31] = vb_[i]; }
        hsync();
#pragma unroll 2
        for (int r = ty; r < 32; r += 2) { float s = 0; _Pragma("unroll 16") for (int d = 0; d < 64; ++d) s += ta[r][d] * tb[d][tx]; t[r][tx] = s; }
    }
    asm volatile("s_waitcnt lgkmcnt(0)" ::: "memory");
#pragma unroll
    for (int i = 0; i < 16; ++i) {
        const int r = ty + 2 * i, n = nt * 32 + r, k = kt * 32 + tx;
        a.dst[(size_t)n * a.ldd + a.doff + k] = f2bf(t[tx][r]);
    }
}
DI void conv_chunk(const float* __restrict__ src, bf16* __restrict__ dst, size_t i0, int n8) {
    for (int i = opq_tid(); i < n8; i += 256) {
        const float4 a = ((const float4*)src)[2 * (i0 + i)], b = ((const float4*)src)[2 * (i0 + i) + 1];
        u32x4 o; o.x = cvt_pk_bf16(a.x, a.y); o.y = cvt_pk_bf16(a.z, a.w); o.z = cvt_pk_bf16(b.x, b.y); o.w = cvt_pk_bf16(b.z, b.w);
        ((u32x4*)dst)[i0 + i] = o;
    }
}
DI void it_gw(const Params& p, int vb) {
    for (int e = 0; e < 4; ++e) {
        const int idx = vb * 1024 + e * 256 + opq_tid();
        const int s = idx & 127, t = (idx >> 7) & 127;
        const float v = (t >= 64 || s < 64) ? p.in[17][idx] : 0.f;
        ((bf16*)(wsb(p) + WS_GW))[idx] = f2bf(v);
    }
}
DI void it_ssm_pw(const Params& p, int vb) {
    const int idx = vb * 256 + opq_tid();
    const int pp = idx & 63, g = (idx >> 6) & 15, l = idx >> 10;
    const float lre = -__expf(p.in[7][idx]), lim = p.in[8][idx];
    const float dt = __expf(p.in[14][l * 16 + g]);
    float* pw = (float*)(wsb(p) + WS_PW) + ((size_t)(l * 16 + g) * 65) * 128;
    for (int d = 0; d <= 64; ++d) {
        const float mag = expf(lre * dt * (float)d); float sn, cs; sincosf(lim * dt * (float)d, &sn, &cs);
        pw[d * 128 + pp * 2] = mag * cs; pw[d * 128 + pp * 2 + 1] = mag * sn;
    }
    const float mag = expf(lre * dt); float sn, cs; sincosf(lim * dt, &sn, &cs);
    const float are = mag * cs, aim = mag * sn;
    const float den = lre * lre + lim * lim, P = are - 1.f, Q = aim;
    const float fre = (P * lre + Q * lim) / den, fim = (Q * lre - P * lim) / den;
    float* bb = (float*)(wsb(p) + WS_BB) + (size_t)idx * 32;
    for (int h = 0; h < 16; ++h) { const float br = p.in[9][(size_t)idx * 16 + h], bi = p.in[10][(size_t)idx * 16 + h]; bb[h * 2] = fre * br - fim * bi; bb[h * 2 + 1] = fre * bi + fim * br; }
}
DI void it_ssm_kt(const Params& p, int vb, unsigned char* sm) {
    float* cz = (float*)sm;
    float* bz = (float*)(sm + 8192);
    float* pz = (float*)(sm + 16384);
    const int tid = opq_tid();
    const int lg = vb >> 3, d0 = (vb & 7) * 8;
    const float* PW = (const float*)(wsb(p) + WS_PW) + ((size_t)lg * 65 + d0) * 128;
    const float* BB = (const float*)(wsb(p) + WS_BB) + (size_t)lg * 64 * 32;
    hsync();
    for (int i = tid; i < 1024; i += 256) { const int q = i >> 4, h = i & 15; cz[i * 2] = p.in[11][((size_t)lg * 16 + h) * 64 + q]; cz[i * 2 + 1] = p.in[12][((size_t)lg * 16 + h) * 64 + q]; }
    for (int i = tid; i < 2048; i += 256) bz[i] = BB[i];
    for (int i = tid; i < 1024; i += 256) pz[i] = PW[i];
    hsync();
    const int h = tid >> 4, hh = tid & 15;
    float acc[8];
#pragma unroll
    for (int d = 0; d < 8; ++d) acc[d] = 0.f;
    for (int q = 0; q < 64; ++q) {
        const float cr = cz[(q * 16 + h) * 2], ci = cz[(q * 16 + h) * 2 + 1], br = bz[(q * 16 + hh) * 2], bi = bz[(q * 16 + hh) * 2 + 1];
        const float xr = cr * br - ci * bi, xi = cr * bi + ci * br;
#pragma unroll
        for (int d = 0; d < 8; ++d) acc[d] += xr * pz[(d * 64 + q) * 2] - xi * pz[(d * 64 + q) * 2 + 1];
    }
    bf16* KT = (bf16*)(wsb(p) + WS_KT) + ((size_t)lg * 64 + d0) * 256;
    if (d0 == 0 && h == hh) acc[0] += p.in[13][(size_t)lg * 16 + h];
#pragma unroll
    for (int d = 0; d < 8; ++d) KT[d * 256 + tid] = f2bf(acc[d]);
    hsync();
}
DI void ssm_tab_entry(const Params& p, size_t idx) {
    const size_t NE = (size_t)2 * 16 * 128 * 1024;
    const float* PW = (const float*)(wsb(p) + WS_PW); const float* BB = (const float*)(wsb(p) + WS_BB);
    if (idx < NE) {
        const int kk = idx & 1023, pp = (idx >> 10) & 127; const int lg = (int)(idx >> 17);
        const int i = kk >> 4, hh = kk & 15, pq = pp & 63, part = pp >> 6;
        const float* pw = PW + ((size_t)lg * 65 + (63 - i)) * 128 + pq * 2; const float* bb = BB + ((size_t)lg * 64 + pq) * 32 + hh * 2;
        const float v = part ? (pw[0] * bb[1] + pw[1] * bb[0]) : (pw[0] * bb[0] - pw[1] * bb[1]);
        ((bf16*)(wsb(p) + WS_E))[idx] = f2bf(v);
    } else if (idx < 2 * NE) {
        const size_t e = idx - NE; const int pp = e & 127, jh = (e >> 7) & 1023; const int lg = (int)(e >> 17);
        const int j = jh >> 4, h = jh & 15, pq = pp & 63, part = pp >> 6;
        const float* pw = PW + ((size_t)lg * 65 + (j + 1)) * 128 + pq * 2;
        const float cr = p.in[11][((size_t)lg * 16 + h) * 64 + pq], ci = p.in[12][((size_t)lg * 16 + h) * 64 + pq];
        const float v = part ? -(cr * pw[1] + ci * pw[0]) : (cr * pw[0] - ci * pw[1]);
        ((bf16*)(wsb(p) + WS_G))[e] = f2bf(v);
    } else {
        const size_t e = idx - 2 * NE; if (e >= (size_t)2 * 16 * 64 * 256) return;
        const int hh = e & 15, h = (e >> 4) & 15, d = (e >> 8) & 63; const int lg = (int)(e >> 14);
        const float* pw = PW + ((size_t)lg * 65 + d) * 128; const float* bb = BB + (size_t)lg * 64 * 32 + hh * 2;
        const float* cr = p.in[11] + ((size_t)lg * 16 + h) * 64; const float* ci = p.in[12] + ((size_t)lg * 16 + h) * 64;
        float s = 0;
        for (int q = 0; q < 64; ++q) { const float zr = pw[q * 2] * bb[q * 32] - pw[q * 2 + 1] * bb[q * 32 + 1], zi = pw[q * 2] * bb[q * 32 + 1] + pw[q * 2 + 1] * bb[q * 32]; s += cr[q] * zr - ci[q] * zi; }
        ((bf16*)(wsb(p) + WS_KT))[e] = f2bf(s);
    }
}
DI void norm_mod_row(const float* __restrict__ xrow, const float* __restrict__ g, const float* __restrict__ sh, const float* __restrict__ sc, bf16* __restrict__ hrow, int lane) {
    float4 v[4]; float ss = 0;
#pragma unroll
    for (int j = 0; j < 4; ++j) { v[j] = *(const float4*)(xrow + 4 * lane + 256 * j); ss += v[j].x * v[j].x + v[j].y * v[j].y + v[j].z * v[j].z + v[j].w * v[j].w; }
    ss = wave_sum(ss);
    const float r = rsqrtf(ss * (1.f / 1024.f) + 1e-6f);
#pragma unroll
    for (int j = 0; j < 4; ++j) {
        const int c = 4 * lane + 256 * j;
        const float4 gg = *(const float4*)(g + c), s1 = *(const float4*)(sc + c), s0 = *(const float4*)(sh + c);
        u32x2 o; o.x = cvt_pk_bf16(v[j].x * r * gg.x * (1.f + s1.x) + s0.x, v[j].y * r * gg.y * (1.f + s1.y) + s0.y);
        o.y = cvt_pk_bf16(v[j].z * r * gg.z * (1.f + s1.z) + s0.z, v[j].w * r * gg.w * (1.f + s1.w) + s0.w);
        *(u32x2*)(hrow + c) = o;
    }
}
namespace pg8 {
#define PG8_LAS __attribute__((address_space(3)))
typedef unsigned short bf16_t;
constexpr int BM = 256, BK = 64, HALF = 128, HTB = HALF * BK * 2  , STAGE_BYTES = 8 * HTB, NXCD = 8, WGM = 8;
__host__ __device__ __forceinline__ int lds_byte(int r, int c) { const int st = (r >> 4) * 2 + (c >> 5), rr = r & 15, cc = c & 31, ob = rr * 64 + cc * 2; return st * 1024 + (ob ^ (((ob >> 9) & 1) << 5)); }
__host__ __device__ __forceinline__ void stage_rc(int b, int& R, int& C) { const int st = b / 1024, sb = b % 1024, swz = sb ^ (((sb >> 9) & 1) << 5); R = (st >> 1) * 16 + swz / 64; C = (st & 1) * 32 + (swz % 64) / 2; }
__host__ __device__ __forceinline__ int perm32(int rho) { const int n = rho >> 4, i = rho & 15; return 8 * (i >> 2) + 4 * n + (i & 3); }

struct Unit { int pm, pn; };
struct Gemm { const bf16_t* A; const bf16_t* Bt; int M, N, K; };

struct StaticOrder {
    int nM, nN, nwg, G, c;
    __host__ __device__ void init(int M, int N, int G_, int c_) { nM = M / BM; nN = N / BM; nwg = nM * nN; G = G_; c = c_; }
    __host__ __device__ bool next(int i, Unit& u) const {
        const long L = (long)i * G + c; if (L >= nwg) return false;
        int wgid = (int)L; { const int q = nwg / NXCD, r = nwg % NXCD, xcd = wgid % NXCD, off = wgid / NXCD; wgid = (xcd < r ? xcd * (q + 1) : r * (q + 1) + (xcd - r) * q) + off; }
        const int nig = WGM * nN, gid = wgid / nig, fm = gid * WGM, gsz = (nM - fm) < WGM ? (nM - fm) : WGM;
        u.pm = fm + ((wgid % nig) % gsz); u.pn = (wgid % nig) / gsz; return true;
    }
    __device__ __forceinline__ void a_ready(const Unit&) const {}
    __device__ __forceinline__ void done(const Unit&) const {}
};

template <class Epi, class Sched, bool ALIGN_EPI = false, bool SP2 = false>
__device__ __forceinline__ void gemm_phase(PG8_LAS unsigned char* lds, const Gemm g, const Sched& S, const Epi& E) {
    int tid = (int)threadIdx.x; asm volatile("" : "+v"(tid));
    const int wid = __builtin_amdgcn_readfirstlane(tid >> 6), lane = tid & 63, wr = wid >> 2, wc = wid & 3, fr = lane & 15, fq = lane >> 4;
    const int K = g.K, nt = K / BK;
    unsigned voffA[2], voffB[2];
#pragma unroll
    for (int i = 0; i < 2; ++i) { int R, C; stage_rc(tid * 16 + i * 8192, R, C); const int Rb = Epi::PERM ? ((R & ~31) + perm32(R & 31)) : R;
        voffA[i] = (unsigned)(R * K + C) * 2u; voffB[i] = (unsigned)(Rb * K + C) * 2u; }
    const size_t kstep = (size_t)(BK * 2);
    const size_t hstep = (size_t)HALF * K * 2;
    const size_t tstep = 2 * hstep;
    const unsigned ldsw = (unsigned)wid * 1024u;
    const int aoff = lds_byte(wr * 64 + fr, fq * 8), boff = lds_byte(wc * 32 + fr, fq * 8);
#define PG8_SA(b, h) (((b) * 2 + (h)) * HTB)
#define PG8_SB(b, h) ((4 + (b) * 2 + (h)) * HTB)
#define PG8_STAGE(bufoff, gbase, voff) do { _Pragma("unroll") for (int _i = 0; _i < 2; ++_i) \
        __builtin_amdgcn_global_load_lds((const unsigned*)((const char*)(gbase) + (voff)[_i]), (PG8_LAS unsigned*)(lds + (bufoff) + ldsw + _i * 8192), 16, 0, 0); } while (0)
#define PG8_LDA(dst, b, h) do { _Pragma("unroll") for (int m = 0; m < 4; ++m) _Pragma("unroll") for (int k = 0; k < 2; ++k) dst[m][k] = *(const PG8_LAS bf16x8*)(lds + PG8_SA(b, h) + aoff + m * 2048 + k * 1024); } while (0)
#define PG8_LDB(dst, b, h) do { _Pragma("unroll") for (int n = 0; n < 2; ++n) _Pragma("unroll") for (int k = 0; k < 2; ++k) dst[n][k] = *(const PG8_LAS bf16x8*)(lds + PG8_SB(b, h) + boff + n * 2048 + k * 1024); } while (0)
#define PG8_MMA(ai, bj, At, Bt) do { __builtin_amdgcn_s_setprio(1); _Pragma("unroll") for (int m = 0; m < 4; ++m) _Pragma("unroll") for (int n = 0; n < 2; ++n) _Pragma("unroll") for (int k = 0; k < 2; ++k) \
        acc[ai][bj][m][n] = __builtin_amdgcn_mfma_f32_16x16x32_bf16(Bt[n][k], At[m][k], acc[ai][bj][m][n], 0, 0, 0); __builtin_amdgcn_s_setprio(0); } while (0)
#define PG8_WAIT_V(n) asm volatile("s_waitcnt vmcnt(" #n ")" ::: "memory")
#define PG8_WAIT_L(n) asm volatile("s_waitcnt lgkmcnt(" #n ")" ::: "memory")
#define PG8_BAR __builtin_amdgcn_s_barrier()
#define PG8_SCHED __builtin_amdgcn_sched_barrier(0)
    Unit cur, nxt; int ui = 0;
    if (!S.next(0, cur)) return;
    f32x4 acc[2][2][4][2];
#pragma unroll
    for (int a = 0; a < 2; ++a)
#pragma unroll
        for (int b = 0; b < 2; ++b)
#pragma unroll
            for (int m = 0; m < 4; ++m)
#pragma unroll
                for (int n = 0; n < 2; ++n) acc[a][b][m][n] = (f32x4){0.f, 0.f, 0.f, 0.f};
    bf16x8 At[4][2], B0[2][2], B1[2][2];
    const char* cA = (const char*)g.A + (size_t)cur.pm * tstep; const char* cB = (const char*)g.Bt + (size_t)cur.pn * tstep;
    S.a_ready(cur);
    if constexpr (SP2) {
        PG8_STAGE(PG8_SB(0, 0), cB, voffB); PG8_STAGE(PG8_SB(0, 1), cB + hstep, voffB); PG8_STAGE(PG8_SA(0, 0), cA, voffA); PG8_STAGE(PG8_SA(0, 1), cA + hstep, voffA);
        if (wr == 1) PG8_BAR;
        PG8_WAIT_V(2); PG8_BAR;
        PG8_STAGE(PG8_SB(1, 0), cB + kstep, voffB); PG8_STAGE(PG8_SA(1, 0), cA + kstep, voffA); PG8_STAGE(PG8_SB(1, 1), cB + hstep + kstep, voffB);
        PG8_WAIT_V(6); PG8_BAR;
    } else {
        PG8_STAGE(PG8_SB(0, 0), cB, voffB); PG8_STAGE(PG8_SA(0, 0), cA, voffA); PG8_STAGE(PG8_SB(0, 1), cB + hstep, voffB); PG8_STAGE(PG8_SA(0, 1), cA + hstep, voffA);
        if (wr == 1) PG8_BAR;
        PG8_WAIT_V(4); PG8_BAR;
        PG8_STAGE(PG8_SB(1, 0), cB + kstep, voffB); PG8_STAGE(PG8_SA(1, 0), cA + kstep, voffA); PG8_STAGE(PG8_SB(1, 1), cB + hstep + kstep, voffB);
        PG8_WAIT_V(6); PG8_BAR;
    }
    for (;;) {
        const bool has_next = S.next(ui + 1, nxt);
        const char* nA = has_next ? (const char*)g.A + (size_t)nxt.pm * tstep : cA; const char* nB = has_next ? (const char*)g.Bt + (size_t)nxt.pn * tstep : cB;
        for (int t = 0; t < nt; t += 2) {
            const bool last = (t == nt - 2);
            const char* a1 = cA + (size_t)(t + 1) * kstep;
            const char* a2 = last ? nA : cA + (size_t)(t + 2) * kstep; const char* b2 = last ? nB : cB + (size_t)(t + 2) * kstep;
            const char* a3 = a2 + kstep; const char* b3 = b2 + kstep;
            if (last && has_next) S.a_ready(nxt);
            if constexpr (SP2) {
            PG8_LDB(B0, 0, 0); PG8_LDB(B1, 0, 1); PG8_SCHED; PG8_LDA(At, 0, 0); PG8_STAGE(PG8_SA(1, 1), a1 + hstep, voffA);
            PG8_WAIT_V(8); PG8_WAIT_L(0); PG8_BAR; PG8_MMA(0, 0, At, B0); PG8_MMA(0, 1, At, B1); PG8_BAR; PG8_SCHED;
            PG8_LDA(At, 0, 1); PG8_STAGE(PG8_SB(0, 0), b2, voffB); PG8_STAGE(PG8_SB(0, 1), b2 + hstep, voffB); PG8_STAGE(PG8_SA(0, 0), a2, voffA);
            PG8_WAIT_V(8); PG8_WAIT_L(0); PG8_BAR; PG8_MMA(1, 0, At, B0); PG8_MMA(1, 1, At, B1); PG8_BAR; PG8_SCHED;
            PG8_LDB(B0, 1, 0); PG8_LDB(B1, 1, 1); PG8_SCHED; PG8_LDA(At, 1, 0); PG8_STAGE(PG8_SA(0, 1), a2 + hstep, voffA);
            PG8_WAIT_V(8); PG8_WAIT_L(0); PG8_BAR; PG8_MMA(0, 0, At, B0); PG8_MMA(0, 1, At, B1); PG8_BAR; PG8_SCHED;
            PG8_LDA(At, 1, 1); PG8_STAGE(PG8_SB(1, 0), b3, voffB); PG8_STAGE(PG8_SB(1, 1), b3 + hstep, voffB); PG8_STAGE(PG8_SA(1, 0), a3, voffA);
            PG8_WAIT_V(8); PG8_WAIT_L(0); PG8_BAR; PG8_MMA(1, 0, At, B0); PG8_MMA(1, 1, At, B1); PG8_BAR; PG8_SCHED;
            } else {
            PG8_LDB(B0, 0, 0); PG8_SCHED; PG8_LDA(At, 0, 0); PG8_STAGE(PG8_SA(1, 1), a1 + hstep, voffA);
            PG8_WAIT_L(8); PG8_BAR; PG8_WAIT_L(0); PG8_MMA(0, 0, At, B0); PG8_BAR; PG8_SCHED;
            PG8_LDB(B1, 0, 1); PG8_STAGE(PG8_SB(0, 0), b2, voffB);
            PG8_BAR; PG8_WAIT_L(0); PG8_MMA(0, 1, At, B1); PG8_BAR;
            PG8_LDA(At, 0, 1); PG8_STAGE(PG8_SA(0, 0), a2, voffA);
            PG8_BAR; PG8_WAIT_L(0); PG8_MMA(1, 0, At, B0); PG8_BAR; PG8_SCHED;
            PG8_STAGE(PG8_SB(0, 1), b2 + hstep, voffB);
            PG8_WAIT_V(6); PG8_BAR; PG8_MMA(1, 1, At, B1); PG8_BAR;
            PG8_LDB(B0, 1, 0); PG8_SCHED; PG8_LDA(At, 1, 0); PG8_STAGE(PG8_SA(0, 1), a2 + hstep, voffA);
            PG8_WAIT_L(8); PG8_BAR; PG8_WAIT_L(0); PG8_MMA(0, 0, At, B0); PG8_BAR; PG8_SCHED;
            PG8_LDB(B1, 1, 1); PG8_STAGE(PG8_SB(1, 0), b3, voffB);
            PG8_BAR; PG8_WAIT_L(0); PG8_MMA(0, 1, At, B1); PG8_BAR;
            PG8_LDA(At, 1, 1); PG8_STAGE(PG8_SA(1, 0), a3, voffA);
            PG8_BAR; PG8_WAIT_L(0); PG8_MMA(1, 0, At, B0); PG8_BAR; PG8_SCHED;
            PG8_STAGE(PG8_SB(1, 1), b3 + hstep, voffB);
            PG8_WAIT_V(6); PG8_BAR; PG8_MMA(1, 1, At, B1); PG8_BAR;
            }
        }
        if constexpr (ALIGN_EPI) { if (wr == 0) PG8_BAR; }
        if constexpr (!Epi::AFTER_DRAIN) { E(acc, cur, wr, wc, fr, fq); S.done(cur); }
        if (!has_next) break;
#pragma unroll
        for (int a = 0; a < 2; ++a)
#pragma unroll
            for (int b = 0; b < 2; ++b)
#pragma unroll
                for (int m = 0; m < 4; ++m)
#pragma unroll
                    for (int n = 0; n < 2; ++n) acc[a][b][m][n] = (f32x4){0.f, 0.f, 0.f, 0.f};
        cur = nxt; cA = nA; cB = nB; ++ui;
        if constexpr (ALIGN_EPI) { if (wr == 1) PG8_BAR; }
    }
    PG8_WAIT_V(0);
    if constexpr (!ALIGN_EPI) { if (wr == 0) PG8_BAR; }
    PG8_BAR;
    if constexpr (Epi::AFTER_DRAIN) { E.fused(acc, cur, wr, wc, fr, fq, lds, wid, lane); S.done(cur); }
#undef PG8_SA
#undef PG8_SB
#undef PG8_STAGE
#undef PG8_LDA
#undef PG8_LDB
#undef PG8_MMA
#undef PG8_WAIT_V
#undef PG8_WAIT_L
#undef PG8_BAR
#undef PG8_SCHED
}
}
struct EpiBf16 { bf16* C; int ldc; DI void operator()(int r, int c, f32x4 v) const { u32x2 o; o.x = cvt_pk_bf16(v[0], v[1]); o.y = cvt_pk_bf16(v[2], v[3]); *(u32x2*)(C + (size_t)r * ldc + c) = o; } };
struct EpiResid { const float* xin; float* xout; const float* gate;
    DI void operator()(int r, int c, f32x4 v) const { const float4 x = *(const float4*)(xin + (size_t)r * 1024 + c); const float4 g = *(const float4*)(gate + (size_t)(r >> 12) * 6144 + c);
        float4 o; o.x = x.x + g.x * v[0]; o.y = x.y + g.y * v[1]; o.z = x.z + g.z * v[2]; o.w = x.w + g.w * v[3]; *(float4*)(xout + (size_t)r * 1024 + c) = o; } };
struct EpiGlu { const bf16* yg; const float* bglu; bf16* mix;
    DI void operator()(int r, int c, f32x4 v) const { const u32x2 y = *(const u32x2*)(yg + (size_t)r * 256 + c); const float4 b = *(const float4*)(bglu + c);
        u32x2 o; o.x = cvt_pk_bf16(bflo(y.x) * sigmoidf(v[0] + b.x), bfhi(y.x) * sigmoidf(v[1] + b.y)); o.y = cvt_pk_bf16(bflo(y.y) * sigmoidf(v[2] + b.z), bfhi(y.y) * sigmoidf(v[3] + b.w));
        *(u32x2*)(mix + (size_t)r * KMIX + c) = o; } };
constexpr int GP = 72;
template <class Epi>
DI void gemm_tile64(const bf16* __restrict__ A, int lda, const bf16* __restrict__ Bt, int ldb, int K, int m0, int n0, bf16* lds, const Epi& epi) {
    bf16* As = lds; bf16* Bs = lds + 64 * GP;
    const int tid = opq_tid(), lane = tid & 63, wave = tid >> 6, wm = wave >> 1, wn = wave & 1;
    const int fr = lane & 15, fq = lane >> 4;
    const int lrow = tid >> 3, lch = tid & 7;
    f32x4 acc[4][2];
#pragma unroll
    for (int i = 0; i < 4; ++i)
#pragma unroll
        for (int j = 0; j < 2; ++j) acc[i][j] = (f32x4){0.f, 0.f, 0.f, 0.f};
    bf16x8 ra[2], rb[4];
    const bf16* Ag = A + (size_t)(m0 + lrow) * lda + lch * 8;
    const bf16* Bg = Bt + (size_t)(n0 + lrow) * ldb + lch * 8;
#pragma unroll
    for (int i = 0; i < 4; ++i) { if (i < 2) ra[i] = ld16(Ag + (size_t)32 * i * lda); rb[i] = ld16(Bg + (size_t)32 * i * ldb); }
    const int nk = K / 64;
    for (int kt = 0; kt < nk; ++kt) {
        hsync();
#pragma unroll
        for (int i = 0; i < 4; ++i) { if (i < 2) *(bf16x8*)(As + (lrow + 32 * i) * GP + lch * 8) = ra[i]; *(bf16x8*)(Bs + (lrow + 32 * i) * GP + lch * 8) = rb[i]; }
        hsync();
        if (kt + 1 < nk) {
#pragma unroll
            for (int i = 0; i < 4; ++i) { if (i < 2) ra[i] = ld16(Ag + (size_t)32 * i * lda + (kt + 1) * 64); rb[i] = ld16(Bg + (size_t)32 * i * ldb + (kt + 1) * 64); }
        }
#pragma unroll
        for (int ks = 0; ks < 2; ++ks) {
            bf16x8 fa[4], fb[2];
#pragma unroll
            for (int i = 0; i < 4; ++i) fa[i] = ld16(Bs + (64 * wn + 16 * i + fr) * GP + 32 * ks + 8 * fq);
#pragma unroll
            for (int j = 0; j < 2; ++j) fb[j] = ld16(As + (32 * wm + 16 * j + fr) * GP + 32 * ks + 8 * fq);
#pragma unroll
            for (int i = 0; i < 4; ++i)
#pragma unroll
                for (int j = 0; j < 2; ++j) acc[i][j] = MFMA16(fa[i], fb[j], acc[i][j]);
        }
    }
#pragma unroll
    for (int i = 0; i < 4; ++i)
#pragma unroll
        for (int j = 0; j < 2; ++j) epi(m0 + 32 * wm + 16 * j + fr, n0 + 64 * wn + 16 * i + 4 * fq, acc[i][j]);
}
template <class F> struct Epi256 {
    static constexpr bool PERM = false, AFTER_DRAIN = false;
    F f;
    DI void operator()(const f32x4 (&acc)[2][2][4][2], const pg8::Unit& u, int wr, int wc, int, int) const {
        int t_ = (int)threadIdx.x; asm volatile("" : "+v"(t_));
        const int fr = t_ & 15, fq = (t_ >> 4) & 3;
#pragma unroll
        for (int ai = 0; ai < 2; ++ai)
#pragma unroll
            for (int m = 0; m < 4; ++m)
#pragma unroll
                for (int bj = 0; bj < 2; ++bj)
#pragma unroll
                    for (int n = 0; n < 2; ++n) f(u.pm * 256 + ai * 128 + wr * 64 + m * 16 + fr, u.pn * 256 + bj * 128 + wc * 32 + n * 16 + 4 * fq, acc[ai][bj][m][n]);
    }
};

DI unsigned off_b(unsigned row, unsigned ch) { return 256u * row + 16u * (ch ^ (((row & 3u) << 2) | ((row >> 2) & 3u))); }
#define TR8(o0, o1, o2, o3, o4, o5, o6, o7, a0, a1, a2, a3, a4, a5, a6, a7)                                                                         \
    asm volatile("s_waitcnt lgkmcnt(0)\n\t"                                                                                                         \
                 "ds_read_b64_tr_b16 %0, %8\n\tds_read_b64_tr_b16 %1, %9\n\tds_read_b64_tr_b16 %2, %10\n\tds_read_b64_tr_b16 %3, %11\n\t"           \
                 "ds_read_b64_tr_b16 %4, %12\n\tds_read_b64_tr_b16 %5, %13\n\tds_read_b64_tr_b16 %6, %14\n\tds_read_b64_tr_b16 %7, %15\n\t"         \
                 "s_waitcnt lgkmcnt(0)"                                                                                                             \
                 : "=&v"(o0), "=&v"(o1), "=&v"(o2), "=&v"(o3), "=&v"(o4), "=&v"(o5), "=&v"(o6), "=&v"(o7)                                           \
                 : "v"(a0), "v"(a1), "v"(a2), "v"(a3), "v"(a4), "v"(a5), "v"(a6), "v"(a7)                                                           \
                 : "memory")

DI void it_kvn(const Params& p, int l, int vb) {
    const int lane = opq_tid() & 63, wave = opq_tid() >> 6;
    const bf16* proj = (const bf16*)(wsb(p) + WS_PROJ); bf16* kvn = (bf16*)(wsb(p) + WS_KVN);
    const float g0 = p.in[19][l * 128 + 2 * lane], g1 = p.in[19][l * 128 + 2 * lane + 1];
    for (int i = 0; i < 16; ++i) {
        const int row = vb * 64 + i * 4 + wave;
        const unsigned u = *(const unsigned*)(proj + (size_t)row * NPROJ + C_CKV + 2 * lane);
        const float a = bflo(u), b = bfhi(u);
        const float ss = wave_sum(a * a + b * b);
        const float r = rsqrtf(ss * (1.f / 128.f) + 1e-6f);
        *(unsigned*)(kvn + (size_t)row * 128 + 2 * lane) = cvt_pk_bf16(a * r * g0, b * r * g1);
    }
}

DI void it_ssm_a(const Params& p, int l, int item) {
    const int lane = opq_tid() & 63, wave = opq_tid() >> 6, fr = lane & 15, fq = lane >> 4;
    const bf16* proj = (const bf16*)(wsb(p) + WS_PROJ);
    float* sloc = (float*)(wsb(p) + WS_SLOC);
    const int g = item & 15, rt = item >> 4;
    const bf16* E = (const bf16*)(wsb(p) + WS_E) + ((size_t)(l * 16 + g) * 128) * 1024;
    const int R = 16 * rt + fr, b = R >> 6, k = R & 63;
    const bf16* arow = proj + ((size_t)b * 4096 + 64 * k + (fq >> 1)) * NPROJ + C_UA + 16 * g + 8 * (fq & 1);
    f32x4 acc[2] = {(f32x4){0, 0, 0, 0}, (f32x4){0, 0, 0, 0}};
#pragma unroll 4
    for (int ks = 0; ks < 32; ++ks) {
        const bf16x8 a = ld16(arow + (size_t)(2 * ks) * NPROJ);
#pragma unroll
        for (int c = 0; c < 2; ++c) { const int ct = 2 * wave + c; const bf16x8 bf = ld16(E + (size_t)(16 * ct + fr) * 1024 + 32 * ks + 8 * fq); acc[c] = MFMA16(a, bf, acc[c]); }
    }
#pragma unroll
    for (int c = 0; c < 2; ++c)
#pragma unroll
        for (int i = 0; i < 4; ++i) sloc[((size_t)(16 * rt + 4 * fq + i) * 16 + g) * 128 + 16 * (2 * wave + c) + fr] = acc[c][i];
}

DI void it_ssm_c(const Params& p, int l, int item, unsigned char* sm) {
    bf16* sst = (bf16*)sm;
    bf16* ktl = (bf16*)(sm + 17408);
    const int tid = opq_tid(), lane = tid & 63, wave = tid >> 6, fr = lane & 15, fq = lane >> 4;
    const bf16* proj = (const bf16*)(wsb(p) + WS_PROJ);
    const float* sloc = (const float*)(wsb(p) + WS_SLOC);
    bf16* yg = (bf16*)(wsb(p) + WS_YG);
    const int jq = item & 3, g = (item >> 2) & 15, b = item >> 6;
    const bf16* KT = (const bf16*)(wsb(p) + WS_KT) + (size_t)(l * 16 + g) * 64 * 256;
    hsync();
#pragma unroll
    for (int i = 0; i < 8; ++i) *(bf16x8*)(ktl + (i * 256 + tid) * 8) = ld16(KT + (size_t)(i * 256 + tid) * 8);
    if (wave == 0) {
        const float* pw64 = (const float*)(wsb(p) + WS_PW) + ((size_t)(l * 16 + g) * 65 + 64) * 128 + lane * 2;
        const float ar = pw64[0], ai = pw64[1];
        float sr = 0, si = 0;
        const float* s = sloc + ((size_t)(b * 64) * 16 + g) * 128;
#pragma unroll 8
        for (int k = 0; k < 64; ++k) {
            sst[k * 136 + lane] = f2bf(sr); sst[k * 136 + 64 + lane] = f2bf(si);
            const float lr = s[(size_t)k * 2048 + lane], li = s[(size_t)k * 2048 + 64 + lane];
            const float nr = ar * sr - ai * si + lr, ni = ar * si + ai * sr + li;
            sr = nr; si = ni;
        }
    }
    hsync();
    const bf16* G = (const bf16*)(wsb(p) + WS_G) + (size_t)(l * 16 + g) * 1024 * 128;
    const int kch = 16 * wave + fr;
    const bf16* arow = proj + ((size_t)b * 4096 + 64 * kch + (fq >> 1)) * NPROJ + C_UA + 16 * g + 8 * (fq & 1);
    const int j0 = 16 * jq;
    f32x4 acc[16];
#pragma unroll
    for (int jj = 0; jj < 16; ++jj) acc[jj] = (f32x4){0, 0, 0, 0};
    const int nks = (j0 + 15) / 2 + 1;
    bf16x8 a_cur[8], a_nxt[8];
#pragma unroll
    for (int i = 0; i < 8; ++i) a_cur[i] = ld16(arow + (size_t)(2 * i) * NPROJ);
    for (int k0 = 0; k0 < nks; k0 += 8) {
        const bool more = k0 + 8 < nks;
#pragma unroll
        for (int i = 0; i < 8; ++i) a_nxt[i] = more ? ld16(arow + (size_t)(2 * (k0 + 8 + i)) * NPROJ) : zero8();
#pragma unroll
        for (int i = 0; i < 8; ++i) {
            const int ks = k0 + i;
#pragma unroll
            for (int jj = 0; jj < 16; ++jj) {
                const int j = j0 + jj;
                if (2 * ks <= j) {
                    const int d = j - 2 * ks - (fq >> 1);
                    const bf16x8 bl = ld16(ktl + ((d < 0 ? 0 : d) * 16 + fr) * 16 + 8 * (fq & 1));
                    const bf16x8 bf = d >= 0 ? bl : zero8();
                    acc[jj] = MFMA16(bf, a_cur[i], acc[jj]);
                }
            }
        }
#pragma unroll
        for (int i = 0; i < 8; ++i) a_cur[i] = a_nxt[i];
    }
#pragma unroll
    for (int ks = 0; ks < 4; ++ks) {
        const bf16x8 a = ld16(sst + kch * 136 + 32 * ks + 8 * fq);
        bf16x8 bfr[16];
#pragma unroll
        for (int jj = 0; jj < 16; ++jj) bfr[jj] = ld16(G + ((size_t)((j0 + jj) * 16 + fr)) * 128 + 32 * ks + 8 * fq);
#pragma unroll
        for (int jj = 0; jj < 16; ++jj) acc[jj] = MFMA16(bfr[jj], a, acc[jj]);
    }
#pragma unroll
    for (int jj = 0; jj < 16; ++jj) {
        const size_t tok = (size_t)b * 4096 + 64 * (16 * wave + fr) + j0 + jj;
        u32x2 o; o.x = cvt_pk_bf16(gelu_tanh(acc[jj][0]), gelu_tanh(acc[jj][1])); o.y = cvt_pk_bf16(gelu_tanh(acc[jj][2]), gelu_tanh(acc[jj][3]));
        *(u32x2*)(yg + tok * 256 + 16 * g + 4 * fq) = o;
    }
}

DI void it_gmlp(const Params& p, int l, int item, unsigned char* sm) {
    bf16* vnT = (bf16*)sm;
    const int tid = opq_tid(), lane = tid & 63, wave = tid >> 6, fr = lane & 15, fq = lane >> 4;
    const bf16* proj = (const bf16*)(wsb(p) + WS_PROJ); bf16* mix = (bf16*)(wsb(p) + WS_MIX);
    const int h = item & 3, blk = item >> 2;
    const size_t tok0 = (size_t)blk * 128;
    hsync();
    {
        const int row = tid >> 1, half = tid & 1;
        const bf16* vp = proj + (tok0 + row) * NPROJ + C_VB + 64 * h + 32 * half;
        float v[32]; float s = 0;
#pragma unroll
        for (int q = 0; q < 4; ++q) { const bf16x8 t = ld16(vp + 8 * q);
#pragma unroll
            for (int e = 0; e < 8; ++e) { v[8 * q + e] = bf2f((bf16)t[e]); s += v[8 * q + e]; } }
        s += __shfl_xor(s, 1); const float mu = s * (1.f / 64.f);
        float vs = 0;
#pragma unroll
        for (int e = 0; e < 32; ++e) { const float d = v[e] - mu; vs += d * d; }
        vs += __shfl_xor(vs, 1); const float r = rsqrtf(vs * (1.f / 64.f) + 1e-6f);
#pragma unroll
        for (int e = 0; e < 32; ++e) vnT[(32 * half + e) * 136 + row] = f2bf((v[e] - mu) * r);
    }
    hsync();
    const bf16* W = (const bf16*)(wsb(p) + WS_GW) + (size_t)(l * 4 + h) * 128 * 128;
    f32x4 acc[4][2];
#pragma unroll
    for (int i = 0; i < 4; ++i) { acc[i][0] = (f32x4){0, 0, 0, 0}; acc[i][1] = (f32x4){0, 0, 0, 0}; }
#pragma unroll
    for (int ks = 0; ks < 4; ++ks) {
        bf16x8 fa[4], fb[2];
#pragma unroll
        for (int i = 0; i < 4; ++i) fa[i] = ld16(vnT + (16 * i + fr) * 136 + 32 * ks + 8 * fq);
#pragma unroll
        for (int j = 0; j < 2; ++j) fb[j] = ld16(W + (size_t)(16 * (2 * wave + j) + fr) * 128 + 32 * ks + 8 * fq);
#pragma unroll
        for (int i = 0; i < 4; ++i)
#pragma unroll
            for (int j = 0; j < 2; ++j) acc[i][j] = MFMA16(fa[i], fb[j], acc[i][j]);
    }
#pragma unroll
    for (int j = 0; j < 2; ++j) {
        const int t = 16 * (2 * wave + j) + fr;
        const float bs = p.in[18][(l * 4 + h) * 128 + t];
#pragma unroll
        for (int i = 0; i < 4; ++i) {
            const int d = 16 * i + 4 * fq;
            const u32x2 u = *(const u32x2*)(proj + (tok0 + t) * NPROJ + C_UB + 64 * h + d);
            u32x2 o; o.x = cvt_pk_bf16(bflo(u.x) * (acc[i][j][0] + bs), bfhi(u.x) * (acc[i][j][1] + bs)); o.y = cvt_pk_bf16(bflo(u.y) * (acc[i][j][2] + bs), bfhi(u.y) * (acc[i][j][3] + bs));
            *(u32x2*)(mix + (tok0 + t) * KMIX + 256 + 64 * h + d) = o;
        }
    }
}

DI size_t score_row_off(int b, int t) { const int c = t >> 6; return (size_t)b * SCORES_PER_BATCH + (size_t)4096 * (c * (c + 1) / 2) + (size_t)(t & 63) * 64 * (c + 1); }
template <int NR>
DI void dsa_select_impl(const float* __restrict__ srow, int nreg, bf16* __restrict__ so, int lane, unsigned* hist) {
    (void)hist;
    unsigned key[NR];
#pragma unroll
    for (int r = 0; r < NR; ++r) { const float v = srow[64 * r + lane]; key[r] = (r < nreg) ? fkey(v + 0.f) : 0u; }
    unsigned T = 0;
#pragma unroll 1
    for (int bit = 31; bit >= 0; --bit) {
        const unsigned cand = T | (1u << bit);
        unsigned c = 0;
#pragma unroll
        for (int r = 0; r < NR; ++r) asm("v_cmp_ge_u32 vcc, %1, %2\n\tv_addc_co_u32 %0, vcc, 0, %0, vcc" : "+v"(c) : "v"(key[r]), "v"(cand) : "vcc");
        const unsigned cnt = wave_sum_u32(c);
        if (cnt >= 256u) { T = cand; if (cnt == 256u) break; }
    }
    unsigned c = 0;
#pragma unroll
    for (int r = 0; r < NR; ++r) asm("v_cmp_gt_u32 vcc, %1, %2\n\tv_addc_co_u32 %0, vcc, 0, %0, vcc" : "+v"(c) : "v"(key[r]), "v"(T) : "vcc");
    const int need = 256 - (int)wave_sum_u32(c);
    int base = 0, eqb = 0;
    const unsigned long long lt = (1ull << lane) - 1ull;
#pragma unroll
    for (int r = 0; r < NR; ++r) {
        const unsigned long long me = __ballot(key[r] == T);
        const int erank = eqb + __popcll(me & lt);
        const bool take = (key[r] > T) || (key[r] == T && erank < need);
        const unsigned long long mt = __ballot(take);
        if (take) so[base + __popcll(mt & lt)] = (bf16)(64 * r + lane);
        base += __popcll(mt); eqb += __popcll(me);
    }
}
DI void dsa_select_query(const Params& p, int q, int lane, unsigned* hist) {
    const float* scores = (const float*)(wsb(p) + WS_SCORES); bf16* sel = (bf16*)(wsb(p) + WS_SEL);
    const int b = q >> 12, t = q & 4095, c = t >> 6, nreg = c + 1;
    bf16* so = sel + (size_t)q * 256;
    if (nreg <= 4) { for (int r = 0; r < nreg; ++r) so[64 * r + lane] = (bf16)(64 * r + lane); return; }
    const float* srow = scores + score_row_off(b, t);
    if (nreg <= 16) dsa_select_impl<16>(srow, nreg, so, lane, hist);
    else if (nreg <= 32) dsa_select_impl<32>(srow, nreg, so, lane, hist);
    else if (nreg <= 48) dsa_select_impl<48>(srow, nreg, so, lane, hist);
    else dsa_select_impl<64>(srow, nreg, so, lane, hist);
}
DI void it_dsa_index_select(const Params& p, int item, unsigned char* sm, int mode = 3) {
    const int lane = opq_tid() & 63, wave = opq_tid() >> 6, fr = lane & 15, fq = lane >> 4;
    const bf16* proj = (const bf16*)(wsb(p) + WS_PROJ); float* scores = (float*)(wsb(p) + WS_SCORES);
    const int c = 63 - (item >> 4), b = (item >> 2) & 3, qg = item & 3;
    if (c >= 4 && (mode & 1)) {
        const int t = 64 * c + 16 * qg + fr;
        const bf16* qrow = proj + ((size_t)b * 4096 + t) * NPROJ;
        bf16x8 qf[4][2];
#pragma unroll
        for (int hh = 0; hh < 4; ++hh)
#pragma unroll
            for (int ks = 0; ks < 2; ++ks) qf[hh][ks] = ld16(qrow + C_QI + 64 * hh + 32 * ks + 8 * fq);
        float w[4];
        { const u32x2 wv = *(const u32x2*)(qrow + C_WI); w[0] = bflo(wv.x) * 0.0625f; w[1] = bfhi(wv.x) * 0.0625f; w[2] = bflo(wv.y) * 0.0625f; w[3] = bfhi(wv.y) * 0.0625f; }
        float* srow = scores + score_row_off(b, t);
        const int ntile = 4 * (c + 1);
        const bf16* kbase = proj + ((size_t)b * 4096 + fr) * NPROJ + C_KI + 8 * fq;
        bf16x8 k0[4], k1[4];
#pragma unroll
        for (int u = 0; u < 4; ++u) { const bf16* krow = kbase + (size_t)16 * (wave + 4 * u) * NPROJ; k0[u] = ld16(krow); k1[u] = ld16(krow + 32); }
        for (int base = wave; base < ntile; base += 16) {
            bf16x8 n0[4], n1[4];
            const bool more = base + 16 < ntile;
            if (more) {
#pragma unroll
                for (int u = 0; u < 4; ++u) { const bf16* krow = kbase + (size_t)16 * (base + 16 + 4 * u) * NPROJ; n0[u] = ld16(krow); n1[u] = ld16(krow + 32); }
            }
#pragma unroll
            for (int u = 0; u < 4; ++u) {
                const int kt = base + 4 * u;
                if (kt >= ntile) break;
                f32x4 sc = {0, 0, 0, 0};
#pragma unroll
                for (int hh = 0; hh < 4; ++hh) {
                    f32x4 a = {0, 0, 0, 0};
                    a = MFMA16(k0[u], qf[hh][0], a); a = MFMA16(k1[u], qf[hh][1], a);
#pragma unroll
                    for (int i = 0; i < 4; ++i) sc[i] += w[hh] * fmaxf(a[i], 0.f);
                }
#pragma unroll
                for (int i = 0; i < 4; ++i) sc[i] += 0.f;
                *(f32x4*)(srow + 16 * kt + 4 * fq) = sc;
            }
            if (more) {
#pragma unroll
                for (int u = 0; u < 4; ++u) { k0[u] = n0[u]; k1[u] = n1[u]; }
            }
        }
    }
    hsync_g();
    if (mode & 2) for (int i = 0; i < 4; ++i) dsa_select_query(p, b * 4096 + 64 * c + 16 * qg + 4 * wave + i, lane, (unsigned*)sm + 1024 * wave);
}
DI void it_dsa_attn(const Params& p, int item, unsigned char* sm) {
    const int lane = opq_tid() & 63, wave = opq_tid() >> 6, fr = lane & 15, fq = lane >> 4;
    unsigned char* tile = sm + wave * 8192;
    bf16* selw = (bf16*)(sm + 32768 + wave * 512);
    const bf16* proj = (const bf16*)(wsb(p) + WS_PROJ); const bf16* kvn = (const bf16*)(wsb(p) + WS_KVN);
    const bf16* sel = (const bf16*)(wsb(p) + WS_SEL); bf16* mix = (bf16*)(wsb(p) + WS_MIX);
    unsigned wr_addr[8], rd_addr[2][4], tr_addr[8][2];
#pragma unroll
    for (int i = 0; i < 8; ++i) wr_addr[i] = off_b(4 * i + fq, fr);
#pragma unroll
    for (int rb = 0; rb < 2; ++rb)
#pragma unroll
        for (int s = 0; s < 4; ++s) rd_addr[rb][s] = off_b(8 * (fr >> 2) + 4 * rb + (fr & 3), 4 * s + fq);
    const unsigned tbase = (unsigned)(size_t)tile;
    {
        const unsigned q4 = fr >> 2, p4 = fr & 3;
#pragma unroll
        for (int c = 0; c < 8; ++c)
#pragma unroll
            for (int t = 0; t < 2; ++t) tr_addr[c][t] = tbase + off_b(8 * fq + 4 * t + q4, 2 * c + (p4 >> 1)) + 8 * (p4 & 1);
    }
    const float slope = fr < 8 ? exp2f(-(float)(fr + 1)) : 0.f;
    for (int qi = 0; qi < 4; ++qi) {
        const int q = item * 16 + wave * 4 + qi;
        const int b = q >> 12, t = q & 4095, c = t >> 6;
        const int nsel = (c + 1) * 64 < 256 ? (c + 1) * 64 : 256;
        const bf16* qa = proj + (size_t)q * NPROJ + C_QA;
        bf16x8 qf[4];
#pragma unroll
        for (int s = 0; s < 4; ++s) qf[s] = fr < 8 ? ld16(qa + fr * 128 + 32 * s + 8 * fq) : zero8();
        const bf16* selp = sel + (size_t)q * 256;
        const bf16* kvb = kvn + (size_t)b * 4096 * 128;
        if (4 * lane < nsel) *(u32x2*)(selw + 4 * lane) = *(const u32x2*)(selp + 4 * lane);
        float m_run = -INFINITY, l_run = 0.f;
        f32x4 o[8];
#pragma unroll
        for (int i = 0; i < 8; ++i) o[i] = (f32x4){0, 0, 0, 0};
        bf16x8 gk[8];
#pragma unroll
        for (int i = 0; i < 8; ++i) { const int key = selw[4 * i + fq]; gk[i] = ld16(kvb + (size_t)key * 128 + 8 * fr); }
        const int nt = nsel / 32;
        for (int ti = 0; ti < nt; ++ti) {
            const bf16x8 kp = ld16(selw + 32 * ti + 8 * fq);
#pragma unroll
            for (int i = 0; i < 8; ++i) *(bf16x8*)(tile + wr_addr[i]) = gk[i];
            if (ti + 1 < nt) {
#pragma unroll
                for (int i = 0; i < 8; ++i) { const int key = selw[32 * (ti + 1) + 4 * i + fq]; gk[i] = ld16(kvb + (size_t)key * 128 + 8 * fr); }
            }
            f32x4 lg[2] = {(f32x4){0, 0, 0, 0}, (f32x4){0, 0, 0, 0}};
#pragma unroll
            for (int rb = 0; rb < 2; ++rb)
#pragma unroll
                for (int s = 0; s < 4; ++s) lg[rb] = MFMA16(ld16(tile + rd_addr[rb][s]), qf[s], lg[rb]);
            float val[8]; float tmax = -INFINITY;
#pragma unroll
            for (int j = 0; j < 8; ++j) { const float dist = fabsf((float)(t - (int)(unsigned short)kp[j])); val[j] = lg[j >> 2][j & 3] - slope * dist; tmax = fmaxf(tmax, val[j]); }
            tmax = fmaxf(tmax, __shfl_xor(tmax, 16)); tmax = fmaxf(tmax, __shfl_xor(tmax, 32));
            const float m_new = fmaxf(m_run, tmax);
            const float scale = __expf(m_run - m_new);
            l_run *= scale;
#pragma unroll
            for (int i = 0; i < 8; ++i) o[i] *= scale;
            float pv[8];
#pragma unroll
            for (int j = 0; j < 8; ++j) { pv[j] = __expf(val[j] - m_new); l_run += pv[j]; }
            m_run = m_new;
            u32x4 pk; pk.x = cvt_pk_bf16(pv[0], pv[1]); pk.y = cvt_pk_bf16(pv[2], pv[3]); pk.z = cvt_pk_bf16(pv[4], pv[5]); pk.w = cvt_pk_bf16(pv[6], pv[7]);
            const bf16x8 pf = __builtin_bit_cast(bf16x8, pk);
            s16x4 tr[8][2];
            TR8(tr[0][0], tr[0][1], tr[1][0], tr[1][1], tr[2][0], tr[2][1], tr[3][0], tr[3][1], tr_addr[0][0], tr_addr[0][1], tr_addr[1][0], tr_addr[1][1], tr_addr[2][0], tr_addr[2][1], tr_addr[3][0], tr_addr[3][1]);
            TR8(tr[4][0], tr[4][1], tr[5][0], tr[5][1], tr[6][0], tr[6][1], tr[7][0], tr[7][1], tr_addr[4][0], tr_addr[4][1], tr_addr[5][0], tr_addr[5][1], tr_addr[6][0], tr_addr[6][1], tr_addr[7][0], tr_addr[7][1]);
#pragma unroll
            for (int cc = 0; cc < 8; ++cc) {
                bf16x8 kf; kf[0] = tr[cc][0][0]; kf[1] = tr[cc][0][1]; kf[2] = tr[cc][0][2]; kf[3] = tr[cc][0][3]; kf[4] = tr[cc][1][0]; kf[5] = tr[cc][1][1]; kf[6] = tr[cc][1][2]; kf[7] = tr[cc][1][3];
                o[cc] = MFMA16(kf, pf, o[cc]);
            }
        }
        float lt = l_run; lt += __shfl_xor(lt, 16); lt += __shfl_xor(lt, 32);
        const float inv = 1.f / lt;
        if (fr < 8) {
#pragma unroll
            for (int cc = 0; cc < 8; ++cc) { u32x2 ov; ov.x = cvt_pk_bf16(o[cc][0] * inv, o[cc][1] * inv); ov.y = cvt_pk_bf16(o[cc][2] * inv, o[cc][3] * inv);
                *(u32x2*)(mix + (size_t)q * KMIX + 512 + fr * 128 + 16 * cc + 4 * fq) = ov; }
        }
    }
}
typedef float f2 __attribute__((ext_vector_type(2)));
#ifndef PEER_FP8_MASK
#define PEER_FP8_MASK 3
#endif
constexpr float U_SCALE = 64.f, V_SCALE = 8.f;
DI unsigned pack4_fp8(float a, float b, float c, float d) { int p = __builtin_amdgcn_cvt_pk_fp8_f32(a, b, 0, false); p = __builtin_amdgcn_cvt_pk_fp8_f32(c, d, p, true); return (unsigned)p; }
DI void conv_chunk_fp8(const float* __restrict__ src, unsigned char* __restrict__ dst, size_t i0, int n16, float sc) {
    for (int i = opq_tid(); i < n16; i += 256) {
        const float4* s4 = (const float4*)src + 4 * (i0 + i);
        const float4 a = s4[0], b = s4[1], c = s4[2], d = s4[3];
        u32x4 o; o.x = pack4_fp8(a.x * sc, a.y * sc, a.z * sc, a.w * sc); o.y = pack4_fp8(b.x * sc, b.y * sc, b.z * sc, b.w * sc);
        o.z = pack4_fp8(c.x * sc, c.y * sc, c.z * sc, c.w * sc); o.w = pack4_fp8(d.x * sc, d.y * sc, d.z * sc, d.w * sc);
        ((u32x4*)dst)[i0 + i] = o;
    }
}
struct PeerLds2 {
    float trans[4][1024];
    unsigned char li[4][2][64][16];
    unsigned short pe[4][8][128];
    float pg[4][8][128];
};
template <int OFF, int NK>
DI void sort16_desc(unsigned (&k)[NK]) {
#pragma unroll
    for (int size = 2; size <= 16; size <<= 1)
#pragma unroll
        for (int stride = size >> 1; stride > 0; stride >>= 1)
#pragma unroll
            for (int i = 0; i < 16; ++i) {
                const int j = i ^ stride;
                if (j > i) {
                    const bool desc = ((i & size) == 0);
                    const unsigned a = k[OFF + i], b = k[OFF + j];
                    const unsigned hi = a > b ? a : b, lo = a > b ? b : a;
                    k[OFF + i] = desc ? hi : lo; k[OFF + j] = desc ? lo : hi;
                }
            }
}
template <int OA, int OB, int NK>
DI void merge_top16(unsigned (&k)[NK]) {
#pragma unroll
    for (int i = 0; i < 16; ++i) { const unsigned a = k[OA + i], b = k[OB + 15 - i]; k[OA + i] = a > b ? a : b; }
#pragma unroll
    for (int stride = 8; stride > 0; stride >>= 1)
#pragma unroll
        for (int i = 0; i < 16; ++i) {
            const int j = i ^ stride;
            if (j > i) { const unsigned a = k[OA + i], b = k[OA + j]; k[OA + i] = a > b ? a : b; k[OA + j] = a > b ? b : a; }
        }
}
DI void peer_retrieve(const Params& p, int l, int tok0, PeerLds2& S, int lane, int wave) {
    const int fr = lane & 15, fq = lane >> 4;
    const bf16* QP = (const bf16*)(wsb(p) + WS_PROJ);
    const bf16* PK = (const bf16*)(wsb(p) + WS_PK) + (size_t)l * 2 * 128 * 64;
    float* trans = S.trans[wave];
    unsigned K1[16], K2[16];
#pragma unroll
    for (int L = 0; L < 2; ++L) {
        f32x4 acc[4][8];
#pragma unroll
        for (int ct = 0; ct < 4; ++ct)
#pragma unroll
            for (int kt = 0; kt < 8; ++kt) acc[ct][kt] = (f32x4){0, 0, 0, 0};
#pragma unroll
        for (int kt = 0; kt < 8; ++kt) {
            const bf16* krow = PK + (size_t)L * 8192 + (size_t)(16 * kt + fr) * 64 + 8 * fq;
            const bf16x8 a0 = ld16(krow), a1 = ld16(krow + 32);
#pragma unroll
            for (int ct = 0; ct < 4; ++ct) {
                const bf16* qrow = QP + (size_t)(tok0 + 2 * ct + (fr >> 3)) * 1024 + 128 * (fr & 7) + 64 * L + 8 * fq;
                acc[ct][kt] = MFMA16(a0, ld16(qrow), acc[ct][kt]); acc[ct][kt] = MFMA16(a1, ld16(qrow + 32), acc[ct][kt]);
            }
        }
        unsigned k[128];
#define PEER_ROUND(kt)                                                                                                                            \
        {                                                                                                                                         \
            _Pragma("unroll") for (int ct = 0; ct < 4; ++ct) *(f32x4*)(trans + ((ct * 4 + fq) * 16 + fr) * 4) = acc[ct][kt];                       \
            _Pragma("unroll") for (int sq = 0; sq < 4; ++sq) {                                                                                     \
                const f32x4 v = *(const f32x4*)(trans + ((fq * 4 + sq) * 16 + fr) * 4);                                                            \
                _Pragma("unroll") for (int i = 0; i < 4; ++i) k[16 * (kt) + sq * 4 + i] = (fkey(v[i]) & ~0x7fu) | (unsigned)(16 * (kt) + 4 * sq + i); \
            }                                                                                                                                     \
            sort16_desc<16 * (kt)>(k);                                                                                                            \
        }
        PEER_ROUND(0) PEER_ROUND(1) merge_top16<0, 16>(k);
        PEER_ROUND(2) PEER_ROUND(3) merge_top16<32, 48>(k); merge_top16<0, 32>(k);
        PEER_ROUND(4) PEER_ROUND(5) merge_top16<64, 80>(k);
        PEER_ROUND(6) PEER_ROUND(7) merge_top16<96, 112>(k); merge_top16<64, 96>(k);
        merge_top16<0, 64>(k);
#undef PEER_ROUND
        u32x4 ib;
        ib.x = (k[0] & 127u) | ((k[1] & 127u) << 8) | ((k[2] & 127u) << 16) | ((k[3] & 127u) << 24);
        ib.y = (k[4] & 127u) | ((k[5] & 127u) << 8) | ((k[6] & 127u) << 16) | ((k[7] & 127u) << 24);
        ib.z = (k[8] & 127u) | ((k[9] & 127u) << 8) | ((k[10] & 127u) << 16) | ((k[11] & 127u) << 24);
        ib.w = (k[12] & 127u) | ((k[13] & 127u) << 8) | ((k[14] & 127u) << 16) | ((k[15] & 127u) << 24);
        *(u32x4*)(S.li[wave][L][lane]) = ib;
#pragma unroll
        for (int i = 0; i < 16; ++i) { if (L == 0) K1[i] = k[i]; else K2[i] = k[i]; }
    }
    float v1[16], v2[16];
#pragma unroll
    for (int i = 0; i < 16; ++i) { v1[i] = __uint_as_float(unkey(K1[i] & ~0x7fu)); v2[i] = __uint_as_float(unkey(K2[i] & ~0x7fu)); }
    unsigned c[64];
    {
        int idx = 0;
#pragma unroll
        for (int a = 0; a < 16; ++a)
#pragma unroll
            for (int b = 0; b < 16; ++b)
                if ((a + 1) * (b + 1) <= 16) { c[idx] = (fkey(v1[a] + v2[b]) & ~0xffu) | (unsigned)(a * 16 + b); ++idx; }
#pragma unroll
        for (int i = 50; i < 64; ++i) c[i] = 0u;
    }
    sort16_desc<0>(c); sort16_desc<16>(c); sort16_desc<32>(c); sort16_desc<48>(c);
    merge_top16<0, 16>(c); merge_top16<32, 48>(c); merge_top16<0, 32>(c);
    float sc[16]; float sum = 0.f;
    {
        const float m = __uint_as_float(unkey(c[0] & ~0xffu));
#pragma unroll
        for (int i = 0; i < 16; ++i) { sc[i] = __expf(__uint_as_float(unkey(c[i] & ~0xffu)) - m); sum += sc[i]; }
    }
    const float inv = 1.f / sum;
    const int tt = 2 * fq + (fr >> 3), head = fr & 7;
    const unsigned char* l1 = S.li[wave][0][lane]; const unsigned char* l2 = S.li[wave][1][lane];
#pragma unroll
    for (int i = 0; i < 16; ++i) {
        const unsigned ab = c[i] & 0xffu;
        const unsigned e = (unsigned)l1[ab >> 4] * 128u + (unsigned)l2[ab & 15u];
        S.pe[wave][tt][head * 16 + i] = (unsigned short)e; S.pg[wave][tt][head * 16 + i] = sc[i] * inv;
    }
}
template <bool FP8>
DI void peer_experts(const Params& p, int l, int tok, int tt, PeerLds2& S, int lane, int wave) {
    const bf16* H = (const bf16*)(wsb(p) + WS_H);
    const unsigned char* UB = wsb(p) + WS_UB; const unsigned char* VB = wsb(p) + WS_VB;
    const float* X = (const float*)(wsb(p) + WS_X);
    const float* modl = (const float*)(wsb(p) + WS_MOD) + (size_t)l * 4 * 6144;
    const int b = tok >> 12;
    const unsigned short* pe = S.pe[wave][tt]; const float* pg = S.pg[wave][tt];
    f2 hp[8];
    u32x4 h0, h1;
    {
        h0 = *(const u32x4*)(H + (size_t)tok * 1024 + 16 * lane); h1 = *(const u32x4*)(H + (size_t)tok * 1024 + 16 * lane + 8);
        hp[0] = (f2){bflo(h0.x), bfhi(h0.x)}; hp[1] = (f2){bflo(h0.y), bfhi(h0.y)}; hp[2] = (f2){bflo(h0.z), bfhi(h0.z)}; hp[3] = (f2){bflo(h0.w), bfhi(h0.w)};
        hp[4] = (f2){bflo(h1.x), bfhi(h1.x)}; hp[5] = (f2){bflo(h1.y), bfhi(h1.y)}; hp[6] = (f2){bflo(h1.z), bfhi(h1.z)}; hp[7] = (f2){bflo(h1.w), bfhi(h1.w)};
    }
    f2 acc[8];
#pragma unroll
    for (int i = 0; i < 8; ++i) acc[i] = (f2){0.f, 0.f};
    const bool b5 = (lane & 32) != 0, b4_ = (lane & 16) != 0, b3 = (lane & 8) != 0;
    const int eidx = (b3 ? 4 : 0) + (b4_ ? 2 : 0) + (b5 ? 1 : 0);
    if constexpr (FP8) {
    for (int e0 = 0; e0 < 128; e0 += 8) {
        u32x4 ur[8], vr[8];
#pragma unroll
        for (int j = 0; j < 8; ++j) {
            const int e = __builtin_amdgcn_readfirstlane((int)pe[e0 + j]);
            ur[j] = *(const u32x4*)(UB + (size_t)e * 1024 + 16 * lane);
            vr[j] = *(const u32x4*)(VB + (size_t)e * 1024 + 16 * lane);
        }
        float d[8];
#pragma unroll
        for (int j = 0; j < 8; ++j) {
            f2 s2 = {0.f, 0.f};
#pragma unroll
            for (int k = 0; k < 4; ++k) {
                const f2 lo = __builtin_amdgcn_cvt_pk_f32_fp8((int)ur[j][k], false), hi = __builtin_amdgcn_cvt_pk_f32_fp8((int)ur[j][k], true);
                s2 = lo * hp[2 * k] + s2; s2 = hi * hp[2 * k + 1] + s2;
            }
            d[j] = s2.x + s2.y;
        }
        float w[4], x2[2], y;
#pragma unroll
        for (int i = 0; i < 4; ++i) { const float keep = b5 ? d[2 * i + 1] : d[2 * i], send = b5 ? d[2 * i] : d[2 * i + 1]; w[i] = keep + __shfl_xor(send, 32); }
#pragma unroll
        for (int i = 0; i < 2; ++i) { const float keep = b4_ ? w[2 * i + 1] : w[2 * i], send = b4_ ? w[2 * i] : w[2 * i + 1]; x2[i] = keep + __shfl_xor(send, 16); }
        { const float keep = b3 ? x2[1] : x2[0], send = b3 ? x2[0] : x2[1]; y = keep + __shfl_xor(send, 8); }
        y += __shfl_xor(y, 4); y += __shfl_xor(y, 2); y += __shfl_xor(y, 1);
        const float sc = gelu_tanh(y * (1.f / U_SCALE)) * pg[e0 + eidx] * (1.f / V_SCALE);
#pragma unroll
        for (int j = 0; j < 8; ++j) {
            const float sj = __uint_as_float((unsigned)__builtin_amdgcn_readlane((int)__float_as_uint(sc), 32 * (j & 1) + 16 * ((j >> 1) & 1) + 8 * ((j >> 2) & 1)));
            const f2 sj2 = {sj, sj};
#pragma unroll
            for (int k = 0; k < 4; ++k) {
                const f2 lo = __builtin_amdgcn_cvt_pk_f32_fp8((int)vr[j][k], false), hi = __builtin_amdgcn_cvt_pk_f32_fp8((int)vr[j][k], true);
                acc[2 * k] = lo * sj2 + acc[2 * k]; acc[2 * k + 1] = hi * sj2 + acc[2 * k + 1];
            }
        }
    }
    } else {
    for (int e0 = 0; e0 < 128; e0 += 4) {
        const bf16* UBb = (const bf16*)UB; const bf16* VBb = (const bf16*)VB;
        u32x4 ur[4][2], vr[4][2];
#pragma unroll
        for (int j = 0; j < 4; ++j) {
            const int e = __builtin_amdgcn_readfirstlane((int)pe[e0 + j]);
            ur[j][0] = *(const u32x4*)(UBb + (size_t)e * 1024 + 16 * lane); ur[j][1] = *(const u32x4*)(UBb + (size_t)e * 1024 + 16 * lane + 8);
            vr[j][0] = *(const u32x4*)(VBb + (size_t)e * 1024 + 16 * lane); vr[j][1] = *(const u32x4*)(VBb + (size_t)e * 1024 + 16 * lane + 8);
        }
        float d[4];
#pragma unroll
        for (int j = 0; j < 4; ++j) {
            float sa = 0.f, sb = 0.f;
            sa = dot2bf(ur[j][0].x, h0.x, sa); sb = dot2bf(ur[j][0].y, h0.y, sb); sa = dot2bf(ur[j][0].z, h0.z, sa); sb = dot2bf(ur[j][0].w, h0.w, sb);
            sa = dot2bf(ur[j][1].x, h1.x, sa); sb = dot2bf(ur[j][1].y, h1.y, sb); sa = dot2bf(ur[j][1].z, h1.z, sa); sb = dot2bf(ur[j][1].w, h1.w, sb);
            d[j] = sa + sb;
        }
        float w[2], y;
#pragma unroll
        for (int i = 0; i < 2; ++i) { const float keep = b5 ? d[2 * i + 1] : d[2 * i], send = b5 ? d[2 * i] : d[2 * i + 1]; w[i] = keep + __shfl_xor(send, 32); }
        { const float keep = b4_ ? w[1] : w[0], send = b4_ ? w[0] : w[1]; y = keep + __shfl_xor(send, 16); }
        y += __shfl_xor(y, 8); y += __shfl_xor(y, 4); y += __shfl_xor(y, 2); y += __shfl_xor(y, 1);
        const float sc = gelu_tanh(y) * pg[e0 + (b4_ ? 2 : 0) + (b5 ? 1 : 0)];
#pragma unroll
        for (int j = 0; j < 4; ++j) {
            const float sj = __uint_as_float((unsigned)__builtin_amdgcn_readlane((int)__float_as_uint(sc), 32 * (j & 1) + 16 * ((j >> 1) & 1)));
            const f2 sj2 = {sj, sj};
#pragma unroll
            for (int hh = 0; hh < 2; ++hh)
#pragma unroll
                for (int k = 0; k < 4; ++k) { const unsigned dw = vr[j][hh][k]; const f2 vv = {bflo(dw), bfhi(dw)}; acc[4 * hh + k] = vv * sj2 + acc[4 * hh + k]; }
        }
    }
    }
    float xr[16];
    const float* xrow = X + (size_t)tok * 1024 + 16 * lane;
    float* xorow = p.out + (size_t)tok * 1024 + 16 * lane;
    const float* g2 = modl + (size_t)b * 6144 + 5 * 1024 + 16 * lane;
    float ss = 0;
#pragma unroll
    for (int q4 = 0; q4 < 4; ++q4) {
        const float4 xv = *(const float4*)(xrow + 4 * q4), gv = *(const float4*)(g2 + 4 * q4);
        float4 o; o.x = xv.x + gv.x * acc[2 * q4].x; o.y = xv.y + gv.y * acc[2 * q4].y; o.z = xv.z + gv.z * acc[2 * q4 + 1].x; o.w = xv.w + gv.w * acc[2 * q4 + 1].y;
        if (l == 0) *(float4*)(xorow + 4 * q4) = o;
        xr[4 * q4] = o.x; xr[4 * q4 + 1] = o.y; xr[4 * q4 + 2] = o.z; xr[4 * q4 + 3] = o.w;
        ss += o.x * o.x + o.y * o.y + o.z * o.z + o.w * o.w;
    }
    ss = wave_sum(ss);
    const float r = rsqrtf(ss * (1.f / 1024.f) + 1e-6f);
    if (l == 1) {
#pragma unroll
        for (int q4 = 0; q4 < 4; ++q4) {
            const float4 gv = *(const float4*)(p.in[28] + 16 * lane + 4 * q4);
            float4 o; o.x = xr[4 * q4] * r * gv.x; o.y = xr[4 * q4 + 1] * r * gv.y; o.z = xr[4 * q4 + 2] * r * gv.z; o.w = xr[4 * q4 + 3] * r * gv.w;
            *(float4*)(xorow + 4 * q4) = o;
        }
    } else {
        const float* g = p.in[2] + 1024 + 16 * lane; const float* mod1 = (const float*)(wsb(p) + WS_MOD) + ((size_t)4 + b) * 6144 + 16 * lane;
        bf16* hrow = (bf16*)(wsb(p) + WS_H2) + (size_t)tok * 1024 + 16 * lane;
        float hv[16];
#pragma unroll
        for (int q4 = 0; q4 < 4; ++q4) {
            const float4 gg = *(const float4*)(g + 4 * q4), s1 = *(const float4*)(mod1 + 1024 + 4 * q4), s0 = *(const float4*)(mod1 + 4 * q4);
            hv[4 * q4] = xr[4 * q4] * r * gg.x * (1.f + s1.x) + s0.x; hv[4 * q4 + 1] = xr[4 * q4 + 1] * r * gg.y * (1.f + s1.y) + s0.y;
            hv[4 * q4 + 2] = xr[4 * q4 + 2] * r * gg.z * (1.f + s1.z) + s0.z; hv[4 * q4 + 3] = xr[4 * q4 + 3] * r * gg.w * (1.f + s1.w) + s0.w;
        }
        u32x4 o0, o1;
        o0.x = cvt_pk_bf16(hv[0], hv[1]); o0.y = cvt_pk_bf16(hv[2], hv[3]); o0.z = cvt_pk_bf16(hv[4], hv[5]); o0.w = cvt_pk_bf16(hv[6], hv[7]);
        o1.x = cvt_pk_bf16(hv[8], hv[9]); o1.y = cvt_pk_bf16(hv[10], hv[11]); o1.z = cvt_pk_bf16(hv[12], hv[13]); o1.w = cvt_pk_bf16(hv[14], hv[15]);
        *(u32x4*)(hrow) = o0; *(u32x4*)(hrow + 8) = o1;
    }
}

constexpr int SMEM_BYTES = LDS_BYTES;
#ifndef REP_MASK
#define REP_MASK 0xffff
#endif
#ifndef REP_ID
#define REP_ID -1
#endif
#ifndef REP_N
#define REP_N 1
#endif
#define NREP(id) ((id) == REP_ID ? REP_N : 1)
__global__ void __launch_bounds__(512, 2) fwd_megakernel(Params p) {
    unsigned char* smem = g_lds;
    const int tid = threadIdx.x, half = __builtin_amdgcn_readfirstlane(tid >> 8);
    const int Gp = gridDim.x, bidp = blockIdx.x;
    const int G = Gp * 2, bid = bidp + half * Gp;
    unsigned char* sm = smem + half * 65536;
    volatile int* qslot = (volatile int*)(smem + LDS_CTL + 16) + half;
    if (tid < 64) ((unsigned*)(smem + LDS_CTL))[tid] = 0u;
    __syncthreads();
    unsigned* ctl = (unsigned*)(wsb(p) + WS_CTL);
    unsigned* qctr = ctl + 4096;
    XcdBarrier bar = xcd_barrier_post(ctl, (volatile LAS unsigned*)(smem + LDS_CTL));
#define PHASE_PTRS unsigned char* ws = wsb(p); const bf16* H = (const bf16*)(ws + WS_H); bf16* PROJ = (bf16*)(ws + WS_PROJ); float* X = (float*)(ws + WS_X); const float* mod = (const float*)(ws + WS_MOD); (void)H; (void)PROJ; (void)X; (void)mod;
    int qn = 0;

    for (int rep = 0; rep < NREP(0); ++rep) {
            PHASE_PTRS
        constexpr int N_MOD = 192, N_LAYER = 192 + 256 + 128 + 128 + 256 + 256 + 16, N_PK = 4, N_GW = 128, N_PW = 8;
        constexpr int NV = N_MOD + 2 * N_LAYER + N_PK + N_GW + N_PW;
        for (int vb = bid; vb < NV; vb += G) {
            int v = vb;
            if (v < N_MOD) { it_mod(p, v, sm); continue; }
            v -= N_MOD;
            if (v < 2 * N_LAYER) {
                const int l = v / N_LAYER; v -= l * N_LAYER;
                bf16* wtin = (bf16*)(ws + WS_WTIN) + (size_t)l * NPROJ * 1024;
                const float* win = p.in[6] + (size_t)l * 1024 * 1732;
                bf16* wtout = (bf16*)(ws + WS_WTOUT) + (size_t)l * 1024 * KMIX;
                const float* wout = p.in[22] + (size_t)l * 1024 * 1024;
                if (v < 192) { it_transpose(TrArgs{win, 1732, 0, 1732, wtin, 1024, 0, 1024, 768, 0, nullptr}, v, sm); }
                else if ((v -= 192) < 256) { it_transpose(TrArgs{win, 1732, 0, 1732, wtin + (size_t)768 * 1024, 1024, 0, 1024, 1024, 1, p.in[20] + (size_t)l * 8 * 64 * 128}, v, sm); }
                else if ((v -= 256) < 128) { it_transpose(TrArgs{win, 1732, 1280, 1732, wtin + (size_t)1792 * 1024, 1024, 0, 1024, 512, 0, nullptr}, v, sm); }
                else if ((v -= 128) < 128) { it_transpose(TrArgs{wout, 1024, 0, 1024, wtout, KMIX, 0, 512, 1024, 0, nullptr}, v, sm); }
                else if ((v -= 128) < 256) { it_transpose(TrArgs{wout, 1024, 0, 1024, wtout, KMIX, 512, 1024, 1024, 2, p.in[21] + (size_t)l * 8 * 128 * 64}, v, sm); }
                else if ((v -= 256) < 256) { it_transpose(TrArgs{p.in[23] + (size_t)l * 1024 * 1024, 1024, 0, 1024, (bf16*)(ws + WS_WTQ) + (size_t)l * 1024 * 1024, 1024, 0, 1024, 1024, 0, nullptr}, v, sm); }
                else { v -= 256; it_transpose(TrArgs{p.in[15] + (size_t)l * 256 * 256, 256, 0, 256, (bf16*)(ws + WS_WTGLU) + (size_t)l * 256 * 256, 256, 0, 256, 256, 0, nullptr}, v, sm); }
                continue;
            }
            v -= 2 * N_LAYER;
            if (v < N_PK) { const int l = v >> 1, w = v & 1; conv_chunk(p.in[24 + w] + (size_t)l * 8192, (bf16*)(ws + WS_PK) + (size_t)l * 16384 + w * 8192, 0, 1024); continue; }
            v -= N_PK;
            if (v < N_GW) { it_gw(p, v); continue; }
            v -= N_GW;
            it_ssm_pw(p, v);
        }
        xcd_barrier(bar);
    }
    for (int rep = 0; rep < NREP(1); ++rep) {
            PHASE_PTRS
        constexpr int N_NORM = NTOK / 4, N_TAB = 4096, N_KT = 256;
        for (int vb = bid; vb < N_NORM + N_TAB + N_KT; vb += G) {
            if (vb < N_KT) { it_ssm_kt(p, vb, sm); continue; }
            if (vb - N_KT < N_NORM) {
                const int t_ = opq_tid(); const int row = (vb - N_KT) * 4 + (t_ >> 6);
                const float* m0 = (const float*)(wsb(p) + WS_MOD) + (size_t)(row >> 12) * 6144;
                norm_mod_row(p.in[0] + (size_t)row * 1024, p.in[2], m0, m0 + 1024, (bf16*)(wsb(p) + WS_H) + (size_t)row * 1024, t_ & 63);
            } else {
                const size_t base = (size_t)(vb - N_KT - N_NORM) * 2048;
                const int t_ = opq_tid();
#pragma unroll
                for (int e = 0; e < 8; ++e) ssm_tab_entry(p, base + e * 256 + t_);
            }
        }
        xcd_barrier(bar);
    }

    for (int l = 0; l < 2; ++l) {
        const float* xin = l == 0 ? p.in[0] : p.out;
        for (int rep = 0; rep < NREP(2 + 8 * l); ++rep) {
            PHASE_PTRS
            const bf16* Hin = l == 0 ? H : (const bf16*)(ws + WS_H2);
            pg8::StaticOrder S; S.init(NTOK, NPROJ, Gp, bidp);
            pg8::gemm_phase<Epi256<EpiBf16>, pg8::StaticOrder, true, true>((PG8_LAS unsigned char*)g_lds, pg8::Gemm{Hin, (const bf16*)(ws + WS_WTIN) + (size_t)l * NPROJ * 1024, NTOK, NPROJ, 1024}, S, Epi256<EpiBf16>{EpiBf16{PROJ, NPROJ}});
            xcd_barrier(bar);
        }
        for (int rep = 0; rep < NREP(3 + 8 * l); ++rep) {
            PHASE_PTRS
            unsigned* ctr = qctr + 64 * (qn++);
            for (;;) {
                const int it = q_next(ctr, qslot);
                if (it >= 2048) break;
                const bool extra = rep + 1 < NREP(3 + 8 * l);
                const int ty = it < 1024 ? 0 : it < 1536 ? 1 : it < 1792 ? 2 : 3;
                if (extra && !((REP_MASK >> ty) & 1)) continue;
                if (it < 1024) it_dsa_index_select(p, it, sm, extra ? ((REP_MASK >> 4) & 3) : 3);
                else if (it < 1536) it_gmlp(p, l, it - 1024, sm);
                else if (it < 1792) it_ssm_a(p, l, it - 1536);
                else it_kvn(p, l, it - 1792);
            }
            xcd_barrier(bar);
        }
        for (int rep = 0; rep < NREP(4 + 8 * l); ++rep) {
            PHASE_PTRS
            unsigned* ctr = qctr + 64 * (qn++);
            for (;;) {
                const int it = q_next(ctr, qslot);
                if (it >= 256 + 1024 + 512) break;
                { const bool extra = rep + 1 < NREP(4 + 8 * l); const int ty = it < 256 ? 0 : it < 1280 ? 1 : 2; if (extra && !((REP_MASK >> (8 + ty)) & 1)) continue; }
                if (it < 256) it_ssm_c(p, l, it, sm);
                else if (it < 1280) it_dsa_attn(p, it - 256, sm);
                else {
                    const int v = it - 1280, w = v >> 8, ch = v & 255;
                    if (!(PEER_FP8_MASK & (1 << l))) conv_chunk(p.in[26 + w] + (size_t)l * NEXP * 1024, (bf16*)(ws + (w ? WS_VB : WS_UB)), (size_t)ch * 8192, 8192);
                    else conv_chunk_fp8(p.in[26 + w] + (size_t)l * NEXP * 1024, ws + (w ? WS_VB : WS_UB), (size_t)ch * 4096, 4096, w ? V_SCALE : U_SCALE);
                }
            }
            xcd_barrier(bar);
        }
        for (int rep = 0; rep < NREP(5 + 8 * l); ++rep) {
            PHASE_PTRS
            const EpiGlu epi{(const bf16*)(ws + WS_YG), p.in[16] + l * 256, (bf16*)(ws + WS_MIX)};
            const bf16* Bt = (const bf16*)(ws + WS_WTGLU) + (size_t)l * 256 * 256;
            for (int t = bid; t < (NTOK / 64) * 2; t += G) gemm_tile64((const bf16*)(ws + WS_YG), 256, Bt, 256, 256, (t >> 1) * 64, (t & 1) * 128, (bf16*)sm, epi);
            xcd_barrier(bar);
        }
        for (int rep = 0; rep < NREP(6 + 8 * l); ++rep) {
            PHASE_PTRS
            pg8::StaticOrder S; S.init(NTOK, 1024, Gp, bidp);
            pg8::gemm_phase<Epi256<EpiResid>, pg8::StaticOrder, false, true>((PG8_LAS unsigned char*)g_lds, pg8::Gemm{(const bf16*)(ws + WS_MIX), (const bf16*)(ws + WS_WTOUT) + (size_t)l * 1024 * KMIX, NTOK, 1024, KMIX}, S, Epi256<EpiResid>{EpiResid{xin, X, mod + (size_t)l * 4 * 6144 + 2048}});
            xcd_barrier(bar);
        }
        for (int rep = 0; rep < NREP(7 + 8 * l); ++rep) {
            PHASE_PTRS
            for (int vb = bid; vb < NTOK / 4; vb += G) {
                const int t_ = opq_tid(); const int row = vb * 4 + (t_ >> 6);
                const float* m0 = (const float*)(wsb(p) + WS_MOD) + ((size_t)l * 4 + (row >> 12)) * 6144 + 3072;
                norm_mod_row((const float*)(wsb(p) + WS_X) + (size_t)row * 1024, p.in[3] + l * 1024, m0, m0 + 1024, (bf16*)(wsb(p) + WS_H) + (size_t)row * 1024, t_ & 63);
            }
            xcd_barrier(bar);
        }
        for (int rep = 0; rep < NREP(8 + 8 * l); ++rep) {
            PHASE_PTRS
            pg8::StaticOrder S; S.init(NTOK, 1024, Gp, bidp);
            pg8::gemm_phase<Epi256<EpiBf16>, pg8::StaticOrder, false, true>((PG8_LAS unsigned char*)g_lds, pg8::Gemm{H, (const bf16*)(ws + WS_WTQ) + (size_t)l * 1024 * 1024, NTOK, 1024, 1024}, S, Epi256<EpiBf16>{EpiBf16{PROJ, 1024}});
            xcd_barrier(bar);
        }
        for (int rep = 0; rep < NREP(9 + 8 * l); ++rep) {
            PHASE_PTRS
            PeerLds2& S = *(PeerLds2*)sm;
            hsync();
            const int t_ = opq_tid(), lane_ = t_ & 63, wave_ = t_ >> 6;
            for (int wb = bid * 4 + wave_; wb < NTOK / 8; wb += G * 4) {
                peer_retrieve(p, l, wb * 8, S, lane_, wave_);
                for (int tt = 0; tt < 8; ++tt) {
                    if (PEER_FP8_MASK & (1 << l)) peer_experts<true>(p, l, wb * 8 + tt, tt, S, lane_, wave_);
                    else peer_experts<false>(p, l, wb * 8 + tt, tt, S, lane_, wave_);
                }
            }
            if (l == 0 || rep + 1 < NREP(9 + 8 * l)) xcd_barrier(bar);
        }
    }
}

extern "C" void kernel_launch(void* const* d_in, const int* in_sizes, int n_in, void* d_out, int out_size, void* d_ws, size_t ws_size, hipStream_t stream) {
    if (n_in != 29 || ws_size < WS_END) { fprintf(stderr, "kernel_launch: bad args (n_in %d, ws %zu, need %zu)\n", n_in, ws_size, (size_t)WS_END); return; }
    static int grid = 0;
    if (grid == 0) {
        int dev = 0, cus = 0, per_cu = 0;
        if (hipGetDevice(&dev) != hipSuccess || hipDeviceGetAttribute(&cus, hipDeviceAttributeMultiprocessorCount, dev) != hipSuccess) { grid = -1; return; }
        if (hipFuncSetAttribute((const void*)fwd_megakernel, hipFuncAttributeMaxDynamicSharedMemorySize, LDS_BYTES) != hipSuccess) { fprintf(stderr, "kernel_launch: hipFuncSetAttribute failed\n"); grid = -1; return; }
        if (hipOccupancyMaxActiveBlocksPerMultiprocessor(&per_cu, (const void*)fwd_megakernel, 512, LDS_BYTES) != hipSuccess || per_cu < 1) { fprintf(stderr, "kernel_launch: occupancy query failed (%d)\n", per_cu); grid = -1; return; }
        grid = cus;
    }
    if (grid < 0) return;
    if (hipMemsetAsync((char*)d_ws + WS_CTL, 0, 65536, stream) != hipSuccess) { fprintf(stderr, "kernel_launch: memset failed\n"); return; }
    Params p{};
    for (int i = 0; i < 29; ++i) p.in[i] = (const float*)d_in[i];
    p.out = (float*)d_out; p.ws = (unsigned char*)d_ws;
    void* args[] = {&p};
    const hipError_t e = hipLaunchCooperativeKernel((const void*)fwd_megakernel, dim3(grid), dim3(512), args, LDS_BYTES, stream);
    if (e != hipSuccess) fprintf(stderr, "kernel_launch: cooperative launch failed: %s (grid %d)\n", hipGetErrorString(e), grid);
}
```

```cpp
#include <hip/hip_runtime.h>
#include <cstdint>
#include <cstdio>

typedef unsigned short bf16;
typedef short bf16x8 __attribute__((ext_vector_type(8)));
typedef short s16x4 __attribute__((ext_vector_type(4)));
typedef float f32x4 __attribute__((ext_vector_type(4)));
typedef unsigned u32x4 __attribute__((ext_vector_type(4)));
typedef unsigned u32x2 __attribute__((ext_vector_type(2)));
typedef __bf16 bf2 __attribute__((ext_vector_type(2)));
#define DI __device__ __forceinline__
#define MFMA16(a, b, c) __builtin_amdgcn_mfma_f32_16x16x32_bf16((a), (b), (c), 0, 0, 0)

constexpr int DM = 1024, NB = 4, SEQ = 4096, NTOK = NB * SEQ;
constexpr int NPROJ = 2304;
constexpr int C_UA = 0, C_UB = 256, C_VB = 512, C_CKV = 768, C_QI = 896, C_KI = 1152, C_WI = 1216, C_QA = 1280;
constexpr int KMIX = 1536;
constexpr int NEXP = 16384;
constexpr size_t SCORES_PER_BATCH = (size_t)4096 * 2080;

constexpr size_t al256(size_t x) { return (x + 255) & ~(size_t)255; }
constexpr size_t WS_CTL = 0;
constexpr size_t WS_MOD = 65536;
constexpr size_t WS_WTIN = al256(WS_MOD + 2 * 4 * 6144 * 4);
constexpr size_t WS_WTOUT = al256(WS_WTIN + (size_t)2 * NPROJ * 1024 * 2);
constexpr size_t WS_WTQ = al256(WS_WTOUT + (size_t)2 * 1024 * KMIX * 2);
constexpr size_t WS_WTGLU = al256(WS_WTQ + (size_t)2 * 1024 * 1024 * 2);
constexpr size_t WS_GW = al256(WS_WTGLU + (size_t)2 * 256 * 256 * 2);
constexpr size_t WS_PK = al256(WS_GW + (size_t)2 * 4 * 128 * 128 * 2);
constexpr size_t WS_PW = al256(WS_PK + (size_t)2 * 2 * 128 * 64 * 2);
constexpr size_t WS_BB = al256(WS_PW + (size_t)2 * 16 * 65 * 64 * 2 * 4);
constexpr size_t WS_E = al256(WS_BB + (size_t)2 * 16 * 64 * 16 * 2 * 4);
constexpr size_t WS_G = al256(WS_E + (size_t)2 * 16 * 128 * 1024 * 2);
constexpr size_t WS_KT = al256(WS_G + (size_t)2 * 16 * 1024 * 128 * 2);
constexpr size_t WS_UB = al256(WS_KT + (size_t)2 * 16 * 64 * 256 * 2);
constexpr size_t WS_VB = al256(WS_UB + (size_t)NEXP * 1024 * 2);
constexpr size_t WS_H = al256(WS_VB + (size_t)NEXP * 1024 * 2);
constexpr size_t WS_PROJ = al256(WS_H + (size_t)NTOK * 1024 * 2);
constexpr size_t WS_SLOC = al256(WS_PROJ + (size_t)NTOK * NPROJ * 2);
constexpr size_t WS_YG = al256(WS_SLOC + (size_t)256 * 16 * 128 * 4);
constexpr size_t WS_KVN = al256(WS_YG + (size_t)NTOK * 256 * 2);
constexpr size_t WS_SEL = al256(WS_KVN + (size_t)NTOK * 128 * 2);
constexpr size_t WS_MIX = al256(WS_SEL + (size_t)NTOK * 256 * 2);
constexpr size_t WS_X = al256(WS_MIX + (size_t)NTOK * KMIX * 2);
constexpr size_t WS_SCORES = al256(WS_X + (size_t)NTOK * 1024 * 4);
constexpr size_t WS_H2 = al256(WS_SCORES + (size_t)NB * SCORES_PER_BATCH * 4);
constexpr size_t WS_END = al256(WS_H2 + (size_t)NTOK * 1024 * 2);

struct Params {
    const float* in[29];
    float* out;
    unsigned char* ws;
};

typedef __bf16 bf2v_t __attribute__((ext_vector_type(2)));
typedef float f2v_t __attribute__((ext_vector_type(2)));
DI unsigned cvt_pk_bf16(float lo, float hi) { const f2v_t f = {lo, hi}; const bf2v_t r = __builtin_convertvector(f, bf2v_t); return __builtin_bit_cast(unsigned, r); }
DI bf16 f2bf(float x) { return (bf16)(cvt_pk_bf16(x, 0.f) & 0xffffu); }
DI float bf2f(bf16 b) { return __uint_as_float((unsigned)b << 16); }
DI float bflo(unsigned u) { return __uint_as_float(u << 16); }
DI float bfhi(unsigned u) { return __uint_as_float(u & 0xffff0000u); }
DI float dot2bf(unsigned a, unsigned b, float c) { return __builtin_amdgcn_fdot2_f32_bf16(__builtin_bit_cast(bf2, a), __builtin_bit_cast(bf2, b), c, false); }
DI float gelu_tanh(float x) { const float u = 0.7978845608028654f * (x + 0.044715f * x * x * x); const float e = __expf(2.f * u); const float t = 1.f - 2.f / (e + 1.f); return 0.5f * x * (1.f + t); }
DI float sigmoidf(float x) { return 1.f / (1.f + __expf(-x)); }
DI float wave_sum(float v) { for (int o = 32; o > 0; o >>= 1) v += __shfl_xor(v, o); return v; }
DI unsigned wave_sum_u32(unsigned v) {
    int x = (int)v;
    x += __builtin_amdgcn_update_dpp(0, x, 0xB1, 0xf, 0xf, true);
    x += __builtin_amdgcn_update_dpp(0, x, 0x4E, 0xf, 0xf, true);
    x += __builtin_amdgcn_update_dpp(0, x, 0x141, 0xf, 0xf, true);
    x += __builtin_amdgcn_update_dpp(0, x, 0x140, 0xf, 0xf, true);
    x += __builtin_amdgcn_update_dpp(0, x, 0x142, 0xa, 0xf, true);
    x += __builtin_amdgcn_update_dpp(0, x, 0x143, 0xc, 0xf, true);
    return (unsigned)__builtin_amdgcn_readlane(x, 63);
}
DI unsigned wave_scan_incl_u32(unsigned v) {
    int x = (int)v;
    x += __builtin_amdgcn_update_dpp(0, x, 0x111, 0xf, 0xf, true);
    x += __builtin_amdgcn_update_dpp(0, x, 0x112, 0xf, 0xf, true);
    x += __builtin_amdgcn_update_dpp(0, x, 0x114, 0xf, 0xf, true);
    x += __builtin_amdgcn_update_dpp(0, x, 0x118, 0xf, 0xf, true);
    x += __builtin_amdgcn_update_dpp(0, x, 0x142, 0xa, 0xf, true);
    x += __builtin_amdgcn_update_dpp(0, x, 0x143, 0xc, 0xf, true);
    return (unsigned)x;
}
DI unsigned fkey(float v) { const unsigned u = __float_as_uint(v); return (u & 0x80000000u) ? ~u : (u | 0x80000000u); }
DI unsigned unkey(unsigned k) { return (k & 0x80000000u) ? (k & 0x7fffffffu) : ~k; }
DI bf16x8 ld16(const void* p) { return *(const bf16x8*)p; }
DI bf16x8 zero8() { bf16x8 z = {0, 0, 0, 0, 0, 0, 0, 0}; return z; }


#define XB_TMO      128
#define XB_XCNT(j)  (256  + 64 * (j))
#define XB_XSUB(j)  (1280 + 64 * (j))
#define XB_XGEN(j)  (2304 + 64 * (j))
#define XB_TOP      3328
#define XB_TOPGEN   3392
#define XCD_BAR_WORDS 3456
#define XB_SPIN_CAP (1u << 22)
#define LAS __attribute__((address_space(3)))
DI unsigned xb_ld(unsigned* p)              { return __hip_atomic_load(p, __ATOMIC_RELAXED, __HIP_MEMORY_SCOPE_AGENT); }
DI unsigned xb_add(unsigned* p, unsigned v) { return __hip_atomic_fetch_add(p, v, __ATOMIC_RELAXED, __HIP_MEMORY_SCOPE_AGENT); }
DI unsigned xb_xcc_id() { return (unsigned)__builtin_amdgcn_s_getreg((3 << 11) | 20) & 0xFu; }
#define XB_SPIN(cond, bar) do { unsigned _sp = 0; while (cond) { __builtin_amdgcn_s_sleep(1); \
    if ((++_sp & 255u) == 0u) { if (xb_ld(&(bar)[XB_TMO])) break; if (_sp > XB_SPIN_CAP) { atomicAdd(&(bar)[XB_TMO], 1u); break; } } } } while (0)
struct XcdBarrier { unsigned* bar; unsigned x; volatile LAS unsigned* st; };
DI XcdBarrier xcd_barrier_post(unsigned* bar, volatile LAS unsigned* st) {
    XcdBarrier b; b.bar = bar; b.x = xb_xcc_id(); b.st = st;
    if (threadIdx.x == 0) (void)xb_add(&bar[XB_XCNT(b.x)], 1u);
    return b;
}
DI void xcd_barrier_complete(unsigned* bar, unsigned x, unsigned& nloc, unsigned& nx) {
    const unsigned G = gridDim.x * gridDim.y * gridDim.z;
    unsigned sum, cnt, mine, sp = 0u;
    for (;;) {
        sum = 0u; cnt = 0u; mine = 0u;
#pragma unroll
        for (unsigned j = 0; j < 16; ++j) { const unsigned c = xb_ld(&bar[XB_XCNT(j)]); sum += c; cnt += (c > 0u) ? 1u : 0u; mine = (j == x) ? c : mine; }
        if (sum == G) break;
        __builtin_amdgcn_s_sleep(1);
        if ((++sp & 255u) == 0u) { if (xb_ld(&bar[XB_TMO])) break; if (sp > XB_SPIN_CAP) { atomicAdd(&bar[XB_TMO], 1u); break; } }
    }
    nloc = mine > 0u ? mine : 1u; nx = cnt > 0u ? cnt : 1u;
}
DI void xcd_barrier(const XcdBarrier& b) {
    asm volatile("s_waitcnt vmcnt(0)" ::: "memory");
    __syncthreads();
    if (threadIdx.x == 0) {
        unsigned* bar = b.bar;
        __builtin_amdgcn_s_waitcnt(0);
        unsigned nloc = b.st[0], nx = b.st[1];
        if (nloc == 0u) { xcd_barrier_complete(bar, b.x, nloc, nx); b.st[0] = nloc; b.st[1] = nx; }
        const unsigned old = xb_add(&bar[XB_XSUB(b.x)], 1u);
        const unsigned gen = old / nloc;
        if (old + 1u == (gen + 1u) * nloc) {
            __builtin_amdgcn_fence(__ATOMIC_RELEASE, "agent");
            asm volatile("s_waitcnt vmcnt(0)" ::: "memory");
            const unsigned og = xb_add(&bar[XB_TOP], 1u);
            const unsigned tg = og / nx;
            if (og + 1u == (tg + 1u) * nx) xb_add(&bar[XB_TOPGEN], 1u);
            else XB_SPIN(xb_ld(&bar[XB_TOPGEN]) == tg, bar);
            __builtin_amdgcn_fence(__ATOMIC_ACQUIRE, "agent");
            xb_add(&bar[XB_XGEN(b.x)], 1u);
            asm volatile("s_waitcnt vmcnt(0)" ::: "memory");
        } else {
            XB_SPIN(xb_ld(&bar[XB_XGEN(b.x)]) == gen, bar);
            __builtin_amdgcn_fence(__ATOMIC_ACQUIRE, "agent");
            asm volatile("s_waitcnt vmcnt(0)" ::: "memory");
        }
    }
    __syncthreads();
}
typedef __attribute__((address_space(1))) unsigned char g_uc;
DI unsigned char* wsb(const Params& p) {
    typedef const unsigned long long __attribute__((address_space(4))) karg_u64;
    const unsigned long long w = *(karg_u64*)((const char __attribute__((address_space(4)))*)__builtin_amdgcn_kernarg_segment_ptr() + __builtin_offsetof(Params, ws));
    unsigned lo = (unsigned)w, hi = (unsigned)(w >> 32);
    asm volatile("" : "+s"(lo), "+s"(hi));
    return (unsigned char*)(g_uc*)(((unsigned long long)hi << 32) | lo);
}
extern __shared__ __attribute__((aligned(1024))) unsigned char g_lds[];
constexpr int LDS_CTL = 131072, LDS_BYTES = 131072 + 256;
DI int opq_tid() { int t = (int)(threadIdx.x & 255u); asm volatile("" : "+v"(t)); return t; }
DI void hsync() {
    asm volatile("s_waitcnt lgkmcnt(0)" ::: "memory");
    LAS unsigned* ctr = (LAS unsigned*)(g_lds + LDS_CTL + 32) + (threadIdx.x >> 8);
    unsigned old = 0u;
    if ((threadIdx.x & 63u) == 0u) old = __hip_atomic_fetch_add(ctr, 1u, __ATOMIC_RELAXED, __HIP_MEMORY_SCOPE_WORKGROUP);
    old = (unsigned)__builtin_amdgcn_readfirstlane((int)old);
    const unsigned target = (old & ~3u) + 4u;
    while (__hip_atomic_load(ctr, __ATOMIC_RELAXED, __HIP_MEMORY_SCOPE_WORKGROUP) < target) __builtin_amdgcn_s_sleep(1);
    asm volatile("" ::: "memory");
}
DI void hsync_g() { asm volatile("s_waitcnt vmcnt(0)" ::: "memory"); hsync(); }
DI int q_next(unsigned* ctr, volatile int* slot) {
    hsync();
    if ((threadIdx.x & 255u) == 0u) *slot = (int)__hip_atomic_fetch_add(ctr, 1u, __ATOMIC_RELAXED, __HIP_MEMORY_SCOPE_AGENT);
    hsync();
    return *slot;
}
DI void it_mod(const Params& p, int vb, unsigned char* sm) {
    float (*ca)[1024] = (float (*)[1024])sm;
    float (*part)[4][64] = (float (*)[4][64])(sm + 16384);
    const float* c = p.in[1];
    const int tid = opq_tid();
    hsync();
    for (int i = tid; i < 4096; i += 256) { const float v = c[i]; ca[i >> 10][i & 1023] = v / (1.f + __expf(-v)); }
    hsync();
    const int col = tid & 63, sl = tid >> 6;
    const int idx = vb * 64 + col;
    const int l = idx / 6144, n = idx % 6144;
    const float* w = p.in[4] + (size_t)l * 1024 * 6144 + n + (size_t)(256 * sl) * 6144;
    float a0 = 0, a1 = 0, a2 = 0, a3 = 0;
#pragma unroll 32
    for (int k = 0; k < 256; ++k) { const float wv = w[(size_t)k * 6144]; const int kk = 256 * sl + k; a0 += ca[0][kk] * wv; a1 += ca[1][kk] * wv; a2 += ca[2][kk] * wv; a3 += ca[3][kk] * wv; }
    part[sl][0][col] = a0; part[sl][1][col] = a1; part[sl][2][col] = a2; part[sl][3][col] = a3;
    hsync();
    {
        const int bb = tid >> 6;
        const float v = part[0][bb][col] + part[1][bb][col] + part[2][bb][col] + part[3][bb][col] + p.in[5][l * 6144 + n];
        ((float*)(wsb(p) + WS_MOD))[((size_t)l * 4 + bb) * 6144 + n] = v;
    }
}

struct TrArgs { const float* src; int lds, coff, nvalid; bf16* dst; int ldd, doff; int K, N; int mode; const float* aux; };
DI void it_transpose(const TrArgs& a, int vb4, unsigned char* sm) {
    const int tid = opq_tid(), lane = tid & 63, wave = tid >> 6, tx = lane & 31, ty = lane >> 5;
    float (*t)[33] = (float (*)[33])(sm + wave * 4224);
    float (*ta)[65] = (float (*)[65])(sm + 16896 + wave * 8320);
    float (*tb)[33] = (float (*)[33])(sm + 16896 + 33280);
    const int nk = a.K / 32;
    const int vb = vb4 * 4 + wave, kt = vb % nk, nt = vb / nk;
    hsync();
    if (a.mode == 0) {
        float v[16];
#pragma unroll
        for (int i = 0; i < 16; ++i) { const int k = kt * 32 + ty + 2 * i, n = nt * 32 + tx; v[i] = (n + a.coff < a.nvalid) ? a.src[(size_t)k * a.lds + n + a.coff] : 0.f; }
#pragma unroll
        for (int i = 0; i < 16; ++i) t[ty + 2 * i][tx] = v[i];
    } else if (a.mode == 1) {
        const int h = (nt * 32) >> 7, r0 = (nt * 32) & 127;
        float va[32], vb_[8];
#pragma unroll
        for (int i = 0; i < 32; ++i) va[i] = a.src[(size_t)(kt * 32 + i) * a.lds + 768 + 64 * h + lane];
#pragma unroll
        for (int i = 0; i < 8; ++i) { const int e = tid + 256 * i, d = e >> 5, rr = e & 31; vb_[i] = a.aux[((size_t)h * 64 + d) * 128 + r0 + rr]; }
#pragma unroll
        for (int i = 0; i < 32; ++i) ta[i][lane] = va[i];
#pragma unroll
        for (int i = 0; i < 8; ++i) { const int e = tid + 256 * i; tb[e >> 5][e & 31] = vb_[i]; }
        hsync();
#pragma unroll 2
        for (int r = ty; r < 32; r += 2) { float s = 0; _Pragma("unroll 16") for (int d = 0; d < 64; ++d) s += ta[r][d] * tb[d][tx]; t[r][tx] = s * 0.125f; }
    } else {
        const int h = (kt * 32) >> 7, r0 = (kt * 32) & 127;
        float va[32], vb_[8];
#pragma unroll
        for (int i = 0; i < 32; ++i) va[i] = a.aux[((size_t)h * 128 + r0 + i) * 64 + lane];
#pragma unroll
        for (int i = 0; i < 8; ++i) { const int e = tid + 256 * i, d = e >> 5, nn = e & 31; vb_[i] = a.src[(size_t)(512 + 64 * h + d) * a.lds + nt * 32 + nn]; }
#pragma unroll
        for (int i = 0; i < 32; ++i) ta[i][lane] = va[i];
#pragma unroll
        for (int i = 0; i < 8; ++i) { const int e = tid + 256 * i; tb[e >> 5][e & 31] = vb_[i]; }
        hsync();
#pragma unroll 2
        for (int r = ty; r < 32; r += 2) { float s = 0; _Pragma("unroll 16") for (int d = 0; d < 64; ++d) s += ta[r][d] * tb[d][tx]; t[r][tx] = s; }
    }
    asm volatile("s_waitcnt lgkmcnt(0)" ::: "memory");
#pragma unroll
    for (int i = 0; i < 16; ++i) {
        const int r = ty + 2 * i, n = nt * 32 + r, k = kt * 32 + tx;
        a.dst[(size_t)n * a.ldd + a.doff + k] = f2bf(t[tx][r]);
    }
}
DI void conv_chunk(const float* __restrict__ src, bf16* __restrict__ dst, size_t i0, int n8) {
    for (int i = opq_tid(); i < n8; i += 256) {
        const float4 a = ((const float4*)src)[2 * (i0 + i)], b = ((const float4*)src)[2 * (i0 + i) + 1];
        u32x4 o; o.x = cvt_pk_bf16(a.x, a.y); o.y = cvt_pk_bf16(a.z, a.w); o.z = cvt_pk_bf16(b.x, b.y); o.w = cvt_pk_bf16(b.z, b.w);
        ((u32x4*)dst)[i0 + i] = o;
    }
}
DI void it_gw(const Params& p, int vb) {
    for (int e = 0; e < 4; ++e) {
        const int idx = vb * 1024 + e * 256 + opq_tid();
        const int s = idx & 127, t = (idx >> 7) & 127;
        const float v = (t >= 64 || s < 64) ? p.in[17][idx] : 0.f;
        ((bf16*)(wsb(p) + WS_GW))[idx] = f2bf(v);
    }
}
DI void it_ssm_pw(const Params& p, int vb) {
    const int idx = vb * 256 + opq_tid();
    const int pp = idx & 63, g = (idx >> 6) & 15, l = idx >> 10;
    const float lre = -__expf(p.in[7][idx]), lim = p.in[8][idx];
    const float dt = __expf(p.in[14][l * 16 + g]);
    float* pw = (float*)(wsb(p) + WS_PW) + ((size_t)(l * 16 + g) * 65) * 128;
    for (int d = 0; d <= 64; ++d) {
        const float mag = expf(lre * dt * (float)d); float sn, cs; sincosf(lim * dt * (float)d, &sn, &cs);
        pw[d * 128 + pp * 2] = mag * cs; pw[d * 128 + pp * 2 + 1] = mag * sn;
    }
    const float mag = expf(lre * dt); float sn, cs; sincosf(lim * dt, &sn, &cs);
    const float are = mag * cs, aim = mag * sn;
    const float den = lre * lre + lim * lim, P = are - 1.f, Q = aim;
    const float fre = (P * lre + Q * lim) / den, fim = (Q * lre - P * lim) / den;
    float* bb = (float*)(wsb(p) + WS_BB) + (size_t)idx * 32;
    for (int h = 0; h < 16; ++h) { const float br = p.in[9][(size_t)idx * 16 + h], bi = p.in[10][(size_t)idx * 16 + h]; bb[h * 2] = fre * br - fim * bi; bb[h * 2 + 1] = fre * bi + fim * br; }
}
DI void it_ssm_kt(const Params& p, int vb, unsigned char* sm) {
    float* cz = (float*)sm;
    float* bz = (float*)(sm + 8192);
    float* pz = (float*)(sm + 16384);
    const int tid = opq_tid();
    const int lg = vb >> 3, d0 = (vb & 7) * 8;
    const float* PW = (const float*)(wsb(p) + WS_PW) + ((size_t)lg * 65 + d0) * 128;
    const float* BB = (const float*)(wsb(p) + WS_BB) + (size_t)lg * 64 * 32;
    hsync();
    for (int i = tid; i < 1024; i += 256) { const int q = i >> 4, h = i & 15; cz[i * 2] = p.in[11][((size_t)lg * 16 + h) * 64 + q]; cz[i * 2 + 1] = p.in[12][((size_t)lg * 16 + h) * 64 + q]; }
    for (int i = tid; i < 2048; i += 256) bz[i] = BB[i];
    for (int i = tid; i < 1024; i += 256) pz[i] = PW[i];
    hsync();
    const int h = tid >> 4, hh = tid & 15;
    float acc[8];
#pragma unroll
    for (int d = 0; d < 8; ++d) acc[d] = 0.f;
    for (int q = 0; q < 64; ++q) {
        const float cr = cz[(q * 16 + h) * 2], ci = cz[(q * 16 + h) * 2 + 1], br = bz[(q * 16 + hh) * 2], bi = bz[(q * 16 + hh) * 2 + 1];
        const float xr = cr * br - ci * bi, xi = cr * bi + ci * br;
#pragma unroll
        for (int d = 0; d < 8; ++d) acc[d] += xr * pz[(d * 64 + q) * 2] - xi * pz[(d * 64 + q) * 2 + 1];
    }
    bf16* KT = (bf16*)(wsb(p) + WS_KT) + ((size_t)lg * 64 + d0) * 256;
    if (d0 == 0 && h == hh) acc[0] += p.in[13][(size_t)lg * 16 + h];
#pragma unroll
    for (int d = 0; d < 8; ++d) KT[d * 256 + tid] = f2bf(acc[d]);
    hsync();
}
DI void ssm_tab_entry(const Params& p, size_t idx) {
    const size_t NE = (size_t)2 * 16 * 128 * 1024;
    const float* PW = (const float*)(wsb(p) + WS_PW); const float* BB = (const float*)(wsb(p) + WS_BB);
    if (idx < NE) {
        const int kk = idx & 1023, pp = (idx >> 10) & 127; const int lg = (int)(idx >> 17);
        const int i = kk >> 4, hh = kk & 15, pq = pp & 63, part = pp >> 6;
        const float* pw = PW + ((size_t)lg * 65 + (63 - i)) * 128 + pq * 2; const float* bb = BB + ((size_t)lg * 64 + pq) * 32 + hh * 2;
        const float v = part ? (pw[0] * bb[1] + pw[1] * bb[0]) : (pw[0] * bb[0] - pw[1] * bb[1]);
        ((bf16*)(wsb(p) + WS_E))[idx] = f2bf(v);
    } else if (idx < 2 * NE) {
        const size_t e = idx - NE; const int pp = e & 127, jh = (e >> 7) & 1023; const int lg = (int)(e >> 17);
        const int j = jh >> 4, h = jh & 15, pq = pp & 63, part = pp >> 6;
        const float* pw = PW + ((size_t)lg * 65 + (j + 1)) * 128 + pq * 2;
        const float cr = p.in[11][((size_t)lg * 16 + h) * 64 + pq], ci = p.in[12][((size_t)lg * 16 + h) * 64 + pq];
        const float v = part ? -(cr * pw[1] + ci * pw[0]) : (cr * pw[0] - ci * pw[1]);
        ((bf16*)(wsb(p) + WS_G))[e] = f2bf(v);
    } else {
        const size_t e = idx - 2 * NE; if (e >= (size_t)2 * 16 * 64 * 256) return;
        const int hh = e & 15, h = (e >> 4) & 15, d = (e >> 8) & 63; const int lg = (int)(e >> 14);
        const float* pw = PW + ((size_t)lg * 65 + d) * 128; const float* bb = BB + (size_t)lg * 64 * 32 + hh * 2;
        const float* cr = p.in[11] + ((size_t)lg * 16 + h) * 64; const float* ci = p.in[12] + ((size_t)lg * 16 + h) * 64;
        float s = 0;
        for (int q = 0; q < 64; ++q) { const float zr = pw[q * 2] * bb[q * 32] - pw[q * 2 + 1] * bb[q * 32 + 1], zi = pw[q * 2] * bb[q * 32 + 1] + pw[q * 2 + 1] * bb[q * 32]; s += cr[q] * zr - ci[q] * zi; }
        ((bf16*)(wsb(p) + WS_KT))[e] = f2bf(s);
    }
}
DI void norm_mod_row(const float* __restrict__ xrow, const float* __restrict__ g, const float* __restrict__ sh, const float* __restrict__ sc, bf16* __restrict__ hrow, int lane) {
    float4 v[4]; float ss = 0;
#pragma unroll
    for (int j = 0; j < 4; ++j) { v[j] = *(const float4*)(xrow + 4 * lane + 256 * j); ss += v[j].x * v[j].x + v[j].y * v[j].y + v[j].z * v[j].z + v[j].w * v[j].w; }
    ss = wave_sum(ss);
    const float r = rsqrtf(ss * (1.f / 1024.f) + 1e-6f);
#pragma unroll
    for (int j = 0; j < 4; ++j) {
        const int c = 4 * lane + 256 * j;
        const float4 gg = *(const float4*)(g + c), s1 = *(const float4*)(sc + c), s0 = *(const float4*)(sh + c);
        u32x2 o; o.x = cvt_pk_bf16(v[j].x * r * gg.x * (1.f + s1.x) + s0.x, v[j].y * r * gg.y * (1.f + s1.y) + s0.y);
        o.y = cvt_pk_bf16(v[j].z * r * gg.z * (1.f + s1.z) + s0.z, v[j].w * r * gg.w * (1.f + s1.w) + s0.w);
        *(u32x2*)(hrow + c) = o;
    }
}
namespace pg8 {
#define PG8_LAS __attribute__((address_space(3)))
typedef unsigned short bf16_t;
constexpr int BM = 256, BK = 64, HALF = 128, HTB = HALF * BK * 2  , STAGE_BYTES = 8 * HTB, NXCD = 8, WGM = 8;
__host__ __device__ __forceinline__ int lds_byte(int r, int c) { const int st = (r >> 4) * 2 + (c >> 5), rr = r & 15, cc = c & 31, ob = rr * 64 + cc * 2; return st * 1024 + (ob ^ (((ob >> 9) & 1) << 5)); }
__host__ __device__ __forceinline__ void stage_rc(int b, int& R, int& C) { const int st = b / 1024, sb = b % 1024, swz = sb ^ (((sb >> 9) & 1) << 5); R = (st >> 1) * 16 + swz / 64; C = (st & 1) * 32 + (swz % 64) / 2; }
__host__ __device__ __forceinline__ int perm32(int rho) { const int n = rho >> 4, i = rho & 15; return 8 * (i >> 2) + 4 * n + (i & 3); }

struct Unit { int pm, pn; };
struct Gemm { const bf16_t* A; const bf16_t* Bt; int M, N, K; };

struct StaticOrder {
    int nM, nN, nwg, G, c;
    __host__ __device__ void init(int M, int N, int G_, int c_) { nM = M / BM; nN = N / BM; nwg = nM * nN; G = G_; c = c_; }
    __host__ __device__ bool next(int i, Unit& u) const {
        const long L = (long)i * G + c; if (L >= nwg) return false;
        int wgid = (int)L; { const int q = nwg / NXCD, r = nwg % NXCD, xcd = wgid % NXCD, off = wgid / NXCD; wgid = (xcd < r ? xcd * (q + 1) : r * (q + 1) + (xcd - r) * q) + off; }
        const int nig = WGM * nN, gid = wgid / nig, fm = gid * WGM, gsz = (nM - fm) < WGM ? (nM - fm) : WGM;
        u.pm = fm + ((wgid % nig) % gsz); u.pn = (wgid % nig) / gsz; return true;
    }
    __device__ __forceinline__ void a_ready(const Unit&) const {}
    __device__ __forceinline__ void done(const Unit&) const {}
};

template <class Epi, class Sched, bool ALIGN_EPI = false, bool SP2 = false>
__device__ __forceinline__ void gemm_phase(PG8_LAS unsigned char* lds, const Gemm g, const Sched& S, const Epi& E) {
    int tid = (int)threadIdx.x; asm volatile("" : "+v"(tid));
    const int wid = __builtin_amdgcn_readfirstlane(tid >> 6), lane = tid & 63, wr = wid >> 2, wc = wid & 3, fr = lane & 15, fq = lane >> 4;
    const int K = g.K, nt = K / BK;
    unsigned voffA[2], voffB[2];
#pragma unroll
    for (int i = 0; i < 2; ++i) { int R, C; stage_rc(tid * 16 + i * 8192, R, C); const int Rb = Epi::PERM ? ((R & ~31) + perm32(R & 31)) : R;
        voffA[i] = (unsigned)(R * K + C) * 2u; voffB[i] = (unsigned)(Rb * K + C) * 2u; }
    const size_t kstep = (size_t)(BK * 2);
    const size_t hstep = (size_t)HALF * K * 2;
    const size_t tstep = 2 * hstep;
    const unsigned ldsw = (unsigned)wid * 1024u;
    const int aoff = lds_byte(wr * 64 + fr, fq * 8), boff = lds_byte(wc * 32 + fr, fq * 8);
#define PG8_SA(b, h) (((b) * 2 + (h)) * HTB)
#define PG8_SB(b, h) ((4 + (b) * 2 + (h)) * HTB)
#define PG8_STAGE(bufoff, gbase, voff) do { _Pragma("unroll") for (int _i = 0; _i < 2; ++_i) \
        __builtin_amdgcn_global_load_lds((const unsigned*)((const char*)(gbase) + (voff)[_i]), (PG8_LAS unsigned*)(lds + (bufoff) + ldsw + _i * 8192), 16, 0, 0); } while (0)
#define PG8_LDA(dst, b, h) do { _Pragma("unroll") for (int m = 0; m < 4; ++m) _Pragma("unroll") for (int k = 0; k < 2; ++k) dst[m][k] = *(const PG8_LAS bf16x8*)(lds + PG8_SA(b, h) + aoff + m * 2048 + k * 1024); } while (0)
#define PG8_LDB(dst, b, h) do { _Pragma("unroll") for (int n = 0; n < 2; ++n) _Pragma("unroll") for (int k = 0; k < 2; ++k) dst[n][k] = *(const PG8_LAS bf16x8*)(lds + PG8_SB(b, h) + boff + n * 2048 + k * 1024); } while (0)
#define PG8_MMA(ai, bj, At, Bt) do { __builtin_amdgcn_s_setprio(1); _Pragma("unroll") for (int m = 0; m < 4; ++m) _Pragma("unroll") for (int n = 0; n < 2; ++n) _Pragma("unroll") for (int k = 0; k < 2; ++k) \
        acc[ai][bj][m][n] = __builtin_amdgcn_mfma_f32_16x16x32_bf16(Bt[n][k], At[m][k], acc[ai][bj][m][n], 0, 0, 0); __builtin_amdgcn_s_setprio(0); } while (0)
#define PG8_WAIT_V(n) asm volatile("s_waitcnt vmcnt(" #n ")" ::: "memory")
#define PG8_WAIT_L(n) asm volatile("s_waitcnt lgkmcnt(" #n ")" ::: "memory")
#define PG8_BAR __builtin_amdgcn_s_barrier()
#define PG8_SCHED __builtin_amdgcn_sched_barrier(0)
    Unit cur, nxt; int ui = 0;
    if (!S.next(0, cur)) return;
    f32x4 acc[2][2][4][2];
#pragma unroll
    for (int a = 0; a < 2; ++a)
#pragma unroll
        for (int b = 0; b < 2; ++b)
#pragma unroll
            for (int m = 0; m < 4; ++m)
#pragma unroll
                for (int n = 0; n < 2; ++n) acc[a][b][m][n] = (f32x4){0.f, 0.f, 0.f, 0.f};
    bf16x8 At[4][2], B0[2][2], B1[2][2];
    const char* cA = (const char*)g.A + (size_t)cur.pm * tstep; const char* cB = (const char*)g.Bt + (size_t)cur.pn * tstep;
    S.a_ready(cur);
    if constexpr (SP2) {
        PG8_STAGE(PG8_SB(0, 0), cB, voffB); PG8_STAGE(PG8_SB(0, 1), cB + hstep, voffB); PG8_STAGE(PG8_SA(0, 0), cA, voffA); PG8_STAGE(PG8_SA(0, 1), cA + hstep, voffA);
        if (wr == 1) PG8_BAR;
        PG8_WAIT_V(2); PG8_BAR;
        PG8_STAGE(PG8_SB(1, 0), cB + kstep, voffB); PG8_STAGE(PG8_SA(1, 0), cA + kstep, voffA); PG8_STAGE(PG8_SB(1, 1), cB + hstep + kstep, voffB);
        PG8_WAIT_V(6); PG8_BAR;
    } else {
        PG8_STAGE(PG8_SB(0, 0), cB, voffB); PG8_STAGE(PG8_SA(0, 0), cA, voffA); PG8_STAGE(PG8_SB(0, 1), cB + hstep, voffB); PG8_STAGE(PG8_SA(0, 1), cA + hstep, voffA);
        if (wr == 1) PG8_BAR;
        PG8_WAIT_V(4); PG8_BAR;
        PG8_STAGE(PG8_SB(1, 0), cB + kstep, voffB); PG8_STAGE(PG8_SA(1, 0), cA + kstep, voffA); PG8_STAGE(PG8_SB(1, 1), cB + hstep + kstep, voffB);
        PG8_WAIT_V(6); PG8_BAR;
    }
    for (;;) {
        const bool has_next = S.next(ui + 1, nxt);
        const char* nA = has_next ? (const char*)g.A + (size_t)nxt.pm * tstep : cA; const char* nB = has_next ? (const char*)g.Bt + (size_t)nxt.pn * tstep : cB;
        for (int t = 0; t < nt; t += 2) {
            const bool last = (t == nt - 2);
            const char* a1 = cA + (size_t)(t + 1) * kstep;
            const char* a2 = last ? nA : cA + (size_t)(t + 2) * kstep; const char* b2 = last ? nB : cB + (size_t)(t + 2) * kstep;
            const char* a3 = a2 + kstep; const char* b3 = b2 + kstep;
            if (last && has_next) S.a_ready(nxt);
            if constexpr (SP2) {
            PG8_LDB(B0, 0, 0); PG8_LDB(B1, 0, 1); PG8_SCHED; PG8_LDA(At, 0, 0); PG8_STAGE(PG8_SA(1, 1), a1 + hstep, voffA);
            PG8_WAIT_V(8); PG8_WAIT_L(0); PG8_BAR; PG8_MMA(0, 0, At, B0); PG8_MMA(0, 1, At, B1); PG8_BAR; PG8_SCHED;
            PG8_LDA(At, 0, 1); PG8_STAGE(PG8_SB(0, 0), b2, voffB); PG8_STAGE(PG8_SB(0, 1), b2 + hstep, voffB); PG8_STAGE(PG8_SA(0, 0), a2, voffA);
            PG8_WAIT_V(8); PG8_WAIT_L(0); PG8_BAR; PG8_MMA(1, 0, At, B0); PG8_MMA(1, 1, At, B1); PG8_BAR; PG8_SCHED;
            PG8_LDB(B0, 1, 0); PG8_LDB(B1, 1, 1); PG8_SCHED; PG8_LDA(At, 1, 0); PG8_STAGE(PG8_SA(0, 1), a2 + hstep, voffA);
            PG8_WAIT_V(8); PG8_WAIT_L(0); PG8_BAR; PG8_MMA(0, 0, At, B0); PG8_MMA(0, 1, At, B1); PG8_BAR; PG8_SCHED;
            PG8_LDA(At, 1, 1); PG8_STAGE(PG8_SB(1, 0), b3, voffB); PG8_STAGE(PG8_SB(1, 1), b3 + hstep, voffB); PG8_STAGE(PG8_SA(1, 0), a3, voffA);
            PG8_WAIT_V(8); PG8_WAIT_L(0); PG8_BAR; PG8_MMA(1, 0, At, B0); PG8_MMA(1, 1, At, B1); PG8_BAR; PG8_SCHED;
            } else {
            PG8_LDB(B0, 0, 0); PG8_SCHED; PG8_LDA(At, 0, 0); PG8_STAGE(PG8_SA(1, 1), a1 + hstep, voffA);
            PG8_WAIT_L(8); PG8_BAR; PG8_WAIT_L(0); PG8_MMA(0, 0, At, B0); PG8_BAR; PG8_SCHED;
            PG8_LDB(B1, 0, 1); PG8_STAGE(PG8_SB(0, 0), b2, voffB);
            PG8_BAR; PG8_WAIT_L(0); PG8_MMA(0, 1, At, B1); PG8_BAR;
            PG8_LDA(At, 0, 1); PG8_STAGE(PG8_SA(0, 0), a2, voffA);
            PG8_BAR; PG8_WAIT_L(0); PG8_MMA(1, 0, At, B0); PG8_BAR; PG8_SCHED;
            PG8_STAGE(PG8_SB(0, 1), b2 + hstep, voffB);
            PG8_WAIT_V(6); PG8_BAR; PG8_MMA(1, 1, At, B1); PG8_BAR;
            PG8_LDB(B0, 1, 0); PG8_SCHED; PG8_LDA(At, 1, 0); PG8_STAGE(PG8_SA(0, 1), a2 + hstep, voffA);
            PG8_WAIT_L(8); PG8_BAR; PG8_WAIT_L(0); PG8_MMA(0, 0, At, B0); PG8_BAR; PG8_SCHED;
            PG8_LDB(B1, 1, 1); PG8_STAGE(PG8_SB(1, 0), b3, voffB);
            PG8_BAR; PG8_WAIT_L(0); PG8_MMA(0, 1, At, B1); PG8_BAR;
            PG8_LDA(At, 1, 1); PG8_STAGE(PG8_SA(1, 0), a3, voffA);
            PG8_BAR; PG8_WAIT_L(0); PG8_MMA(1, 0, At, B0); PG8_BAR; PG8_SCHED;
            PG8_STAGE(PG8_SB(1, 1), b3 + hstep, voffB);
            PG8_WAIT_V(6); PG8_BAR; PG8_MMA(1, 1, At, B1); PG8_BAR;
            }
        }
        if constexpr (ALIGN_EPI) { if (wr == 0) PG8_BAR; }
        if constexpr (!Epi::AFTER_DRAIN) { E(acc, cur, wr, wc, fr, fq); S.done(cur); }
        if (!has_next) break;
#pragma unroll
        for (int a = 0; a < 2; ++a)
#pragma unroll
            for (int b = 0; b < 2; ++b)
#pragma unroll
                for (int m = 0; m < 4; ++m)
#pragma unroll
                    for (int n = 0; n < 2; ++n) acc[a][b][m][n] = (f32x4){0.f, 0.f, 0.f, 0.f};
        cur = nxt; cA = nA; cB = nB; ++ui;
        if constexpr (ALIGN_EPI) { if (wr == 1) PG8_BAR; }
    }
    PG8_WAIT_V(0);
    if constexpr (!ALIGN_EPI) { if (wr == 0) PG8_BAR; }
    PG8_BAR;
    if constexpr (Epi::AFTER_DRAIN) { E.fused(acc, cur, wr, wc, fr, fq, lds, wid, lane); S.done(cur); }
#undef PG8_SA
#undef PG8_SB
#undef PG8_STAGE
#undef PG8_LDA
#undef PG8_LDB
#undef PG8_MMA
#undef PG8_WAIT_V
#undef PG8_WAIT_L
#undef PG8_BAR
#undef PG8_SCHED
}
}
struct EpiBf16 { bf16* C; int ldc; DI void operator()(int r, int c, f32x4 v) const { u32x2 o; o.x = cvt_pk_bf16(v[0], v[1]); o.y = cvt_pk_bf16(v[2], v[3]); *(u32x2*)(C + (size_t)r * ldc + c) = o; } };
struct EpiResid { const float* xin; float* xout; const float* gate;
    DI void operator()(int r, int c, f32x4 v) const { const float4 x = *(const float4*)(xin + (size_t)r * 1024 + c); const float4 g = *(const float4*)(gate + (size_t)(r >> 12) * 6144 + c);
        float4 o; o.x = x.x + g.x * v[0]; o.y = x.y + g.y * v[1]; o.z = x.z + g.z * v[2]; o.w = x.w + g.w * v[3]; *(float4*)(xout + (size_t)r * 1024 + c) = o; } };
struct EpiGlu { const bf16* yg; const float* bglu; bf16* mix;
    DI void operator()(int r, int c, f32x4 v) const { const u32x2 y = *(const u32x2*)(yg + (size_t)r * 256 + c); const float4 b = *(const float4*)(bglu + c);
        u32x2 o; o.x = cvt_pk_bf16(bflo(y.x) * sigmoidf(v[0] + b.x), bfhi(y.x) * sigmoidf(v[1] + b.y)); o.y = cvt_pk_bf16(bflo(y.y) * sigmoidf(v[2] + b.z), bfhi(y.y) * sigmoidf(v[3] + b.w));
        *(u32x2*)(mix + (size_t)r * KMIX + c) = o; } };
constexpr int GP = 72;
template <class Epi>
DI void gemm_tile64(const bf16* __restrict__ A, int lda, const bf16* __restrict__ Bt, int ldb, int K, int m0, int n0, bf16* lds, const Epi& epi) {
    bf16* As = lds; bf16* Bs = lds + 64 * GP;
    const int tid = opq_tid(), lane = tid & 63, wave = tid >> 6, wm = wave >> 1, wn = wave & 1;
    const int fr = lane & 15, fq = lane >> 4;
    const int lrow = tid >> 3, lch = tid & 7;
    f32x4 acc[4][2];
#pragma unroll
    for (int i = 0; i < 4; ++i)
#pragma unroll
        for (int j = 0; j < 2; ++j) acc[i][j] = (f32x4){0.f, 0.f, 0.f, 0.f};
    bf16x8 ra[2], rb[4];
    const bf16* Ag = A + (size_t)(m0 + lrow) * lda + lch * 8;
    const bf16* Bg = Bt + (size_t)(n0 + lrow) * ldb + lch * 8;
#pragma unroll
    for (int i = 0; i < 4; ++i) { if (i < 2) ra[i] = ld16(Ag + (size_t)32 * i * lda); rb[i] = ld16(Bg + (size_t)32 * i * ldb); }
    const int nk = K / 64;
    for (int kt = 0; kt < nk; ++kt) {
        hsync();
#pragma unroll
        for (int i = 0; i < 4; ++i) { if (i < 2) *(bf16x8*)(As + (lrow + 32 * i) * GP + lch * 8) = ra[i]; *(bf16x8*)(Bs + (lrow + 32 * i) * GP + lch * 8) = rb[i]; }
        hsync();
        if (kt + 1 < nk) {
#pragma unroll
            for (int i = 0; i < 4; ++i) { if (i < 2) ra[i] = ld16(Ag + (size_t)32 * i * lda + (kt + 1) * 64); rb[i] = ld16(Bg + (size_t)32 * i * ldb + (kt + 1) * 64); }
        }
#pragma unroll
        for (int ks = 0; ks < 2; ++ks) {
            bf16x8 fa[4], fb[2];
#pragma unroll
            for (int i = 0; i < 4; ++i) fa[i] = ld16(Bs + (64 * wn + 16 * i + fr) * GP + 32 * ks + 8 * fq);
#pragma unroll
            for (int j = 0; j < 2; ++j) fb[j] = ld16(As + (32 * wm + 16 * j + fr) * GP + 32 * ks + 8 * fq);
#pragma unroll
            for (int i = 0; i < 4; ++i)
#pragma unroll
                for (int j = 0; j < 2; ++j) acc[i][j] = MFMA16(fa[i], fb[j], acc[i][j]);
        }
    }
#pragma unroll
    for (int i = 0; i < 4; ++i)
#pragma unroll
        for (int j = 0; j < 2; ++j) epi(m0 + 32 * wm + 16 * j + fr, n0 + 64 * wn + 16 * i + 4 * fq, acc[i][j]);
}
template <class F> struct Epi256 {
    static constexpr bool PERM = false, AFTER_DRAIN = false;
    F f;
    DI void operator()(const f32x4 (&acc)[2][2][4][2], const pg8::Unit& u, int wr, int wc, int, int) const {
        int t_ = (int)threadIdx.x; asm volatile("" : "+v"(t_));
        const int fr = t_ & 15, fq = (t_ >> 4) & 3;
#pragma unroll
        for (int ai = 0; ai < 2; ++ai)
#pragma unroll
            for (int m = 0; m < 4; ++m)
#pragma unroll
                for (int bj = 0; bj < 2; ++bj)
#pragma unroll
                    for (int n = 0; n < 2; ++n) f(u.pm * 256 + ai * 128 + wr * 64 + m * 16 + fr, u.pn * 256 + bj * 128 + wc * 32 + n * 16 + 4 * fq, acc[ai][bj][m][n]);
    }
};

DI unsigned off_b(unsigned row, unsigned ch) { return 256u * row + 16u * (ch ^ (((row & 3u) << 2) | ((row >> 2) & 3u))); }
#define TR8(o0, o1, o2, o3, o4, o5, o6, o7, a0, a1, a2, a3, a4, a5, a6, a7)                                                                         \
    asm volatile("s_waitcnt lgkmcnt(0)\n\t"                                                                                                         \
                 "ds_read_b64_tr_b16 %0, %8\n\tds_read_b64_tr_b16 %1, %9\n\tds_read_b64_tr_b16 %2, %10\n\tds_read_b64_tr_b16 %3, %11\n\t"           \
                 "ds_read_b64_tr_b16 %4, %12\n\tds_read_b64_tr_b16 %5, %13\n\tds_read_b64_tr_b16 %6, %14\n\tds_read_b64_tr_b16 %7, %15\n\t"         \
                 "s_waitcnt lgkmcnt(0)"                                                                                                             \
                 : "=&v"(o0), "=&v"(o1), "=&v"(o2), "=&v"(o3), "=&v"(o4), "=&v"(o5), "=&v"(o6), "=&v"(o7)                                           \
                 : "v"(a0), "v"(a1), "v"(a2), "v"(a3), "v"(a4), "v"(a5), "v"(a6), "v"(a7)                                                           \
                 : "memory")

DI void it_kvn(const Params& p, int l, int vb) {
    const int lane = opq_tid() & 63, wave = opq_tid() >> 6;
    const bf16* proj = (const bf16*)(wsb(p) + WS_PROJ); bf16* kvn = (bf16*)(wsb(p) + WS_KVN);
    const float g0 = p.in[19][l * 128 + 2 * lane], g1 = p.in[19][l * 128 + 2 * lane + 1];
    for (int i = 0; i < 16; ++i) {
        const int row = vb * 64 + i * 4 + wave;
        const unsigned u = *(const unsigned*)(proj + (size_t)row * NPROJ + C_CKV + 2 * lane);
        const float a = bflo(u), b = bfhi(u);
        const float ss = wave_sum(a * a + b * b);
        const float r = rsqrtf(ss * (1.f / 128.f) + 1e-6f);
        *(unsigned*)(kvn + (size_t)row * 128 + 2 * lane) = cvt_pk_bf16(a * r * g0, b * r * g1);
    }
}

DI void it_ssm_a(const Params& p, int l, int item) {
    const int lane = opq_tid() & 63, wave = opq_tid() >> 6, fr = lane & 15, fq = lane >> 4;
    const bf16* proj = (const bf16*)(wsb(p) + WS_PROJ);
    float* sloc = (float*)(wsb(p) + WS_SLOC);
    const int g = item & 15, rt = item >> 4;
    const bf16* E = (const bf16*)(wsb(p) + WS_E) + ((size_t)(l * 16 + g) * 128) * 1024;
    const int R = 16 * rt + fr, b = R >> 6, k = R & 63;
    const bf16* arow = proj + ((size_t)b * 4096 + 64 * k + (fq >> 1)) * NPROJ + C_UA + 16 * g + 8 * (fq & 1);
    f32x4 acc[2] = {(f32x4){0, 0, 0, 0}, (f32x4){0, 0, 0, 0}};
#pragma unroll 4
    for (int ks = 0; ks < 32; ++ks) {
        const bf16x8 a = ld16(arow + (size_t)(2 * ks) * NPROJ);
#pragma unroll
        for (int c = 0; c < 2; ++c) { const int ct = 2 * wave + c; const bf16x8 bf = ld16(E + (size_t)(16 * ct + fr) * 1024 + 32 * ks + 8 * fq); acc[c] = MFMA16(a, bf, acc[c]); }
    }
#pragma unroll
    for (int c = 0; c < 2; ++c)
#pragma unroll
        for (int i = 0; i < 4; ++i) sloc[((size_t)(16 * rt + 4 * fq + i) * 16 + g) * 128 + 16 * (2 * wave + c) + fr] = acc[c][i];
}

DI void it_ssm_c(const Params& p, int l, int item, unsigned char* sm) {
    bf16* sst = (bf16*)sm;
    bf16* ktl = (bf16*)(sm + 17408);
    const int tid = opq_tid(), lane = tid & 63, wave = tid >> 6, fr = lane & 15, fq = lane >> 4;
    const bf16* proj = (const bf16*)(wsb(p) + WS_PROJ);
    const float* sloc = (const float*)(wsb(p) + WS_SLOC);
    bf16* yg = (bf16*)(wsb(p) + WS_YG);
    const int jq = item & 3, g = (item >> 2) & 15, b = item >> 6;
    const bf16* KT = (const bf16*)(wsb(p) + WS_KT) + (size_t)(l * 16 + g) * 64 * 256;
    hsync();
#pragma unroll
    for (int i = 0; i < 8; ++i) *(bf16x8*)(ktl + (i * 256 + tid) * 8) = ld16(KT + (size_t)(i * 256 + tid) * 8);
    if (wave == 0) {
        const float* pw64 = (const float*)(wsb(p) + WS_PW) + ((size_t)(l * 16 + g) * 65 + 64) * 128 + lane * 2;
        const float ar = pw64[0], ai = pw64[1];
        float sr = 0, si = 0;
        const float* s = sloc + ((size_t)(b * 64) * 16 + g) * 128;
#pragma unroll 8
        for (int k = 0; k < 64; ++k) {
            sst[k * 136 + lane] = f2bf(sr); sst[k * 136 + 64 + lane] = f2bf(si);
            const float lr = s[(size_t)k * 2048 + lane], li = s[(size_t)k * 2048 + 64 + lane];
            const float nr = ar * sr - ai * si + lr, ni = ar * si + ai * sr + li;
            sr = nr; si = ni;
        }
    }
    hsync();
    const bf16* G = (const bf16*)(wsb(p) + WS_G) + (size_t)(l * 16 + g) * 1024 * 128;
    const int kch = 16 * wave + fr;
    const bf16* arow = proj + ((size_t)b * 4096 + 64 * kch + (fq >> 1)) * NPROJ + C_UA + 16 * g + 8 * (fq & 1);
    const int j0 = 16 * jq;
    f32x4 acc[16];
#pragma unroll
    for (int jj = 0; jj < 16; ++jj) acc[jj] = (f32x4){0, 0, 0, 0};
    const int nks = (j0 + 15) / 2 + 1;
    bf16x8 a_cur[8], a_nxt[8];
#pragma unroll
    for (int i = 0; i < 8; ++i) a_cur[i] = ld16(arow + (size_t)(2 * i) * NPROJ);
    for (int k0 = 0; k0 < nks; k0 += 8) {
        const bool more = k0 + 8 < nks;
#pragma unroll
        for (int i = 0; i < 8; ++i) a_nxt[i] = more ? ld16(arow + (size_t)(2 * (k0 + 8 + i)) * NPROJ) : zero8();
#pragma unroll
        for (int i = 0; i < 8; ++i) {
            const int ks = k0 + i;
#pragma unroll
            for (int jj = 0; jj < 16; ++jj) {
                const int j = j0 + jj;
                if (2 * ks <= j) {
                    const int d = j - 2 * ks - (fq >> 1);
                    const bf16x8 bl = ld16(ktl + ((d < 0 ? 0 : d) * 16 + fr) * 16 + 8 * (fq & 1));
                    const bf16x8 bf = d >= 0 ? bl : zero8();
                    acc[jj] = MFMA16(bf, a_cur[i], acc[jj]);
                }
            }
        }
#pragma unroll
        for (int i = 0; i < 8; ++i) a_cur[i] = a_nxt[i];
    }
#pragma unroll
    for (int ks = 0; ks < 4; ++ks) {
        const bf16x8 a = ld16(sst + kch * 136 + 32 * ks + 8 * fq);
        bf16x8 bfr[16];
#pragma unroll
        for (int jj = 0; jj < 16; ++jj) bfr[jj] = ld16(G + ((size_t)((j0 + jj) * 16 + fr)) * 128 + 32 * ks + 8 * fq);
#pragma unroll
        for (int jj = 0; jj < 16; ++jj) acc[jj] = MFMA16(bfr[jj], a, acc[jj]);
    }
#pragma unroll
    for (int jj = 0; jj < 16; ++jj) {
        const size_t tok = (size_t)b * 4096 + 64 * (16 * wave + fr) + j0 + jj;
        u32x2 o; o.x = cvt_pk_bf16(gelu_tanh(acc[jj][0]), gelu_tanh(acc[jj][1])); o.y = cvt_pk_bf16(gelu_tanh(acc[jj][2]), gelu_tanh(acc[jj][3]));
        *(u32x2*)(yg + tok * 256 + 16 * g + 4 * fq) = o;
    }
}

DI void it_gmlp(const Params& p, int l, int item, unsigned char* sm) {
    bf16* vnT = (bf16*)sm;
    const int tid = opq_tid(), lane = tid & 63, wave = tid >> 6, fr = lane & 15, fq = lane >> 4;
    const bf16* proj = (const bf16*)(wsb(p) + WS_PROJ); bf16* mix = (bf16*)(wsb(p) + WS_MIX);
    const int h = item & 3, blk = item >> 2;
    const size_t tok0 = (size_t)blk * 128;
    hsync();
    {
        const int row = tid >> 1, half = tid & 1;
        const bf16* vp = proj + (tok0 + row) * NPROJ + C_VB + 64 * h + 32 * half;
        float v[32]; float s = 0;
#pragma unroll
        for (int q = 0; q < 4; ++q) { const bf16x8 t = ld16(vp + 8 * q);
#pragma unroll
            for (int e = 0; e < 8; ++e) { v[8 * q + e] = bf2f((bf16)t[e]); s += v[8 * q + e]; } }
        s += __shfl_xor(s, 1); const float mu = s * (1.f / 64.f);
        float vs = 0;
#pragma unroll
        for (int e = 0; e < 32; ++e) { const float d = v[e] - mu; vs += d * d; }
        vs += __shfl_xor(vs, 1); const float r = rsqrtf(vs * (1.f / 64.f) + 1e-6f);
#pragma unroll
        for (int e = 0; e < 32; ++e) vnT[(32 * half + e) * 136 + row] = f2bf((v[e] - mu) * r);
    }
    hsync();
    const bf16* W = (const bf16*)(wsb(p) + WS_GW) + (size_t)(l * 4 + h) * 128 * 128;
    f32x4 acc[4][2];
#pragma unroll
    for (int i = 0; i < 4; ++i) { acc[i][0] = (f32x4){0, 0, 0, 0}; acc[i][1] = (f32x4){0, 0, 0, 0}; }
#pragma unroll
    for (int ks = 0; ks < 4; ++ks) {
        bf16x8 fa[4], fb[2];
#pragma unroll
        for (int i = 0; i < 4; ++i) fa[i] = ld16(vnT + (16 * i + fr) * 136 + 32 * ks + 8 * fq);
#pragma unroll
        for (int j = 0; j < 2; ++j) fb[j] = ld16(W + (size_t)(16 * (2 * wave + j) + fr) * 128 + 32 * ks + 8 * fq);
#pragma unroll
        for (int i = 0; i < 4; ++i)
#pragma unroll
            for (int j = 0; j < 2; ++j) acc[i][j] = MFMA16(fa[i], fb[j], acc[i][j]);
    }
#pragma unroll
    for (int j = 0; j < 2; ++j) {
        const int t = 16 * (2 * wave + j) + fr;
        const float bs = p.in[18][(l * 4 + h) * 128 + t];
#pragma unroll
        for (int i = 0; i < 4; ++i) {
            const int d = 16 * i + 4 * fq;
            const u32x2 u = *(const u32x2*)(proj + (tok0 + t) * NPROJ + C_UB + 64 * h + d);
            u32x2 o; o.x = cvt_pk_bf16(bflo(u.x) * (acc[i][j][0] + bs), bfhi(u.x) * (acc[i][j][1] + bs)); o.y = cvt_pk_bf16(bflo(u.y) * (acc[i][j][2] + bs), bfhi(u.y) * (acc[i][j][3] + bs));
            *(u32x2*)(mix + (tok0 + t) * KMIX + 256 + 64 * h + d) = o;
        }
    }
}

DI size_t score_row_off(int b, int t) { const int c = t >> 6; return (size_t)b * SCORES_PER_BATCH + (size_t)4096 * (c * (c + 1) / 2) + (size_t)(t & 63) * 64 * (c + 1); }
template <int NR>
DI void dsa_select_impl(const float* __restrict__ srow, int nreg, bf16* __restrict__ so, int lane, unsigned* hist) {
    (void)hist;
    unsigned key[NR];
#pragma unroll
    for (int r = 0; r < NR; ++r) { const float v = srow[64 * r + lane]; key[r] = (r < nreg) ? fkey(v + 0.f) : 0u; }
    unsigned T = 0;
#pragma unroll 1
    for (int bit = 31; bit >= 0; --bit) {
        const unsigned cand = T | (1u << bit);
        unsigned c = 0;
#pragma unroll
        for (int r = 0; r < NR; ++r) asm("v_cmp_ge_u32 vcc, %1, %2\n\tv_addc_co_u32 %0, vcc, 0, %0, vcc" : "+v"(c) : "v"(key[r]), "v"(cand) : "vcc");
        const unsigned cnt = wave_sum_u32(c);
        if (cnt >= 256u) { T = cand; if (cnt == 256u) break; }
    }
    unsigned c = 0;
#pragma unroll
    for (int r = 0; r < NR; ++r) asm("v_cmp_gt_u32 vcc, %1, %2\n\tv_addc_co_u32 %0, vcc, 0, %0, vcc" : "+v"(c) : "v"(key[r]), "v"(T) : "vcc");
    const int need = 256 - (int)wave_sum_u32(c);
    int base = 0, eqb = 0;
    const unsigned long long lt = (1ull << lane) - 1ull;
#pragma unroll
    for (int r = 0; r < NR; ++r) {
        const unsigned long long me = __ballot(key[r] == T);
        const int erank = eqb + __popcll(me & lt);
        const bool take = (key[r] > T) || (key[r] == T && erank < need);
        const unsigned long long mt = __ballot(take);
        if (take) so[base + __popcll(mt & lt)] = (bf16)(64 * r + lane);
        base += __popcll(mt); eqb += __popcll(me);
    }
}
DI void dsa_select_query(const Params& p, int q, int lane, unsigned* hist) {
    const float* scores = (const float*)(wsb(p) + WS_SCORES); bf16* sel = (bf16*)(wsb(p) + WS_SEL);
    const int b = q >> 12, t = q & 4095, c = t >> 6, nreg = c + 1;
    bf16* so = sel + (size_t)q * 256;
    if (nreg <= 4) { for (int r = 0; r < nreg; ++r) so[64 * r + lane] = (bf16)(64 * r + lane); return; }
    const float* srow = scores + score_row_off(b, t);
    if (nreg <= 16) dsa_select_impl<16>(srow, nreg, so, lane, hist);
    else if (nreg <= 32) dsa_select_impl<32>(srow, nreg, so, lane, hist);
    else if (nreg <= 48) dsa_select_impl<48>(srow, nreg, so, lane, hist);
    else dsa_select_impl<64>(srow, nreg, so, lane, hist);
}
DI void it_dsa_index_select(const Params& p, int item, unsigned char* sm, int mode = 3) {
    const int lane = opq_tid() & 63, wave = opq_tid() >> 6, fr = lane & 15, fq = lane >> 4;
    const bf16* proj = (const bf16*)(wsb(p) + WS_PROJ); float* scores = (float*)(wsb(p) + WS_SCORES);
    const int c = 63 - (item >> 4), b = (item >> 2) & 3, qg = item & 3;
    if (c >= 4 && (mode & 1)) {
        const int t = 64 * c + 16 * qg + fr;
        const bf16* qrow = proj + ((size_t)b * 4096 + t) * NPROJ;
        bf16x8 qf[4][2];
#pragma unroll
        for (int hh = 0; hh < 4; ++hh)
#pragma unroll
            for (int ks = 0; ks < 2; ++ks) qf[hh][ks] = ld16(qrow + C_QI + 64 * hh + 32 * ks + 8 * fq);
        float w[4];
        { const u32x2 wv = *(const u32x2*)(qrow + C_WI); w[0] = bflo(wv.x) * 0.0625f; w[1] = bfhi(wv.x) * 0.0625f; w[2] = bflo(wv.y) * 0.0625f; w[3] = bfhi(wv.y) * 0.0625f; }
        float* srow = scores + score_row_off(b, t);
        const int ntile = 4 * (c + 1);
        const bf16* kbase = proj + ((size_t)b * 4096 + fr) * NPROJ + C_KI + 8 * fq;
        bf16x8 k0[4], k1[4];
#pragma unroll
        for (int u = 0; u < 4; ++u) { const bf16* krow = kbase + (size_t)16 * (wave + 4 * u) * NPROJ; k0[u] = ld16(krow); k1[u] = ld16(krow + 32); }
        for (int base = wave; base < ntile; base += 16) {
            bf16x8 n0[4], n1[4];
            const bool more = base + 16 < ntile;
            if (more) {
#pragma unroll
                for (int u = 0; u < 4; ++u) { const bf16* krow = kbase + (size_t)16 * (base + 16 + 4 * u) * NPROJ; n0[u] = ld16(krow); n1[u] = ld16(krow + 32); }
            }
#pragma unroll
            for (int u = 0; u < 4; ++u) {
                const int kt = base + 4 * u;
                if (kt >= ntile) break;
                f32x4 sc = {0, 0, 0, 0};
#pragma unroll
                for (int hh = 0; hh < 4; ++hh) {
                    f32x4 a = {0, 0, 0, 0};
                    a = MFMA16(k0[u], qf[hh][0], a); a = MFMA16(k1[u], qf[hh][1], a);
#pragma unroll
                    for (int i = 0; i < 4; ++i) sc[i] += w[hh] * fmaxf(a[i], 0.f);
                }
#pragma unroll
                for (int i = 0; i < 4; ++i) sc[i] += 0.f;
                *(f32x4*)(srow + 16 * kt + 4 * fq) = sc;
            }
            if (more) {
#pragma unroll
                for (int u = 0; u < 4; ++u) { k0[u] = n0[u]; k1[u] = n1[u]; }
            }
        }
    }
    hsync_g();
    if (mode & 2) for (int i = 0; i < 4; ++i) dsa_select_query(p, b * 4096 + 64 * c + 16 * qg + 4 * wave + i, lane, (unsigned*)sm + 1024 * wave);
}
DI void it_dsa_attn(const Params& p, int item, unsigned char* sm) {
    const int lane = opq_tid() & 63, wave = opq_tid() >> 6, fr = lane & 15, fq = lane >> 4;
    unsigned char* tile = sm + wave * 8192;
    bf16* selw = (bf16*)(sm + 32768 + wave * 512);
    const bf16* proj = (const bf16*)(wsb(p) + WS_PROJ); const bf16* kvn = (const bf16*)(wsb(p) + WS_KVN);
    const bf16* sel = (const bf16*)(wsb(p) + WS_SEL); bf16* mix = (bf16*)(wsb(p) + WS_MIX);
    unsigned wr_addr[8], rd_addr[2][4], tr_addr[8][2];
#pragma unroll
    for (int i = 0; i < 8; ++i) wr_addr[i] = off_b(4 * i + fq, fr);
#pragma unroll
    for (int rb = 0; rb < 2; ++rb)
#pragma unroll
        for (int s = 0; s < 4; ++s) rd_addr[rb][s] = off_b(8 * (fr >> 2) + 4 * rb + (fr & 3), 4 * s + fq);
    const unsigned tbase = (unsigned)(size_t)tile;
    {
        const unsigned q4 = fr >> 2, p4 = fr & 3;
#pragma unroll
        for (int c = 0; c < 8; ++c)
#pragma unroll
            for (int t = 0; t < 2; ++t) tr_addr[c][t] = tbase + off_b(8 * fq + 4 * t + q4, 2 * c + (p4 >> 1)) + 8 * (p4 & 1);
    }
    const float slope = fr < 8 ? exp2f(-(float)(fr + 1)) : 0.f;
    for (int qi = 0; qi < 4; ++qi) {
        const int q = item * 16 + wave * 4 + qi;
        const int b = q >> 12, t = q & 4095, c = t >> 6;
        const int nsel = (c + 1) * 64 < 256 ? (c + 1) * 64 : 256;
        const bf16* qa = proj + (size_t)q * NPROJ + C_QA;
        bf16x8 qf[4];
#pragma unroll
        for (int s = 0; s < 4; ++s) qf[s] = fr < 8 ? ld16(qa + fr * 128 + 32 * s + 8 * fq) : zero8();
        const bf16* selp = sel + (size_t)q * 256;
        const bf16* kvb = kvn + (size_t)b * 4096 * 128;
        if (4 * lane < nsel) *(u32x2*)(selw + 4 * lane) = *(const u32x2*)(selp + 4 * lane);
        float m_run = -INFINITY, l_run = 0.f;
        f32x4 o[8];
#pragma unroll
        for (int i = 0; i < 8; ++i) o[i] = (f32x4){0, 0, 0, 0};
        bf16x8 gk[8];
#pragma unroll
        for (int i = 0; i < 8; ++i) { const int key = selw[4 * i + fq]; gk[i] = ld16(kvb + (size_t)key * 128 + 8 * fr); }
        const int nt = nsel / 32;
        for (int ti = 0; ti < nt; ++ti) {
            const bf16x8 kp = ld16(selw + 32 * ti + 8 * fq);
#pragma unroll
            for (int i = 0; i < 8; ++i) *(bf16x8*)(tile + wr_addr[i]) = gk[i];
            if (ti + 1 < nt) {
#pragma unroll
                for (int i = 0; i < 8; ++i) { const int key = selw[32 * (ti + 1) + 4 * i + fq]; gk[i] = ld16(kvb + (size_t)key * 128 + 8 * fr); }
            }
            f32x4 lg[2] = {(f32x4){0, 0, 0, 0}, (f32x4){0, 0, 0, 0}};
#pragma unroll
            for (int rb = 0; rb < 2; ++rb)
#pragma unroll
                for (int s = 0; s < 4; ++s) lg[rb] = MFMA16(ld16(tile + rd_addr[rb][s]), qf[s], lg[rb]);
            float val[8]; float tmax = -INFINITY;
#pragma unroll
            for (int j = 0; j < 8; ++j) { const float dist = fabsf((float)(t - (int)(unsigned short)kp[j])); val[j] = lg[j >> 2][j & 3] - slope * dist; tmax = fmaxf(tmax, val[j]); }
            tmax = fmaxf(tmax, __shfl_xor(tmax, 16)); tmax = fmaxf(tmax, __shfl_xor(tmax, 32));
            const float m_new = fmaxf(m_run, tmax);
            const float scale = __expf(m_run - m_new);
            l_run *= scale;
#pragma unroll
            for (int i = 0; i < 8; ++i) o[i] *= scale;
            float pv[8];
#pragma unroll
            for (int j = 0; j < 8; ++j) { pv[j] = __expf(val[j] - m_new); l_run += pv[j]; }
            m_run = m_new;
            u32x4 pk; pk.x = cvt_pk_bf16(pv[0], pv[1]); pk.y = cvt_pk_bf16(pv[2], pv[3]); pk.z = cvt_pk_bf16(pv[4], pv[5]); pk.w = cvt_pk_bf16(pv[6], pv[7]);
            const bf16x8 pf = __builtin_bit_cast(bf16x8, pk);
            s16x4 tr[8][2];
            TR8(tr[0][0], tr[0][1], tr[1][0], tr[1][1], tr[2][0], tr[2][1], tr[3][0], tr[3][1], tr_addr[0][0], tr_addr[0][1], tr_addr[1][0], tr_addr[1][1], tr_addr[2][0], tr_addr[2][1], tr_addr[3][0], tr_addr[3][1]);
            TR8(tr[4][0], tr[4][1], tr[5][0], tr[5][1], tr[6][0], tr[6][1], tr[7][0], tr[7][1], tr_addr[4][0], tr_addr[4][1], tr_addr[5][0], tr_addr[5][1], tr_addr[6][0], tr_addr[6][1], tr_addr[7][0], tr_addr[7][1]);
#pragma unroll
            for (int cc = 0; cc < 8; ++cc) {
                bf16x8 kf; kf[0] = tr[cc][0][0]; kf[1] = tr[cc][0][1]; kf[2] = tr[cc][0][2]; kf[3] = tr[cc][0][3]; kf[4] = tr[cc][1][0]; kf[5] = tr[cc][1][1]; kf[6] = tr[cc][1][2]; kf[7] = tr[cc][1][3];
                o[cc] = MFMA16(kf, pf, o[cc]);
            }
        }
        float lt = l_run; lt += __shfl_xor(lt, 16); lt += __shfl_xor(lt, 32);
        const float inv = 1.f / lt;
        if (fr < 8) {
#pragma unroll
            for (int cc = 0; cc < 8; ++cc) { u32x2 ov; ov.x = cvt_pk_bf16(o[cc][0] * inv, o[cc][1] * inv); ov.y = cvt_pk_bf16(o[cc][2] * inv, o[cc][3] * inv);
                *(u32x2*)(mix + (size_t)q * KMIX + 512 + fr * 128 + 16 * cc + 4 * fq) = ov; }
        }
    }
}
typedef float f2 __attribute__((ext_vector_type(2)));
#ifndef PEER_FP8_MASK
#define PEER_FP8_MASK 3
#endif
constexpr float U_SCALE = 64.f, V_SCALE = 8.f;
DI unsigned pack4_fp8(float a, float b, float c, float d) { int p = __builtin_amdgcn_cvt_pk_fp8_f32(a, b, 0, false); p = __builtin_amdgcn_cvt_pk_fp8_f32(c, d, p, true); return (unsigned)p; }
DI void conv_chunk_fp8(const float* __restrict__ src, unsigned char* __restrict__ dst, size_t i0, int n16, float sc) {
    for (int i = opq_tid(); i < n16; i += 256) {
        const float4* s4 = (const float4*)src + 4 * (i0 + i);
        const float4 a = s4[0], b = s4[1], c = s4[2], d = s4[3];
        u32x4 o; o.x = pack4_fp8(a.x * sc, a.y * sc, a.z * sc, a.w * sc); o.y = pack4_fp8(b.x * sc, b.y * sc, b.z * sc, b.w * sc);
        o.z = pack4_fp8(c.x * sc, c.y * sc, c.z * sc, c.w * sc); o.w = pack4_fp8(d.x * sc, d.y * sc, d.z * sc, d.w * sc);
        ((u32x4*)dst)[i0 + i] = o;
    }
}
struct PeerLds2 {
    float trans[4][1024];
    unsigned char li[4][2][64][16];
    unsigned short pe[4][8][128];
    float pg[4][8][128];
};
template <int OFF, int NK>
DI void sort16_desc(unsigned (&k)[NK]) {
#pragma unroll
    for (int size = 2; size <= 16; size <<= 1)
#pragma unroll
        for (int stride = size >> 1; stride > 0; stride >>= 1)
#pragma unroll
            for (int i = 0; i < 16; ++i) {
                const int j = i ^ stride;
                if (j > i) {
                    const bool desc = ((i & size) == 0);
                    const unsigned a = k[OFF + i], b = k[OFF + j];
                    const unsigned hi = a > b ? a : b, lo = a > b ? b : a;
                    k[OFF + i] = desc ? hi : lo; k[OFF + j] = desc ? lo : hi;
                }
            }
}
template <int OA, int OB, int NK>
DI void merge_top16(unsigned (&k)[NK]) {
#pragma unroll
    for (int i = 0; i < 16; ++i) { const unsigned a = k[OA + i], b = k[OB + 15 - i]; k[OA + i] = a > b ? a : b; }
#pragma unroll
    for (int stride = 8; stride > 0; stride >>= 1)
#pragma unroll
        for (int i = 0; i < 16; ++i) {
            const int j = i ^ stride;
            if (j > i) { const unsigned a = k[OA + i], b = k[OA + j]; k[OA + i] = a > b ? a : b; k[OA + j] = a > b ? b : a; }
        }
}
DI void peer_retrieve(const Params& p, int l, int tok0, PeerLds2& S, int lane, int wave) {
    const int fr = lane & 15, fq = lane >> 4;
    const bf16* QP = (const bf16*)(wsb(p) + WS_PROJ);
    const bf16* PK = (const bf16*)(wsb(p) + WS_PK) + (size_t)l * 2 * 128 * 64;
    float* trans = S.trans[wave];
    unsigned K1[16], K2[16];
#pragma unroll
    for (int L = 0; L < 2; ++L) {
        f32x4 acc[4][8];
#pragma unroll
        for (int ct = 0; ct < 4; ++ct)
#pragma unroll
            for (int kt = 0; kt < 8; ++kt) acc[ct][kt] = (f32x4){0, 0, 0, 0};
#pragma unroll
        for (int kt = 0; kt < 8; ++kt) {
            const bf16* krow = PK + (size_t)L * 8192 + (size_t)(16 * kt + fr) * 64 + 8 * fq;
            const bf16x8 a0 = ld16(krow), a1 = ld16(krow + 32);
#pragma unroll
            for (int ct = 0; ct < 4; ++ct) {
                const bf16* qrow = QP + (size_t)(tok0 + 2 * ct + (fr >> 3)) * 1024 + 128 * (fr & 7) + 64 * L + 8 * fq;
                acc[ct][kt] = MFMA16(a0, ld16(qrow), acc[ct][kt]); acc[ct][kt] = MFMA16(a1, ld16(qrow + 32), acc[ct][kt]);
            }
        }
        unsigned k[128];
#define PEER_ROUND(kt)                                                                                                                            \
        {                                                                                                                                         \
            _Pragma("unroll") for (int ct = 0; ct < 4; ++ct) *(f32x4*)(trans + ((ct * 4 + fq) * 16 + fr) * 4) = acc[ct][kt];                       \
            _Pragma("unroll") for (int sq = 0; sq < 4; ++sq) {                                                                                     \
                const f32x4 v = *(const f32x4*)(trans + ((fq * 4 + sq) * 16 + fr) * 4);                                                            \
                _Pragma("unroll") for (int i = 0; i < 4; ++i) k[16 * (kt) + sq * 4 + i] = (fkey(v[i]) & ~0x7fu) | (unsigned)(16 * (kt) + 4 * sq + i); \
            }                                                                                                                                     \
            sort16_desc<16 * (kt)>(k);                                                                                                            \
        }
        PEER_ROUND(0) PEER_ROUND(1) merge_top16<0, 16>(k);
        PEER_ROUND(2) PEER_ROUND(3) merge_top16<32, 48>(k); merge_top16<0, 32>(k);
        PEER_ROUND(4) PEER_ROUND(5) merge_top16<64, 80>(k);
        PEER_ROUND(6) PEER_ROUND(7) merge_top16<96, 112>(k); merge_top16<64, 96>(k);
        merge_top16<0, 64>(k);
#undef PEER_ROUND
        u32x4 ib;
        ib.x = (k[0] & 127u) | ((k[1] & 127u) << 8) | ((k[2] & 127u) << 16) | ((k[3] & 127u) << 24);
        ib.y = (k[4] & 127u) | ((k[5] & 127u) << 8) | ((k[6] & 127u) << 16) | ((k[7] & 127u) << 24);
        ib.z = (k[8] & 127u) | ((k[9] & 127u) << 8) | ((k[10] & 127u) << 16) | ((k[11] & 127u) << 24);
        ib.w = (k[12] & 127u) | ((k[13] & 127u) << 8) | ((k[14] & 127u) << 16) | ((k[15] & 127u) << 24);
        *(u32x4*)(S.li[wave][L][lane]) = ib;
#pragma unroll
        for (int i = 0; i < 16; ++i) { if (L == 0) K1[i] = k[i]; else K2[i] = k[i]; }
    }
    float v1[16], v2[16];
#pragma unroll
    for (int i = 0; i < 16; ++i) { v1[i] = __uint_as_float(unkey(K1[i] & ~0x7fu)); v2[i] = __uint_as_float(unkey(K2[i] & ~0x7fu)); }
    unsigned c[64];
    {
        int idx = 0;
#pragma unroll
        for (int a = 0; a < 16; ++a)
#pragma unroll
            for (int b = 0; b < 16; ++b)
                if ((a + 1) * (b + 1) <= 16) { c[idx] = (fkey(v1[a] + v2[b]) & ~0xffu) | (unsigned)(a * 16 + b); ++idx; }
#pragma unroll
        for (int i = 50; i < 64; ++i) c[i] = 0u;
    }
    sort16_desc<0>(c); sort16_desc<16>(c); sort16_desc<32>(c); sort16_desc<48>(c);
    merge_top16<0, 16>(c); merge_top16<32, 48>(c); merge_top16<0, 32>(c);
    float sc[16]; float sum = 0.f;
    {
        const float m = __uint_as_float(unkey(c[0] & ~0xffu));
#pragma unroll
        for (int i = 0; i < 16; ++i) { sc[i] = __expf(__uint_as_float(unkey(c[i] & ~0xffu)) - m); sum += sc[i]; }
    }
    const float inv = 1.f / sum;
    const int tt = 2 * fq + (fr >> 3), head = fr & 7;
    const unsigned char* l1 = S.li[wave][0][lane]; const unsigned char* l2 = S.li[wave][1][lane];
#pragma unroll
    for (int i = 0; i < 16; ++i) {
        const unsigned ab = c[i] & 0xffu;
        const unsigned e = (unsigned)l1[ab >> 4] * 128u + (unsigned)l2[ab & 15u];
        S.pe[wave][tt][head * 16 + i] = (unsigned short)e; S.pg[wave][tt][head * 16 + i] = sc[i] * inv;
    }
}
template <bool FP8>
DI void peer_experts(const Params& p, int l, int tok, int tt, PeerLds2& S, int lane, int wave) {
    const bf16* H = (const bf16*)(wsb(p) + WS_H);
    const unsigned char* UB = wsb(p) + WS_UB; const unsigned char* VB = wsb(p) + WS_VB;
    const float* X = (const float*)(wsb(p) + WS_X);
    const float* modl = (const float*)(wsb(p) + WS_MOD) + (size_t)l * 4 * 6144;
    const int b = tok >> 12;
    const unsigned short* pe = S.pe[wave][tt]; const float* pg = S.pg[wave][tt];
    f2 hp[8];
    u32x4 h0, h1;
    {
        h0 = *(const u32x4*)(H + (size_t)tok * 1024 + 16 * lane); h1 = *(const u32x4*)(H + (size_t)tok * 1024 + 16 * lane + 8);
        hp[0] = (f2){bflo(h0.x), bfhi(h0.x)}; hp[1] = (f2){bflo(h0.y), bfhi(h0.y)}; hp[2] = (f2){bflo(h0.z), bfhi(h0.z)}; hp[3] = (f2){bflo(h0.w), bfhi(h0.w)};
        hp[4] = (f2){bflo(h1.x), bfhi(h1.x)}; hp[5] = (f2){bflo(h1.y), bfhi(h1.y)}; hp[6] = (f2){bflo(h1.z), bfhi(h1.z)}; hp[7] = (f2){bflo(h1.w), bfhi(h1.w)};
    }
    f2 acc[8];
#pragma unroll
    for (int i = 0; i < 8; ++i) acc[i] = (f2){0.f, 0.f};
    const bool b5 = (lane & 32) != 0, b4_ = (lane & 16) != 0, b3 = (lane & 8) != 0;
    const int eidx = (b3 ? 4 : 0) + (b4_ ? 2 : 0) + (b5 ? 1 : 0);
    if constexpr (FP8) {
    for (int e0 = 0; e0 < 128; e0 += 8) {
        u32x4 ur[8], vr[8];
#pragma unroll
        for (int j = 0; j < 8; ++j) {
            const int e = __builtin_amdgcn_readfirstlane((int)pe[e0 + j]);
            ur[j] = *(const u32x4*)(UB + (size_t)e * 1024 + 16 * lane);
            vr[j] = *(const u32x4*)(VB + (size_t)e * 1024 + 16 * lane);
        }
        float d[8];
#pragma unroll
        for (int j = 0; j < 8; ++j) {
            f2 s2 = {0.f, 0.f};
#pragma unroll
            for (int k = 0; k < 4; ++k) {
                const f2 lo = __builtin_amdgcn_cvt_pk_f32_fp8((int)ur[j][k], false), hi = __builtin_amdgcn_cvt_pk_f32_fp8((int)ur[j][k], true);
                s2 = lo * hp[2 * k] + s2; s2 = hi * hp[2 * k + 1] + s2;
            }
            d[j] = s2.x + s2.y;
        }
        float w[4], x2[2], y;
#pragma unroll
        for (int i = 0; i < 4; ++i) { const float keep = b5 ? d[2 * i + 1] : d[2 * i], send = b5 ? d[2 * i] : d[2 * i + 1]; w[i] = keep + __shfl_xor(send, 32); }
#pragma unroll
        for (int i = 0; i < 2; ++i) { const float keep = b4_ ? w[2 * i + 1] : w[2 * i], send = b4_ ? w[2 * i] : w[2 * i + 1]; x2[i] = keep + __shfl_xor(send, 16); }
        { const float keep = b3 ? x2[1] : x2[0], send = b3 ? x2[0] : x2[1]; y = keep + __shfl_xor(send, 8); }
        y += __shfl_xor(y, 4); y += __shfl_xor(y, 2); y += __shfl_xor(y, 1);
        const float sc = gelu_tanh(y * (1.f / U_SCALE)) * pg[e0 + eidx] * (1.f / V_SCALE);
#pragma unroll
        for (int j = 0; j < 8; ++j) {
            const float sj = __uint_as_float((unsigned)__builtin_amdgcn_readlane((int)__float_as_uint(sc), 32 * (j & 1) + 16 * ((j >> 1) & 1) + 8 * ((j >> 2) & 1)));
            const f2 sj2 = {sj, sj};
#pragma unroll
            for (int k = 0; k < 4; ++k) {
                const f2 lo = __builtin_amdgcn_cvt_pk_f32_fp8((int)vr[j][k], false), hi = __builtin_amdgcn_cvt_pk_f32_fp8((int)vr[j][k], true);
                acc[2 * k] = lo * sj2 + acc[2 * k]; acc[2 * k + 1] = hi * sj2 + acc[2 * k + 1];
            }
        }
    }
    } else {
    for (int e0 = 0; e0 < 128; e0 += 4) {
        const bf16* UBb = (const bf16*)UB; const bf16* VBb = (const bf16*)VB;
        u32x4 ur[4][2], vr[4][2];
#pragma unroll
        for (int j = 0; j < 4; ++j) {
            const int e = __builtin_amdgcn_readfirstlane((int)pe[e0 + j]);
            ur[j][0] = *(const u32x4*)(UBb + (size_t)e * 1024 + 16 * lane); ur[j][1] = *(const u32x4*)(UBb + (size_t)e * 1024 + 16 * lane + 8);
            vr[j][0] = *(const u32x4*)(VBb + (size_t)e * 1024 + 16 * lane); vr[j][1] = *(const u32x4*)(VBb + (size_t)e * 1024 + 16 * lane + 8);
        }
        float d[4];
#pragma unroll
        for (int j = 0; j < 4; ++j) {
            float sa = 0.f, sb = 0.f;
            sa = dot2bf(ur[j][0].x, h0.x, sa); sb = dot2bf(ur[j][0].y, h0.y, sb); sa = dot2bf(ur[j][0].z, h0.z, sa); sb = dot2bf(ur[j][0].w, h0.w, sb);
            sa = dot2bf(ur[j][1].x, h1.x, sa); sb = dot2bf(ur[j][1].y, h1.y, sb); sa = dot2bf(ur[j][1].z, h1.z, sa); sb = dot2bf(ur[j][1].w, h1.w, sb);
            d[j] = sa + sb;
        }
        float w[2], y;
#pragma unroll
        for (int i = 0; i < 2; ++i) { const float keep = b5 ? d[2 * i + 1] : d[2 * i], send = b5 ? d[2 * i] : d[2 * i + 1]; w[i] = keep + __shfl_xor(send, 32); }
        { const float keep = b4_ ? w[1] : w[0], send = b4_ ? w[0] : w[1]; y = keep + __shfl_xor(send, 16); }
        y += __shfl_xor(y, 8); y += __shfl_xor(y, 4); y += __shfl_xor(y, 2); y += __shfl_xor(y, 1);
        const float sc = gelu_tanh(y) * pg[e0 + (b4_ ? 2 : 0) + (b5 ? 1 : 0)];
#pragma unroll
        for (int j = 0; j < 4; ++j) {
            const float sj = __uint_as_float((unsigned)__builtin_amdgcn_readlane((int)__float_as_uint(sc), 32 * (j & 1) + 16 * ((j >> 1) & 1)));
            const f2 sj2 = {sj, sj};
#pragma unroll
            for (int hh = 0; hh < 2; ++hh)
#pragma unroll
                for (int k = 0; k < 4; ++k) { const unsigned dw = vr[j][hh][k]; const f2 vv = {bflo(dw), bfhi(dw)}; acc[4 * hh + k] = vv * sj2 + acc[4 * hh + k]; }
        }
    }
    }
    float xr[16];
    const float* xrow = X + (size_t)tok * 1024 + 16 * lane;
    float* xorow = p.out + (size_t)tok * 1024 + 16 * lane;
    const float* g2 = modl + (size_t)b * 6144 + 5 * 1024 + 16 * lane;
    float ss = 0;
#pragma unroll
    for (int q4 = 0; q4 < 4; ++q4) {
        const float4 xv = *(const float4*)(xrow + 4 * q4), gv = *(const float4*)(g2 + 4 * q4);
        float4 o; o.x = xv.x + gv.x * acc[2 * q4].x; o.y = xv.y + gv.y * acc[2 * q4].y; o.z = xv.z + gv.z * acc[2 * q4 + 1].x; o.w = xv.w + gv.w * acc[2 * q4 + 1].y;
        if (l == 0) *(float4*)(xorow + 4 * q4) = o;
        xr[4 * q4] = o.x; xr[4 * q4 + 1] = o.y; xr[4 * q4 + 2] = o.z; xr[4 * q4 + 3] = o.w;
        ss += o.x * o.x + o.y * o.y + o.z * o.z + o.w * o.w;
    }
    ss = wave_sum(ss);
    const float r = rsqrtf(ss * (1.f / 1024.f) + 1e-6f);
    if (l == 1) {
#pragma unroll
        for (int q4 = 0; q4 < 4; ++q4) {
            const float4 gv = *(const float4*)(p.in[28] + 16 * lane + 4 * q4);
            float4 o; o.x = xr[4 * q4] * r * gv.x; o.y = xr[4 * q4 + 1] * r * gv.y; o.z = xr[4 * q4 + 2] * r * gv.z; o.w = xr[4 * q4 + 3] * r * gv.w;
            *(float4*)(xorow + 4 * q4) = o;
        }
    } else {
        const float* g = p.in[2] + 1024 + 16 * lane; const float* mod1 = (const float*)(wsb(p) + WS_MOD) + ((size_t)4 + b) * 6144 + 16 * lane;
        bf16* hrow = (bf16*)(wsb(p) + WS_H2) + (size_t)tok * 1024 + 16 * lane;
        float hv[16];
#pragma unroll
        for (int q4 = 0; q4 < 4; ++q4) {
            const float4 gg = *(const float4*)(g + 4 * q4), s1 = *(const float4*)(mod1 + 1024 + 4 * q4), s0 = *(const float4*)(mod1 + 4 * q4);
            hv[4 * q4] = xr[4 * q4] * r * gg.x * (1.f + s1.x) + s0.x; hv[4 * q4 + 1] = xr[4 * q4 + 1] * r * gg.y * (1.f + s1.y) + s0.y;
            hv[4 * q4 + 2] = xr[4 * q4 + 2] * r * gg.z * (1.f + s1.z) + s0.z; hv[4 * q4 + 3] = xr[4 * q4 + 3] * r * gg.w * (1.f + s1.w) + s0.w;
        }
        u32x4 o0, o1;
        o0.x = cvt_pk_bf16(hv[0], hv[1]); o0.y = cvt_pk_bf16(hv[2], hv[3]); o0.z = cvt_pk_bf16(hv[4], hv[5]); o0.w = cvt_pk_bf16(hv[6], hv[7]);
        o1.x = cvt_pk_bf16(hv[8], hv[9]); o1.y = cvt_pk_bf16(hv[10], hv[11]); o1.z = cvt_pk_bf16(hv[12], hv[13]); o1.w = cvt_pk_bf16(hv[14], hv[15]);
        *(u32x4*)(hrow) = o0; *(u32x4*)(hrow + 8) = o1;
    }
}

constexpr int SMEM_BYTES = LDS_BYTES;
#ifndef REP_MASK
#define REP_MASK 0xffff
#endif
#ifndef REP_ID
#define REP_ID -1
#endif
#ifndef REP_N
#define REP_N 1
#endif
#define NREP(id) ((id) == REP_ID ? REP_N : 1)
__global__ void __launch_bounds__(512, 2) fwd_megakernel(Params p) {
    unsigned char* smem = g_lds;
    const int tid = threadIdx.x, half = __builtin_amdgcn_readfirstlane(tid >> 8);
    const int Gp = gridDim.x, bidp = blockIdx.x;
    const int G = Gp * 2, bid = bidp + half * Gp;
    unsigned char* sm = smem + half * 65536;
    volatile int* qslot = (volatile int*)(smem + LDS_CTL + 16) + half;
    if (tid < 64) ((unsigned*)(smem + LDS_CTL))[tid] = 0u;
    __syncthreads();
    unsigned* ctl = (unsigned*)(wsb(p) + WS_CTL);
    unsigned* qctr = ctl + 4096;
    XcdBarrier bar = xcd_barrier_post(ctl, (volatile LAS unsigned*)(smem + LDS_CTL));
#define PHASE_PTRS unsigned char* ws = wsb(p); const bf16* H = (const bf16*)(ws + WS_H); bf16* PROJ = (bf16*)(ws + WS_PROJ); float* X = (float*)(ws + WS_X); const float* mod = (const float*)(ws + WS_MOD); (void)H; (void)PROJ; (void)X; (void)mod;
    int qn = 0;

    for (int rep = 0; rep < NREP(0); ++rep) {
            PHASE_PTRS
        constexpr int N_MOD = 192, N_LAYER = 192 + 256 + 128 + 128 + 256 + 256 + 16, N_PK = 4, N_GW = 128, N_PW = 8;
        constexpr int NV = N_MOD + 2 * N_LAYER + N_PK + N_GW + N_PW;
        for (int vb = bid; vb < NV; vb += G) {
            int v = vb;
            if (v < N_MOD) { it_mod(p, v, sm); continue; }
            v -= N_MOD;
            if (v < 2 * N_LAYER) {
                const int l = v / N_LAYER; v -= l * N_LAYER;
                bf16* wtin = (bf16*)(ws + WS_WTIN) + (size_t)l * NPROJ * 1024;
                const float* win = p.in[6] + (size_t)l * 1024 * 1732;
                bf16* wtout = (bf16*)(ws + WS_WTOUT) + (size_t)l * 1024 * KMIX;
                const float* wout = p.in[22] + (size_t)l * 1024 * 1024;
                if (v < 192) { it_transpose(TrArgs{win, 1732, 0, 1732, wtin, 1024, 0, 1024, 768, 0, nullptr}, v, sm); }
                else if ((v -= 192) < 256) { it_transpose(TrArgs{win, 1732, 0, 1732, wtin + (size_t)C_QA * 1024, 1024, 0, 1024, 1024, 1, p.in[20] + (size_t)l * 8 * 64 * 128}, v, sm); }
                else if ((v -= 256) < 128) { it_transpose(TrArgs{win, 1732, 1280, 1732, wtin + (size_t)C_CKV * 1024, 1024, 0, 1024, 512, 0, nullptr}, v, sm); }
                else if ((v -= 128) < 128) { it_transpose(TrArgs{wout, 1024, 0, 1024, wtout, KMIX, 0, 512, 1024, 0, nullptr}, v, sm); }
                else if ((v -= 128) < 256) { it_transpose(TrArgs{wout, 1024, 0, 1024, wtout, KMIX, 512, 1024, 1024, 2, p.in[21] + (size_t)l * 8 * 128 * 64}, v, sm); }
                else if ((v -= 256) < 256) { it_transpose(TrArgs{p.in[23] + (size_t)l * 1024 * 1024, 1024, 0, 1024, (bf16*)(ws + WS_WTQ) + (size_t)l * 1024 * 1024, 1024, 0, 1024, 1024, 0, nullptr}, v, sm); }
                else { v -= 256; it_transpose(TrArgs{p.in[15] + (size_t)l * 256 * 256, 256, 0, 256, (bf16*)(ws + WS_WTGLU) + (size_t)l * 256 * 256, 256, 0, 256, 256, 0, nullptr}, v, sm); }
                continue;
            }
            v -= 2 * N_LAYER;
            if (v < N_PK) { const int l = v >> 1, w = v & 1; conv_chunk(p.in[24 + w] + (size_t)l * 8192, (bf16*)(ws + WS_PK) + (size_t)l * 16384 + w * 8192, 0, 1024); continue; }
            v -= N_PK;
            if (v < N_GW) { it_gw(p, v); continue; }
            v -= N_GW;
            it_ssm_pw(p, v);
        }
        xcd_barrier(bar);
    }
    for (int rep = 0; rep < NREP(1); ++rep) {
            PHASE_PTRS
        constexpr int N_NORM = NTOK / 4, N_TAB = 4096, N_KT = 256;
        for (int vb = bid; vb < N_NORM + N_TAB + N_KT; vb += G) {
            if (vb < N_KT) { it_ssm_kt(p, vb, sm); continue; }
            if (vb - N_KT < N_NORM) {
                const int t_ = opq_tid(); const int row = (vb - N_KT) * 4 + (t_ >> 6);
                const float* m0 = (const float*)(wsb(p) + WS_MOD) + (size_t)(row >> 12) * 6144;
                norm_mod_row(p.in[0] + (size_t)row * 1024, p.in[2], m0, m0 + 1024, (bf16*)(wsb(p) + WS_H) + (size_t)row * 1024, t_ & 63);
            } else {
                const size_t base = (size_t)(vb - N_KT - N_NORM) * 2048;
                const int t_ = opq_tid();
#pragma unroll
                for (int e = 0; e < 8; ++e) ssm_tab_entry(p, base + e * 256 + t_);
            }
        }
        xcd_barrier(bar);
    }

    for (int l = 0; l < 2; ++l) {
        const float* xin = l == 0 ? p.in[0] : p.out;
        for (int rep = 0; rep < NREP(2 + 8 * l); ++rep) {
            PHASE_PTRS
            const bf16* Hin = l == 0 ? H : (const bf16*)(ws + WS_H2);
            pg8::StaticOrder S; S.init(NTOK, 2048, Gp, bidp);
            pg8::gemm_phase<Epi256<EpiBf16>, pg8::StaticOrder, true, true>((PG8_LAS unsigned char*)g_lds, pg8::Gemm{Hin, (const bf16*)(ws + WS_WTIN) + (size_t)l * NPROJ * 1024, NTOK, 2048, 1024}, S, Epi256<EpiBf16>{EpiBf16{PROJ, NPROJ}});
            xcd_barrier(bar);
        }
        for (int rep = 0; rep < NREP(3 + 8 * l); ++rep) {
            PHASE_PTRS
            {
                const bf16* Hin = l == 0 ? H : (const bf16*)(ws + WS_H2);
                pg8::StaticOrder S; S.init(NTOK, 256, Gp, bidp);
                pg8::gemm_phase<Epi256<EpiBf16>, pg8::StaticOrder, false, true>((PG8_LAS unsigned char*)g_lds, pg8::Gemm{Hin, (const bf16*)(ws + WS_WTIN) + ((size_t)l * NPROJ + 2048) * 1024, NTOK, 256, 1024}, S, Epi256<EpiBf16>{EpiBf16{PROJ + 2048, NPROJ}});
            }
            unsigned* ctr = qctr + 64 * (qn++);
            for (;;) {
                const int it = q_next(ctr, qslot);
                if (it >= 2048) break;
                const bool extra = rep + 1 < NREP(3 + 8 * l);
                const int ty = it < 1024 ? 0 : it < 1536 ? 1 : it < 1792 ? 2 : 3;
                if (extra && !((REP_MASK >> ty) & 1)) continue;
                if (it < 1024) it_dsa_index_select(p, it, sm, extra ? ((REP_MASK >> 4) & 3) : 3);
                else if (it < 1536) it_gmlp(p, l, it - 1024, sm);
                else if (it < 1792) it_ssm_a(p, l, it - 1536);
                else it_kvn(p, l, it - 1792);
            }
            xcd_barrier(bar);
        }
        for (int rep = 0; rep < NREP(4 + 8 * l); ++rep) {
            PHASE_PTRS
            unsigned* ctr = qctr + 64 * (qn++);
            for (;;) {
                const int it = q_next(ctr, qslot);
                if (it >= 256 + 1024 + 512) break;
                { const bool extra = rep + 1 < NREP(4 + 8 * l); const int ty = it < 256 ? 0 : it < 1280 ? 1 : 2; if (extra && !((REP_MASK >> (8 + ty)) & 1)) continue; }
                if (it < 256) it_ssm_c(p, l, it, sm);
                else if (it < 1280) it_dsa_attn(p, it - 256, sm);
                else {
                    const int v = it - 1280, w = v >> 8, ch = v & 255;
                    if (!(PEER_FP8_MASK & (1 << l))) conv_chunk(p.in[26 + w] + (size_t)l * NEXP * 1024, (bf16*)(ws + (w ? WS_VB : WS_UB)), (size_t)ch * 8192, 8192);
                    else conv_chunk_fp8(p.in[26 + w] + (size_t)l * NEXP * 1024, ws + (w ? WS_VB : WS_UB), (size_t)ch * 4096, 4096, w ? V_SCALE : U_SCALE);
                }
            }
            xcd_barrier(bar);
        }
        for (int rep = 0; rep < NREP(5 + 8 * l); ++rep) {
            PHASE_PTRS
            const EpiGlu epi{(const bf16*)(ws + WS_YG), p.in[16] + l * 256, (bf16*)(ws + WS_MIX)};
            const bf16* Bt = (const bf16*)(ws + WS_WTGLU) + (size_t)l * 256 * 256;
            for (int t = bid; t < (NTOK / 64) * 2; t += G) gemm_tile64((const bf16*)(ws + WS_YG), 256, Bt, 256, 256, (t >> 1) * 64, (t & 1) * 128, (bf16*)sm, epi);
            xcd_barrier(bar);
        }
        for (int rep = 0; rep < NREP(6 + 8 * l); ++rep) {
            PHASE_PTRS
            pg8::StaticOrder S; S.init(NTOK, 1024, Gp, bidp);
            pg8::gemm_phase<Epi256<EpiResid>, pg8::StaticOrder, false, true>((PG8_LAS unsigned char*)g_lds, pg8::Gemm{(const bf16*)(ws + WS_MIX), (const bf16*)(ws + WS_WTOUT) + (size_t)l * 1024 * KMIX, NTOK, 1024, KMIX}, S, Epi256<EpiResid>{EpiResid{xin, X, mod + (size_t)l * 4 * 6144 + 2048}});
            xcd_barrier(bar);
        }
        for (int rep = 0; rep < NREP(7 + 8 * l); ++rep) {
            PHASE_PTRS
            for (int vb = bid; vb < NTOK / 4; vb += G) {
                const int t_ = opq_tid(); const int row = vb * 4 + (t_ >> 6);
                const float* m0 = (const float*)(wsb(p) + WS_MOD) + ((size_t)l * 4 + (row >> 12)) * 6144 + 3072;
                norm_mod_row((const float*)(wsb(p) + WS_X) + (size_t)row * 1024, p.in[3] + l * 1024, m0, m0 + 1024, (bf16*)(wsb(p) + WS_H) + (size_t)row * 1024, t_ & 63);
            }
            xcd_barrier(bar);
        }
        for (int rep = 0; rep < NREP(8 + 8 * l); ++rep) {
            PHASE_PTRS
            pg8::StaticOrder S; S.init(NTOK, 1024, Gp, bidp);
            pg8::gemm_phase<Epi256<EpiBf16>, pg8::StaticOrder, false, true>((PG8_LAS unsigned char*)g_lds, pg8::Gemm{H, (const bf16*)(ws + WS_WTQ) + (size_t)l * 1024 * 1024, NTOK, 1024, 1024}, S, Epi256<EpiBf16>{EpiBf16{PROJ, 1024}});
            xcd_barrier(bar);
        }
        for (int rep = 0; rep < NREP(9 + 8 * l); ++rep) {
            PHASE_PTRS
            PeerLds2& S = *(PeerLds2*)sm;
            hsync();
            const int t_ = opq_tid(), lane_ = t_ & 63, wave_ = t_ >> 6;
            for (int wb = bid * 4 + wave_; wb < NTOK / 8; wb += G * 4) {
                peer_retrieve(p, l, wb * 8, S, lane_, wave_);
                for (int tt = 0; tt < 8; ++tt) {
                    if (PEER_FP8_MASK & (1 << l)) peer_experts<true>(p, l, wb * 8 + tt, tt, S, lane_, wave_);
                    else peer_experts<false>(p, l, wb * 8 + tt, tt, S, lane_, wave_);
                }
            }
            if (l == 0 || rep + 1 < NREP(9 + 8 * l)) xcd_barrier(bar);
        }
    }
}

extern "C" void kernel_launch(void* const* d_in, const int* in_sizes, int n_in, void* d_out, int out_size, void* d_ws, size_t ws_size, hipStream_t stream) {
    if (n_in != 29 || ws_size < WS_END) { fprintf(stderr, "kernel_launch: bad args (n_in %d, ws %zu, need %zu)\n", n_in, ws_size, (size_t)WS_END); return; }
    static int grid = 0;
    if (grid == 0) {
        int dev = 0, cus = 0, per_cu = 0;
        if (hipGetDevice(&dev) != hipSuccess || hipDeviceGetAttribute(&cus, hipDeviceAttributeMultiprocessorCount, dev) != hipSuccess) { grid = -1; return; }
        if (hipFuncSetAttribute((const void*)fwd_megakernel, hipFuncAttributeMaxDynamicSharedMemorySize, LDS_BYTES) != hipSuccess) { fprintf(stderr, "kernel_launch: hipFuncSetAttribute failed\n"); grid = -1; return; }
        if (hipOccupancyMaxActiveBlocksPerMultiprocessor(&per_cu, (const void*)fwd_megakernel, 512, LDS_BYTES) != hipSuccess || per_cu < 1) { fprintf(stderr, "kernel_launch: occupancy query failed (%d)\n", per_cu); grid = -1; return; }
        grid = cus;
    }
    if (grid < 0) return;
    if (hipMemsetAsync((char*)d_ws + WS_CTL, 0, 65536, stream) != hipSuccess) { fprintf(stderr, "kernel_launch: memset failed\n"); return; }
    Params p{};
    for (int i = 0; i < 29; ++i) p.in[i] = (const float*)d_in[i];
    p.out = (float*)d_out; p.ws = (unsigned char*)d_ws;
    void* args[] = {&p};
    const hipError_t e = hipLaunchCooperativeKernel((const void*)fwd_megakernel, dim3(grid), dim3(512), args, LDS_BYTES, stream);
    if (e != hipSuccess) fprintf(stderr, "kernel_launch: cooperative launch failed: %s (grid %d)\n", hipGetErrorString(e), grid);
}
```

```cpp
#include <hip/hip_runtime.h>
#include <cstdint>
#include <cstdio>

typedef unsigned short bf16;
typedef short bf16x8 __attribute__((ext_vector_type(8)));
typedef short s16x4 __attribute__((ext_vector_type(4)));
typedef float f32x4 __attribute__((ext_vector_type(4)));
typedef unsigned u32x4 __attribute__((ext_vector_type(4)));
typedef unsigned u32x2 __attribute__((ext_vector_type(2)));
typedef __bf16 bf2 __attribute__((ext_vector_type(2)));
#define DI __device__ __forceinline__
#define MFMA16(a, b, c) __builtin_amdgcn_mfma_f32_16x16x32_bf16((a), (b), (c), 0, 0, 0)

constexpr int DM = 1024, NB = 4, SEQ = 4096, NTOK = NB * SEQ;
constexpr int NPROJ = 2304;
constexpr int C_UA = 0, C_UB = 256, C_VB = 512, C_CKV = 768, C_QI = 896, C_KI = 1152, C_WI = 1216, C_QA = 1280;
constexpr int KMIX = 1536;
constexpr int NEXP = 16384;
constexpr size_t SCORES_PER_BATCH = (size_t)4096 * 2080;

constexpr size_t al256(size_t x) { return (x + 255) & ~(size_t)255; }
constexpr size_t WS_CTL = 0;
constexpr size_t WS_MOD = 65536;
constexpr size_t WS_WTIN = al256(WS_MOD + 2 * 4 * 6144 * 4);
constexpr size_t WS_WTOUT = al256(WS_WTIN + (size_t)2 * NPROJ * 1024 * 2);
constexpr size_t WS_WTQ = al256(WS_WTOUT + (size_t)2 * 1024 * KMIX * 2);
constexpr size_t WS_WTGLU = al256(WS_WTQ + (size_t)2 * 1024 * 1024 * 2);
constexpr size_t WS_GW = al256(WS_WTGLU + (size_t)2 * 256 * 256 * 2);
constexpr size_t WS_PK = al256(WS_GW + (size_t)2 * 4 * 128 * 128 * 2);
constexpr size_t WS_PW = al256(WS_PK + (size_t)2 * 2 * 128 * 64 * 2);
constexpr size_t WS_BB = al256(WS_PW + (size_t)2 * 16 * 65 * 64 * 2 * 4);
constexpr size_t WS_E = al256(WS_BB + (size_t)2 * 16 * 64 * 16 * 2 * 4);
constexpr size_t WS_G = al256(WS_E + (size_t)2 * 16 * 128 * 1024 * 2);
constexpr size_t WS_KT = al256(WS_G + (size_t)2 * 16 * 1024 * 128 * 2);
constexpr size_t WS_UB = al256(WS_KT + (size_t)2 * 16 * 64 * 256 * 2);
constexpr size_t WS_VB = al256(WS_UB + (size_t)NEXP * 1024 * 2);
constexpr size_t WS_H = al256(WS_VB + (size_t)NEXP * 1024 * 2);
constexpr size_t WS_PROJ = al256(WS_H + (size_t)NTOK * 1024 * 2);
constexpr size_t WS_SLOC = al256(WS_PROJ + (size_t)NTOK * NPROJ * 2);
constexpr size_t WS_YG = al256(WS_SLOC + (size_t)256 * 16 * 128 * 4);
constexpr size_t WS_KVN = al256(WS_YG + (size_t)NTOK * 256 * 2);
constexpr size_t WS_SEL = al256(WS_KVN + (size_t)NTOK * 128 * 2);
constexpr size_t WS_MIX = al256(WS_SEL + (size_t)NTOK * 256 * 2);
constexpr size_t WS_X = al256(WS_MIX + (size_t)NTOK * KMIX * 2);
constexpr size_t WS_SCORES = al256(WS_X + (size_t)NTOK * 1024 * 4);
constexpr size_t WS_H2 = al256(WS_SCORES + (size_t)NB * SCORES_PER_BATCH * 4);
constexpr size_t WS_END = al256(WS_H2 + (size_t)NTOK * 1024 * 2);

struct Params {
    const float* in[29];
    float* out;
    unsigned char* ws;
};

typedef __bf16 bf2v_t __attribute__((ext_vector_type(2)));
typedef float f2v_t __attribute__((ext_vector_type(2)));
DI unsigned cvt_pk_bf16(float lo, float hi) { const f2v_t f = {lo, hi}; const bf2v_t r = __builtin_convertvector(f, bf2v_t); return __builtin_bit_cast(unsigned, r); }
DI bf16 f2bf(float x) { return (bf16)(cvt_pk_bf16(x, 0.f) & 0xffffu); }
DI float bf2f(bf16 b) { return __uint_as_float((unsigned)b << 16); }
DI float bflo(unsigned u) { return __uint_as_float(u << 16); }
DI float bfhi(unsigned u) { return __uint_as_float(u & 0xffff0000u); }
DI float dot2bf(unsigned a, unsigned b, float c) { return __builtin_amdgcn_fdot2_f32_bf16(__builtin_bit_cast(bf2, a), __builtin_bit_cast(bf2, b), c, false); }
DI float gelu_tanh(float x) { const float u = 0.7978845608028654f * (x + 0.044715f * x * x * x); const float e = __expf(2.f * u); const float t = 1.f - 2.f / (e + 1.f); return 0.5f * x * (1.f + t); }
DI float sigmoidf(float x) { return 1.f / (1.f + __expf(-x)); }
DI float wave_sum(float v) { for (int o = 32; o > 0; o >>= 1) v += __shfl_xor(v, o); return v; }
DI unsigned wave_sum_u32(unsigned v) {
    int x = (int)v;
    x += __builtin_amdgcn_update_dpp(0, x, 0xB1, 0xf, 0xf, true);
    x += __builtin_amdgcn_update_dpp(0, x, 0x4E, 0xf, 0xf, true);
    x += __builtin_amdgcn_update_dpp(0, x, 0x141, 0xf, 0xf, true);
    x += __builtin_amdgcn_update_dpp(0, x, 0x140, 0xf, 0xf, true);
    x += __builtin_amdgcn_update_dpp(0, x, 0x142, 0xa, 0xf, true);
    x += __builtin_amdgcn_update_dpp(0, x, 0x143, 0xc, 0xf, true);
    return (unsigned)__builtin_amdgcn_readlane(x, 63);
}
DI unsigned wave_scan_incl_u32(unsigned v) {
    int x = (int)v;
    x += __builtin_amdgcn_update_dpp(0, x, 0x111, 0xf, 0xf, true);
    x += __builtin_amdgcn_update_dpp(0, x, 0x112, 0xf, 0xf, true);
    x += __builtin_amdgcn_update_dpp(0, x, 0x114, 0xf, 0xf, true);
    x += __builtin_amdgcn_update_dpp(0, x, 0x118, 0xf, 0xf, true);
    x += __builtin_amdgcn_update_dpp(0, x, 0x142, 0xa, 0xf, true);
    x += __builtin_amdgcn_update_dpp(0, x, 0x143, 0xc, 0xf, true);
    return (unsigned)x;
}
DI unsigned fkey(float v) { const unsigned u = __float_as_uint(v); return (u & 0x80000000u) ? ~u : (u | 0x80000000u); }
DI unsigned unkey(unsigned k) { return (k & 0x80000000u) ? (k & 0x7fffffffu) : ~k; }
DI bf16x8 ld16(const void* p) { return *(const bf16x8*)p; }
DI bf16x8 zero8() { bf16x8 z = {0, 0, 0, 0, 0, 0, 0, 0}; return z; }


#define XB_TMO      128
#define XB_XCNT(j)  (256  + 64 * (j))
#define XB_XSUB(j)  (1280 + 64 * (j))
#define XB_XGEN(j)  (2304 + 64 * (j))
#define XB_TOP      3328
#define XB_TOPGEN   3392
#define XCD_BAR_WORDS 3456
#define XB_SPIN_CAP (1u << 22)
#define LAS __attribute__((address_space(3)))
DI unsigned xb_ld(unsigned* p)              { return __hip_atomic_load(p, __ATOMIC_RELAXED, __HIP_MEMORY_SCOPE_AGENT); }
DI unsigned xb_add(unsigned* p, unsigned v) { return __hip_atomic_fetch_add(p, v, __ATOMIC_RELAXED, __HIP_MEMORY_SCOPE_AGENT); }
DI unsigned xb_xcc_id() { return (unsigned)__builtin_amdgcn_s_getreg((3 << 11) | 20) & 0xFu; }
#define XB_SPIN(cond, bar) do { unsigned _sp = 0; while (cond) { __builtin_amdgcn_s_sleep(1); \
    if ((++_sp & 255u) == 0u) { if (xb_ld(&(bar)[XB_TMO])) break; if (_sp > XB_SPIN_CAP) { atomicAdd(&(bar)[XB_TMO], 1u); break; } } } } while (0)
struct XcdBarrier { unsigned* bar; unsigned x; volatile LAS unsigned* st; };
DI XcdBarrier xcd_barrier_post(unsigned* bar, volatile LAS unsigned* st) {
    XcdBarrier b; b.bar = bar; b.x = xb_xcc_id(); b.st = st;
    if (threadIdx.x == 0) (void)xb_add(&bar[XB_XCNT(b.x)], 1u);
    return b;
}
DI void xcd_barrier_complete(unsigned* bar, unsigned x, unsigned& nloc, unsigned& nx) {
    const unsigned G = gridDim.x * gridDim.y * gridDim.z;
    unsigned sum, cnt, mine, sp = 0u;
    for (;;) {
        sum = 0u; cnt = 0u; mine = 0u;
#pragma unroll
        for (unsigned j = 0; j < 16; ++j) { const unsigned c = xb_ld(&bar[XB_XCNT(j)]); sum += c; cnt += (c > 0u) ? 1u : 0u; mine = (j == x) ? c : mine; }
        if (sum == G) break;
        __builtin_amdgcn_s_sleep(1);
        if ((++sp & 255u) == 0u) { if (xb_ld(&bar[XB_TMO])) break; if (sp > XB_SPIN_CAP) { atomicAdd(&bar[XB_TMO], 1u); break; } }
    }
    nloc = mine > 0u ? mine : 1u; nx = cnt > 0u ? cnt : 1u;
}
DI void xcd_barrier(const XcdBarrier& b) {
    asm volatile("s_waitcnt vmcnt(0)" ::: "memory");
    __syncthreads();
    if (threadIdx.x == 0) {
        unsigned* bar = b.bar;
        __builtin_amdgcn_s_waitcnt(0);
        unsigned nloc = b.st[0], nx = b.st[1];
        if (nloc == 0u) { xcd_barrier_complete(bar, b.x, nloc, nx); b.st[0] = nloc; b.st[1] = nx; }
        const unsigned old = xb_add(&bar[XB_XSUB(b.x)], 1u);
        const unsigned gen = old / nloc;
        if (old + 1u == (gen + 1u) * nloc) {
            __builtin_amdgcn_fence(__ATOMIC_RELEASE, "agent");
            asm volatile("s_waitcnt vmcnt(0)" ::: "memory");
            const unsigned og = xb_add(&bar[XB_TOP], 1u);
            const unsigned tg = og / nx;
            if (og + 1u == (tg + 1u) * nx) xb_add(&bar[XB_TOPGEN], 1u);
            else XB_SPIN(xb_ld(&bar[XB_TOPGEN]) == tg, bar);
            __builtin_amdgcn_fence(__ATOMIC_ACQUIRE, "agent");
            xb_add(&bar[XB_XGEN(b.x)], 1u);
            asm volatile("s_waitcnt vmcnt(0)" ::: "memory");
        } else {
            XB_SPIN(xb_ld(&bar[XB_XGEN(b.x)]) == gen, bar);
            __builtin_amdgcn_fence(__ATOMIC_ACQUIRE, "agent");
            asm volatile("s_waitcnt vmcnt(0)" ::: "memory");
        }
    }
    __syncthreads();
}
typedef __attribute__((address_space(1))) unsigned char g_uc;
DI unsigned char* wsb(const Params& p) {
    typedef const unsigned long long __attribute__((address_space(4))) karg_u64;
    const unsigned long long w = *(karg_u64*)((const char __attribute__((address_space(4)))*)__builtin_amdgcn_kernarg_segment_ptr() + __builtin_offsetof(Params, ws));
    unsigned lo = (unsigned)w, hi = (unsigned)(w >> 32);
    asm volatile("" : "+s"(lo), "+s"(hi));
    return (unsigned char*)(g_uc*)(((unsigned long long)hi << 32) | lo);
}
extern __shared__ __attribute__((aligned(1024))) unsigned char g_lds[];
constexpr int LDS_CTL = 131072, LDS_BYTES = 131072 + 256;
DI int opq_tid() { int t = (int)(threadIdx.x & 255u); asm volatile("" : "+v"(t)); return t; }
DI void hsync() {
    asm volatile("s_waitcnt lgkmcnt(0)" ::: "memory");
    LAS unsigned* ctr = (LAS unsigned*)(g_lds + LDS_CTL + 32) + (threadIdx.x >> 8);
    unsigned old = 0u;
    if ((threadIdx.x & 63u) == 0u) old = __hip_atomic_fetch_add(ctr, 1u, __ATOMIC_RELAXED, __HIP_MEMORY_SCOPE_WORKGROUP);
    old = (unsigned)__builtin_amdgcn_readfirstlane((int)old);
    const unsigned target = (old & ~3u) + 4u;
    while (__hip_atomic_load(ctr, __ATOMIC_RELAXED, __HIP_MEMORY_SCOPE_WORKGROUP) < target) __builtin_amdgcn_s_sleep(1);
    asm volatile("" ::: "memory");
}
DI void hsync_g() { asm volatile("s_waitcnt vmcnt(0)" ::: "memory"); hsync(); }
DI int q_next(unsigned* ctr, volatile int* slot) {
    hsync();
    if ((threadIdx.x & 255u) == 0u) *slot = (int)__hip_atomic_fetch_add(ctr, 1u, __ATOMIC_RELAXED, __HIP_MEMORY_SCOPE_AGENT);
    hsync();
    return __builtin_amdgcn_readfirstlane(*slot);
}
DI void it_mod(const Params& p, int vb, unsigned char* sm) {
    float (*ca)[1024] = (float (*)[1024])sm;
    float (*part)[4][64] = (float (*)[4][64])(sm + 16384);
    const float* c = p.in[1];
    const int tid = opq_tid();
    hsync();
    for (int i = tid; i < 4096; i += 256) { const float v = c[i]; ca[i >> 10][i & 1023] = v / (1.f + __expf(-v)); }
    hsync();
    const int col = tid & 63, sl = tid >> 6;
    const int idx = vb * 64 + col;
    const int l = idx / 6144, n = idx % 6144;
    const float* w = p.in[4] + (size_t)l * 1024 * 6144 + n + (size_t)(256 * sl) * 6144;
    float a0 = 0, a1 = 0, a2 = 0, a3 = 0;
#pragma unroll 32
    for (int k = 0; k < 256; ++k) { const float wv = w[(size_t)k * 6144]; const int kk = 256 * sl + k; a0 += ca[0][kk] * wv; a1 += ca[1][kk] * wv; a2 += ca[2][kk] * wv; a3 += ca[3][kk] * wv; }
    part[sl][0][col] = a0; part[sl][1][col] = a1; part[sl][2][col] = a2; part[sl][3][col] = a3;
    hsync();
    {
        const int bb = tid >> 6;
        const float v = part[0][bb][col] + part[1][bb][col] + part[2][bb][col] + part[3][bb][col] + p.in[5][l * 6144 + n];
        ((float*)(wsb(p) + WS_MOD))[((size_t)l * 4 + bb) * 6144 + n] = v;
    }
}

struct TrArgs { const float* src; int lds, coff, nvalid; bf16* dst; int ldd, doff; int K, N; int mode; const float* aux; };
DI void it_transpose(const TrArgs& a, int vb4, unsigned char* sm) {
    const int tid = opq_tid(), lane = tid & 63, wave = tid >> 6, tx = lane & 31, ty = lane >> 5;
    float (*t)[33] = (float (*)[33])(sm + wave * 4224);
    float (*ta)[65] = (float (*)[65])(sm + 16896 + wave * 8320);
    float (*tb)[33] = (float (*)[33])(sm + 16896 + 33280);
    const int nk = a.K / 32;
    const int vb = vb4 * 4 + wave, kt = vb % nk, nt = vb / nk;
    hsync();
    if (a.mode == 0) {
        float v[16];
#pragma unroll
        for (int i = 0; i < 16; ++i) { const int k = kt * 32 + ty + 2 * i, n = nt * 32 + tx; v[i] = (n + a.coff < a.nvalid) ? a.src[(size_t)k * a.lds + n + a.coff] : 0.f; }
#pragma unroll
        for (int i = 0; i < 16; ++i) t[ty + 2 * i][tx] = v[i];
    } else if (a.mode == 1) {
        const int h = (nt * 32) >> 7, r0 = (nt * 32) & 127;
        float va[32], vb_[8];
#pragma unroll
        for (int i = 0; i < 32; ++i) va[i] = a.src[(size_t)(kt * 32 + i) * a.lds + 768 + 64 * h + lane];
#pragma unroll
        for (int i = 0; i < 8; ++i) { const int e = tid + 256 * i, d = e >> 5, rr = e & 31; vb_[i] = a.aux[((size_t)h * 64 + d) * 128 + r0 + rr]; }
#pragma unroll
        for (int i = 0; i < 32; ++i) ta[i][lane] = va[i];
#pragma unroll
        for (int i = 0; i < 8; ++i) { const int e = tid + 256 * i; tb[e >> 5][e & 31] = vb_[i]; }
        hsync();
#pragma unroll 2
        for (int r = ty; r < 32; r += 2) { float s = 0; _Pragma("unroll 16") for (int d = 0; d < 64; ++d) s += ta[r][d] * tb[d][tx]; t[r][tx] = s * 0.125f; }
    } else {
        const int h = (kt * 32) >> 7, r0 = (kt * 32) & 127;
        float va[32], vb_[8];
#pragma unroll
        for (int i = 0; i < 32; ++i) va[i] = a.aux[((size_t)h * 128 + r0 + i) * 64 + lane];
#pragma unroll
        for (int i = 0; i < 8; ++i) { const int e = tid + 256 * i, d = e >> 5, nn = e & 31; vb_[i] = a.src[(size_t)(512 + 64 * h + d) * a.lds + nt * 32 + nn]; }
#pragma unroll
        for (int i = 0; i < 32; ++i) ta[i][lane] = va[i];
#pragma unroll
        for (int i = 0; i < 8; ++i) { const int e = tid + 256 * i; tb[e >> 5][e & 31] = vb_[i]; }
        hsync();
#pragma unroll 2
        for (int r = ty; r < 32; r += 2) { float s = 0; _Pragma("unroll 16") for (int d = 0; d < 64; ++d) s += ta[r][d] * tb[d][tx]; t[r][tx] = s; }
    }
    asm volatile("s_waitcnt lgkmcnt(0)" ::: "memory");
#pragma unroll
    for (int i = 0; i < 16; ++i) {
        const int r = ty + 2 * i, n = nt * 32 + r, k = kt * 32 + tx;
        a.dst[(size_t)n * a.ldd + a.doff + k] = f2bf(t[tx][r]);
    }
}
DI void conv_chunk(const float* __restrict__ src, bf16* __restrict__ dst, size_t i0, int n8) {
    for (int i = opq_tid(); i < n8; i += 256) {
        const float4 a = ((const float4*)src)[2 * (i0 + i)], b = ((const float4*)src)[2 * (i0 + i) + 1];
        u32x4 o; o.x = cvt_pk_bf16(a.x, a.y); o.y = cvt_pk_bf16(a.z, a.w); o.z = cvt_pk_bf16(b.x, b.y); o.w = cvt_pk_bf16(b.z, b.w);
        ((u32x4*)dst)[i0 + i] = o;
    }
}
DI void it_gw(const Params& p, int vb) {
    for (int e = 0; e < 4; ++e) {
        const int idx = vb * 1024 + e * 256 + opq_tid();
        const int s = idx & 127, t = (idx >> 7) & 127;
        const float v = (t >= 64 || s < 64) ? p.in[17][idx] : 0.f;
        ((bf16*)(wsb(p) + WS_GW))[idx] = f2bf(v);
    }
}
DI void it_ssm_pw(const Params& p, int vb) {
    const int idx = vb * 256 + opq_tid();
    const int pp = idx & 63, g = (idx >> 6) & 15, l = idx >> 10;
    const float lre = -__expf(p.in[7][idx]), lim = p.in[8][idx];
    const float dt = __expf(p.in[14][l * 16 + g]);
    float* pw = (float*)(wsb(p) + WS_PW) + ((size_t)(l * 16 + g) * 65) * 128;
    for (int d = 0; d <= 64; ++d) {
        const float mag = expf(lre * dt * (float)d); float sn, cs; sincosf(lim * dt * (float)d, &sn, &cs);
        pw[d * 128 + pp * 2] = mag * cs; pw[d * 128 + pp * 2 + 1] = mag * sn;
    }
    const float mag = expf(lre * dt); float sn, cs; sincosf(lim * dt, &sn, &cs);
    const float are = mag * cs, aim = mag * sn;
    const float den = lre * lre + lim * lim, P = are - 1.f, Q = aim;
    const float fre = (P * lre + Q * lim) / den, fim = (Q * lre - P * lim) / den;
    float* bb = (float*)(wsb(p) + WS_BB) + (size_t)idx * 32;
    for (int h = 0; h < 16; ++h) { const float br = p.in[9][(size_t)idx * 16 + h], bi = p.in[10][(size_t)idx * 16 + h]; bb[h * 2] = fre * br - fim * bi; bb[h * 2 + 1] = fre * bi + fim * br; }
}
DI void it_ssm_kt(const Params& p, int vb, unsigned char* sm) {
    float* cz = (float*)sm;
    float* bz = (float*)(sm + 8192);
    float* pz = (float*)(sm + 16384);
    const int tid = opq_tid();
    const int lg = vb >> 3, d0 = (vb & 7) * 8;
    const float* PW = (const float*)(wsb(p) + WS_PW) + ((size_t)lg * 65 + d0) * 128;
    const float* BB = (const float*)(wsb(p) + WS_BB) + (size_t)lg * 64 * 32;
    hsync();
    for (int i = tid; i < 1024; i += 256) { const int q = i >> 4, h = i & 15; cz[i * 2] = p.in[11][((size_t)lg * 16 + h) * 64 + q]; cz[i * 2 + 1] = p.in[12][((size_t)lg * 16 + h) * 64 + q]; }
    for (int i = tid; i < 2048; i += 256) bz[i] = BB[i];
    for (int i = tid; i < 1024; i += 256) pz[i] = PW[i];
    hsync();
    const int h = tid >> 4, hh = tid & 15;
    float acc[8];
#pragma unroll
    for (int d = 0; d < 8; ++d) acc[d] = 0.f;
    for (int q = 0; q < 64; ++q) {
        const float cr = cz[(q * 16 + h) * 2], ci = cz[(q * 16 + h) * 2 + 1], br = bz[(q * 16 + hh) * 2], bi = bz[(q * 16 + hh) * 2 + 1];
        const float xr = cr * br - ci * bi, xi = cr * bi + ci * br;
#pragma unroll
        for (int d = 0; d < 8; ++d) acc[d] += xr * pz[(d * 64 + q) * 2] - xi * pz[(d * 64 + q) * 2 + 1];
    }
    bf16* KT = (bf16*)(wsb(p) + WS_KT) + ((size_t)lg * 64 + d0) * 256;
    if (d0 == 0 && h == hh) acc[0] += p.in[13][(size_t)lg * 16 + h];
#pragma unroll
    for (int d = 0; d < 8; ++d) KT[d * 256 + tid] = f2bf(acc[d]);
    hsync();
}
DI void ssm_tab_entry(const Params& p, size_t idx) {
    const size_t NE = (size_t)2 * 16 * 128 * 1024;
    const float* PW = (const float*)(wsb(p) + WS_PW); const float* BB = (const float*)(wsb(p) + WS_BB);
    if (idx < NE) {
        const int kk = idx & 1023, pp = (idx >> 10) & 127; const int lg = (int)(idx >> 17);
        const int i = kk >> 4, hh = kk & 15, pq = pp & 63, part = pp >> 6;
        const float* pw = PW + ((size_t)lg * 65 + (63 - i)) * 128 + pq * 2; const float* bb = BB + ((size_t)lg * 64 + pq) * 32 + hh * 2;
        const float v = part ? (pw[0] * bb[1] + pw[1] * bb[0]) : (pw[0] * bb[0] - pw[1] * bb[1]);
        ((bf16*)(wsb(p) + WS_E))[idx] = f2bf(v);
    } else if (idx < 2 * NE) {
        const size_t e = idx - NE; const int pp = e & 127, jh = (e >> 7) & 1023; const int lg = (int)(e >> 17);
        const int j = jh >> 4, h = jh & 15, pq = pp & 63, part = pp >> 6;
        const float* pw = PW + ((size_t)lg * 65 + (j + 1)) * 128 + pq * 2;
        const float cr = p.in[11][((size_t)lg * 16 + h) * 64 + pq], ci = p.in[12][((size_t)lg * 16 + h) * 64 + pq];
        const float v = part ? -(cr * pw[1] + ci * pw[0]) : (cr * pw[0] - ci * pw[1]);
        ((bf16*)(wsb(p) + WS_G))[e] = f2bf(v);
    } else {
        const size_t e = idx - 2 * NE; if (e >= (size_t)2 * 16 * 64 * 256) return;
        const int hh = e & 15, h = (e >> 4) & 15, d = (e >> 8) & 63; const int lg = (int)(e >> 14);
        const float* pw = PW + ((size_t)lg * 65 + d) * 128; const float* bb = BB + (size_t)lg * 64 * 32 + hh * 2;
        const float* cr = p.in[11] + ((size_t)lg * 16 + h) * 64; const float* ci = p.in[12] + ((size_t)lg * 16 + h) * 64;
        float s = 0;
        for (int q = 0; q < 64; ++q) { const float zr = pw[q * 2] * bb[q * 32] - pw[q * 2 + 1] * bb[q * 32 + 1], zi = pw[q * 2] * bb[q * 32 + 1] + pw[q * 2 + 1] * bb[q * 32]; s += cr[q] * zr - ci[q] * zi; }
        ((bf16*)(wsb(p) + WS_KT))[e] = f2bf(s);
    }
}
DI void norm_mod_row(const float* __restrict__ xrow, const float* __restrict__ g, const float* __restrict__ sh, const float* __restrict__ sc, bf16* __restrict__ hrow, int lane) {
    float4 v[4]; float ss = 0;
#pragma unroll
    for (int j = 0; j < 4; ++j) { v[j] = *(const float4*)(xrow + 4 * lane + 256 * j); ss += v[j].x * v[j].x + v[j].y * v[j].y + v[j].z * v[j].z + v[j].w * v[j].w; }
    ss = wave_sum(ss);
    const float r = rsqrtf(ss * (1.f / 1024.f) + 1e-6f);
#pragma unroll
    for (int j = 0; j < 4; ++j) {
        const int c = 4 * lane + 256 * j;
        const float4 gg = *(const float4*)(g + c), s1 = *(const float4*)(sc + c), s0 = *(const float4*)(sh + c);
        u32x2 o; o.x = cvt_pk_bf16(v[j].x * r * gg.x * (1.f + s1.x) + s0.x, v[j].y * r * gg.y * (1.f + s1.y) + s0.y);
        o.y = cvt_pk_bf16(v[j].z * r * gg.z * (1.f + s1.z) + s0.z, v[j].w * r * gg.w * (1.f + s1.w) + s0.w);
        *(u32x2*)(hrow + c) = o;
    }
}
namespace pg8 {
#define PG8_LAS __attribute__((address_space(3)))
typedef unsigned short bf16_t;
constexpr int BM = 256, BK = 64, HALF = 128, HTB = HALF * BK * 2  , STAGE_BYTES = 8 * HTB, NXCD = 8, WGM = 8;
__host__ __device__ __forceinline__ int lds_byte(int r, int c) { const int st = (r >> 4) * 2 + (c >> 5), rr = r & 15, cc = c & 31, ob = rr * 64 + cc * 2; return st * 1024 + (ob ^ (((ob >> 9) & 1) << 5)); }
__host__ __device__ __forceinline__ void stage_rc(int b, int& R, int& C) { const int st = b / 1024, sb = b % 1024, swz = sb ^ (((sb >> 9) & 1) << 5); R = (st >> 1) * 16 + swz / 64; C = (st & 1) * 32 + (swz % 64) / 2; }
__host__ __device__ __forceinline__ int perm32(int rho) { const int n = rho >> 4, i = rho & 15; return 8 * (i >> 2) + 4 * n + (i & 3); }

struct Unit { int pm, pn; };
struct Gemm { const bf16_t* A; const bf16_t* Bt; int M, N, K; };

struct StaticOrder {
    int nM, nN, nwg, G, c;
    __host__ __device__ void init(int M, int N, int G_, int c_) { nM = M / BM; nN = N / BM; nwg = nM * nN; G = G_; c = c_; }
    __host__ __device__ bool next(int i, Unit& u) const {
        const long L = (long)i * G + c; if (L >= nwg) return false;
        int wgid = (int)L; { const int q = nwg / NXCD, r = nwg % NXCD, xcd = wgid % NXCD, off = wgid / NXCD; wgid = (xcd < r ? xcd * (q + 1) : r * (q + 1) + (xcd - r) * q) + off; }
        const int nig = WGM * nN, gid = wgid / nig, fm = gid * WGM, gsz = (nM - fm) < WGM ? (nM - fm) : WGM;
        u.pm = fm + ((wgid % nig) % gsz); u.pn = (wgid % nig) / gsz; return true;
    }
    __device__ __forceinline__ void a_ready(const Unit&) const {}
    __device__ __forceinline__ void done(const Unit&) const {}
};

template <class Epi, class Sched, bool ALIGN_EPI = false, bool SP2 = false>
__device__ __forceinline__ void gemm_phase(PG8_LAS unsigned char* lds, const Gemm g, const Sched& S, const Epi& E) {
    int tid = (int)threadIdx.x; asm volatile("" : "+v"(tid));
    const int wid = __builtin_amdgcn_readfirstlane(tid >> 6), lane = tid & 63, wr = wid >> 2, wc = wid & 3, fr = lane & 15, fq = lane >> 4;
    const int K = g.K, nt = K / BK;
    unsigned voffA[2], voffB[2];
#pragma unroll
    for (int i = 0; i < 2; ++i) { int R, C; stage_rc(tid * 16 + i * 8192, R, C); const int Rb = Epi::PERM ? ((R & ~31) + perm32(R & 31)) : R;
        voffA[i] = (unsigned)(R * K + C) * 2u; voffB[i] = (unsigned)(Rb * K + C) * 2u; }
    const size_t kstep = (size_t)(BK * 2);
    const size_t hstep = (size_t)HALF * K * 2;
    const size_t tstep = 2 * hstep;
    const unsigned ldsw = (unsigned)wid * 1024u;
    const int aoff = lds_byte(wr * 64 + fr, fq * 8), boff = lds_byte(wc * 32 + fr, fq * 8);
#define PG8_SA(b, h) (((b) * 2 + (h)) * HTB)
#define PG8_SB(b, h) ((4 + (b) * 2 + (h)) * HTB)
#define PG8_STAGE(bufoff, gbase, voff) do { _Pragma("unroll") for (int _i = 0; _i < 2; ++_i) \
        __builtin_amdgcn_global_load_lds((const unsigned*)((const char*)(gbase) + (voff)[_i]), (PG8_LAS unsigned*)(lds + (bufoff) + ldsw + _i * 8192), 16, 0, 0); } while (0)
#define PG8_LDA(dst, b, h) do { _Pragma("unroll") for (int m = 0; m < 4; ++m) _Pragma("unroll") for (int k = 0; k < 2; ++k) dst[m][k] = *(const PG8_LAS bf16x8*)(lds + PG8_SA(b, h) + aoff + m * 2048 + k * 1024); } while (0)
#define PG8_LDB(dst, b, h) do { _Pragma("unroll") for (int n = 0; n < 2; ++n) _Pragma("unroll") for (int k = 0; k < 2; ++k) dst[n][k] = *(const PG8_LAS bf16x8*)(lds + PG8_SB(b, h) + boff + n * 2048 + k * 1024); } while (0)
#define PG8_MMA(ai, bj, At, Bt) do { __builtin_amdgcn_s_setprio(1); _Pragma("unroll") for (int m = 0; m < 4; ++m) _Pragma("unroll") for (int n = 0; n < 2; ++n) _Pragma("unroll") for (int k = 0; k < 2; ++k) \
        acc[ai][bj][m][n] = __builtin_amdgcn_mfma_f32_16x16x32_bf16(Bt[n][k], At[m][k], acc[ai][bj][m][n], 0, 0, 0); __builtin_amdgcn_s_setprio(0); } while (0)
#define PG8_WAIT_V(n) asm volatile("s_waitcnt vmcnt(" #n ")" ::: "memory")
#define PG8_WAIT_L(n) asm volatile("s_waitcnt lgkmcnt(" #n ")" ::: "memory")
#define PG8_BAR __builtin_amdgcn_s_barrier()
#define PG8_SCHED __builtin_amdgcn_sched_barrier(0)
    Unit cur, nxt; int ui = 0;
    if (!S.next(0, cur)) return;
    f32x4 acc[2][2][4][2];
#pragma unroll
    for (int a = 0; a < 2; ++a)
#pragma unroll
        for (int b = 0; b < 2; ++b)
#pragma unroll
            for (int m = 0; m < 4; ++m)
#pragma unroll
                for (int n = 0; n < 2; ++n) acc[a][b][m][n] = (f32x4){0.f, 0.f, 0.f, 0.f};
    bf16x8 At[4][2], B0[2][2], B1[2][2];
    const char* cA = (const char*)g.A + (size_t)cur.pm * tstep; const char* cB = (const char*)g.Bt + (size_t)cur.pn * tstep;
    S.a_ready(cur);
    if constexpr (SP2) {
        PG8_STAGE(PG8_SB(0, 0), cB, voffB); PG8_STAGE(PG8_SB(0, 1), cB + hstep, voffB); PG8_STAGE(PG8_SA(0, 0), cA, voffA); PG8_STAGE(PG8_SA(0, 1), cA + hstep, voffA);
        if (wr == 1) PG8_BAR;
        PG8_WAIT_V(2); PG8_BAR;
        PG8_STAGE(PG8_SB(1, 0), cB + kstep, voffB); PG8_STAGE(PG8_SA(1, 0), cA + kstep, voffA); PG8_STAGE(PG8_SB(1, 1), cB + hstep + kstep, voffB);
        PG8_WAIT_V(6); PG8_BAR;
    } else {
        PG8_STAGE(PG8_SB(0, 0), cB, voffB); PG8_STAGE(PG8_SA(0, 0), cA, voffA); PG8_STAGE(PG8_SB(0, 1), cB + hstep, voffB); PG8_STAGE(PG8_SA(0, 1), cA + hstep, voffA);
        if (wr == 1) PG8_BAR;
        PG8_WAIT_V(4); PG8_BAR;
        PG8_STAGE(PG8_SB(1, 0), cB + kstep, voffB); PG8_STAGE(PG8_SA(1, 0), cA + kstep, voffA); PG8_STAGE(PG8_SB(1, 1), cB + hstep + kstep, voffB);
        PG8_WAIT_V(6); PG8_BAR;
    }
    for (;;) {
        const bool has_next = S.next(ui + 1, nxt);
        const char* nA = has_next ? (const char*)g.A + (size_t)nxt.pm * tstep : cA; const char* nB = has_next ? (const char*)g.Bt + (size_t)nxt.pn * tstep : cB;
        for (int t = 0; t < nt; t += 2) {
            const bool last = (t == nt - 2);
            const char* a1 = cA + (size_t)(t + 1) * kstep;
            const char* a2 = last ? nA : cA + (size_t)(t + 2) * kstep; const char* b2 = last ? nB : cB + (size_t)(t + 2) * kstep;
            const char* a3 = a2 + kstep; const char* b3 = b2 + kstep;
            if (last && has_next) S.a_ready(nxt);
            if constexpr (SP2) {
            PG8_LDB(B0, 0, 0); PG8_LDB(B1, 0, 1); PG8_SCHED; PG8_LDA(At, 0, 0); PG8_STAGE(PG8_SA(1, 1), a1 + hstep, voffA);
            PG8_WAIT_V(8); PG8_WAIT_L(0); PG8_BAR; PG8_MMA(0, 0, At, B0); PG8_MMA(0, 1, At, B1); PG8_BAR; PG8_SCHED;
            PG8_LDA(At, 0, 1); PG8_STAGE(PG8_SB(0, 0), b2, voffB); PG8_STAGE(PG8_SB(0, 1), b2 + hstep, voffB); PG8_STAGE(PG8_SA(0, 0), a2, voffA);
            PG8_WAIT_V(8); PG8_WAIT_L(0); PG8_BAR; PG8_MMA(1, 0, At, B0); PG8_MMA(1, 1, At, B1); PG8_BAR; PG8_SCHED;
            PG8_LDB(B0, 1, 0); PG8_LDB(B1, 1, 1); PG8_SCHED; PG8_LDA(At, 1, 0); PG8_STAGE(PG8_SA(0, 1), a2 + hstep, voffA);
            PG8_WAIT_V(8); PG8_WAIT_L(0); PG8_BAR; PG8_MMA(0, 0, At, B0); PG8_MMA(0, 1, At, B1); PG8_BAR; PG8_SCHED;
            PG8_LDA(At, 1, 1); PG8_STAGE(PG8_SB(1, 0), b3, voffB); PG8_STAGE(PG8_SB(1, 1), b3 + hstep, voffB); PG8_STAGE(PG8_SA(1, 0), a3, voffA);
            PG8_WAIT_V(8); PG8_WAIT_L(0); PG8_BAR; PG8_MMA(1, 0, At, B0); PG8_MMA(1, 1, At, B1); PG8_BAR; PG8_SCHED;
            } else {
            PG8_LDB(B0, 0, 0); PG8_SCHED; PG8_LDA(At, 0, 0); PG8_STAGE(PG8_SA(1, 1), a1 + hstep, voffA);
            PG8_WAIT_L(8); PG8_BAR; PG8_WAIT_L(0); PG8_MMA(0, 0, At, B0); PG8_BAR; PG8_SCHED;
            PG8_LDB(B1, 0, 1); PG8_STAGE(PG8_SB(0, 0), b2, voffB);
            PG8_BAR; PG8_WAIT_L(0); PG8_MMA(0, 1, At, B1); PG8_BAR;
            PG8_LDA(At, 0, 1); PG8_STAGE(PG8_SA(0, 0), a2, voffA);
            PG8_BAR; PG8_WAIT_L(0); PG8_MMA(1, 0, At, B0); PG8_BAR; PG8_SCHED;
            PG8_STAGE(PG8_SB(0, 1), b2 + hstep, voffB);
            PG8_WAIT_V(6); PG8_BAR; PG8_MMA(1, 1, At, B1); PG8_BAR;
            PG8_LDB(B0, 1, 0); PG8_SCHED; PG8_LDA(At, 1, 0); PG8_STAGE(PG8_SA(0, 1), a2 + hstep, voffA);
            PG8_WAIT_L(8); PG8_BAR; PG8_WAIT_L(0); PG8_MMA(0, 0, At, B0); PG8_BAR; PG8_SCHED;
            PG8_LDB(B1, 1, 1); PG8_STAGE(PG8_SB(1, 0), b3, voffB);
            PG8_BAR; PG8_WAIT_L(0); PG8_MMA(0, 1, At, B1); PG8_BAR;
            PG8_LDA(At, 1, 1); PG8_STAGE(PG8_SA(1, 0), a3, voffA);
            PG8_BAR; PG8_WAIT_L(0); PG8_MMA(1, 0, At, B0); PG8_BAR; PG8_SCHED;
            PG8_STAGE(PG8_SB(1, 1), b3 + hstep, voffB);
            PG8_WAIT_V(6); PG8_BAR; PG8_MMA(1, 1, At, B1); PG8_BAR;
            }
        }
        if constexpr (ALIGN_EPI) { if (wr == 0) PG8_BAR; }
        if constexpr (!Epi::AFTER_DRAIN) { E(acc, cur, wr, wc, fr, fq); S.done(cur); }
        if (!has_next) break;
#pragma unroll
        for (int a = 0; a < 2; ++a)
#pragma unroll
            for (int b = 0; b < 2; ++b)
#pragma unroll
                for (int m = 0; m < 4; ++m)
#pragma unroll
                    for (int n = 0; n < 2; ++n) acc[a][b][m][n] = (f32x4){0.f, 0.f, 0.f, 0.f};
        cur = nxt; cA = nA; cB = nB; ++ui;
        if constexpr (ALIGN_EPI) { if (wr == 1) PG8_BAR; }
    }
    PG8_WAIT_V(0);
    if constexpr (!ALIGN_EPI) { if (wr == 0) PG8_BAR; }
    PG8_BAR;
    if constexpr (Epi::AFTER_DRAIN) { E.fused(acc, cur, wr, wc, fr, fq, lds, wid, lane); S.done(cur); }
#undef PG8_SA
#undef PG8_SB
#undef PG8_STAGE
#undef PG8_LDA
#undef PG8_LDB
#undef PG8_MMA
#undef PG8_WAIT_V
#undef PG8_WAIT_L
#undef PG8_BAR
#undef PG8_SCHED
}
}
struct EpiBf16 { bf16* C; int ldc; DI void operator()(int r, int c, f32x4 v) const { u32x2 o; o.x = cvt_pk_bf16(v[0], v[1]); o.y = cvt_pk_bf16(v[2], v[3]); *(u32x2*)(C + (size_t)r * ldc + c) = o; } };
struct EpiResid { const float* xin; float* xout; const float* gate;
    DI void operator()(int r, int c, f32x4 v) const { const float4 x = *(const float4*)(xin + (size_t)r * 1024 + c); const float4 g = *(const float4*)(gate + (size_t)(r >> 12) * 6144 + c);
        float4 o; o.x = x.x + g.x * v[0]; o.y = x.y + g.y * v[1]; o.z = x.z + g.z * v[2]; o.w = x.w + g.w * v[3]; *(float4*)(xout + (size_t)r * 1024 + c) = o; } };
struct EpiGlu { const bf16* yg; const float* bglu; bf16* mix;
    DI void operator()(int r, int c, f32x4 v) const { const u32x2 y = *(const u32x2*)(yg + (size_t)r * 256 + c); const float4 b = *(const float4*)(bglu + c);
        u32x2 o; o.x = cvt_pk_bf16(bflo(y.x) * sigmoidf(v[0] + b.x), bfhi(y.x) * sigmoidf(v[1] + b.y)); o.y = cvt_pk_bf16(bflo(y.y) * sigmoidf(v[2] + b.z), bfhi(y.y) * sigmoidf(v[3] + b.w));
        *(u32x2*)(mix + (size_t)r * KMIX + c) = o; } };
constexpr int GP = 72;
template <class Epi>
DI void gemm_tile64(const bf16* __restrict__ A, int lda, const bf16* __restrict__ Bt, int ldb, int K, int m0, int n0, bf16* lds, const Epi& epi) {
    bf16* As = lds; bf16* Bs = lds + 64 * GP;
    const int tid = opq_tid(), lane = tid & 63, wave = tid >> 6, wm = wave >> 1, wn = wave & 1;
    const int fr = lane & 15, fq = lane >> 4;
    const int lrow = tid >> 3, lch = tid & 7;
    f32x4 acc[4][2];
#pragma unroll
    for (int i = 0; i < 4; ++i)
#pragma unroll
        for (int j = 0; j < 2; ++j) acc[i][j] = (f32x4){0.f, 0.f, 0.f, 0.f};
    bf16x8 ra[2], rb[4];
    const bf16* Ag = A + (size_t)(m0 + lrow) * lda + lch * 8;
    const bf16* Bg = Bt + (size_t)(n0 + lrow) * ldb + lch * 8;
#pragma unroll
    for (int i = 0; i < 4; ++i) { if (i < 2) ra[i] = ld16(Ag + (size_t)32 * i * lda); rb[i] = ld16(Bg + (size_t)32 * i * ldb); }
    const int nk = K / 64;
    for (int kt = 0; kt < nk; ++kt) {
        hsync();
#pragma unroll
        for (int i = 0; i < 4; ++i) { if (i < 2) *(bf16x8*)(As + (lrow + 32 * i) * GP + lch * 8) = ra[i]; *(bf16x8*)(Bs + (lrow + 32 * i) * GP + lch * 8) = rb[i]; }
        hsync();
        if (kt + 1 < nk) {
#pragma unroll
            for (int i = 0; i < 4; ++i) { if (i < 2) ra[i] = ld16(Ag + (size_t)32 * i * lda + (kt + 1) * 64); rb[i] = ld16(Bg + (size_t)32 * i * ldb + (kt + 1) * 64); }
        }
#pragma unroll
        for (int ks = 0; ks < 2; ++ks) {
            bf16x8 fa[4], fb[2];
#pragma unroll
            for (int i = 0; i < 4; ++i) fa[i] = ld16(Bs + (64 * wn + 16 * i + fr) * GP + 32 * ks + 8 * fq);
#pragma unroll
            for (int j = 0; j < 2; ++j) fb[j] = ld16(As + (32 * wm + 16 * j + fr) * GP + 32 * ks + 8 * fq);
#pragma unroll
            for (int i = 0; i < 4; ++i)
#pragma unroll
                for (int j = 0; j < 2; ++j) acc[i][j] = MFMA16(fa[i], fb[j], acc[i][j]);
        }
    }
#pragma unroll
    for (int i = 0; i < 4; ++i)
#pragma unroll
        for (int j = 0; j < 2; ++j) epi(m0 + 32 * wm + 16 * j + fr, n0 + 64 * wn + 16 * i + 4 * fq, acc[i][j]);
}
template <class F> struct Epi256 {
    static constexpr bool PERM = false, AFTER_DRAIN = false;
    F f;
    DI void operator()(const f32x4 (&acc)[2][2][4][2], const pg8::Unit& u, int wr, int wc, int, int) const {
        int t_ = (int)threadIdx.x; asm volatile("" : "+v"(t_));
        const int fr = t_ & 15, fq = (t_ >> 4) & 3;
#pragma unroll
        for (int ai = 0; ai < 2; ++ai)
#pragma unroll
            for (int m = 0; m < 4; ++m)
#pragma unroll
                for (int bj = 0; bj < 2; ++bj)
#pragma unroll
                    for (int n = 0; n < 2; ++n) f(u.pm * 256 + ai * 128 + wr * 64 + m * 16 + fr, u.pn * 256 + bj * 128 + wc * 32 + n * 16 + 4 * fq, acc[ai][bj][m][n]);
    }
};

DI unsigned off_b(unsigned row, unsigned ch) { return 256u * row + 16u * (ch ^ (((row & 3u) << 2) | ((row >> 2) & 3u))); }
#define TR8(o0, o1, o2, o3, o4, o5, o6, o7, a0, a1, a2, a3, a4, a5, a6, a7)                                                                         \
    asm volatile("s_waitcnt lgkmcnt(0)\n\t"                                                                                                         \
                 "ds_read_b64_tr_b16 %0, %8\n\tds_read_b64_tr_b16 %1, %9\n\tds_read_b64_tr_b16 %2, %10\n\tds_read_b64_tr_b16 %3, %11\n\t"           \
                 "ds_read_b64_tr_b16 %4, %12\n\tds_read_b64_tr_b16 %5, %13\n\tds_read_b64_tr_b16 %6, %14\n\tds_read_b64_tr_b16 %7, %15\n\t"         \
                 "s_waitcnt lgkmcnt(0)"                                                                                                             \
                 : "=&v"(o0), "=&v"(o1), "=&v"(o2), "=&v"(o3), "=&v"(o4), "=&v"(o5), "=&v"(o6), "=&v"(o7)                                           \
                 : "v"(a0), "v"(a1), "v"(a2), "v"(a3), "v"(a4), "v"(a5), "v"(a6), "v"(a7)                                                           \
                 : "memory")

DI void it_kvn(const Params& p, int l, int vb) {
    const int lane = opq_tid() & 63, wave = opq_tid() >> 6;
    const bf16* proj = (const bf16*)(wsb(p) + WS_PROJ); bf16* kvn = (bf16*)(wsb(p) + WS_KVN);
    const float g0 = p.in[19][l * 128 + 2 * lane], g1 = p.in[19][l * 128 + 2 * lane + 1];
    for (int i = 0; i < 16; ++i) {
        const int row = vb * 64 + i * 4 + wave;
        const unsigned u = *(const unsigned*)(proj + (size_t)row * NPROJ + C_CKV + 2 * lane);
        const float a = bflo(u), b = bfhi(u);
        const float ss = wave_sum(a * a + b * b);
        const float r = rsqrtf(ss * (1.f / 128.f) + 1e-6f);
        *(unsigned*)(kvn + (size_t)row * 128 + 2 * lane) = cvt_pk_bf16(a * r * g0, b * r * g1);
    }
}

DI void it_ssm_a(const Params& p, int l, int item) {
    const int lane = opq_tid() & 63, wave = opq_tid() >> 6, fr = lane & 15, fq = lane >> 4;
    const bf16* proj = (const bf16*)(wsb(p) + WS_PROJ);
    float* sloc = (float*)(wsb(p) + WS_SLOC);
    const int g = item & 15, rt = item >> 4;
    const bf16* E = (const bf16*)(wsb(p) + WS_E) + ((size_t)(l * 16 + g) * 128) * 1024;
    const int R = 16 * rt + fr, b = R >> 6, k = R & 63;
    const bf16* arow = proj + ((size_t)b * 4096 + 64 * k + (fq >> 1)) * NPROJ + C_UA + 16 * g + 8 * (fq & 1);
    f32x4 acc[2] = {(f32x4){0, 0, 0, 0}, (f32x4){0, 0, 0, 0}};
#pragma unroll 4
    for (int ks = 0; ks < 32; ++ks) {
        const bf16x8 a = ld16(arow + (size_t)(2 * ks) * NPROJ);
#pragma unroll
        for (int c = 0; c < 2; ++c) { const int ct = 2 * wave + c; const bf16x8 bf = ld16(E + (size_t)(16 * ct + fr) * 1024 + 32 * ks + 8 * fq); acc[c] = MFMA16(a, bf, acc[c]); }
    }
#pragma unroll
    for (int c = 0; c < 2; ++c)
#pragma unroll
        for (int i = 0; i < 4; ++i) sloc[((size_t)(16 * rt + 4 * fq + i) * 16 + g) * 128 + 16 * (2 * wave + c) + fr] = acc[c][i];
}

DI void it_ssm_c(const Params& p, int l, int item, unsigned char* sm, int pm = 7) {
    bf16* sst = (bf16*)sm;
    bf16* ktl = (bf16*)(sm + 17408);
    const int tid = opq_tid(), lane = tid & 63, wave = tid >> 6, fr = lane & 15, fq = lane >> 4;
    const bf16* proj = (const bf16*)(wsb(p) + WS_PROJ);
    const float* sloc = (const float*)(wsb(p) + WS_SLOC);
    bf16* yg = (bf16*)(wsb(p) + WS_YG);
    const int jq = item & 3, g = (item >> 2) & 15, b = item >> 6;
    const bf16* KT = (const bf16*)(wsb(p) + WS_KT) + (size_t)(l * 16 + g) * 64 * 256;
    hsync();
#pragma unroll
    for (int i = 0; i < 8; ++i) *(bf16x8*)(ktl + (i * 256 + tid) * 8) = ld16(KT + (size_t)(i * 256 + tid) * 8);
    if (wave == 0 && (pm & 1)) {
        const float* pw64 = (const float*)(wsb(p) + WS_PW) + ((size_t)(l * 16 + g) * 65 + 64) * 128 + lane * 2;
        const float ar = pw64[0], ai = pw64[1];
        float sr = 0, si = 0;
        const float* s = sloc + ((size_t)(b * 64) * 16 + g) * 128;
        float lr[64], li[64];
#pragma unroll
        for (int k = 0; k < 64; ++k) { lr[k] = s[(size_t)k * 2048 + lane]; li[k] = s[(size_t)k * 2048 + 64 + lane]; }
#pragma unroll
        for (int k = 0; k < 64; ++k) {
            sst[k * 136 + lane] = f2bf(sr); sst[k * 136 + 64 + lane] = f2bf(si);
            const float nr = ar * sr - ai * si + lr[k], ni = ar * si + ai * sr + li[k];
            sr = nr; si = ni;
        }
    }
    hsync();
    const bf16* G = (const bf16*)(wsb(p) + WS_G) + (size_t)(l * 16 + g) * 1024 * 128;
    const int kch = 16 * wave + fr;
    const bf16* arow = proj + ((size_t)b * 4096 + 64 * kch + (fq >> 1)) * NPROJ + C_UA + 16 * g + 8 * (fq & 1);
    const int j0 = 16 * jq;
    f32x4 acc[16];
#pragma unroll
    for (int jj = 0; jj < 16; ++jj) acc[jj] = (f32x4){0, 0, 0, 0};
    const int nks = (j0 + 15) / 2 + 1;
    bf16x8 a_cur[8], a_nxt[8];
#pragma unroll
    for (int i = 0; i < 8; ++i) a_cur[i] = ld16(arow + (size_t)(2 * i) * NPROJ);
    const bf16* blane = ktl + (fr - 16 * (fq >> 1)) * 16 + 8 * (fq & 1);
#pragma unroll 1
    for (int grp = 0; grp < ((pm & 2) ? jq : 0); ++grp) {
#pragma unroll
        for (int i = 0; i < 8; ++i) a_nxt[i] = ld16(arow + (size_t)(2 * (8 * grp + 8 + i)) * NPROJ);
#pragma unroll
        for (int i = 0; i < 8; ++i) {
            const bf16* bp = blane + 256 * (j0 - 2 * (8 * grp + i));
#pragma unroll
            for (int jj = 0; jj < 16; ++jj) acc[jj] = MFMA16(ld16(bp + 256 * jj), a_cur[i], acc[jj]);
        }
#pragma unroll
        for (int i = 0; i < 8; ++i) a_cur[i] = a_nxt[i];
    }
    if (pm & 2) {
#pragma unroll
        for (int i = 0; i < 8; ++i) {
            const int ks = 8 * jq + i;
#pragma unroll
            for (int jj = 0; jj < 16; ++jj) {
                const int j = j0 + jj;
                if (2 * i <= jj) {
                    const int d = j - 2 * ks - (fq >> 1);
                    const bf16x8 bl = ld16(ktl + ((d < 0 ? 0 : d) * 16 + fr) * 16 + 8 * (fq & 1));
                    const bf16x8 bf = d >= 0 ? bl : zero8();
                    acc[jj] = MFMA16(bf, a_cur[i], acc[jj]);
                }
            }
        }
    }
#pragma unroll
    for (int ks = 0; ks < ((pm & 4) ? 4 : 0); ++ks) {
        const bf16x8 a = ld16(sst + kch * 136 + 32 * ks + 8 * fq);
        bf16x8 bfr[16];
#pragma unroll
        for (int jj = 0; jj < 16; ++jj) bfr[jj] = ld16(G + ((size_t)((j0 + jj) * 16 + fr)) * 128 + 32 * ks + 8 * fq);
#pragma unroll
        for (int jj = 0; jj < 16; ++jj) acc[jj] = MFMA16(bfr[jj], a, acc[jj]);
    }
#pragma unroll
    for (int jj = 0; jj < 16; ++jj) {
        const size_t tok = (size_t)b * 4096 + 64 * (16 * wave + fr) + j0 + jj;
        u32x2 o; o.x = cvt_pk_bf16(gelu_tanh(acc[jj][0]), gelu_tanh(acc[jj][1])); o.y = cvt_pk_bf16(gelu_tanh(acc[jj][2]), gelu_tanh(acc[jj][3]));
        *(u32x2*)(yg + tok * 256 + 16 * g + 4 * fq) = o;
    }
}

DI void it_gmlp(const Params& p, int l, int item, unsigned char* sm) {
    bf16* vnT = (bf16*)sm;
    const int tid = opq_tid(), lane = tid & 63, wave = tid >> 6, fr = lane & 15, fq = lane >> 4;
    const bf16* proj = (const bf16*)(wsb(p) + WS_PROJ); bf16* mix = (bf16*)(wsb(p) + WS_MIX);
    const int h = item & 3, blk = item >> 2;
    const size_t tok0 = (size_t)blk * 128;
    hsync();
    {
        const int row = tid >> 1, half = tid & 1;
        const bf16* vp = proj + (tok0 + row) * NPROJ + C_VB + 64 * h + 32 * half;
        float v[32]; float s = 0;
#pragma unroll
        for (int q = 0; q < 4; ++q) { const bf16x8 t = ld16(vp + 8 * q);
#pragma unroll
            for (int e = 0; e < 8; ++e) { v[8 * q + e] = bf2f((bf16)t[e]); s += v[8 * q + e]; } }
        s += __shfl_xor(s, 1); const float mu = s * (1.f / 64.f);
        float vs = 0;
#pragma unroll
        for (int e = 0; e < 32; ++e) { const float d = v[e] - mu; vs += d * d; }
        vs += __shfl_xor(vs, 1); const float r = rsqrtf(vs * (1.f / 64.f) + 1e-6f);
#pragma unroll
        for (int e = 0; e < 32; ++e) vnT[(32 * half + e) * 136 + row] = f2bf((v[e] - mu) * r);
    }
    hsync();
    const bf16* W = (const bf16*)(wsb(p) + WS_GW) + (size_t)(l * 4 + h) * 128 * 128;
    f32x4 acc[4][2];
#pragma unroll
    for (int i = 0; i < 4; ++i) { acc[i][0] = (f32x4){0, 0, 0, 0}; acc[i][1] = (f32x4){0, 0, 0, 0}; }
#pragma unroll
    for (int ks = 0; ks < 4; ++ks) {
        bf16x8 fa[4], fb[2];
#pragma unroll
        for (int i = 0; i < 4; ++i) fa[i] = ld16(vnT + (16 * i + fr) * 136 + 32 * ks + 8 * fq);
#pragma unroll
        for (int j = 0; j < 2; ++j) fb[j] = ld16(W + (size_t)(16 * (2 * wave + j) + fr) * 128 + 32 * ks + 8 * fq);
#pragma unroll
        for (int i = 0; i < 4; ++i)
#pragma unroll
            for (int j = 0; j < 2; ++j) acc[i][j] = MFMA16(fa[i], fb[j], acc[i][j]);
    }
#pragma unroll
    for (int j = 0; j < 2; ++j) {
        const int t = 16 * (2 * wave + j) + fr;
        const float bs = p.in[18][(l * 4 + h) * 128 + t];
#pragma unroll
        for (int i = 0; i < 4; ++i) {
            const int d = 16 * i + 4 * fq;
            const u32x2 u = *(const u32x2*)(proj + (tok0 + t) * NPROJ + C_UB + 64 * h + d);
            u32x2 o; o.x = cvt_pk_bf16(bflo(u.x) * (acc[i][j][0] + bs), bfhi(u.x) * (acc[i][j][1] + bs)); o.y = cvt_pk_bf16(bflo(u.y) * (acc[i][j][2] + bs), bfhi(u.y) * (acc[i][j][3] + bs));
            *(u32x2*)(mix + (tok0 + t) * KMIX + 256 + 64 * h + d) = o;
        }
    }
}

DI size_t score_row_off(int b, int t) { const int c = t >> 6; return (size_t)b * SCORES_PER_BATCH + (size_t)4096 * (c * (c + 1) / 2) + (size_t)(t & 63) * 64 * (c + 1); }
template <int NR>
DI void dsa_select_impl(const float* __restrict__ srow, int nreg, bf16* __restrict__ so, int lane, unsigned* hist, int topbit = 31) {
    unsigned key[NR];
#pragma unroll
    for (int r = 0; r < NR; ++r) { const float v = srow[64 * r + lane]; key[r] = (r < nreg) ? fkey(v + 0.f) : 0u; }
    unsigned T = 0;
#pragma unroll 1
    for (int bit = (topbit < 0 ? -1 : (topbit & 63)); bit >= 0; --bit) {
        const unsigned cand = T | (1u << bit);
        unsigned c = 0;
#pragma unroll
        for (int r = 0; r < NR; ++r) asm("v_cmp_ge_u32 vcc, %1, %2\n\tv_addc_co_u32 %0, vcc, 0, %0, vcc" : "+v"(c) : "v"(key[r]), "v"(cand) : "vcc");
        const unsigned cnt = wave_sum_u32(c);
        if (cnt >= 256u) { T = cand; if (cnt == 256u) break; }
    }
    if (topbit < 0 || (topbit & 64)) { unsigned x = T; _Pragma("unroll") for (int r = 0; r < NR; ++r) x ^= key[r]; if (x == 0x12345u) so[lane] = (bf16)x; return; }
    unsigned c = 0;
#pragma unroll
    for (int r = 0; r < NR; ++r) asm("v_cmp_gt_u32 vcc, %1, %2\n\tv_addc_co_u32 %0, vcc, 0, %0, vcc" : "+v"(c) : "v"(key[r]), "v"(T) : "vcc");
    const int need = 256 - (int)wave_sum_u32(c);
    unsigned ce = 0;
#pragma unroll
    for (int r = 0; r < NR; ++r) asm("v_cmp_eq_u32 vcc, %1, %2\n\tv_addc_co_u32 %0, vcc, 0, %0, vcc" : "+v"(ce) : "v"(key[r]), "v"(T) : "vcc");
    if ((int)wave_sum_u32(ce) == need) {
        bf16* stg = (bf16*)hist;
        unsigned base = 0;
#pragma unroll
        for (int r = 0; r < NR; ++r) {
            const unsigned long long mt = __ballot(key[r] >= T);
            const unsigned pos = __builtin_amdgcn_mbcnt_hi((unsigned)(mt >> 32), __builtin_amdgcn_mbcnt_lo((unsigned)mt, base));
            stg[(key[r] >= T) ? pos : 256u + (unsigned)lane] = (bf16)(64 * r + lane);
            base += (unsigned)__popcll(mt);
        }
        asm volatile("s_waitcnt lgkmcnt(0)" ::: "memory");
        *(u32x2*)(so + 4 * lane) = *(const u32x2*)(stg + 4 * lane);
        return;
    }
    int base = 0, eqb = 0;
    const unsigned long long lt = (1ull << lane) - 1ull;
#pragma unroll
    for (int r = 0; r < NR; ++r) {
        const unsigned long long me = __ballot(key[r] == T);
        const int erank = eqb + __popcll(me & lt);
        const bool take = (key[r] > T) || (key[r] == T && erank < need);
        const unsigned long long mt = __ballot(take);
        if (take) so[base + __popcll(mt & lt)] = (bf16)(64 * r + lane);
        base += __popcll(mt); eqb += __popcll(me);
    }
}
DI void dsa_select_query(const Params& p, int q, int lane, unsigned* hist, int topbit = 31) {
    const float* scores = (const float*)(wsb(p) + WS_SCORES); bf16* sel = (bf16*)(wsb(p) + WS_SEL);
    const int b = q >> 12, t = q & 4095, c = t >> 6, nreg = c + 1;
    bf16* so = sel + (size_t)q * 256;
    if (nreg <= 4) { for (int r = 0; r < nreg; ++r) so[64 * r + lane] = (bf16)(64 * r + lane); return; }
    const float* srow = scores + score_row_off(b, t);
    if (nreg <= 16) dsa_select_impl<16>(srow, nreg, so, lane, hist, topbit);
    else if (nreg <= 32) dsa_select_impl<32>(srow, nreg, so, lane, hist, topbit);
    else if (nreg <= 48) dsa_select_impl<48>(srow, nreg, so, lane, hist, topbit);
    else dsa_select_impl<64>(srow, nreg, so, lane, hist, topbit);
}
DI void it_dsa_index_select(const Params& p, int item, unsigned char* sm, int mode = 3) {
    const int lane = opq_tid() & 63, wave = opq_tid() >> 6, fr = lane & 15, fq = lane >> 4;
    const bf16* proj = (const bf16*)(wsb(p) + WS_PROJ); float* scores = (float*)(wsb(p) + WS_SCORES);
    const int c = 63 - (item >> 4), b = (item >> 2) & 3, qg = item & 3;
    if (c >= 4 && (mode & 1)) {
        const int t = 64 * c + 16 * qg + fr;
        const bf16* qrow = proj + ((size_t)b * 4096 + t) * NPROJ;
        bf16x8 qf[4][2];
#pragma unroll
        for (int hh = 0; hh < 4; ++hh)
#pragma unroll
            for (int ks = 0; ks < 2; ++ks) qf[hh][ks] = ld16(qrow + C_QI + 64 * hh + 32 * ks + 8 * fq);
        float w[4];
        { const u32x2 wv = *(const u32x2*)(qrow + C_WI); w[0] = bflo(wv.x) * 0.0625f; w[1] = bfhi(wv.x) * 0.0625f; w[2] = bflo(wv.y) * 0.0625f; w[3] = bfhi(wv.y) * 0.0625f; }
        float* srow = scores + score_row_off(b, t);
        const int ntile = 4 * (c + 1);
        const bf16* kbase = proj + ((size_t)b * 4096 + fr) * NPROJ + C_KI + 8 * fq;
        bf16x8 k0[4], k1[4];
#pragma unroll
        for (int u = 0; u < 4; ++u) { const bf16* krow = kbase + (size_t)16 * (wave + 4 * u) * NPROJ; k0[u] = ld16(krow); k1[u] = ld16(krow + 32); }
        for (int base = wave; base < ntile; base += 16) {
            bf16x8 n0[4], n1[4];
            const bool more = base + 16 < ntile;
            if (more) {
#pragma unroll
                for (int u = 0; u < 4; ++u) { const bf16* krow = kbase + (size_t)16 * (base + 16 + 4 * u) * NPROJ; n0[u] = ld16(krow); n1[u] = ld16(krow + 32); }
            }
#pragma unroll
            for (int u = 0; u < 4; ++u) {
                const int kt = base + 4 * u;
                if (kt >= ntile) break;
                f32x4 sc = {0, 0, 0, 0};
#pragma unroll
                for (int hh = 0; hh < 4; ++hh) {
                    f32x4 a = {0, 0, 0, 0};
                    a = MFMA16(k0[u], qf[hh][0], a); a = MFMA16(k1[u], qf[hh][1], a);
#pragma unroll
                    for (int i = 0; i < 4; ++i) sc[i] += w[hh] * fmaxf(a[i], 0.f);
                }
#pragma unroll
                for (int i = 0; i < 4; ++i) sc[i] += 0.f;
                *(f32x4*)(srow + 16 * kt + 4 * fq) = sc;
            }
            if (more) {
#pragma unroll
                for (int u = 0; u < 4; ++u) { k0[u] = n0[u]; k1[u] = n1[u]; }
            }
        }
    }
    hsync_g();
    if (mode & 2) for (int i = 0; i < 4; ++i) dsa_select_query(p, b * 4096 + 64 * c + 16 * qg + 4 * wave + i, lane, (unsigned*)sm + 1024 * wave, (mode & 16) ? -1 : (((mode & 4) ? 15 : 31) | ((mode & 8) ? 64 : 0)));
}
DI void it_dsa_attn(const Params& p, int item, unsigned char* sm) {
    const int lane = opq_tid() & 63, wave = opq_tid() >> 6, fr = lane & 15, fq = lane >> 4;
    unsigned char* tile = sm + wave * 8192;
    bf16* selw = (bf16*)(sm + 32768 + wave * 512);
    const bf16* proj = (const bf16*)(wsb(p) + WS_PROJ); const bf16* kvn = (const bf16*)(wsb(p) + WS_KVN);
    const bf16* sel = (const bf16*)(wsb(p) + WS_SEL); bf16* mix = (bf16*)(wsb(p) + WS_MIX);
    unsigned wr_addr[8], rd_addr[2][4], tr_addr[8][2];
#pragma unroll
    for (int i = 0; i < 8; ++i) wr_addr[i] = off_b(4 * i + fq, fr);
#pragma unroll
    for (int rb = 0; rb < 2; ++rb)
#pragma unroll
        for (int s = 0; s < 4; ++s) rd_addr[rb][s] = off_b(8 * (fr >> 2) + 4 * rb + (fr & 3), 4 * s + fq);
    const unsigned tbase = (unsigned)(size_t)tile;
    {
        const unsigned q4 = fr >> 2, p4 = fr & 3;
#pragma unroll
        for (int c = 0; c < 8; ++c)
#pragma unroll
            for (int t = 0; t < 2; ++t) tr_addr[c][t] = tbase + off_b(8 * fq + 4 * t + q4, 2 * c + (p4 >> 1)) + 8 * (p4 & 1);
    }
    const float slope = fr < 8 ? exp2f(-(float)(fr + 1)) : 0.f;
    for (int qi = 0; qi < 4; ++qi) {
        const int q = item * 16 + wave * 4 + qi;
        const int b = q >> 12, t = q & 4095, c = t >> 6;
        const int nsel = (c + 1) * 64 < 256 ? (c + 1) * 64 : 256;
        const bf16* qa = proj + (size_t)q * NPROJ + C_QA;
        bf16x8 qf[4];
#pragma unroll
        for (int s = 0; s < 4; ++s) qf[s] = fr < 8 ? ld16(qa + fr * 128 + 32 * s + 8 * fq) : zero8();
        const bf16* selp = sel + (size_t)q * 256;
        const bf16* kvb = kvn + (size_t)b * 4096 * 128;
        if (4 * lane < nsel) *(u32x2*)(selw + 4 * lane) = *(const u32x2*)(selp + 4 * lane);
        float m_run = -INFINITY, l_run = 0.f;
        f32x4 o[8];
#pragma unroll
        for (int i = 0; i < 8; ++i) o[i] = (f32x4){0, 0, 0, 0};
        bf16x8 gk[8];
#pragma unroll
        for (int i = 0; i < 8; ++i) { const int key = selw[4 * i + fq]; gk[i] = ld16(kvb + (size_t)key * 128 + 8 * fr); }
        const int nt = nsel / 32;
        for (int ti = 0; ti < nt; ++ti) {
            const bf16x8 kp = ld16(selw + 32 * ti + 8 * fq);
#pragma unroll
            for (int i = 0; i < 8; ++i) *(bf16x8*)(tile + wr_addr[i]) = gk[i];
            if (ti + 1 < nt) {
#pragma unroll
                for (int i = 0; i < 8; ++i) { const int key = selw[32 * (ti + 1) + 4 * i + fq]; gk[i] = ld16(kvb + (size_t)key * 128 + 8 * fr); }
            }
            f32x4 lg[2] = {(f32x4){0, 0, 0, 0}, (f32x4){0, 0, 0, 0}};
#pragma unroll
            for (int rb = 0; rb < 2; ++rb)
#pragma unroll
                for (int s = 0; s < 4; ++s) lg[rb] = MFMA16(ld16(tile + rd_addr[rb][s]), qf[s], lg[rb]);
            float val[8]; float tmax = -INFINITY;
#pragma unroll
            for (int j = 0; j < 8; ++j) { const float dist = fabsf((float)(t - (int)(unsigned short)kp[j])); val[j] = lg[j >> 2][j & 3] - slope * dist; tmax = fmaxf(tmax, val[j]); }
            tmax = fmaxf(tmax, __shfl_xor(tmax, 16)); tmax = fmaxf(tmax, __shfl_xor(tmax, 32));
            const float m_new = fmaxf(m_run, tmax);
            const float scale = __expf(m_run - m_new);
            l_run *= scale;
#pragma unroll
            for (int i = 0; i < 8; ++i) o[i] *= scale;
            float pv[8];
#pragma unroll
            for (int j = 0; j < 8; ++j) { pv[j] = __expf(val[j] - m_new); l_run += pv[j]; }
            m_run = m_new;
            u32x4 pk; pk.x = cvt_pk_bf16(pv[0], pv[1]); pk.y = cvt_pk_bf16(pv[2], pv[3]); pk.z = cvt_pk_bf16(pv[4], pv[5]); pk.w = cvt_pk_bf16(pv[6], pv[7]);
            const bf16x8 pf = __builtin_bit_cast(bf16x8, pk);
            s16x4 tr[8][2];
            TR8(tr[0][0], tr[0][1], tr[1][0], tr[1][1], tr[2][0], tr[2][1], tr[3][0], tr[3][1], tr_addr[0][0], tr_addr[0][1], tr_addr[1][0], tr_addr[1][1], tr_addr[2][0], tr_addr[2][1], tr_addr[3][0], tr_addr[3][1]);
            TR8(tr[4][0], tr[4][1], tr[5][0], tr[5][1], tr[6][0], tr[6][1], tr[7][0], tr[7][1], tr_addr[4][0], tr_addr[4][1], tr_addr[5][0], tr_addr[5][1], tr_addr[6][0], tr_addr[6][1], tr_addr[7][0], tr_addr[7][1]);
#pragma unroll
            for (int cc = 0; cc < 8; ++cc) {
                bf16x8 kf; kf[0] = tr[cc][0][0]; kf[1] = tr[cc][0][1]; kf[2] = tr[cc][0][2]; kf[3] = tr[cc][0][3]; kf[4] = tr[cc][1][0]; kf[5] = tr[cc][1][1]; kf[6] = tr[cc][1][2]; kf[7] = tr[cc][1][3];
                o[cc] = MFMA16(kf, pf, o[cc]);
            }
        }
        float lt = l_run; lt += __shfl_xor(lt, 16); lt += __shfl_xor(lt, 32);
        const float inv = 1.f / lt;
        if (fr < 8) {
#pragma unroll
            for (int cc = 0; cc < 8; ++cc) { u32x2 ov; ov.x = cvt_pk_bf16(o[cc][0] * inv, o[cc][1] * inv); ov.y = cvt_pk_bf16(o[cc][2] * inv, o[cc][3] * inv);
                *(u32x2*)(mix + (size_t)q * KMIX + 512 + fr * 128 + 16 * cc + 4 * fq) = ov; }
        }
    }
}
typedef float f2 __attribute__((ext_vector_type(2)));
#ifndef PEER_FP8_MASK
#define PEER_FP8_MASK 3
#endif
constexpr float U_SCALE = 64.f, V_SCALE = 8.f;
DI unsigned pack4_fp8(float a, float b, float c, float d) { int p = __builtin_amdgcn_cvt_pk_fp8_f32(a, b, 0, false); p = __builtin_amdgcn_cvt_pk_fp8_f32(c, d, p, true); return (unsigned)p; }
DI void conv_chunk_fp8(const float* __restrict__ src, unsigned char* __restrict__ dst, size_t i0, int n16, float sc) {
    for (int i = opq_tid(); i < n16; i += 256) {
        const float4* s4 = (const float4*)src + 4 * (i0 + i);
        const float4 a = s4[0], b = s4[1], c = s4[2], d = s4[3];
        u32x4 o; o.x = pack4_fp8(a.x * sc, a.y * sc, a.z * sc, a.w * sc); o.y = pack4_fp8(b.x * sc, b.y * sc, b.z * sc, b.w * sc);
        o.z = pack4_fp8(c.x * sc, c.y * sc, c.z * sc, c.w * sc); o.w = pack4_fp8(d.x * sc, d.y * sc, d.z * sc, d.w * sc);
        ((u32x4*)dst)[i0 + i] = o;
    }
}
struct PeerLds2 {
    float trans[4][1024];
    unsigned char li[4][2][64][16];
    unsigned short pe[4][8][128];
    float pg[4][8][128];
};
template <int OFF, int NK>
DI void sort16_desc(unsigned (&k)[NK]) {
#pragma unroll
    for (int size = 2; size <= 16; size <<= 1)
#pragma unroll
        for (int stride = size >> 1; stride > 0; stride >>= 1)
#pragma unroll
            for (int i = 0; i < 16; ++i) {
                const int j = i ^ stride;
                if (j > i) {
                    const bool desc = ((i & size) == 0);
                    const unsigned a = k[OFF + i], b = k[OFF + j];
                    const unsigned hi = a > b ? a : b, lo = a > b ? b : a;
                    k[OFF + i] = desc ? hi : lo; k[OFF + j] = desc ? lo : hi;
                }
            }
}
template <int OA, int OB, int NK>
DI void merge_top16(unsigned (&k)[NK]) {
#pragma unroll
    for (int i = 0; i < 16; ++i) { const unsigned a = k[OA + i], b = k[OB + 15 - i]; k[OA + i] = a > b ? a : b; }
#pragma unroll
    for (int stride = 8; stride > 0; stride >>= 1)
#pragma unroll
        for (int i = 0; i < 16; ++i) {
            const int j = i ^ stride;
            if (j > i) { const unsigned a = k[OA + i], b = k[OA + j]; k[OA + i] = a > b ? a : b; k[OA + j] = a > b ? b : a; }
        }
}
DI void peer_retrieve(const Params& p, int l, int tok0, PeerLds2& S, int lane, int wave) {
    const int fr = lane & 15, fq = lane >> 4;
    const bf16* QP = (const bf16*)(wsb(p) + WS_PROJ);
    const bf16* PK = (const bf16*)(wsb(p) + WS_PK) + (size_t)l * 2 * 128 * 64;
    float* trans = S.trans[wave];
    unsigned K1[16], K2[16];
#pragma unroll
    for (int L = 0; L < 2; ++L) {
        f32x4 acc[4][8];
#pragma unroll
        for (int ct = 0; ct < 4; ++ct)
#pragma unroll
            for (int kt = 0; kt < 8; ++kt) acc[ct][kt] = (f32x4){0, 0, 0, 0};
#pragma unroll
        for (int kt = 0; kt < 8; ++kt) {
            const bf16* krow = PK + (size_t)L * 8192 + (size_t)(16 * kt + fr) * 64 + 8 * fq;
            const bf16x8 a0 = ld16(krow), a1 = ld16(krow + 32);
#pragma unroll
            for (int ct = 0; ct < 4; ++ct) {
                const bf16* qrow = QP + (size_t)(tok0 + 2 * ct + (fr >> 3)) * 1024 + 128 * (fr & 7) + 64 * L + 8 * fq;
                acc[ct][kt] = MFMA16(a0, ld16(qrow), acc[ct][kt]); acc[ct][kt] = MFMA16(a1, ld16(qrow + 32), acc[ct][kt]);
            }
        }
        unsigned k[128];
#define PEER_ROUND(kt)                                                                                                                            \
        {                                                                                                                                         \
            _Pragma("unroll") for (int ct = 0; ct < 4; ++ct) *(f32x4*)(trans + ((ct * 4 + fq) * 16 + fr) * 4) = acc[ct][kt];                       \
            _Pragma("unroll") for (int sq = 0; sq < 4; ++sq) {                                                                                     \
                const f32x4 v = *(const f32x4*)(trans + ((fq * 4 + sq) * 16 + fr) * 4);                                                            \
                _Pragma("unroll") for (int i = 0; i < 4; ++i) k[16 * (kt) + sq * 4 + i] = (fkey(v[i]) & ~0x7fu) | (unsigned)(16 * (kt) + 4 * sq + i); \
            }                                                                                                                                     \
            sort16_desc<16 * (kt)>(k);                                                                                                            \
        }
        PEER_ROUND(0) PEER_ROUND(1) merge_top16<0, 16>(k);
        PEER_ROUND(2) PEER_ROUND(3) merge_top16<32, 48>(k); merge_top16<0, 32>(k);
        PEER_ROUND(4) PEER_ROUND(5) merge_top16<64, 80>(k);
        PEER_ROUND(6) PEER_ROUND(7) merge_top16<96, 112>(k); merge_top16<64, 96>(k);
        merge_top16<0, 64>(k);
#undef PEER_ROUND
        u32x4 ib;
        ib.x = (k[0] & 127u) | ((k[1] & 127u) << 8) | ((k[2] & 127u) << 16) | ((k[3] & 127u) << 24);
        ib.y = (k[4] & 127u) | ((k[5] & 127u) << 8) | ((k[6] & 127u) << 16) | ((k[7] & 127u) << 24);
        ib.z = (k[8] & 127u) | ((k[9] & 127u) << 8) | ((k[10] & 127u) << 16) | ((k[11] & 127u) << 24);
        ib.w = (k[12] & 127u) | ((k[13] & 127u) << 8) | ((k[14] & 127u) << 16) | ((k[15] & 127u) << 24);
        *(u32x4*)(S.li[wave][L][lane]) = ib;
#pragma unroll
        for (int i = 0; i < 16; ++i) { if (L == 0) K1[i] = k[i]; else K2[i] = k[i]; }
    }
    float v1[16], v2[16];
#pragma unroll
    for (int i = 0; i < 16; ++i) { v1[i] = __uint_as_float(unkey(K1[i] & ~0x7fu)); v2[i] = __uint_as_float(unkey(K2[i] & ~0x7fu)); }
    unsigned c[64];
    {
        int idx = 0;
#pragma unroll
        for (int a = 0; a < 16; ++a)
#pragma unroll
            for (int b = 0; b < 16; ++b)
                if ((a + 1) * (b + 1) <= 16) { c[idx] = (fkey(v1[a] + v2[b]) & ~0xffu) | (unsigned)(a * 16 + b); ++idx; }
#pragma unroll
        for (int i = 50; i < 64; ++i) c[i] = 0u;
    }
    sort16_desc<0>(c); sort16_desc<16>(c); sort16_desc<32>(c); sort16_desc<48>(c);
    merge_top16<0, 16>(c); merge_top16<32, 48>(c); merge_top16<0, 32>(c);
    float sc[16]; float sum = 0.f;
    {
        const float m = __uint_as_float(unkey(c[0] & ~0xffu));
#pragma unroll
        for (int i = 0; i < 16; ++i) { sc[i] = __expf(__uint_as_float(unkey(c[i] & ~0xffu)) - m); sum += sc[i]; }
    }
    const float inv = 1.f / sum;
    const int tt = 2 * fq + (fr >> 3), head = fr & 7;
    const unsigned char* l1 = S.li[wave][0][lane]; const unsigned char* l2 = S.li[wave][1][lane];
#pragma unroll
    for (int i = 0; i < 16; ++i) {
        const unsigned ab = c[i] & 0xffu;
        const unsigned e = (unsigned)l1[ab >> 4] * 128u + (unsigned)l2[ab & 15u];
        S.pe[wave][tt][head * 16 + i] = (unsigned short)e; S.pg[wave][tt][head * 16 + i] = sc[i] * inv;
    }
}
template <bool FP8>
DI void peer_experts(const Params& p, int l, int tok, int tt, PeerLds2& S, int lane, int wave) {
    const bf16* H = (const bf16*)(wsb(p) + WS_H);
    const unsigned char* UB = wsb(p) + WS_UB; const unsigned char* VB = wsb(p) + WS_VB;
    const float* X = (const float*)(wsb(p) + WS_X);
    const float* modl = (const float*)(wsb(p) + WS_MOD) + (size_t)l * 4 * 6144;
    const int b = tok >> 12;
    const unsigned short* pe = S.pe[wave][tt]; const float* pg = S.pg[wave][tt];
    f2 hp[8];
    u32x4 h0, h1;
    {
        h0 = *(const u32x4*)(H + (size_t)tok * 1024 + 16 * lane); h1 = *(const u32x4*)(H + (size_t)tok * 1024 + 16 * lane + 8);
        hp[0] = (f2){bflo(h0.x), bfhi(h0.x)}; hp[1] = (f2){bflo(h0.y), bfhi(h0.y)}; hp[2] = (f2){bflo(h0.z), bfhi(h0.z)}; hp[3] = (f2){bflo(h0.w), bfhi(h0.w)};
        hp[4] = (f2){bflo(h1.x), bfhi(h1.x)}; hp[5] = (f2){bflo(h1.y), bfhi(h1.y)}; hp[6] = (f2){bflo(h1.z), bfhi(h1.z)}; hp[7] = (f2){bflo(h1.w), bfhi(h1.w)};
    }
    f2 acc[8];
#pragma unroll
    for (int i = 0; i < 8; ++i) acc[i] = (f2){0.f, 0.f};
    const bool b5 = (lane & 32) != 0, b4_ = (lane & 16) != 0, b3 = (lane & 8) != 0;
    const int eidx = (b3 ? 4 : 0) + (b4_ ? 2 : 0) + (b5 ? 1 : 0);
    if constexpr (FP8) {
    for (int e0 = 0; e0 < 128; e0 += 8) {
        u32x4 ur[8], vr[8];
#pragma unroll
        for (int j = 0; j < 8; ++j) {
            const int e = __builtin_amdgcn_readfirstlane((int)pe[e0 + j]);
            ur[j] = *(const u32x4*)(UB + (size_t)e * 1024 + 16 * lane);
            vr[j] = *(const u32x4*)(VB + (size_t)e * 1024 + 16 * lane);
        }
        float d[8];
#pragma unroll
        for (int j = 0; j < 8; ++j) {
            f2 s2 = {0.f, 0.f};
#pragma unroll
            for (int k = 0; k < 4; ++k) {
                const f2 lo = __builtin_amdgcn_cvt_pk_f32_fp8((int)ur[j][k], false), hi = __builtin_amdgcn_cvt_pk_f32_fp8((int)ur[j][k], true);
                s2 = lo * hp[2 * k] + s2; s2 = hi * hp[2 * k + 1] + s2;
            }
            d[j] = s2.x + s2.y;
        }
        float w[4], x2[2], y;
#pragma unroll
        for (int i = 0; i < 4; ++i) { const float keep = b5 ? d[2 * i + 1] : d[2 * i], send = b5 ? d[2 * i] : d[2 * i + 1]; w[i] = keep + __shfl_xor(send, 32); }
#pragma unroll
        for (int i = 0; i < 2; ++i) { const float keep = b4_ ? w[2 * i + 1] : w[2 * i], send = b4_ ? w[2 * i] : w[2 * i + 1]; x2[i] = keep + __shfl_xor(send, 16); }
        { const float keep = b3 ? x2[1] : x2[0], send = b3 ? x2[0] : x2[1]; y = keep + __shfl_xor(send, 8); }
        y += __shfl_xor(y, 4); y += __shfl_xor(y, 2); y += __shfl_xor(y, 1);
        const float sc = gelu_tanh(y * (1.f / U_SCALE)) * pg[e0 + eidx] * (1.f / V_SCALE);
#pragma unroll
        for (int j = 0; j < 8; ++j) {
            const float sj = __uint_as_float((unsigned)__builtin_amdgcn_readlane((int)__float_as_uint(sc), 32 * (j & 1) + 16 * ((j >> 1) & 1) + 8 * ((j >> 2) & 1)));
            const f2 sj2 = {sj, sj};
#pragma unroll
            for (int k = 0; k < 4; ++k) {
                const f2 lo = __builtin_amdgcn_cvt_pk_f32_fp8((int)vr[j][k], false), hi = __builtin_amdgcn_cvt_pk_f32_fp8((int)vr[j][k], true);
                acc[2 * k] = lo * sj2 + acc[2 * k]; acc[2 * k + 1] = hi * sj2 + acc[2 * k + 1];
            }
        }
    }
    } else {
    for (int e0 = 0; e0 < 128; e0 += 4) {
        const bf16* UBb = (const bf16*)UB; const bf16* VBb = (const bf16*)VB;
        u32x4 ur[4][2], vr[4][2];
#pragma unroll
        for (int j = 0; j < 4; ++j) {
            const int e = __builtin_amdgcn_readfirstlane((int)pe[e0 + j]);
            ur[j][0] = *(const u32x4*)(UBb + (size_t)e * 1024 + 16 * lane); ur[j][1] = *(const u32x4*)(UBb + (size_t)e * 1024 + 16 * lane + 8);
            vr[j][0] = *(const u32x4*)(VBb + (size_t)e * 1024 + 16 * lane); vr[j][1] = *(const u32x4*)(VBb + (size_t)e * 1024 + 16 * lane + 8);
        }
        float d[4];
#pragma unroll
        for (int j = 0; j < 4; ++j) {
            float sa = 0.f, sb = 0.f;
            sa = dot2bf(ur[j][0].x, h0.x, sa); sb = dot2bf(ur[j][0].y, h0.y, sb); sa = dot2bf(ur[j][0].z, h0.z, sa); sb = dot2bf(ur[j][0].w, h0.w, sb);
            sa = dot2bf(ur[j][1].x, h1.x, sa); sb = dot2bf(ur[j][1].y, h1.y, sb); sa = dot2bf(ur[j][1].z, h1.z, sa); sb = dot2bf(ur[j][1].w, h1.w, sb);
            d[j] = sa + sb;
        }
        float w[2], y;
#pragma unroll
        for (int i = 0; i < 2; ++i) { const float keep = b5 ? d[2 * i + 1] : d[2 * i], send = b5 ? d[2 * i] : d[2 * i + 1]; w[i] = keep + __shfl_xor(send, 32); }
        { const float keep = b4_ ? w[1] : w[0], send = b4_ ? w[0] : w[1]; y = keep + __shfl_xor(send, 16); }
        y += __shfl_xor(y, 8); y += __shfl_xor(y, 4); y += __shfl_xor(y, 2); y += __shfl_xor(y, 1);
        const float sc = gelu_tanh(y) * pg[e0 + (b4_ ? 2 : 0) + (b5 ? 1 : 0)];
#pragma unroll
        for (int j = 0; j < 4; ++j) {
            const float sj = __uint_as_float((unsigned)__builtin_amdgcn_readlane((int)__float_as_uint(sc), 32 * (j & 1) + 16 * ((j >> 1) & 1)));
            const f2 sj2 = {sj, sj};
#pragma unroll
            for (int hh = 0; hh < 2; ++hh)
#pragma unroll
                for (int k = 0; k < 4; ++k) { const unsigned dw = vr[j][hh][k]; const f2 vv = {bflo(dw), bfhi(dw)}; acc[4 * hh + k] = vv * sj2 + acc[4 * hh + k]; }
        }
    }
    }
    float xr[16];
    const float* xrow = X + (size_t)tok * 1024 + 16 * lane;
    float* xorow = p.out + (size_t)tok * 1024 + 16 * lane;
    const float* g2 = modl + (size_t)b * 6144 + 5 * 1024 + 16 * lane;
    float ss = 0;
#pragma unroll
    for (int q4 = 0; q4 < 4; ++q4) {
        const float4 xv = *(const float4*)(xrow + 4 * q4), gv = *(const float4*)(g2 + 4 * q4);
        float4 o; o.x = xv.x + gv.x * acc[2 * q4].x; o.y = xv.y + gv.y * acc[2 * q4].y; o.z = xv.z + gv.z * acc[2 * q4 + 1].x; o.w = xv.w + gv.w * acc[2 * q4 + 1].y;
        if (l == 0) *(float4*)(xorow + 4 * q4) = o;
        xr[4 * q4] = o.x; xr[4 * q4 + 1] = o.y; xr[4 * q4 + 2] = o.z; xr[4 * q4 + 3] = o.w;
        ss += o.x * o.x + o.y * o.y + o.z * o.z + o.w * o.w;
    }
    ss = wave_sum(ss);
    const float r = rsqrtf(ss * (1.f / 1024.f) + 1e-6f);
    if (l == 1) {
#pragma unroll
        for (int q4 = 0; q4 < 4; ++q4) {
            const float4 gv = *(const float4*)(p.in[28] + 16 * lane + 4 * q4);
            float4 o; o.x = xr[4 * q4] * r * gv.x; o.y = xr[4 * q4 + 1] * r * gv.y; o.z = xr[4 * q4 + 2] * r * gv.z; o.w = xr[4 * q4 + 3] * r * gv.w;
            *(float4*)(xorow + 4 * q4) = o;
        }
    } else {
        const float* g = p.in[2] + 1024 + 16 * lane; const float* mod1 = (const float*)(wsb(p) + WS_MOD) + ((size_t)4 + b) * 6144 + 16 * lane;
        bf16* hrow = (bf16*)(wsb(p) + WS_H2) + (size_t)tok * 1024 + 16 * lane;
        float hv[16];
#pragma unroll
        for (int q4 = 0; q4 < 4; ++q4) {
            const float4 gg = *(const float4*)(g + 4 * q4), s1 = *(const float4*)(mod1 + 1024 + 4 * q4), s0 = *(const float4*)(mod1 + 4 * q4);
            hv[4 * q4] = xr[4 * q4] * r * gg.x * (1.f + s1.x) + s0.x; hv[4 * q4 + 1] = xr[4 * q4 + 1] * r * gg.y * (1.f + s1.y) + s0.y;
            hv[4 * q4 + 2] = xr[4 * q4 + 2] * r * gg.z * (1.f + s1.z) + s0.z; hv[4 * q4 + 3] = xr[4 * q4 + 3] * r * gg.w * (1.f + s1.w) + s0.w;
        }
        u32x4 o0, o1;
        o0.x = cvt_pk_bf16(hv[0], hv[1]); o0.y = cvt_pk_bf16(hv[2], hv[3]); o0.z = cvt_pk_bf16(hv[4], hv[5]); o0.w = cvt_pk_bf16(hv[6], hv[7]);
        o1.x = cvt_pk_bf16(hv[8], hv[9]); o1.y = cvt_pk_bf16(hv[10], hv[11]); o1.z = cvt_pk_bf16(hv[12], hv[13]); o1.w = cvt_pk_bf16(hv[14], hv[15]);
        *(u32x4*)(hrow) = o0; *(u32x4*)(hrow + 8) = o1;
    }
}

constexpr int SMEM_BYTES = LDS_BYTES;
#ifndef REP_MASK
#define REP_MASK 0xffff
#endif
#ifndef REP_ID
#define REP_ID -1
#endif
#ifndef REP_N
#define REP_N 1
#endif
#define NREP(id) ((id) == REP_ID ? REP_N : 1)
__global__ void __launch_bounds__(512, 2) fwd_megakernel(Params p) {
    unsigned char* smem = g_lds;
    const int tid = threadIdx.x, half = __builtin_amdgcn_readfirstlane(tid >> 8);
    const int Gp = gridDim.x, bidp = blockIdx.x;
    const int G = Gp * 2, bid = bidp + half * Gp;
    unsigned char* sm = smem + half * 65536;
    volatile int* qslot = (volatile int*)(smem + LDS_CTL + 16) + half;
    if (tid < 64) ((unsigned*)(smem + LDS_CTL))[tid] = 0u;
    __syncthreads();
    unsigned* ctl = (unsigned*)(wsb(p) + WS_CTL);
    unsigned* qctr = ctl + 4096;
    XcdBarrier bar = xcd_barrier_post(ctl, (volatile LAS unsigned*)(smem + LDS_CTL));
#define PHASE_PTRS unsigned char* ws = wsb(p); const bf16* H = (const bf16*)(ws + WS_H); bf16* PROJ = (bf16*)(ws + WS_PROJ); float* X = (float*)(ws + WS_X); const float* mod = (const float*)(ws + WS_MOD); (void)H; (void)PROJ; (void)X; (void)mod;
    int qn = 0;

    for (int rep = 0; rep < NREP(0); ++rep) {
            PHASE_PTRS
        constexpr int N_MOD = 192, N_LAYER = 192 + 256 + 128 + 128 + 256 + 256 + 16, N_PK = 4, N_GW = 128, N_PW = 8;
        constexpr int NV = N_MOD + 2 * N_LAYER + N_PK + N_GW + N_PW;
        for (int vb = bid; vb < NV; vb += G) {
            int v = vb;
            if (v < N_MOD) { it_mod(p, v, sm); continue; }
            v -= N_MOD;
            if (v < 2 * N_LAYER) {
                const int l = v / N_LAYER; v -= l * N_LAYER;
                bf16* wtin = (bf16*)(ws + WS_WTIN) + (size_t)l * NPROJ * 1024;
                const float* win = p.in[6] + (size_t)l * 1024 * 1732;
                bf16* wtout = (bf16*)(ws + WS_WTOUT) + (size_t)l * 1024 * KMIX;
                const float* wout = p.in[22] + (size_t)l * 1024 * 1024;
                if (v < 192) { it_transpose(TrArgs{win, 1732, 0, 1732, wtin, 1024, 0, 1024, 768, 0, nullptr}, v, sm); }
                else if ((v -= 192) < 256) { it_transpose(TrArgs{win, 1732, 0, 1732, wtin + (size_t)C_QA * 1024, 1024, 0, 1024, 1024, 1, p.in[20] + (size_t)l * 8 * 64 * 128}, v, sm); }
                else if ((v -= 256) < 128) { it_transpose(TrArgs{win, 1732, 1280, 1732, wtin + (size_t)C_CKV * 1024, 1024, 0, 1024, 512, 0, nullptr}, v, sm); }
                else if ((v -= 128) < 128) { it_transpose(TrArgs{wout, 1024, 0, 1024, wtout, KMIX, 0, 512, 1024, 0, nullptr}, v, sm); }
                else if ((v -= 128) < 256) { it_transpose(TrArgs{wout, 1024, 0, 1024, wtout, KMIX, 512, 1024, 1024, 2, p.in[21] + (size_t)l * 8 * 128 * 64}, v, sm); }
                else if ((v -= 256) < 256) { it_transpose(TrArgs{p.in[23] + (size_t)l * 1024 * 1024, 1024, 0, 1024, (bf16*)(ws + WS_WTQ) + (size_t)l * 1024 * 1024, 1024, 0, 1024, 1024, 0, nullptr}, v, sm); }
                else { v -= 256; it_transpose(TrArgs{p.in[15] + (size_t)l * 256 * 256, 256, 0, 256, (bf16*)(ws + WS_WTGLU) + (size_t)l * 256 * 256, 256, 0, 256, 256, 0, nullptr}, v, sm); }
                continue;
            }
            v -= 2 * N_LAYER;
            if (v < N_PK) { const int l = v >> 1, w = v & 1; conv_chunk(p.in[24 + w] + (size_t)l * 8192, (bf16*)(ws + WS_PK) + (size_t)l * 16384 + w * 8192, 0, 1024); continue; }
            v -= N_PK;
            if (v < N_GW) { it_gw(p, v); continue; }
            v -= N_GW;
            it_ssm_pw(p, v);
        }
        xcd_barrier(bar);
    }
    for (int rep = 0; rep < NREP(1); ++rep) {
            PHASE_PTRS
        constexpr int N_NORM = NTOK / 4, N_TAB = 4096, N_KT = 256;
        for (int vb = bid; vb < N_NORM + N_TAB + N_KT; vb += G) {
            if (vb < N_KT) { it_ssm_kt(p, vb, sm); continue; }
            if (vb - N_KT < N_NORM) {
                const int t_ = opq_tid(); const int row = (vb - N_KT) * 4 + (t_ >> 6);
                const float* m0 = (const float*)(wsb(p) + WS_MOD) + (size_t)(row >> 12) * 6144;
                norm_mod_row(p.in[0] + (size_t)row * 1024, p.in[2], m0, m0 + 1024, (bf16*)(wsb(p) + WS_H) + (size_t)row * 1024, t_ & 63);
            } else {
                const size_t base = (size_t)(vb - N_KT - N_NORM) * 2048;
                const int t_ = opq_tid();
#pragma unroll
                for (int e = 0; e < 8; ++e) ssm_tab_entry(p, base + e * 256 + t_);
            }
        }
        xcd_barrier(bar);
    }

    for (int l = 0; l < 2; ++l) {
        const float* xin = l == 0 ? p.in[0] : p.out;
        for (int rep = 0; rep < NREP(2 + 8 * l); ++rep) {
            PHASE_PTRS
            const bf16* Hin = l == 0 ? H : (const bf16*)(ws + WS_H2);
            pg8::StaticOrder S; S.init(NTOK, 2048, Gp, bidp);
            pg8::gemm_phase<Epi256<EpiBf16>, pg8::StaticOrder, true, true>((PG8_LAS unsigned char*)g_lds, pg8::Gemm{Hin, (const bf16*)(ws + WS_WTIN) + (size_t)l * NPROJ * 1024, NTOK, 2048, 1024}, S, Epi256<EpiBf16>{EpiBf16{PROJ, NPROJ}});
            xcd_barrier(bar);
        }
        for (int rep = 0; rep < NREP(3 + 8 * l); ++rep) {
            PHASE_PTRS
            {
                const bf16* Hin = l == 0 ? H : (const bf16*)(ws + WS_H2);
                pg8::StaticOrder S; S.init(NTOK, 256, Gp, bidp);
                pg8::gemm_phase<Epi256<EpiBf16>, pg8::StaticOrder, false, true>((PG8_LAS unsigned char*)g_lds, pg8::Gemm{Hin, (const bf16*)(ws + WS_WTIN) + ((size_t)l * NPROJ + 2048) * 1024, NTOK, 256, 1024}, S, Epi256<EpiBf16>{EpiBf16{PROJ + 2048, NPROJ}});
            }
            unsigned* ctr = qctr + 64 * (qn++);
            for (;;) {
                const int it = q_next(ctr, qslot);
                if (it >= 2048) break;
                const bool extra = rep + 1 < NREP(3 + 8 * l);
                const int ty = it < 1024 ? 0 : it < 1536 ? 1 : it < 1792 ? 2 : 3;
                if (extra && !((REP_MASK >> ty) & 1)) continue;
                if (it < 1024) it_dsa_index_select(p, it, sm, extra ? ((REP_MASK >> 4) & 31) : 3);
                else if (it < 1536) it_gmlp(p, l, it - 1024, sm);
                else if (it < 1792) it_ssm_a(p, l, it - 1536);
                else it_kvn(p, l, it - 1792);
            }
            xcd_barrier(bar);
        }
        for (int rep = 0; rep < NREP(4 + 8 * l); ++rep) {
            PHASE_PTRS
            unsigned* ctr = qctr + 64 * (qn++);
            for (;;) {
                const int it = q_next(ctr, qslot);
                if (it >= 256 + 1024 + 512) break;
                { const bool extra = rep + 1 < NREP(4 + 8 * l); const int ty = it < 256 ? 0 : it < 1280 ? 1 : 2; if (extra && !((REP_MASK >> (8 + ty)) & 1)) continue; }
                if (it < 256) it_ssm_c(p, l, it, sm, (rep + 1 < NREP(4 + 8 * l)) ? ((REP_MASK >> 12) & 7) : 7);
                else if (it < 1280) it_dsa_attn(p, it - 256, sm);
                else {
                    const int v = it - 1280, w = v >> 8, ch = v & 255;
                    if (!(PEER_FP8_MASK & (1 << l))) conv_chunk(p.in[26 + w] + (size_t)l * NEXP * 1024, (bf16*)(ws + (w ? WS_VB : WS_UB)), (size_t)ch * 8192, 8192);
                    else conv_chunk_fp8(p.in[26 + w] + (size_t)l * NEXP * 1024, ws + (w ? WS_VB : WS_UB), (size_t)ch * 4096, 4096, w ? V_SCALE : U_SCALE);
                }
            }
            xcd_barrier(bar);
        }
        for (int rep = 0; rep < NREP(5 + 8 * l); ++rep) {
            PHASE_PTRS
            const EpiGlu epi{(const bf16*)(ws + WS_YG), p.in[16] + l * 256, (bf16*)(ws + WS_MIX)};
            const bf16* Bt = (const bf16*)(ws + WS_WTGLU) + (size_t)l * 256 * 256;
            for (int t = bid; t < (NTOK / 64) * 2; t += G) gemm_tile64((const bf16*)(ws + WS_YG), 256, Bt, 256, 256, (t >> 1) * 64, (t & 1) * 128, (bf16*)sm, epi);
            xcd_barrier(bar);
        }
        for (int rep = 0; rep < NREP(6 + 8 * l); ++rep) {
            PHASE_PTRS
            pg8::StaticOrder S; S.init(NTOK, 1024, Gp, bidp);
            pg8::gemm_phase<Epi256<EpiResid>, pg8::StaticOrder, false, true>((PG8_LAS unsigned char*)g_lds, pg8::Gemm{(const bf16*)(ws + WS_MIX), (const bf16*)(ws + WS_WTOUT) + (size_t)l * 1024 * KMIX, NTOK, 1024, KMIX}, S, Epi256<EpiResid>{EpiResid{xin, X, mod + (size_t)l * 4 * 6144 + 2048}});
            xcd_barrier(bar);
        }
        for (int rep = 0; rep < NREP(7 + 8 * l); ++rep) {
            PHASE_PTRS
            for (int vb = bid; vb < NTOK / 4; vb += G) {
                const int t_ = opq_tid(); const int row = vb * 4 + (t_ >> 6);
                const float* m0 = (const float*)(wsb(p) + WS_MOD) + ((size_t)l * 4 + (row >> 12)) * 6144 + 3072;
                norm_mod_row((const float*)(wsb(p) + WS_X) + (size_t)row * 1024, p.in[3] + l * 1024, m0, m0 + 1024, (bf16*)(wsb(p) + WS_H) + (size_t)row * 1024, t_ & 63);
            }
            xcd_barrier(bar);
        }
        for (int rep = 0; rep < NREP(8 + 8 * l); ++rep) {
            PHASE_PTRS
            pg8::StaticOrder S; S.init(NTOK, 1024, Gp, bidp);
            pg8::gemm_phase<Epi256<EpiBf16>, pg8::StaticOrder, false, true>((PG8_LAS unsigned char*)g_lds, pg8::Gemm{H, (const bf16*)(ws + WS_WTQ) + (size_t)l * 1024 * 1024, NTOK, 1024, 1024}, S, Epi256<EpiBf16>{EpiBf16{PROJ, 1024}});
            xcd_barrier(bar);
        }
        for (int rep = 0; rep < NREP(9 + 8 * l); ++rep) {
            PHASE_PTRS
            PeerLds2& S = *(PeerLds2*)sm;
            hsync();
            const int t_ = opq_tid(), lane_ = t_ & 63, wave_ = t_ >> 6;
            for (int wb = bid * 4 + wave_; wb < NTOK / 8; wb += G * 4) {
                peer_retrieve(p, l, wb * 8, S, lane_, wave_);
                for (int tt = 0; tt < 8; ++tt) {
                    if (PEER_FP8_MASK & (1 << l)) peer_experts<true>(p, l, wb * 8 + tt, tt, S, lane_, wave_);
                    else peer_experts<false>(p, l, wb * 8 + tt, tt, S, lane_, wave_);
                }
            }
            if (l == 0 || rep + 1 < NREP(9 + 8 * l)) xcd_barrier(bar);
        }
    }
}

extern "C" void kernel_launch(void* const* d_in, const int* in_sizes, int n_in, void* d_out, int out_size, void* d_ws, size_t ws_size, hipStream_t stream) {
    if (n_in != 29 || ws_size < WS_END) { fprintf(stderr, "kernel_launch: bad args (n_in %d, ws %zu, need %zu)\n", n_in, ws_size, (size_t)WS_END); return; }
    static int grid = 0;
    if (grid == 0) {
        int dev = 0, cus = 0, per_cu = 0;
        if (hipGetDevice(&dev) != hipSuccess || hipDeviceGetAttribute(&cus, hipDeviceAttributeMultiprocessorCount, dev) != hipSuccess) { grid = -1; return; }
        if (hipFuncSetAttribute((const void*)fwd_megakernel, hipFuncAttributeMaxDynamicSharedMemorySize, LDS_BYTES) != hipSuccess) { fprintf(stderr, "kernel_launch: hipFuncSetAttribute failed\n"); grid = -1; return; }
        if (hipOccupancyMaxActiveBlocksPerMultiprocessor(&per_cu, (const void*)fwd_megakernel, 512, LDS_BYTES) != hipSuccess || per_cu < 1) { fprintf(stderr, "kernel_launch: occupancy query failed (%d)\n", per_cu); grid = -1; return; }
        grid = cus;
    }
    if (grid < 0) return;
    if (hipMemsetAsync((char*)d_ws + WS_CTL, 0, 65536, stream) != hipSuccess) { fprintf(stderr, "kernel_launch: memset failed\n"); return; }
    Params p{};
    for (int i = 0; i < 29; ++i) p.in[i] = (const float*)d_in[i];
    p.out = (float*)d_out; p.ws = (unsigned char*)d_ws;
    void* args[] = {&p};
    const hipError_t e = hipLaunchCooperativeKernel((const void*)fwd_megakernel, dim3(grid), dim3(512), args, LDS_BYTES, stream);
    if (e != hipSuccess) fprintf(stderr, "kernel_launch: cooperative launch failed: %s (grid %d)\n", hipGetErrorString(e), grid);
}
```

```cpp
#include <hip/hip_runtime.h>
#include <cstdint>
#include <cstdio>

typedef unsigned short bf16;
typedef short bf16x8 __attribute__((ext_vector_type(8)));
typedef short s16x4 __attribute__((ext_vector_type(4)));
typedef float f32x4 __attribute__((ext_vector_type(4)));
typedef unsigned u32x4 __attribute__((ext_vector_type(4)));
typedef unsigned u32x2 __attribute__((ext_vector_type(2)));
typedef __bf16 bf2 __attribute__((ext_vector_type(2)));
#define DI __device__ __forceinline__
#define MFMA16(a, b, c) __builtin_amdgcn_mfma_f32_16x16x32_bf16((a), (b), (c), 0, 0, 0)

constexpr int DM = 1024, NB = 4, SEQ = 4096, NTOK = NB * SEQ;
constexpr int NPROJ = 2304;
constexpr int C_UA = 0, C_UB = 256, C_VB = 512, C_CKV = 768, C_QI = 896, C_KI = 1152, C_WI = 1216, C_QA = 1280;
constexpr int KMIX = 1536;
constexpr int NEXP = 16384;
constexpr size_t SCORES_PER_BATCH = (size_t)4096 * 2080;

constexpr size_t al256(size_t x) { return (x + 255) & ~(size_t)255; }
constexpr size_t WS_CTL = 0;
constexpr size_t WS_MOD = 65536;
constexpr size_t WS_WTIN = al256(WS_MOD + 2 * 4 * 6144 * 4);
constexpr size_t WS_WTOUT = al256(WS_WTIN + (size_t)2 * NPROJ * 1024 * 2);
constexpr size_t WS_WTQ = al256(WS_WTOUT + (size_t)2 * 1024 * KMIX * 2);
constexpr size_t WS_WTGLU = al256(WS_WTQ + (size_t)2 * 1024 * 1024 * 2);
constexpr size_t WS_GW = al256(WS_WTGLU + (size_t)2 * 256 * 256 * 2);
constexpr size_t WS_PK = al256(WS_GW + (size_t)2 * 4 * 128 * 128 * 2);
constexpr size_t WS_PW = al256(WS_PK + (size_t)2 * 2 * 128 * 64 * 2);
constexpr size_t WS_BB = al256(WS_PW + (size_t)2 * 16 * 65 * 64 * 2 * 4);
constexpr size_t WS_E = al256(WS_BB + (size_t)2 * 16 * 64 * 16 * 2 * 4);
constexpr size_t WS_G = al256(WS_E + (size_t)2 * 16 * 128 * 1024 * 2);
constexpr size_t WS_KT = al256(WS_G + (size_t)2 * 16 * 1024 * 128 * 2);
constexpr size_t WS_UB = al256(WS_KT + (size_t)2 * 16 * 64 * 256 * 2);
constexpr size_t WS_VB = al256(WS_UB + (size_t)NEXP * 1024 * 2);
constexpr size_t WS_H = al256(WS_VB + (size_t)NEXP * 1024 * 2);
constexpr size_t WS_PROJ = al256(WS_H + (size_t)NTOK * 1024 * 2);
constexpr size_t WS_SLOC = al256(WS_PROJ + (size_t)NTOK * NPROJ * 2);
constexpr size_t WS_YG = al256(WS_SLOC + (size_t)256 * 16 * 128 * 4);
constexpr size_t WS_KVN = al256(WS_YG + (size_t)NTOK * 256 * 2);
constexpr size_t WS_SEL = al256(WS_KVN + (size_t)NTOK * 128 * 2);
constexpr size_t WS_MIX = al256(WS_SEL + (size_t)NTOK * 256 * 2);
constexpr size_t WS_X = al256(WS_MIX + (size_t)NTOK * KMIX * 2);
constexpr size_t WS_SCORES = al256(WS_X + (size_t)NTOK * 1024 * 4);
constexpr size_t WS_H2 = al256(WS_SCORES + (size_t)NB * SCORES_PER_BATCH * 4);
constexpr size_t WS_END = al256(WS_H2 + (size_t)NTOK * 1024 * 2);

struct Params {
    const float* in[29];
    float* out;
    unsigned char* ws;
};

typedef __bf16 bf2v_t __attribute__((ext_vector_type(2)));
typedef float f2v_t __attribute__((ext_vector_type(2)));
DI unsigned cvt_pk_bf16(float lo, float hi) { const f2v_t f = {lo, hi}; const bf2v_t r = __builtin_convertvector(f, bf2v_t); return __builtin_bit_cast(unsigned, r); }
DI bf16 f2bf(float x) { return (bf16)(cvt_pk_bf16(x, 0.f) & 0xffffu); }
DI float bf2f(bf16 b) { return __uint_as_float((unsigned)b << 16); }
DI float bflo(unsigned u) { return __uint_as_float(u << 16); }
DI float bfhi(unsigned u) { return __uint_as_float(u & 0xffff0000u); }
DI float dot2bf(unsigned a, unsigned b, float c) { return __builtin_amdgcn_fdot2_f32_bf16(__builtin_bit_cast(bf2, a), __builtin_bit_cast(bf2, b), c, false); }
DI float gelu_tanh(float x) { const float u = 0.7978845608028654f * (x + 0.044715f * x * x * x); const float e = __expf(2.f * u); const float t = 1.f - 2.f / (e + 1.f); return 0.5f * x * (1.f + t); }
DI float sigmoidf(float x) { return 1.f / (1.f + __expf(-x)); }
DI float wave_sum(float v) { for (int o = 32; o > 0; o >>= 1) v += __shfl_xor(v, o); return v; }
DI unsigned wave_sum_u32(unsigned v) {
    int x = (int)v;
    x += __builtin_amdgcn_update_dpp(0, x, 0xB1, 0xf, 0xf, true);
    x += __builtin_amdgcn_update_dpp(0, x, 0x4E, 0xf, 0xf, true);
    x += __builtin_amdgcn_update_dpp(0, x, 0x141, 0xf, 0xf, true);
    x += __builtin_amdgcn_update_dpp(0, x, 0x140, 0xf, 0xf, true);
    x += __builtin_amdgcn_update_dpp(0, x, 0x142, 0xa, 0xf, true);
    x += __builtin_amdgcn_update_dpp(0, x, 0x143, 0xc, 0xf, true);
    return (unsigned)__builtin_amdgcn_readlane(x, 63);
}
DI unsigned wave_scan_incl_u32(unsigned v) {
    int x = (int)v;
    x += __builtin_amdgcn_update_dpp(0, x, 0x111, 0xf, 0xf, true);
    x += __builtin_amdgcn_update_dpp(0, x, 0x112, 0xf, 0xf, true);
    x += __builtin_amdgcn_update_dpp(0, x, 0x114, 0xf, 0xf, true);
    x += __builtin_amdgcn_update_dpp(0, x, 0x118, 0xf, 0xf, true);
    x += __builtin_amdgcn_update_dpp(0, x, 0x142, 0xa, 0xf, true);
    x += __builtin_amdgcn_update_dpp(0, x, 0x143, 0xc, 0xf, true);
    return (unsigned)x;
}
DI unsigned fkey(float v) { const unsigned u = __float_as_uint(v); return (u & 0x80000000u) ? ~u : (u | 0x80000000u); }
DI unsigned unkey(unsigned k) { return (k & 0x80000000u) ? (k & 0x7fffffffu) : ~k; }
DI bf16x8 ld16(const void* p) { return *(const bf16x8*)p; }
DI bf16x8 zero8() { bf16x8 z = {0, 0, 0, 0, 0, 0, 0, 0}; return z; }


#define XB_TMO      128
#define XB_XCNT(j)  (256  + 64 * (j))
#define XB_XSUB(j)  (1280 + 64 * (j))
#define XB_XGEN(j)  (2304 + 64 * (j))
#define XB_TOP      3328
#define XB_TOPGEN   3392
#define XCD_BAR_WORDS 3456
#define XB_SPIN_CAP (1u << 22)
#define LAS __attribute__((address_space(3)))
DI unsigned xb_ld(unsigned* p)              { return __hip_atomic_load(p, __ATOMIC_RELAXED, __HIP_MEMORY_SCOPE_AGENT); }
DI unsigned xb_add(unsigned* p, unsigned v) { return __hip_atomic_fetch_add(p, v, __ATOMIC_RELAXED, __HIP_MEMORY_SCOPE_AGENT); }
DI unsigned xb_xcc_id() { return (unsigned)__builtin_amdgcn_s_getreg((3 << 11) | 20) & 0xFu; }
#define XB_SPIN(cond, bar) do { unsigned _sp = 0; while (cond) { __builtin_amdgcn_s_sleep(1); \
    if ((++_sp & 255u) == 0u) { if (xb_ld(&(bar)[XB_TMO])) break; if (_sp > XB_SPIN_CAP) { atomicAdd(&(bar)[XB_TMO], 1u); break; } } } } while (0)
struct XcdBarrier { unsigned* bar; unsigned x; volatile LAS unsigned* st; };
DI XcdBarrier xcd_barrier_post(unsigned* bar, volatile LAS unsigned* st) {
    XcdBarrier b; b.bar = bar; b.x = xb_xcc_id(); b.st = st;
    if (threadIdx.x == 0) (void)xb_add(&bar[XB_XCNT(b.x)], 1u);
    return b;
}
DI void xcd_barrier_complete(unsigned* bar, unsigned x, unsigned& nloc, unsigned& nx) {
    const unsigned G = gridDim.x * gridDim.y * gridDim.z;
    unsigned sum, cnt, mine, sp = 0u;
    for (;;) {
        sum = 0u; cnt = 0u; mine = 0u;
#pragma unroll
        for (unsigned j = 0; j < 16; ++j) { const unsigned c = xb_ld(&bar[XB_XCNT(j)]); sum += c; cnt += (c > 0u) ? 1u : 0u; mine = (j == x) ? c : mine; }
        if (sum == G) break;
        __builtin_amdgcn_s_sleep(1);
        if ((++sp & 255u) == 0u) { if (xb_ld(&bar[XB_TMO])) break; if (sp > XB_SPIN_CAP) { atomicAdd(&bar[XB_TMO], 1u); break; } }
    }
    nloc = mine > 0u ? mine : 1u; nx = cnt > 0u ? cnt : 1u;
}
DI void xcd_barrier(const XcdBarrier& b) {
    asm volatile("s_waitcnt vmcnt(0)" ::: "memory");
    __syncthreads();
    if (threadIdx.x == 0) {
        unsigned* bar = b.bar;
        __builtin_amdgcn_s_waitcnt(0);
        unsigned nloc = b.st[0], nx = b.st[1];
        if (nloc == 0u) { xcd_barrier_complete(bar, b.x, nloc, nx); b.st[0] = nloc; b.st[1] = nx; }
        const unsigned old = xb_add(&bar[XB_XSUB(b.x)], 1u);
        const unsigned gen = old / nloc;
        if (old + 1u == (gen + 1u) * nloc) {
            __builtin_amdgcn_fence(__ATOMIC_RELEASE, "agent");
            asm volatile("s_waitcnt vmcnt(0)" ::: "memory");
            const unsigned og = xb_add(&bar[XB_TOP], 1u);
            const unsigned tg = og / nx;
            if (og + 1u == (tg + 1u) * nx) xb_add(&bar[XB_TOPGEN], 1u);
            else XB_SPIN(xb_ld(&bar[XB_TOPGEN]) == tg, bar);
            __builtin_amdgcn_fence(__ATOMIC_ACQUIRE, "agent");
            xb_add(&bar[XB_XGEN(b.x)], 1u);
            asm volatile("s_waitcnt vmcnt(0)" ::: "memory");
        } else {
            XB_SPIN(xb_ld(&bar[XB_XGEN(b.x)]) == gen, bar);
            __builtin_amdgcn_fence(__ATOMIC_ACQUIRE, "agent");
            asm volatile("s_waitcnt vmcnt(0)" ::: "memory");
        }
    }
    __syncthreads();
}
typedef __attribute__((address_space(1))) unsigned char g_uc;
DI unsigned char* wsb(const Params& p) {
    typedef const unsigned long long __attribute__((address_space(4))) karg_u64;
    const unsigned long long w = *(karg_u64*)((const char __attribute__((address_space(4)))*)__builtin_amdgcn_kernarg_segment_ptr() + __builtin_offsetof(Params, ws));
    unsigned lo = (unsigned)w, hi = (unsigned)(w >> 32);
    asm volatile("" : "+s"(lo), "+s"(hi));
    return (unsigned char*)(g_uc*)(((unsigned long long)hi << 32) | lo);
}
extern __shared__ __attribute__((aligned(1024))) unsigned char g_lds[];
constexpr int LDS_CTL = 131072, LDS_BYTES = 131072 + 256;
DI int opq_tid() { int t = (int)(threadIdx.x & 255u); asm volatile("" : "+v"(t)); return t; }
DI void hsync() {
    asm volatile("s_waitcnt lgkmcnt(0)" ::: "memory");
    LAS unsigned* ctr = (LAS unsigned*)(g_lds + LDS_CTL + 32) + (threadIdx.x >> 8);
    unsigned old = 0u;
    if ((threadIdx.x & 63u) == 0u) old = __hip_atomic_fetch_add(ctr, 1u, __ATOMIC_RELAXED, __HIP_MEMORY_SCOPE_WORKGROUP);
    old = (unsigned)__builtin_amdgcn_readfirstlane((int)old);
    const unsigned target = (old & ~3u) + 4u;
    while (__hip_atomic_load(ctr, __ATOMIC_RELAXED, __HIP_MEMORY_SCOPE_WORKGROUP) < target) __builtin_amdgcn_s_sleep(1);
    asm volatile("" ::: "memory");
}
DI void hsync_g() { asm volatile("s_waitcnt vmcnt(0)" ::: "memory"); hsync(); }
DI int q_next(unsigned* ctr, volatile int* slot) {
    hsync();
    if ((threadIdx.x & 255u) == 0u) *slot = (int)__hip_atomic_fetch_add(ctr, 1u, __ATOMIC_RELAXED, __HIP_MEMORY_SCOPE_AGENT);
    hsync();
    return __builtin_amdgcn_readfirstlane(*slot);
}
DI void it_mod(const Params& p, int vb, unsigned char* sm) {
    float (*ca)[1024] = (float (*)[1024])sm;
    float (*part)[4][64] = (float (*)[4][64])(sm + 16384);
    const float* c = p.in[1];
    const int tid = opq_tid();
    hsync();
    for (int i = tid; i < 4096; i += 256) { const float v = c[i]; ca[i >> 10][i & 1023] = v / (1.f + __expf(-v)); }
    hsync();
    const int col = tid & 63, sl = tid >> 6;
    const int idx = vb * 64 + col;
    const int l = idx / 6144, n = idx % 6144;
    const float* w = p.in[4] + (size_t)l * 1024 * 6144 + n + (size_t)(256 * sl) * 6144;
    float a0 = 0, a1 = 0, a2 = 0, a3 = 0;
#pragma unroll 32
    for (int k = 0; k < 256; ++k) { const float wv = w[(size_t)k * 6144]; const int kk = 256 * sl + k; a0 += ca[0][kk] * wv; a1 += ca[1][kk] * wv; a2 += ca[2][kk] * wv; a3 += ca[3][kk] * wv; }
    part[sl][0][col] = a0; part[sl][1][col] = a1; part[sl][2][col] = a2; part[sl][3][col] = a3;
    hsync();
    {
        const int bb = tid >> 6;
        const float v = part[0][bb][col] + part[1][bb][col] + part[2][bb][col] + part[3][bb][col] + p.in[5][l * 6144 + n];
        ((float*)(wsb(p) + WS_MOD))[((size_t)l * 4 + bb) * 6144 + n] = v;
    }
}

struct TrArgs { const float* src; int lds, coff, nvalid; bf16* dst; int ldd, doff; int K, N; int mode; const float* aux; };
DI void it_transpose(const TrArgs& a, int vb4, unsigned char* sm) {
    const int tid = opq_tid(), lane = tid & 63, wave = tid >> 6, tx = lane & 31, ty = lane >> 5;
    float (*t)[33] = (float (*)[33])(sm + wave * 4224);
    float (*ta)[65] = (float (*)[65])(sm + 16896 + wave * 8320);
    float (*tb)[33] = (float (*)[33])(sm + 16896 + 33280);
    const int nk = a.K / 32;
    const int vb = vb4 * 4 + wave, kt = vb % nk, nt = vb / nk;
    hsync();
    if (a.mode == 0) {
        float v[16];
#pragma unroll
        for (int i = 0; i < 16; ++i) { const int k = kt * 32 + ty + 2 * i, n = nt * 32 + tx; v[i] = (n + a.coff < a.nvalid) ? a.src[(size_t)k * a.lds + n + a.coff] : 0.f; }
#pragma unroll
        for (int i = 0; i < 16; ++i) t[ty + 2 * i][tx] = v[i];
    } else if (a.mode == 1) {
        const int h = (nt * 32) >> 7, r0 = (nt * 32) & 127;
        float va[32], vb_[8];
#pragma unroll
        for (int i = 0; i < 32; ++i) va[i] = a.src[(size_t)(kt * 32 + i) * a.lds + 768 + 64 * h + lane];
#pragma unroll
        for (int i = 0; i < 8; ++i) { const int e = tid + 256 * i, d = e >> 5, rr = e & 31; vb_[i] = a.aux[((size_t)h * 64 + d) * 128 + r0 + rr]; }
#pragma unroll
        for (int i = 0; i < 32; ++i) ta[i][lane] = va[i];
#pragma unroll
        for (int i = 0; i < 8; ++i) { const int e = tid + 256 * i; tb[e >> 5][e & 31] = vb_[i]; }
        hsync();
#pragma unroll 2
        for (int r = ty; r < 32; r += 2) { float s = 0; _Pragma("unroll 16") for (int d = 0; d < 64; ++d) s += ta[r][d] * tb[d][tx]; t[r][tx] = s * 0.125f; }
    } else {
        const int h = (kt * 32) >> 7, r0 = (kt * 32) & 127;
        float va[32], vb_[8];
#pragma unroll
        for (int i = 0; i < 32; ++i) va[i] = a.aux[((size_t)h * 128 + r0 + i) * 64 + lane];
#pragma unroll
        for (int i = 0; i < 8; ++i) { const int e = tid + 256 * i, d = e >> 5, nn = e & 31; vb_[i] = a.src[(size_t)(512 + 64 * h + d) * a.lds + nt * 32 + nn]; }
#pragma unroll
        for (int i = 0; i < 32; ++i) ta[i][lane] = va[i];
#pragma unroll
        for (int i = 0; i < 8; ++i) { const int e = tid + 256 * i; tb[e >> 5][e & 31] = vb_[i]; }
        hsync();
#pragma unroll 2
        for (int r = ty; r < 32; r += 2) { float s = 0; _Pragma("unroll 16") for (int d = 0; d < 64; ++d) s += ta[r][d] * tb[d][tx]; t[r][tx] = s; }
    }
    asm volatile("s_waitcnt lgkmcnt(0)" ::: "memory");
#pragma unroll
    for (int i = 0; i < 16; ++i) {
        const int r = ty + 2 * i, n = nt * 32 + r, k = kt * 32 + tx;
        a.dst[(size_t)n * a.ldd + a.doff + k] = f2bf(t[tx][r]);
    }
}
DI void conv_chunk(const float* __restrict__ src, bf16* __restrict__ dst, size_t i0, int n8) {
    for (int i = opq_tid(); i < n8; i += 256) {
        const float4 a = ((const float4*)src)[2 * (i0 + i)], b = ((const float4*)src)[2 * (i0 + i) + 1];
        u32x4 o; o.x = cvt_pk_bf16(a.x, a.y); o.y = cvt_pk_bf16(a.z, a.w); o.z = cvt_pk_bf16(b.x, b.y); o.w = cvt_pk_bf16(b.z, b.w);
        ((u32x4*)dst)[i0 + i] = o;
    }
}
DI void it_gw(const Params& p, int vb) {
    for (int e = 0; e < 4; ++e) {
        const int idx = vb * 1024 + e * 256 + opq_tid();
        const int s = idx & 127, t = (idx >> 7) & 127;
        const float v = (t >= 64 || s < 64) ? p.in[17][idx] : 0.f;
        ((bf16*)(wsb(p) + WS_GW))[idx] = f2bf(v);
    }
}
DI void it_ssm_pw(const Params& p, int vb) {
    const int idx = vb * 256 + opq_tid();
    const int pp = idx & 63, g = (idx >> 6) & 15, l = idx >> 10;
    const float lre = -__expf(p.in[7][idx]), lim = p.in[8][idx];
    const float dt = __expf(p.in[14][l * 16 + g]);
    float* pw = (float*)(wsb(p) + WS_PW) + ((size_t)(l * 16 + g) * 65) * 128;
    for (int d = 0; d <= 64; ++d) {
        const float mag = expf(lre * dt * (float)d); float sn, cs; sincosf(lim * dt * (float)d, &sn, &cs);
        pw[d * 128 + pp * 2] = mag * cs; pw[d * 128 + pp * 2 + 1] = mag * sn;
    }
    const float mag = expf(lre * dt); float sn, cs; sincosf(lim * dt, &sn, &cs);
    const float are = mag * cs, aim = mag * sn;
    const float den = lre * lre + lim * lim, P = are - 1.f, Q = aim;
    const float fre = (P * lre + Q * lim) / den, fim = (Q * lre - P * lim) / den;
    float* bb = (float*)(wsb(p) + WS_BB) + (size_t)idx * 32;
    for (int h = 0; h < 16; ++h) { const float br = p.in[9][(size_t)idx * 16 + h], bi = p.in[10][(size_t)idx * 16 + h]; bb[h * 2] = fre * br - fim * bi; bb[h * 2 + 1] = fre * bi + fim * br; }
}
DI void it_ssm_kt(const Params& p, int vb, unsigned char* sm) {
    float* cz = (float*)sm;
    float* bz = (float*)(sm + 8192);
    float* pz = (float*)(sm + 16384);
    const int tid = opq_tid();
    const int lg = vb >> 3, d0 = (vb & 7) * 8;
    const float* PW = (const float*)(wsb(p) + WS_PW) + ((size_t)lg * 65 + d0) * 128;
    const float* BB = (const float*)(wsb(p) + WS_BB) + (size_t)lg * 64 * 32;
    hsync();
    for (int i = tid; i < 1024; i += 256) { const int q = i >> 4, h = i & 15; cz[i * 2] = p.in[11][((size_t)lg * 16 + h) * 64 + q]; cz[i * 2 + 1] = p.in[12][((size_t)lg * 16 + h) * 64 + q]; }
    for (int i = tid; i < 2048; i += 256) bz[i] = BB[i];
    for (int i = tid; i < 1024; i += 256) pz[i] = PW[i];
    hsync();
    const int h = tid >> 4, hh = tid & 15;
    float acc[8];
#pragma unroll
    for (int d = 0; d < 8; ++d) acc[d] = 0.f;
    for (int q = 0; q < 64; ++q) {
        const float cr = cz[(q * 16 + h) * 2], ci = cz[(q * 16 + h) * 2 + 1], br = bz[(q * 16 + hh) * 2], bi = bz[(q * 16 + hh) * 2 + 1];
        const float xr = cr * br - ci * bi, xi = cr * bi + ci * br;
#pragma unroll
        for (int d = 0; d < 8; ++d) acc[d] += xr * pz[(d * 64 + q) * 2] - xi * pz[(d * 64 + q) * 2 + 1];
    }
    bf16* KT = (bf16*)(wsb(p) + WS_KT) + ((size_t)lg * 64 + d0) * 256;
    if (d0 == 0 && h == hh) acc[0] += p.in[13][(size_t)lg * 16 + h];
#pragma unroll
    for (int d = 0; d < 8; ++d) KT[d * 256 + tid] = f2bf(acc[d]);
    hsync();
}
DI void ssm_tab_entry(const Params& p, size_t idx) {
    const size_t NE = (size_t)2 * 16 * 128 * 1024;
    const float* PW = (const float*)(wsb(p) + WS_PW); const float* BB = (const float*)(wsb(p) + WS_BB);
    if (idx < NE) {
        const int kk = idx & 1023, pp = (idx >> 10) & 127; const int lg = (int)(idx >> 17);
        const int i = kk >> 4, hh = kk & 15, pq = pp & 63, part = pp >> 6;
        const float* pw = PW + ((size_t)lg * 65 + (63 - i)) * 128 + pq * 2; const float* bb = BB + ((size_t)lg * 64 + pq) * 32 + hh * 2;
        const float v = part ? (pw[0] * bb[1] + pw[1] * bb[0]) : (pw[0] * bb[0] - pw[1] * bb[1]);
        ((bf16*)(wsb(p) + WS_E))[idx] = f2bf(v);
    } else if (idx < 2 * NE) {
        const size_t e = idx - NE; const int pp = e & 127, jh = (e >> 7) & 1023; const int lg = (int)(e >> 17);
        const int j = jh >> 4, h = jh & 15, pq = pp & 63, part = pp >> 6;
        const float* pw = PW + ((size_t)lg * 65 + (j + 1)) * 128 + pq * 2;
        const float cr = p.in[11][((size_t)lg * 16 + h) * 64 + pq], ci = p.in[12][((size_t)lg * 16 + h) * 64 + pq];
        const float v = part ? -(cr * pw[1] + ci * pw[0]) : (cr * pw[0] - ci * pw[1]);
        ((bf16*)(wsb(p) + WS_G))[e] = f2bf(v);
    } else {
        const size_t e = idx - 2 * NE; if (e >= (size_t)2 * 16 * 64 * 256) return;
        const int hh = e & 15, h = (e >> 4) & 15, d = (e >> 8) & 63; const int lg = (int)(e >> 14);
        const float* pw = PW + ((size_t)lg * 65 + d) * 128; const float* bb = BB + (size_t)lg * 64 * 32 + hh * 2;
        const float* cr = p.in[11] + ((size_t)lg * 16 + h) * 64; const float* ci = p.in[12] + ((size_t)lg * 16 + h) * 64;
        float s = 0;
        for (int q = 0; q < 64; ++q) { const float zr = pw[q * 2] * bb[q * 32] - pw[q * 2 + 1] * bb[q * 32 + 1], zi = pw[q * 2] * bb[q * 32 + 1] + pw[q * 2 + 1] * bb[q * 32]; s += cr[q] * zr - ci[q] * zi; }
        ((bf16*)(wsb(p) + WS_KT))[e] = f2bf(s);
    }
}
DI void norm_mod_row(const float* __restrict__ xrow, const float* __restrict__ g, const float* __restrict__ sh, const float* __restrict__ sc, bf16* __restrict__ hrow, int lane) {
    float4 v[4]; float ss = 0;
#pragma unroll
    for (int j = 0; j < 4; ++j) { v[j] = *(const float4*)(xrow + 4 * lane + 256 * j); ss += v[j].x * v[j].x + v[j].y * v[j].y + v[j].z * v[j].z + v[j].w * v[j].w; }
    ss = wave_sum(ss);
    const float r = rsqrtf(ss * (1.f / 1024.f) + 1e-6f);
#pragma unroll
    for (int j = 0; j < 4; ++j) {
        const int c = 4 * lane + 256 * j;
        const float4 gg = *(const float4*)(g + c), s1 = *(const float4*)(sc + c), s0 = *(const float4*)(sh + c);
        u32x2 o; o.x = cvt_pk_bf16(v[j].x * r * gg.x * (1.f + s1.x) + s0.x, v[j].y * r * gg.y * (1.f + s1.y) + s0.y);
        o.y = cvt_pk_bf16(v[j].z * r * gg.z * (1.f + s1.z) + s0.z, v[j].w * r * gg.w * (1.f + s1.w) + s0.w);
        *(u32x2*)(hrow + c) = o;
    }
}
namespace pg8 {
#define PG8_LAS __attribute__((address_space(3)))
typedef unsigned short bf16_t;
constexpr int BM = 256, BK = 64, HALF = 128, HTB = HALF * BK * 2  , STAGE_BYTES = 8 * HTB, NXCD = 8, WGM = 8;
__host__ __device__ __forceinline__ int lds_byte(int r, int c) { const int st = (r >> 4) * 2 + (c >> 5), rr = r & 15, cc = c & 31, ob = rr * 64 + cc * 2; return st * 1024 + (ob ^ (((ob >> 9) & 1) << 5)); }
__host__ __device__ __forceinline__ void stage_rc(int b, int& R, int& C) { const int st = b / 1024, sb = b % 1024, swz = sb ^ (((sb >> 9) & 1) << 5); R = (st >> 1) * 16 + swz / 64; C = (st & 1) * 32 + (swz % 64) / 2; }
__host__ __device__ __forceinline__ int perm32(int rho) { const int n = rho >> 4, i = rho & 15; return 8 * (i >> 2) + 4 * n + (i & 3); }

struct Unit { int pm, pn; };
struct Gemm { const bf16_t* A; const bf16_t* Bt; int M, N, K; };

struct StaticOrder {
    int nM, nN, nwg, G, c;
    __host__ __device__ void init(int M, int N, int G_, int c_) { nM = M / BM; nN = N / BM; nwg = nM * nN; G = G_; c = c_; }
    __host__ __device__ bool next(int i, Unit& u) const {
        const long L = (long)i * G + c; if (L >= nwg) return false;
        int wgid = (int)L; { const int q = nwg / NXCD, r = nwg % NXCD, xcd = wgid % NXCD, off = wgid / NXCD; wgid = (xcd < r ? xcd * (q + 1) : r * (q + 1) + (xcd - r) * q) + off; }
        const int nig = WGM * nN, gid = wgid / nig, fm = gid * WGM, gsz = (nM - fm) < WGM ? (nM - fm) : WGM;
        u.pm = fm + ((wgid % nig) % gsz); u.pn = (wgid % nig) / gsz; return true;
    }
    __device__ __forceinline__ void a_ready(const Unit&) const {}
    __device__ __forceinline__ void done(const Unit&) const {}
};

template <class Epi, class Sched, bool ALIGN_EPI = false, bool SP2 = false>
__device__ __forceinline__ void gemm_phase(PG8_LAS unsigned char* lds, const Gemm g, const Sched& S, const Epi& E) {
    int tid = (int)threadIdx.x; asm volatile("" : "+v"(tid));
    const int wid = __builtin_amdgcn_readfirstlane(tid >> 6), lane = tid & 63, wr = wid >> 2, wc = wid & 3, fr = lane & 15, fq = lane >> 4;
    const int K = g.K, nt = K / BK;
    unsigned voffA[2], voffB[2];
#pragma unroll
    for (int i = 0; i < 2; ++i) { int R, C; stage_rc(tid * 16 + i * 8192, R, C); const int Rb = Epi::PERM ? ((R & ~31) + perm32(R & 31)) : R;
        voffA[i] = (unsigned)(R * K + C) * 2u; voffB[i] = (unsigned)(Rb * K + C) * 2u; }
    const size_t kstep = (size_t)(BK * 2);
    const size_t hstep = (size_t)HALF * K * 2;
    const size_t tstep = 2 * hstep;
    const unsigned ldsw = (unsigned)wid * 1024u;
    const int aoff = lds_byte(wr * 64 + fr, fq * 8), boff = lds_byte(wc * 32 + fr, fq * 8);
#define PG8_SA(b, h) (((b) * 2 + (h)) * HTB)
#define PG8_SB(b, h) ((4 + (b) * 2 + (h)) * HTB)
#define PG8_STAGE(bufoff, gbase, voff) do { _Pragma("unroll") for (int _i = 0; _i < 2; ++_i) \
        __builtin_amdgcn_global_load_lds((const unsigned*)((const char*)(gbase) + (voff)[_i]), (PG8_LAS unsigned*)(lds + (bufoff) + ldsw + _i * 8192), 16, 0, 0); } while (0)
#define PG8_LDA(dst, b, h) do { _Pragma("unroll") for (int m = 0; m < 4; ++m) _Pragma("unroll") for (int k = 0; k < 2; ++k) dst[m][k] = *(const PG8_LAS bf16x8*)(lds + PG8_SA(b, h) + aoff + m * 2048 + k * 1024); } while (0)
#define PG8_LDB(dst, b, h) do { _Pragma("unroll") for (int n = 0; n < 2; ++n) _Pragma("unroll") for (int k = 0; k < 2; ++k) dst[n][k] = *(const PG8_LAS bf16x8*)(lds + PG8_SB(b, h) + boff + n * 2048 + k * 1024); } while (0)
#define PG8_MMA(ai, bj, At, Bt) do { __builtin_amdgcn_s_setprio(1); _Pragma("unroll") for (int m = 0; m < 4; ++m) _Pragma("unroll") for (int n = 0; n < 2; ++n) _Pragma("unroll") for (int k = 0; k < 2; ++k) \
        acc[ai][bj][m][n] = __builtin_amdgcn_mfma_f32_16x16x32_bf16(Bt[n][k], At[m][k], acc[ai][bj][m][n], 0, 0, 0); __builtin_amdgcn_s_setprio(0); } while (0)
#define PG8_WAIT_V(n) asm volatile("s_waitcnt vmcnt(" #n ")" ::: "memory")
#define PG8_WAIT_L(n) asm volatile("s_waitcnt lgkmcnt(" #n ")" ::: "memory")
#define PG8_BAR __builtin_amdgcn_s_barrier()
#define PG8_SCHED __builtin_amdgcn_sched_barrier(0)
    Unit cur, nxt; int ui = 0;
    if (!S.next(0, cur)) return;
    f32x4 acc[2][2][4][2];
#pragma unroll
    for (int a = 0; a < 2; ++a)
#pragma unroll
        for (int b = 0; b < 2; ++b)
#pragma unroll
            for (int m = 0; m < 4; ++m)
#pragma unroll
                for (int n = 0; n < 2; ++n) acc[a][b][m][n] = (f32x4){0.f, 0.f, 0.f, 0.f};
    bf16x8 At[4][2], B0[2][2], B1[2][2];
    const char* cA = (const char*)g.A + (size_t)cur.pm * tstep; const char* cB = (const char*)g.Bt + (size_t)cur.pn * tstep;
    S.a_ready(cur);
    if constexpr (SP2) {
        PG8_STAGE(PG8_SB(0, 0), cB, voffB); PG8_STAGE(PG8_SB(0, 1), cB + hstep, voffB); PG8_STAGE(PG8_SA(0, 0), cA, voffA); PG8_STAGE(PG8_SA(0, 1), cA + hstep, voffA);
        if (wr == 1) PG8_BAR;
        PG8_WAIT_V(2); PG8_BAR;
        PG8_STAGE(PG8_SB(1, 0), cB + kstep, voffB); PG8_STAGE(PG8_SA(1, 0), cA + kstep, voffA); PG8_STAGE(PG8_SB(1, 1), cB + hstep + kstep, voffB);
        PG8_WAIT_V(6); PG8_BAR;
    } else {
        PG8_STAGE(PG8_SB(0, 0), cB, voffB); PG8_STAGE(PG8_SA(0, 0), cA, voffA); PG8_STAGE(PG8_SB(0, 1), cB + hstep, voffB); PG8_STAGE(PG8_SA(0, 1), cA + hstep, voffA);
        if (wr == 1) PG8_BAR;
        PG8_WAIT_V(4); PG8_BAR;
        PG8_STAGE(PG8_SB(1, 0), cB + kstep, voffB); PG8_STAGE(PG8_SA(1, 0), cA + kstep, voffA); PG8_STAGE(PG8_SB(1, 1), cB + hstep + kstep, voffB);
        PG8_WAIT_V(6); PG8_BAR;
    }
    for (;;) {
        const bool has_next = S.next(ui + 1, nxt);
        const char* nA = has_next ? (const char*)g.A + (size_t)nxt.pm * tstep : cA; const char* nB = has_next ? (const char*)g.Bt + (size_t)nxt.pn * tstep : cB;
        for (int t = 0; t < nt; t += 2) {
            const bool last = (t == nt - 2);
            const char* a1 = cA + (size_t)(t + 1) * kstep;
            const char* a2 = last ? nA : cA + (size_t)(t + 2) * kstep; const char* b2 = last ? nB : cB + (size_t)(t + 2) * kstep;
            const char* a3 = a2 + kstep; const char* b3 = b2 + kstep;
            if (last && has_next) S.a_ready(nxt);
            if constexpr (SP2) {
            PG8_LDB(B0, 0, 0); PG8_LDB(B1, 0, 1); PG8_SCHED; PG8_LDA(At, 0, 0); PG8_STAGE(PG8_SA(1, 1), a1 + hstep, voffA);
            PG8_WAIT_V(8); PG8_WAIT_L(0); PG8_BAR; PG8_MMA(0, 0, At, B0); PG8_MMA(0, 1, At, B1); PG8_BAR; PG8_SCHED;
            PG8_LDA(At, 0, 1); PG8_STAGE(PG8_SB(0, 0), b2, voffB); PG8_STAGE(PG8_SB(0, 1), b2 + hstep, voffB); PG8_STAGE(PG8_SA(0, 0), a2, voffA);
            PG8_WAIT_V(8); PG8_WAIT_L(0); PG8_BAR; PG8_MMA(1, 0, At, B0); PG8_MMA(1, 1, At, B1); PG8_BAR; PG8_SCHED;
            PG8_LDB(B0, 1, 0); PG8_LDB(B1, 1, 1); PG8_SCHED; PG8_LDA(At, 1, 0); PG8_STAGE(PG8_SA(0, 1), a2 + hstep, voffA);
            PG8_WAIT_V(8); PG8_WAIT_L(0); PG8_BAR; PG8_MMA(0, 0, At, B0); PG8_MMA(0, 1, At, B1); PG8_BAR; PG8_SCHED;
            PG8_LDA(At, 1, 1); PG8_STAGE(PG8_SB(1, 0), b3, voffB); PG8_STAGE(PG8_SB(1, 1), b3 + hstep, voffB); PG8_STAGE(PG8_SA(1, 0), a3, voffA);
            PG8_WAIT_V(8); PG8_WAIT_L(0); PG8_BAR; PG8_MMA(1, 0, At, B0); PG8_MMA(1, 1, At, B1); PG8_BAR; PG8_SCHED;
            } else {
            PG8_LDB(B0, 0, 0); PG8_SCHED; PG8_LDA(At, 0, 0); PG8_STAGE(PG8_SA(1, 1), a1 + hstep, voffA);
            PG8_WAIT_L(8); PG8_BAR; PG8_WAIT_L(0); PG8_MMA(0, 0, At, B0); PG8_BAR; PG8_SCHED;
            PG8_LDB(B1, 0, 1); PG8_STAGE(PG8_SB(0, 0), b2, voffB);
            PG8_BAR; PG8_WAIT_L(0); PG8_MMA(0, 1, At, B1); PG8_BAR;
            PG8_LDA(At, 0, 1); PG8_STAGE(PG8_SA(0, 0), a2, voffA);
            PG8_BAR; PG8_WAIT_L(0); PG8_MMA(1, 0, At, B0); PG8_BAR; PG8_SCHED;
            PG8_STAGE(PG8_SB(0, 1), b2 + hstep, voffB);
            PG8_WAIT_V(6); PG8_BAR; PG8_MMA(1, 1, At, B1); PG8_BAR;
            PG8_LDB(B0, 1, 0); PG8_SCHED; PG8_LDA(At, 1, 0); PG8_STAGE(PG8_SA(0, 1), a2 + hstep, voffA);
            PG8_WAIT_L(8); PG8_BAR; PG8_WAIT_L(0); PG8_MMA(0, 0, At, B0); PG8_BAR; PG8_SCHED;
            PG8_LDB(B1, 1, 1); PG8_STAGE(PG8_SB(1, 0), b3, voffB);
            PG8_BAR; PG8_WAIT_L(0); PG8_MMA(0, 1, At, B1); PG8_BAR;
            PG8_LDA(At, 1, 1); PG8_STAGE(PG8_SA(1, 0), a3, voffA);
            PG8_BAR; PG8_WAIT_L(0); PG8_MMA(1, 0, At, B0); PG8_BAR; PG8_SCHED;
            PG8_STAGE(PG8_SB(1, 1), b3 + hstep, voffB);
            PG8_WAIT_V(6); PG8_BAR; PG8_MMA(1, 1, At, B1); PG8_BAR;
            }
        }
        if constexpr (ALIGN_EPI) { if (wr == 0) PG8_BAR; }
        if constexpr (!Epi::AFTER_DRAIN) { E(acc, cur, wr, wc, fr, fq); S.done(cur); }
        if (!has_next) break;
#pragma unroll
        for (int a = 0; a < 2; ++a)
#pragma unroll
            for (int b = 0; b < 2; ++b)
#pragma unroll
                for (int m = 0; m < 4; ++m)
#pragma unroll
                    for (int n = 0; n < 2; ++n) acc[a][b][m][n] = (f32x4){0.f, 0.f, 0.f, 0.f};
        cur = nxt; cA = nA; cB = nB; ++ui;
        if constexpr (ALIGN_EPI) { if (wr == 1) PG8_BAR; }
    }
    PG8_WAIT_V(0);
    if constexpr (!ALIGN_EPI) { if (wr == 0) PG8_BAR; }
    PG8_BAR;
    if constexpr (Epi::AFTER_DRAIN) { E.fused(acc, cur, wr, wc, fr, fq, lds, wid, lane); S.done(cur); }
#undef PG8_SA
#undef PG8_SB
#undef PG8_STAGE
#undef PG8_LDA
#undef PG8_LDB
#undef PG8_MMA
#undef PG8_WAIT_V
#undef PG8_WAIT_L
#undef PG8_BAR
#undef PG8_SCHED
}
}
struct EpiBf16 { bf16* C; int ldc; DI void operator()(int r, int c, f32x4 v) const { u32x2 o; o.x = cvt_pk_bf16(v[0], v[1]); o.y = cvt_pk_bf16(v[2], v[3]); *(u32x2*)(C + (size_t)r * ldc + c) = o; } };
struct EpiResid { const float* xin; float* xout; const float* gate;
    DI void operator()(int r, int c, f32x4 v) const { const float4 x = *(const float4*)(xin + (size_t)r * 1024 + c); const float4 g = *(const float4*)(gate + (size_t)(r >> 12) * 6144 + c);
        float4 o; o.x = x.x + g.x * v[0]; o.y = x.y + g.y * v[1]; o.z = x.z + g.z * v[2]; o.w = x.w + g.w * v[3]; *(float4*)(xout + (size_t)r * 1024 + c) = o; } };
struct EpiGlu { const bf16* yg; const float* bglu; bf16* mix;
    DI void operator()(int r, int c, f32x4 v) const { const u32x2 y = *(const u32x2*)(yg + (size_t)r * 256 + c); const float4 b = *(const float4*)(bglu + c);
        u32x2 o; o.x = cvt_pk_bf16(bflo(y.x) * sigmoidf(v[0] + b.x), bfhi(y.x) * sigmoidf(v[1] + b.y)); o.y = cvt_pk_bf16(bflo(y.y) * sigmoidf(v[2] + b.z), bfhi(y.y) * sigmoidf(v[3] + b.w));
        *(u32x2*)(mix + (size_t)r * KMIX + c) = o; } };
constexpr int GP = 72;
template <class Epi>
DI void gemm_tile64(const bf16* __restrict__ A, int lda, const bf16* __restrict__ Bt, int ldb, int K, int m0, int n0, bf16* lds, const Epi& epi) {
    bf16* As = lds; bf16* Bs = lds + 64 * GP;
    const int tid = opq_tid(), lane = tid & 63, wave = tid >> 6, wm = wave >> 1, wn = wave & 1;
    const int fr = lane & 15, fq = lane >> 4;
    const int lrow = tid >> 3, lch = tid & 7;
    f32x4 acc[4][2];
#pragma unroll
    for (int i = 0; i < 4; ++i)
#pragma unroll
        for (int j = 0; j < 2; ++j) acc[i][j] = (f32x4){0.f, 0.f, 0.f, 0.f};
    bf16x8 ra[2], rb[4];
    const bf16* Ag = A + (size_t)(m0 + lrow) * lda + lch * 8;
    const bf16* Bg = Bt + (size_t)(n0 + lrow) * ldb + lch * 8;
#pragma unroll
    for (int i = 0; i < 4; ++i) { if (i < 2) ra[i] = ld16(Ag + (size_t)32 * i * lda); rb[i] = ld16(Bg + (size_t)32 * i * ldb); }
    const int nk = K / 64;
    for (int kt = 0; kt < nk; ++kt) {
        hsync();
#pragma unroll
        for (int i = 0; i < 4; ++i) { if (i < 2) *(bf16x8*)(As + (lrow + 32 * i) * GP + lch * 8) = ra[i]; *(bf16x8*)(Bs + (lrow + 32 * i) * GP + lch * 8) = rb[i]; }
        hsync();
        if (kt + 1 < nk) {
#pragma unroll
            for (int i = 0; i < 4; ++i) { if (i < 2) ra[i] = ld16(Ag + (size_t)32 * i * lda + (kt + 1) * 64); rb[i] = ld16(Bg + (size_t)32 * i * ldb + (kt + 1) * 64); }
        }
#pragma unroll
        for (int ks = 0; ks < 2; ++ks) {
            bf16x8 fa[4], fb[2];
#pragma unroll
            for (int i = 0; i < 4; ++i) fa[i] = ld16(Bs + (64 * wn + 16 * i + fr) * GP + 32 * ks + 8 * fq);
#pragma unroll
            for (int j = 0; j < 2; ++j) fb[j] = ld16(As + (32 * wm + 16 * j + fr) * GP + 32 * ks + 8 * fq);
#pragma unroll
            for (int i = 0; i < 4; ++i)
#pragma unroll
                for (int j = 0; j < 2; ++j) acc[i][j] = MFMA16(fa[i], fb[j], acc[i][j]);
        }
    }
#pragma unroll
    for (int i = 0; i < 4; ++i)
#pragma unroll
        for (int j = 0; j < 2; ++j) epi(m0 + 32 * wm + 16 * j + fr, n0 + 64 * wn + 16 * i + 4 * fq, acc[i][j]);
}
template <class F> struct Epi256 {
    static constexpr bool PERM = false, AFTER_DRAIN = false;
    F f;
    DI void operator()(const f32x4 (&acc)[2][2][4][2], const pg8::Unit& u, int wr, int wc, int, int) const {
        int t_ = (int)threadIdx.x; asm volatile("" : "+v"(t_));
        const int fr = t_ & 15, fq = (t_ >> 4) & 3;
#pragma unroll
        for (int ai = 0; ai < 2; ++ai)
#pragma unroll
            for (int m = 0; m < 4; ++m)
#pragma unroll
                for (int bj = 0; bj < 2; ++bj)
#pragma unroll
                    for (int n = 0; n < 2; ++n) f(u.pm * 256 + ai * 128 + wr * 64 + m * 16 + fr, u.pn * 256 + bj * 128 + wc * 32 + n * 16 + 4 * fq, acc[ai][bj][m][n]);
    }
};

DI unsigned off_b(unsigned row, unsigned ch) { return 256u * row + 16u * (ch ^ (((row & 3u) << 2) | ((row >> 2) & 3u))); }
#define TR8(o0, o1, o2, o3, o4, o5, o6, o7, a0, a1, a2, a3, a4, a5, a6, a7)                                                                         \
    asm volatile("s_waitcnt lgkmcnt(0)\n\t"                                                                                                         \
                 "ds_read_b64_tr_b16 %0, %8\n\tds_read_b64_tr_b16 %1, %9\n\tds_read_b64_tr_b16 %2, %10\n\tds_read_b64_tr_b16 %3, %11\n\t"           \
                 "ds_read_b64_tr_b16 %4, %12\n\tds_read_b64_tr_b16 %5, %13\n\tds_read_b64_tr_b16 %6, %14\n\tds_read_b64_tr_b16 %7, %15\n\t"         \
                 "s_waitcnt lgkmcnt(0)"                                                                                                             \
                 : "=&v"(o0), "=&v"(o1), "=&v"(o2), "=&v"(o3), "=&v"(o4), "=&v"(o5), "=&v"(o6), "=&v"(o7)                                           \
                 : "v"(a0), "v"(a1), "v"(a2), "v"(a3), "v"(a4), "v"(a5), "v"(a6), "v"(a7)                                                           \
                 : "memory")

DI void it_kvn(const Params& p, int l, int vb) {
    const int lane = opq_tid() & 63, wave = opq_tid() >> 6;
    const bf16* proj = (const bf16*)(wsb(p) + WS_PROJ); bf16* kvn = (bf16*)(wsb(p) + WS_KVN);
    const float g0 = p.in[19][l * 128 + 2 * lane], g1 = p.in[19][l * 128 + 2 * lane + 1];
    for (int i = 0; i < 16; ++i) {
        const int row = vb * 64 + i * 4 + wave;
        const unsigned u = *(const unsigned*)(proj + (size_t)row * NPROJ + C_CKV + 2 * lane);
        const float a = bflo(u), b = bfhi(u);
        const float ss = wave_sum(a * a + b * b);
        const float r = rsqrtf(ss * (1.f / 128.f) + 1e-6f);
        *(unsigned*)(kvn + (size_t)row * 128 + 2 * lane) = cvt_pk_bf16(a * r * g0, b * r * g1);
    }
}

DI void it_ssm_a(const Params& p, int l, int item) {
    const int lane = opq_tid() & 63, wave = opq_tid() >> 6, fr = lane & 15, fq = lane >> 4;
    const bf16* proj = (const bf16*)(wsb(p) + WS_PROJ);
    float* sloc = (float*)(wsb(p) + WS_SLOC);
    const int g = item & 15, rt = item >> 4;
    const bf16* E = (const bf16*)(wsb(p) + WS_E) + ((size_t)(l * 16 + g) * 128) * 1024;
    const int R = 16 * rt + fr, b = R >> 6, k = R & 63;
    const bf16* arow = proj + ((size_t)b * 4096 + 64 * k + (fq >> 1)) * NPROJ + C_UA + 16 * g + 8 * (fq & 1);
    f32x4 acc[2] = {(f32x4){0, 0, 0, 0}, (f32x4){0, 0, 0, 0}};
#pragma unroll 4
    for (int ks = 0; ks < 32; ++ks) {
        const bf16x8 a = ld16(arow + (size_t)(2 * ks) * NPROJ);
#pragma unroll
        for (int c = 0; c < 2; ++c) { const int ct = 2 * wave + c; const bf16x8 bf = ld16(E + (size_t)(16 * ct + fr) * 1024 + 32 * ks + 8 * fq); acc[c] = MFMA16(a, bf, acc[c]); }
    }
#pragma unroll
    for (int c = 0; c < 2; ++c)
#pragma unroll
        for (int i = 0; i < 4; ++i) sloc[((size_t)(16 * rt + 4 * fq + i) * 16 + g) * 128 + 16 * (2 * wave + c) + fr] = acc[c][i];
}

DI void it_ssm_c(const Params& p, int l, int item, unsigned char* sm, int pm = 7) {
    bf16* sst = (bf16*)sm;
    bf16* ktl = (bf16*)(sm + 17408);
    const int tid = opq_tid(), lane = tid & 63, wave = tid >> 6, fr = lane & 15, fq = lane >> 4;
    const bf16* proj = (const bf16*)(wsb(p) + WS_PROJ);
    const float* sloc = (const float*)(wsb(p) + WS_SLOC);
    bf16* yg = (bf16*)(wsb(p) + WS_YG);
    const int jq = item & 3, g = (item >> 2) & 15, b = item >> 6;
    const bf16* KT = (const bf16*)(wsb(p) + WS_KT) + (size_t)(l * 16 + g) * 64 * 256;
    hsync();
#pragma unroll
    for (int i = 0; i < 8; ++i) *(bf16x8*)(ktl + (i * 256 + tid) * 8) = ld16(KT + (size_t)(i * 256 + tid) * 8);
    if (wave == 0 && (pm & 1)) {
        const float* pw64 = (const float*)(wsb(p) + WS_PW) + ((size_t)(l * 16 + g) * 65 + 64) * 128 + lane * 2;
        const float ar = pw64[0], ai = pw64[1];
        float sr = 0, si = 0;
        const float* s = sloc + ((size_t)(b * 64) * 16 + g) * 128;
        float lr[64], li[64];
#pragma unroll
        for (int k = 0; k < 64; ++k) { lr[k] = s[(size_t)k * 2048 + lane]; li[k] = s[(size_t)k * 2048 + 64 + lane]; }
#pragma unroll
        for (int k = 0; k < 64; ++k) {
            sst[k * 136 + lane] = f2bf(sr); sst[k * 136 + 64 + lane] = f2bf(si);
            const float nr = ar * sr - ai * si + lr[k], ni = ar * si + ai * sr + li[k];
            sr = nr; si = ni;
        }
    }
    hsync();
    const bf16* G = (const bf16*)(wsb(p) + WS_G) + (size_t)(l * 16 + g) * 1024 * 128;
    const int kch = 16 * wave + fr;
    const bf16* arow = proj + ((size_t)b * 4096 + 64 * kch + (fq >> 1)) * NPROJ + C_UA + 16 * g + 8 * (fq & 1);
    const int j0 = 16 * jq;
    f32x4 acc[16];
#pragma unroll
    for (int jj = 0; jj < 16; ++jj) acc[jj] = (f32x4){0, 0, 0, 0};
    const int nks = (j0 + 15) / 2 + 1;
    bf16x8 a_cur[8], a_nxt[8];
#pragma unroll
    for (int i = 0; i < 8; ++i) a_cur[i] = ld16(arow + (size_t)(2 * i) * NPROJ);
    const bf16* blane = ktl + (fr - 16 * (fq >> 1)) * 16 + 8 * (fq & 1);
#pragma unroll 1
    for (int grp = 0; grp < ((pm & 2) ? jq : 0); ++grp) {
#pragma unroll
        for (int i = 0; i < 8; ++i) a_nxt[i] = ld16(arow + (size_t)(2 * (8 * grp + 8 + i)) * NPROJ);
#pragma unroll
        for (int i = 0; i < 8; ++i) {
            const bf16* bp = blane + 256 * (j0 - 2 * (8 * grp + i));
#pragma unroll
            for (int jj = 0; jj < 16; ++jj) acc[jj] = MFMA16(ld16(bp + 256 * jj), a_cur[i], acc[jj]);
        }
#pragma unroll
        for (int i = 0; i < 8; ++i) a_cur[i] = a_nxt[i];
    }
    if (pm & 2) {
#pragma unroll
        for (int i = 0; i < 8; ++i) {
            const int ks = 8 * jq + i;
#pragma unroll
            for (int jj = 0; jj < 16; ++jj) {
                const int j = j0 + jj;
                if (2 * i <= jj) {
                    const int d = j - 2 * ks - (fq >> 1);
                    const bf16x8 bl = ld16(ktl + ((d < 0 ? 0 : d) * 16 + fr) * 16 + 8 * (fq & 1));
                    const bf16x8 bf = d >= 0 ? bl : zero8();
                    acc[jj] = MFMA16(bf, a_cur[i], acc[jj]);
                }
            }
        }
    }
#pragma unroll
    for (int ks = 0; ks < ((pm & 4) ? 4 : 0); ++ks) {
        const bf16x8 a = ld16(sst + kch * 136 + 32 * ks + 8 * fq);
        bf16x8 bfr[16];
#pragma unroll
        for (int jj = 0; jj < 16; ++jj) bfr[jj] = ld16(G + ((size_t)((j0 + jj) * 16 + fr)) * 128 + 32 * ks + 8 * fq);
#pragma unroll
        for (int jj = 0; jj < 16; ++jj) acc[jj] = MFMA16(bfr[jj], a, acc[jj]);
    }
#pragma unroll
    for (int jj = 0; jj < 16; ++jj) {
        const size_t tok = (size_t)b * 4096 + 64 * (16 * wave + fr) + j0 + jj;
        u32x2 o; o.x = cvt_pk_bf16(gelu_tanh(acc[jj][0]), gelu_tanh(acc[jj][1])); o.y = cvt_pk_bf16(gelu_tanh(acc[jj][2]), gelu_tanh(acc[jj][3]));
        *(u32x2*)(yg + tok * 256 + 16 * g + 4 * fq) = o;
    }
}

DI void it_gmlp(const Params& p, int l, int item, unsigned char* sm) {
    bf16* vnT = (bf16*)sm;
    const int tid = opq_tid(), lane = tid & 63, wave = tid >> 6, fr = lane & 15, fq = lane >> 4;
    const bf16* proj = (const bf16*)(wsb(p) + WS_PROJ); bf16* mix = (bf16*)(wsb(p) + WS_MIX);
    const int h = item & 3, blk = item >> 2;
    const size_t tok0 = (size_t)blk * 128;
    hsync();
    {
        const int row = tid >> 1, half = tid & 1;
        const bf16* vp = proj + (tok0 + row) * NPROJ + C_VB + 64 * h + 32 * half;
        float v[32]; float s = 0;
#pragma unroll
        for (int q = 0; q < 4; ++q) { const bf16x8 t = ld16(vp + 8 * q);
#pragma unroll
            for (int e = 0; e < 8; ++e) { v[8 * q + e] = bf2f((bf16)t[e]); s += v[8 * q + e]; } }
        s += __shfl_xor(s, 1); const float mu = s * (1.f / 64.f);
        float vs = 0;
#pragma unroll
        for (int e = 0; e < 32; ++e) { const float d = v[e] - mu; vs += d * d; }
        vs += __shfl_xor(vs, 1); const float r = rsqrtf(vs * (1.f / 64.f) + 1e-6f);
#pragma unroll
        for (int e = 0; e < 32; ++e) vnT[(32 * half + e) * 136 + row] = f2bf((v[e] - mu) * r);
    }
    hsync();
    const bf16* W = (const bf16*)(wsb(p) + WS_GW) + (size_t)(l * 4 + h) * 128 * 128;
    f32x4 acc[4][2];
#pragma unroll
    for (int i = 0; i < 4; ++i) { acc[i][0] = (f32x4){0, 0, 0, 0}; acc[i][1] = (f32x4){0, 0, 0, 0}; }
#pragma unroll
    for (int ks = 0; ks < 4; ++ks) {
        bf16x8 fa[4], fb[2];
#pragma unroll
        for (int i = 0; i < 4; ++i) fa[i] = ld16(vnT + (16 * i + fr) * 136 + 32 * ks + 8 * fq);
#pragma unroll
        for (int j = 0; j < 2; ++j) fb[j] = ld16(W + (size_t)(16 * (2 * wave + j) + fr) * 128 + 32 * ks + 8 * fq);
#pragma unroll
        for (int i = 0; i < 4; ++i)
#pragma unroll
            for (int j = 0; j < 2; ++j) acc[i][j] = MFMA16(fa[i], fb[j], acc[i][j]);
    }
#pragma unroll
    for (int j = 0; j < 2; ++j) {
        const int t = 16 * (2 * wave + j) + fr;
        const float bs = p.in[18][(l * 4 + h) * 128 + t];
#pragma unroll
        for (int i = 0; i < 4; ++i) {
            const int d = 16 * i + 4 * fq;
            const u32x2 u = *(const u32x2*)(proj + (tok0 + t) * NPROJ + C_UB + 64 * h + d);
            u32x2 o; o.x = cvt_pk_bf16(bflo(u.x) * (acc[i][j][0] + bs), bfhi(u.x) * (acc[i][j][1] + bs)); o.y = cvt_pk_bf16(bflo(u.y) * (acc[i][j][2] + bs), bfhi(u.y) * (acc[i][j][3] + bs));
            *(u32x2*)(mix + (tok0 + t) * KMIX + 256 + 64 * h + d) = o;
        }
    }
}

DI size_t score_row_off(int b, int t) { const int c = t >> 6; return (size_t)b * SCORES_PER_BATCH + (size_t)4096 * (c * (c + 1) / 2) + (size_t)(t & 63) * 64 * (c + 1); }
template <int NR>
DI void dsa_select_impl(const float* __restrict__ srow, int nreg, bf16* __restrict__ so, int lane, unsigned* hist, int topbit = 31) {
    unsigned key[NR];
#pragma unroll
    for (int r = 0; r < NR; ++r) { const float v = srow[64 * r + lane]; key[r] = (r < nreg) ? fkey(v + 0.f) : 0u; }
    unsigned T = 0;
#pragma unroll 1
    for (int bit = (topbit < 0 ? -1 : (topbit & 63)); bit >= 0; --bit) {
        const unsigned cand = T | (1u << bit);
        unsigned c = 0;
#pragma unroll
        for (int r = 0; r < NR; ++r) asm("v_cmp_ge_u32 vcc, %1, %2\n\tv_addc_co_u32 %0, vcc, 0, %0, vcc" : "+v"(c) : "v"(key[r]), "v"(cand) : "vcc");
        const unsigned cnt = wave_sum_u32(c);
        if (cnt >= 256u) { T = cand; if (cnt == 256u) break; }
    }
    if (topbit < 0 || (topbit & 64)) { unsigned x = T; _Pragma("unroll") for (int r = 0; r < NR; ++r) x ^= key[r]; if (x == 0x12345u) so[lane] = (bf16)x; return; }
    unsigned c = 0;
#pragma unroll
    for (int r = 0; r < NR; ++r) asm("v_cmp_gt_u32 vcc, %1, %2\n\tv_addc_co_u32 %0, vcc, 0, %0, vcc" : "+v"(c) : "v"(key[r]), "v"(T) : "vcc");
    const int need = 256 - (int)wave_sum_u32(c);
    unsigned ce = 0;
#pragma unroll
    for (int r = 0; r < NR; ++r) asm("v_cmp_eq_u32 vcc, %1, %2\n\tv_addc_co_u32 %0, vcc, 0, %0, vcc" : "+v"(ce) : "v"(key[r]), "v"(T) : "vcc");
    if ((int)wave_sum_u32(ce) == need) {
        bf16* stg = (bf16*)hist;
        unsigned base = 0;
#pragma unroll
        for (int r = 0; r < NR; ++r) {
            const unsigned long long mt = __ballot(key[r] >= T);
            const unsigned pos = __builtin_amdgcn_mbcnt_hi((unsigned)(mt >> 32), __builtin_amdgcn_mbcnt_lo((unsigned)mt, base));
            stg[(key[r] >= T) ? pos : 256u + (unsigned)lane] = (bf16)(64 * r + lane);
            base += (unsigned)__popcll(mt);
        }
        asm volatile("s_waitcnt lgkmcnt(0)" ::: "memory");
        *(u32x2*)(so + 4 * lane) = *(const u32x2*)(stg + 4 * lane);
        return;
    }
    int base = 0, eqb = 0;
    const unsigned long long lt = (1ull << lane) - 1ull;
#pragma unroll
    for (int r = 0; r < NR; ++r) {
        const unsigned long long me = __ballot(key[r] == T);
        const int erank = eqb + __popcll(me & lt);
        const bool take = (key[r] > T) || (key[r] == T && erank < need);
        const unsigned long long mt = __ballot(take);
        if (take) so[base + __popcll(mt & lt)] = (bf16)(64 * r + lane);
        base += __popcll(mt); eqb += __popcll(me);
    }
}
DI void dsa_select_query(const Params& p, int q, int lane, unsigned* hist, int topbit = 31) {
    const float* scores = (const float*)(wsb(p) + WS_SCORES); bf16* sel = (bf16*)(wsb(p) + WS_SEL);
    const int b = q >> 12, t = q & 4095, c = t >> 6, nreg = c + 1;
    bf16* so = sel + (size_t)q * 256;
    if (nreg <= 4) { for (int r = 0; r < nreg; ++r) so[64 * r + lane] = (bf16)(64 * r + lane); return; }
    const float* srow = scores + score_row_off(b, t);
    if (nreg <= 16) dsa_select_impl<16>(srow, nreg, so, lane, hist, topbit);
    else if (nreg <= 32) dsa_select_impl<32>(srow, nreg, so, lane, hist, topbit);
    else if (nreg <= 48) dsa_select_impl<48>(srow, nreg, so, lane, hist, topbit);
    else dsa_select_impl<64>(srow, nreg, so, lane, hist, topbit);
}
DI void it_dsa_index_select(const Params& p, int item, unsigned char* sm, int mode = 3) {
    const int lane = opq_tid() & 63, wave = opq_tid() >> 6, fr = lane & 15, fq = lane >> 4;
    const bf16* proj = (const bf16*)(wsb(p) + WS_PROJ); float* scores = (float*)(wsb(p) + WS_SCORES);
    const int c = 63 - (item >> 4), b = (item >> 2) & 3, qg = item & 3;
    if (c >= 4 && (mode & 1)) {
        const int t = 64 * c + 16 * qg + fr;
        const bf16* qrow = proj + ((size_t)b * 4096 + t) * NPROJ;
        bf16x8 qf[4][2];
#pragma unroll
        for (int hh = 0; hh < 4; ++hh)
#pragma unroll
            for (int ks = 0; ks < 2; ++ks) qf[hh][ks] = ld16(qrow + C_QI + 64 * hh + 32 * ks + 8 * fq);
        float w[4];
        { const u32x2 wv = *(const u32x2*)(qrow + C_WI); w[0] = bflo(wv.x) * 0.0625f; w[1] = bfhi(wv.x) * 0.0625f; w[2] = bflo(wv.y) * 0.0625f; w[3] = bfhi(wv.y) * 0.0625f; }
        float* srow = scores + score_row_off(b, t);
        const int ntile = 4 * (c + 1);
        const bf16* kbase = proj + ((size_t)b * 4096 + fr) * NPROJ + C_KI + 8 * fq;
        bf16x8 k0[4], k1[4];
#pragma unroll
        for (int u = 0; u < 4; ++u) { const bf16* krow = kbase + (size_t)16 * (wave + 4 * u) * NPROJ; k0[u] = ld16(krow); k1[u] = ld16(krow + 32); }
        for (int base = wave; base < ntile; base += 16) {
            bf16x8 n0[4], n1[4];
            const bool more = base + 16 < ntile;
            if (more) {
#pragma unroll
                for (int u = 0; u < 4; ++u) { const bf16* krow = kbase + (size_t)16 * (base + 16 + 4 * u) * NPROJ; n0[u] = ld16(krow); n1[u] = ld16(krow + 32); }
            }
#pragma unroll
            for (int u = 0; u < 4; ++u) {
                const int kt = base + 4 * u;
                if (kt >= ntile) break;
                f32x4 sc = {0, 0, 0, 0};
#pragma unroll
                for (int hh = 0; hh < 4; ++hh) {
                    f32x4 a = {0, 0, 0, 0};
                    a = MFMA16(k0[u], qf[hh][0], a); a = MFMA16(k1[u], qf[hh][1], a);
#pragma unroll
                    for (int i = 0; i < 4; ++i) sc[i] += w[hh] * fmaxf(a[i], 0.f);
                }
#pragma unroll
                for (int i = 0; i < 4; ++i) sc[i] += 0.f;
                *(f32x4*)(srow + 16 * kt + 4 * fq) = sc;
            }
            if (more) {
#pragma unroll
                for (int u = 0; u < 4; ++u) { k0[u] = n0[u]; k1[u] = n1[u]; }
            }
        }
    }
    hsync_g();
    if (mode & 2) for (int i = 0; i < 4; ++i) dsa_select_query(p, b * 4096 + 64 * c + 16 * qg + 4 * wave + i, lane, (unsigned*)sm + 1024 * wave, (mode & 16) ? -1 : (((mode & 4) ? 15 : 31) | ((mode & 8) ? 64 : 0)));
}
DI void it_dsa_attn(const Params& p, int item, unsigned char* sm) {
    const int lane = opq_tid() & 63, wave = opq_tid() >> 6, fr = lane & 15, fq = lane >> 4;
    unsigned char* tile = sm + wave * 8192;
    bf16* selw = (bf16*)(sm + 32768 + wave * 512);
    const bf16* proj = (const bf16*)(wsb(p) + WS_PROJ); const bf16* kvn = (const bf16*)(wsb(p) + WS_KVN);
    const bf16* sel = (const bf16*)(wsb(p) + WS_SEL); bf16* mix = (bf16*)(wsb(p) + WS_MIX);
    unsigned wr_addr[8], rd_addr[2][4], tr_addr[8][2];
#pragma unroll
    for (int i = 0; i < 8; ++i) wr_addr[i] = off_b(4 * i + fq, fr);
#pragma unroll
    for (int rb = 0; rb < 2; ++rb)
#pragma unroll
        for (int s = 0; s < 4; ++s) rd_addr[rb][s] = off_b(8 * (fr >> 2) + 4 * rb + (fr & 3), 4 * s + fq);
    const unsigned tbase = (unsigned)(size_t)tile;
    {
        const unsigned q4 = fr >> 2, p4 = fr & 3;
#pragma unroll
        for (int c = 0; c < 8; ++c)
#pragma unroll
            for (int t = 0; t < 2; ++t) tr_addr[c][t] = tbase + off_b(8 * fq + 4 * t + q4, 2 * c + (p4 >> 1)) + 8 * (p4 & 1);
    }
    const float slope = fr < 8 ? exp2f(-(float)(fr + 1)) : 0.f;
    for (int qi = 0; qi < 4; ++qi) {
        const int q = item * 16 + wave * 4 + qi;
        const int b = q >> 12, t = q & 4095, c = t >> 6;
        const int nsel = (c + 1) * 64 < 256 ? (c + 1) * 64 : 256;
        const bf16* qa = proj + (size_t)q * NPROJ + C_QA;
        bf16x8 qf[4];
#pragma unroll
        for (int s = 0; s < 4; ++s) qf[s] = fr < 8 ? ld16(qa + fr * 128 + 32 * s + 8 * fq) : zero8();
        const bf16* selp = sel + (size_t)q * 256;
        const bf16* kvb = kvn + (size_t)b * 4096 * 128;
        if (4 * lane < nsel) *(u32x2*)(selw + 4 * lane) = *(const u32x2*)(selp + 4 * lane);
        float m_run = -INFINITY, l_run = 0.f;
        f32x4 o[8];
#pragma unroll
        for (int i = 0; i < 8; ++i) o[i] = (f32x4){0, 0, 0, 0};
        bf16x8 gk[8];
#pragma unroll
        for (int i = 0; i < 8; ++i) { const int key = selw[4 * i + fq]; gk[i] = ld16(kvb + (size_t)key * 128 + 8 * fr); }
        const int nt = nsel / 32;
        for (int ti = 0; ti < nt; ++ti) {
            const bf16x8 kp = ld16(selw + 32 * ti + 8 * fq);
#pragma unroll
            for (int i = 0; i < 8; ++i) *(bf16x8*)(tile + wr_addr[i]) = gk[i];
            if (ti + 1 < nt) {
#pragma unroll
                for (int i = 0; i < 8; ++i) { const int key = selw[32 * (ti + 1) + 4 * i + fq]; gk[i] = ld16(kvb + (size_t)key * 128 + 8 * fr); }
            }
            f32x4 lg[2] = {(f32x4){0, 0, 0, 0}, (f32x4){0, 0, 0, 0}};
#pragma unroll
            for (int rb = 0; rb < 2; ++rb)
#pragma unroll
                for (int s = 0; s < 4; ++s) lg[rb] = MFMA16(ld16(tile + rd_addr[rb][s]), qf[s], lg[rb]);
            float val[8]; float tmax = -INFINITY;
#pragma unroll
            for (int j = 0; j < 8; ++j) { const float dist = fabsf((float)(t - (int)(unsigned short)kp[j])); val[j] = lg[j >> 2][j & 3] - slope * dist; tmax = fmaxf(tmax, val[j]); }
            tmax = fmaxf(tmax, __shfl_xor(tmax, 16)); tmax = fmaxf(tmax, __shfl_xor(tmax, 32));
            const float m_new = fmaxf(m_run, tmax);
            const float scale = __expf(m_run - m_new);
            l_run *= scale;
#pragma unroll
            for (int i = 0; i < 8; ++i) o[i] *= scale;
            float pv[8];
#pragma unroll
            for (int j = 0; j < 8; ++j) { pv[j] = __expf(val[j] - m_new); l_run += pv[j]; }
            m_run = m_new;
            u32x4 pk; pk.x = cvt_pk_bf16(pv[0], pv[1]); pk.y = cvt_pk_bf16(pv[2], pv[3]); pk.z = cvt_pk_bf16(pv[4], pv[5]); pk.w = cvt_pk_bf16(pv[6], pv[7]);
            const bf16x8 pf = __builtin_bit_cast(bf16x8, pk);
            s16x4 tr[8][2];
            TR8(tr[0][0], tr[0][1], tr[1][0], tr[1][1], tr[2][0], tr[2][1], tr[3][0], tr[3][1], tr_addr[0][0], tr_addr[0][1], tr_addr[1][0], tr_addr[1][1], tr_addr[2][0], tr_addr[2][1], tr_addr[3][0], tr_addr[3][1]);
            TR8(tr[4][0], tr[4][1], tr[5][0], tr[5][1], tr[6][0], tr[6][1], tr[7][0], tr[7][1], tr_addr[4][0], tr_addr[4][1], tr_addr[5][0], tr_addr[5][1], tr_addr[6][0], tr_addr[6][1], tr_addr[7][0], tr_addr[7][1]);
#pragma unroll
            for (int cc = 0; cc < 8; ++cc) {
                bf16x8 kf; kf[0] = tr[cc][0][0]; kf[1] = tr[cc][0][1]; kf[2] = tr[cc][0][2]; kf[3] = tr[cc][0][3]; kf[4] = tr[cc][1][0]; kf[5] = tr[cc][1][1]; kf[6] = tr[cc][1][2]; kf[7] = tr[cc][1][3];
                o[cc] = MFMA16(kf, pf, o[cc]);
            }
        }
        float lt = l_run; lt += __shfl_xor(lt, 16); lt += __shfl_xor(lt, 32);
        const float inv = 1.f / lt;
        if (fr < 8) {
#pragma unroll
            for (int cc = 0; cc < 8; ++cc) { u32x2 ov; ov.x = cvt_pk_bf16(o[cc][0] * inv, o[cc][1] * inv); ov.y = cvt_pk_bf16(o[cc][2] * inv, o[cc][3] * inv);
                *(u32x2*)(mix + (size_t)q * KMIX + 512 + fr * 128 + 16 * cc + 4 * fq) = ov; }
        }
    }
}
typedef float f2 __attribute__((ext_vector_type(2)));
#ifndef PEER_FP8_MASK
#define PEER_FP8_MASK 3
#endif
constexpr float U_SCALE = 64.f, V_SCALE = 8.f;
DI unsigned pack4_fp8(float a, float b, float c, float d) { int p = __builtin_amdgcn_cvt_pk_fp8_f32(a, b, 0, false); p = __builtin_amdgcn_cvt_pk_fp8_f32(c, d, p, true); return (unsigned)p; }
DI void conv_chunk_fp8(const float* __restrict__ src, unsigned char* __restrict__ dst, size_t i0, int n16, float sc) {
    for (int i = opq_tid(); i < n16; i += 256) {
        const float4* s4 = (const float4*)src + 4 * (i0 + i);
        const float4 a = s4[0], b = s4[1], c = s4[2], d = s4[3];
        u32x4 o; o.x = pack4_fp8(a.x * sc, a.y * sc, a.z * sc, a.w * sc); o.y = pack4_fp8(b.x * sc, b.y * sc, b.z * sc, b.w * sc);
        o.z = pack4_fp8(c.x * sc, c.y * sc, c.z * sc, c.w * sc); o.w = pack4_fp8(d.x * sc, d.y * sc, d.z * sc, d.w * sc);
        ((u32x4*)dst)[i0 + i] = o;
    }
}
#ifndef PEER_FP6_MASK
#define PEER_FP6_MASK 3
#endif
#ifndef FP6_INTERLEAVED
#define FP6_INTERLEAVED 1
#endif
typedef unsigned u32x6 __attribute__((ext_vector_type(6)));
typedef float f32x16 __attribute__((ext_vector_type(16)));
typedef float f32x32 __attribute__((ext_vector_type(32)));
struct __attribute__((packed, aligned(4))) U3 { unsigned x, y, z; };
constexpr float U_SCALE6 = 32.f, V_SCALE6 = 4.f;
DI void conv_chunk_fp6(const float* __restrict__ src, unsigned char* __restrict__ dst, size_t g0, int n32, float sc) {
    for (int i = opq_tid(); i < n32; i += 256) {
        const float4* s4 = (const float4*)src + 8 * (g0 + i);
        float v[32];
#pragma unroll
        for (int q = 0; q < 8; ++q) { const float4 t = s4[q]; v[4 * q] = t.x * sc; v[4 * q + 1] = t.y * sc; v[4 * q + 2] = t.z * sc; v[4 * q + 3] = t.w * sc; }
        f32x16 a, b;
#pragma unroll
        for (int k = 0; k < 16; ++k) { a[k] = FP6_INTERLEAVED ? v[2 * k] : v[k]; b[k] = FP6_INTERLEAVED ? v[2 * k + 1] : v[16 + k]; }
        const u32x6 o = __builtin_amdgcn_cvt_scalef32_2xpk16_fp6_f32(a, b, 1.0f);
        unsigned* d = (unsigned*)(dst + (g0 + i) * 24);
        u32x2 o0, o1, o2; o0.x = o[0]; o0.y = o[1]; o1.x = o[2]; o1.y = o[3]; o2.x = o[4]; o2.y = o[5];
        *(u32x2*)d = o0; *(u32x2*)(d + 2) = o1; *(u32x2*)(d + 4) = o2;
    }
}
struct PeerLds2 {
    float trans[4][1024];
    unsigned char li[4][2][64][16];
    unsigned short pe[4][8][128];
    float pg[4][8][128];
};
template <int OFF, int NK>
DI void sort16_desc(unsigned (&k)[NK]) {
#pragma unroll
    for (int size = 2; size <= 16; size <<= 1)
#pragma unroll
        for (int stride = size >> 1; stride > 0; stride >>= 1)
#pragma unroll
            for (int i = 0; i < 16; ++i) {
                const int j = i ^ stride;
                if (j > i) {
                    const bool desc = ((i & size) == 0);
                    const unsigned a = k[OFF + i], b = k[OFF + j];
                    const unsigned hi = a > b ? a : b, lo = a > b ? b : a;
                    k[OFF + i] = desc ? hi : lo; k[OFF + j] = desc ? lo : hi;
                }
            }
}
template <int OA, int OB, int NK>
DI void merge_top16(unsigned (&k)[NK]) {
#pragma unroll
    for (int i = 0; i < 16; ++i) { const unsigned a = k[OA + i], b = k[OB + 15 - i]; k[OA + i] = a > b ? a : b; }
#pragma unroll
    for (int stride = 8; stride > 0; stride >>= 1)
#pragma unroll
        for (int i = 0; i < 16; ++i) {
            const int j = i ^ stride;
            if (j > i) { const unsigned a = k[OA + i], b = k[OA + j]; k[OA + i] = a > b ? a : b; k[OA + j] = a > b ? b : a; }
        }
}
DI void peer_retrieve(const Params& p, int l, int tok0, PeerLds2& S, int lane, int wave) {
    const int fr = lane & 15, fq = lane >> 4;
    const bf16* QP = (const bf16*)(wsb(p) + WS_PROJ);
    const bf16* PK = (const bf16*)(wsb(p) + WS_PK) + (size_t)l * 2 * 128 * 64;
    float* trans = S.trans[wave];
    unsigned K1[16], K2[16];
#pragma unroll
    for (int L = 0; L < 2; ++L) {
        f32x4 acc[4][8];
#pragma unroll
        for (int ct = 0; ct < 4; ++ct)
#pragma unroll
            for (int kt = 0; kt < 8; ++kt) acc[ct][kt] = (f32x4){0, 0, 0, 0};
#pragma unroll
        for (int kt = 0; kt < 8; ++kt) {
            const bf16* krow = PK + (size_t)L * 8192 + (size_t)(16 * kt + fr) * 64 + 8 * fq;
            const bf16x8 a0 = ld16(krow), a1 = ld16(krow + 32);
#pragma unroll
            for (int ct = 0; ct < 4; ++ct) {
                const bf16* qrow = QP + (size_t)(tok0 + 2 * ct + (fr >> 3)) * 1024 + 128 * (fr & 7) + 64 * L + 8 * fq;
                acc[ct][kt] = MFMA16(a0, ld16(qrow), acc[ct][kt]); acc[ct][kt] = MFMA16(a1, ld16(qrow + 32), acc[ct][kt]);
            }
        }
        unsigned k[128];
#define PEER_ROUND(kt)                                                                                                                            \
        {                                                                                                                                         \
            _Pragma("unroll") for (int ct = 0; ct < 4; ++ct) *(f32x4*)(trans + ((ct * 4 + fq) * 16 + fr) * 4) = acc[ct][kt];                       \
            _Pragma("unroll") for (int sq = 0; sq < 4; ++sq) {                                                                                     \
                const f32x4 v = *(const f32x4*)(trans + ((fq * 4 + sq) * 16 + fr) * 4);                                                            \
                _Pragma("unroll") for (int i = 0; i < 4; ++i) k[16 * (kt) + sq * 4 + i] = (fkey(v[i]) & ~0x7fu) | (unsigned)(16 * (kt) + 4 * sq + i); \
            }                                                                                                                                     \
            sort16_desc<16 * (kt)>(k);                                                                                                            \
        }
        PEER_ROUND(0) PEER_ROUND(1) merge_top16<0, 16>(k);
        PEER_ROUND(2) PEER_ROUND(3) merge_top16<32, 48>(k); merge_top16<0, 32>(k);
        PEER_ROUND(4) PEER_ROUND(5) merge_top16<64, 80>(k);
        PEER_ROUND(6) PEER_ROUND(7) merge_top16<96, 112>(k); merge_top16<64, 96>(k);
        merge_top16<0, 64>(k);
#undef PEER_ROUND
        u32x4 ib;
        ib.x = (k[0] & 127u) | ((k[1] & 127u) << 8) | ((k[2] & 127u) << 16) | ((k[3] & 127u) << 24);
        ib.y = (k[4] & 127u) | ((k[5] & 127u) << 8) | ((k[6] & 127u) << 16) | ((k[7] & 127u) << 24);
        ib.z = (k[8] & 127u) | ((k[9] & 127u) << 8) | ((k[10] & 127u) << 16) | ((k[11] & 127u) << 24);
        ib.w = (k[12] & 127u) | ((k[13] & 127u) << 8) | ((k[14] & 127u) << 16) | ((k[15] & 127u) << 24);
        *(u32x4*)(S.li[wave][L][lane]) = ib;
#pragma unroll
        for (int i = 0; i < 16; ++i) { if (L == 0) K1[i] = k[i]; else K2[i] = k[i]; }
    }
    float v1[16], v2[16];
#pragma unroll
    for (int i = 0; i < 16; ++i) { v1[i] = __uint_as_float(unkey(K1[i] & ~0x7fu)); v2[i] = __uint_as_float(unkey(K2[i] & ~0x7fu)); }
    unsigned c[64];
    {
        int idx = 0;
#pragma unroll
        for (int a = 0; a < 16; ++a)
#pragma unroll
            for (int b = 0; b < 16; ++b)
                if ((a + 1) * (b + 1) <= 16) { c[idx] = (fkey(v1[a] + v2[b]) & ~0xffu) | (unsigned)(a * 16 + b); ++idx; }
#pragma unroll
        for (int i = 50; i < 64; ++i) c[i] = 0u;
    }
    sort16_desc<0>(c); sort16_desc<16>(c); sort16_desc<32>(c); sort16_desc<48>(c);
    merge_top16<0, 16>(c); merge_top16<32, 48>(c); merge_top16<0, 32>(c);
    float sc[16]; float sum = 0.f;
    {
        const float m = __uint_as_float(unkey(c[0] & ~0xffu));
#pragma unroll
        for (int i = 0; i < 16; ++i) { sc[i] = __expf(__uint_as_float(unkey(c[i] & ~0xffu)) - m); sum += sc[i]; }
    }
    const float inv = 1.f / sum;
    const int tt = 2 * fq + (fr >> 3), head = fr & 7;
    const unsigned char* l1 = S.li[wave][0][lane]; const unsigned char* l2 = S.li[wave][1][lane];
#pragma unroll
    for (int i = 0; i < 16; ++i) {
        const unsigned ab = c[i] & 0xffu;
        const unsigned e = (unsigned)l1[ab >> 4] * 128u + (unsigned)l2[ab & 15u];
        S.pe[wave][tt][head * 16 + i] = (unsigned short)e; S.pg[wave][tt][head * 16 + i] = sc[i] * inv;
    }
}
template <int FMT>
DI void peer_experts(const Params& p, int l, int tok, int tt, PeerLds2& S, int lane, int wave) {
    const bf16* H = (const bf16*)(wsb(p) + WS_H);
    const unsigned char* UB = wsb(p) + WS_UB; const unsigned char* VB = wsb(p) + WS_VB;
    const float* X = (const float*)(wsb(p) + WS_X);
    const float* modl = (const float*)(wsb(p) + WS_MOD) + (size_t)l * 4 * 6144;
    const int b = tok >> 12;
    const unsigned short* pe = S.pe[wave][tt]; const float* pg = S.pg[wave][tt];
    f2 hp[8];
    u32x4 h0, h1;
    {
        h0 = *(const u32x4*)(H + (size_t)tok * 1024 + 16 * lane); h1 = *(const u32x4*)(H + (size_t)tok * 1024 + 16 * lane + 8);
        hp[0] = (f2){bflo(h0.x), bfhi(h0.x)}; hp[1] = (f2){bflo(h0.y), bfhi(h0.y)}; hp[2] = (f2){bflo(h0.z), bfhi(h0.z)}; hp[3] = (f2){bflo(h0.w), bfhi(h0.w)};
        hp[4] = (f2){bflo(h1.x), bfhi(h1.x)}; hp[5] = (f2){bflo(h1.y), bfhi(h1.y)}; hp[6] = (f2){bflo(h1.z), bfhi(h1.z)}; hp[7] = (f2){bflo(h1.w), bfhi(h1.w)};
    }
    f2 acc[8];
#pragma unroll
    for (int i = 0; i < 8; ++i) acc[i] = (f2){0.f, 0.f};
    const bool b5 = (lane & 32) != 0, b4_ = (lane & 16) != 0, b3 = (lane & 8) != 0;
    const int eidx = (b3 ? 4 : 0) + (b4_ ? 2 : 0) + (b5 ? 1 : 0);
    if constexpr (FMT == 1) {
    for (int e0 = 0; e0 < 128; e0 += 8) {
        u32x4 ur[8], vr[8];
#pragma unroll
        for (int j = 0; j < 8; ++j) {
            const int e = __builtin_amdgcn_readfirstlane((int)pe[e0 + j]);
            ur[j] = *(const u32x4*)(UB + (size_t)e * 1024 + 16 * lane);
            vr[j] = *(const u32x4*)(VB + (size_t)e * 1024 + 16 * lane);
        }
        float d[8];
#pragma unroll
        for (int j = 0; j < 8; ++j) {
            f2 s2 = {0.f, 0.f};
#pragma unroll
            for (int k = 0; k < 4; ++k) {
                const f2 lo = __builtin_amdgcn_cvt_pk_f32_fp8((int)ur[j][k], false), hi = __builtin_amdgcn_cvt_pk_f32_fp8((int)ur[j][k], true);
                s2 = lo * hp[2 * k] + s2; s2 = hi * hp[2 * k + 1] + s2;
            }
            d[j] = s2.x + s2.y;
        }
        float w[4], x2[2], y;
#pragma unroll
        for (int i = 0; i < 4; ++i) { const float keep = b5 ? d[2 * i + 1] : d[2 * i], send = b5 ? d[2 * i] : d[2 * i + 1]; w[i] = keep + __shfl_xor(send, 32); }
#pragma unroll
        for (int i = 0; i < 2; ++i) { const float keep = b4_ ? w[2 * i + 1] : w[2 * i], send = b4_ ? w[2 * i] : w[2 * i + 1]; x2[i] = keep + __shfl_xor(send, 16); }
        { const float keep = b3 ? x2[1] : x2[0], send = b3 ? x2[0] : x2[1]; y = keep + __shfl_xor(send, 8); }
        y += __shfl_xor(y, 4); y += __shfl_xor(y, 2); y += __shfl_xor(y, 1);
        const float sc = gelu_tanh(y * (1.f / U_SCALE)) * pg[e0 + eidx] * (1.f / V_SCALE);
#pragma unroll
        for (int j = 0; j < 8; ++j) {
            const float sj = __uint_as_float((unsigned)__builtin_amdgcn_readlane((int)__float_as_uint(sc), 32 * (j & 1) + 16 * ((j >> 1) & 1) + 8 * ((j >> 2) & 1)));
            const f2 sj2 = {sj, sj};
#pragma unroll
            for (int k = 0; k < 4; ++k) {
                const f2 lo = __builtin_amdgcn_cvt_pk_f32_fp8((int)vr[j][k], false), hi = __builtin_amdgcn_cvt_pk_f32_fp8((int)vr[j][k], true);
                acc[2 * k] = lo * sj2 + acc[2 * k]; acc[2 * k + 1] = hi * sj2 + acc[2 * k + 1];
            }
        }
    }
    } else if constexpr (FMT == 2) {
    for (int e0 = 0; e0 < 128; e0 += 8) {
        U3 ur[8], vr[8];
#pragma unroll
        for (int j = 0; j < 8; ++j) {
            const int e = __builtin_amdgcn_readfirstlane((int)pe[e0 + j]);
            ur[j] = *(const U3*)(UB + (size_t)e * 768 + 12 * lane);
            vr[j] = *(const U3*)(VB + (size_t)e * 768 + 12 * lane);
        }
        float d[8];
#pragma unroll
        for (int jp = 0; jp < 4; ++jp) {
            u32x6 pk; pk[0] = ur[2 * jp].x; pk[1] = ur[2 * jp].y; pk[2] = ur[2 * jp].z; pk[3] = ur[2 * jp + 1].x; pk[4] = ur[2 * jp + 1].y; pk[5] = ur[2 * jp + 1].z;
            const f32x32 o = __builtin_amdgcn_cvt_scalef32_pk32_f32_fp6(pk, 1.0f);
            f2 s0 = {0.f, 0.f}, s1 = {0.f, 0.f};
#pragma unroll
            for (int k = 0; k < 8; ++k) { const f2 ua = {o[2 * k], o[2 * k + 1]}, ub = {o[16 + 2 * k], o[17 + 2 * k]}; s0 = ua * hp[k] + s0; s1 = ub * hp[k] + s1; }
            d[2 * jp] = s0.x + s0.y; d[2 * jp + 1] = s1.x + s1.y;
        }
        float w[4], x2[2], y;
#pragma unroll
        for (int i = 0; i < 4; ++i) { const float keep = b5 ? d[2 * i + 1] : d[2 * i], send = b5 ? d[2 * i] : d[2 * i + 1]; w[i] = keep + __shfl_xor(send, 32); }
#pragma unroll
        for (int i = 0; i < 2; ++i) { const float keep = b4_ ? w[2 * i + 1] : w[2 * i], send = b4_ ? w[2 * i] : w[2 * i + 1]; x2[i] = keep + __shfl_xor(send, 16); }
        { const float keep = b3 ? x2[1] : x2[0], send = b3 ? x2[0] : x2[1]; y = keep + __shfl_xor(send, 8); }
        y += __shfl_xor(y, 4); y += __shfl_xor(y, 2); y += __shfl_xor(y, 1);
        const float sc = gelu_tanh(y * (1.f / U_SCALE6)) * pg[e0 + eidx] * (1.f / V_SCALE6);
#pragma unroll
        for (int jp = 0; jp < 4; ++jp) {
            u32x6 pk; pk[0] = vr[2 * jp].x; pk[1] = vr[2 * jp].y; pk[2] = vr[2 * jp].z; pk[3] = vr[2 * jp + 1].x; pk[4] = vr[2 * jp + 1].y; pk[5] = vr[2 * jp + 1].z;
            const f32x32 o = __builtin_amdgcn_cvt_scalef32_pk32_f32_fp6(pk, 1.0f);
            const int ja = 2 * jp, jb = 2 * jp + 1;
            const float sa = __uint_as_float((unsigned)__builtin_amdgcn_readlane((int)__float_as_uint(sc), 32 * (ja & 1) + 16 * ((ja >> 1) & 1) + 8 * ((ja >> 2) & 1)));
            const float sb = __uint_as_float((unsigned)__builtin_amdgcn_readlane((int)__float_as_uint(sc), 32 * (jb & 1) + 16 * ((jb >> 1) & 1) + 8 * ((jb >> 2) & 1)));
            const f2 sa2 = {sa, sa}, sb2 = {sb, sb};
#pragma unroll
            for (int i = 0; i < 8; ++i) { const f2 va = {o[2 * i], o[2 * i + 1]}, vb = {o[16 + 2 * i], o[17 + 2 * i]}; acc[i] = va * sa2 + acc[i]; acc[i] = vb * sb2 + acc[i]; }
        }
    }
    } else {
    for (int e0 = 0; e0 < 128; e0 += 4) {
        const bf16* UBb = (const bf16*)UB; const bf16* VBb = (const bf16*)VB;
        u32x4 ur[4][2], vr[4][2];
#pragma unroll
        for (int j = 0; j < 4; ++j) {
            const int e = __builtin_amdgcn_readfirstlane((int)pe[e0 + j]);
            ur[j][0] = *(const u32x4*)(UBb + (size_t)e * 1024 + 16 * lane); ur[j][1] = *(const u32x4*)(UBb + (size_t)e * 1024 + 16 * lane + 8);
            vr[j][0] = *(const u32x4*)(VBb + (size_t)e * 1024 + 16 * lane); vr[j][1] = *(const u32x4*)(VBb + (size_t)e * 1024 + 16 * lane + 8);
        }
        float d[4];
#pragma unroll
        for (int j = 0; j < 4; ++j) {
            float sa = 0.f, sb = 0.f;
            sa = dot2bf(ur[j][0].x, h0.x, sa); sb = dot2bf(ur[j][0].y, h0.y, sb); sa = dot2bf(ur[j][0].z, h0.z, sa); sb = dot2bf(ur[j][0].w, h0.w, sb);
            sa = dot2bf(ur[j][1].x, h1.x, sa); sb = dot2bf(ur[j][1].y, h1.y, sb); sa = dot2bf(ur[j][1].z, h1.z, sa); sb = dot2bf(ur[j][1].w, h1.w, sb);
            d[j] = sa + sb;
        }
        float w[2], y;
#pragma unroll
        for (int i = 0; i < 2; ++i) { const float keep = b5 ? d[2 * i + 1] : d[2 * i], send = b5 ? d[2 * i] : d[2 * i + 1]; w[i] = keep + __shfl_xor(send, 32); }
        { const float keep = b4_ ? w[1] : w[0], send = b4_ ? w[0] : w[1]; y = keep + __shfl_xor(send, 16); }
        y += __shfl_xor(y, 8); y += __shfl_xor(y, 4); y += __shfl_xor(y, 2); y += __shfl_xor(y, 1);
        const float sc = gelu_tanh(y) * pg[e0 + (b4_ ? 2 : 0) + (b5 ? 1 : 0)];
#pragma unroll
        for (int j = 0; j < 4; ++j) {
            const float sj = __uint_as_float((unsigned)__builtin_amdgcn_readlane((int)__float_as_uint(sc), 32 * (j & 1) + 16 * ((j >> 1) & 1)));
            const f2 sj2 = {sj, sj};
#pragma unroll
            for (int hh = 0; hh < 2; ++hh)
#pragma unroll
                for (int k = 0; k < 4; ++k) { const unsigned dw = vr[j][hh][k]; const f2 vv = {bflo(dw), bfhi(dw)}; acc[4 * hh + k] = vv * sj2 + acc[4 * hh + k]; }
        }
    }
    }
    float xr[16];
    const float* xrow = X + (size_t)tok * 1024 + 16 * lane;
    float* xorow = p.out + (size_t)tok * 1024 + 16 * lane;
    const float* g2 = modl + (size_t)b * 6144 + 5 * 1024 + 16 * lane;
    float ss = 0;
#pragma unroll
    for (int q4 = 0; q4 < 4; ++q4) {
        const float4 xv = *(const float4*)(xrow + 4 * q4), gv = *(const float4*)(g2 + 4 * q4);
        float4 o; o.x = xv.x + gv.x * acc[2 * q4].x; o.y = xv.y + gv.y * acc[2 * q4].y; o.z = xv.z + gv.z * acc[2 * q4 + 1].x; o.w = xv.w + gv.w * acc[2 * q4 + 1].y;
        if (l == 0) *(float4*)(xorow + 4 * q4) = o;
        xr[4 * q4] = o.x; xr[4 * q4 + 1] = o.y; xr[4 * q4 + 2] = o.z; xr[4 * q4 + 3] = o.w;
        ss += o.x * o.x + o.y * o.y + o.z * o.z + o.w * o.w;
    }
    ss = wave_sum(ss);
    const float r = rsqrtf(ss * (1.f / 1024.f) + 1e-6f);
    if (l == 1) {
#pragma unroll
        for (int q4 = 0; q4 < 4; ++q4) {
            const float4 gv = *(const float4*)(p.in[28] + 16 * lane + 4 * q4);
            float4 o; o.x = xr[4 * q4] * r * gv.x; o.y = xr[4 * q4 + 1] * r * gv.y; o.z = xr[4 * q4 + 2] * r * gv.z; o.w = xr[4 * q4 + 3] * r * gv.w;
            *(float4*)(xorow + 4 * q4) = o;
        }
    } else {
        const float* g = p.in[2] + 1024 + 16 * lane; const float* mod1 = (const float*)(wsb(p) + WS_MOD) + ((size_t)4 + b) * 6144 + 16 * lane;
        bf16* hrow = (bf16*)(wsb(p) + WS_H2) + (size_t)tok * 1024 + 16 * lane;
        float hv[16];
#pragma unroll
        for (int q4 = 0; q4 < 4; ++q4) {
            const float4 gg = *(const float4*)(g + 4 * q4), s1 = *(const float4*)(mod1 + 1024 + 4 * q4), s0 = *(const float4*)(mod1 + 4 * q4);
            hv[4 * q4] = xr[4 * q4] * r * gg.x * (1.f + s1.x) + s0.x; hv[4 * q4 + 1] = xr[4 * q4 + 1] * r * gg.y * (1.f + s1.y) + s0.y;
            hv[4 * q4 + 2] = xr[4 * q4 + 2] * r * gg.z * (1.f + s1.z) + s0.z; hv[4 * q4 + 3] = xr[4 * q4 + 3] * r * gg.w * (1.f + s1.w) + s0.w;
        }
        u32x4 o0, o1;
        o0.x = cvt_pk_bf16(hv[0], hv[1]); o0.y = cvt_pk_bf16(hv[2], hv[3]); o0.z = cvt_pk_bf16(hv[4], hv[5]); o0.w = cvt_pk_bf16(hv[6], hv[7]);
        o1.x = cvt_pk_bf16(hv[8], hv[9]); o1.y = cvt_pk_bf16(hv[10], hv[11]); o1.z = cvt_pk_bf16(hv[12], hv[13]); o1.w = cvt_pk_bf16(hv[14], hv[15]);
        *(u32x4*)(hrow) = o0; *(u32x4*)(hrow + 8) = o1;
    }
}

constexpr int SMEM_BYTES = LDS_BYTES;
#ifndef REP_MASK
#define REP_MASK 0xffff
#endif
#ifndef REP_ID
#define REP_ID -1
#endif
#ifndef REP_N
#define REP_N 1
#endif
#define NREP(id) ((id) == REP_ID ? REP_N : 1)
__global__ void __launch_bounds__(512, 2) fwd_megakernel(Params p) {
    unsigned char* smem = g_lds;
    const int tid = threadIdx.x, half = __builtin_amdgcn_readfirstlane(tid >> 8);
    const int Gp = gridDim.x, bidp = blockIdx.x;
    const int G = Gp * 2, bid = bidp + half * Gp;
    unsigned char* sm = smem + half * 65536;
    volatile int* qslot = (volatile int*)(smem + LDS_CTL + 16) + half;
    if (tid < 64) ((unsigned*)(smem + LDS_CTL))[tid] = 0u;
    __syncthreads();
    unsigned* ctl = (unsigned*)(wsb(p) + WS_CTL);
    unsigned* qctr = ctl + 4096;
    XcdBarrier bar = xcd_barrier_post(ctl, (volatile LAS unsigned*)(smem + LDS_CTL));
#define PHASE_PTRS unsigned char* ws = wsb(p); const bf16* H = (const bf16*)(ws + WS_H); bf16* PROJ = (bf16*)(ws + WS_PROJ); float* X = (float*)(ws + WS_X); const float* mod = (const float*)(ws + WS_MOD); (void)H; (void)PROJ; (void)X; (void)mod;
    int qn = 0;

    for (int rep = 0; rep < NREP(0); ++rep) {
            PHASE_PTRS
        constexpr int N_MOD = 192, N_LAYER = 192 + 256 + 128 + 128 + 256 + 256 + 16, N_PK = 4, N_GW = 128, N_PW = 8;
        constexpr int NV = N_MOD + 2 * N_LAYER + N_PK + N_GW + N_PW;
        for (int vb = bid; vb < NV; vb += G) {
            int v = vb;
            if (v < N_MOD) { it_mod(p, v, sm); continue; }
            v -= N_MOD;
            if (v < 2 * N_LAYER) {
                const int l = v / N_LAYER; v -= l * N_LAYER;
                bf16* wtin = (bf16*)(ws + WS_WTIN) + (size_t)l * NPROJ * 1024;
                const float* win = p.in[6] + (size_t)l * 1024 * 1732;
                bf16* wtout = (bf16*)(ws + WS_WTOUT) + (size_t)l * 1024 * KMIX;
                const float* wout = p.in[22] + (size_t)l * 1024 * 1024;
                if (v < 192) { it_transpose(TrArgs{win, 1732, 0, 1732, wtin, 1024, 0, 1024, 768, 0, nullptr}, v, sm); }
                else if ((v -= 192) < 256) { it_transpose(TrArgs{win, 1732, 0, 1732, wtin + (size_t)C_QA * 1024, 1024, 0, 1024, 1024, 1, p.in[20] + (size_t)l * 8 * 64 * 128}, v, sm); }
                else if ((v -= 256) < 128) { it_transpose(TrArgs{win, 1732, 1280, 1732, wtin + (size_t)C_CKV * 1024, 1024, 0, 1024, 512, 0, nullptr}, v, sm); }
                else if ((v -= 128) < 128) { it_transpose(TrArgs{wout, 1024, 0, 1024, wtout, KMIX, 0, 512, 1024, 0, nullptr}, v, sm); }
                else if ((v -= 128) < 256) { it_transpose(TrArgs{wout, 1024, 0, 1024, wtout, KMIX, 512, 1024, 1024, 2, p.in[21] + (size_t)l * 8 * 128 * 64}, v, sm); }
                else if ((v -= 256) < 256) { it_transpose(TrArgs{p.in[23] + (size_t)l * 1024 * 1024, 1024, 0, 1024, (bf16*)(ws + WS_WTQ) + (size_t)l * 1024 * 1024, 1024, 0, 1024, 1024, 0, nullptr}, v, sm); }
                else { v -= 256; it_transpose(TrArgs{p.in[15] + (size_t)l * 256 * 256, 256, 0, 256, (bf16*)(ws + WS_WTGLU) + (size_t)l * 256 * 256, 256, 0, 256, 256, 0, nullptr}, v, sm); }
                continue;
            }
            v -= 2 * N_LAYER;
            if (v < N_PK) { const int l = v >> 1, w = v & 1; conv_chunk(p.in[24 + w] + (size_t)l * 8192, (bf16*)(ws + WS_PK) + (size_t)l * 16384 + w * 8192, 0, 1024); continue; }
            v -= N_PK;
            if (v < N_GW) { it_gw(p, v); continue; }
            v -= N_GW;
            it_ssm_pw(p, v);
        }
        xcd_barrier(bar);
    }
    for (int rep = 0; rep < NREP(1); ++rep) {
            PHASE_PTRS
        constexpr int N_NORM = NTOK / 4, N_TAB = 4096, N_KT = 256;
        for (int vb = bid; vb < N_NORM + N_TAB + N_KT; vb += G) {
            if (vb < N_KT) { it_ssm_kt(p, vb, sm); continue; }
            if (vb - N_KT < N_NORM) {
                const int t_ = opq_tid(); const int row = (vb - N_KT) * 4 + (t_ >> 6);
                const float* m0 = (const float*)(wsb(p) + WS_MOD) + (size_t)(row >> 12) * 6144;
                norm_mod_row(p.in[0] + (size_t)row * 1024, p.in[2], m0, m0 + 1024, (bf16*)(wsb(p) + WS_H) + (size_t)row * 1024, t_ & 63);
            } else {
                const size_t base = (size_t)(vb - N_KT - N_NORM) * 2048;
                const int t_ = opq_tid();
#pragma unroll
                for (int e = 0; e < 8; ++e) ssm_tab_entry(p, base + e * 256 + t_);
            }
        }
        xcd_barrier(bar);
    }

    for (int l = 0; l < 2; ++l) {
        const float* xin = l == 0 ? p.in[0] : p.out;
        for (int rep = 0; rep < NREP(2 + 8 * l); ++rep) {
            PHASE_PTRS
            const bf16* Hin = l == 0 ? H : (const bf16*)(ws + WS_H2);
            pg8::StaticOrder S; S.init(NTOK, 2048, Gp, bidp);
            pg8::gemm_phase<Epi256<EpiBf16>, pg8::StaticOrder, true, true>((PG8_LAS unsigned char*)g_lds, pg8::Gemm{Hin, (const bf16*)(ws + WS_WTIN) + (size_t)l * NPROJ * 1024, NTOK, 2048, 1024}, S, Epi256<EpiBf16>{EpiBf16{PROJ, NPROJ}});
            xcd_barrier(bar);
        }
        for (int rep = 0; rep < NREP(3 + 8 * l); ++rep) {
            PHASE_PTRS
            {
                const bf16* Hin = l == 0 ? H : (const bf16*)(ws + WS_H2);
                pg8::StaticOrder S; S.init(NTOK, 256, Gp, bidp);
                pg8::gemm_phase<Epi256<EpiBf16>, pg8::StaticOrder, false, true>((PG8_LAS unsigned char*)g_lds, pg8::Gemm{Hin, (const bf16*)(ws + WS_WTIN) + ((size_t)l * NPROJ + 2048) * 1024, NTOK, 256, 1024}, S, Epi256<EpiBf16>{EpiBf16{PROJ + 2048, NPROJ}});
            }
            unsigned* ctr = qctr + 64 * (qn++);
            for (;;) {
                const int it = q_next(ctr, qslot);
                if (it >= 2048) break;
                const bool extra = rep + 1 < NREP(3 + 8 * l);
                const int ty = it < 1024 ? 0 : it < 1536 ? 1 : it < 1792 ? 2 : 3;
                if (extra && !((REP_MASK >> ty) & 1)) continue;
                if (it < 1024) it_dsa_index_select(p, it, sm, extra ? ((REP_MASK >> 4) & 31) : 3);
                else if (it < 1536) it_gmlp(p, l, it - 1024, sm);
                else if (it < 1792) it_ssm_a(p, l, it - 1536);
                else it_kvn(p, l, it - 1792);
            }
            xcd_barrier(bar);
        }
        for (int rep = 0; rep < NREP(4 + 8 * l); ++rep) {
            PHASE_PTRS
            unsigned* ctr = qctr + 64 * (qn++);
            for (;;) {
                const int it = q_next(ctr, qslot);
                if (it >= 256 + 1024 + 512) break;
                { const bool extra = rep + 1 < NREP(4 + 8 * l); const int ty = it < 256 ? 0 : it < 1280 ? 1 : 2; if (extra && !((REP_MASK >> (8 + ty)) & 1)) continue; }
                if (it < 256) it_ssm_c(p, l, it, sm, (rep + 1 < NREP(4 + 8 * l)) ? ((REP_MASK >> 12) & 7) : 7);
                else if (it < 1280) it_dsa_attn(p, it - 256, sm);
                else {
                    const int v = it - 1280, w = v >> 8, ch = v & 255;
                    if (PEER_FP6_MASK & (1 << l)) conv_chunk_fp6(p.in[26 + w] + (size_t)l * NEXP * 1024, ws + (w ? WS_VB : WS_UB), (size_t)ch * 2048, 2048, w ? V_SCALE6 : U_SCALE6);
                    else if (!(PEER_FP8_MASK & (1 << l))) conv_chunk(p.in[26 + w] + (size_t)l * NEXP * 1024, (bf16*)(ws + (w ? WS_VB : WS_UB)), (size_t)ch * 8192, 8192);
                    else conv_chunk_fp8(p.in[26 + w] + (size_t)l * NEXP * 1024, ws + (w ? WS_VB : WS_UB), (size_t)ch * 4096, 4096, w ? V_SCALE : U_SCALE);
                }
            }
            xcd_barrier(bar);
        }
        for (int rep = 0; rep < NREP(5 + 8 * l); ++rep) {
            PHASE_PTRS
            const EpiGlu epi{(const bf16*)(ws + WS_YG), p.in[16] + l * 256, (bf16*)(ws + WS_MIX)};
            const bf16* Bt = (const bf16*)(ws + WS_WTGLU) + (size_t)l * 256 * 256;
            for (int t = bid; t < (NTOK / 64) * 2; t += G) gemm_tile64((const bf16*)(ws + WS_YG), 256, Bt, 256, 256, (t >> 1) * 64, (t & 1) * 128, (bf16*)sm, epi);
            xcd_barrier(bar);
        }
        for (int rep = 0; rep < NREP(6 + 8 * l); ++rep) {
            PHASE_PTRS
            pg8::StaticOrder S; S.init(NTOK, 1024, Gp, bidp);
            pg8::gemm_phase<Epi256<EpiResid>, pg8::StaticOrder, false, true>((PG8_LAS unsigned char*)g_lds, pg8::Gemm{(const bf16*)(ws + WS_MIX), (const bf16*)(ws + WS_WTOUT) + (size_t)l * 1024 * KMIX, NTOK, 1024, KMIX}, S, Epi256<EpiResid>{EpiResid{xin, X, mod + (size_t)l * 4 * 6144 + 2048}});
            xcd_barrier(bar);
        }
        for (int rep = 0; rep < NREP(7 + 8 * l); ++rep) {
            PHASE_PTRS
            for (int vb = bid; vb < NTOK / 4; vb += G) {
                const int t_ = opq_tid(); const int row = vb * 4 + (t_ >> 6);
                const float* m0 = (const float*)(wsb(p) + WS_MOD) + ((size_t)l * 4 + (row >> 12)) * 6144 + 3072;
                norm_mod_row((const float*)(wsb(p) + WS_X) + (size_t)row * 1024, p.in[3] + l * 1024, m0, m0 + 1024, (bf16*)(wsb(p) + WS_H) + (size_t)row * 1024, t_ & 63);
            }
            xcd_barrier(bar);
        }
        for (int rep = 0; rep < NREP(8 + 8 * l); ++rep) {
            PHASE_PTRS
            pg8::StaticOrder S; S.init(NTOK, 1024, Gp, bidp);
            pg8::gemm_phase<Epi256<EpiBf16>, pg8::StaticOrder, false, true>((PG8_LAS unsigned char*)g_lds, pg8::Gemm{H, (const bf16*)(ws + WS_WTQ) + (size_t)l * 1024 * 1024, NTOK, 1024, 1024}, S, Epi256<EpiBf16>{EpiBf16{PROJ, 1024}});
            xcd_barrier(bar);
        }
        for (int rep = 0; rep < NREP(9 + 8 * l); ++rep) {
            PHASE_PTRS
            PeerLds2& S = *(PeerLds2*)sm;
            hsync();
            const int t_ = opq_tid(), lane_ = t_ & 63, wave_ = t_ >> 6;
            for (int wb = bid * 4 + wave_; wb < NTOK / 8; wb += G * 4) {
                peer_retrieve(p, l, wb * 8, S, lane_, wave_);
                for (int tt = 0; tt < 8; ++tt) {
                    if (PEER_FP6_MASK & (1 << l)) peer_experts<2>(p, l, wb * 8 + tt, tt, S, lane_, wave_);
                    else if (PEER_FP8_MASK & (1 << l)) peer_experts<1>(p, l, wb * 8 + tt, tt, S, lane_, wave_);
                    else peer_experts<0>(p, l, wb * 8 + tt, tt, S, lane_, wave_);
                }
            }
            if (l == 0 || rep + 1 < NREP(9 + 8 * l)) xcd_barrier(bar);
        }
    }
}

extern "C" void kernel_launch(void* const* d_in, const int* in_sizes, int n_in, void* d_out, int out_size, void* d_ws, size_t ws_size, hipStream_t stream) {
    if (n_in != 29 || ws_size < WS_END) { fprintf(stderr, "kernel_launch: bad args (n_in %d, ws %zu, need %zu)\n", n_in, ws_size, (size_t)WS_END); return; }
    static int grid = 0;
    if (grid == 0) {
        int dev = 0, cus = 0, per_cu = 0;
        if (hipGetDevice(&dev) != hipSuccess || hipDeviceGetAttribute(&cus, hipDeviceAttributeMultiprocessorCount, dev) != hipSuccess) { grid = -1; return; }
        if (hipFuncSetAttribute((const void*)fwd_megakernel, hipFuncAttributeMaxDynamicSharedMemorySize, LDS_BYTES) != hipSuccess) { fprintf(stderr, "kernel_launch: hipFuncSetAttribute failed\n"); grid = -1; return; }
        if (hipOccupancyMaxActiveBlocksPerMultiprocessor(&per_cu, (const void*)fwd_megakernel, 512, LDS_BYTES) != hipSuccess || per_cu < 1) { fprintf(stderr, "kernel_launch: occupancy query failed (%d)\n", per_cu); grid = -1; return; }
        grid = cus;
    }
    if (grid < 0) return;
    if (hipMemsetAsync((char*)d_ws + WS_CTL, 0, 65536, stream) != hipSuccess) { fprintf(stderr, "kernel_launch: memset failed\n"); return; }
    Params p{};
    for (int i = 0; i < 29; ++i) p.in[i] = (const float*)d_in[i];
    p.out = (float*)d_out; p.ws = (unsigned char*)d_ws;
    void* args[] = {&p};
    const hipError_t e = hipLaunchCooperativeKernel((const void*)fwd_megakernel, dim3(grid), dim3(512), args, LDS_BYTES, stream);
    if (e != hipSuccess) fprintf(stderr, "kernel_launch: cooperative launch failed: %s (grid %d)\n", hipGetErrorString(e), grid);
}
```

```cpp
#include <hip/hip_runtime.h>
#include <cstdint>
#include <cstdio>

typedef unsigned short bf16;
typedef short bf16x8 __attribute__((ext_vector_type(8)));
typedef short s16x4 __attribute__((ext_vector_type(4)));
typedef float f32x4 __attribute__((ext_vector_type(4)));
typedef unsigned u32x4 __attribute__((ext_vector_type(4)));
typedef unsigned u32x2 __attribute__((ext_vector_type(2)));
typedef __bf16 bf2 __attribute__((ext_vector_type(2)));
#define DI __device__ __forceinline__
#define MFMA16(a, b, c) __builtin_amdgcn_mfma_f32_16x16x32_bf16((a), (b), (c), 0, 0, 0)

constexpr int DM = 1024, NB = 4, SEQ = 4096, NTOK = NB * SEQ;
constexpr int NPROJ = 2304;
constexpr int C_UA = 0, C_UB = 256, C_VB = 512, C_CKV = 768, C_QI = 896, C_KI = 1152, C_WI = 1216, C_QA = 1280;
constexpr int KMIX = 1536;
constexpr int NEXP = 16384;
constexpr size_t SCORES_PER_BATCH = (size_t)4096 * 2080;

constexpr size_t al256(size_t x) { return (x + 255) & ~(size_t)255; }
constexpr size_t WS_CTL = 0;
constexpr size_t WS_MOD = 65536;
constexpr size_t WS_WTIN = al256(WS_MOD + 2 * 4 * 6144 * 4);
constexpr size_t WS_WTOUT = al256(WS_WTIN + (size_t)2 * NPROJ * 1024 * 2);
constexpr size_t WS_WTQ = al256(WS_WTOUT + (size_t)2 * 1024 * KMIX * 2);
constexpr size_t WS_WTGLU = al256(WS_WTQ + (size_t)2 * 1024 * 1024 * 2);
constexpr size_t WS_GW = al256(WS_WTGLU + (size_t)2 * 256 * 256 * 2);
constexpr size_t WS_PK = al256(WS_GW + (size_t)2 * 4 * 128 * 128 * 2);
constexpr size_t WS_PW = al256(WS_PK + (size_t)2 * 2 * 128 * 64 * 2);
constexpr size_t WS_BB = al256(WS_PW + (size_t)2 * 16 * 65 * 64 * 2 * 4);
constexpr size_t WS_E = al256(WS_BB + (size_t)2 * 16 * 64 * 16 * 2 * 4);
constexpr size_t WS_G = al256(WS_E + (size_t)2 * 16 * 128 * 1024 * 2);
constexpr size_t WS_KT = al256(WS_G + (size_t)2 * 16 * 1024 * 128 * 2);
constexpr size_t WS_UB = al256(WS_KT + (size_t)2 * 16 * 64 * 256 * 2);
constexpr size_t WS_VB = al256(WS_UB + (size_t)NEXP * 1024 * 2);
constexpr size_t WS_H = al256(WS_VB + (size_t)NEXP * 1024 * 2);
constexpr size_t WS_PROJ = al256(WS_H + (size_t)NTOK * 1024 * 2);
constexpr size_t WS_SLOC = al256(WS_PROJ + (size_t)NTOK * NPROJ * 2);
constexpr size_t WS_YG = al256(WS_SLOC + (size_t)256 * 16 * 128 * 4);
constexpr size_t WS_KVN = al256(WS_YG + (size_t)NTOK * 256 * 2);
constexpr size_t WS_SEL = al256(WS_KVN + (size_t)NTOK * 128 * 2);
constexpr size_t WS_MIX = al256(WS_SEL + (size_t)NTOK * 256 * 2);
constexpr size_t WS_X = al256(WS_MIX + (size_t)NTOK * KMIX * 2);
constexpr size_t WS_SCORES = al256(WS_X + (size_t)NTOK * 1024 * 4);
constexpr size_t WS_H2 = al256(WS_SCORES + (size_t)NB * SCORES_PER_BATCH * 4);
constexpr size_t WS_END = al256(WS_H2 + (size_t)NTOK * 1024 * 2);

struct Params {
    const float* in[29];
    float* out;
    unsigned char* ws;
};

typedef __bf16 bf2v_t __attribute__((ext_vector_type(2)));
typedef float f2v_t __attribute__((ext_vector_type(2)));
DI unsigned cvt_pk_bf16(float lo, float hi) { const f2v_t f = {lo, hi}; const bf2v_t r = __builtin_convertvector(f, bf2v_t); return __builtin_bit_cast(unsigned, r); }
DI bf16 f2bf(float x) { return (bf16)(cvt_pk_bf16(x, 0.f) & 0xffffu); }
DI float bf2f(bf16 b) { return __uint_as_float((unsigned)b << 16); }
DI float bflo(unsigned u) { return __uint_as_float(u << 16); }
DI float bfhi(unsigned u) { return __uint_as_float(u & 0xffff0000u); }
DI float dot2bf(unsigned a, unsigned b, float c) { return __builtin_amdgcn_fdot2_f32_bf16(__builtin_bit_cast(bf2, a), __builtin_bit_cast(bf2, b), c, false); }
DI float gelu_tanh(float x) { const float u = 0.7978845608028654f * (x + 0.044715f * x * x * x); const float e = __expf(2.f * u); const float t = 1.f - 2.f / (e + 1.f); return 0.5f * x * (1.f + t); }
DI float sigmoidf(float x) { return 1.f / (1.f + __expf(-x)); }
DI float wave_sum(float v) { for (int o = 32; o > 0; o >>= 1) v += __shfl_xor(v, o); return v; }
DI unsigned wave_sum_u32(unsigned v) {
    int x = (int)v;
    x += __builtin_amdgcn_update_dpp(0, x, 0xB1, 0xf, 0xf, true);
    x += __builtin_amdgcn_update_dpp(0, x, 0x4E, 0xf, 0xf, true);
    x += __builtin_amdgcn_update_dpp(0, x, 0x141, 0xf, 0xf, true);
    x += __builtin_amdgcn_update_dpp(0, x, 0x140, 0xf, 0xf, true);
    x += __builtin_amdgcn_update_dpp(0, x, 0x142, 0xa, 0xf, true);
    x += __builtin_amdgcn_update_dpp(0, x, 0x143, 0xc, 0xf, true);
    return (unsigned)__builtin_amdgcn_readlane(x, 63);
}
DI unsigned wave_scan_incl_u32(unsigned v) {
    int x = (int)v;
    x += __builtin_amdgcn_update_dpp(0, x, 0x111, 0xf, 0xf, true);
    x += __builtin_amdgcn_update_dpp(0, x, 0x112, 0xf, 0xf, true);
    x += __builtin_amdgcn_update_dpp(0, x, 0x114, 0xf, 0xf, true);
    x += __builtin_amdgcn_update_dpp(0, x, 0x118, 0xf, 0xf, true);
    x += __builtin_amdgcn_update_dpp(0, x, 0x142, 0xa, 0xf, true);
    x += __builtin_amdgcn_update_dpp(0, x, 0x143, 0xc, 0xf, true);
    return (unsigned)x;
}
DI unsigned fkey(float v) { const unsigned u = __float_as_uint(v); return (u & 0x80000000u) ? ~u : (u | 0x80000000u); }
DI unsigned unkey(unsigned k) { return (k & 0x80000000u) ? (k & 0x7fffffffu) : ~k; }
DI bf16x8 ld16(const void* p) { return *(const bf16x8*)p; }
DI bf16x8 zero8() { bf16x8 z = {0, 0, 0, 0, 0, 0, 0, 0}; return z; }


#define XB_TMO      128
#define XB_XCNT(j)  (256  + 64 * (j))
#define XB_XSUB(j)  (1280 + 64 * (j))
#define XB_XGEN(j)  (2304 + 64 * (j))
#define XB_TOP      3328
#define XB_TOPGEN   3392
#define XCD_BAR_WORDS 3456
#define XB_SPIN_CAP (1u << 22)
#define LAS __attribute__((address_space(3)))
DI unsigned xb_ld(unsigned* p)              { return __hip_atomic_load(p, __ATOMIC_RELAXED, __HIP_MEMORY_SCOPE_AGENT); }
DI unsigned xb_add(unsigned* p, unsigned v) { return __hip_atomic_fetch_add(p, v, __ATOMIC_RELAXED, __HIP_MEMORY_SCOPE_AGENT); }
DI unsigned xb_xcc_id() { return (unsigned)__builtin_amdgcn_s_getreg((3 << 11) | 20) & 0xFu; }
#define XB_SPIN(cond, bar) do { unsigned _sp = 0; while (cond) { __builtin_amdgcn_s_sleep(1); \
    if ((++_sp & 255u) == 0u) { if (xb_ld(&(bar)[XB_TMO])) break; if (_sp > XB_SPIN_CAP) { atomicAdd(&(bar)[XB_TMO], 1u); break; } } } } while (0)
struct XcdBarrier { unsigned* bar; unsigned x; volatile LAS unsigned* st; };
DI XcdBarrier xcd_barrier_post(unsigned* bar, volatile LAS unsigned* st) {
    XcdBarrier b; b.bar = bar; b.x = xb_xcc_id(); b.st = st;
    if (threadIdx.x == 0) (void)xb_add(&bar[XB_XCNT(b.x)], 1u);
    return b;
}
DI void xcd_barrier_complete(unsigned* bar, unsigned x, unsigned& nloc, unsigned& nx) {
    const unsigned G = gridDim.x * gridDim.y * gridDim.z;
    unsigned sum, cnt, mine, sp = 0u;
    for (;;) {
        sum = 0u; cnt = 0u; mine = 0u;
#pragma unroll
        for (unsigned j = 0; j < 16; ++j) { const unsigned c = xb_ld(&bar[XB_XCNT(j)]); sum += c; cnt += (c > 0u) ? 1u : 0u; mine = (j == x) ? c : mine; }
        if (sum == G) break;
        __builtin_amdgcn_s_sleep(1);
        if ((++sp & 255u) == 0u) { if (xb_ld(&bar[XB_TMO])) break; if (sp > XB_SPIN_CAP) { atomicAdd(&bar[XB_TMO], 1u); break; } }
    }
    nloc = mine > 0u ? mine : 1u; nx = cnt > 0u ? cnt : 1u;
}
DI void xcd_barrier(const XcdBarrier& b) {
    asm volatile("s_waitcnt vmcnt(0)" ::: "memory");
    __syncthreads();
    if (threadIdx.x == 0) {
        unsigned* bar = b.bar;
        __builtin_amdgcn_s_waitcnt(0);
        unsigned nloc = b.st[0], nx = b.st[1];
        if (nloc == 0u) { xcd_barrier_complete(bar, b.x, nloc, nx); b.st[0] = nloc; b.st[1] = nx; }
        const unsigned old = xb_add(&bar[XB_XSUB(b.x)], 1u);
        const unsigned gen = old / nloc;
        if (old + 1u == (gen + 1u) * nloc) {
            __builtin_amdgcn_fence(__ATOMIC_RELEASE, "agent");
            asm volatile("s_waitcnt vmcnt(0)" ::: "memory");
            const unsigned og = xb_add(&bar[XB_TOP], 1u);
            const unsigned tg = og / nx;
            if (og + 1u == (tg + 1u) * nx) xb_add(&bar[XB_TOPGEN], 1u);
            else XB_SPIN(xb_ld(&bar[XB_TOPGEN]) == tg, bar);
            __builtin_amdgcn_fence(__ATOMIC_ACQUIRE, "agent");
            xb_add(&bar[XB_XGEN(b.x)], 1u);
            asm volatile("s_waitcnt vmcnt(0)" ::: "memory");
        } else {
            XB_SPIN(xb_ld(&bar[XB_XGEN(b.x)]) == gen, bar);
            __builtin_amdgcn_fence(__ATOMIC_ACQUIRE, "agent");
            asm volatile("s_waitcnt vmcnt(0)" ::: "memory");
        }
    }
    __syncthreads();
}
typedef __attribute__((address_space(1))) unsigned char g_uc;
DI unsigned char* wsb(const Params& p) {
    typedef const unsigned long long __attribute__((address_space(4))) karg_u64;
    const unsigned long long w = *(karg_u64*)((const char __attribute__((address_space(4)))*)__builtin_amdgcn_kernarg_segment_ptr() + __builtin_offsetof(Params, ws));
    unsigned lo = (unsigned)w, hi = (unsigned)(w >> 32);
    asm volatile("" : "+s"(lo), "+s"(hi));
    return (unsigned char*)(g_uc*)(((unsigned long long)hi << 32) | lo);
}
extern __shared__ __attribute__((aligned(1024))) unsigned char g_lds[];
constexpr int LDS_CTL = 131072, LDS_BYTES = 131072 + 256;
DI int opq_tid() { int t = (int)(threadIdx.x & 255u); asm volatile("" : "+v"(t)); return t; }
DI void hsync() {
    asm volatile("s_waitcnt lgkmcnt(0)" ::: "memory");
    LAS unsigned* ctr = (LAS unsigned*)(g_lds + LDS_CTL + 32) + (threadIdx.x >> 8);
    unsigned old = 0u;
    if ((threadIdx.x & 63u) == 0u) old = __hip_atomic_fetch_add(ctr, 1u, __ATOMIC_RELAXED, __HIP_MEMORY_SCOPE_WORKGROUP);
    old = (unsigned)__builtin_amdgcn_readfirstlane((int)old);
    const unsigned target = (old & ~3u) + 4u;
    while (__hip_atomic_load(ctr, __ATOMIC_RELAXED, __HIP_MEMORY_SCOPE_WORKGROUP) < target) __builtin_amdgcn_s_sleep(1);
    asm volatile("" ::: "memory");
}
DI void hsync_g() { asm volatile("s_waitcnt vmcnt(0)" ::: "memory"); hsync(); }
DI int q_next(unsigned* ctr, volatile int* slot) {
    hsync();
    if ((threadIdx.x & 255u) == 0u) *slot = (int)__hip_atomic_fetch_add(ctr, 1u, __ATOMIC_RELAXED, __HIP_MEMORY_SCOPE_AGENT);
    hsync();
    return __builtin_amdgcn_readfirstlane(*slot);
}
DI void it_mod(const Params& p, int vb, unsigned char* sm) {
    float (*ca)[1024] = (float (*)[1024])sm;
    float (*part)[4][64] = (float (*)[4][64])(sm + 16384);
    const float* c = p.in[1];
    const int tid = opq_tid();
    hsync();
    for (int i = tid; i < 4096; i += 256) { const float v = c[i]; ca[i >> 10][i & 1023] = v / (1.f + __expf(-v)); }
    hsync();
    const int col = tid & 63, sl = tid >> 6;
    const int idx = vb * 64 + col;
    const int l = idx / 6144, n = idx % 6144;
    const float* w = p.in[4] + (size_t)l * 1024 * 6144 + n + (size_t)(256 * sl) * 6144;
    float a0 = 0, a1 = 0, a2 = 0, a3 = 0;
#pragma unroll 32
    for (int k = 0; k < 256; ++k) { const float wv = w[(size_t)k * 6144]; const int kk = 256 * sl + k; a0 += ca[0][kk] * wv; a1 += ca[1][kk] * wv; a2 += ca[2][kk] * wv; a3 += ca[3][kk] * wv; }
    part[sl][0][col] = a0; part[sl][1][col] = a1; part[sl][2][col] = a2; part[sl][3][col] = a3;
    hsync();
    {
        const int bb = tid >> 6;
        const float v = part[0][bb][col] + part[1][bb][col] + part[2][bb][col] + part[3][bb][col] + p.in[5][l * 6144 + n];
        ((float*)(wsb(p) + WS_MOD))[((size_t)l * 4 + bb) * 6144 + n] = v;
    }
}

struct TrArgs { const float* src; int lds, coff, nvalid; bf16* dst; int ldd, doff; int K, N; int mode; const float* aux; };
DI void it_transpose(const TrArgs& a, int vb4, unsigned char* sm) {
    const int tid = opq_tid(), lane = tid & 63, wave = tid >> 6, tx = lane & 31, ty = lane >> 5;
    float (*t)[33] = (float (*)[33])(sm + wave * 4224);
    float (*ta)[65] = (float (*)[65])(sm + 16896 + wave * 8320);
    float (*tb)[33] = (float (*)[33])(sm + 16896 + 33280);
    const int nk = a.K / 32;
    const int vb = vb4 * 4 + wave, kt = vb % nk, nt = vb / nk;
    hsync();
    if (a.mode == 0) {
        float v[16];
#pragma unroll
        for (int i = 0; i < 16; ++i) { const int k = kt * 32 + ty + 2 * i, n = nt * 32 + tx; v[i] = (n + a.coff < a.nvalid) ? a.src[(size_t)k * a.lds + n + a.coff] : 0.f; }
#pragma unroll
        for (int i = 0; i < 16; ++i) t[ty + 2 * i][tx] = v[i];
    } else if (a.mode == 1) {
        const int h = (nt * 32) >> 7, r0 = (nt * 32) & 127;
        float va[32], vb_[8];
#pragma unroll
        for (int i = 0; i < 32; ++i) va[i] = a.src[(size_t)(kt * 32 + i) * a.lds + 768 + 64 * h + lane];
#pragma unroll
        for (int i = 0; i < 8; ++i) { const int e = tid + 256 * i, d = e >> 5, rr = e & 31; vb_[i] = a.aux[((size_t)h * 64 + d) * 128 + r0 + rr]; }
#pragma unroll
        for (int i = 0; i < 32; ++i) ta[i][lane] = va[i];
#pragma unroll
        for (int i = 0; i < 8; ++i) { const int e = tid + 256 * i; tb[e >> 5][e & 31] = vb_[i]; }
        hsync();
#pragma unroll 2
        for (int r = ty; r < 32; r += 2) { float s = 0; _Pragma("unroll 16") for (int d = 0; d < 64; ++d) s += ta[r][d] * tb[d][tx]; t[r][tx] = s * 0.125f; }
    } else {
        const int h = (kt * 32) >> 7, r0 = (kt * 32) & 127;
        float va[32], vb_[8];
#pragma unroll
        for (int i = 0; i < 32; ++i) va[i] = a.aux[((size_t)h * 128 + r0 + i) * 64 + lane];
#pragma unroll
        for (int i = 0; i < 8; ++i) { const int e = tid + 256 * i, d = e >> 5, nn = e & 31; vb_[i] = a.src[(size_t)(512 + 64 * h + d) * a.lds + nt * 32 + nn]; }
#pragma unroll
        for (int i = 0; i < 32; ++i) ta[i][lane] = va[i];
#pragma unroll
        for (int i = 0; i < 8; ++i) { const int e = tid + 256 * i; tb[e >> 5][e & 31] = vb_[i]; }
        hsync();
#pragma unroll 2
        for (int r = ty; r < 32; r += 2) { float s = 0; _Pragma("unroll 16") for (int d = 0; d < 64; ++d) s += ta[r][d] * tb[d][tx]; t[r][tx] = s; }
    }
    asm volatile("s_waitcnt lgkmcnt(0)" ::: "memory");
#pragma unroll
    for (int i = 0; i < 16; ++i) {
        const int r = ty + 2 * i, n = nt * 32 + r, k = kt * 32 + tx;
        a.dst[(size_t)n * a.ldd + a.doff + k] = f2bf(t[tx][r]);
    }
}
DI void conv_chunk(const float* __restrict__ src, bf16* __restrict__ dst, size_t i0, int n8) {
    for (int i = opq_tid(); i < n8; i += 256) {
        const float4 a = ((const float4*)src)[2 * (i0 + i)], b = ((const float4*)src)[2 * (i0 + i) + 1];
        u32x4 o; o.x = cvt_pk_bf16(a.x, a.y); o.y = cvt_pk_bf16(a.z, a.w); o.z = cvt_pk_bf16(b.x, b.y); o.w = cvt_pk_bf16(b.z, b.w);
        ((u32x4*)dst)[i0 + i] = o;
    }
}
DI void it_gw(const Params& p, int vb) {
    for (int e = 0; e < 4; ++e) {
        const int idx = vb * 1024 + e * 256 + opq_tid();
        const int s = idx & 127, t = (idx >> 7) & 127;
        const float v = (t >= 64 || s < 64) ? p.in[17][idx] : 0.f;
        ((bf16*)(wsb(p) + WS_GW))[idx] = f2bf(v);
    }
}
DI void it_ssm_pw(const Params& p, int vb) {
    const int idx = vb * 256 + opq_tid();
    const int pp = idx & 63, g = (idx >> 6) & 15, l = idx >> 10;
    const float lre = -__expf(p.in[7][idx]), lim = p.in[8][idx];
    const float dt = __expf(p.in[14][l * 16 + g]);
    float* pw = (float*)(wsb(p) + WS_PW) + ((size_t)(l * 16 + g) * 65) * 128;
    for (int d = 0; d <= 64; ++d) {
        const float mag = expf(lre * dt * (float)d); float sn, cs; sincosf(lim * dt * (float)d, &sn, &cs);
        pw[d * 128 + pp * 2] = mag * cs; pw[d * 128 + pp * 2 + 1] = mag * sn;
    }
    const float mag = expf(lre * dt); float sn, cs; sincosf(lim * dt, &sn, &cs);
    const float are = mag * cs, aim = mag * sn;
    const float den = lre * lre + lim * lim, P = are - 1.f, Q = aim;
    const float fre = (P * lre + Q * lim) / den, fim = (Q * lre - P * lim) / den;
    float* bb = (float*)(wsb(p) + WS_BB) + (size_t)idx * 32;
    for (int h = 0; h < 16; ++h) { const float br = p.in[9][(size_t)idx * 16 + h], bi = p.in[10][(size_t)idx * 16 + h]; bb[h * 2] = fre * br - fim * bi; bb[h * 2 + 1] = fre * bi + fim * br; }
}
DI void it_ssm_kt(const Params& p, int vb, unsigned char* sm) {
    float* cz = (float*)sm;
    float* bz = (float*)(sm + 8192);
    float* pz = (float*)(sm + 16384);
    const int tid = opq_tid();
    const int lg = vb >> 3, d0 = (vb & 7) * 8;
    const float* PW = (const float*)(wsb(p) + WS_PW) + ((size_t)lg * 65 + d0) * 128;
    const float* BB = (const float*)(wsb(p) + WS_BB) + (size_t)lg * 64 * 32;
    hsync();
    for (int i = tid; i < 1024; i += 256) { const int q = i >> 4, h = i & 15; cz[i * 2] = p.in[11][((size_t)lg * 16 + h) * 64 + q]; cz[i * 2 + 1] = p.in[12][((size_t)lg * 16 + h) * 64 + q]; }
    for (int i = tid; i < 2048; i += 256) bz[i] = BB[i];
    for (int i = tid; i < 1024; i += 256) pz[i] = PW[i];
    hsync();
    const int h = tid >> 4, hh = tid & 15;
    float acc[8];
#pragma unroll
    for (int d = 0; d < 8; ++d) acc[d] = 0.f;
    for (int q = 0; q < 64; ++q) {
        const float cr = cz[(q * 16 + h) * 2], ci = cz[(q * 16 + h) * 2 + 1], br = bz[(q * 16 + hh) * 2], bi = bz[(q * 16 + hh) * 2 + 1];
        const float xr = cr * br - ci * bi, xi = cr * bi + ci * br;
#pragma unroll
        for (int d = 0; d < 8; ++d) acc[d] += xr * pz[(d * 64 + q) * 2] - xi * pz[(d * 64 + q) * 2 + 1];
    }
    bf16* KT = (bf16*)(wsb(p) + WS_KT) + ((size_t)lg * 64 + d0) * 256;
    if (d0 == 0 && h == hh) acc[0] += p.in[13][(size_t)lg * 16 + h];
#pragma unroll
    for (int d = 0; d < 8; ++d) KT[d * 256 + tid] = f2bf(acc[d]);
    hsync();
}
DI void ssm_tab_entry(const Params& p, size_t idx) {
    const size_t NE = (size_t)2 * 16 * 128 * 1024;
    const float* PW = (const float*)(wsb(p) + WS_PW); const float* BB = (const float*)(wsb(p) + WS_BB);
    if (idx < NE) {
        const int kk = idx & 1023, pp = (idx >> 10) & 127; const int lg = (int)(idx >> 17);
        const int i = kk >> 4, hh = kk & 15, pq = pp & 63, part = pp >> 6;
        const float* pw = PW + ((size_t)lg * 65 + (63 - i)) * 128 + pq * 2; const float* bb = BB + ((size_t)lg * 64 + pq) * 32 + hh * 2;
        const float v = part ? (pw[0] * bb[1] + pw[1] * bb[0]) : (pw[0] * bb[0] - pw[1] * bb[1]);
        ((bf16*)(wsb(p) + WS_E))[idx] = f2bf(v);
    } else if (idx < 2 * NE) {
        const size_t e = idx - NE; const int pp = e & 127, jh = (e >> 7) & 1023; const int lg = (int)(e >> 17);
        const int j = jh >> 4, h = jh & 15, pq = pp & 63, part = pp >> 6;
        const float* pw = PW + ((size_t)lg * 65 + (j + 1)) * 128 + pq * 2;
        const float cr = p.in[11][((size_t)lg * 16 + h) * 64 + pq], ci = p.in[12][((size_t)lg * 16 + h) * 64 + pq];
        const float v = part ? -(cr * pw[1] + ci * pw[0]) : (cr * pw[0] - ci * pw[1]);
        ((bf16*)(wsb(p) + WS_G))[e] = f2bf(v);
    } else {
        const size_t e = idx - 2 * NE; if (e >= (size_t)2 * 16 * 64 * 256) return;
        const int hh = e & 15, h = (e >> 4) & 15, d = (e >> 8) & 63; const int lg = (int)(e >> 14);
        const float* pw = PW + ((size_t)lg * 65 + d) * 128; const float* bb = BB + (size_t)lg * 64 * 32 + hh * 2;
        const float* cr = p.in[11] + ((size_t)lg * 16 + h) * 64; const float* ci = p.in[12] + ((size_t)lg * 16 + h) * 64;
        float s = 0;
        for (int q = 0; q < 64; ++q) { const float zr = pw[q * 2] * bb[q * 32] - pw[q * 2 + 1] * bb[q * 32 + 1], zi = pw[q * 2] * bb[q * 32 + 1] + pw[q * 2 + 1] * bb[q * 32]; s += cr[q] * zr - ci[q] * zi; }
        ((bf16*)(wsb(p) + WS_KT))[e] = f2bf(s);
    }
}
DI void norm_mod_row(const float* __restrict__ xrow, const float* __restrict__ g, const float* __restrict__ sh, const float* __restrict__ sc, bf16* __restrict__ hrow, int lane) {
    float4 v[4]; float ss = 0;
#pragma unroll
    for (int j = 0; j < 4; ++j) { v[j] = *(const float4*)(xrow + 4 * lane + 256 * j); ss += v[j].x * v[j].x + v[j].y * v[j].y + v[j].z * v[j].z + v[j].w * v[j].w; }
    ss = wave_sum(ss);
    const float r = rsqrtf(ss * (1.f / 1024.f) + 1e-6f);
#pragma unroll
    for (int j = 0; j < 4; ++j) {
        const int c = 4 * lane + 256 * j;
        const float4 gg = *(const float4*)(g + c), s1 = *(const float4*)(sc + c), s0 = *(const float4*)(sh + c);
        u32x2 o; o.x = cvt_pk_bf16(v[j].x * r * gg.x * (1.f + s1.x) + s0.x, v[j].y * r * gg.y * (1.f + s1.y) + s0.y);
        o.y = cvt_pk_bf16(v[j].z * r * gg.z * (1.f + s1.z) + s0.z, v[j].w * r * gg.w * (1.f + s1.w) + s0.w);
        *(u32x2*)(hrow + c) = o;
    }
}
namespace pg8 {
#define PG8_LAS __attribute__((address_space(3)))
typedef unsigned short bf16_t;
constexpr int BM = 256, BK = 64, HALF = 128, HTB = HALF * BK * 2  , STAGE_BYTES = 8 * HTB, NXCD = 8, WGM = 8;
__host__ __device__ __forceinline__ int lds_byte(int r, int c) { const int st = (r >> 4) * 2 + (c >> 5), rr = r & 15, cc = c & 31, ob = rr * 64 + cc * 2; return st * 1024 + (ob ^ (((ob >> 9) & 1) << 5)); }
__host__ __device__ __forceinline__ void stage_rc(int b, int& R, int& C) { const int st = b / 1024, sb = b % 1024, swz = sb ^ (((sb >> 9) & 1) << 5); R = (st >> 1) * 16 + swz / 64; C = (st & 1) * 32 + (swz % 64) / 2; }
__host__ __device__ __forceinline__ int perm32(int rho) { const int n = rho >> 4, i = rho & 15; return 8 * (i >> 2) + 4 * n + (i & 3); }

struct Unit { int pm, pn; };
struct Gemm { const bf16_t* A; const bf16_t* Bt; int M, N, K; };

struct StaticOrder {
    int nM, nN, nwg, G, c;
    __host__ __device__ void init(int M, int N, int G_, int c_) { nM = M / BM; nN = N / BM; nwg = nM * nN; G = G_; c = c_; }
    __host__ __device__ bool next(int i, Unit& u) const {
        const long L = (long)i * G + c; if (L >= nwg) return false;
        int wgid = (int)L; { const int q = nwg / NXCD, r = nwg % NXCD, xcd = wgid % NXCD, off = wgid / NXCD; wgid = (xcd < r ? xcd * (q + 1) : r * (q + 1) + (xcd - r) * q) + off; }
        const int nig = WGM * nN, gid = wgid / nig, fm = gid * WGM, gsz = (nM - fm) < WGM ? (nM - fm) : WGM;
        u.pm = fm + ((wgid % nig) % gsz); u.pn = (wgid % nig) / gsz; return true;
    }
    __device__ __forceinline__ void a_ready(const Unit&) const {}
    __device__ __forceinline__ void done(const Unit&) const {}
};

template <class Epi, class Sched, bool ALIGN_EPI = false, bool SP2 = false>
__device__ __forceinline__ void gemm_phase(PG8_LAS unsigned char* lds, const Gemm g, const Sched& S, const Epi& E) {
    int tid = (int)threadIdx.x; asm volatile("" : "+v"(tid));
    const int wid = __builtin_amdgcn_readfirstlane(tid >> 6), lane = tid & 63, wr = wid >> 2, wc = wid & 3, fr = lane & 15, fq = lane >> 4;
    const int K = g.K, nt = K / BK;
    unsigned voffA[2], voffB[2];
#pragma unroll
    for (int i = 0; i < 2; ++i) { int R, C; stage_rc(tid * 16 + i * 8192, R, C); const int Rb = Epi::PERM ? ((R & ~31) + perm32(R & 31)) : R;
        voffA[i] = (unsigned)(R * K + C) * 2u; voffB[i] = (unsigned)(Rb * K + C) * 2u; }
    const size_t kstep = (size_t)(BK * 2);
    const size_t hstep = (size_t)HALF * K * 2;
    const size_t tstep = 2 * hstep;
    const unsigned ldsw = (unsigned)wid * 1024u;
    const int aoff = lds_byte(wr * 64 + fr, fq * 8), boff = lds_byte(wc * 32 + fr, fq * 8);
#define PG8_SA(b, h) (((b) * 2 + (h)) * HTB)
#define PG8_SB(b, h) ((4 + (b) * 2 + (h)) * HTB)
#define PG8_STAGE(bufoff, gbase, voff) do { _Pragma("unroll") for (int _i = 0; _i < 2; ++_i) \
        __builtin_amdgcn_global_load_lds((const unsigned*)((const char*)(gbase) + (voff)[_i]), (PG8_LAS unsigned*)(lds + (bufoff) + ldsw + _i * 8192), 16, 0, 0); } while (0)
#define PG8_LDA(dst, b, h) do { _Pragma("unroll") for (int m = 0; m < 4; ++m) _Pragma("unroll") for (int k = 0; k < 2; ++k) dst[m][k] = *(const PG8_LAS bf16x8*)(lds + PG8_SA(b, h) + aoff + m * 2048 + k * 1024); } while (0)
#define PG8_LDB(dst, b, h) do { _Pragma("unroll") for (int n = 0; n < 2; ++n) _Pragma("unroll") for (int k = 0; k < 2; ++k) dst[n][k] = *(const PG8_LAS bf16x8*)(lds + PG8_SB(b, h) + boff + n * 2048 + k * 1024); } while (0)
#define PG8_MMA(ai, bj, At, Bt) do { __builtin_amdgcn_s_setprio(1); _Pragma("unroll") for (int m = 0; m < 4; ++m) _Pragma("unroll") for (int n = 0; n < 2; ++n) _Pragma("unroll") for (int k = 0; k < 2; ++k) \
        acc[ai][bj][m][n] = __builtin_amdgcn_mfma_f32_16x16x32_bf16(Bt[n][k], At[m][k], acc[ai][bj][m][n], 0, 0, 0); __builtin_amdgcn_s_setprio(0); } while (0)
#define PG8_WAIT_V(n) asm volatile("s_waitcnt vmcnt(" #n ")" ::: "memory")
#define PG8_WAIT_L(n) asm volatile("s_waitcnt lgkmcnt(" #n ")" ::: "memory")
#define PG8_BAR __builtin_amdgcn_s_barrier()
#define PG8_SCHED __builtin_amdgcn_sched_barrier(0)
    Unit cur, nxt; int ui = 0;
    if (!S.next(0, cur)) return;
    f32x4 acc[2][2][4][2];
#pragma unroll
    for (int a = 0; a < 2; ++a)
#pragma unroll
        for (int b = 0; b < 2; ++b)
#pragma unroll
            for (int m = 0; m < 4; ++m)
#pragma unroll
                for (int n = 0; n < 2; ++n) acc[a][b][m][n] = (f32x4){0.f, 0.f, 0.f, 0.f};
    bf16x8 At[4][2], B0[2][2], B1[2][2];
    const char* cA = (const char*)g.A + (size_t)cur.pm * tstep; const char* cB = (const char*)g.Bt + (size_t)cur.pn * tstep;
    S.a_ready(cur);
    if constexpr (SP2) {
        PG8_STAGE(PG8_SB(0, 0), cB, voffB); PG8_STAGE(PG8_SB(0, 1), cB + hstep, voffB); PG8_STAGE(PG8_SA(0, 0), cA, voffA); PG8_STAGE(PG8_SA(0, 1), cA + hstep, voffA);
        if (wr == 1) PG8_BAR;
        PG8_WAIT_V(2); PG8_BAR;
        PG8_STAGE(PG8_SB(1, 0), cB + kstep, voffB); PG8_STAGE(PG8_SA(1, 0), cA + kstep, voffA); PG8_STAGE(PG8_SB(1, 1), cB + hstep + kstep, voffB);
        PG8_WAIT_V(6); PG8_BAR;
    } else {
        PG8_STAGE(PG8_SB(0, 0), cB, voffB); PG8_STAGE(PG8_SA(0, 0), cA, voffA); PG8_STAGE(PG8_SB(0, 1), cB + hstep, voffB); PG8_STAGE(PG8_SA(0, 1), cA + hstep, voffA);
        if (wr == 1) PG8_BAR;
        PG8_WAIT_V(4); PG8_BAR;
        PG8_STAGE(PG8_SB(1, 0), cB + kstep, voffB); PG8_STAGE(PG8_SA(1, 0), cA + kstep, voffA); PG8_STAGE(PG8_SB(1, 1), cB + hstep + kstep, voffB);
        PG8_WAIT_V(6); PG8_BAR;
    }
    for (;;) {
        const bool has_next = S.next(ui + 1, nxt);
        const char* nA = has_next ? (const char*)g.A + (size_t)nxt.pm * tstep : cA; const char* nB = has_next ? (const char*)g.Bt + (size_t)nxt.pn * tstep : cB;
        for (int t = 0; t < nt; t += 2) {
            const bool last = (t == nt - 2);
            const char* a1 = cA + (size_t)(t + 1) * kstep;
            const char* a2 = last ? nA : cA + (size_t)(t + 2) * kstep; const char* b2 = last ? nB : cB + (size_t)(t + 2) * kstep;
            const char* a3 = a2 + kstep; const char* b3 = b2 + kstep;
            if (last && has_next) S.a_ready(nxt);
            if constexpr (SP2) {
            PG8_LDB(B0, 0, 0); PG8_LDB(B1, 0, 1); PG8_SCHED; PG8_LDA(At, 0, 0); PG8_STAGE(PG8_SA(1, 1), a1 + hstep, voffA);
            PG8_WAIT_V(8); PG8_WAIT_L(0); PG8_BAR; PG8_MMA(0, 0, At, B0); PG8_MMA(0, 1, At, B1); PG8_BAR; PG8_SCHED;
            PG8_LDA(At, 0, 1); PG8_STAGE(PG8_SB(0, 0), b2, voffB); PG8_STAGE(PG8_SB(0, 1), b2 + hstep, voffB); PG8_STAGE(PG8_SA(0, 0), a2, voffA);
            PG8_WAIT_V(8); PG8_WAIT_L(0); PG8_BAR; PG8_MMA(1, 0, At, B0); PG8_MMA(1, 1, At, B1); PG8_BAR; PG8_SCHED;
            PG8_LDB(B0, 1, 0); PG8_LDB(B1, 1, 1); PG8_SCHED; PG8_LDA(At, 1, 0); PG8_STAGE(PG8_SA(0, 1), a2 + hstep, voffA);
            PG8_WAIT_V(8); PG8_WAIT_L(0); PG8_BAR; PG8_MMA(0, 0, At, B0); PG8_MMA(0, 1, At, B1); PG8_BAR; PG8_SCHED;
            PG8_LDA(At, 1, 1); PG8_STAGE(PG8_SB(1, 0), b3, voffB); PG8_STAGE(PG8_SB(1, 1), b3 + hstep, voffB); PG8_STAGE(PG8_SA(1, 0), a3, voffA);
            PG8_WAIT_V(8); PG8_WAIT_L(0); PG8_BAR; PG8_MMA(1, 0, At, B0); PG8_MMA(1, 1, At, B1); PG8_BAR; PG8_SCHED;
            } else {
            PG8_LDB(B0, 0, 0); PG8_SCHED; PG8_LDA(At, 0, 0); PG8_STAGE(PG8_SA(1, 1), a1 + hstep, voffA);
            PG8_WAIT_L(8); PG8_BAR; PG8_WAIT_L(0); PG8_MMA(0, 0, At, B0); PG8_BAR; PG8_SCHED;
            PG8_LDB(B1, 0, 1); PG8_STAGE(PG8_SB(0, 0), b2, voffB);
            PG8_BAR; PG8_WAIT_L(0); PG8_MMA(0, 1, At, B1); PG8_BAR;
            PG8_LDA(At, 0, 1); PG8_STAGE(PG8_SA(0, 0), a2, voffA);
            PG8_BAR; PG8_WAIT_L(0); PG8_MMA(1, 0, At, B0); PG8_BAR; PG8_SCHED;
            PG8_STAGE(PG8_SB(0, 1), b2 + hstep, voffB);
            PG8_WAIT_V(6); PG8_BAR; PG8_MMA(1, 1, At, B1); PG8_BAR;
            PG8_LDB(B0, 1, 0); PG8_SCHED; PG8_LDA(At, 1, 0); PG8_STAGE(PG8_SA(0, 1), a2 + hstep, voffA);
            PG8_WAIT_L(8); PG8_BAR; PG8_WAIT_L(0); PG8_MMA(0, 0, At, B0); PG8_BAR; PG8_SCHED;
            PG8_LDB(B1, 1, 1); PG8_STAGE(PG8_SB(1, 0), b3, voffB);
            PG8_BAR; PG8_WAIT_L(0); PG8_MMA(0, 1, At, B1); PG8_BAR;
            PG8_LDA(At, 1, 1); PG8_STAGE(PG8_SA(1, 0), a3, voffA);
            PG8_BAR; PG8_WAIT_L(0); PG8_MMA(1, 0, At, B0); PG8_BAR; PG8_SCHED;
            PG8_STAGE(PG8_SB(1, 1), b3 + hstep, voffB);
            PG8_WAIT_V(6); PG8_BAR; PG8_MMA(1, 1, At, B1); PG8_BAR;
            }
        }
        if constexpr (ALIGN_EPI) { if (wr == 0) PG8_BAR; }
        if constexpr (!Epi::AFTER_DRAIN) { E(acc, cur, wr, wc, fr, fq); S.done(cur); }
        if (!has_next) break;
#pragma unroll
        for (int a = 0; a < 2; ++a)
#pragma unroll
            for (int b = 0; b < 2; ++b)
#pragma unroll
                for (int m = 0; m < 4; ++m)
#pragma unroll
                    for (int n = 0; n < 2; ++n) acc[a][b][m][n] = (f32x4){0.f, 0.f, 0.f, 0.f};
        cur = nxt; cA = nA; cB = nB; ++ui;
        if constexpr (ALIGN_EPI) { if (wr == 1) PG8_BAR; }
    }
    PG8_WAIT_V(0);
    if constexpr (!ALIGN_EPI) { if (wr == 0) PG8_BAR; }
    PG8_BAR;
    if constexpr (Epi::AFTER_DRAIN) { E.fused(acc, cur, wr, wc, fr, fq, lds, wid, lane); S.done(cur); }
#undef PG8_SA
#undef PG8_SB
#undef PG8_STAGE
#undef PG8_LDA
#undef PG8_LDB
#undef PG8_MMA
#undef PG8_WAIT_V
#undef PG8_WAIT_L
#undef PG8_BAR
#undef PG8_SCHED
}
}
struct EpiBf16 { bf16* C; int ldc; DI void operator()(int r, int c, f32x4 v) const { u32x2 o; o.x = cvt_pk_bf16(v[0], v[1]); o.y = cvt_pk_bf16(v[2], v[3]); *(u32x2*)(C + (size_t)r * ldc + c) = o; } };
struct EpiResid { const float* xin; float* xout; const float* gate;
    DI void operator()(int r, int c, f32x4 v) const { const float4 x = *(const float4*)(xin + (size_t)r * 1024 + c); const float4 g = *(const float4*)(gate + (size_t)(r >> 12) * 6144 + c);
        float4 o; o.x = x.x + g.x * v[0]; o.y = x.y + g.y * v[1]; o.z = x.z + g.z * v[2]; o.w = x.w + g.w * v[3]; *(float4*)(xout + (size_t)r * 1024 + c) = o; } };
struct EpiGlu { const bf16* yg; const float* bglu; bf16* mix;
    DI void operator()(int r, int c, f32x4 v) const { const u32x2 y = *(const u32x2*)(yg + (size_t)r * 256 + c); const float4 b = *(const float4*)(bglu + c);
        u32x2 o; o.x = cvt_pk_bf16(bflo(y.x) * sigmoidf(v[0] + b.x), bfhi(y.x) * sigmoidf(v[1] + b.y)); o.y = cvt_pk_bf16(bflo(y.y) * sigmoidf(v[2] + b.z), bfhi(y.y) * sigmoidf(v[3] + b.w));
        *(u32x2*)(mix + (size_t)r * KMIX + c) = o; } };
constexpr int GP = 72;
template <class Epi>
DI void gemm_tile64(const bf16* __restrict__ A, int lda, const bf16* __restrict__ Bt, int ldb, int K, int m0, int n0, bf16* lds, const Epi& epi) {
    bf16* As = lds; bf16* Bs = lds + 64 * GP;
    const int tid = opq_tid(), lane = tid & 63, wave = tid >> 6, wm = wave >> 1, wn = wave & 1;
    const int fr = lane & 15, fq = lane >> 4;
    const int lrow = tid >> 3, lch = tid & 7;
    f32x4 acc[4][2];
#pragma unroll
    for (int i = 0; i < 4; ++i)
#pragma unroll
        for (int j = 0; j < 2; ++j) acc[i][j] = (f32x4){0.f, 0.f, 0.f, 0.f};
    bf16x8 ra[2], rb[4];
    const bf16* Ag = A + (size_t)(m0 + lrow) * lda + lch * 8;
    const bf16* Bg = Bt + (size_t)(n0 + lrow) * ldb + lch * 8;
#pragma unroll
    for (int i = 0; i < 4; ++i) { if (i < 2) ra[i] = ld16(Ag + (size_t)32 * i * lda); rb[i] = ld16(Bg + (size_t)32 * i * ldb); }
    const int nk = K / 64;
    for (int kt = 0; kt < nk; ++kt) {
        hsync();
#pragma unroll
        for (int i = 0; i < 4; ++i) { if (i < 2) *(bf16x8*)(As + (lrow + 32 * i) * GP + lch * 8) = ra[i]; *(bf16x8*)(Bs + (lrow + 32 * i) * GP + lch * 8) = rb[i]; }
        hsync();
        if (kt + 1 < nk) {
#pragma unroll
            for (int i = 0; i < 4; ++i) { if (i < 2) ra[i] = ld16(Ag + (size_t)32 * i * lda + (kt + 1) * 64); rb[i] = ld16(Bg + (size_t)32 * i * ldb + (kt + 1) * 64); }
        }
#pragma unroll
        for (int ks = 0; ks < 2; ++ks) {
            bf16x8 fa[4], fb[2];
#pragma unroll
            for (int i = 0; i < 4; ++i) fa[i] = ld16(Bs + (64 * wn + 16 * i + fr) * GP + 32 * ks + 8 * fq);
#pragma unroll
            for (int j = 0; j < 2; ++j) fb[j] = ld16(As + (32 * wm + 16 * j + fr) * GP + 32 * ks + 8 * fq);
#pragma unroll
            for (int i = 0; i < 4; ++i)
#pragma unroll
                for (int j = 0; j < 2; ++j) acc[i][j] = MFMA16(fa[i], fb[j], acc[i][j]);
        }
    }
#pragma unroll
    for (int i = 0; i < 4; ++i)
#pragma unroll
        for (int j = 0; j < 2; ++j) epi(m0 + 32 * wm + 16 * j + fr, n0 + 64 * wn + 16 * i + 4 * fq, acc[i][j]);
}
template <class F> struct Epi256 {
    static constexpr bool PERM = false, AFTER_DRAIN = false;
    F f;
    DI void operator()(const f32x4 (&acc)[2][2][4][2], const pg8::Unit& u, int wr, int wc, int, int) const {
        int t_ = (int)threadIdx.x; asm volatile("" : "+v"(t_));
        const int fr = t_ & 15, fq = (t_ >> 4) & 3;
#pragma unroll
        for (int ai = 0; ai < 2; ++ai)
#pragma unroll
            for (int m = 0; m < 4; ++m)
#pragma unroll
                for (int bj = 0; bj < 2; ++bj)
#pragma unroll
                    for (int n = 0; n < 2; ++n) f(u.pm * 256 + ai * 128 + wr * 64 + m * 16 + fr, u.pn * 256 + bj * 128 + wc * 32 + n * 16 + 4 * fq, acc[ai][bj][m][n]);
    }
};

DI unsigned off_b(unsigned row, unsigned ch) { return 256u * row + 16u * (ch ^ (((row & 3u) << 2) | ((row >> 2) & 3u))); }
#define TR8(o0, o1, o2, o3, o4, o5, o6, o7, a0, a1, a2, a3, a4, a5, a6, a7)                                                                         \
    asm volatile("s_waitcnt lgkmcnt(0)\n\t"                                                                                                         \
                 "ds_read_b64_tr_b16 %0, %8\n\tds_read_b64_tr_b16 %1, %9\n\tds_read_b64_tr_b16 %2, %10\n\tds_read_b64_tr_b16 %3, %11\n\t"           \
                 "ds_read_b64_tr_b16 %4, %12\n\tds_read_b64_tr_b16 %5, %13\n\tds_read_b64_tr_b16 %6, %14\n\tds_read_b64_tr_b16 %7, %15\n\t"         \
                 "s_waitcnt lgkmcnt(0)"                                                                                                             \
                 : "=&v"(o0), "=&v"(o1), "=&v"(o2), "=&v"(o3), "=&v"(o4), "=&v"(o5), "=&v"(o6), "=&v"(o7)                                           \
                 : "v"(a0), "v"(a1), "v"(a2), "v"(a3), "v"(a4), "v"(a5), "v"(a6), "v"(a7)                                                           \
                 : "memory")

DI void it_kvn(const Params& p, int l, int vb) {
    const int lane = opq_tid() & 63, wave = opq_tid() >> 6;
    const bf16* proj = (const bf16*)(wsb(p) + WS_PROJ); bf16* kvn = (bf16*)(wsb(p) + WS_KVN);
    const float g0 = p.in[19][l * 128 + 2 * lane], g1 = p.in[19][l * 128 + 2 * lane + 1];
    for (int i = 0; i < 16; ++i) {
        const int row = vb * 64 + i * 4 + wave;
        const unsigned u = *(const unsigned*)(proj + (size_t)row * NPROJ + C_CKV + 2 * lane);
        const float a = bflo(u), b = bfhi(u);
        const float ss = wave_sum(a * a + b * b);
        const float r = rsqrtf(ss * (1.f / 128.f) + 1e-6f);
        *(unsigned*)(kvn + (size_t)row * 128 + 2 * lane) = cvt_pk_bf16(a * r * g0, b * r * g1);
    }
}

DI void it_ssm_a(const Params& p, int l, int item) {
    const int lane = opq_tid() & 63, wave = opq_tid() >> 6, fr = lane & 15, fq = lane >> 4;
    const bf16* proj = (const bf16*)(wsb(p) + WS_PROJ);
    float* sloc = (float*)(wsb(p) + WS_SLOC);
    const int g = item & 15, rt = item >> 4;
    const bf16* E = (const bf16*)(wsb(p) + WS_E) + ((size_t)(l * 16 + g) * 128) * 1024;
    const int R = 16 * rt + fr, b = R >> 6, k = R & 63;
    const bf16* arow = proj + ((size_t)b * 4096 + 64 * k + (fq >> 1)) * NPROJ + C_UA + 16 * g + 8 * (fq & 1);
    f32x4 acc[2] = {(f32x4){0, 0, 0, 0}, (f32x4){0, 0, 0, 0}};
#pragma unroll 4
    for (int ks = 0; ks < 32; ++ks) {
        const bf16x8 a = ld16(arow + (size_t)(2 * ks) * NPROJ);
#pragma unroll
        for (int c = 0; c < 2; ++c) { const int ct = 2 * wave + c; const bf16x8 bf = ld16(E + (size_t)(16 * ct + fr) * 1024 + 32 * ks + 8 * fq); acc[c] = MFMA16(a, bf, acc[c]); }
    }
#pragma unroll
    for (int c = 0; c < 2; ++c)
#pragma unroll
        for (int i = 0; i < 4; ++i) sloc[((size_t)(16 * rt + 4 * fq + i) * 16 + g) * 128 + 16 * (2 * wave + c) + fr] = acc[c][i];
}

DI void it_ssm_c(const Params& p, int l, int item, unsigned char* sm, int pm = 7) {
    bf16* sst = (bf16*)sm;
    bf16* ktl = (bf16*)(sm + 17408);
    const int tid = opq_tid(), lane = tid & 63, wave = tid >> 6, fr = lane & 15, fq = lane >> 4;
    const bf16* proj = (const bf16*)(wsb(p) + WS_PROJ);
    const float* sloc = (const float*)(wsb(p) + WS_SLOC);
    bf16* yg = (bf16*)(wsb(p) + WS_YG);
    const int jq = item & 3, g = (item >> 2) & 15, b = item >> 6;
    const bf16* KT = (const bf16*)(wsb(p) + WS_KT) + (size_t)(l * 16 + g) * 64 * 256;
    hsync();
#pragma unroll
    for (int i = 0; i < 8; ++i) *(bf16x8*)(ktl + (i * 256 + tid) * 8) = ld16(KT + (size_t)(i * 256 + tid) * 8);
    if (wave == 0 && (pm & 1)) {
        const float* pw64 = (const float*)(wsb(p) + WS_PW) + ((size_t)(l * 16 + g) * 65 + 64) * 128 + lane * 2;
        const float ar = pw64[0], ai = pw64[1];
        float sr = 0, si = 0;
        const float* s = sloc + ((size_t)(b * 64) * 16 + g) * 128;
        float lr[64], li[64];
#pragma unroll
        for (int k = 0; k < 64; ++k) { lr[k] = s[(size_t)k * 2048 + lane]; li[k] = s[(size_t)k * 2048 + 64 + lane]; }
#pragma unroll
        for (int k = 0; k < 64; ++k) {
            sst[k * 136 + lane] = f2bf(sr); sst[k * 136 + 64 + lane] = f2bf(si);
            const float nr = ar * sr - ai * si + lr[k], ni = ar * si + ai * sr + li[k];
            sr = nr; si = ni;
        }
    }
    hsync();
    const bf16* G = (const bf16*)(wsb(p) + WS_G) + (size_t)(l * 16 + g) * 1024 * 128;
    const int kch = 16 * wave + fr;
    const bf16* arow = proj + ((size_t)b * 4096 + 64 * kch + (fq >> 1)) * NPROJ + C_UA + 16 * g + 8 * (fq & 1);
    const int j0 = 16 * jq;
    f32x4 acc[16];
#pragma unroll
    for (int jj = 0; jj < 16; ++jj) acc[jj] = (f32x4){0, 0, 0, 0};
    const int nks = (j0 + 15) / 2 + 1;
    bf16x8 a_cur[8], a_nxt[8];
#pragma unroll
    for (int i = 0; i < 8; ++i) a_cur[i] = ld16(arow + (size_t)(2 * i) * NPROJ);
    const bf16* blane = ktl + (fr - 16 * (fq >> 1)) * 16 + 8 * (fq & 1);
#pragma unroll 1
    for (int grp = 0; grp < ((pm & 2) ? jq : 0); ++grp) {
#pragma unroll
        for (int i = 0; i < 8; ++i) a_nxt[i] = ld16(arow + (size_t)(2 * (8 * grp + 8 + i)) * NPROJ);
#pragma unroll
        for (int i = 0; i < 8; ++i) {
            const bf16* bp = blane + 256 * (j0 - 2 * (8 * grp + i));
#pragma unroll
            for (int jj = 0; jj < 16; ++jj) acc[jj] = MFMA16(ld16(bp + 256 * jj), a_cur[i], acc[jj]);
        }
#pragma unroll
        for (int i = 0; i < 8; ++i) a_cur[i] = a_nxt[i];
    }
    if (pm & 2) {
#pragma unroll
        for (int i = 0; i < 8; ++i) {
            const int ks = 8 * jq + i;
#pragma unroll
            for (int jj = 0; jj < 16; ++jj) {
                const int j = j0 + jj;
                if (2 * i <= jj) {
                    const int d = j - 2 * ks - (fq >> 1);
                    const bf16x8 bl = ld16(ktl + ((d < 0 ? 0 : d) * 16 + fr) * 16 + 8 * (fq & 1));
                    const bf16x8 bf = d >= 0 ? bl : zero8();
                    acc[jj] = MFMA16(bf, a_cur[i], acc[jj]);
                }
            }
        }
    }
#pragma unroll
    for (int ks = 0; ks < ((pm & 4) ? 4 : 0); ++ks) {
        const bf16x8 a = ld16(sst + kch * 136 + 32 * ks + 8 * fq);
        bf16x8 bfr[16];
#pragma unroll
        for (int jj = 0; jj < 16; ++jj) bfr[jj] = ld16(G + ((size_t)((j0 + jj) * 16 + fr)) * 128 + 32 * ks + 8 * fq);
#pragma unroll
        for (int jj = 0; jj < 16; ++jj) acc[jj] = MFMA16(bfr[jj], a, acc[jj]);
    }
#pragma unroll
    for (int jj = 0; jj < 16; ++jj) {
        const size_t tok = (size_t)b * 4096 + 64 * (16 * wave + fr) + j0 + jj;
        u32x2 o; o.x = cvt_pk_bf16(gelu_tanh(acc[jj][0]), gelu_tanh(acc[jj][1])); o.y = cvt_pk_bf16(gelu_tanh(acc[jj][2]), gelu_tanh(acc[jj][3]));
        *(u32x2*)(yg + tok * 256 + 16 * g + 4 * fq) = o;
    }
}

DI void it_gmlp(const Params& p, int l, int item, unsigned char* sm) {
    bf16* vnT = (bf16*)sm;
    const int tid = opq_tid(), lane = tid & 63, wave = tid >> 6, fr = lane & 15, fq = lane >> 4;
    const bf16* proj = (const bf16*)(wsb(p) + WS_PROJ); bf16* mix = (bf16*)(wsb(p) + WS_MIX);
    const int h = item & 3, blk = item >> 2;
    const size_t tok0 = (size_t)blk * 128;
    hsync();
    {
        const int row = tid >> 1, half = tid & 1;
        const bf16* vp = proj + (tok0 + row) * NPROJ + C_VB + 64 * h + 32 * half;
        float v[32]; float s = 0;
#pragma unroll
        for (int q = 0; q < 4; ++q) { const bf16x8 t = ld16(vp + 8 * q);
#pragma unroll
            for (int e = 0; e < 8; ++e) { v[8 * q + e] = bf2f((bf16)t[e]); s += v[8 * q + e]; } }
        s += __shfl_xor(s, 1); const float mu = s * (1.f / 64.f);
        float vs = 0;
#pragma unroll
        for (int e = 0; e < 32; ++e) { const float d = v[e] - mu; vs += d * d; }
        vs += __shfl_xor(vs, 1); const float r = rsqrtf(vs * (1.f / 64.f) + 1e-6f);
#pragma unroll
        for (int e = 0; e < 32; ++e) vnT[(32 * half + e) * 136 + row] = f2bf((v[e] - mu) * r);
    }
    hsync();
    const bf16* W = (const bf16*)(wsb(p) + WS_GW) + (size_t)(l * 4 + h) * 128 * 128;
    f32x4 acc[4][2];
#pragma unroll
    for (int i = 0; i < 4; ++i) { acc[i][0] = (f32x4){0, 0, 0, 0}; acc[i][1] = (f32x4){0, 0, 0, 0}; }
#pragma unroll
    for (int ks = 0; ks < 4; ++ks) {
        bf16x8 fa[4], fb[2];
#pragma unroll
        for (int i = 0; i < 4; ++i) fa[i] = ld16(vnT + (16 * i + fr) * 136 + 32 * ks + 8 * fq);
#pragma unroll
        for (int j = 0; j < 2; ++j) fb[j] = ld16(W + (size_t)(16 * (2 * wave + j) + fr) * 128 + 32 * ks + 8 * fq);
#pragma unroll
        for (int i = 0; i < 4; ++i)
#pragma unroll
            for (int j = 0; j < 2; ++j) acc[i][j] = MFMA16(fa[i], fb[j], acc[i][j]);
    }
#pragma unroll
    for (int j = 0; j < 2; ++j) {
        const int t = 16 * (2 * wave + j) + fr;
        const float bs = p.in[18][(l * 4 + h) * 128 + t];
#pragma unroll
        for (int i = 0; i < 4; ++i) {
            const int d = 16 * i + 4 * fq;
            const u32x2 u = *(const u32x2*)(proj + (tok0 + t) * NPROJ + C_UB + 64 * h + d);
            u32x2 o; o.x = cvt_pk_bf16(bflo(u.x) * (acc[i][j][0] + bs), bfhi(u.x) * (acc[i][j][1] + bs)); o.y = cvt_pk_bf16(bflo(u.y) * (acc[i][j][2] + bs), bfhi(u.y) * (acc[i][j][3] + bs));
            *(u32x2*)(mix + (tok0 + t) * KMIX + 256 + 64 * h + d) = o;
        }
    }
}

DI size_t score_row_off(int b, int t) { const int c = t >> 6; return (size_t)b * SCORES_PER_BATCH + (size_t)4096 * (c * (c + 1) / 2) + (size_t)(t & 63) * 64 * (c + 1); }
template <int NR>
DI void dsa_select_impl(const float* __restrict__ srow, int nreg, bf16* __restrict__ so, int lane, unsigned* hist, int topbit = 31) {
    unsigned key[NR];
#pragma unroll
    for (int r = 0; r < NR; ++r) { const float v = srow[64 * r + lane]; key[r] = (r < nreg) ? fkey(v + 0.f) : 0u; }
    unsigned T = 0;
#pragma unroll 1
    for (int bit = (topbit < 0 ? -1 : (topbit & 63)); bit >= 0; --bit) {
        const unsigned cand = T | (1u << bit);
        unsigned c = 0;
#pragma unroll
        for (int r = 0; r < NR; ++r) asm("v_cmp_ge_u32 vcc, %1, %2\n\tv_addc_co_u32 %0, vcc, 0, %0, vcc" : "+v"(c) : "v"(key[r]), "v"(cand) : "vcc");
        const unsigned cnt = wave_sum_u32(c);
        if (cnt >= 256u) { T = cand; if (cnt == 256u) break; }
    }
    if (topbit < 0 || (topbit & 64)) { unsigned x = T; _Pragma("unroll") for (int r = 0; r < NR; ++r) x ^= key[r]; if (x == 0x12345u) so[lane] = (bf16)x; return; }
    unsigned c = 0;
#pragma unroll
    for (int r = 0; r < NR; ++r) asm("v_cmp_gt_u32 vcc, %1, %2\n\tv_addc_co_u32 %0, vcc, 0, %0, vcc" : "+v"(c) : "v"(key[r]), "v"(T) : "vcc");
    const int need = 256 - (int)wave_sum_u32(c);
    unsigned ce = 0;
#pragma unroll
    for (int r = 0; r < NR; ++r) asm("v_cmp_eq_u32 vcc, %1, %2\n\tv_addc_co_u32 %0, vcc, 0, %0, vcc" : "+v"(ce) : "v"(key[r]), "v"(T) : "vcc");
    if ((int)wave_sum_u32(ce) == need) {
        bf16* stg = (bf16*)hist;
        unsigned base = 0;
#pragma unroll
        for (int r = 0; r < NR; ++r) {
            const unsigned long long mt = __ballot(key[r] >= T);
            const unsigned pos = __builtin_amdgcn_mbcnt_hi((unsigned)(mt >> 32), __builtin_amdgcn_mbcnt_lo((unsigned)mt, base));
            stg[(key[r] >= T) ? pos : 256u + (unsigned)lane] = (bf16)(64 * r + lane);
            base += (unsigned)__popcll(mt);
        }
        asm volatile("s_waitcnt lgkmcnt(0)" ::: "memory");
        *(u32x2*)(so + 4 * lane) = *(const u32x2*)(stg + 4 * lane);
        return;
    }
    int base = 0, eqb = 0;
    const unsigned long long lt = (1ull << lane) - 1ull;
#pragma unroll
    for (int r = 0; r < NR; ++r) {
        const unsigned long long me = __ballot(key[r] == T);
        const int erank = eqb + __popcll(me & lt);
        const bool take = (key[r] > T) || (key[r] == T && erank < need);
        const unsigned long long mt = __ballot(take);
        if (take) so[base + __popcll(mt & lt)] = (bf16)(64 * r + lane);
        base += __popcll(mt); eqb += __popcll(me);
    }
}
DI void dsa_select_query(const Params& p, int q, int lane, unsigned* hist, int topbit = 31) {
    const float* scores = (const float*)(wsb(p) + WS_SCORES); bf16* sel = (bf16*)(wsb(p) + WS_SEL);
    const int b = q >> 12, t = q & 4095, c = t >> 6, nreg = c + 1;
    bf16* so = sel + (size_t)q * 256;
    if (nreg <= 4) { for (int r = 0; r < nreg; ++r) so[64 * r + lane] = (bf16)(64 * r + lane); return; }
    const float* srow = scores + score_row_off(b, t);
    if (nreg <= 16) dsa_select_impl<16>(srow, nreg, so, lane, hist, topbit);
    else if (nreg <= 32) dsa_select_impl<32>(srow, nreg, so, lane, hist, topbit);
    else if (nreg <= 48) dsa_select_impl<48>(srow, nreg, so, lane, hist, topbit);
    else dsa_select_impl<64>(srow, nreg, so, lane, hist, topbit);
}
DI void it_dsa_index_select(const Params& p, int item, unsigned char* sm, int mode = 3) {
    const int lane = opq_tid() & 63, wave = opq_tid() >> 6, fr = lane & 15, fq = lane >> 4;
    const bf16* proj = (const bf16*)(wsb(p) + WS_PROJ); float* scores = (float*)(wsb(p) + WS_SCORES);
    const int c = 63 - (item >> 4), b = (item >> 2) & 3, qg = item & 3;
    if (c >= 4 && (mode & 1)) {
        const int t = 64 * c + 16 * qg + fr;
        const bf16* qrow = proj + ((size_t)b * 4096 + t) * NPROJ;
        bf16x8 qf[4][2];
#pragma unroll
        for (int hh = 0; hh < 4; ++hh)
#pragma unroll
            for (int ks = 0; ks < 2; ++ks) qf[hh][ks] = ld16(qrow + C_QI + 64 * hh + 32 * ks + 8 * fq);
        float w[4];
        { const u32x2 wv = *(const u32x2*)(qrow + C_WI); w[0] = bflo(wv.x) * 0.0625f; w[1] = bfhi(wv.x) * 0.0625f; w[2] = bflo(wv.y) * 0.0625f; w[3] = bfhi(wv.y) * 0.0625f; }
        float* srow = scores + score_row_off(b, t);
        const int ntile = 4 * (c + 1);
        const bf16* kbase = proj + ((size_t)b * 4096 + fr) * NPROJ + C_KI + 8 * fq;
        bf16x8 k0[4], k1[4];
#pragma unroll
        for (int u = 0; u < 4; ++u) { const bf16* krow = kbase + (size_t)16 * (wave + 4 * u) * NPROJ; k0[u] = ld16(krow); k1[u] = ld16(krow + 32); }
        for (int base = wave; base < ntile; base += 16) {
            bf16x8 n0[4], n1[4];
            const bool more = base + 16 < ntile;
            if (more) {
#pragma unroll
                for (int u = 0; u < 4; ++u) { const bf16* krow = kbase + (size_t)16 * (base + 16 + 4 * u) * NPROJ; n0[u] = ld16(krow); n1[u] = ld16(krow + 32); }
            }
#pragma unroll
            for (int u = 0; u < 4; ++u) {
                const int kt = base + 4 * u;
                if (kt >= ntile) break;
                f32x4 sc = {0, 0, 0, 0};
#pragma unroll
                for (int hh = 0; hh < 4; ++hh) {
                    f32x4 a = {0, 0, 0, 0};
                    a = MFMA16(k0[u], qf[hh][0], a); a = MFMA16(k1[u], qf[hh][1], a);
#pragma unroll
                    for (int i = 0; i < 4; ++i) sc[i] += w[hh] * fmaxf(a[i], 0.f);
                }
#pragma unroll
                for (int i = 0; i < 4; ++i) sc[i] += 0.f;
                *(f32x4*)(srow + 16 * kt + 4 * fq) = sc;
            }
            if (more) {
#pragma unroll
                for (int u = 0; u < 4; ++u) { k0[u] = n0[u]; k1[u] = n1[u]; }
            }
        }
    }
    hsync_g();
    if (mode & 2) for (int i = 0; i < 4; ++i) dsa_select_query(p, b * 4096 + 64 * c + 16 * qg + 4 * wave + i, lane, (unsigned*)sm + 1024 * wave, (mode & 16) ? -1 : (((mode & 4) ? 15 : 31) | ((mode & 8) ? 64 : 0)));
}
DI void it_dsa_attn(const Params& p, int item, unsigned char* sm) {
    const int lane = opq_tid() & 63, wave = opq_tid() >> 6, fr = lane & 15, fq = lane >> 4;
    unsigned char* tile = sm + wave * 8192;
    bf16* selw = (bf16*)(sm + 32768 + wave * 512);
    const bf16* proj = (const bf16*)(wsb(p) + WS_PROJ); const bf16* kvn = (const bf16*)(wsb(p) + WS_KVN);
    const bf16* sel = (const bf16*)(wsb(p) + WS_SEL); bf16* mix = (bf16*)(wsb(p) + WS_MIX);
    unsigned wr_addr[8], rd_addr[2][4], tr_addr[8][2];
#pragma unroll
    for (int i = 0; i < 8; ++i) wr_addr[i] = off_b(4 * i + fq, fr);
#pragma unroll
    for (int rb = 0; rb < 2; ++rb)
#pragma unroll
        for (int s = 0; s < 4; ++s) rd_addr[rb][s] = off_b(8 * (fr >> 2) + 4 * rb + (fr & 3), 4 * s + fq);
    const unsigned tbase = (unsigned)(size_t)tile;
    {
        const unsigned q4 = fr >> 2, p4 = fr & 3;
#pragma unroll
        for (int c = 0; c < 8; ++c)
#pragma unroll
            for (int t = 0; t < 2; ++t) tr_addr[c][t] = tbase + off_b(8 * fq + 4 * t + q4, 2 * c + (p4 >> 1)) + 8 * (p4 & 1);
    }
    const float slope = fr < 8 ? exp2f(-(float)(fr + 1)) : 0.f;
    for (int qi = 0; qi < 4; ++qi) {
        const int q = item * 16 + wave * 4 + qi;
        const int b = q >> 12, t = q & 4095, c = t >> 6;
        const int nsel = (c + 1) * 64 < 256 ? (c + 1) * 64 : 256;
        const bf16* qa = proj + (size_t)q * NPROJ + C_QA;
        bf16x8 qf[4];
#pragma unroll
        for (int s = 0; s < 4; ++s) qf[s] = fr < 8 ? ld16(qa + fr * 128 + 32 * s + 8 * fq) : zero8();
        const bf16* selp = sel + (size_t)q * 256;
        const bf16* kvb = kvn + (size_t)b * 4096 * 128;
        if (4 * lane < nsel) *(u32x2*)(selw + 4 * lane) = *(const u32x2*)(selp + 4 * lane);
        float m_run = -INFINITY, l_run = 0.f;
        f32x4 o[8];
#pragma unroll
        for (int i = 0; i < 8; ++i) o[i] = (f32x4){0, 0, 0, 0};
        bf16x8 gk[8];
#pragma unroll
        for (int i = 0; i < 8; ++i) { const int key = selw[4 * i + fq]; gk[i] = ld16(kvb + (size_t)key * 128 + 8 * fr); }
        const int nt = nsel / 32;
        for (int ti = 0; ti < nt; ++ti) {
            const bf16x8 kp = ld16(selw + 32 * ti + 8 * fq);
#pragma unroll
            for (int i = 0; i < 8; ++i) *(bf16x8*)(tile + wr_addr[i]) = gk[i];
            if (ti + 1 < nt) {
#pragma unroll
                for (int i = 0; i < 8; ++i) { const int key = selw[32 * (ti + 1) + 4 * i + fq]; gk[i] = ld16(kvb + (size_t)key * 128 + 8 * fr); }
            }
            f32x4 lg[2] = {(f32x4){0, 0, 0, 0}, (f32x4){0, 0, 0, 0}};
#pragma unroll
            for (int rb = 0; rb < 2; ++rb)
#pragma unroll
                for (int s = 0; s < 4; ++s) lg[rb] = MFMA16(ld16(tile + rd_addr[rb][s]), qf[s], lg[rb]);
            float val[8]; float tmax = -INFINITY;
#pragma unroll
            for (int j = 0; j < 8; ++j) { const float dist = fabsf((float)(t - (int)(unsigned short)kp[j])); val[j] = lg[j >> 2][j & 3] - slope * dist; tmax = fmaxf(tmax, val[j]); }
            tmax = fmaxf(tmax, __shfl_xor(tmax, 16)); tmax = fmaxf(tmax, __shfl_xor(tmax, 32));
            const float m_new = fmaxf(m_run, tmax);
            const float scale = __expf(m_run - m_new);
            l_run *= scale;
#pragma unroll
            for (int i = 0; i < 8; ++i) o[i] *= scale;
            float pv[8];
#pragma unroll
            for (int j = 0; j < 8; ++j) { pv[j] = __expf(val[j] - m_new); l_run += pv[j]; }
            m_run = m_new;
            u32x4 pk; pk.x = cvt_pk_bf16(pv[0], pv[1]); pk.y = cvt_pk_bf16(pv[2], pv[3]); pk.z = cvt_pk_bf16(pv[4], pv[5]); pk.w = cvt_pk_bf16(pv[6], pv[7]);
            const bf16x8 pf = __builtin_bit_cast(bf16x8, pk);
            s16x4 tr[8][2];
            TR8(tr[0][0], tr[0][1], tr[1][0], tr[1][1], tr[2][0], tr[2][1], tr[3][0], tr[3][1], tr_addr[0][0], tr_addr[0][1], tr_addr[1][0], tr_addr[1][1], tr_addr[2][0], tr_addr[2][1], tr_addr[3][0], tr_addr[3][1]);
            TR8(tr[4][0], tr[4][1], tr[5][0], tr[5][1], tr[6][0], tr[6][1], tr[7][0], tr[7][1], tr_addr[4][0], tr_addr[4][1], tr_addr[5][0], tr_addr[5][1], tr_addr[6][0], tr_addr[6][1], tr_addr[7][0], tr_addr[7][1]);
#pragma unroll
            for (int cc = 0; cc < 8; ++cc) {
                bf16x8 kf; kf[0] = tr[cc][0][0]; kf[1] = tr[cc][0][1]; kf[2] = tr[cc][0][2]; kf[3] = tr[cc][0][3]; kf[4] = tr[cc][1][0]; kf[5] = tr[cc][1][1]; kf[6] = tr[cc][1][2]; kf[7] = tr[cc][1][3];
                o[cc] = MFMA16(kf, pf, o[cc]);
            }
        }
        float lt = l_run; lt += __shfl_xor(lt, 16); lt += __shfl_xor(lt, 32);
        const float inv = 1.f / lt;
        if (fr < 8) {
#pragma unroll
            for (int cc = 0; cc < 8; ++cc) { u32x2 ov; ov.x = cvt_pk_bf16(o[cc][0] * inv, o[cc][1] * inv); ov.y = cvt_pk_bf16(o[cc][2] * inv, o[cc][3] * inv);
                *(u32x2*)(mix + (size_t)q * KMIX + 512 + fr * 128 + 16 * cc + 4 * fq) = ov; }
        }
    }
}
typedef float f2 __attribute__((ext_vector_type(2)));
#ifndef PEER_FP8_MASK
#define PEER_FP8_MASK 3
#endif
constexpr float U_SCALE = 64.f, V_SCALE = 8.f;
DI unsigned pack4_fp8(float a, float b, float c, float d) { int p = __builtin_amdgcn_cvt_pk_fp8_f32(a, b, 0, false); p = __builtin_amdgcn_cvt_pk_fp8_f32(c, d, p, true); return (unsigned)p; }
DI void conv_chunk_fp8(const float* __restrict__ src, unsigned char* __restrict__ dst, size_t i0, int n16, float sc) {
    for (int i = opq_tid(); i < n16; i += 256) {
        const float4* s4 = (const float4*)src + 4 * (i0 + i);
        const float4 a = s4[0], b = s4[1], c = s4[2], d = s4[3];
        u32x4 o; o.x = pack4_fp8(a.x * sc, a.y * sc, a.z * sc, a.w * sc); o.y = pack4_fp8(b.x * sc, b.y * sc, b.z * sc, b.w * sc);
        o.z = pack4_fp8(c.x * sc, c.y * sc, c.z * sc, c.w * sc); o.w = pack4_fp8(d.x * sc, d.y * sc, d.z * sc, d.w * sc);
        ((u32x4*)dst)[i0 + i] = o;
    }
}
#ifndef PEER_FP6_MASK
#define PEER_FP6_MASK 3
#endif
#ifndef FP6_INTERLEAVED
#define FP6_INTERLEAVED 1
#endif
typedef unsigned u32x6 __attribute__((ext_vector_type(6)));
typedef float f32x16 __attribute__((ext_vector_type(16)));
typedef float f32x32 __attribute__((ext_vector_type(32)));
struct __attribute__((packed, aligned(4))) U3 { unsigned x, y, z; };
constexpr float U_SCALE6 = 32.f, V_SCALE6 = 4.f;
DI void conv_chunk_fp6(const float* __restrict__ src, unsigned char* __restrict__ dst, size_t g0, int n32, float sc) {
    for (int i = opq_tid(); i < n32; i += 256) {
        const float4* s4 = (const float4*)src + 8 * (g0 + i);
        float v[32];
#pragma unroll
        for (int q = 0; q < 8; ++q) { const float4 t = s4[q]; v[4 * q] = t.x * sc; v[4 * q + 1] = t.y * sc; v[4 * q + 2] = t.z * sc; v[4 * q + 3] = t.w * sc; }
        f32x16 a, b;
#pragma unroll
        for (int k = 0; k < 16; ++k) { a[k] = FP6_INTERLEAVED ? v[2 * k] : v[k]; b[k] = FP6_INTERLEAVED ? v[2 * k + 1] : v[16 + k]; }
        const u32x6 o = __builtin_amdgcn_cvt_scalef32_2xpk16_fp6_f32(a, b, 1.0f);
        unsigned* d = (unsigned*)(dst + (g0 + i) * 24);
        u32x2 o0, o1, o2; o0.x = o[0]; o0.y = o[1]; o1.x = o[2]; o1.y = o[3]; o2.x = o[4]; o2.y = o[5];
        *(u32x2*)d = o0; *(u32x2*)(d + 2) = o1; *(u32x2*)(d + 4) = o2;
    }
}
#ifndef PEER_FP4_MASK
#define PEER_FP4_MASK 3
#endif
constexpr float U_SCALE4 = 56.f, V_SCALE4 = 5.8333333f;
DI unsigned pack8_fp4(const float4 a, const float4 b, float sc) {
    unsigned o = 0;
    o = __builtin_amdgcn_cvt_scalef32_pk_fp4_f32(o, a.x * sc, a.y * sc, 1.0f, 0);
    o = __builtin_amdgcn_cvt_scalef32_pk_fp4_f32(o, a.z * sc, a.w * sc, 1.0f, 1);
    o = __builtin_amdgcn_cvt_scalef32_pk_fp4_f32(o, b.x * sc, b.y * sc, 1.0f, 2);
    o = __builtin_amdgcn_cvt_scalef32_pk_fp4_f32(o, b.z * sc, b.w * sc, 1.0f, 3);
    return o;
}
DI void conv_chunk_fp4(const float* __restrict__ src, unsigned char* __restrict__ dst, size_t g0, int n32, float sc) {
    for (int i = opq_tid(); i < n32; i += 256) {
        const float4* s4 = (const float4*)src + 8 * (g0 + i);
        float4 t[8];
#pragma unroll
        for (int q = 0; q < 8; ++q) t[q] = s4[q];
        u32x4 o; o.x = pack8_fp4(t[0], t[1], sc); o.y = pack8_fp4(t[2], t[3], sc); o.z = pack8_fp4(t[4], t[5], sc); o.w = pack8_fp4(t[6], t[7], sc);
        ((u32x4*)dst)[g0 + i] = o;
    }
}
struct PeerLds2 {
    float trans[4][1024];
    unsigned char li[4][2][64][16];
    unsigned short pe[4][8][128];
    float pg[4][8][128];
};
template <int OFF, int NK>
DI void sort16_desc(unsigned (&k)[NK]) {
#pragma unroll
    for (int size = 2; size <= 16; size <<= 1)
#pragma unroll
        for (int stride = size >> 1; stride > 0; stride >>= 1)
#pragma unroll
            for (int i = 0; i < 16; ++i) {
                const int j = i ^ stride;
                if (j > i) {
                    const bool desc = ((i & size) == 0);
                    const unsigned a = k[OFF + i], b = k[OFF + j];
                    const unsigned hi = a > b ? a : b, lo = a > b ? b : a;
                    k[OFF + i] = desc ? hi : lo; k[OFF + j] = desc ? lo : hi;
                }
            }
}
template <int OA, int OB, int NK>
DI void merge_top16(unsigned (&k)[NK]) {
#pragma unroll
    for (int i = 0; i < 16; ++i) { const unsigned a = k[OA + i], b = k[OB + 15 - i]; k[OA + i] = a > b ? a : b; }
#pragma unroll
    for (int stride = 8; stride > 0; stride >>= 1)
#pragma unroll
        for (int i = 0; i < 16; ++i) {
            const int j = i ^ stride;
            if (j > i) { const unsigned a = k[OA + i], b = k[OA + j]; k[OA + i] = a > b ? a : b; k[OA + j] = a > b ? b : a; }
        }
}
DI void peer_retrieve(const Params& p, int l, int tok0, PeerLds2& S, int lane, int wave) {
    const int fr = lane & 15, fq = lane >> 4;
    const bf16* QP = (const bf16*)(wsb(p) + WS_PROJ);
    const bf16* PK = (const bf16*)(wsb(p) + WS_PK) + (size_t)l * 2 * 128 * 64;
    float* trans = S.trans[wave];
    unsigned K1[16], K2[16];
#pragma unroll
    for (int L = 0; L < 2; ++L) {
        f32x4 acc[4][8];
#pragma unroll
        for (int ct = 0; ct < 4; ++ct)
#pragma unroll
            for (int kt = 0; kt < 8; ++kt) acc[ct][kt] = (f32x4){0, 0, 0, 0};
#pragma unroll
        for (int kt = 0; kt < 8; ++kt) {
            const bf16* krow = PK + (size_t)L * 8192 + (size_t)(16 * kt + fr) * 64 + 8 * fq;
            const bf16x8 a0 = ld16(krow), a1 = ld16(krow + 32);
#pragma unroll
            for (int ct = 0; ct < 4; ++ct) {
                const bf16* qrow = QP + (size_t)(tok0 + 2 * ct + (fr >> 3)) * 1024 + 128 * (fr & 7) + 64 * L + 8 * fq;
                acc[ct][kt] = MFMA16(a0, ld16(qrow), acc[ct][kt]); acc[ct][kt] = MFMA16(a1, ld16(qrow + 32), acc[ct][kt]);
            }
        }
        unsigned k[128];
#define PEER_ROUND(kt)                                                                                                                            \
        {                                                                                                                                         \
            _Pragma("unroll") for (int ct = 0; ct < 4; ++ct) *(f32x4*)(trans + ((ct * 4 + fq) * 16 + fr) * 4) = acc[ct][kt];                       \
            _Pragma("unroll") for (int sq = 0; sq < 4; ++sq) {                                                                                     \
                const f32x4 v = *(const f32x4*)(trans + ((fq * 4 + sq) * 16 + fr) * 4);                                                            \
                _Pragma("unroll") for (int i = 0; i < 4; ++i) k[16 * (kt) + sq * 4 + i] = (fkey(v[i]) & ~0x7fu) | (unsigned)(16 * (kt) + 4 * sq + i); \
            }                                                                                                                                     \
            sort16_desc<16 * (kt)>(k);                                                                                                            \
        }
        PEER_ROUND(0) PEER_ROUND(1) merge_top16<0, 16>(k);
        PEER_ROUND(2) PEER_ROUND(3) merge_top16<32, 48>(k); merge_top16<0, 32>(k);
        PEER_ROUND(4) PEER_ROUND(5) merge_top16<64, 80>(k);
        PEER_ROUND(6) PEER_ROUND(7) merge_top16<96, 112>(k); merge_top16<64, 96>(k);
        merge_top16<0, 64>(k);
#undef PEER_ROUND
        u32x4 ib;
        ib.x = (k[0] & 127u) | ((k[1] & 127u) << 8) | ((k[2] & 127u) << 16) | ((k[3] & 127u) << 24);
        ib.y = (k[4] & 127u) | ((k[5] & 127u) << 8) | ((k[6] & 127u) << 16) | ((k[7] & 127u) << 24);
        ib.z = (k[8] & 127u) | ((k[9] & 127u) << 8) | ((k[10] & 127u) << 16) | ((k[11] & 127u) << 24);
        ib.w = (k[12] & 127u) | ((k[13] & 127u) << 8) | ((k[14] & 127u) << 16) | ((k[15] & 127u) << 24);
        *(u32x4*)(S.li[wave][L][lane]) = ib;
#pragma unroll
        for (int i = 0; i < 16; ++i) { if (L == 0) K1[i] = k[i]; else K2[i] = k[i]; }
    }
    float v1[16], v2[16];
#pragma unroll
    for (int i = 0; i < 16; ++i) { v1[i] = __uint_as_float(unkey(K1[i] & ~0x7fu)); v2[i] = __uint_as_float(unkey(K2[i] & ~0x7fu)); }
    unsigned c[64];
    {
        int idx = 0;
#pragma unroll
        for (int a = 0; a < 16; ++a)
#pragma unroll
            for (int b = 0; b < 16; ++b)
                if ((a + 1) * (b + 1) <= 16) { c[idx] = (fkey(v1[a] + v2[b]) & ~0xffu) | (unsigned)(a * 16 + b); ++idx; }
#pragma unroll
        for (int i = 50; i < 64; ++i) c[i] = 0u;
    }
    sort16_desc<0>(c); sort16_desc<16>(c); sort16_desc<32>(c); sort16_desc<48>(c);
    merge_top16<0, 16>(c); merge_top16<32, 48>(c); merge_top16<0, 32>(c);
    float sc[16]; float sum = 0.f;
    {
        const float m = __uint_as_float(unkey(c[0] & ~0xffu));
#pragma unroll
        for (int i = 0; i < 16; ++i) { sc[i] = __expf(__uint_as_float(unkey(c[i] & ~0xffu)) - m); sum += sc[i]; }
    }
    const float inv = 1.f / sum;
    const int tt = 2 * fq + (fr >> 3), head = fr & 7;
    const unsigned char* l1 = S.li[wave][0][lane]; const unsigned char* l2 = S.li[wave][1][lane];
#pragma unroll
    for (int i = 0; i < 16; ++i) {
        const unsigned ab = c[i] & 0xffu;
        const unsigned e = (unsigned)l1[ab >> 4] * 128u + (unsigned)l2[ab & 15u];
        S.pe[wave][tt][head * 16 + i] = (unsigned short)e; S.pg[wave][tt][head * 16 + i] = sc[i] * inv;
    }
}
template <int FMT>
DI void peer_experts(const Params& p, int l, int tok, int tt, PeerLds2& S, int lane, int wave) {
    const bf16* H = (const bf16*)(wsb(p) + WS_H);
    const unsigned char* UB = wsb(p) + WS_UB; const unsigned char* VB = wsb(p) + WS_VB;
    const float* X = (const float*)(wsb(p) + WS_X);
    const float* modl = (const float*)(wsb(p) + WS_MOD) + (size_t)l * 4 * 6144;
    const int b = tok >> 12;
    const unsigned short* pe = S.pe[wave][tt]; const float* pg = S.pg[wave][tt];
    f2 hp[8];
    u32x4 h0, h1;
    {
        h0 = *(const u32x4*)(H + (size_t)tok * 1024 + 16 * lane); h1 = *(const u32x4*)(H + (size_t)tok * 1024 + 16 * lane + 8);
        hp[0] = (f2){bflo(h0.x), bfhi(h0.x)}; hp[1] = (f2){bflo(h0.y), bfhi(h0.y)}; hp[2] = (f2){bflo(h0.z), bfhi(h0.z)}; hp[3] = (f2){bflo(h0.w), bfhi(h0.w)};
        hp[4] = (f2){bflo(h1.x), bfhi(h1.x)}; hp[5] = (f2){bflo(h1.y), bfhi(h1.y)}; hp[6] = (f2){bflo(h1.z), bfhi(h1.z)}; hp[7] = (f2){bflo(h1.w), bfhi(h1.w)};
    }
    f2 acc[8];
#pragma unroll
    for (int i = 0; i < 8; ++i) acc[i] = (f2){0.f, 0.f};
    const bool b5 = (lane & 32) != 0, b4_ = (lane & 16) != 0, b3 = (lane & 8) != 0;
    const int eidx = (b3 ? 4 : 0) + (b4_ ? 2 : 0) + (b5 ? 1 : 0);
    if constexpr (FMT == 1) {
    for (int e0 = 0; e0 < 128; e0 += 8) {
        u32x4 ur[8], vr[8];
#pragma unroll
        for (int j = 0; j < 8; ++j) {
            const int e = __builtin_amdgcn_readfirstlane((int)pe[e0 + j]);
            ur[j] = *(const u32x4*)(UB + (size_t)e * 1024 + 16 * lane);
            vr[j] = *(const u32x4*)(VB + (size_t)e * 1024 + 16 * lane);
        }
        float d[8];
#pragma unroll
        for (int j = 0; j < 8; ++j) {
            f2 s2 = {0.f, 0.f};
#pragma unroll
            for (int k = 0; k < 4; ++k) {
                const f2 lo = __builtin_amdgcn_cvt_pk_f32_fp8((int)ur[j][k], false), hi = __builtin_amdgcn_cvt_pk_f32_fp8((int)ur[j][k], true);
                s2 = lo * hp[2 * k] + s2; s2 = hi * hp[2 * k + 1] + s2;
            }
            d[j] = s2.x + s2.y;
        }
        float w[4], x2[2], y;
#pragma unroll
        for (int i = 0; i < 4; ++i) { const float keep = b5 ? d[2 * i + 1] : d[2 * i], send = b5 ? d[2 * i] : d[2 * i + 1]; w[i] = keep + __shfl_xor(send, 32); }
#pragma unroll
        for (int i = 0; i < 2; ++i) { const float keep = b4_ ? w[2 * i + 1] : w[2 * i], send = b4_ ? w[2 * i] : w[2 * i + 1]; x2[i] = keep + __shfl_xor(send, 16); }
        { const float keep = b3 ? x2[1] : x2[0], send = b3 ? x2[0] : x2[1]; y = keep + __shfl_xor(send, 8); }
        y += __shfl_xor(y, 4); y += __shfl_xor(y, 2); y += __shfl_xor(y, 1);
        const float sc = gelu_tanh(y * (1.f / U_SCALE)) * pg[e0 + eidx] * (1.f / V_SCALE);
#pragma unroll
        for (int j = 0; j < 8; ++j) {
            const float sj = __uint_as_float((unsigned)__builtin_amdgcn_readlane((int)__float_as_uint(sc), 32 * (j & 1) + 16 * ((j >> 1) & 1) + 8 * ((j >> 2) & 1)));
            const f2 sj2 = {sj, sj};
#pragma unroll
            for (int k = 0; k < 4; ++k) {
                const f2 lo = __builtin_amdgcn_cvt_pk_f32_fp8((int)vr[j][k], false), hi = __builtin_amdgcn_cvt_pk_f32_fp8((int)vr[j][k], true);
                acc[2 * k] = lo * sj2 + acc[2 * k]; acc[2 * k + 1] = hi * sj2 + acc[2 * k + 1];
            }
        }
    }
    } else if constexpr (FMT == 3) {
    for (int e0 = 0; e0 < 128; e0 += 8) {
        u32x2 ur[8], vr[8];
#pragma unroll
        for (int j = 0; j < 8; ++j) {
            const int e = __builtin_amdgcn_readfirstlane((int)pe[e0 + j]);
            ur[j] = *(const u32x2*)(UB + (size_t)e * 512 + 8 * lane);
            vr[j] = *(const u32x2*)(VB + (size_t)e * 512 + 8 * lane);
        }
        float d[8];
#pragma unroll
        for (int j = 0; j < 8; ++j) {
            f2 s2 = {0.f, 0.f};
#define FP4_DOT(k) s2 = __builtin_amdgcn_cvt_scalef32_pk_f32_fp4(ur[j].x, 1.0f, k) * hp[k] + s2; s2 = __builtin_amdgcn_cvt_scalef32_pk_f32_fp4(ur[j].y, 1.0f, k) * hp[4 + k] + s2;
            FP4_DOT(0) FP4_DOT(1) FP4_DOT(2) FP4_DOT(3)
#undef FP4_DOT
            d[j] = s2.x + s2.y;
        }
        float w[4], x2[2], y;
#pragma unroll
        for (int i = 0; i < 4; ++i) { const float keep = b5 ? d[2 * i + 1] : d[2 * i], send = b5 ? d[2 * i] : d[2 * i + 1]; w[i] = keep + __shfl_xor(send, 32); }
#pragma unroll
        for (int i = 0; i < 2; ++i) { const float keep = b4_ ? w[2 * i + 1] : w[2 * i], send = b4_ ? w[2 * i] : w[2 * i + 1]; x2[i] = keep + __shfl_xor(send, 16); }
        { const float keep = b3 ? x2[1] : x2[0], send = b3 ? x2[0] : x2[1]; y = keep + __shfl_xor(send, 8); }
        y += __shfl_xor(y, 4); y += __shfl_xor(y, 2); y += __shfl_xor(y, 1);
        const float sc = gelu_tanh(y * (1.f / U_SCALE4)) * pg[e0 + eidx] * (1.f / V_SCALE4);
#pragma unroll
        for (int j = 0; j < 8; ++j) {
            const float sj = __uint_as_float((unsigned)__builtin_amdgcn_readlane((int)__float_as_uint(sc), 32 * (j & 1) + 16 * ((j >> 1) & 1) + 8 * ((j >> 2) & 1)));
            const f2 sj2 = {sj, sj};
#define FP4_AXPY(k) acc[k] = __builtin_amdgcn_cvt_scalef32_pk_f32_fp4(vr[j].x, 1.0f, k) * sj2 + acc[k]; acc[4 + k] = __builtin_amdgcn_cvt_scalef32_pk_f32_fp4(vr[j].y, 1.0f, k) * sj2 + acc[4 + k];
            FP4_AXPY(0) FP4_AXPY(1) FP4_AXPY(2) FP4_AXPY(3)
#undef FP4_AXPY
        }
    }
    } else if constexpr (FMT == 2) {
    for (int e0 = 0; e0 < 128; e0 += 8) {
        U3 ur[8], vr[8];
#pragma unroll
        for (int j = 0; j < 8; ++j) {
            const int e = __builtin_amdgcn_readfirstlane((int)pe[e0 + j]);
            ur[j] = *(const U3*)(UB + (size_t)e * 768 + 12 * lane);
            vr[j] = *(const U3*)(VB + (size_t)e * 768 + 12 * lane);
        }
        float d[8];
#pragma unroll
        for (int jp = 0; jp < 4; ++jp) {
            u32x6 pk; pk[0] = ur[2 * jp].x; pk[1] = ur[2 * jp].y; pk[2] = ur[2 * jp].z; pk[3] = ur[2 * jp + 1].x; pk[4] = ur[2 * jp + 1].y; pk[5] = ur[2 * jp + 1].z;
            const f32x32 o = __builtin_amdgcn_cvt_scalef32_pk32_f32_fp6(pk, 1.0f);
            f2 s0 = {0.f, 0.f}, s1 = {0.f, 0.f};
#pragma unroll
            for (int k = 0; k < 8; ++k) { const f2 ua = {o[2 * k], o[2 * k + 1]}, ub = {o[16 + 2 * k], o[17 + 2 * k]}; s0 = ua * hp[k] + s0; s1 = ub * hp[k] + s1; }
            d[2 * jp] = s0.x + s0.y; d[2 * jp + 1] = s1.x + s1.y;
        }
        float w[4], x2[2], y;
#pragma unroll
        for (int i = 0; i < 4; ++i) { const float keep = b5 ? d[2 * i + 1] : d[2 * i], send = b5 ? d[2 * i] : d[2 * i + 1]; w[i] = keep + __shfl_xor(send, 32); }
#pragma unroll
        for (int i = 0; i < 2; ++i) { const float keep = b4_ ? w[2 * i + 1] : w[2 * i], send = b4_ ? w[2 * i] : w[2 * i + 1]; x2[i] = keep + __shfl_xor(send, 16); }
        { const float keep = b3 ? x2[1] : x2[0], send = b3 ? x2[0] : x2[1]; y = keep + __shfl_xor(send, 8); }
        y += __shfl_xor(y, 4); y += __shfl_xor(y, 2); y += __shfl_xor(y, 1);
        const float sc = gelu_tanh(y * (1.f / U_SCALE6)) * pg[e0 + eidx] * (1.f / V_SCALE6);
#pragma unroll
        for (int jp = 0; jp < 4; ++jp) {
            u32x6 pk; pk[0] = vr[2 * jp].x; pk[1] = vr[2 * jp].y; pk[2] = vr[2 * jp].z; pk[3] = vr[2 * jp + 1].x; pk[4] = vr[2 * jp + 1].y; pk[5] = vr[2 * jp + 1].z;
            const f32x32 o = __builtin_amdgcn_cvt_scalef32_pk32_f32_fp6(pk, 1.0f);
            const int ja = 2 * jp, jb = 2 * jp + 1;
            const float sa = __uint_as_float((unsigned)__builtin_amdgcn_readlane((int)__float_as_uint(sc), 32 * (ja & 1) + 16 * ((ja >> 1) & 1) + 8 * ((ja >> 2) & 1)));
            const float sb = __uint_as_float((unsigned)__builtin_amdgcn_readlane((int)__float_as_uint(sc), 32 * (jb & 1) + 16 * ((jb >> 1) & 1) + 8 * ((jb >> 2) & 1)));
            const f2 sa2 = {sa, sa}, sb2 = {sb, sb};
#pragma unroll
            for (int i = 0; i < 8; ++i) { const f2 va = {o[2 * i], o[2 * i + 1]}, vb = {o[16 + 2 * i], o[17 + 2 * i]}; acc[i] = va * sa2 + acc[i]; acc[i] = vb * sb2 + acc[i]; }
        }
    }
    } else {
    for (int e0 = 0; e0 < 128; e0 += 4) {
        const bf16* UBb = (const bf16*)UB; const bf16* VBb = (const bf16*)VB;
        u32x4 ur[4][2], vr[4][2];
#pragma unroll
        for (int j = 0; j < 4; ++j) {
            const int e = __builtin_amdgcn_readfirstlane((int)pe[e0 + j]);
            ur[j][0] = *(const u32x4*)(UBb + (size_t)e * 1024 + 16 * lane); ur[j][1] = *(const u32x4*)(UBb + (size_t)e * 1024 + 16 * lane + 8);
            vr[j][0] = *(const u32x4*)(VBb + (size_t)e * 1024 + 16 * lane); vr[j][1] = *(const u32x4*)(VBb + (size_t)e * 1024 + 16 * lane + 8);
        }
        float d[4];
#pragma unroll
        for (int j = 0; j < 4; ++j) {
            float sa = 0.f, sb = 0.f;
            sa = dot2bf(ur[j][0].x, h0.x, sa); sb = dot2bf(ur[j][0].y, h0.y, sb); sa = dot2bf(ur[j][0].z, h0.z, sa); sb = dot2bf(ur[j][0].w, h0.w, sb);
            sa = dot2bf(ur[j][1].x, h1.x, sa); sb = dot2bf(ur[j][1].y, h1.y, sb); sa = dot2bf(ur[j][1].z, h1.z, sa); sb = dot2bf(ur[j][1].w, h1.w, sb);
            d[j] = sa + sb;
        }
        float w[2], y;
#pragma unroll
        for (int i = 0; i < 2; ++i) { const float keep = b5 ? d[2 * i + 1] : d[2 * i], send = b5 ? d[2 * i] : d[2 * i + 1]; w[i] = keep + __shfl_xor(send, 32); }
        { const float keep = b4_ ? w[1] : w[0], send = b4_ ? w[0] : w[1]; y = keep + __shfl_xor(send, 16); }
        y += __shfl_xor(y, 8); y += __shfl_xor(y, 4); y += __shfl_xor(y, 2); y += __shfl_xor(y, 1);
        const float sc = gelu_tanh(y) * pg[e0 + (b4_ ? 2 : 0) + (b5 ? 1 : 0)];
#pragma unroll
        for (int j = 0; j < 4; ++j) {
            const float sj = __uint_as_float((unsigned)__builtin_amdgcn_readlane((int)__float_as_uint(sc), 32 * (j & 1) + 16 * ((j >> 1) & 1)));
            const f2 sj2 = {sj, sj};
#pragma unroll
            for (int hh = 0; hh < 2; ++hh)
#pragma unroll
                for (int k = 0; k < 4; ++k) { const unsigned dw = vr[j][hh][k]; const f2 vv = {bflo(dw), bfhi(dw)}; acc[4 * hh + k] = vv * sj2 + acc[4 * hh + k]; }
        }
    }
    }
    float xr[16];
    const float* xrow = X + (size_t)tok * 1024 + 16 * lane;
    float* xorow = p.out + (size_t)tok * 1024 + 16 * lane;
    const float* g2 = modl + (size_t)b * 6144 + 5 * 1024 + 16 * lane;
    float ss = 0;
#pragma unroll
    for (int q4 = 0; q4 < 4; ++q4) {
        const float4 xv = *(const float4*)(xrow + 4 * q4), gv = *(const float4*)(g2 + 4 * q4);
        float4 o; o.x = xv.x + gv.x * acc[2 * q4].x; o.y = xv.y + gv.y * acc[2 * q4].y; o.z = xv.z + gv.z * acc[2 * q4 + 1].x; o.w = xv.w + gv.w * acc[2 * q4 + 1].y;
        if (l == 0) *(float4*)(xorow + 4 * q4) = o;
        xr[4 * q4] = o.x; xr[4 * q4 + 1] = o.y; xr[4 * q4 + 2] = o.z; xr[4 * q4 + 3] = o.w;
        ss += o.x * o.x + o.y * o.y + o.z * o.z + o.w * o.w;
    }
    ss = wave_sum(ss);
    const float r = rsqrtf(ss * (1.f / 1024.f) + 1e-6f);
    if (l == 1) {
#pragma unroll
        for (int q4 = 0; q4 < 4; ++q4) {
            const float4 gv = *(const float4*)(p.in[28] + 16 * lane + 4 * q4);
            float4 o; o.x = xr[4 * q4] * r * gv.x; o.y = xr[4 * q4 + 1] * r * gv.y; o.z = xr[4 * q4 + 2] * r * gv.z; o.w = xr[4 * q4 + 3] * r * gv.w;
            *(float4*)(xorow + 4 * q4) = o;
        }
    } else {
        const float* g = p.in[2] + 1024 + 16 * lane; const float* mod1 = (const float*)(wsb(p) + WS_MOD) + ((size_t)4 + b) * 6144 + 16 * lane;
        bf16* hrow = (bf16*)(wsb(p) + WS_H2) + (size_t)tok * 1024 + 16 * lane;
        float hv[16];
#pragma unroll
        for (int q4 = 0; q4 < 4; ++q4) {
            const float4 gg = *(const float4*)(g + 4 * q4), s1 = *(const float4*)(mod1 + 1024 + 4 * q4), s0 = *(const float4*)(mod1 + 4 * q4);
            hv[4 * q4] = xr[4 * q4] * r * gg.x * (1.f + s1.x) + s0.x; hv[4 * q4 + 1] = xr[4 * q4 + 1] * r * gg.y * (1.f + s1.y) + s0.y;
            hv[4 * q4 + 2] = xr[4 * q4 + 2] * r * gg.z * (1.f + s1.z) + s0.z; hv[4 * q4 + 3] = xr[4 * q4 + 3] * r * gg.w * (1.f + s1.w) + s0.w;
        }
        u32x4 o0, o1;
        o0.x = cvt_pk_bf16(hv[0], hv[1]); o0.y = cvt_pk_bf16(hv[2], hv[3]); o0.z = cvt_pk_bf16(hv[4], hv[5]); o0.w = cvt_pk_bf16(hv[6], hv[7]);
        o1.x = cvt_pk_bf16(hv[8], hv[9]); o1.y = cvt_pk_bf16(hv[10], hv[11]); o1.z = cvt_pk_bf16(hv[12], hv[13]); o1.w = cvt_pk_bf16(hv[14], hv[15]);
        *(u32x4*)(hrow) = o0; *(u32x4*)(hrow + 8) = o1;
    }
}

constexpr int SMEM_BYTES = LDS_BYTES;
#ifndef REP_MASK
#define REP_MASK 0xffff
#endif
#ifndef REP_ID
#define REP_ID -1
#endif
#ifndef REP_N
#define REP_N 1
#endif
#define NREP(id) ((id) == REP_ID ? REP_N : 1)
__global__ void __launch_bounds__(512, 2) fwd_megakernel(Params p) {
    unsigned char* smem = g_lds;
    const int tid = threadIdx.x, half = __builtin_amdgcn_readfirstlane(tid >> 8);
    const int Gp = gridDim.x, bidp = blockIdx.x;
    const int G = Gp * 2, bid = bidp + half * Gp;
    unsigned char* sm = smem + half * 65536;
    volatile int* qslot = (volatile int*)(smem + LDS_CTL + 16) + half;
    if (tid < 64) ((unsigned*)(smem + LDS_CTL))[tid] = 0u;
    __syncthreads();
    unsigned* ctl = (unsigned*)(wsb(p) + WS_CTL);
    unsigned* qctr = ctl + 4096;
    XcdBarrier bar = xcd_barrier_post(ctl, (volatile LAS unsigned*)(smem + LDS_CTL));
#define PHASE_PTRS unsigned char* ws = wsb(p); const bf16* H = (const bf16*)(ws + WS_H); bf16* PROJ = (bf16*)(ws + WS_PROJ); float* X = (float*)(ws + WS_X); const float* mod = (const float*)(ws + WS_MOD); (void)H; (void)PROJ; (void)X; (void)mod;
    int qn = 0;

    for (int rep = 0; rep < NREP(0); ++rep) {
            PHASE_PTRS
        constexpr int N_MOD = 192, N_LAYER = 192 + 256 + 128 + 128 + 256 + 256 + 16, N_PK = 4, N_GW = 128, N_PW = 8;
        constexpr int NV = N_MOD + 2 * N_LAYER + N_PK + N_GW + N_PW;
        for (int vb = bid; vb < NV; vb += G) {
            int v = vb;
            if (v < N_MOD) { it_mod(p, v, sm); continue; }
            v -= N_MOD;
            if (v < 2 * N_LAYER) {
                const int l = v / N_LAYER; v -= l * N_LAYER;
                bf16* wtin = (bf16*)(ws + WS_WTIN) + (size_t)l * NPROJ * 1024;
                const float* win = p.in[6] + (size_t)l * 1024 * 1732;
                bf16* wtout = (bf16*)(ws + WS_WTOUT) + (size_t)l * 1024 * KMIX;
                const float* wout = p.in[22] + (size_t)l * 1024 * 1024;
                if (v < 192) { it_transpose(TrArgs{win, 1732, 0, 1732, wtin, 1024, 0, 1024, 768, 0, nullptr}, v, sm); }
                else if ((v -= 192) < 256) { it_transpose(TrArgs{win, 1732, 0, 1732, wtin + (size_t)C_QA * 1024, 1024, 0, 1024, 1024, 1, p.in[20] + (size_t)l * 8 * 64 * 128}, v, sm); }
                else if ((v -= 256) < 128) { it_transpose(TrArgs{win, 1732, 1280, 1732, wtin + (size_t)C_CKV * 1024, 1024, 0, 1024, 512, 0, nullptr}, v, sm); }
                else if ((v -= 128) < 128) { it_transpose(TrArgs{wout, 1024, 0, 1024, wtout, KMIX, 0, 512, 1024, 0, nullptr}, v, sm); }
                else if ((v -= 128) < 256) { it_transpose(TrArgs{wout, 1024, 0, 1024, wtout, KMIX, 512, 1024, 1024, 2, p.in[21] + (size_t)l * 8 * 128 * 64}, v, sm); }
                else if ((v -= 256) < 256) { it_transpose(TrArgs{p.in[23] + (size_t)l * 1024 * 1024, 1024, 0, 1024, (bf16*)(ws + WS_WTQ) + (size_t)l * 1024 * 1024, 1024, 0, 1024, 1024, 0, nullptr}, v, sm); }
                else { v -= 256; it_transpose(TrArgs{p.in[15] + (size_t)l * 256 * 256, 256, 0, 256, (bf16*)(ws + WS_WTGLU) + (size_t)l * 256 * 256, 256, 0, 256, 256, 0, nullptr}, v, sm); }
                continue;
            }
            v -= 2 * N_LAYER;
            if (v < N_PK) { const int l = v >> 1, w = v & 1; conv_chunk(p.in[24 + w] + (size_t)l * 8192, (bf16*)(ws + WS_PK) + (size_t)l * 16384 + w * 8192, 0, 1024); continue; }
            v -= N_PK;
            if (v < N_GW) { it_gw(p, v); continue; }
            v -= N_GW;
            it_ssm_pw(p, v);
        }
        xcd_barrier(bar);
    }
    for (int rep = 0; rep < NREP(1); ++rep) {
            PHASE_PTRS
        constexpr int N_NORM = NTOK / 4, N_TAB = 4096, N_KT = 256;
        for (int vb = bid; vb < N_NORM + N_TAB + N_KT; vb += G) {
            if (vb < N_KT) { it_ssm_kt(p, vb, sm); continue; }
            if (vb - N_KT < N_NORM) {
                const int t_ = opq_tid(); const int row = (vb - N_KT) * 4 + (t_ >> 6);
                const float* m0 = (const float*)(wsb(p) + WS_MOD) + (size_t)(row >> 12) * 6144;
                norm_mod_row(p.in[0] + (size_t)row * 1024, p.in[2], m0, m0 + 1024, (bf16*)(wsb(p) + WS_H) + (size_t)row * 1024, t_ & 63);
            } else {
                const size_t base = (size_t)(vb - N_KT - N_NORM) * 2048;
                const int t_ = opq_tid();
#pragma unroll
                for (int e = 0; e < 8; ++e) ssm_tab_entry(p, base + e * 256 + t_);
            }
        }
        xcd_barrier(bar);
    }

    for (int l = 0; l < 2; ++l) {
        const float* xin = l == 0 ? p.in[0] : p.out;
        for (int rep = 0; rep < NREP(2 + 8 * l); ++rep) {
            PHASE_PTRS
            const bf16* Hin = l == 0 ? H : (const bf16*)(ws + WS_H2);
            pg8::StaticOrder S; S.init(NTOK, 2048, Gp, bidp);
            pg8::gemm_phase<Epi256<EpiBf16>, pg8::StaticOrder, true, true>((PG8_LAS unsigned char*)g_lds, pg8::Gemm{Hin, (const bf16*)(ws + WS_WTIN) + (size_t)l * NPROJ * 1024, NTOK, 2048, 1024}, S, Epi256<EpiBf16>{EpiBf16{PROJ, NPROJ}});
            xcd_barrier(bar);
        }
        for (int rep = 0; rep < NREP(3 + 8 * l); ++rep) {
            PHASE_PTRS
            {
                const bf16* Hin = l == 0 ? H : (const bf16*)(ws + WS_H2);
                pg8::StaticOrder S; S.init(NTOK, 256, Gp, bidp);
                pg8::gemm_phase<Epi256<EpiBf16>, pg8::StaticOrder, false, true>((PG8_LAS unsigned char*)g_lds, pg8::Gemm{Hin, (const bf16*)(ws + WS_WTIN) + ((size_t)l * NPROJ + 2048) * 1024, NTOK, 256, 1024}, S, Epi256<EpiBf16>{EpiBf16{PROJ + 2048, NPROJ}});
            }
            unsigned* ctr = qctr + 64 * (qn++);
            for (;;) {
                const int it = q_next(ctr, qslot);
                if (it >= 2048) break;
                const bool extra = rep + 1 < NREP(3 + 8 * l);
                const int ty = it < 1024 ? 0 : it < 1536 ? 1 : it < 1792 ? 2 : 3;
                if (extra && !((REP_MASK >> ty) & 1)) continue;
                if (it < 1024) it_dsa_index_select(p, it, sm, extra ? ((REP_MASK >> 4) & 31) : 3);
                else if (it < 1536) it_gmlp(p, l, it - 1024, sm);
                else if (it < 1792) it_ssm_a(p, l, it - 1536);
                else it_kvn(p, l, it - 1792);
            }
            xcd_barrier(bar);
        }
        for (int rep = 0; rep < NREP(4 + 8 * l); ++rep) {
            PHASE_PTRS
            unsigned* ctr = qctr + 64 * (qn++);
            for (;;) {
                const int it = q_next(ctr, qslot);
                if (it >= 256 + 1024 + 512) break;
                { const bool extra = rep + 1 < NREP(4 + 8 * l); const int ty = it < 256 ? 0 : it < 1280 ? 1 : 2; if (extra && !((REP_MASK >> (8 + ty)) & 1)) continue; }
                if (it < 256) it_ssm_c(p, l, it, sm, (rep + 1 < NREP(4 + 8 * l)) ? ((REP_MASK >> 12) & 7) : 7);
                else if (it < 1280) it_dsa_attn(p, it - 256, sm);
                else {
                    const int v = it - 1280, w = v >> 8, ch = v & 255;
                    if (PEER_FP4_MASK & (1 << l)) conv_chunk_fp4(p.in[26 + w] + (size_t)l * NEXP * 1024, ws + (w ? WS_VB : WS_UB), (size_t)ch * 2048, 2048, w ? V_SCALE4 : U_SCALE4);
                    else if (PEER_FP6_MASK & (1 << l)) conv_chunk_fp6(p.in[26 + w] + (size_t)l * NEXP * 1024, ws + (w ? WS_VB : WS_UB), (size_t)ch * 2048, 2048, w ? V_SCALE6 : U_SCALE6);
                    else if (!(PEER_FP8_MASK & (1 << l))) conv_chunk(p.in[26 + w] + (size_t)l * NEXP * 1024, (bf16*)(ws + (w ? WS_VB : WS_UB)), (size_t)ch * 8192, 8192);
                    else conv_chunk_fp8(p.in[26 + w] + (size_t)l * NEXP * 1024, ws + (w ? WS_VB : WS_UB), (size_t)ch * 4096, 4096, w ? V_SCALE : U_SCALE);
                }
            }
            xcd_barrier(bar);
        }
        for (int rep = 0; rep < NREP(5 + 8 * l); ++rep) {
            PHASE_PTRS
            const EpiGlu epi{(const bf16*)(ws + WS_YG), p.in[16] + l * 256, (bf16*)(ws + WS_MIX)};
            const bf16* Bt = (const bf16*)(ws + WS_WTGLU) + (size_t)l * 256 * 256;
            for (int t = bid; t < (NTOK / 64) * 2; t += G) gemm_tile64((const bf16*)(ws + WS_YG), 256, Bt, 256, 256, (t >> 1) * 64, (t & 1) * 128, (bf16*)sm, epi);
            xcd_barrier(bar);
        }
        for (int rep = 0; rep < NREP(6 + 8 * l); ++rep) {
            PHASE_PTRS
            pg8::StaticOrder S; S.init(NTOK, 1024, Gp, bidp);
            pg8::gemm_phase<Epi256<EpiResid>, pg8::StaticOrder, false, true>((PG8_LAS unsigned char*)g_lds, pg8::Gemm{(const bf16*)(ws + WS_MIX), (const bf16*)(ws + WS_WTOUT) + (size_t)l * 1024 * KMIX, NTOK, 1024, KMIX}, S, Epi256<EpiResid>{EpiResid{xin, X, mod + (size_t)l * 4 * 6144 + 2048}});
            xcd_barrier(bar);
        }
        for (int rep = 0; rep < NREP(7 + 8 * l); ++rep) {
            PHASE_PTRS
            for (int vb = bid; vb < NTOK / 4; vb += G) {
                const int t_ = opq_tid(); const int row = vb * 4 + (t_ >> 6);
                const float* m0 = (const float*)(wsb(p) + WS_MOD) + ((size_t)l * 4 + (row >> 12)) * 6144 + 3072;
                norm_mod_row((const float*)(wsb(p) + WS_X) + (size_t)row * 1024, p.in[3] + l * 1024, m0, m0 + 1024, (bf16*)(wsb(p) + WS_H) + (size_t)row * 1024, t_ & 63);
            }
            xcd_barrier(bar);
        }
        for (int rep = 0; rep < NREP(8 + 8 * l); ++rep) {
            PHASE_PTRS
            pg8::StaticOrder S; S.init(NTOK, 1024, Gp, bidp);
            pg8::gemm_phase<Epi256<EpiBf16>, pg8::StaticOrder, false, true>((PG8_LAS unsigned char*)g_lds, pg8::Gemm{H, (const bf16*)(ws + WS_WTQ) + (size_t)l * 1024 * 1024, NTOK, 1024, 1024}, S, Epi256<EpiBf16>{EpiBf16{PROJ, 1024}});
            xcd_barrier(bar);
        }
        for (int rep = 0; rep < NREP(9 + 8 * l); ++rep) {
            PHASE_PTRS
            PeerLds2& S = *(PeerLds2*)sm;
            hsync();
            const int t_ = opq_tid(), lane_ = t_ & 63, wave_ = t_ >> 6;
            for (int wb = bid * 4 + wave_; wb < NTOK / 8; wb += G * 4) {
                peer_retrieve(p, l, wb * 8, S, lane_, wave_);
                for (int tt = 0; tt < 8; ++tt) {
                    if (PEER_FP4_MASK & (1 << l)) peer_experts<3>(p, l, wb * 8 + tt, tt, S, lane_, wave_);
                    else if (PEER_FP6_MASK & (1 << l)) peer_experts<2>(p, l, wb * 8 + tt, tt, S, lane_, wave_);
                    else if (PEER_FP8_MASK & (1 << l)) peer_experts<1>(p, l, wb * 8 + tt, tt, S, lane_, wave_);
                    else peer_experts<0>(p, l, wb * 8 + tt, tt, S, lane_, wave_);
                }
            }
            if (l == 0 || rep + 1 < NREP(9 + 8 * l)) xcd_barrier(bar);
        }
    }
}

extern "C" void kernel_launch(void* const* d_in, const int* in_sizes, int n_in, void* d_out, int out_size, void* d_ws, size_t ws_size, hipStream_t stream) {
    if (n_in != 29 || ws_size < WS_END) { fprintf(stderr, "kernel_launch: bad args (n_in %d, ws %zu, need %zu)\n", n_in, ws_size, (size_t)WS_END); return; }
    static int grid = 0;
    if (grid == 0) {
        int dev = 0, cus = 0, per_cu = 0;
        if (hipGetDevice(&dev) != hipSuccess || hipDeviceGetAttribute(&cus, hipDeviceAttributeMultiprocessorCount, dev) != hipSuccess) { grid = -1; return; }
        if (hipFuncSetAttribute((const void*)fwd_megakernel, hipFuncAttributeMaxDynamicSharedMemorySize, LDS_BYTES) != hipSuccess) { fprintf(stderr, "kernel_launch: hipFuncSetAttribute failed\n"); grid = -1; return; }
        if (hipOccupancyMaxActiveBlocksPerMultiprocessor(&per_cu, (const void*)fwd_megakernel, 512, LDS_BYTES) != hipSuccess || per_cu < 1) { fprintf(stderr, "kernel_launch: occupancy query failed (%d)\n", per_cu); grid = -1; return; }
        grid = cus;
    }
    if (grid < 0) return;
    if (hipMemsetAsync((char*)d_ws + WS_CTL, 0, 65536, stream) != hipSuccess) { fprintf(stderr, "kernel_launch: memset failed\n"); return; }
    Params p{};
    for (int i = 0; i < 29; ++i) p.in[i] = (const float*)d_in[i];
    p.out = (float*)d_out; p.ws = (unsigned char*)d_ws;
    void* args[] = {&p};
    const hipError_t e = hipLaunchCooperativeKernel((const void*)fwd_megakernel, dim3(grid), dim3(512), args, LDS_BYTES, stream);
    if (e != hipSuccess) fprintf(stderr, "kernel_launch: cooperative launch failed: %s (grid %d)\n", hipGetErrorString(e), grid);
}
```

```cpp
#include <hip/hip_runtime.h>
#include <cstdint>
#include <cstdio>

typedef unsigned short bf16;
typedef short bf16x8 __attribute__((ext_vector_type(8)));
typedef short s16x4 __attribute__((ext_vector_type(4)));
typedef float f32x4 __attribute__((ext_vector_type(4)));
typedef unsigned u32x4 __attribute__((ext_vector_type(4)));
typedef unsigned u32x2 __attribute__((ext_vector_type(2)));
typedef __bf16 bf2 __attribute__((ext_vector_type(2)));
#define DI __device__ __forceinline__
#define MFMA16(a, b, c) __builtin_amdgcn_mfma_f32_16x16x32_bf16((a), (b), (c), 0, 0, 0)

constexpr int DM = 1024, NB = 4, SEQ = 4096, NTOK = NB * SEQ;
constexpr int NPROJ = 2304;
constexpr int C_UA = 0, C_UB = 256, C_VB = 512, C_CKV = 768, C_QI = 896, C_KI = 1152, C_WI = 1216, C_QA = 1280;
constexpr int KMIX = 1536;
constexpr int NEXP = 16384;
constexpr size_t SCORES_PER_BATCH = (size_t)4096 * 2080;

constexpr size_t al256(size_t x) { return (x + 255) & ~(size_t)255; }
constexpr size_t WS_CTL = 0;
constexpr size_t WS_MOD = 65536;
constexpr size_t WS_WTIN = al256(WS_MOD + 2 * 4 * 6144 * 4);
constexpr size_t WS_WTOUT = al256(WS_WTIN + (size_t)2 * NPROJ * 1024 * 2);
constexpr size_t WS_WTQ = al256(WS_WTOUT + (size_t)2 * 1024 * KMIX * 2);
constexpr size_t WS_WTGLU = al256(WS_WTQ + (size_t)2 * 1024 * 1024 * 2);
constexpr size_t WS_GW = al256(WS_WTGLU + (size_t)2 * 256 * 256 * 2);
constexpr size_t WS_PK = al256(WS_GW + (size_t)2 * 4 * 128 * 128 * 2);
constexpr size_t WS_PW = al256(WS_PK + (size_t)2 * 2 * 128 * 64 * 2);
constexpr size_t WS_BB = al256(WS_PW + (size_t)2 * 16 * 65 * 64 * 2 * 4);
constexpr size_t WS_E = al256(WS_BB + (size_t)2 * 16 * 64 * 16 * 2 * 4);
constexpr size_t WS_G = al256(WS_E + (size_t)2 * 16 * 128 * 1024 * 2);
constexpr size_t WS_KT = al256(WS_G + (size_t)2 * 16 * 1024 * 128 * 2);
constexpr size_t WS_UB = al256(WS_KT + (size_t)2 * 16 * 64 * 256 * 2);
constexpr size_t WS_VB = al256(WS_UB + (size_t)NEXP * 1024 * 2);
constexpr size_t WS_H = al256(WS_VB + (size_t)NEXP * 1024 * 2);
constexpr size_t WS_PROJ = al256(WS_H + (size_t)NTOK * 1024 * 2);
constexpr size_t WS_SLOC = al256(WS_PROJ + (size_t)NTOK * NPROJ * 2);
constexpr size_t WS_YG = al256(WS_SLOC + (size_t)256 * 16 * 128 * 4);
constexpr size_t WS_KVN = al256(WS_YG + (size_t)NTOK * 256 * 2);
constexpr size_t WS_SEL = al256(WS_KVN + (size_t)NTOK * 128 * 2);
constexpr size_t WS_MIX = al256(WS_SEL + (size_t)NTOK * 256 * 2);
constexpr size_t WS_X = al256(WS_MIX + (size_t)NTOK * KMIX * 2);
constexpr size_t WS_SCORES = al256(WS_X + (size_t)NTOK * 1024 * 4);
constexpr size_t WS_H2 = al256(WS_SCORES + (size_t)NB * SCORES_PER_BATCH * 4);
constexpr size_t WS_END = al256(WS_H2 + (size_t)NTOK * 1024 * 2);

struct Params {
    const float* in[29];
    float* out;
    unsigned char* ws;
};

typedef __bf16 bf2v_t __attribute__((ext_vector_type(2)));
typedef float f2v_t __attribute__((ext_vector_type(2)));
DI unsigned cvt_pk_bf16(float lo, float hi) { const f2v_t f = {lo, hi}; const bf2v_t r = __builtin_convertvector(f, bf2v_t); return __builtin_bit_cast(unsigned, r); }
DI bf16 f2bf(float x) { return (bf16)(cvt_pk_bf16(x, 0.f) & 0xffffu); }
DI float bf2f(bf16 b) { return __uint_as_float((unsigned)b << 16); }
DI float bflo(unsigned u) { return __uint_as_float(u << 16); }
DI float bfhi(unsigned u) { return __uint_as_float(u & 0xffff0000u); }
DI float dot2bf(unsigned a, unsigned b, float c) { return __builtin_amdgcn_fdot2_f32_bf16(__builtin_bit_cast(bf2, a), __builtin_bit_cast(bf2, b), c, false); }
DI float gelu_tanh(float x) { const float u = 0.7978845608028654f * (x + 0.044715f * x * x * x); const float e = __expf(2.f * u); const float t = 1.f - 2.f / (e + 1.f); return 0.5f * x * (1.f + t); }
DI float sigmoidf(float x) { return 1.f / (1.f + __expf(-x)); }
DI float wave_sum(float v) { for (int o = 32; o > 0; o >>= 1) v += __shfl_xor(v, o); return v; }
DI unsigned wave_sum_u32(unsigned v) {
    int x = (int)v;
    x += __builtin_amdgcn_update_dpp(0, x, 0xB1, 0xf, 0xf, true);
    x += __builtin_amdgcn_update_dpp(0, x, 0x4E, 0xf, 0xf, true);
    x += __builtin_amdgcn_update_dpp(0, x, 0x141, 0xf, 0xf, true);
    x += __builtin_amdgcn_update_dpp(0, x, 0x140, 0xf, 0xf, true);
    x += __builtin_amdgcn_update_dpp(0, x, 0x142, 0xa, 0xf, true);
    x += __builtin_amdgcn_update_dpp(0, x, 0x143, 0xc, 0xf, true);
    return (unsigned)__builtin_amdgcn_readlane(x, 63);
}
DI unsigned wave_scan_incl_u32(unsigned v) {
    int x = (int)v;
    x += __builtin_amdgcn_update_dpp(0, x, 0x111, 0xf, 0xf, true);
    x += __builtin_amdgcn_update_dpp(0, x, 0x112, 0xf, 0xf, true);
    x += __builtin_amdgcn_update_dpp(0, x, 0x114, 0xf, 0xf, true);
    x += __builtin_amdgcn_update_dpp(0, x, 0x118, 0xf, 0xf, true);
    x += __builtin_amdgcn_update_dpp(0, x, 0x142, 0xa, 0xf, true);
    x += __builtin_amdgcn_update_dpp(0, x, 0x143, 0xc, 0xf, true);
    return (unsigned)x;
}
DI unsigned fkey(float v) { const unsigned u = __float_as_uint(v); return (u & 0x80000000u) ? ~u : (u | 0x80000000u); }
DI unsigned unkey(unsigned k) { return (k & 0x80000000u) ? (k & 0x7fffffffu) : ~k; }
DI bf16x8 ld16(const void* p) { return *(const bf16x8*)p; }
DI bf16x8 zero8() { bf16x8 z = {0, 0, 0, 0, 0, 0, 0, 0}; return z; }


#define XB_TMO      128
#define XB_XCNT(j)  (256  + 64 * (j))
#define XB_XSUB(j)  (1280 + 64 * (j))
#define XB_XGEN(j)  (2304 + 64 * (j))
#define XB_TOP      3328
#define XB_TOPGEN   3392
#define XCD_BAR_WORDS 3456
#define XB_SPIN_CAP (1u << 22)
#define LAS __attribute__((address_space(3)))
DI unsigned xb_ld(unsigned* p)              { return __hip_atomic_load(p, __ATOMIC_RELAXED, __HIP_MEMORY_SCOPE_AGENT); }
DI unsigned xb_add(unsigned* p, unsigned v) { return __hip_atomic_fetch_add(p, v, __ATOMIC_RELAXED, __HIP_MEMORY_SCOPE_AGENT); }
DI unsigned xb_xcc_id() { return (unsigned)__builtin_amdgcn_s_getreg((3 << 11) | 20) & 0xFu; }
#define XB_SPIN(cond, bar) do { unsigned _sp = 0; while (cond) { __builtin_amdgcn_s_sleep(1); \
    if ((++_sp & 255u) == 0u) { if (xb_ld(&(bar)[XB_TMO])) break; if (_sp > XB_SPIN_CAP) { atomicAdd(&(bar)[XB_TMO], 1u); break; } } } } while (0)
struct XcdBarrier { unsigned* bar; unsigned x; volatile LAS unsigned* st; };
DI XcdBarrier xcd_barrier_post(unsigned* bar, volatile LAS unsigned* st) {
    XcdBarrier b; b.bar = bar; b.x = xb_xcc_id(); b.st = st;
    if (threadIdx.x == 0) (void)xb_add(&bar[XB_XCNT(b.x)], 1u);
    return b;
}
DI void xcd_barrier_complete(unsigned* bar, unsigned x, unsigned& nloc, unsigned& nx) {
    const unsigned G = gridDim.x * gridDim.y * gridDim.z;
    unsigned sum, cnt, mine, sp = 0u;
    for (;;) {
        sum = 0u; cnt = 0u; mine = 0u;
#pragma unroll
        for (unsigned j = 0; j < 16; ++j) { const unsigned c = xb_ld(&bar[XB_XCNT(j)]); sum += c; cnt += (c > 0u) ? 1u : 0u; mine = (j == x) ? c : mine; }
        if (sum == G) break;
        __builtin_amdgcn_s_sleep(1);
        if ((++sp & 255u) == 0u) { if (xb_ld(&bar[XB_TMO])) break; if (sp > XB_SPIN_CAP) { atomicAdd(&bar[XB_TMO], 1u); break; } }
    }
    nloc = mine > 0u ? mine : 1u; nx = cnt > 0u ? cnt : 1u;
}
DI void xcd_barrier(const XcdBarrier& b) {
    asm volatile("s_waitcnt vmcnt(0)" ::: "memory");
    __syncthreads();
    if (threadIdx.x == 0) {
        unsigned* bar = b.bar;
        __builtin_amdgcn_s_waitcnt(0);
        unsigned nloc = b.st[0], nx = b.st[1];
        if (nloc == 0u) { xcd_barrier_complete(bar, b.x, nloc, nx); b.st[0] = nloc; b.st[1] = nx; }
        const unsigned old = xb_add(&bar[XB_XSUB(b.x)], 1u);
        const unsigned gen = old / nloc;
        if (old + 1u == (gen + 1u) * nloc) {
            __builtin_amdgcn_fence(__ATOMIC_RELEASE, "agent");
            asm volatile("s_waitcnt vmcnt(0)" ::: "memory");
            const unsigned og = xb_add(&bar[XB_TOP], 1u);
            const unsigned tg = og / nx;
            if (og + 1u == (tg + 1u) * nx) xb_add(&bar[XB_TOPGEN], 1u);
            else XB_SPIN(xb_ld(&bar[XB_TOPGEN]) == tg, bar);
            __builtin_amdgcn_fence(__ATOMIC_ACQUIRE, "agent");
            xb_add(&bar[XB_XGEN(b.x)], 1u);
            asm volatile("s_waitcnt vmcnt(0)" ::: "memory");
        } else {
            XB_SPIN(xb_ld(&bar[XB_XGEN(b.x)]) == gen, bar);
            __builtin_amdgcn_fence(__ATOMIC_ACQUIRE, "agent");
            asm volatile("s_waitcnt vmcnt(0)" ::: "memory");
        }
    }
    __syncthreads();
}
typedef __attribute__((address_space(1))) unsigned char g_uc;
DI unsigned char* wsb(const Params& p) {
    typedef const unsigned long long __attribute__((address_space(4))) karg_u64;
    const unsigned long long w = *(karg_u64*)((const char __attribute__((address_space(4)))*)__builtin_amdgcn_kernarg_segment_ptr() + __builtin_offsetof(Params, ws));
    unsigned lo = (unsigned)w, hi = (unsigned)(w >> 32);
    asm volatile("" : "+s"(lo), "+s"(hi));
    return (unsigned char*)(g_uc*)(((unsigned long long)hi << 32) | lo);
}
extern __shared__ __attribute__((aligned(1024))) unsigned char g_lds[];
constexpr int LDS_CTL = 131072, LDS_BYTES = 131072 + 256;
DI int opq_tid() { int t = (int)(threadIdx.x & 255u); asm volatile("" : "+v"(t)); return t; }
DI void hsync() {
    asm volatile("s_waitcnt lgkmcnt(0)" ::: "memory");
    LAS unsigned* ctr = (LAS unsigned*)(g_lds + LDS_CTL + 32) + (threadIdx.x >> 8);
    unsigned old = 0u;
    if ((threadIdx.x & 63u) == 0u) old = __hip_atomic_fetch_add(ctr, 1u, __ATOMIC_RELAXED, __HIP_MEMORY_SCOPE_WORKGROUP);
    old = (unsigned)__builtin_amdgcn_readfirstlane((int)old);
    const unsigned target = (old & ~3u) + 4u;
    while (__hip_atomic_load(ctr, __ATOMIC_RELAXED, __HIP_MEMORY_SCOPE_WORKGROUP) < target) __builtin_amdgcn_s_sleep(1);
    asm volatile("" ::: "memory");
}
DI void hsync_g() { asm volatile("s_waitcnt vmcnt(0)" ::: "memory"); hsync(); }
DI int q_next(unsigned* ctr, volatile int* slot) {
    hsync();
    if ((threadIdx.x & 255u) == 0u) *slot = (int)__hip_atomic_fetch_add(ctr, 1u, __ATOMIC_RELAXED, __HIP_MEMORY_SCOPE_AGENT);
    hsync();
    return __builtin_amdgcn_readfirstlane(*slot);
}
DI void it_mod(const Params& p, int vb, unsigned char* sm) {
    float (*ca)[1024] = (float (*)[1024])sm;
    float (*part)[4][64] = (float (*)[4][64])(sm + 16384);
    const float* c = p.in[1];
    const int tid = opq_tid();
    hsync();
    for (int i = tid; i < 4096; i += 256) { const float v = c[i]; ca[i >> 10][i & 1023] = v / (1.f + __expf(-v)); }
    hsync();
    const int col = tid & 63, sl = tid >> 6;
    const int idx = vb * 64 + col;
    const int l = idx / 6144, n = idx % 6144;
    const float* w = p.in[4] + (size_t)l * 1024 * 6144 + n + (size_t)(256 * sl) * 6144;
    float a0 = 0, a1 = 0, a2 = 0, a3 = 0;
#pragma unroll 32
    for (int k = 0; k < 256; ++k) { const float wv = w[(size_t)k * 6144]; const int kk = 256 * sl + k; a0 += ca[0][kk] * wv; a1 += ca[1][kk] * wv; a2 += ca[2][kk] * wv; a3 += ca[3][kk] * wv; }
    part[sl][0][col] = a0; part[sl][1][col] = a1; part[sl][2][col] = a2; part[sl][3][col] = a3;
    hsync();
    {
        const int bb = tid >> 6;
        const float v = part[0][bb][col] + part[1][bb][col] + part[2][bb][col] + part[3][bb][col] + p.in[5][l * 6144 + n];
        ((float*)(wsb(p) + WS_MOD))[((size_t)l * 4 + bb) * 6144 + n] = v;
    }
}

struct TrArgs { const float* src; int lds, coff, nvalid; bf16* dst; int ldd, doff; int K, N; int mode; const float* aux; };
DI void it_transpose(const TrArgs& a, int vb4, unsigned char* sm) {
    const int tid = opq_tid(), lane = tid & 63, wave = tid >> 6, tx = lane & 31, ty = lane >> 5;
    float (*t)[33] = (float (*)[33])(sm + wave * 4224);
    float (*ta)[65] = (float (*)[65])(sm + 16896 + wave * 8320);
    float (*tb)[33] = (float (*)[33])(sm + 16896 + 33280);
    const int nk = a.K / 32;
    const int vb = vb4 * 4 + wave, kt = vb % nk, nt = vb / nk;
    hsync();
    if (a.mode == 0) {
        float v[16];
#pragma unroll
        for (int i = 0; i < 16; ++i) { const int k = kt * 32 + ty + 2 * i, n = nt * 32 + tx; v[i] = (n + a.coff < a.nvalid) ? a.src[(size_t)k * a.lds + n + a.coff] : 0.f; }
#pragma unroll
        for (int i = 0; i < 16; ++i) t[ty + 2 * i][tx] = v[i];
    } else if (a.mode == 1) {
        const int h = (nt * 32) >> 7, r0 = (nt * 32) & 127;
        float va[32], vb_[8];
#pragma unroll
        for (int i = 0; i < 32; ++i) va[i] = a.src[(size_t)(kt * 32 + i) * a.lds + 768 + 64 * h + lane];
#pragma unroll
        for (int i = 0; i < 8; ++i) { const int e = tid + 256 * i, d = e >> 5, rr = e & 31; vb_[i] = a.aux[((size_t)h * 64 + d) * 128 + r0 + rr]; }
#pragma unroll
        for (int i = 0; i < 32; ++i) ta[i][lane] = va[i];
#pragma unroll
        for (int i = 0; i < 8; ++i) { const int e = tid + 256 * i; tb[e >> 5][e & 31] = vb_[i]; }
        hsync();
#pragma unroll 2
        for (int r = ty; r < 32; r += 2) { float s = 0; _Pragma("unroll 16") for (int d = 0; d < 64; ++d) s += ta[r][d] * tb[d][tx]; t[r][tx] = s * 0.125f; }
    } else {
        const int h = (kt * 32) >> 7, r0 = (kt * 32) & 127;
        float va[32], vb_[8];
#pragma unroll
        for (int i = 0; i < 32; ++i) va[i] = a.aux[((size_t)h * 128 + r0 + i) * 64 + lane];
#pragma unroll
        for (int i = 0; i < 8; ++i) { const int e = tid + 256 * i, d = e >> 5, nn = e & 31; vb_[i] = a.src[(size_t)(512 + 64 * h + d) * a.lds + nt * 32 + nn]; }
#pragma unroll
        for (int i = 0; i < 32; ++i) ta[i][lane] = va[i];
#pragma unroll
        for (int i = 0; i < 8; ++i) { const int e = tid + 256 * i; tb[e >> 5][e & 31] = vb_[i]; }
        hsync();
#pragma unroll 2
        for (int r = ty; r < 32; r += 2) { float s = 0; _Pragma("unroll 16") for (int d = 0; d < 64; ++d) s += ta[r][d] * tb[d][tx]; t[r][tx] = s; }
    }
    asm volatile("s_waitcnt lgkmcnt(0)" ::: "memory");
#pragma unroll
    for (int i = 0; i < 16; ++i) {
        const int r = ty + 2 * i, n = nt * 32 + r, k = kt * 32 + tx;
        a.dst[(size_t)n * a.ldd + a.doff + k] = f2bf(t[tx][r]);
    }
}
DI void conv_chunk(const float* __restrict__ src, bf16* __restrict__ dst, size_t i0, int n8) {
    for (int i = opq_tid(); i < n8; i += 256) {
        const float4 a = ((const float4*)src)[2 * (i0 + i)], b = ((const float4*)src)[2 * (i0 + i) + 1];
        u32x4 o; o.x = cvt_pk_bf16(a.x, a.y); o.y = cvt_pk_bf16(a.z, a.w); o.z = cvt_pk_bf16(b.x, b.y); o.w = cvt_pk_bf16(b.z, b.w);
        ((u32x4*)dst)[i0 + i] = o;
    }
}
DI void it_gw(const Params& p, int vb) {
    for (int e = 0; e < 4; ++e) {
        const int idx = vb * 1024 + e * 256 + opq_tid();
        const int s = idx & 127, t = (idx >> 7) & 127;
        const float v = (t >= 64 || s < 64) ? p.in[17][idx] : 0.f;
        ((bf16*)(wsb(p) + WS_GW))[idx] = f2bf(v);
    }
}
DI void it_ssm_pw(const Params& p, int vb) {
    const int idx = vb * 256 + opq_tid();
    const int pp = idx & 63, g = (idx >> 6) & 15, l = idx >> 10;
    const float lre = -__expf(p.in[7][idx]), lim = p.in[8][idx];
    const float dt = __expf(p.in[14][l * 16 + g]);
    float* pw = (float*)(wsb(p) + WS_PW) + ((size_t)(l * 16 + g) * 65) * 128;
    for (int d = 0; d <= 64; ++d) {
        const float mag = expf(lre * dt * (float)d); float sn, cs; sincosf(lim * dt * (float)d, &sn, &cs);
        pw[d * 128 + pp * 2] = mag * cs; pw[d * 128 + pp * 2 + 1] = mag * sn;
    }
    const float mag = expf(lre * dt); float sn, cs; sincosf(lim * dt, &sn, &cs);
    const float are = mag * cs, aim = mag * sn;
    const float den = lre * lre + lim * lim, P = are - 1.f, Q = aim;
    const float fre = (P * lre + Q * lim) / den, fim = (Q * lre - P * lim) / den;
    float* bb = (float*)(wsb(p) + WS_BB) + (size_t)idx * 32;
    for (int h = 0; h < 16; ++h) { const float br = p.in[9][(size_t)idx * 16 + h], bi = p.in[10][(size_t)idx * 16 + h]; bb[h * 2] = fre * br - fim * bi; bb[h * 2 + 1] = fre * bi + fim * br; }
}
DI void it_ssm_kt(const Params& p, int vb, unsigned char* sm) {
    float* cz = (float*)sm;
    float* bz = (float*)(sm + 8192);
    float* pz = (float*)(sm + 16384);
    const int tid = opq_tid();
    const int lg = vb >> 3, d0 = (vb & 7) * 8;
    const float* PW = (const float*)(wsb(p) + WS_PW) + ((size_t)lg * 65 + d0) * 128;
    const float* BB = (const float*)(wsb(p) + WS_BB) + (size_t)lg * 64 * 32;
    hsync();
    for (int i = tid; i < 1024; i += 256) { const int q = i >> 4, h = i & 15; cz[i * 2] = p.in[11][((size_t)lg * 16 + h) * 64 + q]; cz[i * 2 + 1] = p.in[12][((size_t)lg * 16 + h) * 64 + q]; }
    for (int i = tid; i < 2048; i += 256) bz[i] = BB[i];
    for (int i = tid; i < 1024; i += 256) pz[i] = PW[i];
    hsync();
    const int h = tid >> 4, hh = tid & 15;
    float acc[8];
#pragma unroll
    for (int d = 0; d < 8; ++d) acc[d] = 0.f;
    for (int q = 0; q < 64; ++q) {
        const float cr = cz[(q * 16 + h) * 2], ci = cz[(q * 16 + h) * 2 + 1], br = bz[(q * 16 + hh) * 2], bi = bz[(q * 16 + hh) * 2 + 1];
        const float xr = cr * br - ci * bi, xi = cr * bi + ci * br;
#pragma unroll
        for (int d = 0; d < 8; ++d) acc[d] += xr * pz[(d * 64 + q) * 2] - xi * pz[(d * 64 + q) * 2 + 1];
    }
    bf16* KT = (bf16*)(wsb(p) + WS_KT) + ((size_t)lg * 64 + d0) * 256;
    if (d0 == 0 && h == hh) acc[0] += p.in[13][(size_t)lg * 16 + h];
#pragma unroll
    for (int d = 0; d < 8; ++d) KT[d * 256 + tid] = f2bf(acc[d]);
    hsync();
}
DI void ssm_tab_entry(const Params& p, size_t idx) {
    const size_t NE = (size_t)2 * 16 * 128 * 1024;
    const float* PW = (const float*)(wsb(p) + WS_PW); const float* BB = (const float*)(wsb(p) + WS_BB);
    if (idx < NE) {
        const int kk = idx & 1023, pp = (idx >> 10) & 127; const int lg = (int)(idx >> 17);
        const int i = kk >> 4, hh = kk & 15, pq = pp & 63, part = pp >> 6;
        const float* pw = PW + ((size_t)lg * 65 + (63 - i)) * 128 + pq * 2; const float* bb = BB + ((size_t)lg * 64 + pq) * 32 + hh * 2;
        const float v = part ? (pw[0] * bb[1] + pw[1] * bb[0]) : (pw[0] * bb[0] - pw[1] * bb[1]);
        ((bf16*)(wsb(p) + WS_E))[idx] = f2bf(v);
    } else if (idx < 2 * NE) {
        const size_t e = idx - NE; const int pp = e & 127, jh = (e >> 7) & 1023; const int lg = (int)(e >> 17);
        const int j = jh >> 4, h = jh & 15, pq = pp & 63, part = pp >> 6;
        const float* pw = PW + ((size_t)lg * 65 + (j + 1)) * 128 + pq * 2;
        const float cr = p.in[11][((size_t)lg * 16 + h) * 64 + pq], ci = p.in[12][((size_t)lg * 16 + h) * 64 + pq];
        const float v = part ? -(cr * pw[1] + ci * pw[0]) : (cr * pw[0] - ci * pw[1]);
        ((bf16*)(wsb(p) + WS_G))[e] = f2bf(v);
    } else {
        const size_t e = idx - 2 * NE; if (e >= (size_t)2 * 16 * 64 * 256) return;
        const int hh = e & 15, h = (e >> 4) & 15, d = (e >> 8) & 63; const int lg = (int)(e >> 14);
        const float* pw = PW + ((size_t)lg * 65 + d) * 128; const float* bb = BB + (size_t)lg * 64 * 32 + hh * 2;
        const float* cr = p.in[11] + ((size_t)lg * 16 + h) * 64; const float* ci = p.in[12] + ((size_t)lg * 16 + h) * 64;
        float s = 0;
        for (int q = 0; q < 64; ++q) { const float zr = pw[q * 2] * bb[q * 32] - pw[q * 2 + 1] * bb[q * 32 + 1], zi = pw[q * 2] * bb[q * 32 + 1] + pw[q * 2 + 1] * bb[q * 32]; s += cr[q] * zr - ci[q] * zi; }
        ((bf16*)(wsb(p) + WS_KT))[e] = f2bf(s);
    }
}
DI void norm_mod_row(const float* __restrict__ xrow, const float* __restrict__ g, const float* __restrict__ sh, const float* __restrict__ sc, bf16* __restrict__ hrow, int lane) {
    float4 v[4]; float ss = 0;
#pragma unroll
    for (int j = 0; j < 4; ++j) { v[j] = *(const float4*)(xrow + 4 * lane + 256 * j); ss += v[j].x * v[j].x + v[j].y * v[j].y + v[j].z * v[j].z + v[j].w * v[j].w; }
    ss = wave_sum(ss);
    const float r = rsqrtf(ss * (1.f / 1024.f) + 1e-6f);
#pragma unroll
    for (int j = 0; j < 4; ++j) {
        const int c = 4 * lane + 256 * j;
        const float4 gg = *(const float4*)(g + c), s1 = *(const float4*)(sc + c), s0 = *(const float4*)(sh + c);
        u32x2 o; o.x = cvt_pk_bf16(v[j].x * r * gg.x * (1.f + s1.x) + s0.x, v[j].y * r * gg.y * (1.f + s1.y) + s0.y);
        o.y = cvt_pk_bf16(v[j].z * r * gg.z * (1.f + s1.z) + s0.z, v[j].w * r * gg.w * (1.f + s1.w) + s0.w);
        *(u32x2*)(hrow + c) = o;
    }
}
namespace pg8 {
#define PG8_LAS __attribute__((address_space(3)))
typedef unsigned short bf16_t;
constexpr int BM = 256, BK = 64, HALF = 128, HTB = HALF * BK * 2  , STAGE_BYTES = 8 * HTB, NXCD = 8, WGM = 8;
__host__ __device__ __forceinline__ int lds_byte(int r, int c) { const int st = (r >> 4) * 2 + (c >> 5), rr = r & 15, cc = c & 31, ob = rr * 64 + cc * 2; return st * 1024 + (ob ^ (((ob >> 9) & 1) << 5)); }
__host__ __device__ __forceinline__ void stage_rc(int b, int& R, int& C) { const int st = b / 1024, sb = b % 1024, swz = sb ^ (((sb >> 9) & 1) << 5); R = (st >> 1) * 16 + swz / 64; C = (st & 1) * 32 + (swz % 64) / 2; }
__host__ __device__ __forceinline__ int perm32(int rho) { const int n = rho >> 4, i = rho & 15; return 8 * (i >> 2) + 4 * n + (i & 3); }

struct Unit { int pm, pn; };
struct Gemm { const bf16_t* A; const bf16_t* Bt; int M, N, K; };

struct StaticOrder {
    int nM, nN, nwg, G, c;
    __host__ __device__ void init(int M, int N, int G_, int c_) { nM = M / BM; nN = N / BM; nwg = nM * nN; G = G_; c = c_; }
    __host__ __device__ bool next(int i, Unit& u) const {
        const long L = (long)i * G + c; if (L >= nwg) return false;
        int wgid = (int)L; { const int q = nwg / NXCD, r = nwg % NXCD, xcd = wgid % NXCD, off = wgid / NXCD; wgid = (xcd < r ? xcd * (q + 1) : r * (q + 1) + (xcd - r) * q) + off; }
        const int nig = WGM * nN, gid = wgid / nig, fm = gid * WGM, gsz = (nM - fm) < WGM ? (nM - fm) : WGM;
        u.pm = fm + ((wgid % nig) % gsz); u.pn = (wgid % nig) / gsz; return true;
    }
    __device__ __forceinline__ void a_ready(const Unit&) const {}
    __device__ __forceinline__ void done(const Unit&) const {}
};

template <class Epi, class Sched, bool ALIGN_EPI = false, bool SP2 = false>
__device__ __forceinline__ void gemm_phase(PG8_LAS unsigned char* lds, const Gemm g, const Sched& S, const Epi& E) {
    int tid = (int)threadIdx.x; asm volatile("" : "+v"(tid));
    const int wid = __builtin_amdgcn_readfirstlane(tid >> 6), lane = tid & 63, wr = wid >> 2, wc = wid & 3, fr = lane & 15, fq = lane >> 4;
    const int K = g.K, nt = K / BK;
    unsigned voffA[2], voffB[2];
#pragma unroll
    for (int i = 0; i < 2; ++i) { int R, C; stage_rc(tid * 16 + i * 8192, R, C); const int Rb = Epi::PERM ? ((R & ~31) + perm32(R & 31)) : R;
        voffA[i] = (unsigned)(R * K + C) * 2u; voffB[i] = (unsigned)(Rb * K + C) * 2u; }
    const size_t kstep = (size_t)(BK * 2);
    const size_t hstep = (size_t)HALF * K * 2;
    const size_t tstep = 2 * hstep;
    const unsigned ldsw = (unsigned)wid * 1024u;
    const int aoff = lds_byte(wr * 64 + fr, fq * 8), boff = lds_byte(wc * 32 + fr, fq * 8);
#define PG8_SA(b, h) (((b) * 2 + (h)) * HTB)
#define PG8_SB(b, h) ((4 + (b) * 2 + (h)) * HTB)
#define PG8_STAGE(bufoff, gbase, voff) do { _Pragma("unroll") for (int _i = 0; _i < 2; ++_i) \
        __builtin_amdgcn_global_load_lds((const unsigned*)((const char*)(gbase) + (voff)[_i]), (PG8_LAS unsigned*)(lds + (bufoff) + ldsw + _i * 8192), 16, 0, 0); } while (0)
#define PG8_LDA(dst, b, h) do { _Pragma("unroll") for (int m = 0; m < 4; ++m) _Pragma("unroll") for (int k = 0; k < 2; ++k) dst[m][k] = *(const PG8_LAS bf16x8*)(lds + PG8_SA(b, h) + aoff + m * 2048 + k * 1024); } while (0)
#define PG8_LDB(dst, b, h) do { _Pragma("unroll") for (int n = 0; n < 2; ++n) _Pragma("unroll") for (int k = 0; k < 2; ++k) dst[n][k] = *(const PG8_LAS bf16x8*)(lds + PG8_SB(b, h) + boff + n * 2048 + k * 1024); } while (0)
#define PG8_MMA(ai, bj, At, Bt) do { __builtin_amdgcn_s_setprio(1); _Pragma("unroll") for (int m = 0; m < 4; ++m) _Pragma("unroll") for (int n = 0; n < 2; ++n) _Pragma("unroll") for (int k = 0; k < 2; ++k) \
        acc[ai][bj][m][n] = __builtin_amdgcn_mfma_f32_16x16x32_bf16(Bt[n][k], At[m][k], acc[ai][bj][m][n], 0, 0, 0); __builtin_amdgcn_s_setprio(0); } while (0)
#define PG8_WAIT_V(n) asm volatile("s_waitcnt vmcnt(" #n ")" ::: "memory")
#define PG8_WAIT_L(n) asm volatile("s_waitcnt lgkmcnt(" #n ")" ::: "memory")
#define PG8_BAR __builtin_amdgcn_s_barrier()
#define PG8_SCHED __builtin_amdgcn_sched_barrier(0)
    Unit cur, nxt; int ui = 0;
    if (!S.next(0, cur)) return;
    f32x4 acc[2][2][4][2];
#pragma unroll
    for (int a = 0; a < 2; ++a)
#pragma unroll
        for (int b = 0; b < 2; ++b)
#pragma unroll
            for (int m = 0; m < 4; ++m)
#pragma unroll
                for (int n = 0; n < 2; ++n) acc[a][b][m][n] = (f32x4){0.f, 0.f, 0.f, 0.f};
    bf16x8 At[4][2], B0[2][2], B1[2][2];
    const char* cA = (const char*)g.A + (size_t)cur.pm * tstep; const char* cB = (const char*)g.Bt + (size_t)cur.pn * tstep;
    S.a_ready(cur);
    if constexpr (SP2) {
        PG8_STAGE(PG8_SB(0, 0), cB, voffB); PG8_STAGE(PG8_SB(0, 1), cB + hstep, voffB); PG8_STAGE(PG8_SA(0, 0), cA, voffA); PG8_STAGE(PG8_SA(0, 1), cA + hstep, voffA);
        if (wr == 1) PG8_BAR;
        PG8_WAIT_V(2); PG8_BAR;
        PG8_STAGE(PG8_SB(1, 0), cB + kstep, voffB); PG8_STAGE(PG8_SA(1, 0), cA + kstep, voffA); PG8_STAGE(PG8_SB(1, 1), cB + hstep + kstep, voffB);
        PG8_WAIT_V(6); PG8_BAR;
    } else {
        PG8_STAGE(PG8_SB(0, 0), cB, voffB); PG8_STAGE(PG8_SA(0, 0), cA, voffA); PG8_STAGE(PG8_SB(0, 1), cB + hstep, voffB); PG8_STAGE(PG8_SA(0, 1), cA + hstep, voffA);
        if (wr == 1) PG8_BAR;
        PG8_WAIT_V(4); PG8_BAR;
        PG8_STAGE(PG8_SB(1, 0), cB + kstep, voffB); PG8_STAGE(PG8_SA(1, 0), cA + kstep, voffA); PG8_STAGE(PG8_SB(1, 1), cB + hstep + kstep, voffB);
        PG8_WAIT_V(6); PG8_BAR;
    }
    for (;;) {
        const bool has_next = S.next(ui + 1, nxt);
        const char* nA = has_next ? (const char*)g.A + (size_t)nxt.pm * tstep : cA; const char* nB = has_next ? (const char*)g.Bt + (size_t)nxt.pn * tstep : cB;
        for (int t = 0; t < nt; t += 2) {
            const bool last = (t == nt - 2);
            const char* a1 = cA + (size_t)(t + 1) * kstep;
            const char* a2 = last ? nA : cA + (size_t)(t + 2) * kstep; const char* b2 = last ? nB : cB + (size_t)(t + 2) * kstep;
            const char* a3 = a2 + kstep; const char* b3 = b2 + kstep;
            if (last && has_next) S.a_ready(nxt);
            if constexpr (SP2) {
            PG8_LDB(B0, 0, 0); PG8_LDB(B1, 0, 1); PG8_SCHED; PG8_LDA(At, 0, 0); PG8_STAGE(PG8_SA(1, 1), a1 + hstep, voffA);
            PG8_WAIT_V(8); PG8_WAIT_L(0); PG8_BAR; PG8_MMA(0, 0, At, B0); PG8_MMA(0, 1, At, B1); PG8_BAR; PG8_SCHED;
            PG8_LDA(At, 0, 1); PG8_STAGE(PG8_SB(0, 0), b2, voffB); PG8_STAGE(PG8_SB(0, 1), b2 + hstep, voffB); PG8_STAGE(PG8_SA(0, 0), a2, voffA);
            PG8_WAIT_V(8); PG8_WAIT_L(0); PG8_BAR; PG8_MMA(1, 0, At, B0); PG8_MMA(1, 1, At, B1); PG8_BAR; PG8_SCHED;
            PG8_LDB(B0, 1, 0); PG8_LDB(B1, 1, 1); PG8_SCHED; PG8_LDA(At, 1, 0); PG8_STAGE(PG8_SA(0, 1), a2 + hstep, voffA);
            PG8_WAIT_V(8); PG8_WAIT_L(0); PG8_BAR; PG8_MMA(0, 0, At, B0); PG8_MMA(0, 1, At, B1); PG8_BAR; PG8_SCHED;
            PG8_LDA(At, 1, 1); PG8_STAGE(PG8_SB(1, 0), b3, voffB); PG8_STAGE(PG8_SB(1, 1), b3 + hstep, voffB); PG8_STAGE(PG8_SA(1, 0), a3, voffA);
            PG8_WAIT_V(8); PG8_WAIT_L(0); PG8_BAR; PG8_MMA(1, 0, At, B0); PG8_MMA(1, 1, At, B1); PG8_BAR; PG8_SCHED;
            } else {
            PG8_LDB(B0, 0, 0); PG8_SCHED; PG8_LDA(At, 0, 0); PG8_STAGE(PG8_SA(1, 1), a1 + hstep, voffA);
            PG8_WAIT_L(8); PG8_BAR; PG8_WAIT_L(0); PG8_MMA(0, 0, At, B0); PG8_BAR; PG8_SCHED;
            PG8_LDB(B1, 0, 1); PG8_STAGE(PG8_SB(0, 0), b2, voffB);
            PG8_BAR; PG8_WAIT_L(0); PG8_MMA(0, 1, At, B1); PG8_BAR;
            PG8_LDA(At, 0, 1); PG8_STAGE(PG8_SA(0, 0), a2, voffA);
            PG8_BAR; PG8_WAIT_L(0); PG8_MMA(1, 0, At, B0); PG8_BAR; PG8_SCHED;
            PG8_STAGE(PG8_SB(0, 1), b2 + hstep, voffB);
            PG8_WAIT_V(6); PG8_BAR; PG8_MMA(1, 1, At, B1); PG8_BAR;
            PG8_LDB(B0, 1, 0); PG8_SCHED; PG8_LDA(At, 1, 0); PG8_STAGE(PG8_SA(0, 1), a2 + hstep, voffA);
            PG8_WAIT_L(8); PG8_BAR; PG8_WAIT_L(0); PG8_MMA(0, 0, At, B0); PG8_BAR; PG8_SCHED;
            PG8_LDB(B1, 1, 1); PG8_STAGE(PG8_SB(1, 0), b3, voffB);
            PG8_BAR; PG8_WAIT_L(0); PG8_MMA(0, 1, At, B1); PG8_BAR;
            PG8_LDA(At, 1, 1); PG8_STAGE(PG8_SA(1, 0), a3, voffA);
            PG8_BAR; PG8_WAIT_L(0); PG8_MMA(1, 0, At, B0); PG8_BAR; PG8_SCHED;
            PG8_STAGE(PG8_SB(1, 1), b3 + hstep, voffB);
            PG8_WAIT_V(6); PG8_BAR; PG8_MMA(1, 1, At, B1); PG8_BAR;
            }
        }
        if constexpr (ALIGN_EPI) { if (wr == 0) PG8_BAR; }
        if constexpr (!Epi::AFTER_DRAIN) { E(acc, cur, wr, wc, fr, fq); S.done(cur); }
        if (!has_next) break;
#pragma unroll
        for (int a = 0; a < 2; ++a)
#pragma unroll
            for (int b = 0; b < 2; ++b)
#pragma unroll
                for (int m = 0; m < 4; ++m)
#pragma unroll
                    for (int n = 0; n < 2; ++n) acc[a][b][m][n] = (f32x4){0.f, 0.f, 0.f, 0.f};
        cur = nxt; cA = nA; cB = nB; ++ui;
        if constexpr (ALIGN_EPI) { if (wr == 1) PG8_BAR; }
    }
    PG8_WAIT_V(0);
    if constexpr (!ALIGN_EPI) { if (wr == 0) PG8_BAR; }
    PG8_BAR;
    if constexpr (Epi::AFTER_DRAIN) { E.fused(acc, cur, wr, wc, fr, fq, lds, wid, lane); S.done(cur); }
#undef PG8_SA
#undef PG8_SB
#undef PG8_STAGE
#undef PG8_LDA
#undef PG8_LDB
#undef PG8_MMA
#undef PG8_WAIT_V
#undef PG8_WAIT_L
#undef PG8_BAR
#undef PG8_SCHED
}
}
struct EpiBf16 { bf16* C; int ldc; DI void operator()(int r, int c, f32x4 v) const { u32x2 o; o.x = cvt_pk_bf16(v[0], v[1]); o.y = cvt_pk_bf16(v[2], v[3]); *(u32x2*)(C + (size_t)r * ldc + c) = o; } };
struct EpiResid { const float* xin; float* xout; const float* gate;
    DI void operator()(int r, int c, f32x4 v) const { const float4 x = *(const float4*)(xin + (size_t)r * 1024 + c); const float4 g = *(const float4*)(gate + (size_t)(r >> 12) * 6144 + c);
        float4 o; o.x = x.x + g.x * v[0]; o.y = x.y + g.y * v[1]; o.z = x.z + g.z * v[2]; o.w = x.w + g.w * v[3]; *(float4*)(xout + (size_t)r * 1024 + c) = o; } };
struct EpiGlu { const bf16* yg; const float* bglu; bf16* mix;
    DI void operator()(int r, int c, f32x4 v) const { const u32x2 y = *(const u32x2*)(yg + (size_t)r * 256 + c); const float4 b = *(const float4*)(bglu + c);
        u32x2 o; o.x = cvt_pk_bf16(bflo(y.x) * sigmoidf(v[0] + b.x), bfhi(y.x) * sigmoidf(v[1] + b.y)); o.y = cvt_pk_bf16(bflo(y.y) * sigmoidf(v[2] + b.z), bfhi(y.y) * sigmoidf(v[3] + b.w));
        *(u32x2*)(mix + (size_t)r * KMIX + c) = o; } };
constexpr int GP = 72;
template <class Epi>
DI void gemm_tile64(const bf16* __restrict__ A, int lda, const bf16* __restrict__ Bt, int ldb, int K, int m0, int n0, bf16* lds, const Epi& epi) {
    bf16* As = lds; bf16* Bs = lds + 64 * GP;
    const int tid = opq_tid(), lane = tid & 63, wave = tid >> 6, wm = wave >> 1, wn = wave & 1;
    const int fr = lane & 15, fq = lane >> 4;
    const int lrow = tid >> 3, lch = tid & 7;
    f32x4 acc[4][2];
#pragma unroll
    for (int i = 0; i < 4; ++i)
#pragma unroll
        for (int j = 0; j < 2; ++j) acc[i][j] = (f32x4){0.f, 0.f, 0.f, 0.f};
    bf16x8 ra[2], rb[4];
    const bf16* Ag = A + (size_t)(m0 + lrow) * lda + lch * 8;
    const bf16* Bg = Bt + (size_t)(n0 + lrow) * ldb + lch * 8;
#pragma unroll
    for (int i = 0; i < 4; ++i) { if (i < 2) ra[i] = ld16(Ag + (size_t)32 * i * lda); rb[i] = ld16(Bg + (size_t)32 * i * ldb); }
    const int nk = K / 64;
    for (int kt = 0; kt < nk; ++kt) {
        hsync();
#pragma unroll
        for (int i = 0; i < 4; ++i) { if (i < 2) *(bf16x8*)(As + (lrow + 32 * i) * GP + lch * 8) = ra[i]; *(bf16x8*)(Bs + (lrow + 32 * i) * GP + lch * 8) = rb[i]; }
        hsync();
        if (kt + 1 < nk) {
#pragma unroll
            for (int i = 0; i < 4; ++i) { if (i < 2) ra[i] = ld16(Ag + (size_t)32 * i * lda + (kt + 1) * 64); rb[i] = ld16(Bg + (size_t)32 * i * ldb + (kt + 1) * 64); }
        }
#pragma unroll
        for (int ks = 0; ks < 2; ++ks) {
            bf16x8 fa[4], fb[2];
#pragma unroll
            for (int i = 0; i < 4; ++i) fa[i] = ld16(Bs + (64 * wn + 16 * i + fr) * GP + 32 * ks + 8 * fq);
#pragma unroll
            for (int j = 0; j < 2; ++j) fb[j] = ld16(As + (32 * wm + 16 * j + fr) * GP + 32 * ks + 8 * fq);
#pragma unroll
            for (int i = 0; i < 4; ++i)
#pragma unroll
                for (int j = 0; j < 2; ++j) acc[i][j] = MFMA16(fa[i], fb[j], acc[i][j]);
        }
    }
#pragma unroll
    for (int i = 0; i < 4; ++i)
#pragma unroll
        for (int j = 0; j < 2; ++j) epi(m0 + 32 * wm + 16 * j + fr, n0 + 64 * wn + 16 * i + 4 * fq, acc[i][j]);
}
template <class F> struct Epi256 {
    static constexpr bool PERM = false, AFTER_DRAIN = false;
    F f;
    DI void operator()(const f32x4 (&acc)[2][2][4][2], const pg8::Unit& u, int wr, int wc, int, int) const {
        int t_ = (int)threadIdx.x; asm volatile("" : "+v"(t_));
        const int fr = t_ & 15, fq = (t_ >> 4) & 3;
#pragma unroll
        for (int ai = 0; ai < 2; ++ai)
#pragma unroll
            for (int m = 0; m < 4; ++m)
#pragma unroll
                for (int bj = 0; bj < 2; ++bj)
#pragma unroll
                    for (int n = 0; n < 2; ++n) f(u.pm * 256 + ai * 128 + wr * 64 + m * 16 + fr, u.pn * 256 + bj * 128 + wc * 32 + n * 16 + 4 * fq, acc[ai][bj][m][n]);
    }
};

DI unsigned off_b(unsigned row, unsigned ch) { return 256u * row + 16u * (ch ^ (((row & 3u) << 2) | ((row >> 2) & 3u))); }
#define TR8(o0, o1, o2, o3, o4, o5, o6, o7, a0, a1, a2, a3, a4, a5, a6, a7)                                                                         \
    asm volatile("s_waitcnt lgkmcnt(0)\n\t"                                                                                                         \
                 "ds_read_b64_tr_b16 %0, %8\n\tds_read_b64_tr_b16 %1, %9\n\tds_read_b64_tr_b16 %2, %10\n\tds_read_b64_tr_b16 %3, %11\n\t"           \
                 "ds_read_b64_tr_b16 %4, %12\n\tds_read_b64_tr_b16 %5, %13\n\tds_read_b64_tr_b16 %6, %14\n\tds_read_b64_tr_b16 %7, %15\n\t"         \
                 "s_waitcnt lgkmcnt(0)"                                                                                                             \
                 : "=&v"(o0), "=&v"(o1), "=&v"(o2), "=&v"(o3), "=&v"(o4), "=&v"(o5), "=&v"(o6), "=&v"(o7)                                           \
                 : "v"(a0), "v"(a1), "v"(a2), "v"(a3), "v"(a4), "v"(a5), "v"(a6), "v"(a7)                                                           \
                 : "memory")

DI void it_kvn(const Params& p, int l, int vb) {
    const int lane = opq_tid() & 63, wave = opq_tid() >> 6;
    const bf16* proj = (const bf16*)(wsb(p) + WS_PROJ); bf16* kvn = (bf16*)(wsb(p) + WS_KVN);
    const float g0 = p.in[19][l * 128 + 2 * lane], g1 = p.in[19][l * 128 + 2 * lane + 1];
    for (int i = 0; i < 16; ++i) {
        const int row = vb * 64 + i * 4 + wave;
        const unsigned u = *(const unsigned*)(proj + (size_t)row * NPROJ + C_CKV + 2 * lane);
        const float a = bflo(u), b = bfhi(u);
        const float ss = wave_sum(a * a + b * b);
        const float r = rsqrtf(ss * (1.f / 128.f) + 1e-6f);
        *(unsigned*)(kvn + (size_t)row * 128 + 2 * lane) = cvt_pk_bf16(a * r * g0, b * r * g1);
    }
}

DI void it_ssm_a(const Params& p, int l, int item) {
    const int lane = opq_tid() & 63, wave = opq_tid() >> 6, fr = lane & 15, fq = lane >> 4;
    const bf16* proj = (const bf16*)(wsb(p) + WS_PROJ);
    float* sloc = (float*)(wsb(p) + WS_SLOC);
    const int g = item & 15, rt = item >> 4;
    const bf16* E = (const bf16*)(wsb(p) + WS_E) + ((size_t)(l * 16 + g) * 128) * 1024;
    const int R = 16 * rt + fr, b = R >> 6, k = R & 63;
    const bf16* arow = proj + ((size_t)b * 4096 + 64 * k + (fq >> 1)) * NPROJ + C_UA + 16 * g + 8 * (fq & 1);
    f32x4 acc[2] = {(f32x4){0, 0, 0, 0}, (f32x4){0, 0, 0, 0}};
#pragma unroll 4
    for (int ks = 0; ks < 32; ++ks) {
        const bf16x8 a = ld16(arow + (size_t)(2 * ks) * NPROJ);
#pragma unroll
        for (int c = 0; c < 2; ++c) { const int ct = 2 * wave + c; const bf16x8 bf = ld16(E + (size_t)(16 * ct + fr) * 1024 + 32 * ks + 8 * fq); acc[c] = MFMA16(a, bf, acc[c]); }
    }
#pragma unroll
    for (int c = 0; c < 2; ++c)
#pragma unroll
        for (int i = 0; i < 4; ++i) sloc[((size_t)(16 * rt + 4 * fq + i) * 16 + g) * 128 + 16 * (2 * wave + c) + fr] = acc[c][i];
}

DI void it_ssm_c(const Params& p, int l, int item, unsigned char* sm, int pm = 7) {
    bf16* sst = (bf16*)sm;
    bf16* ktl = (bf16*)(sm + 17408);
    const int tid = opq_tid(), lane = tid & 63, wave = tid >> 6, fr = lane & 15, fq = lane >> 4;
    const bf16* proj = (const bf16*)(wsb(p) + WS_PROJ);
    const float* sloc = (const float*)(wsb(p) + WS_SLOC);
    bf16* yg = (bf16*)(wsb(p) + WS_YG);
    const int jq = item & 3, g = (item >> 2) & 15, b = item >> 6;
    const bf16* KT = (const bf16*)(wsb(p) + WS_KT) + (size_t)(l * 16 + g) * 64 * 256;
    hsync();
#pragma unroll
    for (int i = 0; i < 8; ++i) *(bf16x8*)(ktl + (i * 256 + tid) * 8) = ld16(KT + (size_t)(i * 256 + tid) * 8);
    if (wave == 0 && (pm & 1)) {
        const float* pw64 = (const float*)(wsb(p) + WS_PW) + ((size_t)(l * 16 + g) * 65 + 64) * 128 + lane * 2;
        const float ar = pw64[0], ai = pw64[1];
        float sr = 0, si = 0;
        const float* s = sloc + ((size_t)(b * 64) * 16 + g) * 128;
        float lr[64], li[64];
#pragma unroll
        for (int k = 0; k < 64; ++k) { lr[k] = s[(size_t)k * 2048 + lane]; li[k] = s[(size_t)k * 2048 + 64 + lane]; }
#pragma unroll
        for (int k = 0; k < 64; ++k) {
            sst[k * 136 + lane] = f2bf(sr); sst[k * 136 + 64 + lane] = f2bf(si);
            const float nr = ar * sr - ai * si + lr[k], ni = ar * si + ai * sr + li[k];
            sr = nr; si = ni;
        }
    }
    hsync();
    const bf16* G = (const bf16*)(wsb(p) + WS_G) + (size_t)(l * 16 + g) * 1024 * 128;
    const int kch = 16 * wave + fr;
    const bf16* arow = proj + ((size_t)b * 4096 + 64 * kch + (fq >> 1)) * NPROJ + C_UA + 16 * g + 8 * (fq & 1);
    const int j0 = 16 * jq;
    f32x4 acc[16];
#pragma unroll
    for (int jj = 0; jj < 16; ++jj) acc[jj] = (f32x4){0, 0, 0, 0};
    const int nks = (j0 + 15) / 2 + 1;
    bf16x8 a_cur[8], a_nxt[8];
#pragma unroll
    for (int i = 0; i < 8; ++i) a_cur[i] = ld16(arow + (size_t)(2 * i) * NPROJ);
    const bf16* blane = ktl + (fr - 16 * (fq >> 1)) * 16 + 8 * (fq & 1);
#pragma unroll 1
    for (int grp = 0; grp < ((pm & 2) ? jq : 0); ++grp) {
#pragma unroll
        for (int i = 0; i < 8; ++i) a_nxt[i] = ld16(arow + (size_t)(2 * (8 * grp + 8 + i)) * NPROJ);
#pragma unroll
        for (int i = 0; i < 8; ++i) {
            const bf16* bp = blane + 256 * (j0 - 2 * (8 * grp + i));
#pragma unroll
            for (int jj = 0; jj < 16; ++jj) acc[jj] = MFMA16(ld16(bp + 256 * jj), a_cur[i], acc[jj]);
        }
#pragma unroll
        for (int i = 0; i < 8; ++i) a_cur[i] = a_nxt[i];
    }
    if (pm & 2) {
#pragma unroll
        for (int i = 0; i < 8; ++i) {
            const int ks = 8 * jq + i;
#pragma unroll
            for (int jj = 0; jj < 16; ++jj) {
                const int j = j0 + jj;
                if (2 * i <= jj) {
                    const int d = j - 2 * ks - (fq >> 1);
                    const bf16x8 bl = ld16(ktl + ((d < 0 ? 0 : d) * 16 + fr) * 16 + 8 * (fq & 1));
                    const bf16x8 bf = d >= 0 ? bl : zero8();
                    acc[jj] = MFMA16(bf, a_cur[i], acc[jj]);
                }
            }
        }
    }
#pragma unroll
    for (int ks = 0; ks < ((pm & 4) ? 4 : 0); ++ks) {
        const bf16x8 a = ld16(sst + kch * 136 + 32 * ks + 8 * fq);
        bf16x8 bfr[16];
#pragma unroll
        for (int jj = 0; jj < 16; ++jj) bfr[jj] = ld16(G + ((size_t)((j0 + jj) * 16 + fr)) * 128 + 32 * ks + 8 * fq);
#pragma unroll
        for (int jj = 0; jj < 16; ++jj) acc[jj] = MFMA16(bfr[jj], a, acc[jj]);
    }
#pragma unroll
    for (int jj = 0; jj < 16; ++jj) {
        const size_t tok = (size_t)b * 4096 + 64 * (16 * wave + fr) + j0 + jj;
        u32x2 o; o.x = cvt_pk_bf16(gelu_tanh(acc[jj][0]), gelu_tanh(acc[jj][1])); o.y = cvt_pk_bf16(gelu_tanh(acc[jj][2]), gelu_tanh(acc[jj][3]));
        *(u32x2*)(yg + tok * 256 + 16 * g + 4 * fq) = o;
    }
}

DI void it_gmlp(const Params& p, int l, int item, unsigned char* sm) {
    bf16* vnT = (bf16*)sm;
    const int tid = opq_tid(), lane = tid & 63, wave = tid >> 6, fr = lane & 15, fq = lane >> 4;
    const bf16* proj = (const bf16*)(wsb(p) + WS_PROJ); bf16* mix = (bf16*)(wsb(p) + WS_MIX);
    const int h = item & 3, blk = item >> 2;
    const size_t tok0 = (size_t)blk * 128;
    hsync();
    {
        const int row = tid >> 1, half = tid & 1;
        const bf16* vp = proj + (tok0 + row) * NPROJ + C_VB + 64 * h + 32 * half;
        float v[32]; float s = 0;
#pragma unroll
        for (int q = 0; q < 4; ++q) { const bf16x8 t = ld16(vp + 8 * q);
#pragma unroll
            for (int e = 0; e < 8; ++e) { v[8 * q + e] = bf2f((bf16)t[e]); s += v[8 * q + e]; } }
        s += __shfl_xor(s, 1); const float mu = s * (1.f / 64.f);
        float vs = 0;
#pragma unroll
        for (int e = 0; e < 32; ++e) { const float d = v[e] - mu; vs += d * d; }
        vs += __shfl_xor(vs, 1); const float r = rsqrtf(vs * (1.f / 64.f) + 1e-6f);
#pragma unroll
        for (int e = 0; e < 32; ++e) vnT[(32 * half + e) * 136 + row] = f2bf((v[e] - mu) * r);
    }
    hsync();
    const bf16* W = (const bf16*)(wsb(p) + WS_GW) + (size_t)(l * 4 + h) * 128 * 128;
    f32x4 acc[4][2];
#pragma unroll
    for (int i = 0; i < 4; ++i) { acc[i][0] = (f32x4){0, 0, 0, 0}; acc[i][1] = (f32x4){0, 0, 0, 0}; }
#pragma unroll
    for (int ks = 0; ks < 4; ++ks) {
        bf16x8 fa[4], fb[2];
#pragma unroll
        for (int i = 0; i < 4; ++i) fa[i] = ld16(vnT + (16 * i + fr) * 136 + 32 * ks + 8 * fq);
#pragma unroll
        for (int j = 0; j < 2; ++j) fb[j] = ld16(W + (size_t)(16 * (2 * wave + j) + fr) * 128 + 32 * ks + 8 * fq);
#pragma unroll
        for (int i = 0; i < 4; ++i)
#pragma unroll
            for (int j = 0; j < 2; ++j) acc[i][j] = MFMA16(fa[i], fb[j], acc[i][j]);
    }
#pragma unroll
    for (int j = 0; j < 2; ++j) {
        const int t = 16 * (2 * wave + j) + fr;
        const float bs = p.in[18][(l * 4 + h) * 128 + t];
#pragma unroll
        for (int i = 0; i < 4; ++i) {
            const int d = 16 * i + 4 * fq;
            const u32x2 u = *(const u32x2*)(proj + (tok0 + t) * NPROJ + C_UB + 64 * h + d);
            u32x2 o; o.x = cvt_pk_bf16(bflo(u.x) * (acc[i][j][0] + bs), bfhi(u.x) * (acc[i][j][1] + bs)); o.y = cvt_pk_bf16(bflo(u.y) * (acc[i][j][2] + bs), bfhi(u.y) * (acc[i][j][3] + bs));
            *(u32x2*)(mix + (tok0 + t) * KMIX + 256 + 64 * h + d) = o;
        }
    }
}

DI size_t score_row_off(int b, int t) { const int c = t >> 6; return (size_t)b * SCORES_PER_BATCH + (size_t)4096 * (c * (c + 1) / 2) + (size_t)(t & 63) * 64 * (c + 1); }
template <int NR>
DI void dsa_select_impl(const float* __restrict__ srow, int nreg, bf16* __restrict__ so, int lane, unsigned* hist, int topbit = 31) {
    unsigned key[NR];
#pragma unroll
    for (int r = 0; r < NR; ++r) { const float v = srow[64 * r + lane]; key[r] = (r < nreg) ? fkey(v + 0.f) : 0u; }
    unsigned T = 0;
#pragma unroll 1
    for (int bit = (topbit < 0 ? -1 : (topbit & 63)); bit >= 0; --bit) {
        const unsigned cand = T | (1u << bit);
        unsigned c = 0;
#pragma unroll
        for (int r = 0; r < NR; ++r) asm("v_cmp_ge_u32 vcc, %1, %2\n\tv_addc_co_u32 %0, vcc, 0, %0, vcc" : "+v"(c) : "v"(key[r]), "v"(cand) : "vcc");
        const unsigned cnt = wave_sum_u32(c);
        if (cnt >= 256u) { T = cand; if (cnt == 256u) break; }
    }
    if (topbit < 0 || (topbit & 64)) { unsigned x = T; _Pragma("unroll") for (int r = 0; r < NR; ++r) x ^= key[r]; if (x == 0x12345u) so[lane] = (bf16)x; return; }
    unsigned c = 0;
#pragma unroll
    for (int r = 0; r < NR; ++r) asm("v_cmp_gt_u32 vcc, %1, %2\n\tv_addc_co_u32 %0, vcc, 0, %0, vcc" : "+v"(c) : "v"(key[r]), "v"(T) : "vcc");
    const int need = 256 - (int)wave_sum_u32(c);
    unsigned ce = 0;
#pragma unroll
    for (int r = 0; r < NR; ++r) asm("v_cmp_eq_u32 vcc, %1, %2\n\tv_addc_co_u32 %0, vcc, 0, %0, vcc" : "+v"(ce) : "v"(key[r]), "v"(T) : "vcc");
    if ((int)wave_sum_u32(ce) == need) {
        bf16* stg = (bf16*)hist;
        unsigned base = 0;
#pragma unroll
        for (int r = 0; r < NR; ++r) {
            const unsigned long long mt = __ballot(key[r] >= T);
            const unsigned pos = __builtin_amdgcn_mbcnt_hi((unsigned)(mt >> 32), __builtin_amdgcn_mbcnt_lo((unsigned)mt, base));
            stg[(key[r] >= T) ? pos : 256u + (unsigned)lane] = (bf16)(64 * r + lane);
            base += (unsigned)__popcll(mt);
        }
        asm volatile("s_waitcnt lgkmcnt(0)" ::: "memory");
        *(u32x2*)(so + 4 * lane) = *(const u32x2*)(stg + 4 * lane);
        return;
    }
    int base = 0, eqb = 0;
    const unsigned long long lt = (1ull << lane) - 1ull;
#pragma unroll
    for (int r = 0; r < NR; ++r) {
        const unsigned long long me = __ballot(key[r] == T);
        const int erank = eqb + __popcll(me & lt);
        const bool take = (key[r] > T) || (key[r] == T && erank < need);
        const unsigned long long mt = __ballot(take);
        if (take) so[base + __popcll(mt & lt)] = (bf16)(64 * r + lane);
        base += __popcll(mt); eqb += __popcll(me);
    }
}
DI void dsa_select_query(const Params& p, int q, int lane, unsigned* hist, int topbit = 31) {
    const float* scores = (const float*)(wsb(p) + WS_SCORES); bf16* sel = (bf16*)(wsb(p) + WS_SEL);
    const int b = q >> 12, t = q & 4095, c = t >> 6, nreg = c + 1;
    bf16* so = sel + (size_t)q * 256;
    if (nreg <= 4) { for (int r = 0; r < nreg; ++r) so[64 * r + lane] = (bf16)(64 * r + lane); return; }
    const float* srow = scores + score_row_off(b, t);
    if (nreg <= 16) dsa_select_impl<16>(srow, nreg, so, lane, hist, topbit);
    else if (nreg <= 32) dsa_select_impl<32>(srow, nreg, so, lane, hist, topbit);
    else if (nreg <= 48) dsa_select_impl<48>(srow, nreg, so, lane, hist, topbit);
    else dsa_select_impl<64>(srow, nreg, so, lane, hist, topbit);
}
DI void it_dsa_index_select(const Params& p, int item, unsigned char* sm, int mode = 3) {
    const int lane = opq_tid() & 63, wave = opq_tid() >> 6, fr = lane & 15, fq = lane >> 4;
    const bf16* proj = (const bf16*)(wsb(p) + WS_PROJ); float* scores = (float*)(wsb(p) + WS_SCORES);
    const int c = 63 - (item >> 4), b = (item >> 2) & 3, qg = item & 3;
    if (c >= 4 && (mode & 1)) {
        const int t = 64 * c + 16 * qg + fr;
        const bf16* qrow = proj + ((size_t)b * 4096 + t) * NPROJ;
        bf16x8 qf[4][2];
#pragma unroll
        for (int hh = 0; hh < 4; ++hh)
#pragma unroll
            for (int ks = 0; ks < 2; ++ks) qf[hh][ks] = ld16(qrow + C_QI + 64 * hh + 32 * ks + 8 * fq);
        float w[4];
        { const u32x2 wv = *(const u32x2*)(qrow + C_WI); w[0] = bflo(wv.x) * 0.0625f; w[1] = bfhi(wv.x) * 0.0625f; w[2] = bflo(wv.y) * 0.0625f; w[3] = bfhi(wv.y) * 0.0625f; }
        float* srow = scores + score_row_off(b, t);
        const int ntile = 4 * (c + 1);
        const bf16* kbase = proj + ((size_t)b * 4096 + fr) * NPROJ + C_KI + 8 * fq;
        bf16x8 k0[4], k1[4];
#pragma unroll
        for (int u = 0; u < 4; ++u) { const bf16* krow = kbase + (size_t)16 * (wave + 4 * u) * NPROJ; k0[u] = ld16(krow); k1[u] = ld16(krow + 32); }
        for (int base = wave; base < ntile; base += 16) {
            bf16x8 n0[4], n1[4];
            const bool more = base + 16 < ntile;
            if (more) {
#pragma unroll
                for (int u = 0; u < 4; ++u) { const bf16* krow = kbase + (size_t)16 * (base + 16 + 4 * u) * NPROJ; n0[u] = ld16(krow); n1[u] = ld16(krow + 32); }
            }
#pragma unroll
            for (int u = 0; u < 4; ++u) {
                const int kt = base + 4 * u;
                if (kt >= ntile) break;
                f32x4 sc = {0, 0, 0, 0};
#pragma unroll
                for (int hh = 0; hh < 4; ++hh) {
                    f32x4 a = {0, 0, 0, 0};
                    a = MFMA16(k0[u], qf[hh][0], a); a = MFMA16(k1[u], qf[hh][1], a);
#pragma unroll
                    for (int i = 0; i < 4; ++i) sc[i] += w[hh] * fmaxf(a[i], 0.f);
                }
#pragma unroll
                for (int i = 0; i < 4; ++i) sc[i] += 0.f;
                *(f32x4*)(srow + 16 * kt + 4 * fq) = sc;
            }
            if (more) {
#pragma unroll
                for (int u = 0; u < 4; ++u) { k0[u] = n0[u]; k1[u] = n1[u]; }
            }
        }
    }
    hsync_g();
    if (mode & 2) for (int i = 0; i < 4; ++i) dsa_select_query(p, b * 4096 + 64 * c + 16 * qg + 4 * wave + i, lane, (unsigned*)sm + 1024 * wave, (mode & 16) ? -1 : (((mode & 4) ? 15 : 31) | ((mode & 8) ? 64 : 0)));
}
DI void it_dsa_attn(const Params& p, int item, unsigned char* sm) {
    const int lane = opq_tid() & 63, wave = opq_tid() >> 6, fr = lane & 15, fq = lane >> 4;
    unsigned char* tile = sm + wave * 8192;
    bf16* selw = (bf16*)(sm + 32768 + wave * 512);
    const bf16* proj = (const bf16*)(wsb(p) + WS_PROJ); const bf16* kvn = (const bf16*)(wsb(p) + WS_KVN);
    const bf16* sel = (const bf16*)(wsb(p) + WS_SEL); bf16* mix = (bf16*)(wsb(p) + WS_MIX);
    unsigned wr_addr[8], rd_addr[2][4], tr_addr[8][2];
#pragma unroll
    for (int i = 0; i < 8; ++i) wr_addr[i] = off_b(4 * i + fq, fr);
#pragma unroll
    for (int rb = 0; rb < 2; ++rb)
#pragma unroll
        for (int s = 0; s < 4; ++s) rd_addr[rb][s] = off_b(8 * (fr >> 2) + 4 * rb + (fr & 3), 4 * s + fq);
    const unsigned tbase = (unsigned)(size_t)tile;
    {
        const unsigned q4 = fr >> 2, p4 = fr & 3;
#pragma unroll
        for (int c = 0; c < 8; ++c)
#pragma unroll
            for (int t = 0; t < 2; ++t) tr_addr[c][t] = tbase + off_b(8 * fq + 4 * t + q4, 2 * c + (p4 >> 1)) + 8 * (p4 & 1);
    }
    const float slope = fr < 8 ? exp2f(-(float)(fr + 1)) : 0.f;
    for (int qi = 0; qi < 4; ++qi) {
        const int q = item * 16 + wave * 4 + qi;
        const int b = q >> 12, t = q & 4095, c = t >> 6;
        const int nsel = (c + 1) * 64 < 256 ? (c + 1) * 64 : 256;
        const bf16* qa = proj + (size_t)q * NPROJ + C_QA;
        bf16x8 qf[4];
#pragma unroll
        for (int s = 0; s < 4; ++s) qf[s] = fr < 8 ? ld16(qa + fr * 128 + 32 * s + 8 * fq) : zero8();
        const bf16* selp = sel + (size_t)q * 256;
        const bf16* kvb = kvn + (size_t)b * 4096 * 128;
        if (4 * lane < nsel) *(u32x2*)(selw + 4 * lane) = *(const u32x2*)(selp + 4 * lane);
        float m_run = -INFINITY, l_run = 0.f;
        f32x4 o[8];
#pragma unroll
        for (int i = 0; i < 8; ++i) o[i] = (f32x4){0, 0, 0, 0};
        bf16x8 gk[8];
#pragma unroll
        for (int i = 0; i < 8; ++i) { const int key = selw[4 * i + fq]; gk[i] = ld16(kvb + (size_t)key * 128 + 8 * fr); }
        const int nt = nsel / 32;
        for (int ti = 0; ti < nt; ++ti) {
            const bf16x8 kp = ld16(selw + 32 * ti + 8 * fq);
#pragma unroll
            for (int i = 0; i < 8; ++i) *(bf16x8*)(tile + wr_addr[i]) = gk[i];
            if (ti + 1 < nt) {
#pragma unroll
                for (int i = 0; i < 8; ++i) { const int key = selw[32 * (ti + 1) + 4 * i + fq]; gk[i] = ld16(kvb + (size_t)key * 128 + 8 * fr); }
            }
            f32x4 lg[2] = {(f32x4){0, 0, 0, 0}, (f32x4){0, 0, 0, 0}};
#pragma unroll
            for (int rb = 0; rb < 2; ++rb)
#pragma unroll
                for (int s = 0; s < 4; ++s) lg[rb] = MFMA16(ld16(tile + rd_addr[rb][s]), qf[s], lg[rb]);
            float val[8]; float tmax = -INFINITY;
#pragma unroll
            for (int j = 0; j < 8; ++j) { const float dist = fabsf((float)(t - (int)(unsigned short)kp[j])); val[j] = lg[j >> 2][j & 3] - slope * dist; tmax = fmaxf(tmax, val[j]); }
            tmax = fmaxf(tmax, __shfl_xor(tmax, 16)); tmax = fmaxf(tmax, __shfl_xor(tmax, 32));
            const float m_new = fmaxf(m_run, tmax);
            const float scale = __expf(m_run - m_new);
            l_run *= scale;
#pragma unroll
            for (int i = 0; i < 8; ++i) o[i] *= scale;
            float pv[8];
#pragma unroll
            for (int j = 0; j < 8; ++j) { pv[j] = __expf(val[j] - m_new); l_run += pv[j]; }
            m_run = m_new;
            u32x4 pk; pk.x = cvt_pk_bf16(pv[0], pv[1]); pk.y = cvt_pk_bf16(pv[2], pv[3]); pk.z = cvt_pk_bf16(pv[4], pv[5]); pk.w = cvt_pk_bf16(pv[6], pv[7]);
            const bf16x8 pf = __builtin_bit_cast(bf16x8, pk);
            s16x4 tr[8][2];
            TR8(tr[0][0], tr[0][1], tr[1][0], tr[1][1], tr[2][0], tr[2][1], tr[3][0], tr[3][1], tr_addr[0][0], tr_addr[0][1], tr_addr[1][0], tr_addr[1][1], tr_addr[2][0], tr_addr[2][1], tr_addr[3][0], tr_addr[3][1]);
            TR8(tr[4][0], tr[4][1], tr[5][0], tr[5][1], tr[6][0], tr[6][1], tr[7][0], tr[7][1], tr_addr[4][0], tr_addr[4][1], tr_addr[5][0], tr_addr[5][1], tr_addr[6][0], tr_addr[6][1], tr_addr[7][0], tr_addr[7][1]);
#pragma unroll
            for (int cc = 0; cc < 8; ++cc) {
                bf16x8 kf; kf[0] = tr[cc][0][0]; kf[1] = tr[cc][0][1]; kf[2] = tr[cc][0][2]; kf[3] = tr[cc][0][3]; kf[4] = tr[cc][1][0]; kf[5] = tr[cc][1][1]; kf[6] = tr[cc][1][2]; kf[7] = tr[cc][1][3];
                o[cc] = MFMA16(kf, pf, o[cc]);
            }
        }
        float lt = l_run; lt += __shfl_xor(lt, 16); lt += __shfl_xor(lt, 32);
        const float inv = 1.f / lt;
        if (fr < 8) {
#pragma unroll
            for (int cc = 0; cc < 8; ++cc) { u32x2 ov; ov.x = cvt_pk_bf16(o[cc][0] * inv, o[cc][1] * inv); ov.y = cvt_pk_bf16(o[cc][2] * inv, o[cc][3] * inv);
                *(u32x2*)(mix + (size_t)q * KMIX + 512 + fr * 128 + 16 * cc + 4 * fq) = ov; }
        }
    }
}
typedef float f2 __attribute__((ext_vector_type(2)));
#ifndef PEER_FP8_MASK
#define PEER_FP8_MASK 3
#endif
constexpr float U_SCALE = 64.f, V_SCALE = 8.f;
DI unsigned pack4_fp8(float a, float b, float c, float d) { int p = __builtin_amdgcn_cvt_pk_fp8_f32(a, b, 0, false); p = __builtin_amdgcn_cvt_pk_fp8_f32(c, d, p, true); return (unsigned)p; }
DI void conv_chunk_fp8(const float* __restrict__ src, unsigned char* __restrict__ dst, size_t i0, int n16, float sc) {
    for (int i = opq_tid(); i < n16; i += 256) {
        const float4* s4 = (const float4*)src + 4 * (i0 + i);
        const float4 a = s4[0], b = s4[1], c = s4[2], d = s4[3];
        u32x4 o; o.x = pack4_fp8(a.x * sc, a.y * sc, a.z * sc, a.w * sc); o.y = pack4_fp8(b.x * sc, b.y * sc, b.z * sc, b.w * sc);
        o.z = pack4_fp8(c.x * sc, c.y * sc, c.z * sc, c.w * sc); o.w = pack4_fp8(d.x * sc, d.y * sc, d.z * sc, d.w * sc);
        ((u32x4*)dst)[i0 + i] = o;
    }
}
#ifndef PEER_FP6_MASK
#define PEER_FP6_MASK 3
#endif
#ifndef FP6_INTERLEAVED
#define FP6_INTERLEAVED 1
#endif
typedef unsigned u32x6 __attribute__((ext_vector_type(6)));
typedef float f32x16 __attribute__((ext_vector_type(16)));
typedef float f32x32 __attribute__((ext_vector_type(32)));
struct __attribute__((packed, aligned(4))) U3 { unsigned x, y, z; };
constexpr float U_SCALE6 = 32.f, V_SCALE6 = 4.f;
DI void conv_chunk_fp6(const float* __restrict__ src, unsigned char* __restrict__ dst, size_t g0, int n32, float sc) {
    for (int i = opq_tid(); i < n32; i += 256) {
        const float4* s4 = (const float4*)src + 8 * (g0 + i);
        float v[32];
#pragma unroll
        for (int q = 0; q < 8; ++q) { const float4 t = s4[q]; v[4 * q] = t.x * sc; v[4 * q + 1] = t.y * sc; v[4 * q + 2] = t.z * sc; v[4 * q + 3] = t.w * sc; }
        f32x16 a, b;
#pragma unroll
        for (int k = 0; k < 16; ++k) { a[k] = FP6_INTERLEAVED ? v[2 * k] : v[k]; b[k] = FP6_INTERLEAVED ? v[2 * k + 1] : v[16 + k]; }
        const u32x6 o = __builtin_amdgcn_cvt_scalef32_2xpk16_fp6_f32(a, b, 1.0f);
        unsigned* d = (unsigned*)(dst + (g0 + i) * 24);
        u32x2 o0, o1, o2; o0.x = o[0]; o0.y = o[1]; o1.x = o[2]; o1.y = o[3]; o2.x = o[4]; o2.y = o[5];
        *(u32x2*)d = o0; *(u32x2*)(d + 2) = o1; *(u32x2*)(d + 4) = o2;
    }
}
#ifndef PEER_FP4_MASK
#define PEER_FP4_MASK 3
#endif
constexpr float U_SCALE4 = 56.f, V_SCALE4 = 5.8333333f;
DI unsigned pack8_fp4(const float4 a, const float4 b, float sc) {
    unsigned o = 0;
    o = __builtin_amdgcn_cvt_scalef32_pk_fp4_f32(o, a.x * sc, a.y * sc, 1.0f, 0);
    o = __builtin_amdgcn_cvt_scalef32_pk_fp4_f32(o, a.z * sc, a.w * sc, 1.0f, 1);
    o = __builtin_amdgcn_cvt_scalef32_pk_fp4_f32(o, b.x * sc, b.y * sc, 1.0f, 2);
    o = __builtin_amdgcn_cvt_scalef32_pk_fp4_f32(o, b.z * sc, b.w * sc, 1.0f, 3);
    return o;
}
DI void conv_chunk_fp4(const float* __restrict__ src, unsigned char* __restrict__ dst, size_t g0, int n32, float sc) {
    for (int i = opq_tid(); i < n32; i += 256) {
        const float4* s4 = (const float4*)src + 8 * (g0 + i);
        float4 t[8];
#pragma unroll
        for (int q = 0; q < 8; ++q) t[q] = s4[q];
        u32x4 o; o.x = pack8_fp4(t[0], t[1], sc); o.y = pack8_fp4(t[2], t[3], sc); o.z = pack8_fp4(t[4], t[5], sc); o.w = pack8_fp4(t[6], t[7], sc);
        ((u32x4*)dst)[g0 + i] = o;
    }
}
struct PeerLds2 {
    float trans[4][1024];
    unsigned char li[4][2][64][16];
    unsigned short pe[4][8][128];
    float pg[4][8][128];
};
template <int OFF, int NK>
DI void sort16_desc(unsigned (&k)[NK]) {
#pragma unroll
    for (int size = 2; size <= 16; size <<= 1)
#pragma unroll
        for (int stride = size >> 1; stride > 0; stride >>= 1)
#pragma unroll
            for (int i = 0; i < 16; ++i) {
                const int j = i ^ stride;
                if (j > i) {
                    const bool desc = ((i & size) == 0);
                    const unsigned a = k[OFF + i], b = k[OFF + j];
                    const unsigned hi = a > b ? a : b, lo = a > b ? b : a;
                    k[OFF + i] = desc ? hi : lo; k[OFF + j] = desc ? lo : hi;
                }
            }
}
template <int OA, int OB, int NK>
DI void merge_top16(unsigned (&k)[NK]) {
#pragma unroll
    for (int i = 0; i < 16; ++i) { const unsigned a = k[OA + i], b = k[OB + 15 - i]; k[OA + i] = a > b ? a : b; }
#pragma unroll
    for (int stride = 8; stride > 0; stride >>= 1)
#pragma unroll
        for (int i = 0; i < 16; ++i) {
            const int j = i ^ stride;
            if (j > i) { const unsigned a = k[OA + i], b = k[OA + j]; k[OA + i] = a > b ? a : b; k[OA + j] = a > b ? b : a; }
        }
}
DI void peer_retrieve(const Params& p, int l, int tok0, PeerLds2& S, int lane, int wave) {
    const int fr = lane & 15, fq = lane >> 4;
    const bf16* QP = (const bf16*)(wsb(p) + WS_PROJ);
    const bf16* PK = (const bf16*)(wsb(p) + WS_PK) + (size_t)l * 2 * 128 * 64;
    float* trans = S.trans[wave];
    unsigned K1[16], K2[16];
#pragma unroll
    for (int L = 0; L < 2; ++L) {
        f32x4 acc[4][8];
#pragma unroll
        for (int ct = 0; ct < 4; ++ct)
#pragma unroll
            for (int kt = 0; kt < 8; ++kt) acc[ct][kt] = (f32x4){0, 0, 0, 0};
#pragma unroll
        for (int kt = 0; kt < 8; ++kt) {
            const bf16* krow = PK + (size_t)L * 8192 + (size_t)(16 * kt + fr) * 64 + 8 * fq;
            const bf16x8 a0 = ld16(krow), a1 = ld16(krow + 32);
#pragma unroll
            for (int ct = 0; ct < 4; ++ct) {
                const bf16* qrow = QP + (size_t)(tok0 + 2 * ct + (fr >> 3)) * 1024 + 128 * (fr & 7) + 64 * L + 8 * fq;
                acc[ct][kt] = MFMA16(a0, ld16(qrow), acc[ct][kt]); acc[ct][kt] = MFMA16(a1, ld16(qrow + 32), acc[ct][kt]);
            }
        }
        unsigned k[128];
#define PEER_ROUND(kt)                                                                                                                            \
        {                                                                                                                                         \
            _Pragma("unroll") for (int ct = 0; ct < 4; ++ct) *(f32x4*)(trans + ((ct * 4 + fq) * 16 + fr) * 4) = acc[ct][kt];                       \
            _Pragma("unroll") for (int sq = 0; sq < 4; ++sq) {                                                                                     \
                const f32x4 v = *(const f32x4*)(trans + ((fq * 4 + sq) * 16 + fr) * 4);                                                            \
                _Pragma("unroll") for (int i = 0; i < 4; ++i) k[16 * (kt) + sq * 4 + i] = (fkey(v[i]) & ~0x7fu) | (unsigned)(16 * (kt) + 4 * sq + i); \
            }                                                                                                                                     \
            sort16_desc<16 * (kt)>(k);                                                                                                            \
        }
        PEER_ROUND(0) PEER_ROUND(1) merge_top16<0, 16>(k);
        PEER_ROUND(2) PEER_ROUND(3) merge_top16<32, 48>(k); merge_top16<0, 32>(k);
        PEER_ROUND(4) PEER_ROUND(5) merge_top16<64, 80>(k);
        PEER_ROUND(6) PEER_ROUND(7) merge_top16<96, 112>(k); merge_top16<64, 96>(k);
        merge_top16<0, 64>(k);
#undef PEER_ROUND
        u32x4 ib;
        ib.x = (k[0] & 127u) | ((k[1] & 127u) << 8) | ((k[2] & 127u) << 16) | ((k[3] & 127u) << 24);
        ib.y = (k[4] & 127u) | ((k[5] & 127u) << 8) | ((k[6] & 127u) << 16) | ((k[7] & 127u) << 24);
        ib.z = (k[8] & 127u) | ((k[9] & 127u) << 8) | ((k[10] & 127u) << 16) | ((k[11] & 127u) << 24);
        ib.w = (k[12] & 127u) | ((k[13] & 127u) << 8) | ((k[14] & 127u) << 16) | ((k[15] & 127u) << 24);
        *(u32x4*)(S.li[wave][L][lane]) = ib;
#pragma unroll
        for (int i = 0; i < 16; ++i) { if (L == 0) K1[i] = k[i]; else K2[i] = k[i]; }
    }
    float v1[16], v2[16];
#pragma unroll
    for (int i = 0; i < 16; ++i) { v1[i] = __uint_as_float(unkey(K1[i] & ~0x7fu)); v2[i] = __uint_as_float(unkey(K2[i] & ~0x7fu)); }
    unsigned c[64];
    {
        int idx = 0;
#pragma unroll
        for (int a = 0; a < 16; ++a)
#pragma unroll
            for (int b = 0; b < 16; ++b)
                if ((a + 1) * (b + 1) <= 16) { c[idx] = (fkey(v1[a] + v2[b]) & ~0xffu) | (unsigned)(a * 16 + b); ++idx; }
#pragma unroll
        for (int i = 50; i < 64; ++i) c[i] = 0u;
    }
    sort16_desc<0>(c); sort16_desc<16>(c); sort16_desc<32>(c); sort16_desc<48>(c);
    merge_top16<0, 16>(c); merge_top16<32, 48>(c); merge_top16<0, 32>(c);
    float sc[16]; float sum = 0.f;
    {
        const float m = __uint_as_float(unkey(c[0] & ~0xffu));
#pragma unroll
        for (int i = 0; i < 16; ++i) { sc[i] = __expf(__uint_as_float(unkey(c[i] & ~0xffu)) - m); sum += sc[i]; }
    }
    const float inv = 1.f / sum;
    const int tt = 2 * fq + (fr >> 3), head = fr & 7;
    const unsigned char* l1 = S.li[wave][0][lane]; const unsigned char* l2 = S.li[wave][1][lane];
#pragma unroll
    for (int i = 0; i < 16; ++i) {
        const unsigned ab = c[i] & 0xffu;
        const unsigned e = (unsigned)l1[ab >> 4] * 128u + (unsigned)l2[ab & 15u];
        S.pe[wave][tt][head * 16 + i] = (unsigned short)e; S.pg[wave][tt][head * 16 + i] = sc[i] * inv;
    }
}
template <int FMT>
DI void peer_experts(const Params& p, int l, int tok, int tt, PeerLds2& S, int lane, int wave, int emask = 0xffff) {
    const bf16* H = (const bf16*)(wsb(p) + WS_H);
    const unsigned char* UB = wsb(p) + WS_UB; const unsigned char* VB = wsb(p) + WS_VB;
    const float* X = (const float*)(wsb(p) + WS_X);
    const float* modl = (const float*)(wsb(p) + WS_MOD) + (size_t)l * 4 * 6144;
    const int b = tok >> 12;
    const unsigned short* pe = S.pe[wave][tt]; const float* pg = S.pg[wave][tt];
    f2 hp[8];
    u32x4 h0, h1;
    {
        h0 = *(const u32x4*)(H + (size_t)tok * 1024 + 16 * lane); h1 = *(const u32x4*)(H + (size_t)tok * 1024 + 16 * lane + 8);
        hp[0] = (f2){bflo(h0.x), bfhi(h0.x)}; hp[1] = (f2){bflo(h0.y), bfhi(h0.y)}; hp[2] = (f2){bflo(h0.z), bfhi(h0.z)}; hp[3] = (f2){bflo(h0.w), bfhi(h0.w)};
        hp[4] = (f2){bflo(h1.x), bfhi(h1.x)}; hp[5] = (f2){bflo(h1.y), bfhi(h1.y)}; hp[6] = (f2){bflo(h1.z), bfhi(h1.z)}; hp[7] = (f2){bflo(h1.w), bfhi(h1.w)};
    }
    f2 acc[8];
#pragma unroll
    for (int i = 0; i < 8; ++i) acc[i] = (f2){0.f, 0.f};
    const bool b5 = (lane & 32) != 0, b4_ = (lane & 16) != 0, b3 = (lane & 8) != 0;
    const int eidx = (b3 ? 4 : 0) + (b4_ ? 2 : 0) + (b5 ? 1 : 0);
    if constexpr (FMT == 1) {
    for (int e0 = 0; e0 < 128; e0 += 8) {
        u32x4 ur[8], vr[8];
#pragma unroll
        for (int j = 0; j < 8; ++j) {
            const int e = __builtin_amdgcn_readfirstlane((int)pe[e0 + j]);
            ur[j] = *(const u32x4*)(UB + (size_t)e * 1024 + 16 * lane);
            vr[j] = *(const u32x4*)(VB + (size_t)e * 1024 + 16 * lane);
        }
        float d[8];
#pragma unroll
        for (int j = 0; j < 8; ++j) {
            f2 s2 = {0.f, 0.f};
#pragma unroll
            for (int k = 0; k < 4; ++k) {
                const f2 lo = __builtin_amdgcn_cvt_pk_f32_fp8((int)ur[j][k], false), hi = __builtin_amdgcn_cvt_pk_f32_fp8((int)ur[j][k], true);
                s2 = lo * hp[2 * k] + s2; s2 = hi * hp[2 * k + 1] + s2;
            }
            d[j] = s2.x + s2.y;
        }
        float w[4], x2[2], y;
#pragma unroll
        for (int i = 0; i < 4; ++i) { const float keep = b5 ? d[2 * i + 1] : d[2 * i], send = b5 ? d[2 * i] : d[2 * i + 1]; w[i] = keep + __shfl_xor(send, 32); }
#pragma unroll
        for (int i = 0; i < 2; ++i) { const float keep = b4_ ? w[2 * i + 1] : w[2 * i], send = b4_ ? w[2 * i] : w[2 * i + 1]; x2[i] = keep + __shfl_xor(send, 16); }
        { const float keep = b3 ? x2[1] : x2[0], send = b3 ? x2[0] : x2[1]; y = keep + __shfl_xor(send, 8); }
        y += __shfl_xor(y, 4); y += __shfl_xor(y, 2); y += __shfl_xor(y, 1);
        const float sc = gelu_tanh(y * (1.f / U_SCALE)) * pg[e0 + eidx] * (1.f / V_SCALE);
#pragma unroll
        for (int j = 0; j < 8; ++j) {
            const float sj = __uint_as_float((unsigned)__builtin_amdgcn_readlane((int)__float_as_uint(sc), 32 * (j & 1) + 16 * ((j >> 1) & 1) + 8 * ((j >> 2) & 1)));
            const f2 sj2 = {sj, sj};
#pragma unroll
            for (int k = 0; k < 4; ++k) {
                const f2 lo = __builtin_amdgcn_cvt_pk_f32_fp8((int)vr[j][k], false), hi = __builtin_amdgcn_cvt_pk_f32_fp8((int)vr[j][k], true);
                acc[2 * k] = lo * sj2 + acc[2 * k]; acc[2 * k + 1] = hi * sj2 + acc[2 * k + 1];
            }
        }
    }
    } else if constexpr (FMT == 3) {
    const bool b2 = (lane & 4) != 0;
    const int eidx16 = (b2 ? 8 : 0) + eidx;
#pragma unroll 1
    for (int e0 = 0; e0 < 128; e0 += 16) {
        u32x2 ur[16], vr[16];
#pragma unroll
        for (int j = 0; j < 16; ++j) {
            const int e = __builtin_amdgcn_readfirstlane((int)pe[e0 + j]) & emask;
            ur[j] = *(const u32x2*)(UB + (size_t)e * 512 + 8 * lane);
            vr[j] = *(const u32x2*)(VB + (size_t)e * 512 + 8 * lane);
        }
        float d[16];
#pragma unroll
        for (int j = 0; j < 16; ++j) {
            f2 s2 = {0.f, 0.f};
#define FP4_DOT(k) s2 = __builtin_amdgcn_cvt_scalef32_pk_f32_fp4(ur[j].x, 1.0f, k) * hp[k] + s2; s2 = __builtin_amdgcn_cvt_scalef32_pk_f32_fp4(ur[j].y, 1.0f, k) * hp[4 + k] + s2;
            FP4_DOT(0) FP4_DOT(1) FP4_DOT(2) FP4_DOT(3)
#undef FP4_DOT
            d[j] = s2.x + s2.y;
        }
        float w[8], x4[4], x2[2], y;
#pragma unroll
        for (int i = 0; i < 8; ++i) { const float keep = b5 ? d[2 * i + 1] : d[2 * i], send = b5 ? d[2 * i] : d[2 * i + 1]; w[i] = keep + __shfl_xor(send, 32); }
#pragma unroll
        for (int i = 0; i < 4; ++i) { const float keep = b4_ ? w[2 * i + 1] : w[2 * i], send = b4_ ? w[2 * i] : w[2 * i + 1]; x4[i] = keep + __shfl_xor(send, 16); }
#pragma unroll
        for (int i = 0; i < 2; ++i) { const float keep = b3 ? x4[2 * i + 1] : x4[2 * i], send = b3 ? x4[2 * i] : x4[2 * i + 1]; x2[i] = keep + __shfl_xor(send, 8); }
        { const float keep = b2 ? x2[1] : x2[0], send = b2 ? x2[0] : x2[1]; y = keep + __shfl_xor(send, 4); }
        y += __shfl_xor(y, 2); y += __shfl_xor(y, 1);
        const float sc = gelu_tanh(y * (1.f / U_SCALE4)) * pg[e0 + eidx16] * (1.f / V_SCALE4);
#pragma unroll
        for (int j = 0; j < 16; ++j) {
            const float sj = __uint_as_float((unsigned)__builtin_amdgcn_readlane((int)__float_as_uint(sc), 32 * (j & 1) + 16 * ((j >> 1) & 1) + 8 * ((j >> 2) & 1) + 4 * ((j >> 3) & 1)));
            const f2 sj2 = {sj, sj};
#define FP4_AXPY(k) acc[k] = __builtin_amdgcn_cvt_scalef32_pk_f32_fp4(vr[j].x, 1.0f, k) * sj2 + acc[k]; acc[4 + k] = __builtin_amdgcn_cvt_scalef32_pk_f32_fp4(vr[j].y, 1.0f, k) * sj2 + acc[4 + k];
            FP4_AXPY(0) FP4_AXPY(1) FP4_AXPY(2) FP4_AXPY(3)
#undef FP4_AXPY
        }
    }
    } else if constexpr (FMT == 2) {
    for (int e0 = 0; e0 < 128; e0 += 8) {
        U3 ur[8], vr[8];
#pragma unroll
        for (int j = 0; j < 8; ++j) {
            const int e = __builtin_amdgcn_readfirstlane((int)pe[e0 + j]);
            ur[j] = *(const U3*)(UB + (size_t)e * 768 + 12 * lane);
            vr[j] = *(const U3*)(VB + (size_t)e * 768 + 12 * lane);
        }
        float d[8];
#pragma unroll
        for (int jp = 0; jp < 4; ++jp) {
            u32x6 pk; pk[0] = ur[2 * jp].x; pk[1] = ur[2 * jp].y; pk[2] = ur[2 * jp].z; pk[3] = ur[2 * jp + 1].x; pk[4] = ur[2 * jp + 1].y; pk[5] = ur[2 * jp + 1].z;
            const f32x32 o = __builtin_amdgcn_cvt_scalef32_pk32_f32_fp6(pk, 1.0f);
            f2 s0 = {0.f, 0.f}, s1 = {0.f, 0.f};
#pragma unroll
            for (int k = 0; k < 8; ++k) { const f2 ua = {o[2 * k], o[2 * k + 1]}, ub = {o[16 + 2 * k], o[17 + 2 * k]}; s0 = ua * hp[k] + s0; s1 = ub * hp[k] + s1; }
            d[2 * jp] = s0.x + s0.y; d[2 * jp + 1] = s1.x + s1.y;
        }
        float w[4], x2[2], y;
#pragma unroll
        for (int i = 0; i < 4; ++i) { const float keep = b5 ? d[2 * i + 1] : d[2 * i], send = b5 ? d[2 * i] : d[2 * i + 1]; w[i] = keep + __shfl_xor(send, 32); }
#pragma unroll
        for (int i = 0; i < 2; ++i) { const float keep = b4_ ? w[2 * i + 1] : w[2 * i], send = b4_ ? w[2 * i] : w[2 * i + 1]; x2[i] = keep + __shfl_xor(send, 16); }
        { const float keep = b3 ? x2[1] : x2[0], send = b3 ? x2[0] : x2[1]; y = keep + __shfl_xor(send, 8); }
        y += __shfl_xor(y, 4); y += __shfl_xor(y, 2); y += __shfl_xor(y, 1);
        const float sc = gelu_tanh(y * (1.f / U_SCALE6)) * pg[e0 + eidx] * (1.f / V_SCALE6);
#pragma unroll
        for (int jp = 0; jp < 4; ++jp) {
            u32x6 pk; pk[0] = vr[2 * jp].x; pk[1] = vr[2 * jp].y; pk[2] = vr[2 * jp].z; pk[3] = vr[2 * jp + 1].x; pk[4] = vr[2 * jp + 1].y; pk[5] = vr[2 * jp + 1].z;
            const f32x32 o = __builtin_amdgcn_cvt_scalef32_pk32_f32_fp6(pk, 1.0f);
            const int ja = 2 * jp, jb = 2 * jp + 1;
            const float sa = __uint_as_float((unsigned)__builtin_amdgcn_readlane((int)__float_as_uint(sc), 32 * (ja & 1) + 16 * ((ja >> 1) & 1) + 8 * ((ja >> 2) & 1)));
            const float sb = __uint_as_float((unsigned)__builtin_amdgcn_readlane((int)__float_as_uint(sc), 32 * (jb & 1) + 16 * ((jb >> 1) & 1) + 8 * ((jb >> 2) & 1)));
            const f2 sa2 = {sa, sa}, sb2 = {sb, sb};
#pragma unroll
            for (int i = 0; i < 8; ++i) { const f2 va = {o[2 * i], o[2 * i + 1]}, vb = {o[16 + 2 * i], o[17 + 2 * i]}; acc[i] = va * sa2 + acc[i]; acc[i] = vb * sb2 + acc[i]; }
        }
    }
    } else {
    for (int e0 = 0; e0 < 128; e0 += 4) {
        const bf16* UBb = (const bf16*)UB; const bf16* VBb = (const bf16*)VB;
        u32x4 ur[4][2], vr[4][2];
#pragma unroll
        for (int j = 0; j < 4; ++j) {
            const int e = __builtin_amdgcn_readfirstlane((int)pe[e0 + j]);
            ur[j][0] = *(const u32x4*)(UBb + (size_t)e * 1024 + 16 * lane); ur[j][1] = *(const u32x4*)(UBb + (size_t)e * 1024 + 16 * lane + 8);
            vr[j][0] = *(const u32x4*)(VBb + (size_t)e * 1024 + 16 * lane); vr[j][1] = *(const u32x4*)(VBb + (size_t)e * 1024 + 16 * lane + 8);
        }
        float d[4];
#pragma unroll
        for (int j = 0; j < 4; ++j) {
            float sa = 0.f, sb = 0.f;
            sa = dot2bf(ur[j][0].x, h0.x, sa); sb = dot2bf(ur[j][0].y, h0.y, sb); sa = dot2bf(ur[j][0].z, h0.z, sa); sb = dot2bf(ur[j][0].w, h0.w, sb);
            sa = dot2bf(ur[j][1].x, h1.x, sa); sb = dot2bf(ur[j][1].y, h1.y, sb); sa = dot2bf(ur[j][1].z, h1.z, sa); sb = dot2bf(ur[j][1].w, h1.w, sb);
            d[j] = sa + sb;
        }
        float w[2], y;
#pragma unroll
        for (int i = 0; i < 2; ++i) { const float keep = b5 ? d[2 * i + 1] : d[2 * i], send = b5 ? d[2 * i] : d[2 * i + 1]; w[i] = keep + __shfl_xor(send, 32); }
        { const float keep = b4_ ? w[1] : w[0], send = b4_ ? w[0] : w[1]; y = keep + __shfl_xor(send, 16); }
        y += __shfl_xor(y, 8); y += __shfl_xor(y, 4); y += __shfl_xor(y, 2); y += __shfl_xor(y, 1);
        const float sc = gelu_tanh(y) * pg[e0 + (b4_ ? 2 : 0) + (b5 ? 1 : 0)];
#pragma unroll
        for (int j = 0; j < 4; ++j) {
            const float sj = __uint_as_float((unsigned)__builtin_amdgcn_readlane((int)__float_as_uint(sc), 32 * (j & 1) + 16 * ((j >> 1) & 1)));
            const f2 sj2 = {sj, sj};
#pragma unroll
            for (int hh = 0; hh < 2; ++hh)
#pragma unroll
                for (int k = 0; k < 4; ++k) { const unsigned dw = vr[j][hh][k]; const f2 vv = {bflo(dw), bfhi(dw)}; acc[4 * hh + k] = vv * sj2 + acc[4 * hh + k]; }
        }
    }
    }
    float xr[16];
    const float* xrow = X + (size_t)tok * 1024 + 16 * lane;
    float* xorow = p.out + (size_t)tok * 1024 + 16 * lane;
    const float* g2 = modl + (size_t)b * 6144 + 5 * 1024 + 16 * lane;
    float ss = 0;
#pragma unroll
    for (int q4 = 0; q4 < 4; ++q4) {
        const float4 xv = *(const float4*)(xrow + 4 * q4), gv = *(const float4*)(g2 + 4 * q4);
        float4 o; o.x = xv.x + gv.x * acc[2 * q4].x; o.y = xv.y + gv.y * acc[2 * q4].y; o.z = xv.z + gv.z * acc[2 * q4 + 1].x; o.w = xv.w + gv.w * acc[2 * q4 + 1].y;
        if (l == 0) *(float4*)(xorow + 4 * q4) = o;
        xr[4 * q4] = o.x; xr[4 * q4 + 1] = o.y; xr[4 * q4 + 2] = o.z; xr[4 * q4 + 3] = o.w;
        ss += o.x * o.x + o.y * o.y + o.z * o.z + o.w * o.w;
    }
    ss = wave_sum(ss);
    const float r = rsqrtf(ss * (1.f / 1024.f) + 1e-6f);
    if (l == 1) {
#pragma unroll
        for (int q4 = 0; q4 < 4; ++q4) {
            const float4 gv = *(const float4*)(p.in[28] + 16 * lane + 4 * q4);
            float4 o; o.x = xr[4 * q4] * r * gv.x; o.y = xr[4 * q4 + 1] * r * gv.y; o.z = xr[4 * q4 + 2] * r * gv.z; o.w = xr[4 * q4 + 3] * r * gv.w;
            *(float4*)(xorow + 4 * q4) = o;
        }
    } else {
        const float* g = p.in[2] + 1024 + 16 * lane; const float* mod1 = (const float*)(wsb(p) + WS_MOD) + ((size_t)4 + b) * 6144 + 16 * lane;
        bf16* hrow = (bf16*)(wsb(p) + WS_H2) + (size_t)tok * 1024 + 16 * lane;
        float hv[16];
#pragma unroll
        for (int q4 = 0; q4 < 4; ++q4) {
            const float4 gg = *(const float4*)(g + 4 * q4), s1 = *(const float4*)(mod1 + 1024 + 4 * q4), s0 = *(const float4*)(mod1 + 4 * q4);
            hv[4 * q4] = xr[4 * q4] * r * gg.x * (1.f + s1.x) + s0.x; hv[4 * q4 + 1] = xr[4 * q4 + 1] * r * gg.y * (1.f + s1.y) + s0.y;
            hv[4 * q4 + 2] = xr[4 * q4 + 2] * r * gg.z * (1.f + s1.z) + s0.z; hv[4 * q4 + 3] = xr[4 * q4 + 3] * r * gg.w * (1.f + s1.w) + s0.w;
        }
        u32x4 o0, o1;
        o0.x = cvt_pk_bf16(hv[0], hv[1]); o0.y = cvt_pk_bf16(hv[2], hv[3]); o0.z = cvt_pk_bf16(hv[4], hv[5]); o0.w = cvt_pk_bf16(hv[6], hv[7]);
        o1.x = cvt_pk_bf16(hv[8], hv[9]); o1.y = cvt_pk_bf16(hv[10], hv[11]); o1.z = cvt_pk_bf16(hv[12], hv[13]); o1.w = cvt_pk_bf16(hv[14], hv[15]);
        *(u32x4*)(hrow) = o0; *(u32x4*)(hrow + 8) = o1;
    }
}

constexpr int SMEM_BYTES = LDS_BYTES;
#ifndef REP_MASK
#define REP_MASK 0xffff
#endif
#ifndef REP_ID
#define REP_ID -1
#endif
#ifndef REP_N
#define REP_N 1
#endif
#define NREP(id) ((id) == REP_ID ? REP_N : 1)
__global__ void __launch_bounds__(512, 2) fwd_megakernel(Params p) {
    unsigned char* smem = g_lds;
    const int tid = threadIdx.x, half = __builtin_amdgcn_readfirstlane(tid >> 8);
    const int Gp = gridDim.x, bidp = blockIdx.x;
    const int G = Gp * 2, bid = bidp + half * Gp;
    unsigned char* sm = smem + half * 65536;
    volatile int* qslot = (volatile int*)(smem + LDS_CTL + 16) + half;
    if (tid < 64) ((unsigned*)(smem + LDS_CTL))[tid] = 0u;
    __syncthreads();
    unsigned* ctl = (unsigned*)(wsb(p) + WS_CTL);
    unsigned* qctr = ctl + 4096;
    XcdBarrier bar = xcd_barrier_post(ctl, (volatile LAS unsigned*)(smem + LDS_CTL));
#define PHASE_PTRS unsigned char* ws = wsb(p); const bf16* H = (const bf16*)(ws + WS_H); bf16* PROJ = (bf16*)(ws + WS_PROJ); float* X = (float*)(ws + WS_X); const float* mod = (const float*)(ws + WS_MOD); (void)H; (void)PROJ; (void)X; (void)mod;
    int qn = 0;

    for (int rep = 0; rep < NREP(0); ++rep) {
            PHASE_PTRS
        constexpr int N_MOD = 192, N_LAYER = 192 + 256 + 128 + 128 + 256 + 256 + 16, N_PK = 4, N_GW = 128, N_PW = 8;
        constexpr int NV = N_MOD + 2 * N_LAYER + N_PK + N_GW + N_PW;
        for (int vb = bid; vb < NV; vb += G) {
            int v = vb;
            if (v < N_MOD) { it_mod(p, v, sm); continue; }
            v -= N_MOD;
            if (v < 2 * N_LAYER) {
                const int l = v / N_LAYER; v -= l * N_LAYER;
                bf16* wtin = (bf16*)(ws + WS_WTIN) + (size_t)l * NPROJ * 1024;
                const float* win = p.in[6] + (size_t)l * 1024 * 1732;
                bf16* wtout = (bf16*)(ws + WS_WTOUT) + (size_t)l * 1024 * KMIX;
                const float* wout = p.in[22] + (size_t)l * 1024 * 1024;
                if (v < 192) { it_transpose(TrArgs{win, 1732, 0, 1732, wtin, 1024, 0, 1024, 768, 0, nullptr}, v, sm); }
                else if ((v -= 192) < 256) { it_transpose(TrArgs{win, 1732, 0, 1732, wtin + (size_t)C_QA * 1024, 1024, 0, 1024, 1024, 1, p.in[20] + (size_t)l * 8 * 64 * 128}, v, sm); }
                else if ((v -= 256) < 128) { it_transpose(TrArgs{win, 1732, 1280, 1732, wtin + (size_t)C_CKV * 1024, 1024, 0, 1024, 512, 0, nullptr}, v, sm); }
                else if ((v -= 128) < 128) { it_transpose(TrArgs{wout, 1024, 0, 1024, wtout, KMIX, 0, 512, 1024, 0, nullptr}, v, sm); }
                else if ((v -= 128) < 256) { it_transpose(TrArgs{wout, 1024, 0, 1024, wtout, KMIX, 512, 1024, 1024, 2, p.in[21] + (size_t)l * 8 * 128 * 64}, v, sm); }
                else if ((v -= 256) < 256) { it_transpose(TrArgs{p.in[23] + (size_t)l * 1024 * 1024, 1024, 0, 1024, (bf16*)(ws + WS_WTQ) + (size_t)l * 1024 * 1024, 1024, 0, 1024, 1024, 0, nullptr}, v, sm); }
                else { v -= 256; it_transpose(TrArgs{p.in[15] + (size_t)l * 256 * 256, 256, 0, 256, (bf16*)(ws + WS_WTGLU) + (size_t)l * 256 * 256, 256, 0, 256, 256, 0, nullptr}, v, sm); }
                continue;
            }
            v -= 2 * N_LAYER;
            if (v < N_PK) { const int l = v >> 1, w = v & 1; conv_chunk(p.in[24 + w] + (size_t)l * 8192, (bf16*)(ws + WS_PK) + (size_t)l * 16384 + w * 8192, 0, 1024); continue; }
            v -= N_PK;
            if (v < N_GW) { it_gw(p, v); continue; }
            v -= N_GW;
            it_ssm_pw(p, v);
        }
        xcd_barrier(bar);
    }
    for (int rep = 0; rep < NREP(1); ++rep) {
            PHASE_PTRS
        constexpr int N_NORM = NTOK / 4, N_TAB = 4096, N_KT = 256;
        for (int vb = bid; vb < N_NORM + N_TAB + N_KT; vb += G) {
            if (vb < N_KT) { it_ssm_kt(p, vb, sm); continue; }
            if (vb - N_KT < N_NORM) {
                const int t_ = opq_tid(); const int row = (vb - N_KT) * 4 + (t_ >> 6);
                const float* m0 = (const float*)(wsb(p) + WS_MOD) + (size_t)(row >> 12) * 6144;
                norm_mod_row(p.in[0] + (size_t)row * 1024, p.in[2], m0, m0 + 1024, (bf16*)(wsb(p) + WS_H) + (size_t)row * 1024, t_ & 63);
            } else {
                const size_t base = (size_t)(vb - N_KT - N_NORM) * 2048;
                const int t_ = opq_tid();
#pragma unroll
                for (int e = 0; e < 8; ++e) ssm_tab_entry(p, base + e * 256 + t_);
            }
        }
        xcd_barrier(bar);
    }

    for (int l = 0; l < 2; ++l) {
        const float* xin = l == 0 ? p.in[0] : p.out;
        for (int rep = 0; rep < NREP(2 + 8 * l); ++rep) {
            PHASE_PTRS
            const bf16* Hin = l == 0 ? H : (const bf16*)(ws + WS_H2);
            pg8::StaticOrder S; S.init(NTOK, 2048, Gp, bidp);
            pg8::gemm_phase<Epi256<EpiBf16>, pg8::StaticOrder, true, true>((PG8_LAS unsigned char*)g_lds, pg8::Gemm{Hin, (const bf16*)(ws + WS_WTIN) + (size_t)l * NPROJ * 1024, NTOK, 2048, 1024}, S, Epi256<EpiBf16>{EpiBf16{PROJ, NPROJ}});
            xcd_barrier(bar);
        }
        for (int rep = 0; rep < NREP(3 + 8 * l); ++rep) {
            PHASE_PTRS
            {
                const bf16* Hin = l == 0 ? H : (const bf16*)(ws + WS_H2);
                pg8::StaticOrder S; S.init(NTOK, 256, Gp, bidp);
                pg8::gemm_phase<Epi256<EpiBf16>, pg8::StaticOrder, false, true>((PG8_LAS unsigned char*)g_lds, pg8::Gemm{Hin, (const bf16*)(ws + WS_WTIN) + ((size_t)l * NPROJ + 2048) * 1024, NTOK, 256, 1024}, S, Epi256<EpiBf16>{EpiBf16{PROJ + 2048, NPROJ}});
            }
            unsigned* ctr = qctr + 64 * (qn++);
            for (;;) {
                const int it = q_next(ctr, qslot);
                if (it >= 2048) break;
                const bool extra = rep + 1 < NREP(3 + 8 * l);
                const int ty = it < 1024 ? 0 : it < 1536 ? 1 : it < 1792 ? 2 : 3;
                if (extra && !((REP_MASK >> ty) & 1)) continue;
                if (it < 1024) it_dsa_index_select(p, it, sm, extra ? ((REP_MASK >> 4) & 31) : 3);
                else if (it < 1536) it_gmlp(p, l, it - 1024, sm);
                else if (it < 1792) it_ssm_a(p, l, it - 1536);
                else it_kvn(p, l, it - 1792);
            }
            xcd_barrier(bar);
        }
        for (int rep = 0; rep < NREP(4 + 8 * l); ++rep) {
            PHASE_PTRS
            unsigned* ctr = qctr + 64 * (qn++);
            for (;;) {
                const int it = q_next(ctr, qslot);
                if (it >= 256 + 1024 + 512) break;
                { const bool extra = rep + 1 < NREP(4 + 8 * l); const int ty = it < 256 ? 0 : it < 1280 ? 1 : 2; if (extra && !((REP_MASK >> (8 + ty)) & 1)) continue; }
                if (it < 256) it_ssm_c(p, l, it, sm, (rep + 1 < NREP(4 + 8 * l)) ? ((REP_MASK >> 12) & 7) : 7);
                else if (it < 1280) it_dsa_attn(p, it - 256, sm);
                else {
                    const int v = it - 1280, w = v >> 8, ch = v & 255;
                    if (PEER_FP4_MASK & (1 << l)) conv_chunk_fp4(p.in[26 + w] + (size_t)l * NEXP * 1024, ws + (w ? WS_VB : WS_UB), (size_t)ch * 2048, 2048, w ? V_SCALE4 : U_SCALE4);
                    else if (PEER_FP6_MASK & (1 << l)) conv_chunk_fp6(p.in[26 + w] + (size_t)l * NEXP * 1024, ws + (w ? WS_VB : WS_UB), (size_t)ch * 2048, 2048, w ? V_SCALE6 : U_SCALE6);
                    else if (!(PEER_FP8_MASK & (1 << l))) conv_chunk(p.in[26 + w] + (size_t)l * NEXP * 1024, (bf16*)(ws + (w ? WS_VB : WS_UB)), (size_t)ch * 8192, 8192);
                    else conv_chunk_fp8(p.in[26 + w] + (size_t)l * NEXP * 1024, ws + (w ? WS_VB : WS_UB), (size_t)ch * 4096, 4096, w ? V_SCALE : U_SCALE);
                }
            }
            xcd_barrier(bar);
        }
        for (int rep = 0; rep < NREP(5 + 8 * l); ++rep) {
            PHASE_PTRS
            const EpiGlu epi{(const bf16*)(ws + WS_YG), p.in[16] + l * 256, (bf16*)(ws + WS_MIX)};
            const bf16* Bt = (const bf16*)(ws + WS_WTGLU) + (size_t)l * 256 * 256;
            for (int t = bid; t < (NTOK / 64) * 2; t += G) gemm_tile64((const bf16*)(ws + WS_YG), 256, Bt, 256, 256, (t >> 1) * 64, (t & 1) * 128, (bf16*)sm, epi);
            xcd_barrier(bar);
        }
        for (int rep = 0; rep < NREP(6 + 8 * l); ++rep) {
            PHASE_PTRS
            pg8::StaticOrder S; S.init(NTOK, 1024, Gp, bidp);
            pg8::gemm_phase<Epi256<EpiResid>, pg8::StaticOrder, false, true>((PG8_LAS unsigned char*)g_lds, pg8::Gemm{(const bf16*)(ws + WS_MIX), (const bf16*)(ws + WS_WTOUT) + (size_t)l * 1024 * KMIX, NTOK, 1024, KMIX}, S, Epi256<EpiResid>{EpiResid{xin, X, mod + (size_t)l * 4 * 6144 + 2048}});
            xcd_barrier(bar);
        }
        for (int rep = 0; rep < NREP(7 + 8 * l); ++rep) {
            PHASE_PTRS
            for (int vb = bid; vb < NTOK / 4; vb += G) {
                const int t_ = opq_tid(); const int row = vb * 4 + (t_ >> 6);
                const float* m0 = (const float*)(wsb(p) + WS_MOD) + ((size_t)l * 4 + (row >> 12)) * 6144 + 3072;
                norm_mod_row((const float*)(wsb(p) + WS_X) + (size_t)row * 1024, p.in[3] + l * 1024, m0, m0 + 1024, (bf16*)(wsb(p) + WS_H) + (size_t)row * 1024, t_ & 63);
            }
            xcd_barrier(bar);
        }
        for (int rep = 0; rep < NREP(8 + 8 * l); ++rep) {
            PHASE_PTRS
            pg8::StaticOrder S; S.init(NTOK, 1024, Gp, bidp);
            pg8::gemm_phase<Epi256<EpiBf16>, pg8::StaticOrder, false, true>((PG8_LAS unsigned char*)g_lds, pg8::Gemm{H, (const bf16*)(ws + WS_WTQ) + (size_t)l * 1024 * 1024, NTOK, 1024, 1024}, S, Epi256<EpiBf16>{EpiBf16{PROJ, 1024}});
            xcd_barrier(bar);
        }
        for (int rep = 0; rep < NREP(9 + 8 * l); ++rep) {
            PHASE_PTRS
            PeerLds2& S = *(PeerLds2*)sm;
            hsync();
            const int t_ = opq_tid(), lane_ = t_ & 63, wave_ = t_ >> 6;
            for (int wb = bid * 4 + wave_; wb < NTOK / 8; wb += G * 4) {
                peer_retrieve(p, l, wb * 8, S, lane_, wave_);
                for (int tt = 0; tt < 8; ++tt) {
                    if (PEER_FP4_MASK & (1 << l)) peer_experts<3>(p, l, wb * 8 + tt, tt, S, lane_, wave_, (rep + 1 < NREP(9 + 8 * l) && ((REP_MASK >> 13) & 1)) ? 63 : 0xffff);
                    else if (PEER_FP6_MASK & (1 << l)) peer_experts<2>(p, l, wb * 8 + tt, tt, S, lane_, wave_);
                    else if (PEER_FP8_MASK & (1 << l)) peer_experts<1>(p, l, wb * 8 + tt, tt, S, lane_, wave_);
                    else peer_experts<0>(p, l, wb * 8 + tt, tt, S, lane_, wave_);
                }
            }
            if (l == 0 || rep + 1 < NREP(9 + 8 * l)) xcd_barrier(bar);
        }
    }
}

extern "C" void kernel_launch(void* const* d_in, const int* in_sizes, int n_in, void* d_out, int out_size, void* d_ws, size_t ws_size, hipStream_t stream) {
    if (n_in != 29 || ws_size < WS_END) { fprintf(stderr, "kernel_launch: bad args (n_in %d, ws %zu, need %zu)\n", n_in, ws_size, (size_t)WS_END); return; }
    static int grid = 0;
    if (grid == 0) {
        int dev = 0, cus = 0, per_cu = 0;
        if (hipGetDevice(&dev) != hipSuccess || hipDeviceGetAttribute(&cus, hipDeviceAttributeMultiprocessorCount, dev) != hipSuccess) { grid = -1; return; }
        if (hipFuncSetAttribute((const void*)fwd_megakernel, hipFuncAttributeMaxDynamicSharedMemorySize, LDS_BYTES) != hipSuccess) { fprintf(stderr, "kernel_launch: hipFuncSetAttribute failed\n"); grid = -1; return; }
        if (hipOccupancyMaxActiveBlocksPerMultiprocessor(&per_cu, (const void*)fwd_megakernel, 512, LDS_BYTES) != hipSuccess || per_cu < 1) { fprintf(stderr, "kernel_launch: occupancy query failed (%d)\n", per_cu); grid = -1; return; }
        grid = cus;
    }
    if (grid < 0) return;
    if (hipMemsetAsync((char*)d_ws + WS_CTL, 0, 65536, stream) != hipSuccess) { fprintf(stderr, "kernel_launch: memset failed\n"); return; }
    Params p{};
    for (int i = 0; i < 29; ++i) p.in[i] = (const float*)d_in[i];
    p.out = (float*)d_out; p.ws = (unsigned char*)d_ws;
    void* args[] = {&p};
    const hipError_t e = hipLaunchCooperativeKernel((const void*)fwd_megakernel, dim3(grid), dim3(512), args, LDS_BYTES, stream);
    if (e != hipSuccess) fprintf(stderr, "kernel_launch: cooperative launch failed: %s (grid %d)\n", hipGetErrorString(e), grid);
}
```
